# Optimizing an MI355X kernel written in HIP

```python
import math
import jax, jax.numpy as jnp
from jax import lax
import numpy as np

D_MODEL = 2048
BATCH = 4
SEQ = 4096
DEPTH = 2

MEM_TOKENS = 256
EPS = 1e-6
ROPE_THETA = 500000.0
N_EVEN = (DEPTH + 1) // 2
N_ODD = DEPTH // 2

ML_HEADS = 4
ML_DV = D_MODEL // 2 // ML_HEADS
ML_DK = ML_DV // 2
ML_CHUNK = 64
ML_CONV = 4
ML_FORGET_BIAS = 3.0
RW_HEAD = 64
RW_HEADS = D_MODEL // 2 // RW_HEAD
RW_DIM = RW_HEADS * RW_HEAD
RW_LORA_W = 64
RW_LORA_A = 64
RW_LORA_G = 128
RW_LN_EPS = 64e-5
ML_SPLITS = (2 * ML_HEADS * ML_DK, ML_HEADS * ML_DV, ML_HEADS * ML_DV, 2 * ML_HEADS)
RW_SPLITS = (RW_DIM, RW_DIM, RW_DIM, RW_LORA_W, RW_LORA_A, RW_LORA_G)
ML_COLS = sum(ML_SPLITS)
RW_COLS = sum(RW_SPLITS)
AB_COLS = ML_COLS + RW_COLS

NSA_HEADS = 16
NSA_KV = 4
NSA_REP = NSA_HEADS // NSA_KV
NSA_HD = D_MODEL // NSA_HEADS
ROPE_DIM = NSA_HD // 4
CMP_BLOCK = 32
CMP_STRIDE = 16
SEL_BLOCK = 64
SEL_TOPK = 16
WINDOW = 512
NSA_QCHUNK = 32
NSA_SPLITS = (NSA_HEADS * NSA_HD,) + (NSA_KV * NSA_HD,) * 6 + (3 * NSA_HEADS,)
NSA_COLS = sum(NSA_SPLITS)

CA_HEADS = 4
CA_HD = D_MODEL // CA_HEADS

MOE_GROUPS = 8
MOE_PER_GROUP = 8
MOE_EXPERTS = MOE_GROUPS * MOE_PER_GROUP
MOE_TOPK = 2
MOE_FF = D_MODEL // 4
MOE_ROWS = 128

kernel_name = 'hybrid_mlstm_rwkv7_nsa_hmoe'

F32 = jnp.float32


def _split(x, sizes):
    return jnp.split(x, [int(s) for s in np.cumsum(sizes)[:-1]], axis=-1)


def _rmsnorm(x, w):
    xf = x.astype(F32)
    y = xf * lax.rsqrt(jnp.mean(xf * xf, axis=-1, keepdims=True) + EPS)
    return (y * w.astype(F32)).astype(x.dtype)


def _masked_softmax(s, mask):
    s = jnp.where(mask, s.astype(F32), -jnp.inf)
    m = jnp.max(s, axis=-1, keepdims=True)
    m = jnp.where(jnp.isfinite(m), m, 0.0)
    e = jnp.exp(s - m)
    d = jnp.sum(e, axis=-1, keepdims=True)
    return e / jnp.where(d > 0, d, 1.0)


def _rope(x, pos):
    half = ROPE_DIM // 2
    inv = 1.0 / (ROPE_THETA ** (jnp.arange(half, dtype=F32) / half))
    ang = pos.astype(F32)[:, None] * inv[None, :]
    shape = (ang.shape[0],) + (1,) * (x.ndim - 3) + (half,)
    cos = jnp.cos(ang).reshape(shape)
    sin = jnp.sin(ang).reshape(shape)
    xf = x.astype(F32)
    x1 = xf[..., :half]
    x2 = xf[..., half:ROPE_DIM]
    out = jnp.concatenate([x1 * cos - x2 * sin, x2 * cos + x1 * sin, xf[..., ROPE_DIM:]], axis=-1)
    return out.astype(x.dtype)


def _token_shift(p):
    return jnp.pad(p, ((0, 0), (1, 0), (0, 0)))[:, :-1]


def _causal_conv(x, w, b):
    k_len = w.shape[0]
    s_len = x.shape[1]
    xp = jnp.pad(x, ((0, 0), (k_len - 1, 0), (0, 0)))
    y = b
    for j in range(k_len):
        y = y + xp[:, j:j + s_len] * w[j]
    return y


def _mlstm(q, k, v, i_pre, f_pre):
    B, S, H, DK = q.shape
    DV = v.shape[-1]
    L = ML_CHUNK
    NC = S // L

    def chunks(t):
        t = t.astype(F32).reshape((B, NC, L, H) + t.shape[3:])
        return t.transpose((1, 0, 3, 2) + tuple(range(4, t.ndim)))

    qc = chunks(q) * (DK ** -0.5)
    kc = chunks(k)
    vc = chunks(v)
    ic = chunks(i_pre)
    lfc = chunks(jax.nn.log_sigmoid(f_pre.astype(F32)))
    causal = jnp.asarray(np.tril(np.ones((L, L), dtype=bool)))

    def step(carry, xs):
        C, n, m = carry
        q_, k_, v_, i_, lf = xs
        b = jnp.cumsum(lf, axis=-1)
        dmat = jnp.where(causal, b[..., :, None] - b[..., None, :] + i_[..., None, :], -jnp.inf)
        inter = b + m[..., None]
        m_row = jnp.maximum(inter, jnp.max(dmat, axis=-1))
        w_in = jnp.exp(dmat - m_row[..., None])
        w_st = jnp.exp(inter - m_row)
        s = jnp.einsum('bhjd,bhld->bhjl', q_, k_) * w_in
        num = w_st[..., None] * jnp.einsum('bhjd,bhde->bhje', q_, C) + jnp.einsum('bhjl,bhle->bhje', s, v_)
        den = w_st * jnp.einsum('bhjd,bhd->bhj', q_, n) + jnp.sum(s, axis=-1)
        h = num / jnp.maximum(jnp.abs(den), jnp.exp(-m_row))[..., None]
        b_last = b[..., -1]
        g_key = b_last[..., None] - b + i_
        m_new = jnp.maximum(b_last + m, jnp.max(g_key, axis=-1))
        wk = jnp.exp(g_key - m_new[..., None])
        decay = jnp.exp(b_last + m - m_new)
        C_new = decay[..., None, None] * C + jnp.einsum('bhld,bhle->bhde', k_ * wk[..., None], v_)
        n_new = decay[..., None] * n + jnp.einsum('bhl,bhld->bhd', wk, k_)
        return (C_new, n_new, m_new), h

    init = (jnp.zeros((B, H, DK, DV), F32), jnp.zeros((B, H, DK), F32), jnp.zeros((B, H), F32))
    _, hs = lax.scan(step, init, (qc, kc, vc, ic, lfc))
    return hs.transpose(1, 0, 3, 2, 4).reshape(B, S, H, DV)


def _rwkv7_scan(r, w, k, v, kk, a):
    def step(state, xs):
        r_t, w_t, k_t, v_t, kk_t, a_t = xs
        sk = jnp.einsum('bhvk,bhk->bhv', state, kk_t)
        state = (state * w_t[:, :, None, :] - sk[..., None] * (kk_t * a_t)[:, :, None, :]
                 + v_t[..., None] * k_t[:, :, None, :])
        return state, jnp.einsum('bhvk,bhk->bhv', state, r_t)

    B, S, H, N = r.shape
    xs = tuple(t.transpose(1, 0, 2, 3) for t in (r, w, k, v, kk, a))
    _, y = lax.scan(step, jnp.zeros((B, H, N, N), F32), xs)
    return y.transpose(1, 0, 2, 3)


def _ab_mixer(h, w_in, conv_w, conv_b, gate_b, mu, w0, w_up, a0, a_up, g_up, k_k, k_a, r_k, ln_w, ln_b, w_out):
    B, S, _ = h.shape
    p = h @ w_in
    ml_p, rw_p = p[..., :ML_COLS], p[..., ML_COLS:]
    qk, v_m, o_m, gif = _split(ml_p, ML_SPLITS)
    qk = jax.nn.silu(_causal_conv(qk, conv_w, conv_b))
    q_m, k_m = jnp.split(qk, 2, axis=-1)
    gif = (gif + gate_b).astype(F32)
    h_m = _mlstm(q_m.reshape(B, S, ML_HEADS, ML_DK), k_m.reshape(B, S, ML_HEADS, ML_DK),
                 v_m.reshape(B, S, ML_HEADS, ML_DV), gif[..., :ML_HEADS], gif[..., ML_HEADS:])
    y_m = jax.nn.sigmoid(o_m.astype(F32)) * h_m.reshape(B, S, ML_HEADS * ML_DV)
    rw_p = (rw_p + (_token_shift(rw_p) - rw_p) * mu).astype(F32)
    r, k, v, xw, xa, xg = _split(rw_p, RW_SPLITS)
    logw = -math.exp(-0.5) * jax.nn.sigmoid(w0 + jnp.tanh(xw) @ w_up)
    a = jax.nn.sigmoid(a0 + xa @ a_up)
    g = jax.nn.sigmoid(xg) @ g_up

    def heads(t):
        return t.reshape(B, S, RW_HEADS, RW_HEAD)

    kk = heads(k * k_k)
    kk = kk * lax.rsqrt(jnp.sum(kk * kk, axis=-1, keepdims=True) + 1e-12)
    k = k * (1.0 + (a - 1.0) * k_a)
    rh, kh, vh, ah = heads(r), heads(k), heads(v), heads(a)
    y = _rwkv7_scan(rh, jnp.exp(heads(logw)), kh, vh, kk, ah)
    y_mu = jnp.mean(y, axis=-1, keepdims=True)
    y_var = jnp.mean(jnp.square(y - y_mu), axis=-1, keepdims=True)
    yn = ((y - y_mu) * lax.rsqrt(y_var + RW_LN_EPS)).reshape(B, S, RW_DIM) * ln_w + ln_b
    bonus = (jnp.sum(rh * kh * r_k.reshape(RW_HEADS, RW_HEAD), axis=-1, keepdims=True) * vh).reshape(B, S, RW_DIM)
    y_r = (yn + bonus) * g
    y_cat = jnp.concatenate([y_m, y_r], axis=-1).astype(h.dtype)
    return y_cat @ w_out


def _nsa(h, w_in, gate_b, cmp_pos, cmp_w1, cmp_w2, w_out):
    B, S, _ = h.shape
    G, R, HD = NSA_KV, NSA_REP, NSA_HD
    QC = NSA_QCHUNK
    scale = HD ** -0.5
    pos = jnp.arange(S)
    q, kc, vc, ks, vs, kw, vw, gl = _split(h @ w_in, NSA_SPLITS)
    q = q.reshape(B, S, G, R, HD)

    def kvh(t):
        return t.reshape(B, S, G, HD)

    q_rot = _rope(q, pos)
    ks = _rope(kvh(ks), pos)
    kw = _rope(kvh(kw), pos)
    vs = kvh(vs)
    vw = kvh(vw)
    gates = jax.nn.sigmoid((gl + gate_b).astype(F32)).reshape(B, S, 3, G, R)

    n_cmp = (S - CMP_BLOCK) // CMP_STRIDE + 1
    cidx = np.arange(n_cmp)[:, None] * CMP_STRIDE + np.arange(CMP_BLOCK)[None, :]

    def compress(t, pe, w1, w2):
        blocks = t[:, cidx] + pe[None, None, :, None, :]
        return jax.nn.gelu(jnp.einsum('bjpgd,pde->bjge', blocks, w1)) @ w2

    k_cmp = compress(kvh(kc), cmp_pos[0], cmp_w1[0], cmp_w2[0])
    v_cmp = compress(kvh(vc), cmp_pos[1], cmp_w1[1], cmp_w2[1])
    cmp_end = jnp.asarray(cidx[:, -1])

    n_sel = S // SEL_BLOCK
    c0 = np.arange(n_cmp)[:, None] * CMP_STRIDE
    s0 = np.arange(n_sel)[None, :] * SEL_BLOCK
    ov = np.clip(np.minimum(c0 + CMP_BLOCK, s0 + SEL_BLOCK) - np.maximum(c0, s0), 0, None) / CMP_BLOCK
    ov = jnp.asarray(ov, dtype=F32)
    n_top = min(SEL_TOPK, n_sel)
    k_blk = ks.reshape(B, n_sel, SEL_BLOCK, G, HD).transpose(0, 3, 1, 2, 4)
    v_blk = vs.reshape(B, n_sel, SEL_BLOCK, G, HD).transpose(0, 3, 1, 2, 4)
    kw_pad = jnp.pad(kw, ((0, 0), (WINDOW, 0), (0, 0), (0, 0)))
    vw_pad = jnp.pad(vw, ((0, 0), (WINDOW, 0), (0, 0), (0, 0)))
    bi = jnp.arange(B)[:, None, None, None]
    gi = jnp.arange(G)[None, :, None, None]
    blk_ids = jnp.arange(n_sel)

    def chunk(c):
        t0 = c * QC
        qt = t0 + jnp.arange(QC)
        q_c = lax.dynamic_slice_in_dim(q, t0, QC, axis=1)
        qr_c = lax.dynamic_slice_in_dim(q_rot, t0, QC, axis=1)
        g_c = lax.dynamic_slice_in_dim(gates, t0, QC, axis=1)
        p_cmp = _masked_softmax(jnp.einsum('bqgrd,bjgd->bgrqj', q_c, k_cmp) * scale,
                                cmp_end[None, :] <= qt[:, None])
        o_cmp = jnp.einsum('bgrqj,bjgd->bqgrd', p_cmp.astype(v_cmp.dtype), v_cmp)
        imp = jnp.einsum('bgrqj,js->bgqs', p_cmp, ov)
        cur = (qt // SEL_BLOCK)[:, None]
        forced = (blk_ids[None, :] == 0) | (blk_ids[None, :] == cur) | (blk_ids[None, :] == cur - 1)
        score = jnp.where(forced, jnp.inf, jnp.where(blk_ids[None, :] <= cur, imp, -jnp.inf))
        top_v, top_i = lax.top_k(score, n_top)
        k_g = k_blk[bi, gi, top_i].reshape(B, G, QC, n_top * SEL_BLOCK, HD)
        v_g = v_blk[bi, gi, top_i].reshape(B, G, QC, n_top * SEL_BLOCK, HD)
        kpos = (top_i[..., None] * SEL_BLOCK + jnp.arange(SEL_BLOCK)).reshape(B, G, QC, n_top * SEL_BLOCK)
        kmask = jnp.repeat(top_v > -jnp.inf, SEL_BLOCK, axis=-1) & (kpos <= qt[None, None, :, None])
        p_slc = _masked_softmax(jnp.einsum('bqgrd,bgqkd->bgrqk', qr_c, k_g) * scale, kmask[:, :, None])
        o_slc = jnp.einsum('bgrqk,bgqkd->bqgrd', p_slc.astype(v_g.dtype), v_g)
        k_w = lax.dynamic_slice_in_dim(kw_pad, t0, QC + WINDOW, axis=1)
        v_w = lax.dynamic_slice_in_dim(vw_pad, t0, QC + WINDOW, axis=1)
        wpos = t0 - WINDOW + jnp.arange(QC + WINDOW)
        dist = qt[:, None] - wpos[None, :]
        wmask = (dist >= 0) & (dist < WINDOW) & (wpos[None, :] >= 0)
        p_win = _masked_softmax(jnp.einsum('bqgrd,bkgd->bgrqk', qr_c, k_w) * scale, wmask)
        o_win = jnp.einsum('bgrqk,bkgd->bqgrd', p_win.astype(v_w.dtype), v_w)
        return (g_c[:, :, 0, :, :, None] * o_cmp + g_c[:, :, 1, :, :, None] * o_slc
                + g_c[:, :, 2, :, :, None] * o_win)

    o = lax.map(chunk, jnp.arange(S // QC))
    o = o.transpose(1, 0, 2, 3, 4, 5).reshape(B, S, NSA_HEADS * HD).astype(h.dtype)
    return o @ w_out


def _cross_attn(h, m, wq, wk, wv, wo):
    B, S, D = h.shape
    M = m.shape[1]
    q = (h @ wq).reshape(B, S, CA_HEADS, CA_HD)
    k = (m @ wk).reshape(B, M, CA_HEADS, CA_HD)
    v = (m @ wv).reshape(B, M, CA_HEADS, CA_HD)
    s = jnp.einsum('bshd,bmhd->bhsm', q, k).astype(F32) * (CA_HD ** -0.5)
    p = jax.nn.softmax(s, axis=-1).astype(v.dtype)
    o = jnp.einsum('bhsm,bmhd->bshd', p, v).reshape(B, S, D)
    return o @ wo


def _hier_moe(h, wg, bg, we, be, w_gate, w_up, w_down):
    B, S, D = h.shape
    T = B * S
    A = T * MOE_TOPK
    xt = h.reshape(T, D)
    lg = (xt @ wg + bg).astype(F32)
    grp = jnp.argmax(lg, axis=-1)
    p_grp = jnp.take_along_axis(jax.nn.softmax(lg, axis=-1), grp[:, None], axis=-1)
    le = (xt @ we + be).astype(F32).reshape(T, MOE_GROUPS, MOE_PER_GROUP)
    le = jnp.take_along_axis(le, grp[:, None, None], axis=1)[:, 0]
    top_l, top_e = lax.top_k(le, MOE_TOPK)
    wts = (p_grp * jax.nn.softmax(top_l, axis=-1)).reshape(A)
    eid = (grp[:, None] * MOE_PER_GROUP + top_e).reshape(A)
    tok = jnp.repeat(jnp.arange(T, dtype=jnp.int32), MOE_TOPK)
    order = jnp.argsort(eid)
    e_s, tok_s, w_s = eid[order], tok[order], wts[order]
    counts = jax.ops.segment_sum(jnp.ones((A,), jnp.int32), eid, num_segments=MOE_EXPERTS)
    padded = (counts + MOE_ROWS - 1) // MOE_ROWS * MOE_ROWS
    ends = jnp.cumsum(padded)
    dest = (ends - padded)[e_s] + jnp.arange(A, dtype=jnp.int32) - (jnp.cumsum(counts) - counts)[e_s]
    n_chunks = -(-A // MOE_ROWS) + MOE_EXPERTS
    rows = n_chunks * MOE_ROWS
    row_tok = jnp.full((rows,), T, jnp.int32).at[dest].set(tok_s)
    row_w = jnp.zeros((rows,), F32).at[dest].set(w_s)
    chunk_e = jnp.minimum(jnp.searchsorted(ends, jnp.arange(n_chunks, dtype=jnp.int32) * MOE_ROWS, side='right'),
                          MOE_EXPERTS - 1)
    x_pad = jnp.concatenate([xt, jnp.zeros((1, D), xt.dtype)], axis=0)

    def expert_rows(args):
        t_idx, w_r, e = args
        xr = x_pad[t_idx]
        hid = jax.nn.silu(xr @ w_gate[e]) * (xr @ w_up[e])
        y = hid @ w_down[e]
        return y * w_r[:, None].astype(y.dtype)

    out = lax.map(expert_rows, (row_tok.reshape(n_chunks, MOE_ROWS), row_w.reshape(n_chunks, MOE_ROWS), chunk_e))
    y = jax.ops.segment_sum(out.reshape(rows, D), row_tok, num_segments=T + 1)[:T]
    return y.reshape(B, S, D).astype(h.dtype)


def setup_inputs(seed: int = 0) -> dict:
    key = jax.random.key(seed)
    ks = iter(jax.random.split(key, 48))
    D = D_MODEL

    def nrm(shape, scale):
        return scale * jax.random.normal(next(ks), shape, F32)

    def gain(shape):
        return 1.0 + nrm(shape, 0.05)

    gate_offset = jnp.concatenate([jnp.zeros((ML_HEADS,), F32), jnp.full((ML_HEADS,), ML_FORGET_BIAS, F32)])
    return {
        'x': nrm((BATCH, SEQ, D), 1.0),
        'mem': nrm((BATCH, MEM_TOKENS, D), 1.0),
        'norm_mix': gain((DEPTH, D)),
        'norm_cross': gain((DEPTH, D)),
        'norm_mem': gain((DEPTH, D)),
        'norm_ffn': gain((DEPTH, D)),
        'norm_final': gain((D,)),
        'ab_w_in': nrm((N_EVEN, D, AB_COLS), D ** -0.5),
        'ml_conv_w': nrm((N_EVEN, ML_CONV, 2 * ML_HEADS * ML_DK), 0.5),
        'ml_conv_b': nrm((N_EVEN, 2 * ML_HEADS * ML_DK), 0.02),
        'ml_gate_b': nrm((N_EVEN, 2 * ML_HEADS), 0.1) + gate_offset,
        'rw_mu': 0.5 + nrm((N_EVEN, RW_COLS), 0.15),
        'rw_w0': nrm((N_EVEN, RW_DIM), 0.5),
        'rw_w_up': nrm((N_EVEN, RW_LORA_W, RW_DIM), 0.1),
        'rw_a0': nrm((N_EVEN, RW_DIM), 0.1),
        'rw_a_up': nrm((N_EVEN, RW_LORA_A, RW_DIM), 0.5 * RW_LORA_A ** -0.5),
        'rw_g_up': nrm((N_EVEN, RW_LORA_G, RW_DIM), RW_LORA_G ** -0.5),
        'rw_k_k': 0.85 + nrm((N_EVEN, RW_DIM), 0.05),
        'rw_k_a': 1.0 + nrm((N_EVEN, RW_DIM), 0.05),
        'rw_r_k': nrm((N_EVEN, RW_DIM), 0.1),
        'rw_ln_w': gain((N_EVEN, RW_DIM)),
        'rw_ln_b': nrm((N_EVEN, RW_DIM), 0.02),
        'ab_w_out': nrm((N_EVEN, ML_HEADS * ML_DV + RW_DIM, D), (ML_HEADS * ML_DV + RW_DIM) ** -0.5),
        'nsa_w_in': nrm((N_ODD, D, NSA_COLS), D ** -0.5),
        'nsa_gate_b': nrm((N_ODD, 3 * NSA_HEADS), 0.1),
        'cmp_pos': nrm((N_ODD, 2, CMP_BLOCK, NSA_HD), 0.02),
        'cmp_w1': nrm((N_ODD, 2, CMP_BLOCK, NSA_HD, NSA_HD), (CMP_BLOCK * NSA_HD) ** -0.5),
        'cmp_w2': nrm((N_ODD, 2, NSA_HD, NSA_HD), NSA_HD ** -0.5),
        'nsa_w_out': nrm((N_ODD, NSA_HEADS * NSA_HD, D), (NSA_HEADS * NSA_HD) ** -0.5),
        'ca_wq': nrm((DEPTH, D, D), D ** -0.5),
        'ca_wk': nrm((DEPTH, D, D), D ** -0.5),
        'ca_wv': nrm((DEPTH, D, D), D ** -0.5),
        'ca_wo': nrm((DEPTH, D, D), D ** -0.5),
        'moe_wg': nrm((DEPTH, D, MOE_GROUPS), D ** -0.5),
        'moe_bg': nrm((DEPTH, MOE_GROUPS), 0.01),
        'moe_we': nrm((DEPTH, D, MOE_EXPERTS), D ** -0.5),
        'moe_be': nrm((DEPTH, MOE_EXPERTS), 0.01),
        'moe_w_gate': nrm((DEPTH, MOE_EXPERTS, D, MOE_FF), D ** -0.5),
        'moe_w_up': nrm((DEPTH, MOE_EXPERTS, D, MOE_FF), D ** -0.5),
        'moe_w_down': nrm((DEPTH, MOE_EXPERTS, MOE_FF, D), MOE_FF ** -0.5),
    }


def reference(x, mem, norm_mix, norm_cross, norm_mem, norm_ffn, norm_final,
              ab_w_in, ml_conv_w, ml_conv_b, ml_gate_b, rw_mu, rw_w0, rw_w_up, rw_a0, rw_a_up, rw_g_up,
              rw_k_k, rw_k_a, rw_r_k, rw_ln_w, rw_ln_b, ab_w_out,
              nsa_w_in, nsa_gate_b, cmp_pos, cmp_w1, cmp_w2, nsa_w_out,
              ca_wq, ca_wk, ca_wv, ca_wo,
              moe_wg, moe_bg, moe_we, moe_be, moe_w_gate, moe_w_up, moe_w_down):
    for l in range(DEPTH):
        j = l // 2
        hn = _rmsnorm(x, norm_mix[l])
        if l % 2 == 0:
            x = x + _ab_mixer(hn, ab_w_in[j], ml_conv_w[j], ml_conv_b[j], ml_gate_b[j], rw_mu[j], rw_w0[j],
                              rw_w_up[j], rw_a0[j], rw_a_up[j], rw_g_up[j], rw_k_k[j], rw_k_a[j], rw_r_k[j],
                              rw_ln_w[j], rw_ln_b[j], ab_w_out[j])
        else:
            x = x + _nsa(hn, nsa_w_in[j], nsa_gate_b[j], cmp_pos[j], cmp_w1[j], cmp_w2[j], nsa_w_out[j])
        x = x + _cross_attn(_rmsnorm(x, norm_cross[l]), _rmsnorm(mem, norm_mem[l]),
                            ca_wq[l], ca_wk[l], ca_wv[l], ca_wo[l])
        x = x + _hier_moe(_rmsnorm(x, norm_ffn[l]), moe_wg[l], moe_bg[l], moe_we[l], moe_be[l],
                          moe_w_gate[l], moe_w_up[l], moe_w_down[l])
    return _rmsnorm(x, norm_final)
```

```cpp
#include <hip/hip_runtime.h>
#include <cstdio>
#include <cstdint>

#define LAS __attribute__((address_space(3)))
#define GAS __attribute__((address_space(1)))
typedef unsigned short bf16;
typedef short bf16x8 __attribute__((ext_vector_type(8)));
typedef float f32x4 __attribute__((ext_vector_type(4)));
typedef float f32x2 __attribute__((ext_vector_type(2)));
typedef unsigned u32x4 __attribute__((ext_vector_type(4)));
typedef unsigned u32x2 __attribute__((ext_vector_type(2)));

constexpr int BATCH = 4, SEQ = 4096, DM = 2048, T = BATCH * SEQ, MEMT = 256, MT = BATCH * MEMT;
constexpr float EPS = 1e-6f;
constexpr int ML_COLS = 3080, RW_COLS = 3328, AB_COLS = 6408, AB_PAD = 6656;
constexpr int NSA_COLS = 5168, NSA_PAD = 5376;
constexpr int NEXP = 64, FF = 512;
constexpr int XS_ROWS = 49152;
constexpr int SPAD = SEQ + 64;

enum { I_X = 0, I_MEM, I_NORM_MIX, I_NORM_CROSS, I_NORM_MEM, I_NORM_FFN, I_NORM_FINAL, I_AB_W_IN, I_ML_CONV_W, I_ML_CONV_B, I_ML_GATE_B,
       I_RW_MU, I_RW_W0, I_RW_W_UP, I_RW_A0, I_RW_A_UP, I_RW_G_UP, I_RW_K_K, I_RW_K_A, I_RW_R_K, I_RW_LN_W, I_RW_LN_B, I_AB_W_OUT,
       I_NSA_W_IN, I_NSA_GATE_B, I_CMP_POS, I_CMP_W1, I_CMP_W2, I_NSA_W_OUT, I_CA_WQ, I_CA_WK, I_CA_WV, I_CA_WO,
       I_MOE_WG, I_MOE_BG, I_MOE_WE, I_MOE_BE, I_MOE_W_GATE, I_MOE_W_UP, I_MOE_W_DOWN, N_INPUTS };

constexpr size_t MiB = (size_t)1 << 20;
constexpr size_t WS_CTL = 0, CTL_BYTES = 1 * MiB;
constexpr size_t WS_TAB = 1 * MiB;
constexpr size_t WS_W_ABIN = 3 * MiB;
constexpr size_t WS_W_ABOUT = WS_W_ABIN + 26 * MiB;
constexpr size_t WS_W_LORA = WS_W_ABOUT + 8 * MiB;
constexpr size_t WS_W_NSAIN = WS_W_LORA + 2 * MiB;
constexpr size_t WS_W_NSAOUT = WS_W_NSAIN + 21 * MiB;
constexpr size_t WS_W_CMP1 = WS_W_NSAOUT + 8 * MiB;
constexpr size_t WS_W_CAQ = WS_W_CMP1 + 4 * MiB;
constexpr size_t WS_W_CAK = WS_W_CAQ + 16 * MiB;
constexpr size_t WS_W_CAV = WS_W_CAK + 16 * MiB;
constexpr size_t WS_W_CAO = WS_W_CAV + 16 * MiB;
constexpr size_t WS_W_ROUTER = WS_W_CAO + 16 * MiB;
constexpr size_t WS_W_GU = WS_W_ROUTER + 2 * MiB;
constexpr size_t WS_W_DN = WS_W_GU + 512 * MiB;
constexpr size_t WS_MEMN = WS_W_DN + 256 * MiB;
constexpr size_t WS_KP = WS_MEMN + 8 * MiB;
constexpr size_t WS_VP = WS_KP + 8 * MiB;
constexpr size_t WS_WKT = WS_VP + 8 * MiB;
constexpr size_t WS_VWT = WS_WKT + 32 * MiB;
constexpr size_t WS_XR = WS_VWT + 32 * MiB;
constexpr size_t WS_XN = WS_XR + 128 * MiB;
constexpr size_t WS_ARENA = WS_XN + 64 * MiB;
constexpr size_t A_PAB = 0;
constexpr size_t A_GF32 = A_PAB + 208 * MiB;
constexpr size_t A_QM = A_GF32 + 16 * MiB;
constexpr size_t A_KM = A_QM + 16 * MiB;
constexpr size_t A_IG = A_KM + 16 * MiB;
constexpr size_t A_LF = A_IG + 1 * MiB;
constexpr size_t A_RR = A_LF + 1 * MiB;
constexpr size_t A_KR = A_RR + 32 * MiB;
constexpr size_t A_VR = A_KR + 32 * MiB;
constexpr size_t A_KK = A_VR + 32 * MiB;
constexpr size_t A_LIN = A_KK + 32 * MiB;
constexpr size_t A_WD = A_LIN + 8 * MiB;
constexpr size_t A_BV = A_WD + 64 * MiB;
constexpr size_t A_KP = A_BV + 32 * MiB;
constexpr size_t A_GG = A_KP + 32 * MiB;
constexpr size_t A_YCAT = A_GG + 32 * MiB;
constexpr size_t A_END0 = A_YCAT + 64 * MiB;
constexpr size_t A_SC = 0;
constexpr size_t A_PC = A_SC + 64 * MiB;
constexpr size_t A_LOGIT = 0;
constexpr size_t A_EID = A_LOGIT + 16 * MiB;
constexpr size_t A_WTS = A_EID + 1 * MiB;
constexpr size_t A_ROWSLOT = A_WTS + 1 * MiB;
constexpr size_t A_XS = A_ROWSLOT + 1 * MiB;
constexpr size_t A_HID = A_XS + 192 * MiB;
constexpr size_t A_YE = A_HID + 48 * MiB;
constexpr size_t A_END2 = A_YE + 128 * MiB;
constexpr size_t A_Q = 0;
constexpr size_t A_QROT = A_Q + 64 * MiB;
constexpr size_t A_KV6 = A_QROT + 64 * MiB;
constexpr size_t KV6_STRIDE = 17 * MiB;
constexpr size_t A_GATES = A_KV6 + 6 * KV6_STRIDE;
constexpr size_t A_CPART = A_GATES + 4 * MiB;
constexpr size_t A_KCMP = A_CPART + 64 * MiB;
constexpr size_t A_VCMP = A_KCMP + 1 * MiB;
constexpr size_t A_SELMASK = A_VCMP + 1 * MiB;
constexpr size_t A_OACC = A_SELMASK + 1 * MiB;
constexpr size_t A_OCAT = A_OACC + 128 * MiB;
constexpr size_t A_END3 = A_OCAT + 64 * MiB;
constexpr size_t ARENA_BYTES = 640 * MiB;
static_assert(A_END0 <= ARENA_BYTES && A_END2 <= ARENA_BYTES && A_END3 <= ARENA_BYTES, "arena");
constexpr size_t WS_END = WS_ARENA + ARENA_BYTES;
static_assert(WS_END <= (size_t)2048 * MiB, "workspace");
constexpr size_t TAB_ROPE_COS = 0, TAB_ROPE_SIN = 256 * 1024, TAB_CMPBIAS = 512 * 1024;
constexpr int CW_BAR = 4096;
constexpr int CW_MOE_CNT = 16384;
constexpr int CW_MOE_CUR = 16384 + 256;

__device__ __forceinline__ float bf2f(bf16 v) { return __uint_as_float((unsigned)v << 16); }
__device__ __forceinline__ unsigned f2bf(float f) { unsigned u = __float_as_uint(f); return (u + 0x7fffu + ((u >> 16) & 1u)) >> 16; }
__device__ __forceinline__ unsigned pk2(float lo, float hi) { return f2bf(lo) | (f2bf(hi) << 16); }
__device__ __forceinline__ float lo_bf(unsigned w) { return __uint_as_float(w << 16); }
__device__ __forceinline__ float hi_bf(unsigned w) { return __uint_as_float(w & 0xffff0000u); }
__device__ __forceinline__ float sigmoidf_(float x) { return 1.f / (1.f + __expf(-x)); }
__device__ __forceinline__ float siluf_(float x) { return x / (1.f + __expf(-x)); }
__device__ __forceinline__ float wave_sum(float v) {
#pragma unroll
    for (int o = 1; o < 64; o <<= 1) v += __shfl_xor(v, o);
    return v;
}
__device__ __forceinline__ float wave_max(float v) {
#pragma unroll
    for (int o = 1; o < 64; o <<= 1) v = fmaxf(v, __shfl_xor(v, o));
    return v;
}
__device__ __forceinline__ void unpack8(u32x4 w, float* f) {
    f[0] = lo_bf(w.x); f[1] = hi_bf(w.x); f[2] = lo_bf(w.y); f[3] = hi_bf(w.y); f[4] = lo_bf(w.z); f[5] = hi_bf(w.z); f[6] = lo_bf(w.w); f[7] = hi_bf(w.w);
}
__device__ __forceinline__ u32x4 pack8f(const float* f) { u32x4 w; w.x = pk2(f[0], f[1]); w.y = pk2(f[2], f[3]); w.z = pk2(f[4], f[5]); w.w = pk2(f[6], f[7]); return w; }

namespace pg8 {
constexpr int BM = 256, BK = 64, HALF = 128, HTB = HALF * BK * 2, STAGE_BYTES = 8 * HTB, NXCD = 8, WGM = 8;
__host__ __device__ __forceinline__ int lds_byte(int r, int c) { const int st = (r >> 4) * 2 + (c >> 5), rr = r & 15, cc = c & 31, ob = rr * 64 + cc * 2; return st * 1024 + (ob ^ (((ob >> 9) & 1) << 5)); }
__host__ __device__ __forceinline__ void stage_rc(int b, int& R, int& C) { const int st = b / 1024, sb = b % 1024, swz = sb ^ (((sb >> 9) & 1) << 5); R = (st >> 1) * 16 + swz / 64; C = (st & 1) * 32 + (swz % 64) / 2; }
__host__ __device__ __forceinline__ int perm32(int rho) { const int n = rho >> 4, i = rho & 15; return 8 * (i >> 2) + 4 * n + (i & 3); }

struct Unit { long long aoff, boff, coff; int pm, pn, aux; };
struct Gemm { const bf16* A; const bf16* Bt; int lda, ldb, K; };

__device__ __forceinline__ bool tile_of(long L, int nM, int nN, int& pm, int& pn) {
    const int nwg = nM * nN; if (L >= nwg) return false;
    int wgid = (int)L; { const int q = nwg / NXCD, r = nwg % NXCD, xcd = wgid % NXCD, off = wgid / NXCD; wgid = (xcd < r ? xcd * (q + 1) : r * (q + 1) + (xcd - r) * q) + off; }
    const int nig = WGM * nN, gid = wgid / nig, fm = gid * WGM, gsz = (nM - fm) < WGM ? (nM - fm) : WGM;
    pm = fm + ((wgid % nig) % gsz); pn = (wgid % nig) / gsz; return true;
}
struct DenseOrder {
    int nM, nN, G, c, ldc; long long astep, bstep;
    __device__ void init(int M, int N, int lda, int ldb, int ldc_, int G_, int c_) { nM = M / BM; nN = N / BM; G = G_; c = c_; ldc = ldc_; astep = (long long)BM * lda * 2; bstep = (long long)BM * ldb * 2; }
    __device__ __forceinline__ bool next(int i, Unit& u) const {
        int pm, pn; if (!tile_of((long)i * G + c, nM, nN, pm, pn)) return false;
        u.pm = pm; u.pn = pn; u.aux = 0; u.aoff = pm * astep; u.boff = pn * bstep; u.coff = (long long)pm * BM * ldc + pn * BM; return true;
    }
};

__device__ __forceinline__ unsigned cvt_pk_bf16(float lo, float hi) { unsigned r; asm volatile("v_cvt_pk_bf16_f32 %0, %1, %2" : "=v"(r) : "v"(lo), "v"(hi)); return r; }

template <class Epi, class Sched>
__device__ __forceinline__ void gemm_phase(LAS unsigned char* lds, const Gemm g, const Sched& S, const Epi& E) {
    const int tid = threadIdx.x, wid = __builtin_amdgcn_readfirstlane(tid >> 6), lane = tid & 63, wr = wid >> 2, wc = wid & 3, fr = lane & 15, fq = lane >> 4;
    const int nt = g.K / BK;
    unsigned voffA[2], voffB[2];
#pragma unroll
    for (int i = 0; i < 2; ++i) { int R, C; stage_rc(tid * 16 + i * 8192, R, C); const int Rb = (R & ~31) + perm32(R & 31);
        voffA[i] = (unsigned)(R * g.lda + C) * 2u; voffB[i] = (unsigned)(Rb * g.ldb + C) * 2u; }
    const size_t kstep = (size_t)(BK * 2);
    const size_t hstepA = (size_t)HALF * g.lda * 2, hstepB = (size_t)HALF * g.ldb * 2;
    const unsigned ldsw = (unsigned)wid * 1024u;
    const int aoff = lds_byte(wr * 64 + fr, fq * 8), boff = lds_byte(wc * 32 + fr, fq * 8);
#define PG8_SA(b, h) (((b) * 2 + (h)) * HTB)
#define PG8_SB(b, h) ((4 + (b) * 2 + (h)) * HTB)
#define PG8_STAGE(bufoff, gbase, voff) do { _Pragma("unroll") for (int _i = 0; _i < 2; ++_i) \
        __builtin_amdgcn_global_load_lds((const unsigned*)((const char*)(gbase) + (voff)[_i]), (LAS unsigned*)(lds + (bufoff) + ldsw + _i * 8192), 16, 0, 0); } while (0)
#define PG8_LDA(dst, b, h) do { _Pragma("unroll") for (int m = 0; m < 4; ++m) _Pragma("unroll") for (int k = 0; k < 2; ++k) dst[m][k] = *(const LAS bf16x8*)(lds + PG8_SA(b, h) + aoff + m * 2048 + k * 1024); } while (0)
#define PG8_LDB(dst, b, h) do { _Pragma("unroll") for (int n = 0; n < 2; ++n) _Pragma("unroll") for (int k = 0; k < 2; ++k) dst[n][k] = *(const LAS bf16x8*)(lds + PG8_SB(b, h) + boff + n * 2048 + k * 1024); } while (0)
#define PG8_MMA(ai, bj, At, Bt) do { __builtin_amdgcn_s_setprio(1); _Pragma("unroll") for (int m = 0; m < 4; ++m) _Pragma("unroll") for (int n = 0; n < 2; ++n) _Pragma("unroll") for (int k = 0; k < 2; ++k) \
        acc[ai][bj][m][n] = __builtin_amdgcn_mfma_f32_16x16x32_bf16(Bt[n][k], At[m][k], acc[ai][bj][m][n], 0, 0, 0); __builtin_amdgcn_s_setprio(0); } while (0)
#define PG8_WAIT_V(n) asm volatile("s_waitcnt vmcnt(" #n ")" ::: "memory")
#define PG8_WAIT_L(n) asm volatile("s_waitcnt lgkmcnt(" #n ")" ::: "memory")
#define PG8_BAR __builtin_amdgcn_s_barrier()
#define PG8_SCHED __builtin_amdgcn_sched_barrier(0)
    Unit cur, nxt; int ui = 0;
    if (!S.next(0, cur)) return;
    f32x4 acc[2][2][4][2];
#pragma unroll
    for (int a = 0; a < 2; ++a)
#pragma unroll
        for (int b = 0; b < 2; ++b)
#pragma unroll
            for (int m = 0; m < 4; ++m)
#pragma unroll
                for (int n = 0; n < 2; ++n) acc[a][b][m][n] = (f32x4){0.f, 0.f, 0.f, 0.f};
    bf16x8 At[4][2], B0[2][2], B1[2][2];
    const char* cA = (const char*)g.A + cur.aoff; const char* cB = (const char*)g.Bt + cur.boff;
    PG8_STAGE(PG8_SB(0, 0), cB, voffB); PG8_STAGE(PG8_SB(0, 1), cB + hstepB, voffB); PG8_STAGE(PG8_SA(0, 0), cA, voffA); PG8_STAGE(PG8_SA(0, 1), cA + hstepA, voffA);
    if (wr == 1) PG8_BAR;
    PG8_WAIT_V(2); PG8_BAR;
    PG8_STAGE(PG8_SB(1, 0), cB + kstep, voffB); PG8_STAGE(PG8_SA(1, 0), cA + kstep, voffA); PG8_STAGE(PG8_SB(1, 1), cB + hstepB + kstep, voffB);
    PG8_WAIT_V(6); PG8_BAR;
    for (;;) {
        const bool has_next = S.next(ui + 1, nxt);
        const char* nA = has_next ? (const char*)g.A + nxt.aoff : cA; const char* nB = has_next ? (const char*)g.Bt + nxt.boff : cB;
        for (int t = 0; t < nt; t += 2) {
            const bool last = (t == nt - 2);
            const char* a1 = cA + (size_t)(t + 1) * kstep;
            const char* a2 = last ? nA : cA + (size_t)(t + 2) * kstep; const char* b2 = last ? nB : cB + (size_t)(t + 2) * kstep;
            const char* a3 = a2 + kstep; const char* b3 = b2 + kstep;
            PG8_LDB(B0, 0, 0); PG8_LDB(B1, 0, 1); PG8_SCHED; PG8_LDA(At, 0, 0); PG8_STAGE(PG8_SA(1, 1), a1 + hstepA, voffA);
            PG8_WAIT_V(8); PG8_WAIT_L(0); PG8_BAR; PG8_MMA(0, 0, At, B0); PG8_MMA(0, 1, At, B1); PG8_BAR; PG8_SCHED;
            PG8_LDA(At, 0, 1); PG8_STAGE(PG8_SB(0, 0), b2, voffB); PG8_STAGE(PG8_SB(0, 1), b2 + hstepB, voffB); PG8_STAGE(PG8_SA(0, 0), a2, voffA);
            PG8_WAIT_V(8); PG8_WAIT_L(0); PG8_BAR; PG8_MMA(1, 0, At, B0); PG8_MMA(1, 1, At, B1); PG8_BAR; PG8_SCHED;
            PG8_LDB(B0, 1, 0); PG8_LDB(B1, 1, 1); PG8_SCHED; PG8_LDA(At, 1, 0); PG8_STAGE(PG8_SA(0, 1), a2 + hstepA, voffA);
            PG8_WAIT_V(8); PG8_WAIT_L(0); PG8_BAR; PG8_MMA(0, 0, At, B0); PG8_MMA(0, 1, At, B1); PG8_BAR; PG8_SCHED;
            PG8_LDA(At, 1, 1); PG8_STAGE(PG8_SB(1, 0), b3, voffB); PG8_STAGE(PG8_SB(1, 1), b3 + hstepB, voffB); PG8_STAGE(PG8_SA(1, 0), a3, voffA);
            PG8_WAIT_V(8); PG8_WAIT_L(0); PG8_BAR; PG8_MMA(1, 0, At, B0); PG8_MMA(1, 1, At, B1); PG8_BAR; PG8_SCHED;
        }
        if (wr == 0) PG8_BAR;
        E(acc, cur, wr, wc, fr, fq);
        if (!has_next) break;
#pragma unroll
        for (int a = 0; a < 2; ++a)
#pragma unroll
            for (int b = 0; b < 2; ++b)
#pragma unroll
                for (int m = 0; m < 4; ++m)
#pragma unroll
                    for (int n = 0; n < 2; ++n) acc[a][b][m][n] = (f32x4){0.f, 0.f, 0.f, 0.f};
        cur = nxt; cA = nA; cB = nB; ++ui;
        if (wr == 1) PG8_BAR;
    }
    PG8_WAIT_V(0);
    PG8_BAR;
#undef PG8_SA
#undef PG8_SB
#undef PG8_STAGE
#undef PG8_LDA
#undef PG8_LDB
#undef PG8_MMA
#undef PG8_WAIT_V
#undef PG8_WAIT_L
#undef PG8_BAR
#undef PG8_SCHED
}
}

#define XB_TMO      128
#define XB_XCNT(j)  (256  + 64 * (j))
#define XB_XSUB(j)  (1280 + 64 * (j))
#define XB_XGEN(j)  (2304 + 64 * (j))
#define XB_TOP      3328
#define XB_TOPGEN   3392
#define XCD_BAR_WORDS 3456
#define XB_SPIN_CAP (1u << 22)
__device__ __forceinline__ unsigned xb_ld(unsigned* p)              { return __hip_atomic_load(p, __ATOMIC_RELAXED, __HIP_MEMORY_SCOPE_AGENT); }
__device__ __forceinline__ unsigned xb_add(unsigned* p, unsigned v) { return __hip_atomic_fetch_add(p, v, __ATOMIC_RELAXED, __HIP_MEMORY_SCOPE_AGENT); }
__device__ __forceinline__ unsigned xb_xcc_id() { return (unsigned)__builtin_amdgcn_s_getreg((3 << 11) | 20) & 0xFu; }
#define XB_SPIN(cond, bar) do { unsigned _sp = 0; while (cond) { __builtin_amdgcn_s_sleep(1); \
    if ((++_sp & 255u) == 0u) { if (xb_ld(&(bar)[XB_TMO])) break; if (_sp > XB_SPIN_CAP) { atomicAdd(&(bar)[XB_TMO], 1u); break; } } } } while (0)
struct XcdBarrier { unsigned* bar; unsigned x; volatile LAS unsigned* st; };
__device__ __forceinline__ XcdBarrier xcd_barrier_post(unsigned* bar, volatile LAS unsigned* st) {
    XcdBarrier b; b.bar = bar; b.x = xb_xcc_id(); b.st = st;
    if (threadIdx.x == 0) (void)xb_add(&bar[XB_XCNT(b.x)], 1u);
    return b;
}
__device__ __forceinline__ void xcd_barrier_complete(unsigned* bar, unsigned x, unsigned& nloc, unsigned& nx) {
    const unsigned G = gridDim.x * gridDim.y * gridDim.z;
    unsigned sum, cnt, mine, sp = 0u;
    for (;;) {
        sum = 0u; cnt = 0u; mine = 0u;
#pragma unroll
        for (unsigned j = 0; j < 16; ++j) { const unsigned c = xb_ld(&bar[XB_XCNT(j)]); sum += c; cnt += (c > 0u) ? 1u : 0u; mine = (j == x) ? c : mine; }
        if (sum == G) break;
        __builtin_amdgcn_s_sleep(1);
        if ((++sp & 255u) == 0u) { if (xb_ld(&bar[XB_TMO])) break; if (sp > XB_SPIN_CAP) { atomicAdd(&bar[XB_TMO], 1u); break; } }
    }
    nloc = mine > 0u ? mine : 1u; nx = cnt > 0u ? cnt : 1u;
}
__device__ __forceinline__ void xcd_barrier(const XcdBarrier& b) {
    asm volatile("s_waitcnt vmcnt(0)" ::: "memory");
    __syncthreads();
    if (threadIdx.x == 0) {
        unsigned* bar = b.bar;
        __builtin_amdgcn_s_waitcnt(0);
        unsigned nloc = b.st[0], nx = b.st[1];
        if (nloc == 0u) { xcd_barrier_complete(bar, b.x, nloc, nx); b.st[0] = nloc; b.st[1] = nx; }
        const unsigned old = xb_add(&bar[XB_XSUB(b.x)], 1u);
        const unsigned gen = old / nloc;
        if (old + 1u == (gen + 1u) * nloc) {
            __builtin_amdgcn_fence(__ATOMIC_RELEASE, "agent");
            asm volatile("s_waitcnt vmcnt(0)" ::: "memory");
            const unsigned og = xb_add(&bar[XB_TOP], 1u);
            const unsigned tg = og / nx;
            if (og + 1u == (tg + 1u) * nx) xb_add(&bar[XB_TOPGEN], 1u);
            else XB_SPIN(xb_ld(&bar[XB_TOPGEN]) == tg, bar);
            __builtin_amdgcn_fence(__ATOMIC_ACQUIRE, "agent");
            xb_add(&bar[XB_XGEN(b.x)], 1u);
            asm volatile("s_waitcnt vmcnt(0)" ::: "memory");
        } else {
            XB_SPIN(xb_ld(&bar[XB_XGEN(b.x)]) == gen, bar);
            __builtin_amdgcn_fence(__ATOMIC_ACQUIRE, "agent");
            asm volatile("s_waitcnt vmcnt(0)" ::: "memory");
        }
    }
    __syncthreads();
}

constexpr int NWAVES = 8, NTHR = 512;
constexpr int LDS_MAIN = 131072;
constexpr int LDS_AUX = 131072, LDS_AUX_BYTES = 16384;
constexpr int LDS_MISC = LDS_AUX + LDS_AUX_BYTES;
constexpr int LDS_BYTES = LDS_MISC + 256;
struct Args { const float* in[N_INPUTS]; float* out; unsigned char* ws; int ph_lo, ph_hi; };

struct Ctx {
    LAS unsigned char* lds;
    int tid, lane, wave, G, bid, gw, ngw;
    unsigned char* ws;
};
#define WSP(T_, off) ((T_*)(C.ws + (off)))
#define ARP(T_, off) ((T_*)(C.ws + WS_ARENA + (off)))
#define LDS_WAIT() asm volatile("s_waitcnt lgkmcnt(0)" ::: "memory")

__device__ __forceinline__ void rms_row_bf16(const float* xrow, const float* gain, bf16* orow, int lane) {
    f32x4 v[8]; float s = 0.f;
#pragma unroll
    for (int j = 0; j < 8; ++j) { v[j] = *(const f32x4*)(xrow + (j * 64 + lane) * 4); s += v[j].x * v[j].x + v[j].y * v[j].y + v[j].z * v[j].z + v[j].w * v[j].w; }
    const float rstd = rsqrtf(wave_sum(s) * (1.f / DM) + EPS);
#pragma unroll
    for (int j = 0; j < 8; ++j) { const f32x4 g = *(const f32x4*)(gain + (j * 64 + lane) * 4);
        u32x2 w; w.x = pk2(v[j].x * rstd * g.x, v[j].y * rstd * g.y); w.y = pk2(v[j].z * rstd * g.z, v[j].w * rstd * g.w);
        *(u32x2*)(orow + (j * 64 + lane) * 4) = w; }
}

template <class F>
__device__ __forceinline__ void transpose_tile(const float* W, int ldw, int nvalid, int k0, int n0, bf16* WT, int ldt, F drow, LAS float* scr, int lane) {
    const int nn = n0 + (lane & 31);
#pragma unroll 8
    for (int i = 0; i < 32; ++i) { const int kk = 2 * i + (lane >> 5); scr[kk * 33 + (lane & 31)] = (nn < nvalid) ? W[(size_t)(k0 + kk) * ldw + nn] : 0.f; }
    LDS_WAIT(); asm volatile("" ::: "memory");
    const int c = lane & 7;
#pragma unroll
    for (int j = 0; j < 4; ++j) { const int n = (lane >> 3) + 8 * j; const LAS float* s = scr + (8 * c) * 33 + n;
        u32x4 o; o.x = pk2(s[0 * 33], s[1 * 33]); o.y = pk2(s[2 * 33], s[3 * 33]); o.z = pk2(s[4 * 33], s[5 * 33]); o.w = pk2(s[6 * 33], s[7 * 33]);
        *(u32x4*)(WT + (size_t)drow(n0 + n) * ldt + k0 + 8 * c) = o; }
    LDS_WAIT(); asm volatile("" ::: "memory");
}
template <class F>
__device__ __forceinline__ void transpose_matrix(const Ctx& C, const float* W, int K, int N, int Npad, bf16* WT, int ldt, F drow, LAS float* scr) {
    const int nblk = Npad / 32, items = (K / 64) * nblk;
    for (int it = C.gw; it < items; it += C.ngw) { const int kb = it / nblk, nb = it % nblk; transpose_tile(W, N, N, kb * 64, nb * 32, WT, ldt, drow, scr, C.lane); }
}

#define EPI_ARGS const f32x4 (&acc)[2][2][4][2], const pg8::Unit& u, int wr, int wc, int fr, int fq
struct EpiStoreBf16 {
    bf16* O; int ldc; float scale;
    __device__ __forceinline__ void operator()(EPI_ARGS) const {
        bf16* base = O + u.coff + (size_t)(wr * 64 + fr) * ldc + wc * 32 + 8 * fq;
#pragma unroll
        for (int ai = 0; ai < 2; ++ai)
#pragma unroll
            for (int m = 0; m < 4; ++m) { bf16* rowp = base + (size_t)(ai * 128 + m * 16) * ldc;
#pragma unroll
                for (int bj = 0; bj < 2; ++bj) { const f32x4 v0 = acc[ai][bj][m][0] * scale, v1 = acc[ai][bj][m][1] * scale;
                    u32x4 w; w.x = pg8::cvt_pk_bf16(v0[0], v0[1]); w.y = pg8::cvt_pk_bf16(v0[2], v0[3]); w.z = pg8::cvt_pk_bf16(v1[0], v1[1]); w.w = pg8::cvt_pk_bf16(v1[2], v1[3]);
                    *(u32x4*)(rowp + bj * 128) = w; } }
    }
};
struct EpiStoreF32 {
    float* O; int ldc;
    __device__ __forceinline__ void operator()(EPI_ARGS) const {
        float* base = O + u.coff + (size_t)(wr * 64 + fr) * ldc + wc * 32 + 8 * fq;
#pragma unroll
        for (int ai = 0; ai < 2; ++ai)
#pragma unroll
            for (int m = 0; m < 4; ++m) { float* rowp = base + (size_t)(ai * 128 + m * 16) * ldc;
#pragma unroll
                for (int bj = 0; bj < 2; ++bj) { *(f32x4*)(rowp + bj * 128) = acc[ai][bj][m][0]; *(f32x4*)(rowp + bj * 128 + 4) = acc[ai][bj][m][1]; } }
    }
};
struct EpiResid {
    const float* base; float* out; int ldc;
    __device__ __forceinline__ void operator()(EPI_ARGS) const {
        const size_t o0 = (size_t)u.coff + (size_t)(wr * 64 + fr) * ldc + wc * 32 + 8 * fq;
#pragma unroll
        for (int ai = 0; ai < 2; ++ai)
#pragma unroll
            for (int m = 0; m < 4; ++m) { const size_t o = o0 + (size_t)(ai * 128 + m * 16) * ldc;
#pragma unroll
                for (int bj = 0; bj < 2; ++bj) {
                    const f32x4 b0 = *(const f32x4*)(base + o + bj * 128), b1 = *(const f32x4*)(base + o + bj * 128 + 4);
                    *(f32x4*)(out + o + bj * 128) = b0 + acc[ai][bj][m][0]; *(f32x4*)(out + o + bj * 128 + 4) = b1 + acc[ai][bj][m][1]; } }
    }
};
struct EpiAbIn {
    bf16* P; float* G32;
    __device__ __forceinline__ void operator()(EPI_ARGS) const {
        const int row0 = u.pm * 256 + wr * 64 + fr, col0 = u.pn * 256 + wc * 32 + 8 * fq;
#pragma unroll
        for (int ai = 0; ai < 2; ++ai)
#pragma unroll
            for (int m = 0; m < 4; ++m) { const int row = row0 + ai * 128 + m * 16; bf16* rowp = P + (size_t)row * AB_PAD + col0;
#pragma unroll
                for (int bj = 0; bj < 2; ++bj) { const f32x4 v0 = acc[ai][bj][m][0], v1 = acc[ai][bj][m][1];
                    u32x4 w; w.x = pg8::cvt_pk_bf16(v0[0], v0[1]); w.y = pg8::cvt_pk_bf16(v0[2], v0[3]); w.z = pg8::cvt_pk_bf16(v1[0], v1[1]); w.w = pg8::cvt_pk_bf16(v1[2], v1[3]);
                    *(u32x4*)(rowp + bj * 128) = w;
                    if (u.pn == 12) { float* g = G32 + (size_t)row * 256 + wc * 32 + 8 * fq + bj * 128; *(f32x4*)g = v0; *(f32x4*)(g + 4) = v1; } } }
    }
};
struct EpiLora {
    const float *w0, *a0, *k_a; const bf16 *KK, *KR; float* WD; bf16 *BV, *KP, *GG;
    __device__ __forceinline__ void operator()(EPI_ARGS) const {
        const int grp = u.pn >> 2, row0 = u.pm * 256 + wr * 64 + fr, cc0 = (u.pn & 3) * 256 + wc * 32 + 8 * fq;
#pragma unroll
        for (int ai = 0; ai < 2; ++ai)
#pragma unroll
            for (int m = 0; m < 4; ++m) { const size_t ro = (size_t)(row0 + ai * 128 + m * 16) * 1024;
#pragma unroll
                for (int bj = 0; bj < 2; ++bj) { const int cc = cc0 + bj * 128; float v[8];
#pragma unroll
                    for (int j = 0; j < 4; ++j) { v[j] = acc[ai][bj][m][0][j]; v[4 + j] = acc[ai][bj][m][1][j]; }
                    if (grp == 0) { float o[8];
#pragma unroll
                        for (int j = 0; j < 8; ++j) o[j] = __expf(-0.6065306597126334f * sigmoidf_(w0[cc + j] + v[j]));
                        *(f32x4*)(WD + ro + cc) = (f32x4){o[0], o[1], o[2], o[3]}; *(f32x4*)(WD + ro + cc + 4) = (f32x4){o[4], o[5], o[6], o[7]};
                    } else if (grp == 1) { float kk[8], kr[8], ob[8], ok[8];
                        unpack8(*(const u32x4*)(KK + ro + cc), kk); unpack8(*(const u32x4*)(KR + ro + cc), kr);
#pragma unroll
                        for (int j = 0; j < 8; ++j) { const float a = sigmoidf_(a0[cc + j] + v[j]); ob[j] = kk[j] * a; ok[j] = kr[j] * (1.f + (a - 1.f) * k_a[cc + j]); }
                        *(u32x4*)(BV + ro + cc) = pack8f(ob); *(u32x4*)(KP + ro + cc) = pack8f(ok);
                    } else { *(u32x4*)(GG + ro + cc) = pack8f(v); } } }
    }
};
struct EpiHid {
    bf16* H;
    __device__ __forceinline__ void operator()(EPI_ARGS) const {
        bf16* base = H + (size_t)(u.aux + wr * 64 + fr) * FF + u.pn * 128 + wc * 32 + 8 * fq;
#pragma unroll
        for (int ai = 0; ai < 2; ++ai)
#pragma unroll
            for (int m = 0; m < 4; ++m) { float h[8];
#pragma unroll
                for (int j = 0; j < 4; ++j) { h[j] = siluf_(acc[ai][0][m][0][j]) * acc[ai][1][m][0][j]; h[4 + j] = siluf_(acc[ai][0][m][1][j]) * acc[ai][1][m][1][j]; }
                *(u32x4*)(base + (size_t)(ai * 128 + m * 16) * FF) = pack8f(h); }
    }
};
struct EpiMoeDown {
    const int* rowslot; const float* wts; bf16* YE;
    __device__ __forceinline__ void operator()(EPI_ARGS) const {
#pragma unroll
        for (int ai = 0; ai < 2; ++ai)
#pragma unroll
            for (int m = 0; m < 4; ++m) { const int r = ai * 128 + wr * 64 + m * 16 + fr;
                if (r < u.pm) { const int slot = rowslot[u.aux + r]; const float w = wts[slot]; bf16* rowp = YE + (size_t)slot * DM + u.pn * 256 + wc * 32 + 8 * fq;
#pragma unroll
                    for (int bj = 0; bj < 2; ++bj) { const f32x4 v0 = acc[ai][bj][m][0] * w, v1 = acc[ai][bj][m][1] * w;
                        u32x4 o; o.x = pg8::cvt_pk_bf16(v0[0], v0[1]); o.y = pg8::cvt_pk_bf16(v0[2], v0[3]); o.z = pg8::cvt_pk_bf16(v1[0], v1[1]); o.w = pg8::cvt_pk_bf16(v1[2], v1[3]);
                        *(u32x4*)(rowp + bj * 128) = o; } } }
    }
};
struct EpiNsaIn {
    bf16 *Q, *QROT, *KV6; float* GATES; const float *gate_b, *rcos, *rsin;
    __device__ __forceinline__ void operator()(EPI_ARGS) const {
        const int pn = u.pn;
#pragma unroll
        for (int ai = 0; ai < 2; ++ai)
#pragma unroll
            for (int m = 0; m < 4; ++m) { const int t = u.pm * 256 + ai * 128 + wr * 64 + m * 16 + fr, b = t >> 12, s = t & 4095;
#pragma unroll
                for (int bj = 0; bj < 2; ++bj) { float v[8];
#pragma unroll
                    for (int j = 0; j < 4; ++j) { v[j] = acc[ai][bj][m][0][j]; v[4 + j] = acc[ai][bj][m][1][j]; }
                    const int d0 = wc * 32 + 8 * fq;
                    if (pn == 20) {
                        const int c = bj * 128 + d0;
                        if (c < 48) { float o[8];
#pragma unroll
                            for (int j = 0; j < 8; ++j) o[j] = sigmoidf_(v[j] + gate_b[c + j]);
                            float* g = GATES + (size_t)t * 48 + c; *(f32x4*)g = (f32x4){o[0], o[1], o[2], o[3]}; *(f32x4*)(g + 4) = (f32x4){o[4], o[5], o[6], o[7]}; }
                        continue; }
                    float vr[8];
                    { float pv[8];
#pragma unroll
                      for (int j = 0; j < 8; ++j) pv[j] = __shfl_xor(v[j], 32);
                      const float* cs = rcos + s * 16 + 8 * (fq & 1); const float* sn = rsin + s * 16 + 8 * (fq & 1);
#pragma unroll
                      for (int j = 0; j < 8; ++j) { const float c_ = cs[j], s_ = sn[j]; vr[j] = (fq < 2) ? (v[j] * c_ - pv[j] * s_) : (v[j] * c_ + pv[j] * s_); } }
                    if (pn < 8) { const int hh = pn * 2 + bj; const size_t o = (((size_t)(b * 16 + hh)) * SEQ + s) * 128 + d0;
                        *(u32x4*)(Q + o) = pack8f(v); *(u32x4*)(QROT + o) = (wc == 0) ? pack8f(vr) : pack8f(v);
                    } else { const int i6 = (pn - 8) >> 1, g = ((pn - 8) & 1) * 2 + bj; const bool rot = (i6 == 2 || i6 == 4) && wc == 0;
                        bf16* dst = (bf16*)((unsigned char*)KV6 + (size_t)i6 * KV6_STRIDE) + (((size_t)(b * 4 + g)) * SPAD + s) * 128 + d0;
                        *(u32x4*)dst = rot ? pack8f(vr) : pack8f(v); } } }
    }
};

__device__ __forceinline__ void phase_prologue(const Ctx& C, const Args& A) {
    LAS float* scr = (LAS float*)(C.lds + C.wave * 8448);
    auto ident = [](int n) { return n; };
    transpose_matrix(C, A.in[I_AB_W_IN], DM, AB_COLS, AB_PAD, WSP(bf16, WS_W_ABIN), DM, ident, scr);
    transpose_matrix(C, A.in[I_AB_W_OUT], DM, DM, DM, WSP(bf16, WS_W_ABOUT), DM, ident, scr);
    transpose_matrix(C, A.in[I_NSA_W_IN], DM, NSA_COLS, NSA_PAD, WSP(bf16, WS_W_NSAIN), DM, ident, scr);
    transpose_matrix(C, A.in[I_NSA_W_OUT], DM, DM, DM, WSP(bf16, WS_W_NSAOUT), DM, ident, scr);
    for (int l = 0; l < 2; ++l) {
        transpose_matrix(C, A.in[I_CA_WK] + (size_t)l * DM * DM, DM, DM, DM, WSP(bf16, WS_W_CAK) + (size_t)l * DM * DM, DM, ident, scr);
        transpose_matrix(C, A.in[I_CA_WV] + (size_t)l * DM * DM, DM, DM, DM, WSP(bf16, WS_W_CAV) + (size_t)l * DM * DM, DM, ident, scr);
        transpose_matrix(C, A.in[I_CA_WO] + (size_t)l * DM * DM, DM, DM, DM, WSP(bf16, WS_W_CAO) + (size_t)l * DM * DM, DM, ident, scr);
    }
    for (int kv = 0; kv < 2; ++kv)
        transpose_matrix(C, A.in[I_CMP_W1] + (size_t)kv * 4096 * 128, 4096, 128, 128, WSP(bf16, WS_W_CMP1) + (size_t)kv * 256 * 4096, 4096, ident, scr);
    {
        auto dg = [](int n) { return (n >> 7) * 256 + (n & 127); };
        auto du = [](int n) { return (n >> 7) * 256 + 128 + (n & 127); };
        const int per = 512;
        const int total = 2 * NEXP * 3 * per;
        for (int it = C.gw; it < total; it += C.ngw) {
            const int le = it / (3 * per), r = it % (3 * per), which = r / per, q = r % per;
            if (which == 0) { const int kb = q / 16, nb = q % 16; transpose_tile(A.in[I_MOE_W_GATE] + (size_t)le * DM * FF, FF, FF, kb * 64, nb * 32, WSP(bf16, WS_W_GU) + (size_t)le * 1024 * DM, DM, dg, scr, C.lane); }
            else if (which == 1) { const int kb = q / 16, nb = q % 16; transpose_tile(A.in[I_MOE_W_UP] + (size_t)le * DM * FF, FF, FF, kb * 64, nb * 32, WSP(bf16, WS_W_GU) + (size_t)le * 1024 * DM, DM, du, scr, C.lane); }
            else { const int kb = q / 64, nb = q % 64; transpose_tile(A.in[I_MOE_W_DOWN] + (size_t)le * FF * DM, DM, DM, kb * 64, nb * 32, WSP(bf16, WS_W_DN) + (size_t)le * DM * FF, FF, ident, scr, C.lane); }
        }
    }
    const size_t gt = (size_t)C.bid * NTHR + C.tid, gn = (size_t)C.G * NTHR;
    { const float* src = A.in[I_CA_WQ]; bf16* dst = WSP(bf16, WS_W_CAQ);
      for (size_t i = gt; i < (size_t)2 * DM * DM / 4; i += gn) { const f32x4 v = *(const f32x4*)(src + i * 4); u32x2 w; w.x = pk2(v.x, v.y); w.y = pk2(v.z, v.w); *(u32x2*)(dst + i * 4) = w; } }
    { bf16* dst = WSP(bf16, WS_W_LORA);
      for (size_t i = gt; i < (size_t)3072 * 256; i += gn) { const int n = (int)(i >> 8), k = (int)(i & 255); float v = 0.f;
          if (n < 1024) { if (k < 64) v = A.in[I_RW_W_UP][k * 1024 + n]; }
          else if (n < 2048) { if (k >= 64 && k < 128) v = A.in[I_RW_A_UP][(k - 64) * 1024 + (n - 1024)]; }
          else { if (k >= 128) v = A.in[I_RW_G_UP][(k - 128) * 1024 + (n - 2048)]; }
          dst[i] = (bf16)f2bf(v); } }
    { bf16* dst = WSP(bf16, WS_W_ROUTER);
      for (size_t i = gt; i < (size_t)2 * 256 * DM; i += gn) { const int l = (int)(i / (256 * DM)), n = (int)((i / DM) & 255), k = (int)(i % DM); float v = 0.f;
          if (n < 8) v = A.in[I_MOE_WG][((size_t)l * DM + k) * 8 + n]; else if (n < 72) v = A.in[I_MOE_WE][((size_t)l * DM + k) * 64 + (n - 8)];
          dst[i] = (bf16)f2bf(v); } }
    { float* rc = WSP(float, WS_TAB + TAB_ROPE_COS); float* rs = WSP(float, WS_TAB + TAB_ROPE_SIN);
      for (size_t i = gt; i < (size_t)SEQ * 16; i += gn) { const int pos = (int)(i >> 4), j = (int)(i & 15);
          const float inv = 1.0f / powf(500000.0f, (float)j / 16.0f); const float ang = (float)pos * inv; rc[i] = cosf(ang); rs[i] = sinf(ang); } }
    for (int o = C.gw; o < 256; o += C.ngw) { const int kv = o >> 7, e = o & 127; float s = 0.f;
        for (int i = C.lane; i < 4096; i += 64) s += A.in[I_CMP_POS][kv * 4096 + i] * A.in[I_CMP_W1][((size_t)kv * 4096 + i) * 128 + e];
        s = wave_sum(s); if (C.lane == 0) WSP(float, WS_TAB + TAB_CMPBIAS)[o] = s; }
    for (int r = C.gw; r < 2 * MT; r += C.ngw) { const int l = r / MT, m = r % MT;
        rms_row_bf16(A.in[I_MEM] + (size_t)m * DM, A.in[I_NORM_MEM] + l * DM, WSP(bf16, WS_MEMN) + ((size_t)l * MT + m) * DM, C.lane); }
    for (int r = C.gw; r < T; r += C.ngw) rms_row_bf16(A.in[I_X] + (size_t)r * DM, A.in[I_NORM_MIX], WSP(bf16, WS_XN) + (size_t)r * DM, C.lane);
}

struct MemProjOrder {
    int G, c;
    __device__ __forceinline__ bool next(int i, pg8::Unit& u) const {
        const int L = i * G + c; if (L >= 128) return false;
        const int pn = L & 7, pm = (L >> 3) & 3, kv = (L >> 5) & 1, l = L >> 6;
        u.pm = pm; u.pn = pn; u.aux = 0;
        u.aoff = ((long long)l * MT + pm * 256) * DM * 2;
        u.boff = ((long long)(kv ? (WS_W_CAV - WS_W_CAK) / 2 : 0) + ((long long)l * DM + pn * 256) * DM) * 2;
        u.coff = (long long)(kv ? (WS_VP - WS_KP) / 2 : 0) + ((long long)l * MT + pm * 256) * DM + pn * 256;
        return true;
    }
};
struct WktOrder {
    int G, c;
    __device__ __forceinline__ bool next(int i, pg8::Unit& u) const {
        const int L = i * G + c; if (L >= 256) return false;
        const int pn = L & 7, h = (L >> 3) & 3, b = (L >> 5) & 3, l = L >> 7;
        u.pm = 0; u.pn = pn; u.aux = 0;
        u.aoff = (((long long)l * MT + b * 256) * DM + h * 512) * 2;
        u.boff = (((long long)l * DM + pn * 256) * DM + h * 512) * 2;
        u.coff = (((long long)(l * 4 + b) * 1024) + h * 256) * DM + pn * 256;
        return true;
    }
};
struct VwtOrder {
    int G, c;
    __device__ __forceinline__ bool next(int i, pg8::Unit& u) const {
        const int L = i * G + c; if (L >= 256) return false;
        const int pm = L & 7, h = (L >> 3) & 3, b = (L >> 5) & 3, l = L >> 7;
        u.pm = pm; u.pn = 0; u.aux = 0;
        u.aoff = (((long long)l * DM + pm * 256) * DM + h * 512) * 2;
        u.boff = (((long long)l * MT + b * 256) * DM + h * 512) * 2;
        u.coff = (((long long)(l * 4 + b) * DM) + pm * 256) * 1024 + h * 256;
        return true;
    }
};
struct CrossOrder {
    int nN, G, c, ldc; long long astep, bstep, bbatch;
    __device__ __forceinline__ bool next(int i, pg8::Unit& u) const {
        int pm, pn; if (!pg8::tile_of((long)i * G + c, T / 256, nN, pm, pn)) return false;
        u.pm = pm; u.pn = pn; u.aux = 0; u.aoff = pm * astep; u.boff = (pm >> 4) * bbatch + pn * bstep; u.coff = (long long)pm * 256 * ldc + pn * 256; return true;
    }
};
struct CmpOrder {
    int G, c;
    __device__ __forceinline__ bool next(int i, pg8::Unit& u) const {
        const int L = i * G + c; if (L >= 256) return false;
        const int bg = L & 15, kv = (L >> 4) & 1, ks = L >> 5;
        u.pm = 0; u.pn = 0; u.aux = 0;
        u.aoff = (long long)kv * KV6_STRIDE + ((long long)bg * SPAD * 128 + ks * 512) * 2;
        u.boff = ((long long)kv * 256 * 4096 + ks * 512) * 2;
        u.coff = ((long long)(ks * 2 + kv) * 16 + bg) * 65536;
        return true;
    }
};
struct MoeOrder {
    const LAS int* tab; int npn, G, c, which;
    __device__ __forceinline__ bool next(int i, pg8::Unit& u) const {
        const int L = i * G + c, ntile = tab[64]; if (L >= ntile * npn) return false;
        const int tix = L / npn, pn = L % npn; int e = 0;
        for (int k = 32; k >= 1; k >>= 1) if (e + k < 64 && tab[e + k] <= tix) e += k;
        while (tab[e + 1] <= tix) ++e;
        const int mt = tix - tab[e], cnt = tab[65 + e], row0 = tab[129 + e] + mt * 256;
        u.pm = min(256, cnt - mt * 256); u.pn = pn; u.aux = row0;
        if (which == 0) { u.aoff = (long long)row0 * DM * 2; u.boff = ((long long)e * 1024 + pn * 256) * DM * 2; }
        else { u.aoff = (long long)row0 * FF * 2; u.boff = ((long long)e * DM + pn * 256) * FF * 2; }
        u.coff = 0; return true;
    }
};
__device__ __forceinline__ void moe_build_table(const Ctx& C, const unsigned* cnt, LAS int* tab) {
    if (C.tid == 0) { int ts = 0, off = 0;
        for (int e = 0; e < 64; ++e) { const int n = (int)cnt[e]; tab[e] = ts; tab[65 + e] = n; tab[129 + e] = off; const int nt = (n + 255) >> 8; ts += nt; off += nt * 256; }
        tab[64] = ts; }
    __syncthreads();
}

__device__ __forceinline__ float log_sigmoidf_(float x) { return fminf(x, 0.f) - log1pf(__expf(-fabsf(x))); }
__device__ __forceinline__ void phase_mixer_prep(const Ctx& C, const Args& A) {
    const bf16* PAB = ARP(bf16, A_PAB); const float* G32 = ARP(float, A_GF32);
    bf16 *QM = ARP(bf16, A_QM), *KM = ARP(bf16, A_KM), *RR = ARP(bf16, A_RR), *KR = ARP(bf16, A_KR), *VR = ARP(bf16, A_VR), *KK = ARP(bf16, A_KK), *LIN = ARP(bf16, A_LIN);
    float *IG = ARP(float, A_IG), *LF = ARP(float, A_LF);
    const float *cw = A.in[I_ML_CONV_W], *cb = A.in[I_ML_CONV_B], *gb = A.in[I_ML_GATE_B], *mu = A.in[I_RW_MU], *k_k = A.in[I_RW_K_K];
    const int lane = C.lane;
    for (int t = C.gw; t < T; t += C.ngw) {
        const int b = t >> 12, s = t & 4095; const bf16* P = PAB + (size_t)t * AB_PAD;
#pragma unroll
        for (int it = 0; it < 2; ++it) { const int c = (lane + 64 * it) * 8; float y[8];
#pragma unroll
            for (int j = 0; j < 8; ++j) y[j] = cb[c + j];
#pragma unroll
            for (int tap = 0; tap < 4; ++tap) { const int back = 3 - tap;
                if (s >= back) { float xv[8]; unpack8(*(const u32x4*)(P - (size_t)back * AB_PAD + c), xv);
#pragma unroll
                    for (int j = 0; j < 8; ++j) y[j] += xv[j] * cw[tap * 1024 + c + j]; } }
#pragma unroll
            for (int j = 0; j < 8; ++j) y[j] = siluf_(y[j]);
            if (c < 512) *(u32x4*)(QM + (size_t)t * 512 + c) = pack8f(y); else *(u32x4*)(KM + (size_t)t * 512 + c - 512) = pack8f(y); }
        if (lane < 8) { const float g = G32[(size_t)t * 256 + lane] + gb[lane];
            if (lane < 4) IG[(size_t)(b * 4 + lane) * SEQ + s] = g; else LF[(size_t)(b * 4 + lane - 4) * SEQ + s] = log_sigmoidf_(g); }
        const bf16* PR = P + ML_COLS;
#pragma unroll
        for (int it = 0; it < 7; ++it) { const int chunk = lane + 64 * it; if (chunk >= 416) break; const int cc = chunk * 8;
            float p[8], pp[8], mx[8]; unpack8(*(const u32x4*)(PR + cc), p);
            if (s > 0) unpack8(*(const u32x4*)(PR - AB_PAD + cc), pp); else {
#pragma unroll
                for (int j = 0; j < 8; ++j) pp[j] = 0.f; }
#pragma unroll
            for (int j = 0; j < 8; ++j) mx[j] = p[j] + (pp[j] - p[j]) * mu[cc + j];
            if (it < 2) *(u32x4*)(RR + (size_t)t * 1024 + cc) = pack8f(mx);
            else if (it < 4) { const int ck = cc - 1024; *(u32x4*)(KR + (size_t)t * 1024 + ck) = pack8f(mx);
                float kk[8], ss = 0.f;
#pragma unroll
                for (int j = 0; j < 8; ++j) { kk[j] = mx[j] * k_k[ck + j]; ss += kk[j] * kk[j]; }
                ss += __shfl_xor(ss, 1); ss += __shfl_xor(ss, 2); ss += __shfl_xor(ss, 4);
                const float rn = rsqrtf(ss + 1e-12f);
#pragma unroll
                for (int j = 0; j < 8; ++j) kk[j] *= rn;
                *(u32x4*)(KK + (size_t)t * 1024 + ck) = pack8f(kk); }
            else if (it < 6) *(u32x4*)(VR + (size_t)t * 1024 + cc - 2048) = pack8f(mx);
            else { float o[8];
#pragma unroll
                for (int j = 0; j < 8; ++j) o[j] = (lane < 8) ? tanhf(mx[j]) : ((lane < 16) ? mx[j] : sigmoidf_(mx[j]));
                *(u32x4*)(LIN + (size_t)t * 256 + lane * 8) = pack8f(o); } }
    }
}

__device__ __forceinline__ void rwkv_scan_unit(const Ctx& C, const Args& A, int bh) {
    const int b = bh >> 4, h = bh & 15, w = C.wave, lane = C.lane, tid = C.tid;
    LAS float* IN = (LAS float*)C.lds;
    LAS float* PART = IN + 2 * 6 * 1024;
    LAS float* YP = PART + 2 * 8 * 64;
    const float* WD = ARP(float, A_WD); const bf16 *KKg = ARP(bf16, A_KK), *BV = ARP(bf16, A_BV), *KP = ARP(bf16, A_KP), *RR = ARP(bf16, A_RR), *VR = ARP(bf16, A_VR), *GG = ARP(bf16, A_GG);
    bf16* YCAT = ARP(bf16, A_YCAT);
    const float *r_k = A.in[I_RW_R_K], *ln_w = A.in[I_RW_LN_W], *ln_b = A.in[I_RW_LN_B];
    const int li = tid >> 5, lch = (tid & 31) * 2;
    const size_t gbase = ((size_t)b * SEQ) * 1024 + h * 64 + lch;
    f32x2 rw; unsigned rk, rb, rp, rr_, rv;
#define RW_LOAD(grp) do { const size_t o = gbase + (size_t)((grp) * 16 + li) * 1024; rw = *(const f32x2*)(WD + o); rk = *(const unsigned*)(KKg + o); rb = *(const unsigned*)(BV + o); \
        rp = *(const unsigned*)(KP + o); rr_ = *(const unsigned*)(RR + o); rv = *(const unsigned*)(VR + o); } while (0)
#define RW_STORE(buf) do { LAS float* d = IN + (buf) * 6144 + li * 64 + lch; *(LAS f32x2*)(d) = rw; *(LAS f32x2*)(d + 1024) = (f32x2){lo_bf(rk), hi_bf(rk)}; *(LAS f32x2*)(d + 2048) = (f32x2){lo_bf(rb), hi_bf(rb)}; \
        *(LAS f32x2*)(d + 3072) = (f32x2){lo_bf(rp), hi_bf(rp)}; *(LAS f32x2*)(d + 4096) = (f32x2){lo_bf(rr_), hi_bf(rr_)}; *(LAS f32x2*)(d + 5120) = (f32x2){lo_bf(rv), hi_bf(rv)}; } while (0)
    float st[8];
#pragma unroll
    for (int j = 0; j < 8; ++j) st[j] = 0.f;
    __syncthreads();
    RW_LOAD(0); RW_STORE(0); __syncthreads();
    for (int grp = 0; grp < SEQ / 16; ++grp) {
        const int buf = grp & 1; const LAS float* I0 = IN + buf * 6144;
        if (grp + 1 < SEQ / 16) RW_LOAD(grp + 1);
        for (int i = 0; i < 16; ++i) {
            const LAS float* q = I0 + i * 64 + 8 * w;
            const f32x4 w0 = *(const LAS f32x4*)(q), w1 = *(const LAS f32x4*)(q + 4), k0 = *(const LAS f32x4*)(q + 1024), k1 = *(const LAS f32x4*)(q + 1028);
            const f32x4 b0 = *(const LAS f32x4*)(q + 2048), b1 = *(const LAS f32x4*)(q + 2052), p0 = *(const LAS f32x4*)(q + 3072), p1 = *(const LAS f32x4*)(q + 3076);
            const f32x4 r0 = *(const LAS f32x4*)(q + 4096), r1 = *(const LAS f32x4*)(q + 4100); const float vv = I0[5120 + i * 64 + lane];
            float skp = 0.f;
#pragma unroll
            for (int j = 0; j < 4; ++j) skp += st[j] * k0[j] + st[4 + j] * k1[j];
            PART[(i & 1) * 512 + w * 64 + lane] = skp;
            LDS_WAIT(); __builtin_amdgcn_s_barrier(); asm volatile("" ::: "memory");
            float sk = 0.f;
#pragma unroll
            for (int ww = 0; ww < 8; ++ww) sk += PART[(i & 1) * 512 + ww * 64 + lane];
            float yp = 0.f;
#pragma unroll
            for (int j = 0; j < 4; ++j) { st[j] = st[j] * w0[j] - sk * b0[j] + vv * p0[j]; st[4 + j] = st[4 + j] * w1[j] - sk * b1[j] + vv * p1[j]; yp += st[j] * r0[j] + st[4 + j] * r1[j]; }
            YP[i * 512 + w * 64 + lane] = yp;
        }
        if (grp + 1 < SEQ / 16) RW_STORE(buf ^ 1);
        __syncthreads();
#pragma unroll
        for (int q = 0; q < 2; ++q) { const int i = 2 * w + q; float y = 0.f;
#pragma unroll
            for (int ww = 0; ww < 8; ++ww) y += YP[i * 512 + ww * 64 + lane];
            const float mean = wave_sum(y) * (1.f / 64.f), dv = y - mean, var = wave_sum(dv * dv) * (1.f / 64.f);
            const int ch = h * 64 + lane; const float yn = dv * rsqrtf(var + 64e-5f) * ln_w[ch] + ln_b[ch];
            const float bonus = wave_sum(I0[4096 + i * 64 + lane] * I0[3072 + i * 64 + lane] * r_k[ch]) * I0[5120 + i * 64 + lane];
            const size_t tt = (size_t)b * SEQ + grp * 16 + i;
            const float g = bf2f(GG[tt * 1024 + ch]);
            YCAT[tt * DM + 1024 + ch] = (bf16)f2bf((yn + bonus) * g); }
    }
#undef RW_LOAD
#undef RW_STORE
    __syncthreads();
}

__device__ __forceinline__ f32x4 lds_mma(const LAS bf16* Am, int lda, const LAS bf16* Bt, int ldb, int tm, int tn, int K, int lane, f32x4 acc) {
    const LAS bf16* ap = Am + (tm * 16 + (lane & 15)) * lda + (lane >> 4) * 8;
    const LAS bf16* bp = Bt + (tn * 16 + (lane & 15)) * ldb + (lane >> 4) * 8;
    for (int k = 0; k < K; k += 32) { const bf16x8 a = *(const LAS bf16x8*)(ap + k); const bf16x8 bb = *(const LAS bf16x8*)(bp + k);
        acc = __builtin_amdgcn_mfma_f32_16x16x32_bf16(bb, a, acc, 0, 0, 0); }
    return acc;
}

__device__ __forceinline__ void mlstm_unit(const Ctx& C, const Args& A, int unit) {
    const int bh = unit >> 3, dvs = unit & 7, b = bh >> 2, h = bh & 3, w = C.wave, lane = C.lane, tid = C.tid;
    LAS float* AA = (LAS float*)C.lds;
    LAS float* MX = AA + 4096;
    LAS bf16* Qs = (LAS bf16*)(MX + 4096);
    LAS bf16* Ks = Qs + 64 * 136;
    LAS bf16* KwT = Ks + 64 * 136;
    LAS bf16* Vt = KwT + 128 * 72;
    LAS bf16* Ps = Vt + 48 * 72;
    LAS bf16* CT = Ps + 64 * 72;
    LAS float* NUM = (LAS float*)(CT + 48 * 136);
    const float *IG = ARP(float, A_IG) + (size_t)bh * SEQ, *LFp = ARP(float, A_LF) + (size_t)bh * SEQ;
    const bf16 *QM = ARP(bf16, A_QM), *KM = ARP(bf16, A_KM), *PAB = ARP(bf16, A_PAB); bf16* YCAT = ARP(bf16, A_YCAT);
    __syncthreads();
    if (w == 0) { float carryF = 0.f, carryM = 0.f;
        for (int c = 0; c < 64; ++c) { const int p = c * 64 + lane; float f = LFp[p];
#pragma unroll
            for (int o = 1; o < 64; o <<= 1) { const float n = __shfl_up(f, o); if (lane >= o) f += n; }
            f += carryF; const float a = IG[p] - f; float m = a;
#pragma unroll
            for (int o = 1; o < 64; o <<= 1) { const float n = __shfl_up(m, o); if (lane >= o) m = fmaxf(m, n); }
            m = fmaxf(m, carryM); AA[p] = a; MX[p] = m; carryF = __shfl(f, 63); carryM = __shfl(m, 63); } }
    for (int i = tid; i < 48 * 72; i += NTHR) { const int r = i / 72; Vt[i] = (r == 32) ? (bf16)0x3f80 : (bf16)0; }
    for (int i = tid; i < 48 * 136; i += NTHR) CT[i] = 0;
    f32x4 accC[3];
#pragma unroll
    for (int k = 0; k < 3; ++k) accC[k] = (f32x4){0.f, 0.f, 0.f, 0.f};
    const size_t tok0 = (size_t)b * SEQ;
    u32x4 rq[2], rk[2], rv;
#define ML_LOAD(c) do { _Pragma("unroll") for (int k = 0; k < 2; ++k) { const int idx = tid + 512 * k, r = idx >> 4, c8 = (idx & 15) * 8; const size_t o = (tok0 + (c) * 64 + r) * 512 + h * 128 + c8; \
            rq[k] = *(const u32x4*)(QM + o); rk[k] = *(const u32x4*)(KM + o); } \
        if (tid < 256) rv = *(const u32x4*)(PAB + (tok0 + (c) * 64 + (tid >> 2)) * AB_PAD + 1024 + h * 256 + dvs * 32 + (tid & 3) * 8); } while (0)
    ML_LOAD(0);
    __syncthreads();
    const float scale = 0.08838834764831845f;
    for (int c = 0; c < 64; ++c) {
        const int t0 = c * 64; const float Mc = c ? MX[t0 - 1] : 0.f, Mc2 = MX[t0 + 63];
#pragma unroll
        for (int k = 0; k < 2; ++k) { const int idx = tid + 512 * k, r = idx >> 4, c8 = (idx & 15) * 8;
            *(LAS u32x4*)(Qs + r * 136 + c8) = rq[k]; *(LAS u32x4*)(Ks + r * 136 + c8) = rk[k];
            float kf[8]; unpack8(rk[k], kf); const float wk = __expf(AA[t0 + r] - Mc2);
#pragma unroll
            for (int j = 0; j < 8; ++j) KwT[(c8 + j) * 72 + r] = (bf16)f2bf(kf[j] * wk); }
        if (tid < 256) { const int r = tid >> 2, e8 = (tid & 3) * 8; const unsigned wv[4] = {rv.x, rv.y, rv.z, rv.w};
#pragma unroll
            for (int j = 0; j < 4; ++j) { Vt[(e8 + 2 * j) * 72 + r] = (bf16)(wv[j] & 0xffff); Vt[(e8 + 2 * j + 1) * 72 + r] = (bf16)(wv[j] >> 16); } }
        if (c + 1 < 64) ML_LOAD(c + 1);
        __syncthreads();
#pragma unroll
        for (int q = 0; q < 2; ++q) { const int tile = 2 * w + q, tm = tile >> 2, tn = tile & 3; const int t = tm * 16 + (lane & 15), l0 = tn * 16 + 4 * (lane >> 4);
            f32x4 s = (f32x4){0.f, 0.f, 0.f, 0.f};
            if (tn <= tm) s = lds_mma(Qs, 136, Ks, 136, tm, tn, 128, lane, s);
            const float mxt = MX[t0 + t]; float pvv[4];
#pragma unroll
            for (int j = 0; j < 4; ++j) { const int l = l0 + j; pvv[j] = (l <= t) ? s[j] * __expf(AA[t0 + l] - mxt) : 0.f; }
            u32x2 pw; pw.x = pk2(pvv[0], pvv[1]); pw.y = pk2(pvv[2], pvv[3]); *(LAS u32x2*)(Ps + t * 72 + l0) = pw; }
        __syncthreads();
        for (int tile = w; tile < 12; tile += 8) { const int tm = tile / 3, tn = tile % 3; const int t = tm * 16 + (lane & 15);
            f32x4 a1 = lds_mma(Ps, 72, Vt, 72, tm, tn, 64, lane, (f32x4){0.f, 0.f, 0.f, 0.f});
            f32x4 a2 = lds_mma(Qs, 136, CT, 136, tm, tn, 128, lane, (f32x4){0.f, 0.f, 0.f, 0.f});
            const float wst = __expf(Mc - MX[t0 + t]);
            *(LAS f32x4*)(NUM + t * 48 + tn * 16 + 4 * (lane >> 4)) = (a1 + a2 * wst) * scale; }
        __syncthreads();
        { const int t = tid >> 3, e4 = (tid & 7) * 4; const size_t tt = tok0 + t0 + t;
          const float den = NUM[t * 48 + 32], mrow = IG[t0 + t] - AA[t0 + t] + MX[t0 + t];
          const float inv = 1.f / fmaxf(fabsf(den), __expf(-mrow));
          const f32x4 nv = *(const LAS f32x4*)(NUM + t * 48 + e4);
          const u32x2 og = *(const u32x2*)(PAB + tt * AB_PAD + 2048 + h * 256 + dvs * 32 + e4);
          u32x2 o; o.x = pk2(sigmoidf_(lo_bf(og.x)) * nv[0] * inv, sigmoidf_(hi_bf(og.x)) * nv[1] * inv); o.y = pk2(sigmoidf_(lo_bf(og.y)) * nv[2] * inv, sigmoidf_(hi_bf(og.y)) * nv[3] * inv);
          *(u32x2*)(YCAT + tt * DM + h * 256 + dvs * 32 + e4) = o; }
        { const float decay = __expf(Mc - Mc2);
#pragma unroll
          for (int tm = 0; tm < 3; ++tm) { accC[tm] = lds_mma(Vt, 72, KwT, 72, tm, w, 64, lane, accC[tm] * decay);
              u32x2 cw; cw.x = pk2(accC[tm][0], accC[tm][1]); cw.y = pk2(accC[tm][2], accC[tm][3]);
              *(LAS u32x2*)(CT + (tm * 16 + (lane & 15)) * 136 + w * 16 + 4 * (lane >> 4)) = cw; } }
        __syncthreads();
    }
#undef ML_LOAD
}

__device__ __forceinline__ void phase_norm(const Ctx& C, const float* X, const float* gain, bf16* XNo) {
    for (int r = C.gw; r < T; r += C.ngw) rms_row_bf16(X + (size_t)r * DM, gain, XNo + (size_t)r * DM, C.lane);
}
__device__ __forceinline__ void phase_softmax256(const Ctx& C) {
    const float* SC = ARP(float, A_SC); bf16* PC = ARP(bf16, A_PC);
    for (int it = C.gw; it < T * 4; it += C.ngw) { const size_t o = (size_t)it * 256 + C.lane * 4;
        const f32x4 v = *(const f32x4*)(SC + o); const float m = wave_max(fmaxf(fmaxf(v.x, v.y), fmaxf(v.z, v.w)));
        const float e0 = __expf(v.x - m), e1 = __expf(v.y - m), e2 = __expf(v.z - m), e3 = __expf(v.w - m);
        const float inv = 1.f / wave_sum(e0 + e1 + e2 + e3);
        u32x2 w; w.x = pk2(e0 * inv, e1 * inv); w.y = pk2(e2 * inv, e3 * inv); *(u32x2*)(PC + o) = w; }
}
__device__ __forceinline__ void phase_route(const Ctx& C, const Args& A, int l) {
    const float* LG = ARP(float, A_LOGIT); int* EID = ARP(int, A_EID); float* WTS = ARP(float, A_WTS);
    unsigned* cnt = WSP(unsigned, WS_CTL) + CW_MOE_CNT + l * 64;
    const float *bg = A.in[I_MOE_BG] + l * 8, *be = A.in[I_MOE_BE] + l * 64;
    for (int t = C.bid * NTHR + C.tid; t < T; t += C.G * NTHR) { const float* L = LG + (size_t)t * 256;
        float lg[8], mx = -INFINITY; int grp = 0;
#pragma unroll
        for (int g = 0; g < 8; ++g) { lg[g] = L[g] + bg[g]; if (lg[g] > mx) { mx = lg[g]; grp = g; } }
        float se = 0.f;
#pragma unroll
        for (int g = 0; g < 8; ++g) se += __expf(lg[g] - mx);
        const float pgrp = 1.f / se;
        float l1 = -INFINITY, l2 = -INFINITY; int i1 = 0, i2 = 0;
        for (int j = 0; j < 8; ++j) { const float v = L[8 + grp * 8 + j] + be[grp * 8 + j];
            if (v > l1) { l2 = l1; i2 = i1; l1 = v; i1 = j; } else if (v > l2) { l2 = v; i2 = j; } }
        const float w1 = 1.f / (1.f + __expf(l2 - l1)), w2 = 1.f - w1;
        const int e1 = grp * 8 + i1, e2 = grp * 8 + i2;
        EID[2 * t] = e1; EID[2 * t + 1] = e2; WTS[2 * t] = pgrp * w1; WTS[2 * t + 1] = pgrp * w2;
        atomicAdd(cnt + e1, 1u); atomicAdd(cnt + e2, 1u); }
}
__device__ __forceinline__ void phase_gather(const Ctx& C, int l) {
    LAS int* tab = (LAS int*)(C.lds + LDS_AUX);
    moe_build_table(C, WSP(unsigned, WS_CTL) + CW_MOE_CNT + l * 64, tab);
    unsigned* cur = WSP(unsigned, WS_CTL) + CW_MOE_CUR + l * 64;
    const int* EID = ARP(int, A_EID); int* ROWSLOT = ARP(int, A_ROWSLOT); const bf16* XNp = WSP(bf16, WS_XN); bf16* XS = ARP(bf16, A_XS);
    for (int a = C.gw; a < 2 * T; a += C.ngw) { const int e = EID[a]; int pos = 0;
        if (C.lane == 0) { pos = tab[129 + e] + (int)atomicAdd(cur + e, 1u); ROWSLOT[pos] = a; }
        pos = __shfl(pos, 0);
        const u32x4* src = (const u32x4*)(XNp + (size_t)(a >> 1) * DM); u32x4* dst = (u32x4*)(XS + (size_t)pos * DM);
#pragma unroll
        for (int k = 0; k < 4; ++k) dst[k * 64 + C.lane] = src[k * 64 + C.lane]; }
}
__device__ __forceinline__ void phase_combine_norm(const Ctx& C, const float* gain, bf16* XNo, float* OUT) {
    float* XR = WSP(float, WS_XR); const bf16* YE = ARP(bf16, A_YE); const int lane = C.lane;
    for (int t = C.gw; t < T; t += C.ngw) { float* xr = XR + (size_t)t * DM; const bf16* y0 = YE + (size_t)(2 * t) * DM; const bf16* y1 = y0 + DM;
        f32x4 v[8]; float s = 0.f;
#pragma unroll
        for (int j = 0; j < 8; ++j) { const int o = (j * 64 + lane) * 4; v[j] = *(const f32x4*)(xr + o); const u32x2 a = *(const u32x2*)(y0 + o), bq = *(const u32x2*)(y1 + o);
            v[j].x += lo_bf(a.x) + lo_bf(bq.x); v[j].y += hi_bf(a.x) + hi_bf(bq.x); v[j].z += lo_bf(a.y) + lo_bf(bq.y); v[j].w += hi_bf(a.y) + hi_bf(bq.y);
            s += v[j].x * v[j].x + v[j].y * v[j].y + v[j].z * v[j].z + v[j].w * v[j].w; if (!OUT) *(f32x4*)(xr + o) = v[j]; }
        const float rstd = rsqrtf(wave_sum(s) * (1.f / DM) + EPS);
#pragma unroll
        for (int j = 0; j < 8; ++j) { const int o = (j * 64 + lane) * 4; const f32x4 g = *(const f32x4*)(gain + o);
            if (OUT) *(f32x4*)(OUT + (size_t)t * DM + o) = (f32x4){v[j].x * rstd * g.x, v[j].y * rstd * g.y, v[j].z * rstd * g.z, v[j].w * rstd * g.w};
            else { u32x2 w; w.x = pk2(v[j].x * rstd * g.x, v[j].y * rstd * g.y); w.y = pk2(v[j].z * rstd * g.z, v[j].w * rstd * g.w); *(u32x2*)(XNo + (size_t)t * DM + o) = w; } }
    }
}

__device__ __forceinline__ float gelu_tanh(float x) { return 0.5f * x * (1.f + tanhf(0.7978845608028654f * (x + 0.044715f * x * x * x))); }
__device__ __forceinline__ void phase_cmp_finish(const Ctx& C, const Args& A) {
    const float* CP = ARP(float, A_CPART); const float* bias = WSP(float, WS_TAB + TAB_CMPBIAS); const float* w2 = A.in[I_CMP_W2];
    LAS float* hid = (LAS float*)C.lds + C.wave * 128; const int lane = C.lane;
    for (int it = C.gw; it < 2 * 16 * 256; it += C.ngw) { const int j = it & 255, bg = (it >> 8) & 15, kv = it >> 12;
        bf16* dst = ARP(bf16, kv ? A_VCMP : A_KCMP) + ((size_t)bg * 256 + j) * 128;
        if (j == 255) { dst[lane] = 0; dst[lane + 64] = 0; continue; }
        float h0 = bias[kv * 128 + lane], h1 = bias[kv * 128 + 64 + lane];
#pragma unroll
        for (int ks = 0; ks < 8; ++ks) { const float* p = CP + ((size_t)((ks * 2 + kv) * 16 + bg) * 256 + j) * 256; h0 += p[lane]; h1 += p[64 + lane]; }
        hid[lane] = gelu_tanh(h0); hid[64 + lane] = gelu_tanh(h1); LDS_WAIT(); asm volatile("" ::: "memory");
        float o0 = 0.f, o1 = 0.f; const float* W = w2 + (size_t)kv * 128 * 128;
        for (int e = 0; e < 128; ++e) { const float hv = hid[e]; o0 += hv * W[e * 128 + lane]; o1 += hv * W[e * 128 + 64 + lane]; }
        dst[lane] = (bf16)f2bf(o0); dst[lane + 64] = (bf16)f2bf(o1); LDS_WAIT(); asm volatile("" ::: "memory"); }
}
__device__ __forceinline__ void phase_cmp_attn(const Ctx& C) {
    const bf16 *Q = ARP(bf16, A_Q), *KC = ARP(bf16, A_KCMP), *VC = ARP(bf16, A_VCMP); const float* GATES = ARP(float, A_GATES);
    float* OACC = ARP(float, A_OACC); unsigned long long* SELM = ARP(unsigned long long, A_SELMASK);
    LAS float* qs = (LAS float*)C.lds + C.wave * 1536;
    LAS float* ps = qs + 512; const int lane = C.lane; const float scale = 0.08838834764831845f;
    for (int it = C.gw; it < T * 4; it += C.ngw) { const int t = it >> 2, g = it & 3, b = t >> 12, s = t & 4095;
        const int nvalid = (s >= 31) ? ((s - 31) >> 4) + 1 : 0;
#pragma unroll
        for (int r = 0; r < 4; ++r) { const bf16* qp = Q + (((size_t)(b * 16 + g * 4 + r)) * SEQ + s) * 128; qs[r * 128 + lane] = bf2f(qp[lane]); qs[r * 128 + 64 + lane] = bf2f(qp[64 + lane]); }
        LDS_WAIT(); asm volatile("" ::: "memory");
        float sc[4][4];
#pragma unroll
        for (int i = 0; i < 4; ++i) { const int j = lane + 64 * i;
#pragma unroll
            for (int r = 0; r < 4; ++r) sc[r][i] = 0.f;
            if (j < nvalid) { const bf16* kp = KC + ((size_t)(b * 4 + g) * 256 + j) * 128;
                for (int d8 = 0; d8 < 16; ++d8) { float kf[8]; unpack8(*(const u32x4*)(kp + d8 * 8), kf);
#pragma unroll
                    for (int r = 0; r < 4; ++r) { float a = 0.f;
#pragma unroll
                        for (int jj = 0; jj < 8; ++jj) a += qs[r * 128 + d8 * 8 + jj] * kf[jj];
                        sc[r][i] += a; } } } }
#pragma unroll
        for (int r = 0; r < 4; ++r) { float m = -INFINITY;
#pragma unroll
            for (int i = 0; i < 4; ++i) if (lane + 64 * i < nvalid) m = fmaxf(m, sc[r][i] * scale);
            m = wave_max(m); if (!(m > -INFINITY)) m = 0.f; float e[4], sum = 0.f;
#pragma unroll
            for (int i = 0; i < 4; ++i) { e[i] = (lane + 64 * i < nvalid) ? __expf(sc[r][i] * scale - m) : 0.f; sum += e[i]; }
            sum = wave_sum(sum); const float inv = sum > 0.f ? 1.f / sum : 1.f;
#pragma unroll
            for (int i = 0; i < 4; ++i) ps[r * 256 + lane + 64 * i] = e[i] * inv; }
        LDS_WAIT(); asm volatile("" ::: "memory");
        float o[4][2];
#pragma unroll
        for (int r = 0; r < 4; ++r) { o[r][0] = 0.f; o[r][1] = 0.f; }
        for (int j = 0; j < nvalid; ++j) { const bf16* vp = VC + ((size_t)(b * 4 + g) * 256 + j) * 128; const float v0 = bf2f(vp[lane]), v1 = bf2f(vp[64 + lane]);
#pragma unroll
            for (int r = 0; r < 4; ++r) { const float p = ps[r * 256 + j]; o[r][0] += p * v0; o[r][1] += p * v1; } }
#pragma unroll
        for (int r = 0; r < 4; ++r) { const float gt = GATES[(size_t)t * 48 + g * 4 + r]; float* op = OACC + (size_t)t * DM + (g * 4 + r) * 128; op[lane] = gt * o[r][0]; op[64 + lane] = gt * o[r][1]; }
        float imp = 0.f;
#pragma unroll
        for (int r = 0; r < 4; ++r) { const LAS float* p = ps + r * 256; const int j0 = 4 * lane;
            imp += (j0 > 0 ? 0.5f * p[j0 - 1] : 0.f) + p[j0] + p[j0 + 1] + p[j0 + 2] + 0.5f * p[j0 + 3]; }
        const int cur = s >> 6; float score;
        if (lane == 0 || lane == cur || lane == cur - 1) score = INFINITY; else score = (lane <= cur) ? imp : -INFINITY;
        int rank = 0;
        for (int o2 = 0; o2 < 64; ++o2) { const float so = __shfl(score, o2); rank += (so > score || (so == score && o2 < lane)) ? 1 : 0; }
        const unsigned long long m = __ballot(rank < 16 && score > -INFINITY);
        if (lane == 0) SELM[(size_t)t * 4 + g] = m;
        LDS_WAIT(); asm volatile("" ::: "memory");
    }
}
struct NaiveAttnState { float m[4], l[4], o[4][2]; };
__device__ __forceinline__ void naive_tile(NaiveAttnState& S, const LAS float* qs, LAS float* pt, const bf16* Kt, const bf16* Vt_, int key0, bool valid, int lane) {
    float sc[4] = {0.f, 0.f, 0.f, 0.f}; const float scale = 0.08838834764831845f;
    if (valid) { const bf16* kp = Kt + (size_t)(key0 + lane) * 128;
        for (int d8 = 0; d8 < 16; ++d8) { float kf[8]; unpack8(*(const u32x4*)(kp + d8 * 8), kf);
#pragma unroll
            for (int r = 0; r < 4; ++r) { float a = 0.f;
#pragma unroll
                for (int jj = 0; jj < 8; ++jj) a += qs[r * 128 + d8 * 8 + jj] * kf[jj];
                sc[r] += a; } } }
    const unsigned long long vm = __ballot(valid);
    if (vm == 0ull) return;
#pragma unroll
    for (int r = 0; r < 4; ++r) { const float sv = valid ? sc[r] * scale : -INFINITY; const float mt = wave_max(sv), mn = fmaxf(S.m[r], mt);
        const float alpha = __expf(S.m[r] - mn), p = valid ? __expf(sv - mn) : 0.f;
        S.l[r] = S.l[r] * alpha + wave_sum(p); S.o[r][0] *= alpha; S.o[r][1] *= alpha; S.m[r] = mn; pt[r * 64 + lane] = p; }
    LDS_WAIT(); asm volatile("" ::: "memory");
    for (int k = 0; k < 64; ++k) { if (!((vm >> k) & 1ull)) continue; const bf16* vp = Vt_ + (size_t)(key0 + k) * 128; const float v0 = bf2f(vp[lane]), v1 = bf2f(vp[64 + lane]);
#pragma unroll
        for (int r = 0; r < 4; ++r) { const float p = pt[r * 64 + k]; S.o[r][0] += p * v0; S.o[r][1] += p * v1; } }
    LDS_WAIT(); asm volatile("" ::: "memory");
}
__device__ __forceinline__ void phase_selwin_naive(const Ctx& C) {
    const bf16* QR = ARP(bf16, A_QROT); const float* GATES = ARP(float, A_GATES); const float* OACC = ARP(float, A_OACC);
    const unsigned long long* SELM = ARP(const unsigned long long, A_SELMASK); bf16* OCAT = ARP(bf16, A_OCAT);
    const bf16* KS = (const bf16*)(C.ws + WS_ARENA + A_KV6 + 2 * KV6_STRIDE); const bf16* VS = (const bf16*)(C.ws + WS_ARENA + A_KV6 + 3 * KV6_STRIDE);
    const bf16* KW = (const bf16*)(C.ws + WS_ARENA + A_KV6 + 4 * KV6_STRIDE); const bf16* VW = (const bf16*)(C.ws + WS_ARENA + A_KV6 + 5 * KV6_STRIDE);
    LAS float* qs = (LAS float*)C.lds + C.wave * 768; LAS float* pt = qs + 512; const int lane = C.lane;
    for (int it = C.gw; it < T * 4; it += C.ngw) { const int t = it >> 2, g = it & 3, b = t >> 12, s = t & 4095; const size_t slab = (size_t)(b * 4 + g) * SPAD * 128;
#pragma unroll
        for (int r = 0; r < 4; ++r) { const bf16* qp = QR + (((size_t)(b * 16 + g * 4 + r)) * SEQ + s) * 128; qs[r * 128 + lane] = bf2f(qp[lane]); qs[r * 128 + 64 + lane] = bf2f(qp[64 + lane]); }
        LDS_WAIT(); asm volatile("" ::: "memory");
        float res[4][2];
#pragma unroll
        for (int r = 0; r < 4; ++r) { res[r][0] = OACC[(size_t)t * DM + (g * 4 + r) * 128 + lane]; res[r][1] = OACC[(size_t)t * DM + (g * 4 + r) * 128 + 64 + lane]; }
        { NaiveAttnState S;
#pragma unroll
          for (int r = 0; r < 4; ++r) { S.m[r] = -1e30f; S.l[r] = 0.f; S.o[r][0] = 0.f; S.o[r][1] = 0.f; }
          const unsigned long long m = SELM[(size_t)t * 4 + g];
          for (int blk = 0; blk <= (s >> 6); ++blk) if ((m >> blk) & 1ull) naive_tile(S, qs, pt, KS + slab, VS + slab, blk * 64, blk * 64 + lane <= s, lane);
#pragma unroll
          for (int r = 0; r < 4; ++r) { const float gt = GATES[(size_t)t * 48 + 16 + g * 4 + r], inv = S.l[r] > 0.f ? 1.f / S.l[r] : 0.f; res[r][0] += gt * S.o[r][0] * inv; res[r][1] += gt * S.o[r][1] * inv; } }
        { NaiveAttnState S;
#pragma unroll
          for (int r = 0; r < 4; ++r) { S.m[r] = -1e30f; S.l[r] = 0.f; S.o[r][0] = 0.f; S.o[r][1] = 0.f; }
          const int lo = s - 511 > 0 ? s - 511 : 0;
          for (int k0 = lo & ~63; k0 <= s; k0 += 64) naive_tile(S, qs, pt, KW + slab, VW + slab, k0, (k0 + lane >= lo) && (k0 + lane <= s), lane);
#pragma unroll
          for (int r = 0; r < 4; ++r) { const float gt = GATES[(size_t)t * 48 + 32 + g * 4 + r], inv = S.l[r] > 0.f ? 1.f / S.l[r] : 0.f; res[r][0] += gt * S.o[r][0] * inv; res[r][1] += gt * S.o[r][1] * inv; } }
#pragma unroll
        for (int r = 0; r < 4; ++r) { bf16* op = OCAT + (size_t)t * DM + (g * 4 + r) * 128; op[lane] = (bf16)f2bf(res[r][0]); op[64 + lane] = (bf16)f2bf(res[r][1]); }
    }
}

#ifndef MK_SPLIT
#define MK_SPLIT 1
#endif
constexpr int N_PHASES = 36;
#define COMMON_PHASES(l, pb) \
      \
    if (IN(pb + 0)) { phase_norm(C, WSP(float, WS_XR), A.in[I_NORM_CROSS] + l * DM, WSP(bf16, WS_XN)); } SEAM(pb + 0); \
    if (IN(pb + 1)) { pg8::Gemm g{WSP(bf16, WS_XN), WSP(bf16, WS_WKT) + (size_t)l * 4 * 1024 * DM, DM, DM, DM}; \
                      CrossOrder S{4, G, c, 1024, (long long)256 * DM * 2, (long long)256 * DM * 2, (long long)1024 * DM * 2}; EpiStoreF32 E{ARP(float, A_SC), 1024}; pg8::gemm_phase(L, g, S, E); } SEAM(pb + 1); \
    if (IN(pb + 2)) { phase_softmax256(C); } SEAM(pb + 2); \
    if (IN(pb + 3)) { pg8::Gemm g{ARP(bf16, A_PC), WSP(bf16, WS_VWT) + (size_t)l * 4 * DM * 1024, 1024, 1024, 1024}; \
                      CrossOrder S{8, G, c, DM, (long long)256 * 1024 * 2, (long long)256 * 1024 * 2, (long long)DM * 1024 * 2}; EpiResid E{WSP(float, WS_XR), WSP(float, WS_XR), DM}; pg8::gemm_phase(L, g, S, E); } SEAM(pb + 3); \
      \
    if (IN(pb + 4)) { phase_norm(C, WSP(float, WS_XR), A.in[I_NORM_FFN] + l * DM, WSP(bf16, WS_XN)); } SEAM(pb + 4); \
    if (IN(pb + 5)) { pg8::Gemm g{WSP(bf16, WS_XN), WSP(bf16, WS_W_ROUTER) + (size_t)l * 256 * DM, DM, DM, DM}; pg8::DenseOrder S; S.init(T, 256, DM, DM, 256, G, c); EpiStoreF32 E{ARP(float, A_LOGIT), 256}; pg8::gemm_phase(L, g, S, E); } SEAM(pb + 5); \
    if (IN(pb + 6)) { phase_route(C, A, l); } SEAM(pb + 6); \
    if (IN(pb + 7)) { phase_gather(C, l); } SEAM(pb + 7); \
    if (IN(pb + 8)) { LAS int* tab = (LAS int*)(C.lds + LDS_AUX); moe_build_table(C, ctl + CW_MOE_CNT + l * 64, tab); \
                      pg8::Gemm g{ARP(bf16, A_XS), WSP(bf16, WS_W_GU) + (size_t)l * NEXP * 1024 * DM, DM, DM, DM}; MoeOrder S{tab, 4, G, c, 0}; EpiHid E{ARP(bf16, A_HID)}; pg8::gemm_phase(L, g, S, E); } SEAM(pb + 8); \
    if (IN(pb + 9)) { LAS int* tab = (LAS int*)(C.lds + LDS_AUX); moe_build_table(C, ctl + CW_MOE_CNT + l * 64, tab); \
                      pg8::Gemm g{ARP(bf16, A_HID), WSP(bf16, WS_W_DN) + (size_t)l * NEXP * DM * FF, FF, FF, FF}; MoeOrder S{tab, 8, G, c, 1}; EpiMoeDown E{ARP(int, A_ROWSLOT), ARP(float, A_WTS), ARP(bf16, A_YE)}; pg8::gemm_phase(L, g, S, E); } SEAM(pb + 9); \
    if (IN(pb + 10)) { if (l == 0) phase_combine_norm(C, A.in[I_NORM_MIX] + DM, WSP(bf16, WS_XN), nullptr); else phase_combine_norm(C, A.in[I_NORM_FINAL], nullptr, A.out); } \
    if (l == 0) SEAM(pb + 10);

__global__ void __launch_bounds__(NTHR, 2) mk_fwd(Args args) {
    extern __shared__ __attribute__((aligned(16))) unsigned char lds_raw[];
    Ctx C; C.lds = (LAS unsigned char*)lds_raw; C.tid = threadIdx.x; C.lane = C.tid & 63; C.wave = __builtin_amdgcn_readfirstlane(C.tid >> 6);
    C.G = gridDim.x; C.bid = blockIdx.x; C.gw = C.bid * NWAVES + C.wave; C.ngw = C.G * NWAVES; C.ws = args.ws;
    const Args& A = args;
    volatile LAS unsigned* MISC = (volatile LAS unsigned*)(C.lds + LDS_MISC);
    if (C.tid < 64) MISC[C.tid] = 0u;
    __syncthreads();
    unsigned* ctl = WSP(unsigned, WS_CTL);
    const int lo = args.ph_lo, hi = args.ph_hi;
    XcdBarrier bar; bar.bar = ctl + CW_BAR; bar.x = 0; bar.st = MISC + 8;
    if (hi - lo > 1) bar = xcd_barrier_post(ctl + CW_BAR, MISC + 8);
#ifndef ONLY_PHASE
#define ONLY_PHASE -1
#endif
#define IN(k) ((ONLY_PHASE < 0 || ONLY_PHASE == (k)) && lo <= (k) && (k) < hi)
#define SEAM(k) do { if (IN(k) && IN((k) + 1)) xcd_barrier(bar); } while (0)
    LAS unsigned char* L = C.lds;
    const int c = C.bid, G = C.G;

    if (IN(0)) { phase_prologue(C, A); } SEAM(0);
    if (IN(1)) { pg8::Gemm g{WSP(bf16, WS_MEMN), WSP(bf16, WS_W_CAK), DM, DM, DM}; MemProjOrder S{G, c}; EpiStoreBf16 E{WSP(bf16, WS_KP), DM, 1.f}; pg8::gemm_phase(L, g, S, E); } SEAM(1);
    if (IN(2)) {
        { pg8::Gemm g{WSP(bf16, WS_KP), WSP(bf16, WS_W_CAQ), DM, DM, 512}; WktOrder S{G, c}; EpiStoreBf16 E{WSP(bf16, WS_WKT), DM, 0.04419417382415922f}; pg8::gemm_phase(L, g, S, E); }
        { pg8::Gemm g{WSP(bf16, WS_W_CAO), WSP(bf16, WS_VP), DM, DM, 512}; VwtOrder S{G, c}; EpiStoreBf16 E{WSP(bf16, WS_VWT), 1024, 1.f}; pg8::gemm_phase(L, g, S, E); }
    } SEAM(2);
    if (IN(3)) { pg8::Gemm g{WSP(bf16, WS_XN), WSP(bf16, WS_W_ABIN), DM, DM, DM}; pg8::DenseOrder S; S.init(T, AB_PAD, DM, DM, AB_PAD, G, c); EpiAbIn E{ARP(bf16, A_PAB), ARP(float, A_GF32)}; pg8::gemm_phase(L, g, S, E); } SEAM(3);
    if (IN(4)) { phase_mixer_prep(C, A); } SEAM(4);
    if (IN(5)) { pg8::Gemm g{ARP(bf16, A_LIN), WSP(bf16, WS_W_LORA), 256, 256, 256}; pg8::DenseOrder S; S.init(T, 3072, 256, 256, 3072, G, c);
                 EpiLora E{A.in[I_RW_W0], A.in[I_RW_A0], A.in[I_RW_K_A], ARP(bf16, A_KK), ARP(bf16, A_KR), ARP(float, A_WD), ARP(bf16, A_BV), ARP(bf16, A_KP), ARP(bf16, A_GG)}; pg8::gemm_phase(L, g, S, E); } SEAM(5);
    if (IN(6)) { for (int it = C.bid; it < 192; it += G) { if (it < 64) rwkv_scan_unit(C, A, it); else mlstm_unit(C, A, it - 64); } } SEAM(6);
    if (IN(7)) { pg8::Gemm g{ARP(bf16, A_YCAT), WSP(bf16, WS_W_ABOUT), DM, DM, DM}; pg8::DenseOrder S; S.init(T, DM, DM, DM, DM, G, c); EpiResid E{A.in[I_X], WSP(float, WS_XR), DM}; pg8::gemm_phase(L, g, S, E); } SEAM(7);
    COMMON_PHASES(0, 8)
    if (IN(19)) { pg8::Gemm g{WSP(bf16, WS_XN), WSP(bf16, WS_W_NSAIN), DM, DM, DM}; pg8::DenseOrder S; S.init(T, NSA_PAD, DM, DM, NSA_PAD, G, c);
                  EpiNsaIn E{ARP(bf16, A_Q), ARP(bf16, A_QROT), ARP(bf16, A_KV6), ARP(float, A_GATES), A.in[I_NSA_GATE_B], WSP(float, WS_TAB + TAB_ROPE_COS), WSP(float, WS_TAB + TAB_ROPE_SIN)}; pg8::gemm_phase(L, g, S, E); } SEAM(19);
    if (IN(20)) { pg8::Gemm g{ARP(bf16, A_KV6), WSP(bf16, WS_W_CMP1), 2048, 4096, 512}; CmpOrder S{G, c}; EpiStoreF32 E{ARP(float, A_CPART), 256}; pg8::gemm_phase(L, g, S, E); } SEAM(20);
    if (IN(21)) { phase_cmp_finish(C, A); } SEAM(21);
    if (IN(22)) { phase_cmp_attn(C); } SEAM(22);
    if (IN(23)) { phase_selwin_naive(C); } SEAM(23);
    if (IN(24)) { pg8::Gemm g{ARP(bf16, A_OCAT), WSP(bf16, WS_W_NSAOUT), DM, DM, DM}; pg8::DenseOrder S; S.init(T, DM, DM, DM, DM, G, c); EpiResid E{WSP(float, WS_XR), WSP(float, WS_XR), DM}; pg8::gemm_phase(L, g, S, E); } SEAM(24);
    COMMON_PHASES(1, 25)
#undef IN
#undef SEAM
}

extern "C" void kernel_launch(void* const* d_in, const int* in_sizes, int n_in, void* d_out, int out_size, void* d_ws, size_t ws_size, hipStream_t stream) {
    static int grid = 0;
    if (grid == 0) {
        if (n_in != N_INPUTS || out_size != T * DM || ws_size < WS_END) { fprintf(stderr, "kernel_launch: unexpected shapes (n_in %d, out %d, ws %zu, need %zu)\n", n_in, out_size, ws_size, (size_t)WS_END); grid = -1; return; }
        int dev = 0, cus = 0, per_cu = 0;
        if (hipGetDevice(&dev) != hipSuccess || hipDeviceGetAttribute(&cus, hipDeviceAttributeMultiprocessorCount, dev) != hipSuccess) { grid = -1; return; }
        if (hipFuncSetAttribute((const void*)mk_fwd, hipFuncAttributeMaxDynamicSharedMemorySize, LDS_BYTES) != hipSuccess) { fprintf(stderr, "kernel_launch: hipFuncSetAttribute failed\n"); grid = -1; return; }
        if (hipOccupancyMaxActiveBlocksPerMultiprocessor(&per_cu, (const void*)mk_fwd, NTHR, LDS_BYTES) != hipSuccess || per_cu < 1) fprintf(stderr, "kernel_launch: occupancy query says %d\n", per_cu);
        (void)hipGetLastError();
        grid = cus;
    }
    if (grid < 0) return;
    (void)hipMemsetAsync((char*)d_ws + WS_CTL, 0, CTL_BYTES, stream);
    Args a{};
    for (int i = 0; i < N_INPUTS; ++i) a.in[i] = (const float*)d_in[i];
    a.out = (float*)d_out; a.ws = (unsigned char*)d_ws;
#if MK_SPLIT
    for (int p = 0; p < N_PHASES; ++p) { a.ph_lo = p; a.ph_hi = p + 1; hipLaunchKernelGGL(mk_fwd, dim3(grid), dim3(NTHR), LDS_BYTES, stream, a); }
#else
    a.ph_lo = 0; a.ph_hi = N_PHASES; hipLaunchKernelGGL(mk_fwd, dim3(grid), dim3(NTHR), LDS_BYTES, stream, a);
#endif
}
```

```cpp
#include <hip/hip_runtime.h>
#include <cstdio>
#include <cstdint>

#define LAS __attribute__((address_space(3)))
#define GAS __attribute__((address_space(1)))
typedef unsigned short bf16;
typedef short bf16x8 __attribute__((ext_vector_type(8)));
typedef float f32x4 __attribute__((ext_vector_type(4)));
typedef float f32x2 __attribute__((ext_vector_type(2)));
typedef unsigned u32x4 __attribute__((ext_vector_type(4)));
typedef unsigned u32x2 __attribute__((ext_vector_type(2)));

constexpr int BATCH = 4, SEQ = 4096, DM = 2048, T = BATCH * SEQ, MEMT = 256, MT = BATCH * MEMT;
constexpr float EPS = 1e-6f;
constexpr int ML_COLS = 3080, RW_COLS = 3328, AB_COLS = 6408, AB_PAD = 6656;
constexpr int NSA_COLS = 5168, NSA_PAD = 5376;
constexpr int NEXP = 64, FF = 512;
constexpr int XS_ROWS = 49152;
constexpr int SPAD = SEQ + 64;

enum { I_X = 0, I_MEM, I_NORM_MIX, I_NORM_CROSS, I_NORM_MEM, I_NORM_FFN, I_NORM_FINAL, I_AB_W_IN, I_ML_CONV_W, I_ML_CONV_B, I_ML_GATE_B,
       I_RW_MU, I_RW_W0, I_RW_W_UP, I_RW_A0, I_RW_A_UP, I_RW_G_UP, I_RW_K_K, I_RW_K_A, I_RW_R_K, I_RW_LN_W, I_RW_LN_B, I_AB_W_OUT,
       I_NSA_W_IN, I_NSA_GATE_B, I_CMP_POS, I_CMP_W1, I_CMP_W2, I_NSA_W_OUT, I_CA_WQ, I_CA_WK, I_CA_WV, I_CA_WO,
       I_MOE_WG, I_MOE_BG, I_MOE_WE, I_MOE_BE, I_MOE_W_GATE, I_MOE_W_UP, I_MOE_W_DOWN, N_INPUTS };

constexpr size_t MiB = (size_t)1 << 20;
constexpr size_t WS_CTL = 0, CTL_BYTES = 1 * MiB;
constexpr size_t WS_TAB = 1 * MiB;
constexpr size_t WS_W_ABIN = 3 * MiB;
constexpr size_t WS_W_ABOUT = WS_W_ABIN + 26 * MiB;
constexpr size_t WS_W_LORA = WS_W_ABOUT + 8 * MiB;
constexpr size_t WS_W_NSAIN = WS_W_LORA + 2 * MiB;
constexpr size_t WS_W_NSAOUT = WS_W_NSAIN + 21 * MiB;
constexpr size_t WS_W_CMP1 = WS_W_NSAOUT + 8 * MiB;
constexpr size_t WS_W_CAQ = WS_W_CMP1 + 4 * MiB;
constexpr size_t WS_W_CAK = WS_W_CAQ + 16 * MiB;
constexpr size_t WS_W_CAV = WS_W_CAK + 16 * MiB;
constexpr size_t WS_W_CAO = WS_W_CAV + 16 * MiB;
constexpr size_t WS_W_ROUTER = WS_W_CAO + 16 * MiB;
constexpr size_t WS_W_GU = WS_W_ROUTER + 2 * MiB;
constexpr size_t WS_W_DN = WS_W_GU + 512 * MiB;
constexpr size_t WS_MEMN = WS_W_DN + 256 * MiB;
constexpr size_t WS_KP = WS_MEMN + 8 * MiB;
constexpr size_t WS_VP = WS_KP + 8 * MiB;
constexpr size_t WS_WKT = WS_VP + 8 * MiB;
constexpr size_t WS_VWT = WS_WKT + 32 * MiB;
constexpr size_t WS_XR = WS_VWT + 32 * MiB;
constexpr size_t WS_XN = WS_XR + 128 * MiB;
constexpr size_t WS_ARENA = WS_XN + 64 * MiB;
constexpr size_t A_PAB = 0;
constexpr size_t A_GF32 = A_PAB + 208 * MiB;
constexpr size_t A_QM = A_GF32 + 16 * MiB;
constexpr size_t A_KM = A_QM + 16 * MiB;
constexpr size_t A_IG = A_KM + 16 * MiB;
constexpr size_t A_LF = A_IG + 1 * MiB;
constexpr size_t A_RR = A_LF + 1 * MiB;
constexpr size_t A_KR = A_RR + 32 * MiB;
constexpr size_t A_VR = A_KR + 32 * MiB;
constexpr size_t A_KK = A_VR + 32 * MiB;
constexpr size_t A_LIN = A_KK + 32 * MiB;
constexpr size_t A_WD = A_LIN + 8 * MiB;
constexpr size_t A_BV = A_WD + 64 * MiB;
constexpr size_t A_KP = A_BV + 32 * MiB;
constexpr size_t A_GG = A_KP + 32 * MiB;
constexpr size_t A_YCAT = A_GG + 32 * MiB;
constexpr size_t A_END0 = A_YCAT + 64 * MiB;
constexpr size_t A_SC = 0;
constexpr size_t A_PC = A_SC + 64 * MiB;
constexpr size_t A_LOGIT = 0;
constexpr size_t A_EID = A_LOGIT + 16 * MiB;
constexpr size_t A_WTS = A_EID + 1 * MiB;
constexpr size_t A_ROWSLOT = A_WTS + 1 * MiB;
constexpr size_t A_XS = A_ROWSLOT + 1 * MiB;
constexpr size_t A_HID = A_XS + 192 * MiB;
constexpr size_t A_YE = A_HID + 48 * MiB;
constexpr size_t A_END2 = A_YE + 128 * MiB;
constexpr size_t A_Q = 0;
constexpr size_t A_QROT = A_Q + 64 * MiB;
constexpr size_t A_KV6 = A_QROT + 64 * MiB;
constexpr size_t KV6_STRIDE = 17 * MiB;
constexpr size_t A_GATES = A_KV6 + 6 * KV6_STRIDE;
constexpr size_t A_CPART = A_GATES + 4 * MiB;
constexpr size_t A_KCMP = A_CPART + 64 * MiB;
constexpr size_t A_VCMP = A_KCMP + 1 * MiB;
constexpr size_t A_SELMASK = A_VCMP + 1 * MiB;
constexpr size_t A_OACC = A_SELMASK + 1 * MiB;
constexpr size_t A_OCAT = A_OACC + 128 * MiB;
constexpr size_t A_END3 = A_OCAT + 64 * MiB;
constexpr size_t ARENA_BYTES = 640 * MiB;
static_assert(A_END0 <= ARENA_BYTES && A_END2 <= ARENA_BYTES && A_END3 <= ARENA_BYTES, "arena");
constexpr size_t WS_END = WS_ARENA + ARENA_BYTES;
static_assert(WS_END <= (size_t)2048 * MiB, "workspace");
constexpr size_t TAB_ROPE_COS = 0, TAB_ROPE_SIN = 256 * 1024, TAB_CMPBIAS = 512 * 1024;
constexpr int CW_BAR = 4096;
constexpr int CW_MOE_CNT = 16384;
constexpr int CW_MOE_CUR = 16384 + 256;

__device__ __forceinline__ float bf2f(bf16 v) { return __uint_as_float((unsigned)v << 16); }
__device__ __forceinline__ unsigned f2bf(float f) { unsigned u = __float_as_uint(f); return (u + 0x7fffu + ((u >> 16) & 1u)) >> 16; }
__device__ __forceinline__ unsigned pk2(float lo, float hi) { return f2bf(lo) | (f2bf(hi) << 16); }
__device__ __forceinline__ float lo_bf(unsigned w) { return __uint_as_float(w << 16); }
__device__ __forceinline__ float hi_bf(unsigned w) { return __uint_as_float(w & 0xffff0000u); }
__device__ __forceinline__ float sigmoidf_(float x) { return 1.f / (1.f + __expf(-x)); }
__device__ __forceinline__ float siluf_(float x) { return x / (1.f + __expf(-x)); }
__device__ __forceinline__ float wave_sum(float v) {
#pragma unroll
    for (int o = 1; o < 64; o <<= 1) v += __shfl_xor(v, o);
    return v;
}
__device__ __forceinline__ float wave_max(float v) {
#pragma unroll
    for (int o = 1; o < 64; o <<= 1) v = fmaxf(v, __shfl_xor(v, o));
    return v;
}
__device__ __forceinline__ void unpack8(u32x4 w, float* f) {
    f[0] = lo_bf(w.x); f[1] = hi_bf(w.x); f[2] = lo_bf(w.y); f[3] = hi_bf(w.y); f[4] = lo_bf(w.z); f[5] = hi_bf(w.z); f[6] = lo_bf(w.w); f[7] = hi_bf(w.w);
}
__device__ __forceinline__ u32x4 pack8f(const float* f) { u32x4 w; w.x = pk2(f[0], f[1]); w.y = pk2(f[2], f[3]); w.z = pk2(f[4], f[5]); w.w = pk2(f[6], f[7]); return w; }

namespace pg8 {
constexpr int BM = 256, BK = 64, HALF = 128, HTB = HALF * BK * 2, STAGE_BYTES = 8 * HTB, NXCD = 8, WGM = 8;
__host__ __device__ __forceinline__ int lds_byte(int r, int c) { const int st = (r >> 4) * 2 + (c >> 5), rr = r & 15, cc = c & 31, ob = rr * 64 + cc * 2; return st * 1024 + (ob ^ (((ob >> 9) & 1) << 5)); }
__host__ __device__ __forceinline__ void stage_rc(int b, int& R, int& C) { const int st = b / 1024, sb = b % 1024, swz = sb ^ (((sb >> 9) & 1) << 5); R = (st >> 1) * 16 + swz / 64; C = (st & 1) * 32 + (swz % 64) / 2; }
__host__ __device__ __forceinline__ int perm32(int rho) { const int n = rho >> 4, i = rho & 15; return 8 * (i >> 2) + 4 * n + (i & 3); }

struct Unit { long long aoff, boff, coff; int pm, pn, aux; };
struct Gemm { const bf16* A; const bf16* Bt; int lda, ldb, K; };

__device__ __forceinline__ bool tile_of(long L, int nM, int nN, int& pm, int& pn) {
    const int nwg = nM * nN; if (L >= nwg) return false;
    int wgid = (int)L; { const int q = nwg / NXCD, r = nwg % NXCD, xcd = wgid % NXCD, off = wgid / NXCD; wgid = (xcd < r ? xcd * (q + 1) : r * (q + 1) + (xcd - r) * q) + off; }
    const int nig = WGM * nN, gid = wgid / nig, fm = gid * WGM, gsz = (nM - fm) < WGM ? (nM - fm) : WGM;
    pm = fm + ((wgid % nig) % gsz); pn = (wgid % nig) / gsz; return true;
}
struct DenseOrder {
    int nM, nN, G, c, ldc; long long astep, bstep;
    __device__ void init(int M, int N, int lda, int ldb, int ldc_, int G_, int c_) { nM = M / BM; nN = N / BM; G = G_; c = c_; ldc = ldc_; astep = (long long)BM * lda * 2; bstep = (long long)BM * ldb * 2; }
    __device__ __forceinline__ bool next(int i, Unit& u) const {
        int pm, pn; if (!tile_of((long)i * G + c, nM, nN, pm, pn)) return false;
        u.pm = pm; u.pn = pn; u.aux = 0; u.aoff = pm * astep; u.boff = pn * bstep; u.coff = (long long)pm * BM * ldc + pn * BM; return true;
    }
};

__device__ __forceinline__ unsigned cvt_pk_bf16(float lo, float hi) { unsigned r; asm volatile("v_cvt_pk_bf16_f32 %0, %1, %2" : "=v"(r) : "v"(lo), "v"(hi)); return r; }

template <class Epi, class Sched>
__device__ __forceinline__ void gemm_phase(LAS unsigned char* lds, const Gemm g, const Sched& S, const Epi& E) {
    const int tid = threadIdx.x, wid = __builtin_amdgcn_readfirstlane(tid >> 6), lane = tid & 63, wr = wid >> 2, wc = wid & 3, fr = lane & 15, fq = lane >> 4;
    const int nt = g.K / BK;
    unsigned voffA[2], voffB[2];
#pragma unroll
    for (int i = 0; i < 2; ++i) { int R, C; stage_rc(tid * 16 + i * 8192, R, C); const int Rb = (R & ~31) + perm32(R & 31);
        voffA[i] = (unsigned)(R * g.lda + C) * 2u; voffB[i] = (unsigned)(Rb * g.ldb + C) * 2u; }
    const size_t kstep = (size_t)(BK * 2);
    const size_t hstepA = (size_t)HALF * g.lda * 2, hstepB = (size_t)HALF * g.ldb * 2;
    const unsigned ldsw = (unsigned)wid * 1024u;
    const int aoff = lds_byte(wr * 64 + fr, fq * 8), boff = lds_byte(wc * 32 + fr, fq * 8);
#define PG8_SA(b, h) (((b) * 2 + (h)) * HTB)
#define PG8_SB(b, h) ((4 + (b) * 2 + (h)) * HTB)
#define PG8_STAGE(bufoff, gbase, voff) do { _Pragma("unroll") for (int _i = 0; _i < 2; ++_i) \
        __builtin_amdgcn_global_load_lds((const unsigned*)((const char*)(gbase) + (voff)[_i]), (LAS unsigned*)(lds + (bufoff) + ldsw + _i * 8192), 16, 0, 0); } while (0)
#define PG8_LDA(dst, b, h) do { _Pragma("unroll") for (int m = 0; m < 4; ++m) _Pragma("unroll") for (int k = 0; k < 2; ++k) dst[m][k] = *(const LAS bf16x8*)(lds + PG8_SA(b, h) + aoff + m * 2048 + k * 1024); } while (0)
#define PG8_LDB(dst, b, h) do { _Pragma("unroll") for (int n = 0; n < 2; ++n) _Pragma("unroll") for (int k = 0; k < 2; ++k) dst[n][k] = *(const LAS bf16x8*)(lds + PG8_SB(b, h) + boff + n * 2048 + k * 1024); } while (0)
#define PG8_MMA(ai, bj, At, Bt) do { __builtin_amdgcn_s_setprio(1); _Pragma("unroll") for (int m = 0; m < 4; ++m) _Pragma("unroll") for (int n = 0; n < 2; ++n) _Pragma("unroll") for (int k = 0; k < 2; ++k) \
        acc[ai][bj][m][n] = __builtin_amdgcn_mfma_f32_16x16x32_bf16(Bt[n][k], At[m][k], acc[ai][bj][m][n], 0, 0, 0); __builtin_amdgcn_s_setprio(0); } while (0)
#define PG8_WAIT_V(n) asm volatile("s_waitcnt vmcnt(" #n ")" ::: "memory")
#define PG8_WAIT_L(n) asm volatile("s_waitcnt lgkmcnt(" #n ")" ::: "memory")
#define PG8_BAR __builtin_amdgcn_s_barrier()
#define PG8_SCHED __builtin_amdgcn_sched_barrier(0)
    Unit cur, nxt; int ui = 0;
    if (!S.next(0, cur)) return;
    f32x4 acc[2][2][4][2];
#pragma unroll
    for (int a = 0; a < 2; ++a)
#pragma unroll
        for (int b = 0; b < 2; ++b)
#pragma unroll
            for (int m = 0; m < 4; ++m)
#pragma unroll
                for (int n = 0; n < 2; ++n) acc[a][b][m][n] = (f32x4){0.f, 0.f, 0.f, 0.f};
    bf16x8 At[4][2], B0[2][2], B1[2][2];
    const char* cA = (const char*)g.A + cur.aoff; const char* cB = (const char*)g.Bt + cur.boff;
    PG8_STAGE(PG8_SB(0, 0), cB, voffB); PG8_STAGE(PG8_SB(0, 1), cB + hstepB, voffB); PG8_STAGE(PG8_SA(0, 0), cA, voffA); PG8_STAGE(PG8_SA(0, 1), cA + hstepA, voffA);
    if (wr == 1) PG8_BAR;
    PG8_WAIT_V(2); PG8_BAR;
    PG8_STAGE(PG8_SB(1, 0), cB + kstep, voffB); PG8_STAGE(PG8_SA(1, 0), cA + kstep, voffA); PG8_STAGE(PG8_SB(1, 1), cB + hstepB + kstep, voffB);
    PG8_WAIT_V(6); PG8_BAR;
    for (;;) {
        const bool has_next = S.next(ui + 1, nxt);
        const char* nA = has_next ? (const char*)g.A + nxt.aoff : cA; const char* nB = has_next ? (const char*)g.Bt + nxt.boff : cB;
        for (int t = 0; t < nt; t += 2) {
            const bool last = (t == nt - 2);
            const char* a1 = cA + (size_t)(t + 1) * kstep;
            const char* a2 = last ? nA : cA + (size_t)(t + 2) * kstep; const char* b2 = last ? nB : cB + (size_t)(t + 2) * kstep;
            const char* a3 = a2 + kstep; const char* b3 = b2 + kstep;
            PG8_LDB(B0, 0, 0); PG8_LDB(B1, 0, 1); PG8_SCHED; PG8_LDA(At, 0, 0); PG8_STAGE(PG8_SA(1, 1), a1 + hstepA, voffA);
            PG8_WAIT_V(8); PG8_WAIT_L(0); PG8_BAR; PG8_MMA(0, 0, At, B0); PG8_MMA(0, 1, At, B1); PG8_BAR; PG8_SCHED;
            PG8_LDA(At, 0, 1); PG8_STAGE(PG8_SB(0, 0), b2, voffB); PG8_STAGE(PG8_SB(0, 1), b2 + hstepB, voffB); PG8_STAGE(PG8_SA(0, 0), a2, voffA);
            PG8_WAIT_V(8); PG8_WAIT_L(0); PG8_BAR; PG8_MMA(1, 0, At, B0); PG8_MMA(1, 1, At, B1); PG8_BAR; PG8_SCHED;
            PG8_LDB(B0, 1, 0); PG8_LDB(B1, 1, 1); PG8_SCHED; PG8_LDA(At, 1, 0); PG8_STAGE(PG8_SA(0, 1), a2 + hstepA, voffA);
            PG8_WAIT_V(8); PG8_WAIT_L(0); PG8_BAR; PG8_MMA(0, 0, At, B0); PG8_MMA(0, 1, At, B1); PG8_BAR; PG8_SCHED;
            PG8_LDA(At, 1, 1); PG8_STAGE(PG8_SB(1, 0), b3, voffB); PG8_STAGE(PG8_SB(1, 1), b3 + hstepB, voffB); PG8_STAGE(PG8_SA(1, 0), a3, voffA);
            PG8_WAIT_V(8); PG8_WAIT_L(0); PG8_BAR; PG8_MMA(1, 0, At, B0); PG8_MMA(1, 1, At, B1); PG8_BAR; PG8_SCHED;
        }
        if (wr == 0) PG8_BAR;
        E(acc, cur, wr, wc, fr, fq);
        if (!has_next) break;
#pragma unroll
        for (int a = 0; a < 2; ++a)
#pragma unroll
            for (int b = 0; b < 2; ++b)
#pragma unroll
                for (int m = 0; m < 4; ++m)
#pragma unroll
                    for (int n = 0; n < 2; ++n) acc[a][b][m][n] = (f32x4){0.f, 0.f, 0.f, 0.f};
        cur = nxt; cA = nA; cB = nB; ++ui;
        if (wr == 1) PG8_BAR;
    }
    PG8_WAIT_V(0);
    PG8_BAR;
#undef PG8_SA
#undef PG8_SB
#undef PG8_STAGE
#undef PG8_LDA
#undef PG8_LDB
#undef PG8_MMA
#undef PG8_WAIT_V
#undef PG8_WAIT_L
#undef PG8_BAR
#undef PG8_SCHED
}
}

#define XB_TMO      128
#define XB_XCNT(j)  (256  + 64 * (j))
#define XB_XSUB(j)  (1280 + 64 * (j))
#define XB_XGEN(j)  (2304 + 64 * (j))
#define XB_TOP      3328
#define XB_TOPGEN   3392
#define XCD_BAR_WORDS 3456
#define XB_SPIN_CAP (1u << 22)
__device__ __forceinline__ unsigned xb_ld(unsigned* p)              { return __hip_atomic_load(p, __ATOMIC_RELAXED, __HIP_MEMORY_SCOPE_AGENT); }
__device__ __forceinline__ unsigned xb_add(unsigned* p, unsigned v) { return __hip_atomic_fetch_add(p, v, __ATOMIC_RELAXED, __HIP_MEMORY_SCOPE_AGENT); }
__device__ __forceinline__ unsigned xb_xcc_id() { return (unsigned)__builtin_amdgcn_s_getreg((3 << 11) | 20) & 0xFu; }
#define XB_SPIN(cond, bar) do { unsigned _sp = 0; while (cond) { __builtin_amdgcn_s_sleep(1); \
    if ((++_sp & 255u) == 0u) { if (xb_ld(&(bar)[XB_TMO])) break; if (_sp > XB_SPIN_CAP) { atomicAdd(&(bar)[XB_TMO], 1u); break; } } } } while (0)
struct XcdBarrier { unsigned* bar; unsigned x; volatile LAS unsigned* st; };
__device__ __forceinline__ XcdBarrier xcd_barrier_post(unsigned* bar, volatile LAS unsigned* st) {
    XcdBarrier b; b.bar = bar; b.x = xb_xcc_id(); b.st = st;
    if (threadIdx.x == 0) (void)xb_add(&bar[XB_XCNT(b.x)], 1u);
    return b;
}
__device__ __forceinline__ void xcd_barrier_complete(unsigned* bar, unsigned x, unsigned& nloc, unsigned& nx) {
    const unsigned G = gridDim.x * gridDim.y * gridDim.z;
    unsigned sum, cnt, mine, sp = 0u;
    for (;;) {
        sum = 0u; cnt = 0u; mine = 0u;
#pragma unroll
        for (unsigned j = 0; j < 16; ++j) { const unsigned c = xb_ld(&bar[XB_XCNT(j)]); sum += c; cnt += (c > 0u) ? 1u : 0u; mine = (j == x) ? c : mine; }
        if (sum == G) break;
        __builtin_amdgcn_s_sleep(1);
        if ((++sp & 255u) == 0u) { if (xb_ld(&bar[XB_TMO])) break; if (sp > XB_SPIN_CAP) { atomicAdd(&bar[XB_TMO], 1u); break; } }
    }
    nloc = mine > 0u ? mine : 1u; nx = cnt > 0u ? cnt : 1u;
}
__device__ __forceinline__ void xcd_barrier(const XcdBarrier& b) {
    asm volatile("s_waitcnt vmcnt(0)" ::: "memory");
    __syncthreads();
    if (threadIdx.x == 0) {
        unsigned* bar = b.bar;
        __builtin_amdgcn_s_waitcnt(0);
        unsigned nloc = b.st[0], nx = b.st[1];
        if (nloc == 0u) { xcd_barrier_complete(bar, b.x, nloc, nx); b.st[0] = nloc; b.st[1] = nx; }
        const unsigned old = xb_add(&bar[XB_XSUB(b.x)], 1u);
        const unsigned gen = old / nloc;
        if (old + 1u == (gen + 1u) * nloc) {
            __builtin_amdgcn_fence(__ATOMIC_RELEASE, "agent");
            asm volatile("s_waitcnt vmcnt(0)" ::: "memory");
            const unsigned og = xb_add(&bar[XB_TOP], 1u);
            const unsigned tg = og / nx;
            if (og + 1u == (tg + 1u) * nx) xb_add(&bar[XB_TOPGEN], 1u);
            else XB_SPIN(xb_ld(&bar[XB_TOPGEN]) == tg, bar);
            __builtin_amdgcn_fence(__ATOMIC_ACQUIRE, "agent");
            xb_add(&bar[XB_XGEN(b.x)], 1u);
            asm volatile("s_waitcnt vmcnt(0)" ::: "memory");
        } else {
            XB_SPIN(xb_ld(&bar[XB_XGEN(b.x)]) == gen, bar);
            __builtin_amdgcn_fence(__ATOMIC_ACQUIRE, "agent");
            asm volatile("s_waitcnt vmcnt(0)" ::: "memory");
        }
    }
    __syncthreads();
}

constexpr int NWAVES = 8, NTHR = 512;
constexpr int LDS_MAIN = 131072;
constexpr int LDS_AUX = 131072, LDS_AUX_BYTES = 16384;
constexpr int LDS_MISC = LDS_AUX + LDS_AUX_BYTES;
constexpr int LDS_BYTES = LDS_MISC + 256;
struct Args { const float* in[N_INPUTS]; float* out; unsigned char* ws; int ph_lo, ph_hi; };

struct Ctx {
    LAS unsigned char* lds;
    int tid, lane, wave, G, bid, gw, ngw;
    unsigned char* ws;
};
#define WSP(T_, off) ((T_*)(C.ws + (off)))
#define ARP(T_, off) ((T_*)(C.ws + WS_ARENA + (off)))
#define LDS_WAIT() asm volatile("s_waitcnt lgkmcnt(0)" ::: "memory")

__device__ __forceinline__ void rms_row_bf16(const float* xrow, const float* gain, bf16* orow, int lane) {
    f32x4 v[8]; float s = 0.f;
#pragma unroll
    for (int j = 0; j < 8; ++j) { v[j] = *(const f32x4*)(xrow + (j * 64 + lane) * 4); s += v[j].x * v[j].x + v[j].y * v[j].y + v[j].z * v[j].z + v[j].w * v[j].w; }
    const float rstd = rsqrtf(wave_sum(s) * (1.f / DM) + EPS);
#pragma unroll
    for (int j = 0; j < 8; ++j) { const f32x4 g = *(const f32x4*)(gain + (j * 64 + lane) * 4);
        u32x2 w; w.x = pk2(v[j].x * rstd * g.x, v[j].y * rstd * g.y); w.y = pk2(v[j].z * rstd * g.z, v[j].w * rstd * g.w);
        *(u32x2*)(orow + (j * 64 + lane) * 4) = w; }
}

template <class F>
__device__ __forceinline__ void transpose_tile(const float* W, int ldw, int nvalid, int k0, int n0, bf16* WT, int ldt, F drow, LAS float* scr, int lane) {
    const int nn = n0 + (lane & 31);
#pragma unroll 8
    for (int i = 0; i < 32; ++i) { const int kk = 2 * i + (lane >> 5); scr[kk * 33 + (lane & 31)] = (nn < nvalid) ? W[(size_t)(k0 + kk) * ldw + nn] : 0.f; }
    LDS_WAIT(); asm volatile("" ::: "memory");
    const int c = lane & 7;
#pragma unroll
    for (int j = 0; j < 4; ++j) { const int n = (lane >> 3) + 8 * j; const LAS float* s = scr + (8 * c) * 33 + n;
        u32x4 o; o.x = pk2(s[0 * 33], s[1 * 33]); o.y = pk2(s[2 * 33], s[3 * 33]); o.z = pk2(s[4 * 33], s[5 * 33]); o.w = pk2(s[6 * 33], s[7 * 33]);
        *(u32x4*)(WT + (size_t)drow(n0 + n) * ldt + k0 + 8 * c) = o; }
    LDS_WAIT(); asm volatile("" ::: "memory");
}
template <class F>
__device__ __forceinline__ void transpose_matrix(const Ctx& C, const float* W, int K, int N, int Npad, bf16* WT, int ldt, F drow, LAS float* scr) {
    const int nblk = Npad / 32, items = (K / 64) * nblk;
    for (int it = C.gw; it < items; it += C.ngw) { const int kb = it / nblk, nb = it % nblk; transpose_tile(W, N, N, kb * 64, nb * 32, WT, ldt, drow, scr, C.lane); }
}

#define EPI_ARGS const f32x4 (&acc)[2][2][4][2], const pg8::Unit& u, int wr, int wc, int fr, int fq
struct EpiStoreBf16 {
    bf16* O; int ldc; float scale;
    __device__ __forceinline__ void operator()(EPI_ARGS) const {
        bf16* base = O + u.coff + (size_t)(wr * 64 + fr) * ldc + wc * 32 + 8 * fq;
#pragma unroll
        for (int ai = 0; ai < 2; ++ai)
#pragma unroll
            for (int m = 0; m < 4; ++m) { bf16* rowp = base + (size_t)(ai * 128 + m * 16) * ldc;
#pragma unroll
                for (int bj = 0; bj < 2; ++bj) { const f32x4 v0 = acc[ai][bj][m][0] * scale, v1 = acc[ai][bj][m][1] * scale;
                    u32x4 w; w.x = pg8::cvt_pk_bf16(v0[0], v0[1]); w.y = pg8::cvt_pk_bf16(v0[2], v0[3]); w.z = pg8::cvt_pk_bf16(v1[0], v1[1]); w.w = pg8::cvt_pk_bf16(v1[2], v1[3]);
                    *(u32x4*)(rowp + bj * 128) = w; } }
    }
};
struct EpiStoreF32 {
    float* O; int ldc;
    __device__ __forceinline__ void operator()(EPI_ARGS) const {
        float* base = O + u.coff + (size_t)(wr * 64 + fr) * ldc + wc * 32 + 8 * fq;
#pragma unroll
        for (int ai = 0; ai < 2; ++ai)
#pragma unroll
            for (int m = 0; m < 4; ++m) { float* rowp = base + (size_t)(ai * 128 + m * 16) * ldc;
#pragma unroll
                for (int bj = 0; bj < 2; ++bj) { *(f32x4*)(rowp + bj * 128) = acc[ai][bj][m][0]; *(f32x4*)(rowp + bj * 128 + 4) = acc[ai][bj][m][1]; } }
    }
};
struct EpiResid {
    const float* base; float* out; int ldc;
    __device__ __forceinline__ void operator()(EPI_ARGS) const {
        const size_t o0 = (size_t)u.coff + (size_t)(wr * 64 + fr) * ldc + wc * 32 + 8 * fq;
#pragma unroll
        for (int ai = 0; ai < 2; ++ai)
#pragma unroll
            for (int m = 0; m < 4; ++m) { const size_t o = o0 + (size_t)(ai * 128 + m * 16) * ldc;
#pragma unroll
                for (int bj = 0; bj < 2; ++bj) {
                    const f32x4 b0 = *(const f32x4*)(base + o + bj * 128), b1 = *(const f32x4*)(base + o + bj * 128 + 4);
                    *(f32x4*)(out + o + bj * 128) = b0 + acc[ai][bj][m][0]; *(f32x4*)(out + o + bj * 128 + 4) = b1 + acc[ai][bj][m][1]; } }
    }
};
struct EpiAbIn {
    bf16* P; float* G32;
    __device__ __forceinline__ void operator()(EPI_ARGS) const {
        const int row0 = u.pm * 256 + wr * 64 + fr, col0 = u.pn * 256 + wc * 32 + 8 * fq;
#pragma unroll
        for (int ai = 0; ai < 2; ++ai)
#pragma unroll
            for (int m = 0; m < 4; ++m) { const int row = row0 + ai * 128 + m * 16; bf16* rowp = P + (size_t)row * AB_PAD + col0;
#pragma unroll
                for (int bj = 0; bj < 2; ++bj) { const f32x4 v0 = acc[ai][bj][m][0], v1 = acc[ai][bj][m][1];
                    u32x4 w; w.x = pg8::cvt_pk_bf16(v0[0], v0[1]); w.y = pg8::cvt_pk_bf16(v0[2], v0[3]); w.z = pg8::cvt_pk_bf16(v1[0], v1[1]); w.w = pg8::cvt_pk_bf16(v1[2], v1[3]);
                    *(u32x4*)(rowp + bj * 128) = w;
                    if (u.pn == 12) { float* g = G32 + (size_t)row * 256 + wc * 32 + 8 * fq + bj * 128; *(f32x4*)g = v0; *(f32x4*)(g + 4) = v1; } } }
    }
};
struct EpiLora {
    const float *w0, *a0, *k_a; const bf16 *KK, *KR; float* WD; bf16 *BV, *KP, *GG;
    __device__ __forceinline__ void operator()(EPI_ARGS) const {
        const int grp = u.pn >> 2, row0 = u.pm * 256 + wr * 64 + fr, cc0 = (u.pn & 3) * 256 + wc * 32 + 8 * fq;
#pragma unroll
        for (int ai = 0; ai < 2; ++ai)
#pragma unroll
            for (int m = 0; m < 4; ++m) { const size_t ro = (size_t)(row0 + ai * 128 + m * 16) * 1024;
#pragma unroll
                for (int bj = 0; bj < 2; ++bj) { const int cc = cc0 + bj * 128; float v[8];
#pragma unroll
                    for (int j = 0; j < 4; ++j) { v[j] = acc[ai][bj][m][0][j]; v[4 + j] = acc[ai][bj][m][1][j]; }
                    if (grp == 0) { float o[8];
#pragma unroll
                        for (int j = 0; j < 8; ++j) o[j] = __expf(-0.6065306597126334f * sigmoidf_(w0[cc + j] + v[j]));
                        *(f32x4*)(WD + ro + cc) = (f32x4){o[0], o[1], o[2], o[3]}; *(f32x4*)(WD + ro + cc + 4) = (f32x4){o[4], o[5], o[6], o[7]};
                    } else if (grp == 1) { float kk[8], kr[8], ob[8], ok[8];
                        unpack8(*(const u32x4*)(KK + ro + cc), kk); unpack8(*(const u32x4*)(KR + ro + cc), kr);
#pragma unroll
                        for (int j = 0; j < 8; ++j) { const float a = sigmoidf_(a0[cc + j] + v[j]); ob[j] = kk[j] * a; ok[j] = kr[j] * (1.f + (a - 1.f) * k_a[cc + j]); }
                        *(u32x4*)(BV + ro + cc) = pack8f(ob); *(u32x4*)(KP + ro + cc) = pack8f(ok);
                    } else { *(u32x4*)(GG + ro + cc) = pack8f(v); } } }
    }
};
struct EpiHid {
    bf16* H;
    __device__ __forceinline__ void operator()(EPI_ARGS) const {
        bf16* base = H + (size_t)(u.aux + wr * 64 + fr) * FF + u.pn * 128 + wc * 32 + 8 * fq;
#pragma unroll
        for (int ai = 0; ai < 2; ++ai)
#pragma unroll
            for (int m = 0; m < 4; ++m) { float h[8];
#pragma unroll
                for (int j = 0; j < 4; ++j) { h[j] = siluf_(acc[ai][0][m][0][j]) * acc[ai][1][m][0][j]; h[4 + j] = siluf_(acc[ai][0][m][1][j]) * acc[ai][1][m][1][j]; }
                *(u32x4*)(base + (size_t)(ai * 128 + m * 16) * FF) = pack8f(h); }
    }
};
struct EpiMoeDown {
    const int* rowslot; const float* wts; bf16* YE;
    __device__ __forceinline__ void operator()(EPI_ARGS) const {
#pragma unroll
        for (int ai = 0; ai < 2; ++ai)
#pragma unroll
            for (int m = 0; m < 4; ++m) { const int r = ai * 128 + wr * 64 + m * 16 + fr;
                if (r < u.pm) { const int slot = rowslot[u.aux + r]; const float w = wts[slot]; bf16* rowp = YE + (size_t)slot * DM + u.pn * 256 + wc * 32 + 8 * fq;
#pragma unroll
                    for (int bj = 0; bj < 2; ++bj) { const f32x4 v0 = acc[ai][bj][m][0] * w, v1 = acc[ai][bj][m][1] * w;
                        u32x4 o; o.x = pg8::cvt_pk_bf16(v0[0], v0[1]); o.y = pg8::cvt_pk_bf16(v0[2], v0[3]); o.z = pg8::cvt_pk_bf16(v1[0], v1[1]); o.w = pg8::cvt_pk_bf16(v1[2], v1[3]);
                        *(u32x4*)(rowp + bj * 128) = o; } } }
    }
};
struct EpiNsaIn {
    bf16 *Q, *QROT, *KV6; float* GATES; const float *gate_b, *rcos, *rsin;
    __device__ __forceinline__ void operator()(EPI_ARGS) const {
        const int pn = u.pn;
#pragma unroll
        for (int ai = 0; ai < 2; ++ai)
#pragma unroll
            for (int m = 0; m < 4; ++m) { const int t = u.pm * 256 + ai * 128 + wr * 64 + m * 16 + fr, b = t >> 12, s = t & 4095;
#pragma unroll
                for (int bj = 0; bj < 2; ++bj) { float v[8];
#pragma unroll
                    for (int j = 0; j < 4; ++j) { v[j] = acc[ai][bj][m][0][j]; v[4 + j] = acc[ai][bj][m][1][j]; }
                    const int d0 = wc * 32 + 8 * fq;
                    if (pn == 20) {
                        const int c = bj * 128 + d0;
                        if (c < 48) { float o[8];
#pragma unroll
                            for (int j = 0; j < 8; ++j) o[j] = sigmoidf_(v[j] + gate_b[c + j]);
                            float* g = GATES + (size_t)t * 48 + c; *(f32x4*)g = (f32x4){o[0], o[1], o[2], o[3]}; *(f32x4*)(g + 4) = (f32x4){o[4], o[5], o[6], o[7]}; }
                        continue; }
                    float vr[8];
                    { float pv[8];
#pragma unroll
                      for (int j = 0; j < 8; ++j) pv[j] = __shfl_xor(v[j], 32);
                      const float* cs = rcos + s * 16 + 8 * (fq & 1); const float* sn = rsin + s * 16 + 8 * (fq & 1);
#pragma unroll
                      for (int j = 0; j < 8; ++j) { const float c_ = cs[j], s_ = sn[j]; vr[j] = (fq < 2) ? (v[j] * c_ - pv[j] * s_) : (v[j] * c_ + pv[j] * s_); } }
                    if (pn < 8) { const int hh = pn * 2 + bj; const size_t o = (((size_t)(b * 16 + hh)) * SEQ + s) * 128 + d0;
                        *(u32x4*)(Q + o) = pack8f(v); *(u32x4*)(QROT + o) = (wc == 0) ? pack8f(vr) : pack8f(v);
                    } else { const int i6 = (pn - 8) >> 1, g = ((pn - 8) & 1) * 2 + bj; const bool rot = (i6 == 2 || i6 == 4) && wc == 0;
                        bf16* dst = (bf16*)((unsigned char*)KV6 + (size_t)i6 * KV6_STRIDE) + (((size_t)(b * 4 + g)) * SPAD + s) * 128 + d0;
                        *(u32x4*)dst = rot ? pack8f(vr) : pack8f(v); } } }
    }
};

__device__ __forceinline__ void phase_prologue(const Ctx& C, const Args& A) {
    LAS float* scr = (LAS float*)(C.lds + C.wave * 8448);
    auto ident = [](int n) { return n; };
    transpose_matrix(C, A.in[I_AB_W_IN], DM, AB_COLS, AB_PAD, WSP(bf16, WS_W_ABIN), DM, ident, scr);
    transpose_matrix(C, A.in[I_AB_W_OUT], DM, DM, DM, WSP(bf16, WS_W_ABOUT), DM, ident, scr);
    transpose_matrix(C, A.in[I_NSA_W_IN], DM, NSA_COLS, NSA_PAD, WSP(bf16, WS_W_NSAIN), DM, ident, scr);
    transpose_matrix(C, A.in[I_NSA_W_OUT], DM, DM, DM, WSP(bf16, WS_W_NSAOUT), DM, ident, scr);
    for (int l = 0; l < 2; ++l) {
        transpose_matrix(C, A.in[I_CA_WK] + (size_t)l * DM * DM, DM, DM, DM, WSP(bf16, WS_W_CAK) + (size_t)l * DM * DM, DM, ident, scr);
        transpose_matrix(C, A.in[I_CA_WV] + (size_t)l * DM * DM, DM, DM, DM, WSP(bf16, WS_W_CAV) + (size_t)l * DM * DM, DM, ident, scr);
        transpose_matrix(C, A.in[I_CA_WO] + (size_t)l * DM * DM, DM, DM, DM, WSP(bf16, WS_W_CAO) + (size_t)l * DM * DM, DM, ident, scr);
    }
    for (int kv = 0; kv < 2; ++kv)
        transpose_matrix(C, A.in[I_CMP_W1] + (size_t)kv * 4096 * 128, 4096, 128, 128, WSP(bf16, WS_W_CMP1) + (size_t)kv * 256 * 4096, 4096, ident, scr);
    {
        auto dg = [](int n) { return (n >> 7) * 256 + (n & 127); };
        auto du = [](int n) { return (n >> 7) * 256 + 128 + (n & 127); };
        const int per = 512;
        const int total = 2 * NEXP * 3 * per;
        for (int it = C.gw; it < total; it += C.ngw) {
            const int le = it / (3 * per), r = it % (3 * per), which = r / per, q = r % per;
            if (which == 0) { const int kb = q / 16, nb = q % 16; transpose_tile(A.in[I_MOE_W_GATE] + (size_t)le * DM * FF, FF, FF, kb * 64, nb * 32, WSP(bf16, WS_W_GU) + (size_t)le * 1024 * DM, DM, dg, scr, C.lane); }
            else if (which == 1) { const int kb = q / 16, nb = q % 16; transpose_tile(A.in[I_MOE_W_UP] + (size_t)le * DM * FF, FF, FF, kb * 64, nb * 32, WSP(bf16, WS_W_GU) + (size_t)le * 1024 * DM, DM, du, scr, C.lane); }
            else { const int kb = q / 64, nb = q % 64; transpose_tile(A.in[I_MOE_W_DOWN] + (size_t)le * FF * DM, DM, DM, kb * 64, nb * 32, WSP(bf16, WS_W_DN) + (size_t)le * DM * FF, FF, ident, scr, C.lane); }
        }
    }
    const size_t gt = (size_t)C.bid * NTHR + C.tid, gn = (size_t)C.G * NTHR;
    { const float* src = A.in[I_CA_WQ]; bf16* dst = WSP(bf16, WS_W_CAQ);
      for (size_t i = gt; i < (size_t)2 * DM * DM / 4; i += gn) { const f32x4 v = *(const f32x4*)(src + i * 4); u32x2 w; w.x = pk2(v.x, v.y); w.y = pk2(v.z, v.w); *(u32x2*)(dst + i * 4) = w; } }
    { bf16* dst = WSP(bf16, WS_W_LORA);
      for (size_t i = gt; i < (size_t)3072 * 256; i += gn) { const int n = (int)(i >> 8), k = (int)(i & 255); float v = 0.f;
          if (n < 1024) { if (k < 64) v = A.in[I_RW_W_UP][k * 1024 + n]; }
          else if (n < 2048) { if (k >= 64 && k < 128) v = A.in[I_RW_A_UP][(k - 64) * 1024 + (n - 1024)]; }
          else { if (k >= 128) v = A.in[I_RW_G_UP][(k - 128) * 1024 + (n - 2048)]; }
          dst[i] = (bf16)f2bf(v); } }
    { bf16* dst = WSP(bf16, WS_W_ROUTER);
      for (size_t i = gt; i < (size_t)2 * 256 * DM; i += gn) { const int l = (int)(i / (256 * DM)), n = (int)((i / DM) & 255), k = (int)(i % DM); float v = 0.f;
          if (n < 8) v = A.in[I_MOE_WG][((size_t)l * DM + k) * 8 + n]; else if (n < 72) v = A.in[I_MOE_WE][((size_t)l * DM + k) * 64 + (n - 8)];
          dst[i] = (bf16)f2bf(v); } }
    { float* rc = WSP(float, WS_TAB + TAB_ROPE_COS); float* rs = WSP(float, WS_TAB + TAB_ROPE_SIN);
      for (size_t i = gt; i < (size_t)SEQ * 16; i += gn) { const int pos = (int)(i >> 4), j = (int)(i & 15);
          const float inv = 1.0f / powf(500000.0f, (float)j / 16.0f); const float ang = (float)pos * inv; rc[i] = cosf(ang); rs[i] = sinf(ang); } }
    for (int o = C.gw; o < 256; o += C.ngw) { const int kv = o >> 7, e = o & 127; float s = 0.f;
        for (int i = C.lane; i < 4096; i += 64) s += A.in[I_CMP_POS][kv * 4096 + i] * A.in[I_CMP_W1][((size_t)kv * 4096 + i) * 128 + e];
        s = wave_sum(s); if (C.lane == 0) WSP(float, WS_TAB + TAB_CMPBIAS)[o] = s; }
    for (int r = C.gw; r < 2 * MT; r += C.ngw) { const int l = r / MT, m = r % MT;
        rms_row_bf16(A.in[I_MEM] + (size_t)m * DM, A.in[I_NORM_MEM] + l * DM, WSP(bf16, WS_MEMN) + ((size_t)l * MT + m) * DM, C.lane); }
    for (int r = C.gw; r < T; r += C.ngw) rms_row_bf16(A.in[I_X] + (size_t)r * DM, A.in[I_NORM_MIX], WSP(bf16, WS_XN) + (size_t)r * DM, C.lane);
}

struct MemProjOrder {
    int G, c;
    __device__ __forceinline__ bool next(int i, pg8::Unit& u) const {
        const int L = i * G + c; if (L >= 128) return false;
        const int pn = L & 7, pm = (L >> 3) & 3, kv = (L >> 5) & 1, l = L >> 6;
        u.pm = pm; u.pn = pn; u.aux = 0;
        u.aoff = ((long long)l * MT + pm * 256) * DM * 2;
        u.boff = ((long long)(kv ? (WS_W_CAV - WS_W_CAK) / 2 : 0) + ((long long)l * DM + pn * 256) * DM) * 2;
        u.coff = (long long)(kv ? (WS_VP - WS_KP) / 2 : 0) + ((long long)l * MT + pm * 256) * DM + pn * 256;
        return true;
    }
};
struct WktOrder {
    int G, c;
    __device__ __forceinline__ bool next(int i, pg8::Unit& u) const {
        const int L = i * G + c; if (L >= 256) return false;
        const int pn = L & 7, h = (L >> 3) & 3, b = (L >> 5) & 3, l = L >> 7;
        u.pm = 0; u.pn = pn; u.aux = 0;
        u.aoff = (((long long)l * MT + b * 256) * DM + h * 512) * 2;
        u.boff = (((long long)l * DM + pn * 256) * DM + h * 512) * 2;
        u.coff = (((long long)(l * 4 + b) * 1024) + h * 256) * DM + pn * 256;
        return true;
    }
};
struct VwtOrder {
    int G, c;
    __device__ __forceinline__ bool next(int i, pg8::Unit& u) const {
        const int L = i * G + c; if (L >= 256) return false;
        const int pm = L & 7, h = (L >> 3) & 3, b = (L >> 5) & 3, l = L >> 7;
        u.pm = pm; u.pn = 0; u.aux = 0;
        u.aoff = (((long long)l * DM + pm * 256) * DM + h * 512) * 2;
        u.boff = (((long long)l * MT + b * 256) * DM + h * 512) * 2;
        u.coff = (((long long)(l * 4 + b) * DM) + pm * 256) * 1024 + h * 256;
        return true;
    }
};
struct CrossOrder {
    int nN, G, c, ldc; long long astep, bstep, bbatch;
    __device__ __forceinline__ bool next(int i, pg8::Unit& u) const {
        int pm, pn; if (!pg8::tile_of((long)i * G + c, T / 256, nN, pm, pn)) return false;
        u.pm = pm; u.pn = pn; u.aux = 0; u.aoff = pm * astep; u.boff = (pm >> 4) * bbatch + pn * bstep; u.coff = (long long)pm * 256 * ldc + pn * 256; return true;
    }
};
struct CmpOrder {
    int G, c;
    __device__ __forceinline__ bool next(int i, pg8::Unit& u) const {
        const int L = i * G + c; if (L >= 256) return false;
        const int bg = L & 15, kv = (L >> 4) & 1, ks = L >> 5;
        u.pm = 0; u.pn = 0; u.aux = 0;
        u.aoff = (long long)kv * KV6_STRIDE + ((long long)bg * SPAD * 128 + ks * 512) * 2;
        u.boff = ((long long)kv * 256 * 4096 + ks * 512) * 2;
        u.coff = ((long long)(ks * 2 + kv) * 16 + bg) * 65536;
        return true;
    }
};
struct MoeOrder {
    const LAS int* tab; int npn, G, c, which;
    __device__ __forceinline__ bool next(int i, pg8::Unit& u) const {
        const int L = i * G + c, ntile = tab[64]; if (L >= ntile * npn) return false;
        const int tix = L / npn, pn = L % npn; int e = 0;
        for (int k = 32; k >= 1; k >>= 1) if (e + k < 64 && tab[e + k] <= tix) e += k;
        while (tab[e + 1] <= tix) ++e;
        const int mt = tix - tab[e], cnt = tab[65 + e], row0 = tab[129 + e] + mt * 256;
        u.pm = min(256, cnt - mt * 256); u.pn = pn; u.aux = row0;
        if (which == 0) { u.aoff = (long long)row0 * DM * 2; u.boff = ((long long)e * 1024 + pn * 256) * DM * 2; }
        else { u.aoff = (long long)row0 * FF * 2; u.boff = ((long long)e * DM + pn * 256) * FF * 2; }
        u.coff = 0; return true;
    }
};
__device__ __forceinline__ void moe_build_table(const Ctx& C, const unsigned* cnt, LAS int* tab) {
    if (C.tid == 0) { int ts = 0, off = 0;
        for (int e = 0; e < 64; ++e) { const int n = (int)cnt[e]; tab[e] = ts; tab[65 + e] = n; tab[129 + e] = off; const int nt = (n + 255) >> 8; ts += nt; off += nt * 256; }
        tab[64] = ts; }
    __syncthreads();
}

__device__ __forceinline__ float log_sigmoidf_(float x) { return fminf(x, 0.f) - log1pf(__expf(-fabsf(x))); }
__device__ __forceinline__ void phase_mixer_prep(const Ctx& C, const Args& A) {
    const bf16* PAB = ARP(bf16, A_PAB); const float* G32 = ARP(float, A_GF32);
    bf16 *QM = ARP(bf16, A_QM), *KM = ARP(bf16, A_KM), *RR = ARP(bf16, A_RR), *KR = ARP(bf16, A_KR), *VR = ARP(bf16, A_VR), *KK = ARP(bf16, A_KK), *LIN = ARP(bf16, A_LIN);
    float *IG = ARP(float, A_IG), *LF = ARP(float, A_LF);
    const float *cw = A.in[I_ML_CONV_W], *cb = A.in[I_ML_CONV_B], *gb = A.in[I_ML_GATE_B], *mu = A.in[I_RW_MU], *k_k = A.in[I_RW_K_K];
    const int lane = C.lane;
    for (int t = C.gw; t < T; t += C.ngw) {
        const int b = t >> 12, s = t & 4095; const bf16* P = PAB + (size_t)t * AB_PAD;
#pragma unroll
        for (int it = 0; it < 2; ++it) { const int c = (lane + 64 * it) * 8; float y[8];
#pragma unroll
            for (int j = 0; j < 8; ++j) y[j] = cb[c + j];
#pragma unroll
            for (int tap = 0; tap < 4; ++tap) { const int back = 3 - tap;
                if (s >= back) { float xv[8]; unpack8(*(const u32x4*)(P - (size_t)back * AB_PAD + c), xv);
#pragma unroll
                    for (int j = 0; j < 8; ++j) y[j] += xv[j] * cw[tap * 1024 + c + j]; } }
#pragma unroll
            for (int j = 0; j < 8; ++j) y[j] = siluf_(y[j]);
            if (c < 512) *(u32x4*)(QM + (size_t)t * 512 + c) = pack8f(y); else *(u32x4*)(KM + (size_t)t * 512 + c - 512) = pack8f(y); }
        if (lane < 8) { const float g = G32[(size_t)t * 256 + lane] + gb[lane];
            if (lane < 4) IG[(size_t)(b * 4 + lane) * SEQ + s] = g; else LF[(size_t)(b * 4 + lane - 4) * SEQ + s] = log_sigmoidf_(g); }
        const bf16* PR = P + ML_COLS;
#pragma unroll
        for (int it = 0; it < 7; ++it) { const int chunk = lane + 64 * it; if (chunk >= 416) break; const int cc = chunk * 8;
            float p[8], pp[8], mx[8]; unpack8(*(const u32x4*)(PR + cc), p);
            if (s > 0) unpack8(*(const u32x4*)(PR - AB_PAD + cc), pp); else {
#pragma unroll
                for (int j = 0; j < 8; ++j) pp[j] = 0.f; }
#pragma unroll
            for (int j = 0; j < 8; ++j) mx[j] = p[j] + (pp[j] - p[j]) * mu[cc + j];
            if (it < 2) *(u32x4*)(RR + (size_t)t * 1024 + cc) = pack8f(mx);
            else if (it < 4) { const int ck = cc - 1024; *(u32x4*)(KR + (size_t)t * 1024 + ck) = pack8f(mx);
                float kk[8], ss = 0.f;
#pragma unroll
                for (int j = 0; j < 8; ++j) { kk[j] = mx[j] * k_k[ck + j]; ss += kk[j] * kk[j]; }
                ss += __shfl_xor(ss, 1); ss += __shfl_xor(ss, 2); ss += __shfl_xor(ss, 4);
                const float rn = rsqrtf(ss + 1e-12f);
#pragma unroll
                for (int j = 0; j < 8; ++j) kk[j] *= rn;
                *(u32x4*)(KK + (size_t)t * 1024 + ck) = pack8f(kk); }
            else if (it < 6) *(u32x4*)(VR + (size_t)t * 1024 + cc - 2048) = pack8f(mx);
            else { float o[8];
#pragma unroll
                for (int j = 0; j < 8; ++j) o[j] = (lane < 8) ? tanhf(mx[j]) : ((lane < 16) ? mx[j] : sigmoidf_(mx[j]));
                *(u32x4*)(LIN + (size_t)t * 256 + lane * 8) = pack8f(o); } }
    }
}

__device__ __forceinline__ void rwkv_scan_unit(const Ctx& C, const Args& A, int bh) {
    const int b = bh >> 4, h = bh & 15, w = C.wave, lane = C.lane, tid = C.tid;
    LAS float* IN = (LAS float*)C.lds;
    LAS float* PART = IN + 2 * 6 * 1024;
    LAS float* YP = PART + 2 * 8 * 64;
    const float* WD = ARP(float, A_WD); const bf16 *KKg = ARP(bf16, A_KK), *BV = ARP(bf16, A_BV), *KP = ARP(bf16, A_KP), *RR = ARP(bf16, A_RR), *VR = ARP(bf16, A_VR), *GG = ARP(bf16, A_GG);
    bf16* YCAT = ARP(bf16, A_YCAT);
    const float *r_k = A.in[I_RW_R_K], *ln_w = A.in[I_RW_LN_W], *ln_b = A.in[I_RW_LN_B];
    const int li = tid >> 5, lch = (tid & 31) * 2;
    const size_t gbase = ((size_t)b * SEQ) * 1024 + h * 64 + lch;
    f32x2 rw; unsigned rk, rb, rp, rr_, rv;
#define RW_LOAD(grp) do { const size_t o = gbase + (size_t)((grp) * 16 + li) * 1024; rw = *(const f32x2*)(WD + o); rk = *(const unsigned*)(KKg + o); rb = *(const unsigned*)(BV + o); \
        rp = *(const unsigned*)(KP + o); rr_ = *(const unsigned*)(RR + o); rv = *(const unsigned*)(VR + o); } while (0)
#define RW_STORE(buf) do { LAS float* d = IN + (buf) * 6144 + li * 64 + lch; *(LAS f32x2*)(d) = rw; *(LAS f32x2*)(d + 1024) = (f32x2){lo_bf(rk), hi_bf(rk)}; *(LAS f32x2*)(d + 2048) = (f32x2){lo_bf(rb), hi_bf(rb)}; \
        *(LAS f32x2*)(d + 3072) = (f32x2){lo_bf(rp), hi_bf(rp)}; *(LAS f32x2*)(d + 4096) = (f32x2){lo_bf(rr_), hi_bf(rr_)}; *(LAS f32x2*)(d + 5120) = (f32x2){lo_bf(rv), hi_bf(rv)}; } while (0)
    float st[8];
#pragma unroll
    for (int j = 0; j < 8; ++j) st[j] = 0.f;
    __syncthreads();
    RW_LOAD(0); RW_STORE(0); __syncthreads();
    for (int grp = 0; grp < SEQ / 16; ++grp) {
        const int buf = grp & 1; const LAS float* I0 = IN + buf * 6144;
        if (grp + 1 < SEQ / 16) RW_LOAD(grp + 1);
        for (int i = 0; i < 16; ++i) {
            const LAS float* q = I0 + i * 64 + 8 * w;
            const f32x4 w0 = *(const LAS f32x4*)(q), w1 = *(const LAS f32x4*)(q + 4), k0 = *(const LAS f32x4*)(q + 1024), k1 = *(const LAS f32x4*)(q + 1028);
            const f32x4 b0 = *(const LAS f32x4*)(q + 2048), b1 = *(const LAS f32x4*)(q + 2052), p0 = *(const LAS f32x4*)(q + 3072), p1 = *(const LAS f32x4*)(q + 3076);
            const f32x4 r0 = *(const LAS f32x4*)(q + 4096), r1 = *(const LAS f32x4*)(q + 4100); const float vv = I0[5120 + i * 64 + lane];
            float skp = 0.f;
#pragma unroll
            for (int j = 0; j < 4; ++j) skp += st[j] * k0[j] + st[4 + j] * k1[j];
            PART[(i & 1) * 512 + w * 64 + lane] = skp;
            LDS_WAIT(); __builtin_amdgcn_s_barrier(); asm volatile("" ::: "memory");
            float sk = 0.f;
#pragma unroll
            for (int ww = 0; ww < 8; ++ww) sk += PART[(i & 1) * 512 + ww * 64 + lane];
            float yp = 0.f;
#pragma unroll
            for (int j = 0; j < 4; ++j) { st[j] = st[j] * w0[j] - sk * b0[j] + vv * p0[j]; st[4 + j] = st[4 + j] * w1[j] - sk * b1[j] + vv * p1[j]; yp += st[j] * r0[j] + st[4 + j] * r1[j]; }
            YP[i * 512 + w * 64 + lane] = yp;
        }
        if (grp + 1 < SEQ / 16) RW_STORE(buf ^ 1);
        __syncthreads();
#pragma unroll
        for (int q = 0; q < 2; ++q) { const int i = 2 * w + q; float y = 0.f;
#pragma unroll
            for (int ww = 0; ww < 8; ++ww) y += YP[i * 512 + ww * 64 + lane];
            const float mean = wave_sum(y) * (1.f / 64.f), dv = y - mean, var = wave_sum(dv * dv) * (1.f / 64.f);
            const int ch = h * 64 + lane; const float yn = dv * rsqrtf(var + 64e-5f) * ln_w[ch] + ln_b[ch];
            const float bonus = wave_sum(I0[4096 + i * 64 + lane] * I0[3072 + i * 64 + lane] * r_k[ch]) * I0[5120 + i * 64 + lane];
            const size_t tt = (size_t)b * SEQ + grp * 16 + i;
            const float g = bf2f(GG[tt * 1024 + ch]);
            YCAT[tt * DM + 1024 + ch] = (bf16)f2bf((yn + bonus) * g); }
    }
#undef RW_LOAD
#undef RW_STORE
    __syncthreads();
}

__device__ __forceinline__ f32x4 lds_mma(const LAS bf16* Am, int lda, const LAS bf16* Bt, int ldb, int tm, int tn, int K, int lane, f32x4 acc) {
    const LAS bf16* ap = Am + (tm * 16 + (lane & 15)) * lda + (lane >> 4) * 8;
    const LAS bf16* bp = Bt + (tn * 16 + (lane & 15)) * ldb + (lane >> 4) * 8;
    for (int k = 0; k < K; k += 32) { const bf16x8 a = *(const LAS bf16x8*)(ap + k); const bf16x8 bb = *(const LAS bf16x8*)(bp + k);
        acc = __builtin_amdgcn_mfma_f32_16x16x32_bf16(bb, a, acc, 0, 0, 0); }
    return acc;
}

__device__ __forceinline__ void mlstm_unit(const Ctx& C, const Args& A, int unit) {
    const int bh = unit >> 3, dvs = unit & 7, b = bh >> 2, h = bh & 3, w = C.wave, lane = C.lane, tid = C.tid;
    LAS float* AA = (LAS float*)C.lds;
    LAS float* MX = AA + 4096;
    LAS bf16* Qs = (LAS bf16*)(MX + 4096);
    LAS bf16* Ks = Qs + 64 * 136;
    LAS bf16* KwT = Ks + 64 * 136;
    LAS bf16* Vt = KwT + 128 * 72;
    LAS bf16* Ps = Vt + 48 * 72;
    LAS bf16* CT = Ps + 64 * 72;
    LAS float* NUM = (LAS float*)(CT + 48 * 136);
    const float *IG = ARP(float, A_IG) + (size_t)bh * SEQ, *LFp = ARP(float, A_LF) + (size_t)bh * SEQ;
    const bf16 *QM = ARP(bf16, A_QM), *KM = ARP(bf16, A_KM), *PAB = ARP(bf16, A_PAB); bf16* YCAT = ARP(bf16, A_YCAT);
    __syncthreads();
    if (w == 0) { float carryF = 0.f, carryM = 0.f;
        for (int c = 0; c < 64; ++c) { const int p = c * 64 + lane; float f = LFp[p];
#pragma unroll
            for (int o = 1; o < 64; o <<= 1) { const float n = __shfl_up(f, o); if (lane >= o) f += n; }
            f += carryF; const float a = IG[p] - f; float m = a;
#pragma unroll
            for (int o = 1; o < 64; o <<= 1) { const float n = __shfl_up(m, o); if (lane >= o) m = fmaxf(m, n); }
            m = fmaxf(m, carryM); AA[p] = a; MX[p] = m; carryF = __shfl(f, 63); carryM = __shfl(m, 63); } }
    for (int i = tid; i < 48 * 72; i += NTHR) { const int r = i / 72; Vt[i] = (r == 32) ? (bf16)0x3f80 : (bf16)0; }
    for (int i = tid; i < 48 * 136; i += NTHR) CT[i] = 0;
    f32x4 accC[3];
#pragma unroll
    for (int k = 0; k < 3; ++k) accC[k] = (f32x4){0.f, 0.f, 0.f, 0.f};
    const size_t tok0 = (size_t)b * SEQ;
    u32x4 rq[2], rk[2], rv;
#define ML_LOAD(c) do { _Pragma("unroll") for (int k = 0; k < 2; ++k) { const int idx = tid + 512 * k, r = idx >> 4, c8 = (idx & 15) * 8; const size_t o = (tok0 + (c) * 64 + r) * 512 + h * 128 + c8; \
            rq[k] = *(const u32x4*)(QM + o); rk[k] = *(const u32x4*)(KM + o); } \
        if (tid < 256) rv = *(const u32x4*)(PAB + (tok0 + (c) * 64 + (tid >> 2)) * AB_PAD + 1024 + h * 256 + dvs * 32 + (tid & 3) * 8); } while (0)
    ML_LOAD(0);
    __syncthreads();
    const float scale = 0.08838834764831845f;
    for (int c = 0; c < 64; ++c) {
        const int t0 = c * 64; const float Mc = c ? MX[t0 - 1] : 0.f, Mc2 = MX[t0 + 63];
#pragma unroll
        for (int k = 0; k < 2; ++k) { const int idx = tid + 512 * k, r = idx >> 4, c8 = (idx & 15) * 8;
            *(LAS u32x4*)(Qs + r * 136 + c8) = rq[k]; *(LAS u32x4*)(Ks + r * 136 + c8) = rk[k];
            float kf[8]; unpack8(rk[k], kf); const float wk = __expf(AA[t0 + r] - Mc2);
#pragma unroll
            for (int j = 0; j < 8; ++j) KwT[(c8 + j) * 72 + r] = (bf16)f2bf(kf[j] * wk); }
        if (tid < 256) { const int r = tid >> 2, e8 = (tid & 3) * 8; const unsigned wv[4] = {rv.x, rv.y, rv.z, rv.w};
#pragma unroll
            for (int j = 0; j < 4; ++j) { Vt[(e8 + 2 * j) * 72 + r] = (bf16)(wv[j] & 0xffff); Vt[(e8 + 2 * j + 1) * 72 + r] = (bf16)(wv[j] >> 16); } }
        if (c + 1 < 64) ML_LOAD(c + 1);
        __syncthreads();
#pragma unroll
        for (int q = 0; q < 2; ++q) { const int tile = 2 * w + q, tm = tile >> 2, tn = tile & 3; const int t = tm * 16 + (lane & 15), l0 = tn * 16 + 4 * (lane >> 4);
            f32x4 s = (f32x4){0.f, 0.f, 0.f, 0.f};
            if (tn <= tm) s = lds_mma(Qs, 136, Ks, 136, tm, tn, 128, lane, s);
            const float mxt = MX[t0 + t]; float pvv[4];
#pragma unroll
            for (int j = 0; j < 4; ++j) { const int l = l0 + j; pvv[j] = (l <= t) ? s[j] * __expf(AA[t0 + l] - mxt) : 0.f; }
            u32x2 pw; pw.x = pk2(pvv[0], pvv[1]); pw.y = pk2(pvv[2], pvv[3]); *(LAS u32x2*)(Ps + t * 72 + l0) = pw; }
        __syncthreads();
        for (int tile = w; tile < 12; tile += 8) { const int tm = tile / 3, tn = tile % 3; const int t = tm * 16 + (lane & 15);
            f32x4 a1 = lds_mma(Ps, 72, Vt, 72, tm, tn, 64, lane, (f32x4){0.f, 0.f, 0.f, 0.f});
            f32x4 a2 = lds_mma(Qs, 136, CT, 136, tm, tn, 128, lane, (f32x4){0.f, 0.f, 0.f, 0.f});
            const float wst = __expf(Mc - MX[t0 + t]);
            *(LAS f32x4*)(NUM + t * 48 + tn * 16 + 4 * (lane >> 4)) = (a1 + a2 * wst) * scale; }
        __syncthreads();
        { const int t = tid >> 3, e4 = (tid & 7) * 4; const size_t tt = tok0 + t0 + t;
          const float den = NUM[t * 48 + 32], mrow = IG[t0 + t] - AA[t0 + t] + MX[t0 + t];
          const float inv = 1.f / fmaxf(fabsf(den), __expf(-mrow));
          const f32x4 nv = *(const LAS f32x4*)(NUM + t * 48 + e4);
          const u32x2 og = *(const u32x2*)(PAB + tt * AB_PAD + 2048 + h * 256 + dvs * 32 + e4);
          u32x2 o; o.x = pk2(sigmoidf_(lo_bf(og.x)) * nv[0] * inv, sigmoidf_(hi_bf(og.x)) * nv[1] * inv); o.y = pk2(sigmoidf_(lo_bf(og.y)) * nv[2] * inv, sigmoidf_(hi_bf(og.y)) * nv[3] * inv);
          *(u32x2*)(YCAT + tt * DM + h * 256 + dvs * 32 + e4) = o; }
        { const float decay = __expf(Mc - Mc2);
#pragma unroll
          for (int tm = 0; tm < 3; ++tm) { accC[tm] = lds_mma(Vt, 72, KwT, 72, tm, w, 64, lane, accC[tm] * decay);
              u32x2 cw; cw.x = pk2(accC[tm][0], accC[tm][1]); cw.y = pk2(accC[tm][2], accC[tm][3]);
              *(LAS u32x2*)(CT + (tm * 16 + (lane & 15)) * 136 + w * 16 + 4 * (lane >> 4)) = cw; } }
        __syncthreads();
    }
#undef ML_LOAD
}

__device__ __forceinline__ void phase_norm(const Ctx& C, const float* X, const float* gain, bf16* XNo) {
    for (int r = C.gw; r < T; r += C.ngw) rms_row_bf16(X + (size_t)r * DM, gain, XNo + (size_t)r * DM, C.lane);
}
__device__ __forceinline__ void phase_softmax256(const Ctx& C) {
    const float* SC = ARP(float, A_SC); bf16* PC = ARP(bf16, A_PC);
    for (int it = C.gw; it < T * 4; it += C.ngw) { const size_t o = (size_t)it * 256 + C.lane * 4;
        const f32x4 v = *(const f32x4*)(SC + o); const float m = wave_max(fmaxf(fmaxf(v.x, v.y), fmaxf(v.z, v.w)));
        const float e0 = __expf(v.x - m), e1 = __expf(v.y - m), e2 = __expf(v.z - m), e3 = __expf(v.w - m);
        const float inv = 1.f / wave_sum(e0 + e1 + e2 + e3);
        u32x2 w; w.x = pk2(e0 * inv, e1 * inv); w.y = pk2(e2 * inv, e3 * inv); *(u32x2*)(PC + o) = w; }
}
__device__ __forceinline__ void phase_route(const Ctx& C, const Args& A, int l) {
    const float* LG = ARP(float, A_LOGIT); int* EID = ARP(int, A_EID); float* WTS = ARP(float, A_WTS);
    unsigned* cnt = WSP(unsigned, WS_CTL) + CW_MOE_CNT + l * 64;
    const float *bg = A.in[I_MOE_BG] + l * 8, *be = A.in[I_MOE_BE] + l * 64;
    for (int t = C.bid * NTHR + C.tid; t < T; t += C.G * NTHR) { const float* L = LG + (size_t)t * 256;
        float lg[8], mx = -INFINITY; int grp = 0;
#pragma unroll
        for (int g = 0; g < 8; ++g) { lg[g] = L[g] + bg[g]; if (lg[g] > mx) { mx = lg[g]; grp = g; } }
        float se = 0.f;
#pragma unroll
        for (int g = 0; g < 8; ++g) se += __expf(lg[g] - mx);
        const float pgrp = 1.f / se;
        float l1 = -INFINITY, l2 = -INFINITY; int i1 = 0, i2 = 0;
        for (int j = 0; j < 8; ++j) { const float v = L[8 + grp * 8 + j] + be[grp * 8 + j];
            if (v > l1) { l2 = l1; i2 = i1; l1 = v; i1 = j; } else if (v > l2) { l2 = v; i2 = j; } }
        const float w1 = 1.f / (1.f + __expf(l2 - l1)), w2 = 1.f - w1;
        const int e1 = grp * 8 + i1, e2 = grp * 8 + i2;
        EID[2 * t] = e1; EID[2 * t + 1] = e2; WTS[2 * t] = pgrp * w1; WTS[2 * t + 1] = pgrp * w2;
        atomicAdd(cnt + e1, 1u); atomicAdd(cnt + e2, 1u); }
}
__device__ __forceinline__ void phase_gather(const Ctx& C, int l) {
    LAS int* tab = (LAS int*)(C.lds + LDS_AUX);
    moe_build_table(C, WSP(unsigned, WS_CTL) + CW_MOE_CNT + l * 64, tab);
    unsigned* cur = WSP(unsigned, WS_CTL) + CW_MOE_CUR + l * 64;
    const int* EID = ARP(int, A_EID); int* ROWSLOT = ARP(int, A_ROWSLOT); const bf16* XNp = WSP(bf16, WS_XN); bf16* XS = ARP(bf16, A_XS);
    for (int a = C.gw; a < 2 * T; a += C.ngw) { const int e = EID[a]; int pos = 0;
        if (C.lane == 0) { pos = tab[129 + e] + (int)atomicAdd(cur + e, 1u); ROWSLOT[pos] = a; }
        pos = __shfl(pos, 0);
        const u32x4* src = (const u32x4*)(XNp + (size_t)(a >> 1) * DM); u32x4* dst = (u32x4*)(XS + (size_t)pos * DM);
#pragma unroll
        for (int k = 0; k < 4; ++k) dst[k * 64 + C.lane] = src[k * 64 + C.lane]; }
}
__device__ __forceinline__ void phase_combine_norm(const Ctx& C, const float* gain, bf16* XNo, float* OUT) {
    float* XR = WSP(float, WS_XR); const bf16* YE = ARP(bf16, A_YE); const int lane = C.lane;
    for (int t = C.gw; t < T; t += C.ngw) { float* xr = XR + (size_t)t * DM; const bf16* y0 = YE + (size_t)(2 * t) * DM; const bf16* y1 = y0 + DM;
        f32x4 v[8]; float s = 0.f;
#pragma unroll
        for (int j = 0; j < 8; ++j) { const int o = (j * 64 + lane) * 4; v[j] = *(const f32x4*)(xr + o); const u32x2 a = *(const u32x2*)(y0 + o), bq = *(const u32x2*)(y1 + o);
            v[j].x += lo_bf(a.x) + lo_bf(bq.x); v[j].y += hi_bf(a.x) + hi_bf(bq.x); v[j].z += lo_bf(a.y) + lo_bf(bq.y); v[j].w += hi_bf(a.y) + hi_bf(bq.y);
            s += v[j].x * v[j].x + v[j].y * v[j].y + v[j].z * v[j].z + v[j].w * v[j].w; if (!OUT) *(f32x4*)(xr + o) = v[j]; }
        const float rstd = rsqrtf(wave_sum(s) * (1.f / DM) + EPS);
#pragma unroll
        for (int j = 0; j < 8; ++j) { const int o = (j * 64 + lane) * 4; const f32x4 g = *(const f32x4*)(gain + o);
            if (OUT) *(f32x4*)(OUT + (size_t)t * DM + o) = (f32x4){v[j].x * rstd * g.x, v[j].y * rstd * g.y, v[j].z * rstd * g.z, v[j].w * rstd * g.w};
            else { u32x2 w; w.x = pk2(v[j].x * rstd * g.x, v[j].y * rstd * g.y); w.y = pk2(v[j].z * rstd * g.z, v[j].w * rstd * g.w); *(u32x2*)(XNo + (size_t)t * DM + o) = w; } }
    }
}

__device__ __forceinline__ float gelu_tanh(float x) { return 0.5f * x * (1.f + tanhf(0.7978845608028654f * (x + 0.044715f * x * x * x))); }
__device__ __forceinline__ void phase_cmp_finish(const Ctx& C, const Args& A) {
    const float* CP = ARP(float, A_CPART); const float* bias = WSP(float, WS_TAB + TAB_CMPBIAS); const float* w2 = A.in[I_CMP_W2];
    LAS float* hid = (LAS float*)C.lds + C.wave * 128; const int lane = C.lane;
    for (int it = C.gw; it < 2 * 16 * 256; it += C.ngw) { const int j = it & 255, bg = (it >> 8) & 15, kv = it >> 12;
        bf16* dst = ARP(bf16, kv ? A_VCMP : A_KCMP) + ((size_t)bg * 256 + j) * 128;
        if (j == 255) { dst[lane] = 0; dst[lane + 64] = 0; continue; }
        float h0 = bias[kv * 128 + lane], h1 = bias[kv * 128 + 64 + lane];
#pragma unroll
        for (int ks = 0; ks < 8; ++ks) { const float* p = CP + ((size_t)((ks * 2 + kv) * 16 + bg) * 256 + j) * 256; h0 += p[lane]; h1 += p[64 + lane]; }
        hid[lane] = gelu_tanh(h0); hid[64 + lane] = gelu_tanh(h1); LDS_WAIT(); asm volatile("" ::: "memory");
        float o0 = 0.f, o1 = 0.f; const float* W = w2 + (size_t)kv * 128 * 128;
        for (int e = 0; e < 128; ++e) { const float hv = hid[e]; o0 += hv * W[e * 128 + lane]; o1 += hv * W[e * 128 + 64 + lane]; }
        dst[lane] = (bf16)f2bf(o0); dst[lane + 64] = (bf16)f2bf(o1); LDS_WAIT(); asm volatile("" ::: "memory"); }
}
__device__ __forceinline__ void phase_cmp_attn(const Ctx& C) {
    const bf16 *Q = ARP(bf16, A_Q), *KC = ARP(bf16, A_KCMP), *VC = ARP(bf16, A_VCMP); const float* GATES = ARP(float, A_GATES);
    float* OACC = ARP(float, A_OACC); unsigned long long* SELM = ARP(unsigned long long, A_SELMASK);
    LAS float* qs = (LAS float*)C.lds + C.wave * 1536;
    LAS float* ps = qs + 512; const int lane = C.lane; const float scale = 0.08838834764831845f;
    for (int it = C.gw; it < T * 4; it += C.ngw) { const int t = it >> 2, g = it & 3, b = t >> 12, s = t & 4095;
        const int nvalid = (s >= 31) ? ((s - 31) >> 4) + 1 : 0;
#pragma unroll
        for (int r = 0; r < 4; ++r) { const bf16* qp = Q + (((size_t)(b * 16 + g * 4 + r)) * SEQ + s) * 128; qs[r * 128 + lane] = bf2f(qp[lane]); qs[r * 128 + 64 + lane] = bf2f(qp[64 + lane]); }
        LDS_WAIT(); asm volatile("" ::: "memory");
        float sc[4][4];
#pragma unroll
        for (int i = 0; i < 4; ++i) { const int j = lane + 64 * i;
#pragma unroll
            for (int r = 0; r < 4; ++r) sc[r][i] = 0.f;
            if (j < nvalid) { const bf16* kp = KC + ((size_t)(b * 4 + g) * 256 + j) * 128;
                for (int d8 = 0; d8 < 16; ++d8) { float kf[8]; unpack8(*(const u32x4*)(kp + d8 * 8), kf);
#pragma unroll
                    for (int r = 0; r < 4; ++r) { float a = 0.f;
#pragma unroll
                        for (int jj = 0; jj < 8; ++jj) a += qs[r * 128 + d8 * 8 + jj] * kf[jj];
                        sc[r][i] += a; } } } }
#pragma unroll
        for (int r = 0; r < 4; ++r) { float m = -INFINITY;
#pragma unroll
            for (int i = 0; i < 4; ++i) if (lane + 64 * i < nvalid) m = fmaxf(m, sc[r][i] * scale);
            m = wave_max(m); if (!(m > -INFINITY)) m = 0.f; float e[4], sum = 0.f;
#pragma unroll
            for (int i = 0; i < 4; ++i) { e[i] = (lane + 64 * i < nvalid) ? __expf(sc[r][i] * scale - m) : 0.f; sum += e[i]; }
            sum = wave_sum(sum); const float inv = sum > 0.f ? 1.f / sum : 1.f;
#pragma unroll
            for (int i = 0; i < 4; ++i) ps[r * 256 + lane + 64 * i] = e[i] * inv; }
        LDS_WAIT(); asm volatile("" ::: "memory");
        float o[4][2];
#pragma unroll
        for (int r = 0; r < 4; ++r) { o[r][0] = 0.f; o[r][1] = 0.f; }
        for (int j = 0; j < nvalid; ++j) { const bf16* vp = VC + ((size_t)(b * 4 + g) * 256 + j) * 128; const float v0 = bf2f(vp[lane]), v1 = bf2f(vp[64 + lane]);
#pragma unroll
            for (int r = 0; r < 4; ++r) { const float p = ps[r * 256 + j]; o[r][0] += p * v0; o[r][1] += p * v1; } }
#pragma unroll
        for (int r = 0; r < 4; ++r) { const float gt = GATES[(size_t)t * 48 + g * 4 + r]; float* op = OACC + (size_t)t * DM + (g * 4 + r) * 128; op[lane] = gt * o[r][0]; op[64 + lane] = gt * o[r][1]; }
        float imp = 0.f;
#pragma unroll
        for (int r = 0; r < 4; ++r) { const LAS float* p = ps + r * 256; const int j0 = 4 * lane;
            imp += (j0 > 0 ? 0.5f * p[j0 - 1] : 0.f) + p[j0] + p[j0 + 1] + p[j0 + 2] + 0.5f * p[j0 + 3]; }
        const int cur = s >> 6; float score;
        if (lane == 0 || lane == cur || lane == cur - 1) score = INFINITY; else score = (lane <= cur) ? imp : -INFINITY;
        int rank = 0;
        for (int o2 = 0; o2 < 64; ++o2) { const float so = __shfl(score, o2); rank += (so > score || (so == score && o2 < lane)) ? 1 : 0; }
        const unsigned long long m = __ballot(rank < 16 && score > -INFINITY);
        if (lane == 0) SELM[(size_t)t * 4 + g] = m;
        LDS_WAIT(); asm volatile("" ::: "memory");
    }
}
struct NaiveAttnState { float m[4], l[4], o[4][2]; };
__device__ __forceinline__ void naive_tile(NaiveAttnState& S, const LAS float* qs, LAS float* pt, const bf16* Kt, const bf16* Vt_, int key0, bool valid, int lane) {
    float sc[4] = {0.f, 0.f, 0.f, 0.f}; const float scale = 0.08838834764831845f;
    if (valid) { const bf16* kp = Kt + (size_t)(key0 + lane) * 128;
        for (int d8 = 0; d8 < 16; ++d8) { float kf[8]; unpack8(*(const u32x4*)(kp + d8 * 8), kf);
#pragma unroll
            for (int r = 0; r < 4; ++r) { float a = 0.f;
#pragma unroll
                for (int jj = 0; jj < 8; ++jj) a += qs[r * 128 + d8 * 8 + jj] * kf[jj];
                sc[r] += a; } } }
    const unsigned long long vm = __ballot(valid);
    if (vm == 0ull) return;
#pragma unroll
    for (int r = 0; r < 4; ++r) { const float sv = valid ? sc[r] * scale : -INFINITY; const float mt = wave_max(sv), mn = fmaxf(S.m[r], mt);
        const float alpha = __expf(S.m[r] - mn), p = valid ? __expf(sv - mn) : 0.f;
        S.l[r] = S.l[r] * alpha + wave_sum(p); S.o[r][0] *= alpha; S.o[r][1] *= alpha; S.m[r] = mn; pt[r * 64 + lane] = p; }
    LDS_WAIT(); asm volatile("" ::: "memory");
    for (int k = 0; k < 64; ++k) { if (!((vm >> k) & 1ull)) continue; const bf16* vp = Vt_ + (size_t)(key0 + k) * 128; const float v0 = bf2f(vp[lane]), v1 = bf2f(vp[64 + lane]);
#pragma unroll
        for (int r = 0; r < 4; ++r) { const float p = pt[r * 64 + k]; S.o[r][0] += p * v0; S.o[r][1] += p * v1; } }
    LDS_WAIT(); asm volatile("" ::: "memory");
}
__device__ __forceinline__ void phase_selwin_naive(const Ctx& C) {
    const bf16* QR = ARP(bf16, A_QROT); const float* GATES = ARP(float, A_GATES); const float* OACC = ARP(float, A_OACC);
    const unsigned long long* SELM = ARP(const unsigned long long, A_SELMASK); bf16* OCAT = ARP(bf16, A_OCAT);
    const bf16* KS = (const bf16*)(C.ws + WS_ARENA + A_KV6 + 2 * KV6_STRIDE); const bf16* VS = (const bf16*)(C.ws + WS_ARENA + A_KV6 + 3 * KV6_STRIDE);
    const bf16* KW = (const bf16*)(C.ws + WS_ARENA + A_KV6 + 4 * KV6_STRIDE); const bf16* VW = (const bf16*)(C.ws + WS_ARENA + A_KV6 + 5 * KV6_STRIDE);
    LAS float* qs = (LAS float*)C.lds + C.wave * 768; LAS float* pt = qs + 512; const int lane = C.lane;
    for (int it = C.gw; it < T * 4; it += C.ngw) { const int t = it >> 2, g = it & 3, b = t >> 12, s = t & 4095; const size_t slab = (size_t)(b * 4 + g) * SPAD * 128;
#pragma unroll
        for (int r = 0; r < 4; ++r) { const bf16* qp = QR + (((size_t)(b * 16 + g * 4 + r)) * SEQ + s) * 128; qs[r * 128 + lane] = bf2f(qp[lane]); qs[r * 128 + 64 + lane] = bf2f(qp[64 + lane]); }
        LDS_WAIT(); asm volatile("" ::: "memory");
        float res[4][2];
#pragma unroll
        for (int r = 0; r < 4; ++r) { res[r][0] = OACC[(size_t)t * DM + (g * 4 + r) * 128 + lane]; res[r][1] = OACC[(size_t)t * DM + (g * 4 + r) * 128 + 64 + lane]; }
        { NaiveAttnState S;
#pragma unroll
          for (int r = 0; r < 4; ++r) { S.m[r] = -1e30f; S.l[r] = 0.f; S.o[r][0] = 0.f; S.o[r][1] = 0.f; }
          const unsigned long long m = SELM[(size_t)t * 4 + g];
          for (int blk = 0; blk <= (s >> 6); ++blk) if ((m >> blk) & 1ull) naive_tile(S, qs, pt, KS + slab, VS + slab, blk * 64, blk * 64 + lane <= s, lane);
#pragma unroll
          for (int r = 0; r < 4; ++r) { const float gt = GATES[(size_t)t * 48 + 16 + g * 4 + r], inv = S.l[r] > 0.f ? 1.f / S.l[r] : 0.f; res[r][0] += gt * S.o[r][0] * inv; res[r][1] += gt * S.o[r][1] * inv; } }
        { NaiveAttnState S;
#pragma unroll
          for (int r = 0; r < 4; ++r) { S.m[r] = -1e30f; S.l[r] = 0.f; S.o[r][0] = 0.f; S.o[r][1] = 0.f; }
          const int lo = s - 511 > 0 ? s - 511 : 0;
          for (int k0 = lo & ~63; k0 <= s; k0 += 64) naive_tile(S, qs, pt, KW + slab, VW + slab, k0, (k0 + lane >= lo) && (k0 + lane <= s), lane);
#pragma unroll
          for (int r = 0; r < 4; ++r) { const float gt = GATES[(size_t)t * 48 + 32 + g * 4 + r], inv = S.l[r] > 0.f ? 1.f / S.l[r] : 0.f; res[r][0] += gt * S.o[r][0] * inv; res[r][1] += gt * S.o[r][1] * inv; } }
#pragma unroll
        for (int r = 0; r < 4; ++r) { bf16* op = OCAT + (size_t)t * DM + (g * 4 + r) * 128; op[lane] = (bf16)f2bf(res[r][0]); op[64 + lane] = (bf16)f2bf(res[r][1]); }
    }
}

#ifndef MK_SPLIT
#define MK_SPLIT 0
#endif
constexpr int N_PHASES = 36;
#define COMMON_PHASES(l, pb) \
      \
    if (IN(pb + 0)) { phase_norm(C, WSP(float, WS_XR), A.in[I_NORM_CROSS] + l * DM, WSP(bf16, WS_XN)); } SEAM(pb + 0); \
    if (IN(pb + 1)) { pg8::Gemm g{WSP(bf16, WS_XN), WSP(bf16, WS_WKT) + (size_t)l * 4 * 1024 * DM, DM, DM, DM}; \
                      CrossOrder S{4, G, c, 1024, (long long)256 * DM * 2, (long long)256 * DM * 2, (long long)1024 * DM * 2}; EpiStoreF32 E{ARP(float, A_SC), 1024}; pg8::gemm_phase(L, g, S, E); } SEAM(pb + 1); \
    if (IN(pb + 2)) { phase_softmax256(C); } SEAM(pb + 2); \
    if (IN(pb + 3)) { pg8::Gemm g{ARP(bf16, A_PC), WSP(bf16, WS_VWT) + (size_t)l * 4 * DM * 1024, 1024, 1024, 1024}; \
                      CrossOrder S{8, G, c, DM, (long long)256 * 1024 * 2, (long long)256 * 1024 * 2, (long long)DM * 1024 * 2}; EpiResid E{WSP(float, WS_XR), WSP(float, WS_XR), DM}; pg8::gemm_phase(L, g, S, E); } SEAM(pb + 3); \
      \
    if (IN(pb + 4)) { phase_norm(C, WSP(float, WS_XR), A.in[I_NORM_FFN] + l * DM, WSP(bf16, WS_XN)); } SEAM(pb + 4); \
    if (IN(pb + 5)) { pg8::Gemm g{WSP(bf16, WS_XN), WSP(bf16, WS_W_ROUTER) + (size_t)l * 256 * DM, DM, DM, DM}; pg8::DenseOrder S; S.init(T, 256, DM, DM, 256, G, c); EpiStoreF32 E{ARP(float, A_LOGIT), 256}; pg8::gemm_phase(L, g, S, E); } SEAM(pb + 5); \
    if (IN(pb + 6)) { phase_route(C, A, l); } SEAM(pb + 6); \
    if (IN(pb + 7)) { phase_gather(C, l); } SEAM(pb + 7); \
    if (IN(pb + 8)) { LAS int* tab = (LAS int*)(C.lds + LDS_AUX); moe_build_table(C, ctl + CW_MOE_CNT + l * 64, tab); \
                      pg8::Gemm g{ARP(bf16, A_XS), WSP(bf16, WS_W_GU) + (size_t)l * NEXP * 1024 * DM, DM, DM, DM}; MoeOrder S{tab, 4, G, c, 0}; EpiHid E{ARP(bf16, A_HID)}; pg8::gemm_phase(L, g, S, E); } SEAM(pb + 8); \
    if (IN(pb + 9)) { LAS int* tab = (LAS int*)(C.lds + LDS_AUX); moe_build_table(C, ctl + CW_MOE_CNT + l * 64, tab); \
                      pg8::Gemm g{ARP(bf16, A_HID), WSP(bf16, WS_W_DN) + (size_t)l * NEXP * DM * FF, FF, FF, FF}; MoeOrder S{tab, 8, G, c, 1}; EpiMoeDown E{ARP(int, A_ROWSLOT), ARP(float, A_WTS), ARP(bf16, A_YE)}; pg8::gemm_phase(L, g, S, E); } SEAM(pb + 9); \
    if (IN(pb + 10)) { if (l == 0) phase_combine_norm(C, A.in[I_NORM_MIX] + DM, WSP(bf16, WS_XN), nullptr); else phase_combine_norm(C, A.in[I_NORM_FINAL], nullptr, A.out); } \
    if (l == 0) SEAM(pb + 10);

__global__ void __launch_bounds__(NTHR, 2) mk_fwd(Args args) {
    extern __shared__ __attribute__((aligned(16))) unsigned char lds_raw[];
    Ctx C; C.lds = (LAS unsigned char*)lds_raw; C.tid = threadIdx.x; C.lane = C.tid & 63; C.wave = __builtin_amdgcn_readfirstlane(C.tid >> 6);
    C.G = gridDim.x; C.bid = blockIdx.x; C.gw = C.bid * NWAVES + C.wave; C.ngw = C.G * NWAVES; C.ws = args.ws;
    const Args& A = args;
    volatile LAS unsigned* MISC = (volatile LAS unsigned*)(C.lds + LDS_MISC);
    if (C.tid < 64) MISC[C.tid] = 0u;
    __syncthreads();
    unsigned* ctl = WSP(unsigned, WS_CTL);
    const int lo = args.ph_lo, hi = args.ph_hi;
    XcdBarrier bar; bar.bar = ctl + CW_BAR; bar.x = 0; bar.st = MISC + 8;
    if (hi - lo > 1) bar = xcd_barrier_post(ctl + CW_BAR, MISC + 8);
#ifndef ONLY_PHASE
#define ONLY_PHASE -1
#endif
#define IN(k) ((ONLY_PHASE < 0 || ONLY_PHASE == (k)) && lo <= (k) && (k) < hi)
#define SEAM(k) do { if (IN(k) && IN((k) + 1)) xcd_barrier(bar); } while (0)
    LAS unsigned char* L = C.lds;
    const int c = C.bid, G = C.G;

    if (IN(0)) { phase_prologue(C, A); } SEAM(0);
    if (IN(1)) { pg8::Gemm g{WSP(bf16, WS_MEMN), WSP(bf16, WS_W_CAK), DM, DM, DM}; MemProjOrder S{G, c}; EpiStoreBf16 E{WSP(bf16, WS_KP), DM, 1.f}; pg8::gemm_phase(L, g, S, E); } SEAM(1);
    if (IN(2)) {
        { pg8::Gemm g{WSP(bf16, WS_KP), WSP(bf16, WS_W_CAQ), DM, DM, 512}; WktOrder S{G, c}; EpiStoreBf16 E{WSP(bf16, WS_WKT), DM, 0.04419417382415922f}; pg8::gemm_phase(L, g, S, E); }
        { pg8::Gemm g{WSP(bf16, WS_W_CAO), WSP(bf16, WS_VP), DM, DM, 512}; VwtOrder S{G, c}; EpiStoreBf16 E{WSP(bf16, WS_VWT), 1024, 1.f}; pg8::gemm_phase(L, g, S, E); }
    } SEAM(2);
    if (IN(3)) { pg8::Gemm g{WSP(bf16, WS_XN), WSP(bf16, WS_W_ABIN), DM, DM, DM}; pg8::DenseOrder S; S.init(T, AB_PAD, DM, DM, AB_PAD, G, c); EpiAbIn E{ARP(bf16, A_PAB), ARP(float, A_GF32)}; pg8::gemm_phase(L, g, S, E); } SEAM(3);
    if (IN(4)) { phase_mixer_prep(C, A); } SEAM(4);
    if (IN(5)) { pg8::Gemm g{ARP(bf16, A_LIN), WSP(bf16, WS_W_LORA), 256, 256, 256}; pg8::DenseOrder S; S.init(T, 3072, 256, 256, 3072, G, c);
                 EpiLora E{A.in[I_RW_W0], A.in[I_RW_A0], A.in[I_RW_K_A], ARP(bf16, A_KK), ARP(bf16, A_KR), ARP(float, A_WD), ARP(bf16, A_BV), ARP(bf16, A_KP), ARP(bf16, A_GG)}; pg8::gemm_phase(L, g, S, E); } SEAM(5);
    if (IN(6)) { for (int it = C.bid; it < 192; it += G) { if (it < 64) rwkv_scan_unit(C, A, it); else mlstm_unit(C, A, it - 64); } } SEAM(6);
    if (IN(7)) { pg8::Gemm g{ARP(bf16, A_YCAT), WSP(bf16, WS_W_ABOUT), DM, DM, DM}; pg8::DenseOrder S; S.init(T, DM, DM, DM, DM, G, c); EpiResid E{A.in[I_X], WSP(float, WS_XR), DM}; pg8::gemm_phase(L, g, S, E); } SEAM(7);
    COMMON_PHASES(0, 8)
    if (IN(19)) { pg8::Gemm g{WSP(bf16, WS_XN), WSP(bf16, WS_W_NSAIN), DM, DM, DM}; pg8::DenseOrder S; S.init(T, NSA_PAD, DM, DM, NSA_PAD, G, c);
                  EpiNsaIn E{ARP(bf16, A_Q), ARP(bf16, A_QROT), ARP(bf16, A_KV6), ARP(float, A_GATES), A.in[I_NSA_GATE_B], WSP(float, WS_TAB + TAB_ROPE_COS), WSP(float, WS_TAB + TAB_ROPE_SIN)}; pg8::gemm_phase(L, g, S, E); } SEAM(19);
    if (IN(20)) { pg8::Gemm g{ARP(bf16, A_KV6), WSP(bf16, WS_W_CMP1), 2048, 4096, 512}; CmpOrder S{G, c}; EpiStoreF32 E{ARP(float, A_CPART), 256}; pg8::gemm_phase(L, g, S, E); } SEAM(20);
    if (IN(21)) { phase_cmp_finish(C, A); } SEAM(21);
    if (IN(22)) { phase_cmp_attn(C); } SEAM(22);
    if (IN(23)) { phase_selwin_naive(C); } SEAM(23);
    if (IN(24)) { pg8::Gemm g{ARP(bf16, A_OCAT), WSP(bf16, WS_W_NSAOUT), DM, DM, DM}; pg8::DenseOrder S; S.init(T, DM, DM, DM, DM, G, c); EpiResid E{WSP(float, WS_XR), WSP(float, WS_XR), DM}; pg8::gemm_phase(L, g, S, E); } SEAM(24);
    COMMON_PHASES(1, 25)
#undef IN
#undef SEAM
}

extern "C" void kernel_launch(void* const* d_in, const int* in_sizes, int n_in, void* d_out, int out_size, void* d_ws, size_t ws_size, hipStream_t stream) {
    static int grid = 0;
    if (grid == 0) {
        if (n_in != N_INPUTS || out_size != T * DM || ws_size < WS_END) { fprintf(stderr, "kernel_launch: unexpected shapes (n_in %d, out %d, ws %zu, need %zu)\n", n_in, out_size, ws_size, (size_t)WS_END); grid = -1; return; }
        int dev = 0, cus = 0, per_cu = 0;
        if (hipGetDevice(&dev) != hipSuccess || hipDeviceGetAttribute(&cus, hipDeviceAttributeMultiprocessorCount, dev) != hipSuccess) { grid = -1; return; }
        if (hipFuncSetAttribute((const void*)mk_fwd, hipFuncAttributeMaxDynamicSharedMemorySize, LDS_BYTES) != hipSuccess) { fprintf(stderr, "kernel_launch: hipFuncSetAttribute failed\n"); grid = -1; return; }
        if (hipOccupancyMaxActiveBlocksPerMultiprocessor(&per_cu, (const void*)mk_fwd, NTHR, LDS_BYTES) != hipSuccess || per_cu < 1) fprintf(stderr, "kernel_launch: occupancy query says %d\n", per_cu);
        (void)hipGetLastError();
        grid = cus;
    }
    if (grid < 0) return;
    (void)hipMemsetAsync((char*)d_ws + WS_CTL, 0, CTL_BYTES, stream);
    Args a{};
    for (int i = 0; i < N_INPUTS; ++i) a.in[i] = (const float*)d_in[i];
    a.out = (float*)d_out; a.ws = (unsigned char*)d_ws;
#if MK_SPLIT
    for (int p = 0; p < N_PHASES; ++p) { a.ph_lo = p; a.ph_hi = p + 1; hipLaunchKernelGGL(mk_fwd, dim3(grid), dim3(NTHR), LDS_BYTES, stream, a); }
#else
    a.ph_lo = 0; a.ph_hi = N_PHASES; hipLaunchKernelGGL(mk_fwd, dim3(grid), dim3(NTHR), LDS_BYTES, stream, a);
#endif
}
```

```cpp
#include <hip/hip_runtime.h>
#include <cstdio>
#include <cstdint>

#define LAS __attribute__((address_space(3)))
#define GAS __attribute__((address_space(1)))
typedef unsigned short bf16;
typedef short bf16x8 __attribute__((ext_vector_type(8)));
typedef float f32x4 __attribute__((ext_vector_type(4)));
typedef float f32x2 __attribute__((ext_vector_type(2)));
typedef unsigned u32x4 __attribute__((ext_vector_type(4)));
typedef unsigned u32x2 __attribute__((ext_vector_type(2)));

constexpr int BATCH = 4, SEQ = 4096, DM = 2048, T = BATCH * SEQ, MEMT = 256, MT = BATCH * MEMT;
constexpr float EPS = 1e-6f;
constexpr int ML_COLS = 3080, RW_COLS = 3328, AB_COLS = 6408, AB_PAD = 6656;
constexpr int NSA_COLS = 5168, NSA_PAD = 5376;
constexpr int NEXP = 64, FF = 512;
constexpr int XS_ROWS = 49152;
constexpr int SPAD = SEQ + 64;

enum { I_X = 0, I_MEM, I_NORM_MIX, I_NORM_CROSS, I_NORM_MEM, I_NORM_FFN, I_NORM_FINAL, I_AB_W_IN, I_ML_CONV_W, I_ML_CONV_B, I_ML_GATE_B,
       I_RW_MU, I_RW_W0, I_RW_W_UP, I_RW_A0, I_RW_A_UP, I_RW_G_UP, I_RW_K_K, I_RW_K_A, I_RW_R_K, I_RW_LN_W, I_RW_LN_B, I_AB_W_OUT,
       I_NSA_W_IN, I_NSA_GATE_B, I_CMP_POS, I_CMP_W1, I_CMP_W2, I_NSA_W_OUT, I_CA_WQ, I_CA_WK, I_CA_WV, I_CA_WO,
       I_MOE_WG, I_MOE_BG, I_MOE_WE, I_MOE_BE, I_MOE_W_GATE, I_MOE_W_UP, I_MOE_W_DOWN, N_INPUTS };

constexpr size_t MiB = (size_t)1 << 20;
constexpr size_t WS_CTL = 0, CTL_BYTES = 1 * MiB;
constexpr size_t WS_TAB = 1 * MiB;
constexpr size_t WS_W_ABIN = 3 * MiB;
constexpr size_t WS_W_ABOUT = WS_W_ABIN + 26 * MiB;
constexpr size_t WS_W_LORA = WS_W_ABOUT + 8 * MiB;
constexpr size_t WS_W_NSAIN = WS_W_LORA + 2 * MiB;
constexpr size_t WS_W_NSAOUT = WS_W_NSAIN + 21 * MiB;
constexpr size_t WS_W_CMP1 = WS_W_NSAOUT + 8 * MiB;
constexpr size_t WS_W_CAQ = WS_W_CMP1 + 4 * MiB;
constexpr size_t WS_W_CAK = WS_W_CAQ + 16 * MiB;
constexpr size_t WS_W_CAV = WS_W_CAK + 16 * MiB;
constexpr size_t WS_W_CAO = WS_W_CAV + 16 * MiB;
constexpr size_t WS_W_ROUTER = WS_W_CAO + 16 * MiB;
constexpr size_t WS_W_GU = WS_W_ROUTER + 2 * MiB;
constexpr size_t WS_W_DN = WS_W_GU + 512 * MiB;
constexpr size_t WS_MEMN = WS_W_DN + 256 * MiB;
constexpr size_t WS_KP = WS_MEMN + 8 * MiB;
constexpr size_t WS_VP = WS_KP + 8 * MiB;
constexpr size_t WS_WKT = WS_VP + 8 * MiB;
constexpr size_t WS_VWT = WS_WKT + 32 * MiB;
constexpr size_t WS_XR = WS_VWT + 32 * MiB;
constexpr size_t WS_XN = WS_XR + 128 * MiB;
constexpr size_t WS_ARENA = WS_XN + 64 * MiB;
constexpr size_t A_PAB = 0;
constexpr size_t A_GF32 = A_PAB + 208 * MiB;
constexpr size_t A_QM = A_GF32 + 16 * MiB;
constexpr size_t A_KM = A_QM + 16 * MiB;
constexpr size_t A_IG = A_KM + 16 * MiB;
constexpr size_t A_LF = A_IG + 1 * MiB;
constexpr size_t A_RR = A_LF + 1 * MiB;
constexpr size_t A_KR = A_RR + 32 * MiB;
constexpr size_t A_VR = A_KR + 32 * MiB;
constexpr size_t A_KK = A_VR + 32 * MiB;
constexpr size_t A_LIN = A_KK + 32 * MiB;
constexpr size_t A_WD = A_LIN + 8 * MiB;
constexpr size_t A_BV = A_WD + 64 * MiB;
constexpr size_t A_KP = A_BV + 32 * MiB;
constexpr size_t A_GG = A_KP + 32 * MiB;
constexpr size_t A_YCAT = A_GG + 32 * MiB;
constexpr size_t A_END0 = A_YCAT + 64 * MiB;
constexpr size_t A_SC = 0;
constexpr size_t A_PC = A_SC + 64 * MiB;
constexpr size_t A_LOGIT = 0;
constexpr size_t A_EID = A_LOGIT + 16 * MiB;
constexpr size_t A_WTS = A_EID + 1 * MiB;
constexpr size_t A_ROWSLOT = A_WTS + 1 * MiB;
constexpr size_t A_XS = A_ROWSLOT + 1 * MiB;
constexpr size_t A_HID = A_XS + 192 * MiB;
constexpr size_t A_YE = A_HID + 48 * MiB;
constexpr size_t A_END2 = A_YE + 128 * MiB;
constexpr size_t A_Q = 0;
constexpr size_t A_QROT = A_Q + 64 * MiB;
constexpr size_t A_KV6 = A_QROT + 64 * MiB;
constexpr size_t KV6_STRIDE = 17 * MiB;
constexpr size_t A_GATES = A_KV6 + 6 * KV6_STRIDE;
constexpr size_t A_CPART = A_GATES + 4 * MiB;
constexpr size_t A_KCMP = A_CPART + 64 * MiB;
constexpr size_t A_VCMP = A_KCMP + 1 * MiB;
constexpr size_t A_SELMASK = A_VCMP + 1 * MiB;
constexpr size_t A_OACC = A_SELMASK + 1 * MiB;
constexpr size_t A_OCAT = A_OACC + 128 * MiB;
constexpr size_t A_OCATREF = A_OCAT + 64 * MiB;
constexpr size_t A_END3 = A_OCATREF + 64 * MiB;
constexpr size_t ARENA_BYTES = 640 * MiB;
static_assert(A_END0 <= ARENA_BYTES && A_END2 <= ARENA_BYTES && A_END3 <= ARENA_BYTES, "arena");
constexpr size_t WS_END = WS_ARENA + ARENA_BYTES;
static_assert(WS_END <= (size_t)2048 * MiB, "workspace");
constexpr size_t TAB_ROPE_COS = 0, TAB_ROPE_SIN = 256 * 1024, TAB_CMPBIAS = 512 * 1024;
constexpr int CW_BAR = 4096;
constexpr int CW_MOE_CNT = 16384;
constexpr int CW_MOE_CUR = 16384 + 256;
constexpr int CW_PROBE = 32768;

__device__ __forceinline__ float bf2f(bf16 v) { return __uint_as_float((unsigned)v << 16); }
__device__ __forceinline__ unsigned f2bf(float f) { unsigned u = __float_as_uint(f); return (u + 0x7fffu + ((u >> 16) & 1u)) >> 16; }
__device__ __forceinline__ unsigned pk2(float lo, float hi) { return f2bf(lo) | (f2bf(hi) << 16); }
__device__ __forceinline__ float lo_bf(unsigned w) { return __uint_as_float(w << 16); }
__device__ __forceinline__ float hi_bf(unsigned w) { return __uint_as_float(w & 0xffff0000u); }
__device__ __forceinline__ float sigmoidf_(float x) { return 1.f / (1.f + __expf(-x)); }
__device__ __forceinline__ float siluf_(float x) { return x / (1.f + __expf(-x)); }
__device__ __forceinline__ float wave_sum(float v) {
#pragma unroll
    for (int o = 1; o < 64; o <<= 1) v += __shfl_xor(v, o);
    return v;
}
__device__ __forceinline__ float wave_max(float v) {
#pragma unroll
    for (int o = 1; o < 64; o <<= 1) v = fmaxf(v, __shfl_xor(v, o));
    return v;
}
__device__ __forceinline__ void unpack8(u32x4 w, float* f) {
    f[0] = lo_bf(w.x); f[1] = hi_bf(w.x); f[2] = lo_bf(w.y); f[3] = hi_bf(w.y); f[4] = lo_bf(w.z); f[5] = hi_bf(w.z); f[6] = lo_bf(w.w); f[7] = hi_bf(w.w);
}
__device__ __forceinline__ u32x4 pack8f(const float* f) { u32x4 w; w.x = pk2(f[0], f[1]); w.y = pk2(f[2], f[3]); w.z = pk2(f[4], f[5]); w.w = pk2(f[6], f[7]); return w; }

namespace pg8 {
constexpr int BM = 256, BK = 64, HALF = 128, HTB = HALF * BK * 2, STAGE_BYTES = 8 * HTB, NXCD = 8, WGM = 8;
__host__ __device__ __forceinline__ int lds_byte(int r, int c) { const int st = (r >> 4) * 2 + (c >> 5), rr = r & 15, cc = c & 31, ob = rr * 64 + cc * 2; return st * 1024 + (ob ^ (((ob >> 9) & 1) << 5)); }
__host__ __device__ __forceinline__ void stage_rc(int b, int& R, int& C) { const int st = b / 1024, sb = b % 1024, swz = sb ^ (((sb >> 9) & 1) << 5); R = (st >> 1) * 16 + swz / 64; C = (st & 1) * 32 + (swz % 64) / 2; }
__host__ __device__ __forceinline__ int perm32(int rho) { const int n = rho >> 4, i = rho & 15; return 8 * (i >> 2) + 4 * n + (i & 3); }

struct Unit { long long aoff, boff, coff; int pm, pn, aux; };
struct Gemm { const bf16* A; const bf16* Bt; int lda, ldb, K; };

__device__ __forceinline__ bool tile_of(long L, int nM, int nN, int& pm, int& pn) {
    const int nwg = nM * nN; if (L >= nwg) return false;
    int wgid = (int)L; { const int q = nwg / NXCD, r = nwg % NXCD, xcd = wgid % NXCD, off = wgid / NXCD; wgid = (xcd < r ? xcd * (q + 1) : r * (q + 1) + (xcd - r) * q) + off; }
    const int nig = WGM * nN, gid = wgid / nig, fm = gid * WGM, gsz = (nM - fm) < WGM ? (nM - fm) : WGM;
    pm = fm + ((wgid % nig) % gsz); pn = (wgid % nig) / gsz; return true;
}
struct DenseOrder {
    int nM, nN, G, c, ldc; long long astep, bstep;
    __device__ void init(int M, int N, int lda, int ldb, int ldc_, int G_, int c_) { nM = M / BM; nN = N / BM; G = G_; c = c_; ldc = ldc_; astep = (long long)BM * lda * 2; bstep = (long long)BM * ldb * 2; }
    __device__ __forceinline__ bool next(int i, Unit& u) const {
        int pm, pn; if (!tile_of((long)i * G + c, nM, nN, pm, pn)) return false;
        u.pm = pm; u.pn = pn; u.aux = 0; u.aoff = pm * astep; u.boff = pn * bstep; u.coff = (long long)pm * BM * ldc + pn * BM; return true;
    }
};

__device__ __forceinline__ unsigned cvt_pk_bf16(float lo, float hi) { unsigned r; asm volatile("v_cvt_pk_bf16_f32 %0, %1, %2" : "=v"(r) : "v"(lo), "v"(hi)); return r; }

template <class Epi, class Sched>
__device__ __forceinline__ void gemm_phase(LAS unsigned char* lds, const Gemm g, const Sched& S, const Epi& E, int tid_) {
    __builtin_assume(tid_ >= 0 && tid_ < 512); const int tid = tid_, wid = __builtin_amdgcn_readfirstlane(tid >> 6), lane = tid & 63, wr = wid >> 2, wc = wid & 3, fr = lane & 15, fq = lane >> 4;
    const int nt = g.K / BK;
    unsigned voffA[2], voffB[2];
#pragma unroll
    for (int i = 0; i < 2; ++i) { int R, C; stage_rc(tid * 16 + i * 8192, R, C); const int Rb = (R & ~31) + perm32(R & 31);
        voffA[i] = (unsigned)(R * g.lda + C) * 2u; voffB[i] = (unsigned)(Rb * g.ldb + C) * 2u; }
    const size_t kstep = (size_t)(BK * 2);
    const size_t hstepA = (size_t)HALF * g.lda * 2, hstepB = (size_t)HALF * g.ldb * 2;
    const unsigned ldsw = (unsigned)wid * 1024u;
    const int aoff = lds_byte(wr * 64 + fr, fq * 8), boff = lds_byte(wc * 32 + fr, fq * 8);
#define PG8_SA(b, h) (((b) * 2 + (h)) * HTB)
#define PG8_SB(b, h) ((4 + (b) * 2 + (h)) * HTB)
#define PG8_STAGE(bufoff, gbase, voff) do { _Pragma("unroll") for (int _i = 0; _i < 2; ++_i) \
        __builtin_amdgcn_global_load_lds((const unsigned*)((const char*)(gbase) + (voff)[_i]), (LAS unsigned*)(lds + (bufoff) + ldsw + _i * 8192), 16, 0, 0); } while (0)
#define PG8_LDA(dst, b, h) do { _Pragma("unroll") for (int m = 0; m < 4; ++m) _Pragma("unroll") for (int k = 0; k < 2; ++k) dst[m][k] = *(const LAS bf16x8*)(lds + PG8_SA(b, h) + aoff + m * 2048 + k * 1024); } while (0)
#define PG8_LDB(dst, b, h) do { _Pragma("unroll") for (int n = 0; n < 2; ++n) _Pragma("unroll") for (int k = 0; k < 2; ++k) dst[n][k] = *(const LAS bf16x8*)(lds + PG8_SB(b, h) + boff + n * 2048 + k * 1024); } while (0)
#define PG8_MMA(ai, bj, At, Bt) do { __builtin_amdgcn_s_setprio(1); _Pragma("unroll") for (int m = 0; m < 4; ++m) _Pragma("unroll") for (int n = 0; n < 2; ++n) _Pragma("unroll") for (int k = 0; k < 2; ++k) \
        acc[ai][bj][m][n] = __builtin_amdgcn_mfma_f32_16x16x32_bf16(Bt[n][k], At[m][k], acc[ai][bj][m][n], 0, 0, 0); __builtin_amdgcn_s_setprio(0); } while (0)
#define PG8_WAIT_V(n) asm volatile("s_waitcnt vmcnt(" #n ")" ::: "memory")
#define PG8_WAIT_L(n) asm volatile("s_waitcnt lgkmcnt(" #n ")" ::: "memory")
#define PG8_BAR __builtin_amdgcn_s_barrier()
#define PG8_SCHED __builtin_amdgcn_sched_barrier(0)
    Unit cur, nxt; int ui = 0;
    if (!S.next(0, cur)) return;
    f32x4 acc[2][2][4][2];
#pragma unroll
    for (int a = 0; a < 2; ++a)
#pragma unroll
        for (int b = 0; b < 2; ++b)
#pragma unroll
            for (int m = 0; m < 4; ++m)
#pragma unroll
                for (int n = 0; n < 2; ++n) acc[a][b][m][n] = (f32x4){0.f, 0.f, 0.f, 0.f};
    bf16x8 At[4][2], B0[2][2], B1[2][2];
    const char* cA = (const char*)g.A + cur.aoff; const char* cB = (const char*)g.Bt + cur.boff;
    PG8_STAGE(PG8_SB(0, 0), cB, voffB); PG8_STAGE(PG8_SB(0, 1), cB + hstepB, voffB); PG8_STAGE(PG8_SA(0, 0), cA, voffA); PG8_STAGE(PG8_SA(0, 1), cA + hstepA, voffA);
    if (wr == 1) PG8_BAR;
    PG8_WAIT_V(2); PG8_BAR;
    PG8_STAGE(PG8_SB(1, 0), cB + kstep, voffB); PG8_STAGE(PG8_SA(1, 0), cA + kstep, voffA); PG8_STAGE(PG8_SB(1, 1), cB + hstepB + kstep, voffB);
    PG8_WAIT_V(6); PG8_BAR;
    for (;;) {
        const bool has_next = S.next(ui + 1, nxt);
        const char* nA = has_next ? (const char*)g.A + nxt.aoff : cA; const char* nB = has_next ? (const char*)g.Bt + nxt.boff : cB;
        for (int t = 0; t < nt; t += 2) {
            const bool last = (t == nt - 2);
            const char* a1 = cA + (size_t)(t + 1) * kstep;
            const char* a2 = last ? nA : cA + (size_t)(t + 2) * kstep; const char* b2 = last ? nB : cB + (size_t)(t + 2) * kstep;
            const char* a3 = a2 + kstep; const char* b3 = b2 + kstep;
            PG8_LDB(B0, 0, 0); PG8_LDB(B1, 0, 1); PG8_SCHED; PG8_LDA(At, 0, 0); PG8_STAGE(PG8_SA(1, 1), a1 + hstepA, voffA);
            PG8_WAIT_V(8); PG8_WAIT_L(0); PG8_BAR; PG8_MMA(0, 0, At, B0); PG8_MMA(0, 1, At, B1); PG8_BAR; PG8_SCHED;
            PG8_LDA(At, 0, 1); PG8_STAGE(PG8_SB(0, 0), b2, voffB); PG8_STAGE(PG8_SB(0, 1), b2 + hstepB, voffB); PG8_STAGE(PG8_SA(0, 0), a2, voffA);
            PG8_WAIT_V(8); PG8_WAIT_L(0); PG8_BAR; PG8_MMA(1, 0, At, B0); PG8_MMA(1, 1, At, B1); PG8_BAR; PG8_SCHED;
            PG8_LDB(B0, 1, 0); PG8_LDB(B1, 1, 1); PG8_SCHED; PG8_LDA(At, 1, 0); PG8_STAGE(PG8_SA(0, 1), a2 + hstepA, voffA);
            PG8_WAIT_V(8); PG8_WAIT_L(0); PG8_BAR; PG8_MMA(0, 0, At, B0); PG8_MMA(0, 1, At, B1); PG8_BAR; PG8_SCHED;
            PG8_LDA(At, 1, 1); PG8_STAGE(PG8_SB(1, 0), b3, voffB); PG8_STAGE(PG8_SB(1, 1), b3 + hstepB, voffB); PG8_STAGE(PG8_SA(1, 0), a3, voffA);
            PG8_WAIT_V(8); PG8_WAIT_L(0); PG8_BAR; PG8_MMA(1, 0, At, B0); PG8_MMA(1, 1, At, B1); PG8_BAR; PG8_SCHED;
        }
        if (wr == 0) PG8_BAR;
        E(acc, cur, wr, wc, fr, fq);
        if (!has_next) break;
#pragma unroll
        for (int a = 0; a < 2; ++a)
#pragma unroll
            for (int b = 0; b < 2; ++b)
#pragma unroll
                for (int m = 0; m < 4; ++m)
#pragma unroll
                    for (int n = 0; n < 2; ++n) acc[a][b][m][n] = (f32x4){0.f, 0.f, 0.f, 0.f};
        cur = nxt; cA = nA; cB = nB; ++ui;
        if (wr == 1) PG8_BAR;
    }
    PG8_WAIT_V(0);
    PG8_BAR;
#undef PG8_SA
#undef PG8_SB
#undef PG8_STAGE
#undef PG8_LDA
#undef PG8_LDB
#undef PG8_MMA
#undef PG8_WAIT_V
#undef PG8_WAIT_L
#undef PG8_BAR
#undef PG8_SCHED
}
}

#define XB_TMO      128
#define XB_XCNT(j)  (256  + 64 * (j))
#define XB_XSUB(j)  (1280 + 64 * (j))
#define XB_XGEN(j)  (2304 + 64 * (j))
#define XB_TOP      3328
#define XB_TOPGEN   3392
#define XCD_BAR_WORDS 3456
#define XB_SPIN_CAP (1u << 22)
__device__ __forceinline__ unsigned xb_ld(unsigned* p)              { return __hip_atomic_load(p, __ATOMIC_RELAXED, __HIP_MEMORY_SCOPE_AGENT); }
__device__ __forceinline__ unsigned xb_add(unsigned* p, unsigned v) { return __hip_atomic_fetch_add(p, v, __ATOMIC_RELAXED, __HIP_MEMORY_SCOPE_AGENT); }
__device__ __forceinline__ unsigned xb_xcc_id() { return (unsigned)__builtin_amdgcn_s_getreg((3 << 11) | 20) & 0xFu; }
#define XB_SPIN(cond, bar) do { unsigned _sp = 0; while (cond) { __builtin_amdgcn_s_sleep(1); \
    if ((++_sp & 255u) == 0u) { if (xb_ld(&(bar)[XB_TMO])) break; if (_sp > XB_SPIN_CAP) { atomicAdd(&(bar)[XB_TMO], 1u); break; } } } } while (0)
struct XcdBarrier { unsigned* bar; unsigned x; volatile LAS unsigned* st; };
__device__ __forceinline__ XcdBarrier xcd_barrier_post(unsigned* bar, volatile LAS unsigned* st) {
    XcdBarrier b; b.bar = bar; b.x = xb_xcc_id(); b.st = st;
    if (threadIdx.x == 0) (void)xb_add(&bar[XB_XCNT(b.x)], 1u);
    return b;
}
__device__ __forceinline__ void xcd_barrier_complete(unsigned* bar, unsigned x, unsigned& nloc, unsigned& nx) {
    const unsigned G = gridDim.x * gridDim.y * gridDim.z;
    unsigned sum, cnt, mine, sp = 0u;
    for (;;) {
        sum = 0u; cnt = 0u; mine = 0u;
#pragma unroll
        for (unsigned j = 0; j < 16; ++j) { const unsigned c = xb_ld(&bar[XB_XCNT(j)]); sum += c; cnt += (c > 0u) ? 1u : 0u; mine = (j == x) ? c : mine; }
        if (sum == G) break;
        __builtin_amdgcn_s_sleep(1);
        if ((++sp & 255u) == 0u) { if (xb_ld(&bar[XB_TMO])) break; if (sp > XB_SPIN_CAP) { atomicAdd(&bar[XB_TMO], 1u); break; } }
    }
    nloc = mine > 0u ? mine : 1u; nx = cnt > 0u ? cnt : 1u;
}
__device__ __forceinline__ void xcd_barrier(const XcdBarrier& b) {
    asm volatile("s_waitcnt vmcnt(0)" ::: "memory");
    __syncthreads();
    if (threadIdx.x == 0) {
        unsigned* bar = b.bar;
        __builtin_amdgcn_s_waitcnt(0);
        unsigned nloc = b.st[0], nx = b.st[1];
        if (nloc == 0u) { xcd_barrier_complete(bar, b.x, nloc, nx); b.st[0] = nloc; b.st[1] = nx; }
        const unsigned old = xb_add(&bar[XB_XSUB(b.x)], 1u);
        const unsigned gen = old / nloc;
        if (old + 1u == (gen + 1u) * nloc) {
            __builtin_amdgcn_fence(__ATOMIC_RELEASE, "agent");
            asm volatile("s_waitcnt vmcnt(0)" ::: "memory");
            const unsigned og = xb_add(&bar[XB_TOP], 1u);
            const unsigned tg = og / nx;
            if (og + 1u == (tg + 1u) * nx) xb_add(&bar[XB_TOPGEN], 1u);
            else XB_SPIN(xb_ld(&bar[XB_TOPGEN]) == tg, bar);
            __builtin_amdgcn_fence(__ATOMIC_ACQUIRE, "agent");
            xb_add(&bar[XB_XGEN(b.x)], 1u);
            asm volatile("s_waitcnt vmcnt(0)" ::: "memory");
        } else {
            XB_SPIN(xb_ld(&bar[XB_XGEN(b.x)]) == gen, bar);
            __builtin_amdgcn_fence(__ATOMIC_ACQUIRE, "agent");
            asm volatile("s_waitcnt vmcnt(0)" ::: "memory");
        }
    }
    __syncthreads();
}

constexpr int NWAVES = 8, NTHR = 512;
constexpr int LDS_MAIN = 131072;
constexpr int LDS_AUX = 131072, LDS_AUX_BYTES = 16384;
constexpr int LDS_MISC = LDS_AUX + LDS_AUX_BYTES;
constexpr int LDS_PTAB = LDS_MISC + 256;
constexpr int LDS_BYTES = LDS_MISC + 1024;
struct Args { const float* in[N_INPUTS]; float* out; unsigned char* ws; int ph_lo, ph_hi; };

struct Ctx {
    LAS unsigned char* lds;
    int tid, lane, wave, G, bid, gw, ngw;
    unsigned char* ws;
};
__device__ __forceinline__ const float* lds_inp(LAS unsigned char* lds, int i) {
    const LAS unsigned* p = (const LAS unsigned*)(lds + LDS_PTAB) + 2 * i;
    const unsigned lo = __builtin_amdgcn_readfirstlane(p[0]), hi = __builtin_amdgcn_readfirstlane(p[1]);
    return (const float*)(const GAS float*)(((unsigned long long)hi << 32) | lo);
}
#define INP(i) lds_inp(C.lds, (i))
#define WSP(T_, off) ((T_*)(C.ws + (off)))
#define ARP(T_, off) ((T_*)(C.ws + WS_ARENA + (off)))
#define LDS_WAIT() asm volatile("s_waitcnt lgkmcnt(0)" ::: "memory")

__device__ __forceinline__ void rms_row_bf16(const float* xrow, const float* gain, bf16* orow, int lane) {
    f32x4 v[8]; float s = 0.f;
#pragma unroll
    for (int j = 0; j < 8; ++j) { v[j] = *(const f32x4*)(xrow + (j * 64 + lane) * 4); s += v[j].x * v[j].x + v[j].y * v[j].y + v[j].z * v[j].z + v[j].w * v[j].w; }
    const float rstd = rsqrtf(wave_sum(s) * (1.f / DM) + EPS);
#pragma unroll
    for (int j = 0; j < 8; ++j) { const f32x4 g = *(const f32x4*)(gain + (j * 64 + lane) * 4);
        u32x2 w; w.x = pk2(v[j].x * rstd * g.x, v[j].y * rstd * g.y); w.y = pk2(v[j].z * rstd * g.z, v[j].w * rstd * g.w);
        *(u32x2*)(orow + (j * 64 + lane) * 4) = w; }
}

template <class F>
__device__ __forceinline__ void transpose_tile(const float* W, int ldw, int nvalid, int k0, int n0, bf16* WT, int ldt, F drow, LAS float* scr, int lane) {
    const int nn = n0 + (lane & 31);
#pragma unroll 8
    for (int i = 0; i < 32; ++i) { const int kk = 2 * i + (lane >> 5); scr[kk * 33 + (lane & 31)] = (nn < nvalid) ? W[(size_t)(k0 + kk) * ldw + nn] : 0.f; }
    LDS_WAIT(); asm volatile("" ::: "memory");
    const int c = lane & 7;
#pragma unroll
    for (int j = 0; j < 4; ++j) { const int n = (lane >> 3) + 8 * j; const LAS float* s = scr + (8 * c) * 33 + n;
        u32x4 o; o.x = pk2(s[0 * 33], s[1 * 33]); o.y = pk2(s[2 * 33], s[3 * 33]); o.z = pk2(s[4 * 33], s[5 * 33]); o.w = pk2(s[6 * 33], s[7 * 33]);
        *(u32x4*)(WT + (size_t)drow(n0 + n) * ldt + k0 + 8 * c) = o; }
    LDS_WAIT(); asm volatile("" ::: "memory");
}
template <class F>
__device__ __forceinline__ void transpose_matrix(const Ctx& C, const float* W, int K, int N, int Npad, bf16* WT, int ldt, F drow, LAS float* scr) {
    const int nblk = Npad / 32, items = (K / 64) * nblk;
    for (int it = C.gw; it < items; it += C.ngw) { const int kb = it / nblk, nb = it % nblk; transpose_tile(W, N, N, kb * 64, nb * 32, WT, ldt, drow, scr, C.lane); }
}

#define EPI_ARGS const f32x4 (&acc)[2][2][4][2], const pg8::Unit& u, int wr, int wc, int fr, int fq
struct EpiStoreBf16 {
    bf16* O; int ldc; float scale;
    __device__ __forceinline__ void operator()(EPI_ARGS) const {
        bf16* base = O + u.coff + (size_t)(wr * 64 + fr) * ldc + wc * 32 + 8 * fq;
#pragma unroll
        for (int ai = 0; ai < 2; ++ai)
#pragma unroll
            for (int m = 0; m < 4; ++m) { bf16* rowp = base + (size_t)(ai * 128 + m * 16) * ldc;
#pragma unroll
                for (int bj = 0; bj < 2; ++bj) { const f32x4 v0 = acc[ai][bj][m][0] * scale, v1 = acc[ai][bj][m][1] * scale;
                    u32x4 w; w.x = pg8::cvt_pk_bf16(v0[0], v0[1]); w.y = pg8::cvt_pk_bf16(v0[2], v0[3]); w.z = pg8::cvt_pk_bf16(v1[0], v1[1]); w.w = pg8::cvt_pk_bf16(v1[2], v1[3]);
                    *(u32x4*)(rowp + bj * 128) = w; } }
    }
};
struct EpiStoreF32 {
    float* O; int ldc;
    __device__ __forceinline__ void operator()(EPI_ARGS) const {
        float* base = O + u.coff + (size_t)(wr * 64 + fr) * ldc + wc * 32 + 8 * fq;
#pragma unroll
        for (int ai = 0; ai < 2; ++ai)
#pragma unroll
            for (int m = 0; m < 4; ++m) { float* rowp = base + (size_t)(ai * 128 + m * 16) * ldc;
#pragma unroll
                for (int bj = 0; bj < 2; ++bj) { *(f32x4*)(rowp + bj * 128) = acc[ai][bj][m][0]; *(f32x4*)(rowp + bj * 128 + 4) = acc[ai][bj][m][1]; } }
    }
};
struct EpiResid {
    const float* base; float* out; int ldc;
    __device__ __forceinline__ void operator()(EPI_ARGS) const {
        const size_t o0 = (size_t)u.coff + (size_t)(wr * 64 + fr) * ldc + wc * 32 + 8 * fq;
#pragma unroll
        for (int ai = 0; ai < 2; ++ai)
#pragma unroll
            for (int m = 0; m < 4; ++m) { const size_t o = o0 + (size_t)(ai * 128 + m * 16) * ldc;
#pragma unroll
                for (int bj = 0; bj < 2; ++bj) {
                    const f32x4 b0 = *(const f32x4*)(base + o + bj * 128), b1 = *(const f32x4*)(base + o + bj * 128 + 4);
                    *(f32x4*)(out + o + bj * 128) = b0 + acc[ai][bj][m][0]; *(f32x4*)(out + o + bj * 128 + 4) = b1 + acc[ai][bj][m][1]; } }
    }
};
struct EpiAbIn {
    bf16* P; float* G32;
    __device__ __forceinline__ void operator()(EPI_ARGS) const {
        const int row0 = u.pm * 256 + wr * 64 + fr, col0 = u.pn * 256 + wc * 32 + 8 * fq;
#pragma unroll
        for (int ai = 0; ai < 2; ++ai)
#pragma unroll
            for (int m = 0; m < 4; ++m) { const int row = row0 + ai * 128 + m * 16; bf16* rowp = P + (size_t)row * AB_PAD + col0;
#pragma unroll
                for (int bj = 0; bj < 2; ++bj) { const f32x4 v0 = acc[ai][bj][m][0], v1 = acc[ai][bj][m][1];
                    u32x4 w; w.x = pg8::cvt_pk_bf16(v0[0], v0[1]); w.y = pg8::cvt_pk_bf16(v0[2], v0[3]); w.z = pg8::cvt_pk_bf16(v1[0], v1[1]); w.w = pg8::cvt_pk_bf16(v1[2], v1[3]);
                    *(u32x4*)(rowp + bj * 128) = w;
                    if (u.pn == 12) { float* g = G32 + (size_t)row * 256 + wc * 32 + 8 * fq + bj * 128; *(f32x4*)g = v0; *(f32x4*)(g + 4) = v1; } } }
    }
};
struct EpiLora {
    const float *w0, *a0, *k_a; const bf16 *KK, *KR; float* WD; bf16 *BV, *KP, *GG;
    __device__ __forceinline__ void operator()(EPI_ARGS) const {
        const int grp = u.pn >> 2, row0 = u.pm * 256 + wr * 64 + fr, cc0 = (u.pn & 3) * 256 + wc * 32 + 8 * fq;
#pragma unroll
        for (int ai = 0; ai < 2; ++ai)
#pragma unroll
            for (int m = 0; m < 4; ++m) { const size_t ro = (size_t)(row0 + ai * 128 + m * 16) * 1024;
#pragma unroll
                for (int bj = 0; bj < 2; ++bj) { const int cc = cc0 + bj * 128; float v[8];
#pragma unroll
                    for (int j = 0; j < 4; ++j) { v[j] = acc[ai][bj][m][0][j]; v[4 + j] = acc[ai][bj][m][1][j]; }
                    if (grp == 0) { float o[8];
#pragma unroll
                        for (int j = 0; j < 8; ++j) o[j] = __expf(-0.6065306597126334f * sigmoidf_(w0[cc + j] + v[j]));
                        *(f32x4*)(WD + ro + cc) = (f32x4){o[0], o[1], o[2], o[3]}; *(f32x4*)(WD + ro + cc + 4) = (f32x4){o[4], o[5], o[6], o[7]};
                    } else if (grp == 1) { float kk[8], kr[8], ob[8], ok[8];
                        unpack8(*(const u32x4*)(KK + ro + cc), kk); unpack8(*(const u32x4*)(KR + ro + cc), kr);
#pragma unroll
                        for (int j = 0; j < 8; ++j) { const float a = sigmoidf_(a0[cc + j] + v[j]); ob[j] = kk[j] * a; ok[j] = kr[j] * (1.f + (a - 1.f) * k_a[cc + j]); }
                        *(u32x4*)(BV + ro + cc) = pack8f(ob); *(u32x4*)(KP + ro + cc) = pack8f(ok);
                    } else { *(u32x4*)(GG + ro + cc) = pack8f(v); } } }
    }
};
struct EpiHid {
    bf16* H;
    __device__ __forceinline__ void operator()(EPI_ARGS) const {
        bf16* base = H + (size_t)(u.aux + wr * 64 + fr) * FF + u.pn * 128 + wc * 32 + 8 * fq;
#pragma unroll
        for (int ai = 0; ai < 2; ++ai)
#pragma unroll
            for (int m = 0; m < 4; ++m) { float h[8];
#pragma unroll
                for (int j = 0; j < 4; ++j) { h[j] = siluf_(acc[ai][0][m][0][j]) * acc[ai][1][m][0][j]; h[4 + j] = siluf_(acc[ai][0][m][1][j]) * acc[ai][1][m][1][j]; }
                *(u32x4*)(base + (size_t)(ai * 128 + m * 16) * FF) = pack8f(h); }
    }
};
struct EpiMoeDown {
    const int* rowslot; const float* wts; bf16* YE;
    __device__ __forceinline__ void operator()(EPI_ARGS) const {
#pragma unroll
        for (int ai = 0; ai < 2; ++ai)
#pragma unroll
            for (int m = 0; m < 4; ++m) { const int r = ai * 128 + wr * 64 + m * 16 + fr;
                if (r < u.pm) { const int slot = rowslot[u.aux + r]; const float w = wts[slot]; bf16* rowp = YE + (size_t)slot * DM + u.pn * 256 + wc * 32 + 8 * fq;
#pragma unroll
                    for (int bj = 0; bj < 2; ++bj) { const f32x4 v0 = acc[ai][bj][m][0] * w, v1 = acc[ai][bj][m][1] * w;
                        u32x4 o; o.x = pg8::cvt_pk_bf16(v0[0], v0[1]); o.y = pg8::cvt_pk_bf16(v0[2], v0[3]); o.z = pg8::cvt_pk_bf16(v1[0], v1[1]); o.w = pg8::cvt_pk_bf16(v1[2], v1[3]);
                        *(u32x4*)(rowp + bj * 128) = o; } } }
    }
};
struct EpiNsaIn {
    bf16 *Q, *QROT, *KV6; float* GATES; const float *gate_b, *rcos, *rsin;
    __device__ __forceinline__ void operator()(EPI_ARGS) const {
        const int pn = u.pn;
#pragma unroll
        for (int ai = 0; ai < 2; ++ai)
#pragma unroll
            for (int m = 0; m < 4; ++m) { const int t = u.pm * 256 + ai * 128 + wr * 64 + m * 16 + fr, b = t >> 12, s = t & 4095;
#pragma unroll
                for (int bj = 0; bj < 2; ++bj) { float v[8];
#pragma unroll
                    for (int j = 0; j < 4; ++j) { v[j] = acc[ai][bj][m][0][j]; v[4 + j] = acc[ai][bj][m][1][j]; }
                    const int d0 = wc * 32 + 8 * fq;
                    if (pn == 20) {
                        const int c = bj * 128 + d0;
                        if (c < 48) { float o[8];
#pragma unroll
                            for (int j = 0; j < 8; ++j) o[j] = sigmoidf_(v[j] + gate_b[c + j]);
                            float* g = GATES + (size_t)t * 48 + c; *(f32x4*)g = (f32x4){o[0], o[1], o[2], o[3]}; *(f32x4*)(g + 4) = (f32x4){o[4], o[5], o[6], o[7]}; }
                        continue; }
                    float vr[8];
                    { float pv[8];
#pragma unroll
                      for (int j = 0; j < 8; ++j) pv[j] = __shfl_xor(v[j], 32);
                      const float* cs = rcos + s * 16 + 8 * (fq & 1); const float* sn = rsin + s * 16 + 8 * (fq & 1);
#pragma unroll
                      for (int j = 0; j < 8; ++j) { const float c_ = cs[j], s_ = sn[j]; vr[j] = (fq < 2) ? (v[j] * c_ - pv[j] * s_) : (v[j] * c_ + pv[j] * s_); } }
                    if (pn < 8) { const int hh = pn * 2 + bj; const size_t o = (((size_t)(b * 16 + hh)) * SEQ + s) * 128 + d0;
                        *(u32x4*)(Q + o) = pack8f(v); *(u32x4*)(QROT + o) = (wc == 0) ? pack8f(vr) : pack8f(v);
                    } else { const int i6 = (pn - 8) >> 1, g = ((pn - 8) & 1) * 2 + bj; const bool rot = (i6 == 2 || i6 == 4) && wc == 0;
                        bf16* dst = (bf16*)((unsigned char*)KV6 + (size_t)i6 * KV6_STRIDE) + (((size_t)(b * 4 + g)) * SPAD + s) * 128 + d0;
                        *(u32x4*)dst = rot ? pack8f(vr) : pack8f(v); } } }
    }
};

__device__ __forceinline__ void phase_prologue(const Ctx& C, const Args& A) {
    LAS float* scr = (LAS float*)(C.lds + C.wave * 8448);
    auto ident = [](int n) { return n; };
    transpose_matrix(C, INP(I_AB_W_IN), DM, AB_COLS, AB_PAD, WSP(bf16, WS_W_ABIN), DM, ident, scr);
    transpose_matrix(C, INP(I_AB_W_OUT), DM, DM, DM, WSP(bf16, WS_W_ABOUT), DM, ident, scr);
    transpose_matrix(C, INP(I_NSA_W_IN), DM, NSA_COLS, NSA_PAD, WSP(bf16, WS_W_NSAIN), DM, ident, scr);
    transpose_matrix(C, INP(I_NSA_W_OUT), DM, DM, DM, WSP(bf16, WS_W_NSAOUT), DM, ident, scr);
    for (int l = 0; l < 2; ++l) {
        transpose_matrix(C, INP(I_CA_WK) + (size_t)l * DM * DM, DM, DM, DM, WSP(bf16, WS_W_CAK) + (size_t)l * DM * DM, DM, ident, scr);
        transpose_matrix(C, INP(I_CA_WV) + (size_t)l * DM * DM, DM, DM, DM, WSP(bf16, WS_W_CAV) + (size_t)l * DM * DM, DM, ident, scr);
        transpose_matrix(C, INP(I_CA_WO) + (size_t)l * DM * DM, DM, DM, DM, WSP(bf16, WS_W_CAO) + (size_t)l * DM * DM, DM, ident, scr);
    }
    for (int kv = 0; kv < 2; ++kv)
        transpose_matrix(C, INP(I_CMP_W1) + (size_t)kv * 4096 * 128, 4096, 128, 128, WSP(bf16, WS_W_CMP1) + (size_t)kv * 256 * 4096, 4096, ident, scr);
    {
        auto dg = [](int n) { return (n >> 7) * 256 + (n & 127); };
        auto du = [](int n) { return (n >> 7) * 256 + 128 + (n & 127); };
        const int per = 512;
        const int total = 2 * NEXP * 3 * per;
        for (int it = C.gw; it < total; it += C.ngw) {
            const int le = it / (3 * per), r = it % (3 * per), which = r / per, q = r % per;
            if (which == 0) { const int kb = q / 16, nb = q % 16; transpose_tile(INP(I_MOE_W_GATE) + (size_t)le * DM * FF, FF, FF, kb * 64, nb * 32, WSP(bf16, WS_W_GU) + (size_t)le * 1024 * DM, DM, dg, scr, C.lane); }
            else if (which == 1) { const int kb = q / 16, nb = q % 16; transpose_tile(INP(I_MOE_W_UP) + (size_t)le * DM * FF, FF, FF, kb * 64, nb * 32, WSP(bf16, WS_W_GU) + (size_t)le * 1024 * DM, DM, du, scr, C.lane); }
            else { const int kb = q / 64, nb = q % 64; transpose_tile(INP(I_MOE_W_DOWN) + (size_t)le * FF * DM, DM, DM, kb * 64, nb * 32, WSP(bf16, WS_W_DN) + (size_t)le * DM * FF, FF, ident, scr, C.lane); }
        }
    }
    const size_t gt = (size_t)C.bid * NTHR + C.tid, gn = (size_t)C.G * NTHR;
    { const float* src = INP(I_CA_WQ); bf16* dst = WSP(bf16, WS_W_CAQ);
      for (size_t i = gt; i < (size_t)2 * DM * DM / 4; i += gn) { const f32x4 v = *(const f32x4*)(src + i * 4); u32x2 w; w.x = pk2(v.x, v.y); w.y = pk2(v.z, v.w); *(u32x2*)(dst + i * 4) = w; } }
    { bf16* dst = WSP(bf16, WS_W_LORA);
      for (size_t i = gt; i < (size_t)3072 * 256; i += gn) { const int n = (int)(i >> 8), k = (int)(i & 255); float v = 0.f;
          if (n < 1024) { if (k < 64) v = INP(I_RW_W_UP)[k * 1024 + n]; }
          else if (n < 2048) { if (k >= 64 && k < 128) v = INP(I_RW_A_UP)[(k - 64) * 1024 + (n - 1024)]; }
          else { if (k >= 128) v = INP(I_RW_G_UP)[(k - 128) * 1024 + (n - 2048)]; }
          dst[i] = (bf16)f2bf(v); } }
    { bf16* dst = WSP(bf16, WS_W_ROUTER);
      for (size_t i = gt; i < (size_t)2 * 256 * DM; i += gn) { const int l = (int)(i / (256 * DM)), n = (int)((i / DM) & 255), k = (int)(i % DM); float v = 0.f;
          if (n < 8) v = INP(I_MOE_WG)[((size_t)l * DM + k) * 8 + n]; else if (n < 72) v = INP(I_MOE_WE)[((size_t)l * DM + k) * 64 + (n - 8)];
          dst[i] = (bf16)f2bf(v); } }
    { float* rc = WSP(float, WS_TAB + TAB_ROPE_COS); float* rs = WSP(float, WS_TAB + TAB_ROPE_SIN);
      for (size_t i = gt; i < (size_t)SEQ * 16; i += gn) { const int pos = (int)(i >> 4), j = (int)(i & 15);
          const float inv = 1.0f / powf(500000.0f, (float)j / 16.0f); const float ang = (float)pos * inv; rc[i] = cosf(ang); rs[i] = sinf(ang); } }
    for (int o = C.gw; o < 256; o += C.ngw) { const int kv = o >> 7, e = o & 127; float s = 0.f;
        for (int i = C.lane; i < 4096; i += 64) s += INP(I_CMP_POS)[kv * 4096 + i] * INP(I_CMP_W1)[((size_t)kv * 4096 + i) * 128 + e];
        s = wave_sum(s); if (C.lane == 0) WSP(float, WS_TAB + TAB_CMPBIAS)[o] = s; }
    for (int r = C.gw; r < 2 * MT; r += C.ngw) { const int l = r / MT, m = r % MT;
        rms_row_bf16(INP(I_MEM) + (size_t)m * DM, INP(I_NORM_MEM) + l * DM, WSP(bf16, WS_MEMN) + ((size_t)l * MT + m) * DM, C.lane); }
    for (int r = C.gw; r < T; r += C.ngw) rms_row_bf16(INP(I_X) + (size_t)r * DM, INP(I_NORM_MIX), WSP(bf16, WS_XN) + (size_t)r * DM, C.lane);
}

struct MemProjOrder {
    int G, c;
    __device__ __forceinline__ bool next(int i, pg8::Unit& u) const {
        const int L = i * G + c; if (L >= 128) return false;
        const int pn = L & 7, pm = (L >> 3) & 3, kv = (L >> 5) & 1, l = L >> 6;
        u.pm = pm; u.pn = pn; u.aux = 0;
        u.aoff = ((long long)l * MT + pm * 256) * DM * 2;
        u.boff = ((long long)(kv ? (WS_W_CAV - WS_W_CAK) / 2 : 0) + ((long long)l * DM + pn * 256) * DM) * 2;
        u.coff = (long long)(kv ? (WS_VP - WS_KP) / 2 : 0) + ((long long)l * MT + pm * 256) * DM + pn * 256;
        return true;
    }
};
struct WktOrder {
    int G, c;
    __device__ __forceinline__ bool next(int i, pg8::Unit& u) const {
        const int L = i * G + c; if (L >= 256) return false;
        const int pn = L & 7, h = (L >> 3) & 3, b = (L >> 5) & 3, l = L >> 7;
        u.pm = 0; u.pn = pn; u.aux = 0;
        u.aoff = (((long long)l * MT + b * 256) * DM + h * 512) * 2;
        u.boff = (((long long)l * DM + pn * 256) * DM + h * 512) * 2;
        u.coff = (((long long)(l * 4 + b) * 1024) + h * 256) * DM + pn * 256;
        return true;
    }
};
struct VwtOrder {
    int G, c;
    __device__ __forceinline__ bool next(int i, pg8::Unit& u) const {
        const int L = i * G + c; if (L >= 256) return false;
        const int pm = L & 7, h = (L >> 3) & 3, b = (L >> 5) & 3, l = L >> 7;
        u.pm = pm; u.pn = 0; u.aux = 0;
        u.aoff = (((long long)l * DM + pm * 256) * DM + h * 512) * 2;
        u.boff = (((long long)l * MT + b * 256) * DM + h * 512) * 2;
        u.coff = (((long long)(l * 4 + b) * DM) + pm * 256) * 1024 + h * 256;
        return true;
    }
};
struct CrossOrder {
    int nN, G, c, ldc; long long astep, bstep, bbatch;
    __device__ __forceinline__ bool next(int i, pg8::Unit& u) const {
        int pm, pn; if (!pg8::tile_of((long)i * G + c, T / 256, nN, pm, pn)) return false;
        u.pm = pm; u.pn = pn; u.aux = 0; u.aoff = pm * astep; u.boff = (pm >> 4) * bbatch + pn * bstep; u.coff = (long long)pm * 256 * ldc + pn * 256; return true;
    }
};
struct CmpOrder {
    int G, c;
    __device__ __forceinline__ bool next(int i, pg8::Unit& u) const {
        const int L = i * G + c; if (L >= 256) return false;
        const int bg = L & 15, kv = (L >> 4) & 1, ks = L >> 5;
        u.pm = 0; u.pn = 0; u.aux = 0;
        u.aoff = (long long)kv * KV6_STRIDE + ((long long)bg * SPAD * 128 + ks * 512) * 2;
        u.boff = ((long long)kv * 256 * 4096 + ks * 512) * 2;
        u.coff = ((long long)(ks * 2 + kv) * 16 + bg) * 65536;
        return true;
    }
};
struct MoeOrder {
    const LAS int* tab; int npn, G, c, which;
    __device__ __forceinline__ bool next(int i, pg8::Unit& u) const {
        const int L = i * G + c, ntile = tab[64]; if (L >= ntile * npn) return false;
        const int tix = L / npn, pn = L % npn; int e = 0;
        for (int k = 32; k >= 1; k >>= 1) if (e + k < 64 && tab[e + k] <= tix) e += k;
        while (tab[e + 1] <= tix) ++e;
        const int mt = tix - tab[e], cnt = tab[65 + e], row0 = tab[129 + e] + mt * 256;
        u.pm = min(256, cnt - mt * 256); u.pn = pn; u.aux = row0;
        if (which == 0) { u.aoff = (long long)row0 * DM * 2; u.boff = ((long long)e * 1024 + pn * 256) * DM * 2; }
        else { u.aoff = (long long)row0 * FF * 2; u.boff = ((long long)e * DM + pn * 256) * FF * 2; }
        u.coff = 0; return true;
    }
};
__device__ __forceinline__ void moe_build_table(const Ctx& C, const unsigned* cnt, LAS int* tab) {
    if (C.tid == 0) { int ts = 0, off = 0;
        for (int e = 0; e < 64; ++e) { const int n = (int)cnt[e]; tab[e] = ts; tab[65 + e] = n; tab[129 + e] = off; const int nt = (n + 255) >> 8; ts += nt; off += nt * 256; }
        tab[64] = ts; }
    __syncthreads();
}

__device__ __forceinline__ float log_sigmoidf_(float x) { return fminf(x, 0.f) - log1pf(__expf(-fabsf(x))); }
__device__ __forceinline__ void phase_mixer_prep(const Ctx& C, const Args& A) {
    const bf16* PAB = ARP(bf16, A_PAB); const float* G32 = ARP(float, A_GF32);
    bf16 *QM = ARP(bf16, A_QM), *KM = ARP(bf16, A_KM), *RR = ARP(bf16, A_RR), *KR = ARP(bf16, A_KR), *VR = ARP(bf16, A_VR), *KK = ARP(bf16, A_KK), *LIN = ARP(bf16, A_LIN);
    float *IG = ARP(float, A_IG), *LF = ARP(float, A_LF);
    const float *cw = INP(I_ML_CONV_W), *cb = INP(I_ML_CONV_B), *gb = INP(I_ML_GATE_B), *mu = INP(I_RW_MU), *k_k = INP(I_RW_K_K);
    const int lane = C.lane;
    for (int t = C.gw; t < T; t += C.ngw) {
        const int b = t >> 12, s = t & 4095; const bf16* P = PAB + (size_t)t * AB_PAD;
#pragma unroll
        for (int it = 0; it < 2; ++it) { const int c = (lane + 64 * it) * 8; float y[8];
#pragma unroll
            for (int j = 0; j < 8; ++j) y[j] = cb[c + j];
#pragma unroll
            for (int tap = 0; tap < 4; ++tap) { const int back = 3 - tap;
                if (s >= back) { float xv[8]; unpack8(*(const u32x4*)(P - (size_t)back * AB_PAD + c), xv);
#pragma unroll
                    for (int j = 0; j < 8; ++j) y[j] += xv[j] * cw[tap * 1024 + c + j]; } }
#pragma unroll
            for (int j = 0; j < 8; ++j) y[j] = siluf_(y[j]);
            if (c < 512) *(u32x4*)(QM + (size_t)t * 512 + c) = pack8f(y); else *(u32x4*)(KM + (size_t)t * 512 + c - 512) = pack8f(y); }
        if (lane < 8) { const float g = G32[(size_t)t * 256 + lane] + gb[lane];
            if (lane < 4) IG[(size_t)(b * 4 + lane) * SEQ + s] = g; else LF[(size_t)(b * 4 + lane - 4) * SEQ + s] = log_sigmoidf_(g); }
        const bf16* PR = P + ML_COLS;
#pragma unroll
        for (int it = 0; it < 7; ++it) { const int chunk = lane + 64 * it; if (chunk >= 416) break; const int cc = chunk * 8;
            float p[8], pp[8], mx[8]; unpack8(*(const u32x4*)(PR + cc), p);
            if (s > 0) unpack8(*(const u32x4*)(PR - AB_PAD + cc), pp); else {
#pragma unroll
                for (int j = 0; j < 8; ++j) pp[j] = 0.f; }
#pragma unroll
            for (int j = 0; j < 8; ++j) mx[j] = p[j] + (pp[j] - p[j]) * mu[cc + j];
            if (it < 2) *(u32x4*)(RR + (size_t)t * 1024 + cc) = pack8f(mx);
            else if (it < 4) { const int ck = cc - 1024; *(u32x4*)(KR + (size_t)t * 1024 + ck) = pack8f(mx);
                float kk[8], ss = 0.f;
#pragma unroll
                for (int j = 0; j < 8; ++j) { kk[j] = mx[j] * k_k[ck + j]; ss += kk[j] * kk[j]; }
                ss += __shfl_xor(ss, 1); ss += __shfl_xor(ss, 2); ss += __shfl_xor(ss, 4);
                const float rn = rsqrtf(ss + 1e-12f);
#pragma unroll
                for (int j = 0; j < 8; ++j) kk[j] *= rn;
                *(u32x4*)(KK + (size_t)t * 1024 + ck) = pack8f(kk); }
            else if (it < 6) *(u32x4*)(VR + (size_t)t * 1024 + cc - 2048) = pack8f(mx);
            else { float o[8];
#pragma unroll
                for (int j = 0; j < 8; ++j) o[j] = (lane < 8) ? tanhf(mx[j]) : ((lane < 16) ? mx[j] : sigmoidf_(mx[j]));
                *(u32x4*)(LIN + (size_t)t * 256 + lane * 8) = pack8f(o); } }
    }
}

__device__ __forceinline__ void rwkv_scan_unit(const Ctx& C, const Args& A, int bh) {
    const int b = bh >> 4, h = bh & 15, w = C.wave, lane = C.lane, tid = C.tid;
    LAS float* IN = (LAS float*)C.lds;
    LAS float* PART = IN + 2 * 6 * 1024;
    LAS float* YP = PART + 2 * 8 * 64;
    const float* WD = ARP(float, A_WD); const bf16 *KKg = ARP(bf16, A_KK), *BV = ARP(bf16, A_BV), *KP = ARP(bf16, A_KP), *RR = ARP(bf16, A_RR), *VR = ARP(bf16, A_VR), *GG = ARP(bf16, A_GG);
    bf16* YCAT = ARP(bf16, A_YCAT);
    const float *r_k = INP(I_RW_R_K), *ln_w = INP(I_RW_LN_W), *ln_b = INP(I_RW_LN_B);
    const int li = tid >> 5, lch = (tid & 31) * 2;
    const size_t gbase = ((size_t)b * SEQ) * 1024 + h * 64 + lch;
    f32x2 rw; unsigned rk, rb, rp, rr_, rv;
#define RW_LOAD(grp) do { const size_t o = gbase + (size_t)((grp) * 16 + li) * 1024; rw = *(const f32x2*)(WD + o); rk = *(const unsigned*)(KKg + o); rb = *(const unsigned*)(BV + o); \
        rp = *(const unsigned*)(KP + o); rr_ = *(const unsigned*)(RR + o); rv = *(const unsigned*)(VR + o); } while (0)
#define RW_STORE(buf) do { LAS float* d = IN + (buf) * 6144 + li * 64 + lch; *(LAS f32x2*)(d) = rw; *(LAS f32x2*)(d + 1024) = (f32x2){lo_bf(rk), hi_bf(rk)}; *(LAS f32x2*)(d + 2048) = (f32x2){lo_bf(rb), hi_bf(rb)}; \
        *(LAS f32x2*)(d + 3072) = (f32x2){lo_bf(rp), hi_bf(rp)}; *(LAS f32x2*)(d + 4096) = (f32x2){lo_bf(rr_), hi_bf(rr_)}; *(LAS f32x2*)(d + 5120) = (f32x2){lo_bf(rv), hi_bf(rv)}; } while (0)
    float st[8];
#pragma unroll
    for (int j = 0; j < 8; ++j) st[j] = 0.f;
    __syncthreads();
    RW_LOAD(0); RW_STORE(0); __syncthreads();
    for (int grp = 0; grp < SEQ / 16; ++grp) {
        const int buf = grp & 1; const LAS float* I0 = IN + buf * 6144;
        if (grp + 1 < SEQ / 16) RW_LOAD(grp + 1);
        for (int i = 0; i < 16; ++i) {
            const LAS float* q = I0 + i * 64 + 8 * w;
            const f32x4 w0 = *(const LAS f32x4*)(q), w1 = *(const LAS f32x4*)(q + 4), k0 = *(const LAS f32x4*)(q + 1024), k1 = *(const LAS f32x4*)(q + 1028);
            const f32x4 b0 = *(const LAS f32x4*)(q + 2048), b1 = *(const LAS f32x4*)(q + 2052), p0 = *(const LAS f32x4*)(q + 3072), p1 = *(const LAS f32x4*)(q + 3076);
            const f32x4 r0 = *(const LAS f32x4*)(q + 4096), r1 = *(const LAS f32x4*)(q + 4100); const float vv = I0[5120 + i * 64 + lane];
            float skp = 0.f;
#pragma unroll
            for (int j = 0; j < 4; ++j) skp += st[j] * k0[j] + st[4 + j] * k1[j];
            PART[(i & 1) * 512 + w * 64 + lane] = skp;
            LDS_WAIT(); __builtin_amdgcn_s_barrier(); asm volatile("" ::: "memory");
            float sk = 0.f;
#pragma unroll
            for (int ww = 0; ww < 8; ++ww) sk += PART[(i & 1) * 512 + ww * 64 + lane];
            float yp = 0.f;
#pragma unroll
            for (int j = 0; j < 4; ++j) { st[j] = st[j] * w0[j] - sk * b0[j] + vv * p0[j]; st[4 + j] = st[4 + j] * w1[j] - sk * b1[j] + vv * p1[j]; yp += st[j] * r0[j] + st[4 + j] * r1[j]; }
            YP[i * 512 + w * 64 + lane] = yp;
        }
        if (grp + 1 < SEQ / 16) RW_STORE(buf ^ 1);
        __syncthreads();
#pragma unroll
        for (int q = 0; q < 2; ++q) { const int i = 2 * w + q; float y = 0.f;
#pragma unroll
            for (int ww = 0; ww < 8; ++ww) y += YP[i * 512 + ww * 64 + lane];
            const float mean = wave_sum(y) * (1.f / 64.f), dv = y - mean, var = wave_sum(dv * dv) * (1.f / 64.f);
            const int ch = h * 64 + lane; const float yn = dv * rsqrtf(var + 64e-5f) * ln_w[ch] + ln_b[ch];
            const float bonus = wave_sum(I0[4096 + i * 64 + lane] * I0[3072 + i * 64 + lane] * r_k[ch]) * I0[5120 + i * 64 + lane];
            const size_t tt = (size_t)b * SEQ + grp * 16 + i;
            const float g = bf2f(GG[tt * 1024 + ch]);
            YCAT[tt * DM + 1024 + ch] = (bf16)f2bf((yn + bonus) * g); }
    }
#undef RW_LOAD
#undef RW_STORE
    __syncthreads();
}

__device__ __forceinline__ f32x4 lds_mma(const LAS bf16* Am, int lda, const LAS bf16* Bt, int ldb, int tm, int tn, int K, int lane, f32x4 acc) {
    const LAS bf16* ap = Am + (tm * 16 + (lane & 15)) * lda + (lane >> 4) * 8;
    const LAS bf16* bp = Bt + (tn * 16 + (lane & 15)) * ldb + (lane >> 4) * 8;
    for (int k = 0; k < K; k += 32) { const bf16x8 a = *(const LAS bf16x8*)(ap + k); const bf16x8 bb = *(const LAS bf16x8*)(bp + k);
        acc = __builtin_amdgcn_mfma_f32_16x16x32_bf16(bb, a, acc, 0, 0, 0); }
    return acc;
}

__device__ __forceinline__ void mlstm_unit(const Ctx& C, const Args& A, int unit) {
    const int bh = unit >> 3, dvs = unit & 7, b = bh >> 2, h = bh & 3, w = C.wave, lane = C.lane, tid = C.tid;
    LAS float* AA = (LAS float*)C.lds;
    LAS float* MX = AA + 4096;
    LAS bf16* Qs = (LAS bf16*)(MX + 4096);
    LAS bf16* Ks = Qs + 64 * 136;
    LAS bf16* KwT = Ks + 64 * 136;
    LAS bf16* Vt = KwT + 128 * 72;
    LAS bf16* Ps = Vt + 48 * 72;
    LAS bf16* CT = Ps + 64 * 72;
    LAS float* NUM = (LAS float*)(CT + 48 * 136);
    const float *IG = ARP(float, A_IG) + (size_t)bh * SEQ, *LFp = ARP(float, A_LF) + (size_t)bh * SEQ;
    const bf16 *QM = ARP(bf16, A_QM), *KM = ARP(bf16, A_KM), *PAB = ARP(bf16, A_PAB); bf16* YCAT = ARP(bf16, A_YCAT);
    __syncthreads();
    if (w == 0) { float carryF = 0.f, carryM = 0.f;
        for (int c = 0; c < 64; ++c) { const int p = c * 64 + lane; float f = LFp[p];
#pragma unroll
            for (int o = 1; o < 64; o <<= 1) { const float n = __shfl_up(f, o); if (lane >= o) f += n; }
            f += carryF; const float a = IG[p] - f; float m = a;
#pragma unroll
            for (int o = 1; o < 64; o <<= 1) { const float n = __shfl_up(m, o); if (lane >= o) m = fmaxf(m, n); }
            m = fmaxf(m, carryM); AA[p] = a; MX[p] = m; carryF = __shfl(f, 63); carryM = __shfl(m, 63); } }
    for (int i = tid; i < 48 * 72; i += NTHR) { const int r = i / 72; Vt[i] = (r == 32) ? (bf16)0x3f80 : (bf16)0; }
    for (int i = tid; i < 48 * 136; i += NTHR) CT[i] = 0;
    f32x4 accC[3];
#pragma unroll
    for (int k = 0; k < 3; ++k) accC[k] = (f32x4){0.f, 0.f, 0.f, 0.f};
    const size_t tok0 = (size_t)b * SEQ;
    u32x4 rq[2], rk[2], rv;
#define ML_LOAD(c) do { _Pragma("unroll") for (int k = 0; k < 2; ++k) { const int idx = tid + 512 * k, r = idx >> 4, c8 = (idx & 15) * 8; const size_t o = (tok0 + (c) * 64 + r) * 512 + h * 128 + c8; \
            rq[k] = *(const u32x4*)(QM + o); rk[k] = *(const u32x4*)(KM + o); } \
        if (tid < 256) rv = *(const u32x4*)(PAB + (tok0 + (c) * 64 + (tid >> 2)) * AB_PAD + 1024 + h * 256 + dvs * 32 + (tid & 3) * 8); } while (0)
    ML_LOAD(0);
    __syncthreads();
    const float scale = 0.08838834764831845f;
    for (int c = 0; c < 64; ++c) {
        const int t0 = c * 64; const float Mc = c ? MX[t0 - 1] : 0.f, Mc2 = MX[t0 + 63];
#pragma unroll
        for (int k = 0; k < 2; ++k) { const int idx = tid + 512 * k, r = idx >> 4, c8 = (idx & 15) * 8;
            *(LAS u32x4*)(Qs + r * 136 + c8) = rq[k]; *(LAS u32x4*)(Ks + r * 136 + c8) = rk[k];
            float kf[8]; unpack8(rk[k], kf); const float wk = __expf(AA[t0 + r] - Mc2);
#pragma unroll
            for (int j = 0; j < 8; ++j) KwT[(c8 + j) * 72 + r] = (bf16)f2bf(kf[j] * wk); }
        if (tid < 256) { const int r = tid >> 2, e8 = (tid & 3) * 8; const unsigned wv[4] = {rv.x, rv.y, rv.z, rv.w};
#pragma unroll
            for (int j = 0; j < 4; ++j) { Vt[(e8 + 2 * j) * 72 + r] = (bf16)(wv[j] & 0xffff); Vt[(e8 + 2 * j + 1) * 72 + r] = (bf16)(wv[j] >> 16); } }
        if (c + 1 < 64) ML_LOAD(c + 1);
        __syncthreads();
#pragma unroll
        for (int q = 0; q < 2; ++q) { const int tile = 2 * w + q, tm = tile >> 2, tn = tile & 3; const int t = tm * 16 + (lane & 15), l0 = tn * 16 + 4 * (lane >> 4);
            f32x4 s = (f32x4){0.f, 0.f, 0.f, 0.f};
            if (tn <= tm) s = lds_mma(Qs, 136, Ks, 136, tm, tn, 128, lane, s);
            const float mxt = MX[t0 + t]; float pvv[4];
#pragma unroll
            for (int j = 0; j < 4; ++j) { const int l = l0 + j; pvv[j] = (l <= t) ? s[j] * __expf(AA[t0 + l] - mxt) : 0.f; }
            u32x2 pw; pw.x = pk2(pvv[0], pvv[1]); pw.y = pk2(pvv[2], pvv[3]); *(LAS u32x2*)(Ps + t * 72 + l0) = pw; }
        __syncthreads();
        for (int tile = w; tile < 12; tile += 8) { const int tm = tile / 3, tn = tile % 3; const int t = tm * 16 + (lane & 15);
            f32x4 a1 = lds_mma(Ps, 72, Vt, 72, tm, tn, 64, lane, (f32x4){0.f, 0.f, 0.f, 0.f});
            f32x4 a2 = lds_mma(Qs, 136, CT, 136, tm, tn, 128, lane, (f32x4){0.f, 0.f, 0.f, 0.f});
            const float wst = __expf(Mc - MX[t0 + t]);
            *(LAS f32x4*)(NUM + t * 48 + tn * 16 + 4 * (lane >> 4)) = (a1 + a2 * wst) * scale; }
        __syncthreads();
        { const int t = tid >> 3, e4 = (tid & 7) * 4; const size_t tt = tok0 + t0 + t;
          const float den = NUM[t * 48 + 32], mrow = IG[t0 + t] - AA[t0 + t] + MX[t0 + t];
          const float inv = 1.f / fmaxf(fabsf(den), __expf(-mrow));
          const f32x4 nv = *(const LAS f32x4*)(NUM + t * 48 + e4);
          const u32x2 og = *(const u32x2*)(PAB + tt * AB_PAD + 2048 + h * 256 + dvs * 32 + e4);
          u32x2 o; o.x = pk2(sigmoidf_(lo_bf(og.x)) * nv[0] * inv, sigmoidf_(hi_bf(og.x)) * nv[1] * inv); o.y = pk2(sigmoidf_(lo_bf(og.y)) * nv[2] * inv, sigmoidf_(hi_bf(og.y)) * nv[3] * inv);
          *(u32x2*)(YCAT + tt * DM + h * 256 + dvs * 32 + e4) = o; }
        { const float decay = __expf(Mc - Mc2);
#pragma unroll
          for (int tm = 0; tm < 3; ++tm) { accC[tm] = lds_mma(Vt, 72, KwT, 72, tm, w, 64, lane, accC[tm] * decay);
              u32x2 cw; cw.x = pk2(accC[tm][0], accC[tm][1]); cw.y = pk2(accC[tm][2], accC[tm][3]);
              *(LAS u32x2*)(CT + (tm * 16 + (lane & 15)) * 136 + w * 16 + 4 * (lane >> 4)) = cw; } }
        __syncthreads();
    }
#undef ML_LOAD
}

__device__ __forceinline__ void phase_norm(const Ctx& C, const float* X, const float* gain, bf16* XNo) {
    for (int r = C.gw; r < T; r += C.ngw) rms_row_bf16(X + (size_t)r * DM, gain, XNo + (size_t)r * DM, C.lane);
}
__device__ __forceinline__ void phase_softmax256(const Ctx& C) {
    const float* SC = ARP(float, A_SC); bf16* PC = ARP(bf16, A_PC);
    for (int it = C.gw; it < T * 4; it += C.ngw) { const size_t o = (size_t)it * 256 + C.lane * 4;
        const f32x4 v = *(const f32x4*)(SC + o); const float m = wave_max(fmaxf(fmaxf(v.x, v.y), fmaxf(v.z, v.w)));
        const float e0 = __expf(v.x - m), e1 = __expf(v.y - m), e2 = __expf(v.z - m), e3 = __expf(v.w - m);
        const float inv = 1.f / wave_sum(e0 + e1 + e2 + e3);
        u32x2 w; w.x = pk2(e0 * inv, e1 * inv); w.y = pk2(e2 * inv, e3 * inv); *(u32x2*)(PC + o) = w; }
}
__device__ __forceinline__ void phase_route(const Ctx& C, const Args& A, int l) {
    const float* LG = ARP(float, A_LOGIT); int* EID = ARP(int, A_EID); float* WTS = ARP(float, A_WTS);
    unsigned* cnt = WSP(unsigned, WS_CTL) + CW_MOE_CNT + l * 64;
    const float *bg = INP(I_MOE_BG) + l * 8, *be = INP(I_MOE_BE) + l * 64;
    for (int t = C.bid * NTHR + C.tid; t < T; t += C.G * NTHR) { const float* L = LG + (size_t)t * 256;
        float lg[8], mx = -INFINITY; int grp = 0;
#pragma unroll
        for (int g = 0; g < 8; ++g) { lg[g] = L[g] + bg[g]; if (lg[g] > mx) { mx = lg[g]; grp = g; } }
        float se = 0.f;
#pragma unroll
        for (int g = 0; g < 8; ++g) se += __expf(lg[g] - mx);
        const float pgrp = 1.f / se;
        float l1 = -INFINITY, l2 = -INFINITY; int i1 = 0, i2 = 0;
        for (int j = 0; j < 8; ++j) { const float v = L[8 + grp * 8 + j] + be[grp * 8 + j];
            if (v > l1) { l2 = l1; i2 = i1; l1 = v; i1 = j; } else if (v > l2) { l2 = v; i2 = j; } }
        const float w1 = 1.f / (1.f + __expf(l2 - l1)), w2 = 1.f - w1;
        const int e1 = grp * 8 + i1, e2 = grp * 8 + i2;
        EID[2 * t] = e1; EID[2 * t + 1] = e2; WTS[2 * t] = pgrp * w1; WTS[2 * t + 1] = pgrp * w2;
        atomicAdd(cnt + e1, 1u); atomicAdd(cnt + e2, 1u); }
}
__device__ __forceinline__ void phase_gather(const Ctx& C, int l) {
    LAS int* tab = (LAS int*)(C.lds + LDS_AUX);
    moe_build_table(C, WSP(unsigned, WS_CTL) + CW_MOE_CNT + l * 64, tab);
    unsigned* cur = WSP(unsigned, WS_CTL) + CW_MOE_CUR + l * 64;
    const int* EID = ARP(int, A_EID); int* ROWSLOT = ARP(int, A_ROWSLOT); const bf16* XNp = WSP(bf16, WS_XN); bf16* XS = ARP(bf16, A_XS);
    for (int a = C.gw; a < 2 * T; a += C.ngw) { const int e = EID[a]; int pos = 0;
        if (C.lane == 0) { pos = tab[129 + e] + (int)atomicAdd(cur + e, 1u); ROWSLOT[pos] = a; }
        pos = __shfl(pos, 0);
        const u32x4* src = (const u32x4*)(XNp + (size_t)(a >> 1) * DM); u32x4* dst = (u32x4*)(XS + (size_t)pos * DM);
#pragma unroll
        for (int k = 0; k < 4; ++k) dst[k * 64 + C.lane] = src[k * 64 + C.lane]; }
}
__device__ __forceinline__ void phase_combine_norm(const Ctx& C, const float* gain, bf16* XNo, float* OUT) {
    float* XR = WSP(float, WS_XR); const bf16* YE = ARP(bf16, A_YE); const int lane = C.lane;
    for (int t = C.gw; t < T; t += C.ngw) { float* xr = XR + (size_t)t * DM; const bf16* y0 = YE + (size_t)(2 * t) * DM; const bf16* y1 = y0 + DM;
        f32x4 v[8]; float s = 0.f;
#pragma unroll
        for (int j = 0; j < 8; ++j) { const int o = (j * 64 + lane) * 4; v[j] = *(const f32x4*)(xr + o); const u32x2 a = *(const u32x2*)(y0 + o), bq = *(const u32x2*)(y1 + o);
            v[j].x += lo_bf(a.x) + lo_bf(bq.x); v[j].y += hi_bf(a.x) + hi_bf(bq.x); v[j].z += lo_bf(a.y) + lo_bf(bq.y); v[j].w += hi_bf(a.y) + hi_bf(bq.y);
            s += v[j].x * v[j].x + v[j].y * v[j].y + v[j].z * v[j].z + v[j].w * v[j].w; if (!OUT) *(f32x4*)(xr + o) = v[j]; }
        const float rstd = rsqrtf(wave_sum(s) * (1.f / DM) + EPS);
#pragma unroll
        for (int j = 0; j < 8; ++j) { const int o = (j * 64 + lane) * 4; const f32x4 g = *(const f32x4*)(gain + o);
            if (OUT) *(f32x4*)(OUT + (size_t)t * DM + o) = (f32x4){v[j].x * rstd * g.x, v[j].y * rstd * g.y, v[j].z * rstd * g.z, v[j].w * rstd * g.w};
            else { u32x2 w; w.x = pk2(v[j].x * rstd * g.x, v[j].y * rstd * g.y); w.y = pk2(v[j].z * rstd * g.z, v[j].w * rstd * g.w); *(u32x2*)(XNo + (size_t)t * DM + o) = w; } }
    }
}

__device__ __forceinline__ float gelu_tanh(float x) { return 0.5f * x * (1.f + tanhf(0.7978845608028654f * (x + 0.044715f * x * x * x))); }
__device__ __forceinline__ void phase_cmp_finish(const Ctx& C, const Args& A) {
    const float* CP = ARP(float, A_CPART); const float* bias = WSP(float, WS_TAB + TAB_CMPBIAS); const float* w2 = INP(I_CMP_W2);
    LAS float* hid = (LAS float*)C.lds + C.wave * 128; const int lane = C.lane;
    for (int it = C.gw; it < 2 * 16 * 256; it += C.ngw) { const int j = it & 255, bg = (it >> 8) & 15, kv = it >> 12;
        bf16* dst = ARP(bf16, kv ? A_VCMP : A_KCMP) + ((size_t)bg * 256 + j) * 128;
        if (j == 255) { dst[lane] = 0; dst[lane + 64] = 0; continue; }
        float h0 = bias[kv * 128 + lane], h1 = bias[kv * 128 + 64 + lane];
#pragma unroll
        for (int ks = 0; ks < 8; ++ks) { const float* p = CP + ((size_t)((ks * 2 + kv) * 16 + bg) * 256 + j) * 256; h0 += p[lane]; h1 += p[64 + lane]; }
        hid[lane] = gelu_tanh(h0); hid[64 + lane] = gelu_tanh(h1); LDS_WAIT(); asm volatile("" ::: "memory");
        float o0 = 0.f, o1 = 0.f; const float* W = w2 + (size_t)kv * 128 * 128;
        for (int e = 0; e < 128; ++e) { const float hv = hid[e]; o0 += hv * W[e * 128 + lane]; o1 += hv * W[e * 128 + 64 + lane]; }
        dst[lane] = (bf16)f2bf(o0); dst[lane + 64] = (bf16)f2bf(o1); LDS_WAIT(); asm volatile("" ::: "memory"); }
}
__device__ __forceinline__ void phase_cmp_attn(const Ctx& C) {
    const bf16 *Q = ARP(bf16, A_Q), *KC = ARP(bf16, A_KCMP), *VC = ARP(bf16, A_VCMP); const float* GATES = ARP(float, A_GATES);
    float* OACC = ARP(float, A_OACC); unsigned long long* SELM = ARP(unsigned long long, A_SELMASK);
    LAS float* qs = (LAS float*)C.lds + C.wave * 1536;
    LAS float* ps = qs + 512; const int lane = C.lane; const float scale = 0.08838834764831845f;
    for (int it = C.gw; it < T * 4; it += C.ngw) { const int t = it >> 2, g = it & 3, b = t >> 12, s = t & 4095;
        const int nvalid = (s >= 31) ? ((s - 31) >> 4) + 1 : 0;
#pragma unroll
        for (int r = 0; r < 4; ++r) { const bf16* qp = Q + (((size_t)(b * 16 + g * 4 + r)) * SEQ + s) * 128; qs[r * 128 + lane] = bf2f(qp[lane]); qs[r * 128 + 64 + lane] = bf2f(qp[64 + lane]); }
        LDS_WAIT(); asm volatile("" ::: "memory");
        float sc[4][4];
#pragma unroll
        for (int i = 0; i < 4; ++i) { const int j = lane + 64 * i;
#pragma unroll
            for (int r = 0; r < 4; ++r) sc[r][i] = 0.f;
            if (j < nvalid) { const bf16* kp = KC + ((size_t)(b * 4 + g) * 256 + j) * 128;
                for (int d8 = 0; d8 < 16; ++d8) { float kf[8]; unpack8(*(const u32x4*)(kp + d8 * 8), kf);
#pragma unroll
                    for (int r = 0; r < 4; ++r) { float a = 0.f;
#pragma unroll
                        for (int jj = 0; jj < 8; ++jj) a += qs[r * 128 + d8 * 8 + jj] * kf[jj];
                        sc[r][i] += a; } } } }
#pragma unroll
        for (int r = 0; r < 4; ++r) { float m = -INFINITY;
#pragma unroll
            for (int i = 0; i < 4; ++i) if (lane + 64 * i < nvalid) m = fmaxf(m, sc[r][i] * scale);
            m = wave_max(m); if (!(m > -INFINITY)) m = 0.f; float e[4], sum = 0.f;
#pragma unroll
            for (int i = 0; i < 4; ++i) { e[i] = (lane + 64 * i < nvalid) ? __expf(sc[r][i] * scale - m) : 0.f; sum += e[i]; }
            sum = wave_sum(sum); const float inv = sum > 0.f ? 1.f / sum : 1.f;
#pragma unroll
            for (int i = 0; i < 4; ++i) ps[r * 256 + lane + 64 * i] = e[i] * inv; }
        LDS_WAIT(); asm volatile("" ::: "memory");
        float o[4][2];
#pragma unroll
        for (int r = 0; r < 4; ++r) { o[r][0] = 0.f; o[r][1] = 0.f; }
        for (int j = 0; j < nvalid; ++j) { const bf16* vp = VC + ((size_t)(b * 4 + g) * 256 + j) * 128; const float v0 = bf2f(vp[lane]), v1 = bf2f(vp[64 + lane]);
#pragma unroll
            for (int r = 0; r < 4; ++r) { const float p = ps[r * 256 + j]; o[r][0] += p * v0; o[r][1] += p * v1; } }
#pragma unroll
        for (int r = 0; r < 4; ++r) { const float gt = GATES[(size_t)t * 48 + g * 4 + r]; float* op = OACC + (size_t)t * DM + (g * 4 + r) * 128; op[lane] = gt * o[r][0]; op[64 + lane] = gt * o[r][1]; }
        float imp = 0.f;
#pragma unroll
        for (int r = 0; r < 4; ++r) { const LAS float* p = ps + r * 256; const int j0 = 4 * lane;
            imp += (j0 > 0 ? 0.5f * p[j0 - 1] : 0.f) + p[j0] + p[j0 + 1] + p[j0 + 2] + 0.5f * p[j0 + 3]; }
        const int cur = s >> 6; float score;
        if (lane == 0 || lane == cur || lane == cur - 1) score = INFINITY; else score = (lane <= cur) ? imp : -INFINITY;
        int rank = 0;
        for (int o2 = 0; o2 < 64; ++o2) { const float so = __shfl(score, o2); rank += (so > score || (so == score && o2 < lane)) ? 1 : 0; }
        const unsigned long long m = __ballot(rank < 16 && score > -INFINITY);
        if (lane == 0) SELM[(size_t)t * 4 + g] = m;
        LDS_WAIT(); asm volatile("" ::: "memory");
    }
}
struct NaiveAttnState { float m[4], l[4], o[4][2]; };
__device__ __forceinline__ void naive_tile(NaiveAttnState& S, const LAS float* qs, LAS float* pt, const bf16* Kt, const bf16* Vt_, int key0, bool valid, int lane) {
    float sc[4] = {0.f, 0.f, 0.f, 0.f}; const float scale = 0.08838834764831845f;
    if (valid) { const bf16* kp = Kt + (size_t)(key0 + lane) * 128;
        for (int d8 = 0; d8 < 16; ++d8) { float kf[8]; unpack8(*(const u32x4*)(kp + d8 * 8), kf);
#pragma unroll
            for (int r = 0; r < 4; ++r) { float a = 0.f;
#pragma unroll
                for (int jj = 0; jj < 8; ++jj) a += qs[r * 128 + d8 * 8 + jj] * kf[jj];
                sc[r] += a; } } }
    const unsigned long long vm = __ballot(valid);
    if (vm == 0ull) return;
#pragma unroll
    for (int r = 0; r < 4; ++r) { const float sv = valid ? sc[r] * scale : -INFINITY; const float mt = wave_max(sv), mn = fmaxf(S.m[r], mt);
        const float alpha = __expf(S.m[r] - mn), p = valid ? __expf(sv - mn) : 0.f;
        S.l[r] = S.l[r] * alpha + wave_sum(p); S.o[r][0] *= alpha; S.o[r][1] *= alpha; S.m[r] = mn; pt[r * 64 + lane] = p; }
    LDS_WAIT(); asm volatile("" ::: "memory");
    for (int k = 0; k < 64; ++k) { if (!((vm >> k) & 1ull)) continue; const bf16* vp = Vt_ + (size_t)(key0 + k) * 128; const float v0 = bf2f(vp[lane]), v1 = bf2f(vp[64 + lane]);
#pragma unroll
        for (int r = 0; r < 4; ++r) { const float p = pt[r * 64 + k]; S.o[r][0] += p * v0; S.o[r][1] += p * v1; } }
    LDS_WAIT(); asm volatile("" ::: "memory");
}
__device__ __forceinline__ void phase_selwin_naive(const Ctx& C, bf16* OCAT) {
    const bf16* QR = ARP(bf16, A_QROT); const float* GATES = ARP(float, A_GATES); const float* OACC = ARP(float, A_OACC);
    const unsigned long long* SELM = ARP(const unsigned long long, A_SELMASK);
    const bf16* KS = (const bf16*)(C.ws + WS_ARENA + A_KV6 + 2 * KV6_STRIDE); const bf16* VS = (const bf16*)(C.ws + WS_ARENA + A_KV6 + 3 * KV6_STRIDE);
    const bf16* KW = (const bf16*)(C.ws + WS_ARENA + A_KV6 + 4 * KV6_STRIDE); const bf16* VW = (const bf16*)(C.ws + WS_ARENA + A_KV6 + 5 * KV6_STRIDE);
    LAS float* qs = (LAS float*)C.lds + C.wave * 768; LAS float* pt = qs + 512; const int lane = C.lane;
    for (int it = C.gw; it < T * 4; it += C.ngw) { const int t = it >> 2, g = it & 3, b = t >> 12, s = t & 4095; const size_t slab = (size_t)(b * 4 + g) * SPAD * 128;
#pragma unroll
        for (int r = 0; r < 4; ++r) { const bf16* qp = QR + (((size_t)(b * 16 + g * 4 + r)) * SEQ + s) * 128; qs[r * 128 + lane] = bf2f(qp[lane]); qs[r * 128 + 64 + lane] = bf2f(qp[64 + lane]); }
        LDS_WAIT(); asm volatile("" ::: "memory");
        float res[4][2];
#pragma unroll
        for (int r = 0; r < 4; ++r) { res[r][0] = OACC[(size_t)t * DM + (g * 4 + r) * 128 + lane]; res[r][1] = OACC[(size_t)t * DM + (g * 4 + r) * 128 + 64 + lane]; }
        { NaiveAttnState S;
#pragma unroll
          for (int r = 0; r < 4; ++r) { S.m[r] = -1e30f; S.l[r] = 0.f; S.o[r][0] = 0.f; S.o[r][1] = 0.f; }
          const unsigned long long m = SELM[(size_t)t * 4 + g];
          for (int blk = 0; blk <= (s >> 6); ++blk) if ((m >> blk) & 1ull) naive_tile(S, qs, pt, KS + slab, VS + slab, blk * 64, blk * 64 + lane <= s, lane);
#pragma unroll
          for (int r = 0; r < 4; ++r) { const float gt = GATES[(size_t)t * 48 + 16 + g * 4 + r], inv = S.l[r] > 0.f ? 1.f / S.l[r] : 0.f; res[r][0] += gt * S.o[r][0] * inv; res[r][1] += gt * S.o[r][1] * inv; } }
        { NaiveAttnState S;
#pragma unroll
          for (int r = 0; r < 4; ++r) { S.m[r] = -1e30f; S.l[r] = 0.f; S.o[r][0] = 0.f; S.o[r][1] = 0.f; }
          const int lo = s - 511 > 0 ? s - 511 : 0;
          for (int k0 = lo & ~63; k0 <= s; k0 += 64) naive_tile(S, qs, pt, KW + slab, VW + slab, k0, (k0 + lane >= lo) && (k0 + lane <= s), lane);
#pragma unroll
          for (int r = 0; r < 4; ++r) { const float gt = GATES[(size_t)t * 48 + 32 + g * 4 + r], inv = S.l[r] > 0.f ? 1.f / S.l[r] : 0.f; res[r][0] += gt * S.o[r][0] * inv; res[r][1] += gt * S.o[r][1] * inv; } }
#pragma unroll
        for (int r = 0; r < 4; ++r) { bf16* op = OCAT + (size_t)t * DM + (g * 4 + r) * 128; op[lane] = (bf16)f2bf(res[r][0]); op[64 + lane] = (bf16)f2bf(res[r][1]); }
    }
}


namespace swa {
constexpr int D = 128, NW = 8, QBLK = 32, KVBLK = 64, QB = NW * QBLK;
constexpr int SHM_V = KVBLK * D * 2, SHM_K = KVBLK * D * 2;
constexpr int LDS_BYTES = 2 * SHM_V + 2 * SHM_K + NW * 64 * 4;
constexpr float SCALE = 0.08838834764831845f, THR = 8.f;
typedef short s16x4 __attribute__((ext_vector_type(4)));
typedef float f32x16 __attribute__((ext_vector_type(16)));
#define KSWZ(row, colB) ((row) * 256 + ((colB) ^ (((row) & 7) << 4)))
#define SBAR() __builtin_amdgcn_sched_barrier(0)
__device__ __forceinline__ int v_st(int k, int c) { const int kk = (k & ~0xC) | ((k & 4) << 1) | ((k & 8) >> 1); return ((kk >> 3) * 4 + (c >> 5)) * 512 + ((kk & 7) * 32 + (c & 31)) * 2; }
__device__ __forceinline__ int v_rd_base(int lane) { return ((lane & 3) << 3) | (((lane >> 2) & 3) << 6) | (((lane >> 4) & 1) << 5) | (((lane >> 5) & 1) << 8); }
constexpr int v_rd_off(int d0, int ks, int half) { return d0 * 512 + ks * 4096 + half * 2048; }
__device__ __forceinline__ int crow(int r, int hi) { return (r & 3) + 8 * (r >> 2) + 4 * hi; }
__device__ __forceinline__ unsigned cvtpk(float lo, float hi) { unsigned r; asm volatile("v_cvt_pk_bf16_f32 %0, %1, %2" : "=v"(r) : "v"(lo), "v"(hi)); return r; }
__device__ __forceinline__ bf16x8 load8(const bf16* p) { return *reinterpret_cast<const bf16x8*>(p); }
__device__ __forceinline__ void mask_tile(f32x16& p0, f32x16& p1, int dq, unsigned W) {
    const float NEG = -__builtin_inff();
    asm volatile("" : "+v"(dq));
#pragma unroll
    for (int r = 0; r < 16; ++r) { const int c = (r & 3) + 8 * (r >> 2);
        if ((unsigned)(dq - c) >= W) p0[r] = NEG;
        if ((unsigned)(dq - c - 32) >= W) p1[r] = NEG; }
}
__device__ __forceinline__ void mask_all(f32x16& p0, f32x16& p1, bool on) {
    const float NEG = -__builtin_inff();
#pragma unroll
    for (int r = 0; r < 16; ++r) { p0[r] = on ? p0[r] : NEG; p1[r] = on ? p1[r] : NEG; }
}
__device__ __forceinline__ void partialSM(f32x16& p0, f32x16& p1, float& m_reg, float& mn, float& alpha) {
    float pmax = p0[0]; for (int r = 1; r < 16; ++r) pmax = fmaxf(pmax, p0[r]); for (int r = 0; r < 16; ++r) pmax = fmaxf(pmax, p1[r]);
    { auto rr = __builtin_amdgcn_permlane32_swap(__float_as_uint(pmax), __float_as_uint(pmax), false, false);
      pmax = fmaxf(__uint_as_float(rr[0]), __uint_as_float(rr[1])); }
    constexpr float C2 = 1.4426950408889634f * SCALE;
    if (__builtin_expect(__all((pmax - m_reg) * SCALE <= THR), 1)) { mn = m_reg; alpha = 1.f; }
    else { mn = fmaxf(m_reg, pmax); alpha = __builtin_amdgcn_exp2f((m_reg - mn) * C2); m_reg = mn; }
    const float mnL = -mn * C2;
    for (int r = 0; r < 16; ++r) p0[r] = fmaf(p0[r], C2, mnL); for (int r = 0; r < 16; ++r) p1[r] = fmaf(p1[r], C2, mnL);
    for (int r = 0; r < 16; ++r) p0[r] = __builtin_amdgcn_exp2f(p0[r]);
}
__device__ __forceinline__ void finishSM(f32x16& p0, f32x16& p1, float alpha, float& l_reg, bf16x8& pa0, bf16x8& pa1, bf16x8& pa2, bf16x8& pa3) {
    for (int r = 0; r < 16; ++r) p1[r] = __builtin_amdgcn_exp2f(p1[r]);
    float ps = 0; for (int r = 0; r < 16; ++r) ps += p0[r]; for (int r = 0; r < 16; ++r) ps += p1[r];
    { auto rr = __builtin_amdgcn_permlane32_swap(__float_as_uint(ps), __float_as_uint(ps), false, false);
      ps = __uint_as_float(rr[0]) + __uint_as_float(rr[1]); }
    l_reg = l_reg * alpha + ps;
#define PK4(P, B_, OUT) do { unsigned a0 = cvtpk(P[B_+0], P[B_+1]), a1 = cvtpk(P[B_+2], P[B_+3]);                          \
        unsigned b0 = cvtpk(P[B_+4], P[B_+5]), b1 = cvtpk(P[B_+6], P[B_+7]);                                             \
        auto r0 = __builtin_amdgcn_permlane32_swap(a0, b0, false, false); auto r1 = __builtin_amdgcn_permlane32_swap(a1, b1, false, false); \
        u32x4 w = {r0[0], r1[0], r0[1], r1[1]}; OUT = *reinterpret_cast<bf16x8*>(&w); } while (0)
    PK4(p0, 0, pa0); PK4(p0, 8, pa1); PK4(p1, 0, pa2); PK4(p1, 8, pa3);
#undef PK4
}
template <int KB>
__device__ __forceinline__ void qkt(f32x16& p0, f32x16& p1, const char* K_lds, int r32, int hi, const bf16x8* qr) {
    p0 = f32x16{}; p1 = f32x16{};
    const char* kb[4];
#pragma unroll
    for (int dd = 0; dd < 4; ++dd) kb[dd] = K_lds + KB * SHM_K + KSWZ(r32, (dd * 16 + hi * 8) * 2);
#pragma unroll
    for (int d0 = 0; d0 < 8; ++d0) { const char* a = kb[d0 & 3] + (d0 >> 2) * 128;
        bf16x8 b0 = *reinterpret_cast<const bf16x8*>(a);
        bf16x8 b1 = *reinterpret_cast<const bf16x8*>(a + 32 * 256);
        p0 = __builtin_amdgcn_mfma_f32_32x32x16_bf16(b0, qr[d0], p0, 0, 0, 0);
        p1 = __builtin_amdgcn_mfma_f32_32x32x16_bf16(b1, qr[d0], p1, 0, 0, 0); }
}
template <int VB>
__device__ __forceinline__ void pv_tile(f32x16* o, int vb0, bf16x8 pa0, bf16x8 pa1, bf16x8 pa2, bf16x8 pa3) {
#define TRRD(dst, off) asm volatile("ds_read_b64_tr_b16 %0, %1 offset:%2" : "=&v"(dst) : "v"(vb0), "i"(off) : "memory")
#define PV_D0(d0) do { s16x4 l0, l1, l2, l3, h0, h1, h2, h3; constexpr int b_ = VB * SHM_V + v_rd_off(d0, 0, 0);   \
        TRRD(l0, b_); TRRD(h0, b_ + 2048); TRRD(l1, b_ + 4096); TRRD(h1, b_ + 6144); TRRD(l2, b_ + 8192); TRRD(h2, b_ + 10240); TRRD(l3, b_ + 12288); TRRD(h3, b_ + 14336); \
        asm volatile("s_waitcnt lgkmcnt(0)" ::: "memory"); SBAR();   \
        o[d0] = __builtin_amdgcn_mfma_f32_32x32x16_bf16(pa0, (bf16x8){l0[0], l0[1], l0[2], l0[3], h0[0], h0[1], h0[2], h0[3]}, o[d0], 0, 0, 0);   \
        o[d0] = __builtin_amdgcn_mfma_f32_32x32x16_bf16(pa1, (bf16x8){l1[0], l1[1], l1[2], l1[3], h1[0], h1[1], h1[2], h1[3]}, o[d0], 0, 0, 0);   \
        o[d0] = __builtin_amdgcn_mfma_f32_32x32x16_bf16(pa2, (bf16x8){l2[0], l2[1], l2[2], l2[3], h2[0], h2[1], h2[2], h2[3]}, o[d0], 0, 0, 0);   \
        o[d0] = __builtin_amdgcn_mfma_f32_32x32x16_bf16(pa3, (bf16x8){l3[0], l3[1], l3[2], l3[3], h3[0], h3[1], h3[2], h3[3]}, o[d0], 0, 0, 0); } while (0)
    PV_D0(0); PV_D0(1); PV_D0(2); PV_D0(3);
#undef PV_D0
#undef TRRD
}
struct BlockRef { const bf16* Q; const bf16* K; const bf16* V; int P0, tok0, hh; };
struct Seam { bf16x8 qr[8]; bf16x8 st_v0, st_v1, st_k0, st_k1; };
__device__ __forceinline__ int swa_jlo(int P0, int W) { const int lowk = P0 - W + 1; return lowk > 0 ? lowk / KVBLK : 0; }
#define ROW(p, k0, rr) ((p) + (size_t)((k0) + (rr)) * D + sc)
#define VMW() asm volatile("s_waitcnt vmcnt(0)" ::: "memory")
#define VMWN(n) asm volatile("s_waitcnt vmcnt(%0)" :: "i"(n) : "memory")
#define SLOAD_H(Kp, Vp, k0) do { S.st_v0 = load8(ROW(Vp, k0, sr)); S.st_v1 = load8(ROW(Vp, k0, 32 + sr));              \
                         S.st_k0 = load8(ROW(Kp, k0, sr)); S.st_k1 = load8(ROW(Kp, k0, 32 + sr)); } while (0)
#define SWRITE_HK(bf) do { *(bf16x8*)(K_lds + (bf) * SHM_K + kws) = S.st_k0; *(bf16x8*)(K_lds + (bf) * SHM_K + kws + 32 * 256) = S.st_k1; } while (0)
#define SWRITE_HV(bf) do { *(bf16x8*)(V_lds + (bf) * SHM_V + vst0) = S.st_v0; *(bf16x8*)(V_lds + (bf) * SHM_V + vst1) = S.st_v1; } while (0)
#define SWRITE_H(bf) do { SWRITE_HV(bf); SWRITE_HK(bf); } while (0)
__device__ __forceinline__ int lane_id() { return (int)__builtin_amdgcn_mbcnt_hi(~0u, __builtin_amdgcn_mbcnt_lo(~0u, 0u)); }
__device__ __forceinline__ void prime(const BlockRef& cur, int W, char* lds, Seam& S, int wid) {
    (void)wid; const int tid = threadIdx.x, lane = tid & 63, r32 = lane & 31, hi = lane >> 5;
    const int sr = tid >> 4, sc = (tid & 15) * 8, kws = KSWZ(sr, sc * 2); char* K_lds = lds + 2 * SHM_V;
    const int kb0 = swa_jlo(cur.P0, W) * KVBLK;
    for (int d0 = 0; d0 < 8; ++d0) S.qr[d0] = load8(cur.Q + (size_t)(wid * QBLK + r32) * D + d0 * 16 + hi * 8);
    SLOAD_H(cur.K, cur.V, kb0); VMW(); SWRITE_HK(0);
    __syncthreads();
}
template <bool SEL, int MODE>
__device__ __forceinline__ void block(const BlockRef& cur, const BlockRef& nxt, int skv, int W, char* lds, Seam& S,
                                      const unsigned long long* SELM, const float* GATES, int gate_off, float* OACC, bf16* OCAT, int wid) {
    (void)wid; const int tid = threadIdx.x, lane = tid & 63, r32 = lane & 31, hi = lane >> 5;
    const int j_lo = swa_jlo(cur.P0, W);
    int j_hi = (cur.P0 + QB - 1) / KVBLK + 1; if (j_hi > skv / KVBLK) j_hi = skv / KVBLK;
    const int NT = j_hi - j_lo;
    const int kbn = swa_jlo(nxt.P0, W) * KVBLK;
    const int qlo = cur.P0 + wid * QBLK, qm = qlo + r32 - 4 * hi;
    char* V_lds = lds; char* K_lds = lds + 2 * SHM_V;
    float* ws = (float*)(lds + 2 * SHM_V + 2 * SHM_K) + wid * 64; float* li_l = ws, * al_l = ws + 32;
    float m_reg = -1e30f, l_reg = 0; f32x16 o[4] = {};
    const int sr = tid >> 4, sc = (tid & 15) * 8, vst0 = v_st(sr, sc), vst1 = v_st(32 + sr, sc), kws = KSWZ(sr, sc * 2);
    const int vb0 = (int)(uintptr_t)V_lds + v_rd_base(lane);
    const bf16* Kh = cur.K; const bf16* Vh = cur.V;
    unsigned long long* selt = (unsigned long long*)(lds + LDS_BYTES) + wid * 32;
    if (SEL) { if (hi == 0) selt[r32] = SELM[(size_t)(cur.tok0 + wid * QBLK + r32) * 4 + (cur.hh >> 2)]; }
#define RESC(a) do { if (__any((a) < 1.f)) { if (hi == 0) al_l[r32] = (a); asm volatile("s_waitcnt lgkmcnt(0)" ::: "memory");              \
                     for (int d_ = 0; d_ < 4; ++d_) for (int r = 0; r < 16; ++r) o[d_][r] *= al_l[crow(r, hi)]; } } while (0)
#define KBASE(t) ((j_lo + (t)) * KVBLK)
#define MASKT(P0_, P1_, t) do { const int kb_ = KBASE(t); if (kb_ + KVBLK - 1 > qlo || kb_ <= qlo + QBLK - 1 - W) mask_tile(P0_, P1_, qm - kb_, (unsigned)W); \
                                if (SEL) { const unsigned long long sm_ = selt[r32]; mask_all(P0_, P1_, ((sm_ >> (j_lo + (t))) & 1ull) != 0ull); } } while (0)
    constexpr int NQL = 8;
#define SEAM_K0() do { VMWN(NQL); SWRITE_HK(0); SBAR(); } while (0)
    f32x16 pA0, pA1, pB0, pB1; float mnA, mnB, alA, alB; bf16x8 pa0, pa1, pa2, pa3;
    SWRITE_HV(0); SBAR();
    if (NT > 1) { SLOAD_H(Kh, Vh, KBASE(1)); }
    SBAR(); qkt<0>(pA0, pA1, K_lds, r32, hi, S.qr);
    MASKT(pA0, pA1, 0); partialSM(pA0, pA1, m_reg, mnA, alA);
    if (NT > 1) { VMW(); SWRITE_H(1); }
    __syncthreads();
#define HALF_STEP(PX0, PX1, mnX, alX, PY0, PY1, alY, t, KB, VB, SB) do {                                                      \
        SBAR(); qkt<KB>(PX0, PX1, K_lds, r32, hi, S.qr);                                             \
        finishSM(PY0, PY1, alY, l_reg, pa0, pa1, pa2, pa3); SBAR();                                                           \
        if ((t) + 1 < NT) { SLOAD_H(Kh, Vh, KBASE((t) + 1)); SBAR(); }                                               \
        pv_tile<VB>(o, vb0, pa0, pa1, pa2, pa3); MASKT(PX0, PX1, (t)); partialSM(PX0, PX1, m_reg, mnX, alX);                                        \
        __syncthreads();                                                                                                      \
        if ((t) + 1 < NT) { VMW(); SWRITE_H(SB); }                                                                          \
        RESC(alX); __syncthreads(); } while (0)
    for (int t = 1; t + 1 < NT; t += 2) {
        HALF_STEP(pB0, pB1, mnB, alB, pA0, pA1, alA, t, 1, 0, 0);
        HALF_STEP(pA0, pA1, mnA, alA, pB0, pB1, alB, t + 1, 0, 1, 1);
    }
    const bool even = (NT & 1) == 0;
    if (even) { SBAR(); qkt<1>(pB0, pB1, K_lds, r32, hi, S.qr); SBAR(); }
    SLOAD_H(nxt.K, nxt.V, kbn); SBAR();
#pragma unroll
    for (int d0 = 0; d0 < 8; ++d0) S.qr[d0] = load8(nxt.Q + (size_t)(wid * QBLK + r32) * D + d0 * 16 + hi * 8);
    SBAR();
    finishSM(pA0, pA1, alA, l_reg, pa0, pa1, pa2, pa3); SBAR();
    pv_tile<0>(o, vb0, pa0, pa1, pa2, pa3);
    if (even) { MASKT(pB0, pB1, NT - 1); partialSM(pB0, pB1, m_reg, mnB, alB); __syncthreads(); RESC(alB);
        finishSM(pB0, pB1, alB, l_reg, pa0, pa1, pa2, pa3); SBAR(); pv_tile<1>(o, vb0, pa0, pa1, pa2, pa3); }
    SBAR(); SEAM_K0();
    if (hi == 0) li_l[r32] = l_reg; asm volatile("s_waitcnt lgkmcnt(0)" ::: "memory");
    { const int le = lane_id(), r32e = le & 31, hie = le >> 5;
      const int tokw = cur.tok0 + wid * QBLK; const float* gp = GATES + (size_t)tokw * 48 + gate_off + cur.hh;
      float* op = OACC + (size_t)tokw * DM + cur.hh * 128; bf16* cp = OCAT + (size_t)tokw * DM + cur.hh * 128;
#pragma unroll
      for (int r = 0; r < 16; ++r) { const int orow = crow(r, hie);
        const float sc_ = gp[orow * 48] * __builtin_amdgcn_rcpf(li_l[orow]);
        const unsigned ob = (unsigned)(orow * DM + r32e);
#pragma unroll
        for (int d0 = 0; d0 < 4; ++d0) { const float v = op[ob + d0 * 32] + o[d0][r] * sc_;
            if (MODE == 0) op[ob + d0 * 32] = v;
            else cp[ob + d0 * 32] = (bf16)(cvtpk(v, v) & 0xffffu); } } }
    __syncthreads();
#undef RESC
#undef KBASE
#undef MASKT
#undef SEAM_K0
#undef HALF_STEP
}
#undef ROW
#undef VMW
#undef VMWN
#undef SLOAD_H
#undef SWRITE_HK
#undef SWRITE_HV
#undef SWRITE_H
__device__ __forceinline__ int swa_nramp(int nqb, int W) { const int t = W - 1; const int n = t < 0 ? 0 : t / QB + 1; return n > nqb ? nqb : n; }
struct SwaItem { int bh, qb0, qb1; };
__device__ __forceinline__ SwaItem swa_decode(int L, int nqb, int nx, int nramp) {
    SwaItem it; it.bh = L / nx; const int x = L - it.bh * nx; const int ns = nqb - nramp;
    if (x < ns) { it.qb0 = it.qb1 = nqb - 1 - x; } else { it.qb0 = x - ns; it.qb1 = nramp - 1 - it.qb0; }
    return it;
}
template <bool SEL, int MODE>
__device__ __forceinline__ void phase(int wid, char* lds, const bf16* Q, const bf16* K, const bf16* V, int W, const unsigned long long* SELM, const float* GATES, int gate_off, float* OACC, bf16* OCAT) {
    constexpr int nqb = SEQ / QB;
    const int nramp = swa_nramp(nqb, W), nx = (nramp + 1) / 2 + (nqb - nramp), total = nx * BATCH * 16, stride = gridDim.x;
    int L = blockIdx.x; if (L >= total) return;
    auto mkref = [&](const SwaItem& it, int pass) { const int qb = pass ? it.qb1 : it.qb0, b = it.bh >> 4, hh = it.bh & 15; BlockRef r;
        r.Q = Q + ((size_t)it.bh * SEQ + (size_t)qb * QB) * D; r.K = K + (size_t)(b * 4 + (hh >> 2)) * SPAD * D; r.V = V + (size_t)(b * 4 + (hh >> 2)) * SPAD * D;
        r.P0 = qb * QB; r.tok0 = b * SEQ + qb * QB; r.hh = hh; return r; };
    SwaItem it = swa_decode(L, nqb, nx, nramp); int pass = 0;
    BlockRef cur = mkref(it, 0);
    Seam S;
    __syncthreads();
    prime(cur, W, lds, S, wid);
    for (;;) {
        const bool more_pass = pass == 0 && it.qb1 != it.qb0, more_item = L + stride < total, last = !more_pass && !more_item;
        SwaItem itn = it; int passn = pass + 1, Ln = L;
        if (!more_pass) { passn = 0; Ln = more_item ? L + stride : L; itn = swa_decode(Ln, nqb, nx, nramp); }
        const BlockRef nxt = last ? cur : mkref(itn, passn);
        block<SEL, MODE>(cur, nxt, SEQ, W, lds, S, SELM, GATES, gate_off, OACC, OCAT, wid);
        if (last) break;
        cur = nxt; it = itn; pass = passn; L = Ln;
    }
}
#undef KSWZ
#undef SBAR
}

#ifndef PROBE
#define PROBE 0
#endif
__device__ __forceinline__ void probe_compare(const Ctx& C, const bf16* Xa, const bf16* Xb, size_t n) {
    float se = 0.f, sr = 0.f;
    for (size_t i = (size_t)C.bid * NTHR + C.tid; i < n; i += (size_t)C.G * NTHR) { const float a = bf2f(Xa[i]), b = bf2f(Xb[i]); se += (a - b) * (a - b); sr += b * b; }
    se = wave_sum(se); sr = wave_sum(sr);
    if (C.lane == 0) { atomicAdd(WSP(float, WS_CTL) + CW_PROBE, se); atomicAdd(WSP(float, WS_CTL) + CW_PROBE + 1, sr); }
}
#ifndef MK_SPLIT
#define MK_SPLIT 0
#endif
constexpr int N_PHASES = 37;
#define COMMON_PHASES(l, pb) \
      \
    if (IN(pb + 0)) { phase_norm(C, WSP(float, WS_XR), INP(I_NORM_CROSS) + l * DM, WSP(bf16, WS_XN)); } SEAM(pb + 0); \
    if (IN(pb + 1)) { pg8::Gemm g{WSP(bf16, WS_XN), WSP(bf16, WS_WKT) + (size_t)l * 4 * 1024 * DM, DM, DM, DM}; \
                      CrossOrder S{4, G, c, 1024, (long long)256 * DM * 2, (long long)256 * DM * 2, (long long)1024 * DM * 2}; EpiStoreF32 E{ARP(float, A_SC), 1024}; pg8::gemm_phase(L, g, S, E, C.tid); } SEAM(pb + 1); \
    if (IN(pb + 2)) { phase_softmax256(C); } SEAM(pb + 2); \
    if (IN(pb + 3)) { pg8::Gemm g{ARP(bf16, A_PC), WSP(bf16, WS_VWT) + (size_t)l * 4 * DM * 1024, 1024, 1024, 1024}; \
                      CrossOrder S{8, G, c, DM, (long long)256 * 1024 * 2, (long long)256 * 1024 * 2, (long long)DM * 1024 * 2}; EpiResid E{WSP(float, WS_XR), WSP(float, WS_XR), DM}; pg8::gemm_phase(L, g, S, E, C.tid); } SEAM(pb + 3); \
      \
    if (IN(pb + 4)) { phase_norm(C, WSP(float, WS_XR), INP(I_NORM_FFN) + l * DM, WSP(bf16, WS_XN)); } SEAM(pb + 4); \
    if (IN(pb + 5)) { pg8::Gemm g{WSP(bf16, WS_XN), WSP(bf16, WS_W_ROUTER) + (size_t)l * 256 * DM, DM, DM, DM}; pg8::DenseOrder S; S.init(T, 256, DM, DM, 256, G, c); EpiStoreF32 E{ARP(float, A_LOGIT), 256}; pg8::gemm_phase(L, g, S, E, C.tid); } SEAM(pb + 5); \
    if (IN(pb + 6)) { phase_route(C, A, l); } SEAM(pb + 6); \
    if (IN(pb + 7)) { phase_gather(C, l); } SEAM(pb + 7); \
    if (IN(pb + 8)) { LAS int* tab = (LAS int*)(C.lds + LDS_AUX); moe_build_table(C, ctl + CW_MOE_CNT + l * 64, tab); \
                      pg8::Gemm g{ARP(bf16, A_XS), WSP(bf16, WS_W_GU) + (size_t)l * NEXP * 1024 * DM, DM, DM, DM}; MoeOrder S{tab, 4, G, c, 0}; EpiHid E{ARP(bf16, A_HID)}; pg8::gemm_phase(L, g, S, E, C.tid); } SEAM(pb + 8); \
    if (IN(pb + 9)) { LAS int* tab = (LAS int*)(C.lds + LDS_AUX); moe_build_table(C, ctl + CW_MOE_CNT + l * 64, tab); \
                      pg8::Gemm g{ARP(bf16, A_HID), WSP(bf16, WS_W_DN) + (size_t)l * NEXP * DM * FF, FF, FF, FF}; MoeOrder S{tab, 8, G, c, 1}; EpiMoeDown E{ARP(int, A_ROWSLOT), ARP(float, A_WTS), ARP(bf16, A_YE)}; pg8::gemm_phase(L, g, S, E, C.tid); } SEAM(pb + 9); \
    if (IN(pb + 10)) { if (l == 0) phase_combine_norm(C, INP(I_NORM_MIX) + DM, WSP(bf16, WS_XN), nullptr); else phase_combine_norm(C, INP(I_NORM_FINAL), nullptr, ((float*)INP(N_INPUTS))); } \
    if (l == 0) SEAM(pb + 10);

__global__ void __launch_bounds__(NTHR, 2) mk_fwd(Args args) {
    extern __shared__ __attribute__((aligned(16))) unsigned char lds_raw[];
    Ctx C; C.lds = (LAS unsigned char*)lds_raw; C.tid = threadIdx.x; C.lane = C.tid & 63; C.wave = __builtin_amdgcn_readfirstlane(C.tid >> 6);
    C.G = gridDim.x; C.bid = blockIdx.x; C.gw = C.bid * NWAVES + C.wave; C.ngw = C.G * NWAVES; C.ws = args.ws;
    const Args& A = args; (void)A;
    volatile LAS unsigned* MISC = (volatile LAS unsigned*)(C.lds + LDS_MISC);
    if (C.tid < 64) MISC[C.tid] = 0u;
    if (C.tid <= N_INPUTS) ((LAS unsigned long long*)(C.lds + LDS_PTAB))[C.tid] = (C.tid < N_INPUTS) ? (unsigned long long)args.in[C.tid < N_INPUTS ? C.tid : 0] : (unsigned long long)args.out;
    __syncthreads();
    unsigned* ctl = WSP(unsigned, WS_CTL);
    const int lo = args.ph_lo, hi = args.ph_hi;
    XcdBarrier bar; bar.bar = ctl + CW_BAR; bar.x = 0; bar.st = MISC + 8;
    if (hi - lo > 1) bar = xcd_barrier_post(ctl + CW_BAR, MISC + 8);
#ifndef ONLY_PHASE
#define ONLY_PHASE -1
#endif
#define IN(k) ((ONLY_PHASE < 0 || ONLY_PHASE == (k)) && lo <= (k) && (k) < hi)
#define SEAM(k) do { if (IN(k) && IN((k) + 1)) xcd_barrier(bar); } while (0)
    LAS unsigned char* L = C.lds;
    const int c = C.bid, G = C.G;

    if (IN(0)) { phase_prologue(C, A); } SEAM(0);
    if (IN(1)) { pg8::Gemm g{WSP(bf16, WS_MEMN), WSP(bf16, WS_W_CAK), DM, DM, DM}; MemProjOrder S{G, c}; EpiStoreBf16 E{WSP(bf16, WS_KP), DM, 1.f}; pg8::gemm_phase(L, g, S, E, C.tid); } SEAM(1);
    if (IN(2)) {
        { pg8::Gemm g{WSP(bf16, WS_KP), WSP(bf16, WS_W_CAQ), DM, DM, 512}; WktOrder S{G, c}; EpiStoreBf16 E{WSP(bf16, WS_WKT), DM, 0.04419417382415922f}; pg8::gemm_phase(L, g, S, E, C.tid); }
        { pg8::Gemm g{WSP(bf16, WS_W_CAO), WSP(bf16, WS_VP), DM, DM, 512}; VwtOrder S{G, c}; EpiStoreBf16 E{WSP(bf16, WS_VWT), 1024, 1.f}; pg8::gemm_phase(L, g, S, E, C.tid); }
    } SEAM(2);
    if (IN(3)) { pg8::Gemm g{WSP(bf16, WS_XN), WSP(bf16, WS_W_ABIN), DM, DM, DM}; pg8::DenseOrder S; S.init(T, AB_PAD, DM, DM, AB_PAD, G, c); EpiAbIn E{ARP(bf16, A_PAB), ARP(float, A_GF32)}; pg8::gemm_phase(L, g, S, E, C.tid); } SEAM(3);
    if (IN(4)) { phase_mixer_prep(C, A); } SEAM(4);
    if (IN(5)) { pg8::Gemm g{ARP(bf16, A_LIN), WSP(bf16, WS_W_LORA), 256, 256, 256}; pg8::DenseOrder S; S.init(T, 3072, 256, 256, 3072, G, c);
                 EpiLora E{INP(I_RW_W0), INP(I_RW_A0), INP(I_RW_K_A), ARP(bf16, A_KK), ARP(bf16, A_KR), ARP(float, A_WD), ARP(bf16, A_BV), ARP(bf16, A_KP), ARP(bf16, A_GG)}; pg8::gemm_phase(L, g, S, E, C.tid); } SEAM(5);
    if (IN(6)) { for (int it = C.bid; it < 192; it += G) { if (it < 64) rwkv_scan_unit(C, A, it); else mlstm_unit(C, A, it - 64); } } SEAM(6);
    if (IN(7)) { pg8::Gemm g{ARP(bf16, A_YCAT), WSP(bf16, WS_W_ABOUT), DM, DM, DM}; pg8::DenseOrder S; S.init(T, DM, DM, DM, DM, G, c); EpiResid E{INP(I_X), WSP(float, WS_XR), DM}; pg8::gemm_phase(L, g, S, E, C.tid); } SEAM(7);
    COMMON_PHASES(0, 8)
    if (IN(19)) { pg8::Gemm g{WSP(bf16, WS_XN), WSP(bf16, WS_W_NSAIN), DM, DM, DM}; pg8::DenseOrder S; S.init(T, NSA_PAD, DM, DM, NSA_PAD, G, c);
                  EpiNsaIn E{ARP(bf16, A_Q), ARP(bf16, A_QROT), ARP(bf16, A_KV6), ARP(float, A_GATES), INP(I_NSA_GATE_B), WSP(float, WS_TAB + TAB_ROPE_COS), WSP(float, WS_TAB + TAB_ROPE_SIN)}; pg8::gemm_phase(L, g, S, E, C.tid); } SEAM(19);
    if (IN(20)) { pg8::Gemm g{ARP(bf16, A_KV6), WSP(bf16, WS_W_CMP1), 2048, 4096, 512}; CmpOrder S{G, c}; EpiStoreF32 E{ARP(float, A_CPART), 256}; pg8::gemm_phase(L, g, S, E, C.tid); } SEAM(20);
    if (IN(21)) { phase_cmp_finish(C, A); } SEAM(21);
    if (IN(22)) { phase_cmp_attn(C); } SEAM(22);
#if PROBE == 1
    if (IN(23)) { phase_selwin_naive(C, ARP(bf16, A_OCATREF)); xcd_barrier(bar); }
#endif
    if (IN(23)) { swa::phase<true, 0>(C.wave, (char*)lds_raw, ARP(bf16, A_QROT), (const bf16*)(C.ws + WS_ARENA + A_KV6 + 2 * KV6_STRIDE), (const bf16*)(C.ws + WS_ARENA + A_KV6 + 3 * KV6_STRIDE), SEQ,
                                      ARP(const unsigned long long, A_SELMASK), ARP(float, A_GATES), 16, ARP(float, A_OACC), ARP(bf16, A_OCAT)); } SEAM(23);
    if (IN(24)) { swa::phase<false, 1>(C.wave, (char*)lds_raw, ARP(bf16, A_QROT), (const bf16*)(C.ws + WS_ARENA + A_KV6 + 4 * KV6_STRIDE), (const bf16*)(C.ws + WS_ARENA + A_KV6 + 5 * KV6_STRIDE), 512,
                                       ARP(const unsigned long long, A_SELMASK), ARP(float, A_GATES), 32, ARP(float, A_OACC), ARP(bf16, A_OCAT)); } SEAM(24);
#if PROBE == 1
    if (IN(24)) { probe_compare(C, ARP(bf16, A_OCAT), ARP(bf16, A_OCATREF), (size_t)T * DM); }
#endif
    { int t2 = C.wave * 64 + swa::lane_id(); asm volatile("" : "+v"(t2)); C.tid = t2 & 511; C.lane = t2 & 63; }
    if (IN(25)) { pg8::Gemm g{ARP(bf16, A_OCAT), WSP(bf16, WS_W_NSAOUT), DM, DM, DM}; pg8::DenseOrder S; S.init(T, DM, DM, DM, DM, G, c); EpiResid E{WSP(float, WS_XR), WSP(float, WS_XR), DM}; pg8::gemm_phase(L, g, S, E, C.tid); } SEAM(25);
    COMMON_PHASES(1, 26)
#if PROBE
    xcd_barrier(bar);
    if (C.bid == 0 && C.tid == 0) { const float se = __hip_atomic_load((float*)(ctl + CW_PROBE), __ATOMIC_RELAXED, __HIP_MEMORY_SCOPE_AGENT), sr = __hip_atomic_load((float*)(ctl + CW_PROBE + 1), __ATOMIC_RELAXED, __HIP_MEMORY_SCOPE_AGENT);
        ((float*)INP(N_INPUTS))[0] = 1e6f * sqrtf(se / fmaxf(sr, 1e-30f)); }
#endif
#undef IN
#undef SEAM
}

extern "C" void kernel_launch(void* const* d_in, const int* in_sizes, int n_in, void* d_out, int out_size, void* d_ws, size_t ws_size, hipStream_t stream) {
    static int grid = 0;
    if (grid == 0) {
        if (n_in != N_INPUTS || out_size != T * DM || ws_size < WS_END) { fprintf(stderr, "kernel_launch: unexpected shapes (n_in %d, out %d, ws %zu, need %zu)\n", n_in, out_size, ws_size, (size_t)WS_END); grid = -1; return; }
        int dev = 0, cus = 0, per_cu = 0;
        if (hipGetDevice(&dev) != hipSuccess || hipDeviceGetAttribute(&cus, hipDeviceAttributeMultiprocessorCount, dev) != hipSuccess) { grid = -1; return; }
        if (hipFuncSetAttribute((const void*)mk_fwd, hipFuncAttributeMaxDynamicSharedMemorySize, LDS_BYTES) != hipSuccess) { fprintf(stderr, "kernel_launch: hipFuncSetAttribute failed\n"); grid = -1; return; }
        if (hipOccupancyMaxActiveBlocksPerMultiprocessor(&per_cu, (const void*)mk_fwd, NTHR, LDS_BYTES) != hipSuccess || per_cu < 1) fprintf(stderr, "kernel_launch: occupancy query says %d\n", per_cu);
        (void)hipGetLastError();
        grid = cus;
    }
    if (grid < 0) return;
    (void)hipMemsetAsync((char*)d_ws + WS_CTL, 0, CTL_BYTES, stream);
    Args a{};
    for (int i = 0; i < N_INPUTS; ++i) a.in[i] = (const float*)d_in[i];
    a.out = (float*)d_out; a.ws = (unsigned char*)d_ws;
#if MK_SPLIT
    for (int p = 0; p < N_PHASES; ++p) { a.ph_lo = p; a.ph_hi = p + 1; hipLaunchKernelGGL(mk_fwd, dim3(grid), dim3(NTHR), LDS_BYTES, stream, a); }
#else
    a.ph_lo = 0; a.ph_hi = N_PHASES; hipLaunchKernelGGL(mk_fwd, dim3(grid), dim3(NTHR), LDS_BYTES, stream, a);
#endif
}
```

```cpp
#include <hip/hip_runtime.h>
#include <cstdio>
#include <cstdint>

#define LAS __attribute__((address_space(3)))
#define GAS __attribute__((address_space(1)))
typedef unsigned short bf16;
typedef short bf16x8 __attribute__((ext_vector_type(8)));
typedef float f32x4 __attribute__((ext_vector_type(4)));
typedef float f32x2 __attribute__((ext_vector_type(2)));
typedef unsigned u32x4 __attribute__((ext_vector_type(4)));
typedef unsigned u32x2 __attribute__((ext_vector_type(2)));

constexpr int BATCH = 4, SEQ = 4096, DM = 2048, T = BATCH * SEQ, MEMT = 256, MT = BATCH * MEMT;
constexpr float EPS = 1e-6f;
constexpr int ML_COLS = 3080, RW_COLS = 3328, AB_COLS = 6408, AB_PAD = 6656;
constexpr int NSA_COLS = 5168, NSA_PAD = 5376;
constexpr int NEXP = 64, FF = 512;
constexpr int XS_ROWS = 49152;
constexpr int SPAD = SEQ + 64;

enum { I_X = 0, I_MEM, I_NORM_MIX, I_NORM_CROSS, I_NORM_MEM, I_NORM_FFN, I_NORM_FINAL, I_AB_W_IN, I_ML_CONV_W, I_ML_CONV_B, I_ML_GATE_B,
       I_RW_MU, I_RW_W0, I_RW_W_UP, I_RW_A0, I_RW_A_UP, I_RW_G_UP, I_RW_K_K, I_RW_K_A, I_RW_R_K, I_RW_LN_W, I_RW_LN_B, I_AB_W_OUT,
       I_NSA_W_IN, I_NSA_GATE_B, I_CMP_POS, I_CMP_W1, I_CMP_W2, I_NSA_W_OUT, I_CA_WQ, I_CA_WK, I_CA_WV, I_CA_WO,
       I_MOE_WG, I_MOE_BG, I_MOE_WE, I_MOE_BE, I_MOE_W_GATE, I_MOE_W_UP, I_MOE_W_DOWN, N_INPUTS };

constexpr size_t MiB = (size_t)1 << 20;
constexpr size_t WS_CTL = 0, CTL_BYTES = 1 * MiB;
constexpr size_t WS_TAB = 1 * MiB;
constexpr size_t WS_W_ABIN = 3 * MiB;
constexpr size_t WS_W_ABOUT = WS_W_ABIN + 26 * MiB;
constexpr size_t WS_W_LORA = WS_W_ABOUT + 8 * MiB;
constexpr size_t WS_W_NSAIN = WS_W_LORA + 2 * MiB;
constexpr size_t WS_W_NSAOUT = WS_W_NSAIN + 21 * MiB;
constexpr size_t WS_W_CMP1 = WS_W_NSAOUT + 8 * MiB;
constexpr size_t WS_W_CAQ = WS_W_CMP1 + 4 * MiB;
constexpr size_t WS_W_CAK = WS_W_CAQ + 16 * MiB;
constexpr size_t WS_W_CAV = WS_W_CAK + 16 * MiB;
constexpr size_t WS_W_CAO = WS_W_CAV + 16 * MiB;
constexpr size_t WS_W_ROUTER = WS_W_CAO + 16 * MiB;
constexpr size_t WS_W_GU = WS_W_ROUTER + 2 * MiB;
constexpr size_t WS_W_DN = WS_W_GU + 512 * MiB;
constexpr size_t WS_MEMN = WS_W_DN + 256 * MiB;
constexpr size_t WS_KP = WS_MEMN + 8 * MiB;
constexpr size_t WS_VP = WS_KP + 8 * MiB;
constexpr size_t WS_WKT = WS_VP + 8 * MiB;
constexpr size_t WS_VWT = WS_WKT + 32 * MiB;
constexpr size_t WS_XR = WS_VWT + 32 * MiB;
constexpr size_t WS_RSQ = WS_XR + 64 * MiB;
constexpr size_t WS_XN = WS_XR + 128 * MiB;
constexpr size_t WS_ARENA = WS_XN + 64 * MiB;
constexpr size_t A_PAB = 0;
constexpr size_t A_GF32 = A_PAB + 208 * MiB;
constexpr size_t A_QM = A_GF32 + 16 * MiB;
constexpr size_t A_KM = A_QM + 16 * MiB;
constexpr size_t A_IG = A_KM + 16 * MiB;
constexpr size_t A_LF = A_IG + 1 * MiB;
constexpr size_t A_MLA = A_LF + 256 * 1024, A_MLM = A_LF + 512 * 1024;
constexpr size_t A_RR = A_LF + 1 * MiB;
constexpr size_t A_KR = A_RR + 32 * MiB;
constexpr size_t A_VR = A_KR + 32 * MiB;
constexpr size_t A_KK = A_VR + 32 * MiB;
constexpr size_t A_LIN = A_KK + 32 * MiB;
constexpr size_t A_WD = A_LIN + 8 * MiB;
constexpr size_t A_BV = A_WD + 64 * MiB;
constexpr size_t A_KP = A_BV + 32 * MiB;
constexpr size_t A_GG = A_KP + 32 * MiB;
constexpr size_t A_YCAT = A_GG + 32 * MiB;
constexpr size_t A_RWM = A_YCAT + 64 * MiB;
constexpr size_t A_RWN = A_RWM + 32 * MiB, A_RWRW = A_RWN + 32 * MiB, A_RWYL = A_RWRW + 32 * MiB;
constexpr size_t A_MLKV = A_RWYL + 32 * MiB;
constexpr size_t A_MLNUM = A_MLKV + 68 * MiB;
constexpr size_t A_END0 = A_MLNUM + 34 * MiB;
constexpr size_t A_SC = 0;
constexpr size_t A_PC = A_SC + 64 * MiB;
constexpr size_t A_LOGIT = 0;
constexpr size_t A_EID = A_LOGIT + 16 * MiB;
constexpr size_t A_WTS = A_EID + 1 * MiB;
constexpr size_t A_ROWSLOT = A_WTS + 1 * MiB;
constexpr size_t A_LRANK = A_ROWSLOT + 256 * 1024, A_BHIST = A_ROWSLOT + 512 * 1024;
constexpr size_t A_XS = A_ROWSLOT + 1 * MiB;
constexpr size_t A_HID = A_XS + 192 * MiB;
constexpr size_t A_YE = A_HID + 48 * MiB;
constexpr size_t A_END2 = A_YE + 128 * MiB;
constexpr size_t A_Q = 0;
constexpr size_t A_QROT = A_Q + 64 * MiB;
constexpr size_t A_KV6 = A_QROT + 64 * MiB;
constexpr size_t KV6_STRIDE = 17 * MiB;
constexpr size_t A_GATES = A_KV6 + 6 * KV6_STRIDE;
constexpr size_t A_CPART = A_GATES + 4 * MiB;
constexpr size_t A_KCMP = A_CPART + 64 * MiB;
constexpr size_t A_VCMP = A_KCMP + 1 * MiB;
constexpr size_t A_SELMASK = A_VCMP + 1 * MiB;
constexpr size_t A_OACC = A_SELMASK + 1 * MiB;
constexpr size_t A_OCAT = A_OACC + 128 * MiB;
constexpr size_t A_OCATREF = A_OCAT + 64 * MiB;
constexpr size_t A_VCT = A_OCATREF + 64 * MiB;
constexpr size_t A_END3 = A_VCT + 1 * MiB;
constexpr size_t ARENA_BYTES = 860 * MiB;
static_assert(A_END0 <= ARENA_BYTES && A_END2 <= ARENA_BYTES && A_END3 <= ARENA_BYTES, "arena");
constexpr size_t WS_END = WS_ARENA + ARENA_BYTES;
static_assert(WS_END <= (size_t)2048 * MiB, "workspace");
constexpr size_t TAB_ROPE_COS = 0, TAB_ROPE_SIN = 256 * 1024, TAB_CMPBIAS = 512 * 1024, TAB_RSTD = 1024 * 1024;
constexpr int CW_BAR = 4096;
constexpr int CW_MOE_CNT = 16384;
constexpr int CW_MOE_CUR = 16384 + 256;
constexpr int CW_PROBE = 32768;
constexpr int CW_RSQ = 65536;

__device__ __forceinline__ float bf2f(bf16 v) { return __uint_as_float((unsigned)v << 16); }
__device__ __forceinline__ unsigned f2bf(float f) { unsigned u = __float_as_uint(f); return (u + 0x7fffu + ((u >> 16) & 1u)) >> 16; }
__device__ __forceinline__ unsigned pk2(float lo, float hi) { return f2bf(lo) | (f2bf(hi) << 16); }
__device__ __forceinline__ float lo_bf(unsigned w) { return __uint_as_float(w << 16); }
__device__ __forceinline__ float hi_bf(unsigned w) { return __uint_as_float(w & 0xffff0000u); }
__device__ __forceinline__ float sigmoidf_(float x) { return 1.f / (1.f + __expf(-x)); }
__device__ __forceinline__ float siluf_(float x) { return x / (1.f + __expf(-x)); }
#define DPPF(v, ctrl) __int_as_float(__builtin_amdgcn_update_dpp(0, __float_as_int(v), (ctrl), 0xf, 0xf, true))
#define DPP_XOR1 0xB1
#define DPP_XOR2 0x4E
#define DPP_HMIRROR 0x141
#define DPP_MIRROR 0x140
__device__ __forceinline__ float xor16f(float v) { const unsigned u = __float_as_uint(v); auto r = __builtin_amdgcn_permlane16_swap(u, u, false, false); return __uint_as_float(r[0] ^ r[1] ^ u); }
__device__ __forceinline__ float xor32f(float v) { const unsigned u = __float_as_uint(v); auto r = __builtin_amdgcn_permlane32_swap(u, u, false, false); return __uint_as_float(r[0] ^ r[1] ^ u); }
__device__ __forceinline__ float wave_sum(float v) {
    v += DPPF(v, DPP_XOR1); v += DPPF(v, DPP_XOR2); v += DPPF(v, DPP_HMIRROR); v += DPPF(v, DPP_MIRROR); v += xor16f(v); v += xor32f(v); return v;
}
__device__ __forceinline__ float wave_max(float v) {
    v = fmaxf(v, DPPF(v, DPP_XOR1)); v = fmaxf(v, DPPF(v, DPP_XOR2)); v = fmaxf(v, DPPF(v, DPP_HMIRROR)); v = fmaxf(v, DPPF(v, DPP_MIRROR)); v = fmaxf(v, xor16f(v)); v = fmaxf(v, xor32f(v)); return v;
}
__device__ __forceinline__ void unpack8(u32x4 w, float* f) {
    f[0] = lo_bf(w.x); f[1] = hi_bf(w.x); f[2] = lo_bf(w.y); f[3] = hi_bf(w.y); f[4] = lo_bf(w.z); f[5] = hi_bf(w.z); f[6] = lo_bf(w.w); f[7] = hi_bf(w.w);
}
__device__ __forceinline__ void st16_f(void* p, u32x4 w) { *(f32x4*)p = __builtin_bit_cast(f32x4, w); }
__device__ __forceinline__ void st8_f(void* p, u32x2 w) { *(f32x2*)p = __builtin_bit_cast(f32x2, w); }
__device__ __forceinline__ u32x4 pack8f(const float* f) { u32x4 w; w.x = pk2(f[0], f[1]); w.y = pk2(f[2], f[3]); w.z = pk2(f[4], f[5]); w.w = pk2(f[6], f[7]); return w; }

namespace pg8 {
constexpr int BM = 256, BK = 64, HALF = 128, HTB = HALF * BK * 2, STAGE_BYTES = 8 * HTB, NXCD = 8, WGM = 8;
__host__ __device__ __forceinline__ int lds_byte(int r, int c) { const int st = (r >> 4) * 2 + (c >> 5), rr = r & 15, cc = c & 31, ob = rr * 64 + cc * 2; return st * 1024 + (ob ^ (((ob >> 9) & 1) << 5)); }
__host__ __device__ __forceinline__ void stage_rc(int b, int& R, int& C) { const int st = b / 1024, sb = b % 1024, swz = sb ^ (((sb >> 9) & 1) << 5); R = (st >> 1) * 16 + swz / 64; C = (st & 1) * 32 + (swz % 64) / 2; }
__host__ __device__ __forceinline__ int perm32(int rho) { const int n = rho >> 4, i = rho & 15; return 8 * (i >> 2) + 4 * n + (i & 3); }

struct Unit { long long aoff, boff, coff; int pm, pn, aux; };
struct Gemm { const bf16* A; const bf16* Bt; int lda, ldb, K; };

__device__ __forceinline__ bool tile_of(long L, int nM, int nN, int& pm, int& pn) {
    const int nwg = nM * nN; if (L >= nwg) return false;
    int wgid = (int)L; { const int q = nwg / NXCD, r = nwg % NXCD, xcd = wgid % NXCD, off = wgid / NXCD; wgid = (xcd < r ? xcd * (q + 1) : r * (q + 1) + (xcd - r) * q) + off; }
    const int nig = WGM * nN, gid = wgid / nig, fm = gid * WGM, gsz = (nM - fm) < WGM ? (nM - fm) : WGM;
    pm = fm + ((wgid % nig) % gsz); pn = (wgid % nig) / gsz; return true;
}
struct DenseOrder {
    int nM, nN, G, c, ldc; long long astep, bstep;
    __device__ void init(int M, int N, int lda, int ldb, int ldc_, int G_, int c_) { nM = M / BM; nN = N / BM; G = G_; c = c_; ldc = ldc_; astep = (long long)BM * lda * 2; bstep = (long long)BM * ldb * 2; }
    __device__ __forceinline__ bool next(int i, Unit& u) const {
        int pm, pn; if (!tile_of((long)i * G + c, nM, nN, pm, pn)) return false;
        u.pm = pm; u.pn = pn; u.aux = 0; u.aoff = pm * astep; u.boff = pn * bstep; u.coff = (long long)pm * BM * ldc + pn * BM; return true;
    }
};

__device__ __forceinline__ unsigned cvt_pk_bf16(float lo, float hi) { unsigned r; asm volatile("v_cvt_pk_bf16_f32 %0, %1, %2" : "=v"(r) : "v"(lo), "v"(hi)); return r; }

template <class Epi, class Sched, bool GATHER = false>
__device__ __forceinline__ void gemm_phase(LAS unsigned char* lds, const Gemm g, const Sched& S, const Epi& E, int tid_, const LAS int* rowcache = nullptr) {
    __builtin_assume(tid_ >= 0 && tid_ < 512); const int tid = tid_, wid = __builtin_amdgcn_readfirstlane(tid >> 6), lane = tid & 63, wr = wid >> 2, wc = wid & 3, fr = lane & 15, fq = lane >> 4;
    int nt = g.K / BK; asm volatile("" : "+s"(nt));
    const size_t kstep = (size_t)(BK * 2);
    const size_t hstepA = (size_t)HALF * g.lda * 2, hstepB = (size_t)HALF * g.ldb * 2;
    unsigned vA0[2], vA1[2], vN0[2], vN1[2], voffB[2]; int Rr[2], Cb[2];
#pragma unroll
    for (int i = 0; i < 2; ++i) { int R, C; stage_rc(tid * 16 + i * 8192, R, C); const int Rb = (R & ~31) + perm32(R & 31); Rr[i] = R; Cb[i] = C * 2;
        vA0[i] = (unsigned)(R * g.lda + C) * 2u; vA1[i] = vA0[i] + (unsigned)hstepA; vN0[i] = vA0[i]; vN1[i] = vA1[i]; voffB[i] = (unsigned)(Rb * g.ldb + C) * 2u; }
#define PG8_GATHER(d0, d1, ui_) do { _Pragma("unroll") for (int _i = 0; _i < 2; ++_i) { d0[_i] = (unsigned)(rowcache[(ui_) * 256 + Rr[_i]] * g.lda * 2 + Cb[_i]); d1[_i] = (unsigned)(rowcache[(ui_) * 256 + 128 + Rr[_i]] * g.lda * 2 + Cb[_i]); } } while (0)
    if (GATHER) PG8_GATHER(vA0, vA1, 0);
    const unsigned ldsw = (unsigned)wid * 1024u;
    const int aoff = lds_byte(wr * 64 + fr, fq * 8), boff = lds_byte(wc * 32 + fr, fq * 8);
#define PG8_SA(b, h) (((b) * 2 + (h)) * HTB)
#define PG8_SB(b, h) ((4 + (b) * 2 + (h)) * HTB)
#define PG8_STAGE(bufoff, gbase, voff) do { _Pragma("unroll") for (int _i = 0; _i < 2; ++_i) \
        __builtin_amdgcn_global_load_lds((const unsigned*)((const char*)(gbase) + (voff)[_i]), (LAS unsigned*)(lds + (bufoff) + ldsw + _i * 8192), 16, 0, 0); } while (0)
#define PG8_LDA(dst, b, h) do { _Pragma("unroll") for (int m = 0; m < 4; ++m) _Pragma("unroll") for (int k = 0; k < 2; ++k) dst[m][k] = *(const LAS bf16x8*)(lds + PG8_SA(b, h) + aoff + m * 2048 + k * 1024); } while (0)
#define PG8_LDB(dst, b, h) do { _Pragma("unroll") for (int n = 0; n < 2; ++n) _Pragma("unroll") for (int k = 0; k < 2; ++k) dst[n][k] = *(const LAS bf16x8*)(lds + PG8_SB(b, h) + boff + n * 2048 + k * 1024); } while (0)
#define PG8_MMA(ai, bj, At, Bt) do { __builtin_amdgcn_s_setprio(1); _Pragma("unroll") for (int m = 0; m < 4; ++m) _Pragma("unroll") for (int n = 0; n < 2; ++n) _Pragma("unroll") for (int k = 0; k < 2; ++k) \
        acc[ai][bj][m][n] = __builtin_amdgcn_mfma_f32_16x16x32_bf16(Bt[n][k], At[m][k], acc[ai][bj][m][n], 0, 0, 0); __builtin_amdgcn_s_setprio(0); } while (0)
#define PG8_WAIT_V(n) asm volatile("s_waitcnt vmcnt(" #n ")" ::: "memory")
#define PG8_WAIT_L(n) asm volatile("s_waitcnt lgkmcnt(" #n ")" ::: "memory")
#define PG8_BAR __builtin_amdgcn_s_barrier()
#define PG8_SCHED __builtin_amdgcn_sched_barrier(0)
    Unit cur, nxt; int ui = 0;
    if (!S.next(0, cur)) return;
    f32x4 acc[2][2][4][2];
#pragma unroll
    for (int a = 0; a < 2; ++a)
#pragma unroll
        for (int b = 0; b < 2; ++b)
#pragma unroll
            for (int m = 0; m < 4; ++m)
#pragma unroll
                for (int n = 0; n < 2; ++n) acc[a][b][m][n] = (f32x4){0.f, 0.f, 0.f, 0.f};
    bf16x8 At[4][2], B0[2][2], B1[2][2];
    const char* cA = (const char*)g.A + cur.aoff; const char* cB = (const char*)g.Bt + cur.boff;
    PG8_STAGE(PG8_SB(0, 0), cB, voffB); PG8_STAGE(PG8_SB(0, 1), cB + hstepB, voffB); PG8_STAGE(PG8_SA(0, 0), cA, vA0); PG8_STAGE(PG8_SA(0, 1), cA, vA1);
    if (wr == 1) PG8_BAR;
    PG8_WAIT_V(2); PG8_BAR;
    PG8_STAGE(PG8_SB(1, 0), cB + kstep, voffB); PG8_STAGE(PG8_SA(1, 0), cA + kstep, vA0); PG8_STAGE(PG8_SB(1, 1), cB + hstepB + kstep, voffB);
    PG8_WAIT_V(6); PG8_BAR;
    for (;;) {
        const bool has_next = S.next(ui + 1, nxt);
        const char* nA = has_next ? (const char*)g.A + nxt.aoff : cA; const char* nB = has_next ? (const char*)g.Bt + nxt.boff : cB;
        if (GATHER) { if (has_next) PG8_GATHER(vN0, vN1, ui + 1); else { vN0[0] = vA0[0]; vN0[1] = vA0[1]; vN1[0] = vA1[0]; vN1[1] = vA1[1]; } }
        for (int t = 0; t < nt; t += 2) {
            const bool last = (t == nt - 2);
            const char* a1 = cA + (size_t)(t + 1) * kstep;
            const char* a2 = last ? nA : cA + (size_t)(t + 2) * kstep; const char* b2 = last ? nB : cB + (size_t)(t + 2) * kstep;
            const char* a3 = a2 + kstep; const char* b3 = b2 + kstep;
            unsigned w0[2], w1[2];
            if (GATHER) { w0[0] = last ? vN0[0] : vA0[0]; w0[1] = last ? vN0[1] : vA0[1]; w1[0] = last ? vN1[0] : vA1[0]; w1[1] = last ? vN1[1] : vA1[1]; } else { w0[0] = vA0[0]; w0[1] = vA0[1]; w1[0] = vA1[0]; w1[1] = vA1[1]; }
            PG8_LDB(B0, 0, 0); PG8_LDB(B1, 0, 1); PG8_SCHED; PG8_LDA(At, 0, 0); PG8_STAGE(PG8_SA(1, 1), a1, vA1);
            PG8_WAIT_V(8); PG8_WAIT_L(0); PG8_BAR; PG8_MMA(0, 0, At, B0); PG8_MMA(0, 1, At, B1); PG8_BAR; PG8_SCHED;
            PG8_LDA(At, 0, 1); PG8_STAGE(PG8_SB(0, 0), b2, voffB); PG8_STAGE(PG8_SB(0, 1), b2 + hstepB, voffB); PG8_STAGE(PG8_SA(0, 0), a2, w0);
            PG8_WAIT_V(8); PG8_WAIT_L(0); PG8_BAR; PG8_MMA(1, 0, At, B0); PG8_MMA(1, 1, At, B1); PG8_BAR; PG8_SCHED;
            PG8_LDB(B0, 1, 0); PG8_LDB(B1, 1, 1); PG8_SCHED; PG8_LDA(At, 1, 0); PG8_STAGE(PG8_SA(0, 1), a2, w1);
            PG8_WAIT_V(8); PG8_WAIT_L(0); PG8_BAR; PG8_MMA(0, 0, At, B0); PG8_MMA(0, 1, At, B1); PG8_BAR; PG8_SCHED;
            PG8_LDA(At, 1, 1); PG8_STAGE(PG8_SB(1, 0), b3, voffB); PG8_STAGE(PG8_SB(1, 1), b3 + hstepB, voffB); PG8_STAGE(PG8_SA(1, 0), a3, w0);
            PG8_WAIT_V(8); PG8_WAIT_L(0); PG8_BAR; PG8_MMA(1, 0, At, B0); PG8_MMA(1, 1, At, B1); PG8_BAR; PG8_SCHED;
        }
        if (wr == 0) PG8_BAR;
        E(acc, cur, wr, wc, fr, fq);
        if (!has_next) break;
#pragma unroll
        for (int a = 0; a < 2; ++a)
#pragma unroll
            for (int b = 0; b < 2; ++b)
#pragma unroll
                for (int m = 0; m < 4; ++m)
#pragma unroll
                    for (int n = 0; n < 2; ++n) acc[a][b][m][n] = (f32x4){0.f, 0.f, 0.f, 0.f};
        cur = nxt; cA = nA; cB = nB; ++ui;
        if (GATHER) { vA0[0] = vN0[0]; vA0[1] = vN0[1]; vA1[0] = vN1[0]; vA1[1] = vN1[1]; }
        if (wr == 1) PG8_BAR;
    }
    PG8_WAIT_V(0);
    PG8_BAR;
#undef PG8_SA
#undef PG8_SB
#undef PG8_STAGE
#undef PG8_GATHER
#undef PG8_LDA
#undef PG8_LDB
#undef PG8_MMA
#undef PG8_WAIT_V
#undef PG8_WAIT_L
#undef PG8_BAR
#undef PG8_SCHED
}
}

#define XB_TMO      128
#define XB_XCNT(j)  (256  + 64 * (j))
#define XB_XSUB(j)  (1280 + 64 * (j))
#define XB_XGEN(j)  (2304 + 64 * (j))
#define XB_TOP      3328
#define XB_TOPGEN   3392
#define XCD_BAR_WORDS 3456
#define XB_SPIN_CAP (1u << 22)
__device__ __forceinline__ unsigned xb_ld(unsigned* p)              { return __hip_atomic_load(p, __ATOMIC_RELAXED, __HIP_MEMORY_SCOPE_AGENT); }
__device__ __forceinline__ unsigned xb_add(unsigned* p, unsigned v) { return __hip_atomic_fetch_add(p, v, __ATOMIC_RELAXED, __HIP_MEMORY_SCOPE_AGENT); }
__device__ __forceinline__ unsigned xb_xcc_id() { return (unsigned)__builtin_amdgcn_s_getreg((3 << 11) | 20) & 0xFu; }
#define XB_SPIN(cond, bar) do { unsigned _sp = 0; while (cond) { __builtin_amdgcn_s_sleep(1); \
    if ((++_sp & 255u) == 0u) { if (xb_ld(&(bar)[XB_TMO])) break; if (_sp > XB_SPIN_CAP) { atomicAdd(&(bar)[XB_TMO], 1u); break; } } } } while (0)
struct XcdBarrier { unsigned* bar; unsigned x; volatile LAS unsigned* st; };
__device__ __forceinline__ XcdBarrier xcd_barrier_post(unsigned* bar, volatile LAS unsigned* st) {
    XcdBarrier b; b.bar = bar; b.x = xb_xcc_id(); b.st = st;
    if (threadIdx.x == 0) (void)xb_add(&bar[XB_XCNT(b.x)], 1u);
    return b;
}
__device__ __forceinline__ void xcd_barrier_complete(unsigned* bar, unsigned x, unsigned& nloc, unsigned& nx) {
    const unsigned G = gridDim.x * gridDim.y * gridDim.z;
    unsigned sum, cnt, mine, sp = 0u;
    for (;;) {
        sum = 0u; cnt = 0u; mine = 0u;
#pragma unroll
        for (unsigned j = 0; j < 16; ++j) { const unsigned c = xb_ld(&bar[XB_XCNT(j)]); sum += c; cnt += (c > 0u) ? 1u : 0u; mine = (j == x) ? c : mine; }
        if (sum == G) break;
        __builtin_amdgcn_s_sleep(1);
        if ((++sp & 255u) == 0u) { if (xb_ld(&bar[XB_TMO])) break; if (sp > XB_SPIN_CAP) { atomicAdd(&bar[XB_TMO], 1u); break; } }
    }
    nloc = mine > 0u ? mine : 1u; nx = cnt > 0u ? cnt : 1u;
}
__device__ __forceinline__ void xcd_barrier(const XcdBarrier& b) {
    asm volatile("s_waitcnt vmcnt(0)" ::: "memory");
    __syncthreads();
    if (threadIdx.x == 0) {
        unsigned* bar = b.bar;
        __builtin_amdgcn_s_waitcnt(0);
        unsigned nloc = b.st[0], nx = b.st[1];
        if (nloc == 0u) { xcd_barrier_complete(bar, b.x, nloc, nx); b.st[0] = nloc; b.st[1] = nx; }
        const unsigned old = xb_add(&bar[XB_XSUB(b.x)], 1u);
        const unsigned gen = old / nloc;
        if (old + 1u == (gen + 1u) * nloc) {
            __builtin_amdgcn_fence(__ATOMIC_RELEASE, "agent");
            asm volatile("s_waitcnt vmcnt(0)" ::: "memory");
            const unsigned og = xb_add(&bar[XB_TOP], 1u);
            const unsigned tg = og / nx;
            if (og + 1u == (tg + 1u) * nx) xb_add(&bar[XB_TOPGEN], 1u);
            else XB_SPIN(xb_ld(&bar[XB_TOPGEN]) == tg, bar);
            __builtin_amdgcn_fence(__ATOMIC_ACQUIRE, "agent");
            xb_add(&bar[XB_XGEN(b.x)], 1u);
            asm volatile("s_waitcnt vmcnt(0)" ::: "memory");
        } else {
            XB_SPIN(xb_ld(&bar[XB_XGEN(b.x)]) == gen, bar);
            __builtin_amdgcn_fence(__ATOMIC_ACQUIRE, "agent");
            asm volatile("s_waitcnt vmcnt(0)" ::: "memory");
        }
    }
    __syncthreads();
}

constexpr int NWAVES = 8, NTHR = 512;
constexpr int LDS_MAIN = 131072;
constexpr int LDS_AUX = 131072, LDS_AUX_BYTES = 16384;
constexpr int LDS_MISC = LDS_AUX + LDS_AUX_BYTES;
constexpr int LDS_PTAB = LDS_MISC + 256;
constexpr int LDS_BYTES = LDS_MISC + 1024;
struct Args { const float* in[N_INPUTS]; float* out; unsigned char* ws; int ph_lo, ph_hi; };

struct Ctx {
    LAS unsigned char* lds;
    int tid, lane, wave, G, bid, gw, ngw;
    unsigned char* ws;
};
__device__ __forceinline__ const float* lds_inp(LAS unsigned char* lds, int i) {
    const LAS unsigned* p = (const LAS unsigned*)(lds + LDS_PTAB) + 2 * i;
    const unsigned lo = __builtin_amdgcn_readfirstlane(p[0]), hi = __builtin_amdgcn_readfirstlane(p[1]);
    return (const float*)(const GAS float*)(((unsigned long long)hi << 32) | lo);
}
#define INP(i) lds_inp(C.lds, (i))
#define WSP(T_, off) ((T_*)(C.ws + (off)))
#define ARP(T_, off) ((T_*)(C.ws + WS_ARENA + (off)))
#define LDS_WAIT() asm volatile("s_waitcnt lgkmcnt(0)" ::: "memory")

__device__ __forceinline__ void rms_row_bf16(const float* xrow, const float* gain, bf16* orow, int lane) {
    f32x4 v[8]; float s = 0.f;
#pragma unroll
    for (int j = 0; j < 8; ++j) { v[j] = *(const f32x4*)(xrow + (j * 64 + lane) * 4); s += v[j].x * v[j].x + v[j].y * v[j].y + v[j].z * v[j].z + v[j].w * v[j].w; }
    const float rstd = rsqrtf(wave_sum(s) * (1.f / DM) + EPS);
#pragma unroll
    for (int j = 0; j < 8; ++j) { const f32x4 g = *(const f32x4*)(gain + (j * 64 + lane) * 4);
        u32x2 w; w.x = pk2(v[j].x * rstd * g.x, v[j].y * rstd * g.y); w.y = pk2(v[j].z * rstd * g.z, v[j].w * rstd * g.w);
        *(u32x2*)(orow + (j * 64 + lane) * 4) = w; }
}

template <int NT, class F>
__device__ __forceinline__ void transpose_tiles(const float* W, int ldw, int nvalid, int k0, int n0, bf16* WT, int ldt, F drow, int lane, const float* kscale) {
    const int g = lane >> 3, c = lane & 7; f32x4 v[NT][8];
#pragma unroll
    for (int q = 0; q < NT; ++q) { const int n = n0 + 32 * q + 4 * c; const bool ok = n < nvalid;
#pragma unroll
        for (int j = 0; j < 8; ++j) v[q][j] = ok ? *(const f32x4*)(W + (size_t)(k0 + 8 * g + j) * ldw + n) : (f32x4){0.f, 0.f, 0.f, 0.f}; }
    f32x4 ka = (f32x4){1.f, 1.f, 1.f, 1.f}, kb = ka;
    if (kscale) { ka = *(const f32x4*)(kscale + k0 + 8 * g); kb = *(const f32x4*)(kscale + k0 + 8 * g + 4); }
#pragma unroll
    for (int q = 0; q < NT; ++q) { const int n = n0 + 32 * q + 4 * c;
#pragma unroll
        for (int i = 0; i < 4; ++i) { u32x4 o; o.x = pk2(v[q][0][i] * ka.x, v[q][1][i] * ka.y); o.y = pk2(v[q][2][i] * ka.z, v[q][3][i] * ka.w); o.z = pk2(v[q][4][i] * kb.x, v[q][5][i] * kb.y); o.w = pk2(v[q][6][i] * kb.z, v[q][7][i] * kb.w);
            *(u32x4*)(WT + (size_t)drow(n + i) * ldt + k0 + 8 * g) = o; } }
}
template <class F>
__device__ __forceinline__ void transpose_tile(const float* W, int ldw, int nvalid, int k0, int n0, bf16* WT, int ldt, F drow, LAS float* scr, int lane, const float* kscale = nullptr) {
    (void)scr; transpose_tiles<1>(W, ldw, nvalid, k0, n0, WT, ldt, drow, lane, kscale);
}
template <class F>
__device__ __forceinline__ void transpose_matrix(const Ctx& C, const float* W, int K, int N, int Npad, bf16* WT, int ldt, F drow, LAS float* scr, const float* kscale = nullptr) {
    const int nblk = Npad / 32, items = (K / 64) * nblk;
    for (int it = C.gw; it < items; it += C.ngw) { const int kb = it / nblk, nb = it % nblk; transpose_tile(W, N, N, kb * 64, nb * 32, WT, ldt, drow, scr, C.lane, kscale); }
}

#define EPI_ARGS const f32x4 (&acc)[2][2][4][2], const pg8::Unit& u, int wr, int wc, int fr, int fq
struct EpiStoreBf16 {
    bf16* O; int ldc; float scale;
    __device__ __forceinline__ void operator()(EPI_ARGS) const {
        bf16* base = O + u.coff + (size_t)(wr * 64 + fr) * ldc + wc * 32 + 8 * fq;
#pragma unroll
        for (int ai = 0; ai < 2; ++ai)
#pragma unroll
            for (int m = 0; m < 4; ++m) { bf16* rowp = base + (size_t)(ai * 128 + m * 16) * ldc;
#pragma unroll
                for (int bj = 0; bj < 2; ++bj) { const f32x4 v0 = acc[ai][bj][m][0] * scale, v1 = acc[ai][bj][m][1] * scale;
                    u32x4 w; w.x = pg8::cvt_pk_bf16(v0[0], v0[1]); w.y = pg8::cvt_pk_bf16(v0[2], v0[3]); w.z = pg8::cvt_pk_bf16(v1[0], v1[1]); w.w = pg8::cvt_pk_bf16(v1[2], v1[3]);
                    *(u32x4*)(rowp + bj * 128) = w; } }
    }
};
struct EpiStoreF32 {
    float* O; int ldc;
    __device__ __forceinline__ void operator()(EPI_ARGS) const {
        float* base = O + u.coff + (size_t)(wr * 64 + fr) * ldc + wc * 32 + 8 * fq;
#pragma unroll
        for (int ai = 0; ai < 2; ++ai)
#pragma unroll
            for (int m = 0; m < 4; ++m) { float* rowp = base + (size_t)(ai * 128 + m * 16) * ldc;
#pragma unroll
                for (int bj = 0; bj < 2; ++bj) { *(f32x4*)(rowp + bj * 128) = acc[ai][bj][m][0]; *(f32x4*)(rowp + bj * 128 + 4) = acc[ai][bj][m][1]; } }
    }
};
template <bool BASE_F32> struct EpiResidT {
    const void* base; bf16* out; int ldc; float* rsq; LAS float* xch;
    __device__ __forceinline__ void operator()(EPI_ARGS) const {
        const size_t o0 = (size_t)u.coff + (size_t)(wr * 64 + fr) * ldc + wc * 32 + 8 * fq;
        u32x4 braw[BASE_F32 ? 1 : 16];
        if (!BASE_F32) {
#pragma unroll
            for (int ai = 0; ai < 2; ++ai)
#pragma unroll
                for (int m = 0; m < 4; ++m)
#pragma unroll
                    for (int bj = 0; bj < 2; ++bj) braw[(ai * 4 + m) * 2 + bj] = *(const u32x4*)((const bf16*)base + o0 + (size_t)(ai * 128 + m * 16) * ldc + bj * 128); }
#pragma unroll
        for (int ai = 0; ai < 2; ++ai)
#pragma unroll
            for (int m = 0; m < 4; ++m) { const size_t o = o0 + (size_t)(ai * 128 + m * 16) * ldc; float ssq = 0.f;
#pragma unroll
                for (int bj = 0; bj < 2; ++bj) { float bv[8];
                    if (BASE_F32) { const f32x4 b0 = *(const f32x4*)((const float*)base + o + bj * 128), b1 = *(const f32x4*)((const float*)base + o + bj * 128 + 4);
                        bv[0] = b0[0]; bv[1] = b0[1]; bv[2] = b0[2]; bv[3] = b0[3]; bv[4] = b1[0]; bv[5] = b1[1]; bv[6] = b1[2]; bv[7] = b1[3]; }
                    else unpack8(braw[BASE_F32 ? 0 : (ai * 4 + m) * 2 + bj], bv);
#pragma unroll
                    for (int j = 0; j < 4; ++j) { bv[j] += acc[ai][bj][m][0][j]; bv[4 + j] += acc[ai][bj][m][1][j]; }
                    const u32x4 w = pack8f(bv); *(u32x4*)(out + o + bj * 128) = w; float rf[8]; unpack8(w, rf);
#pragma unroll
                    for (int j = 0; j < 8; ++j) ssq += rf[j] * rf[j]; }
                ssq += xor16f(ssq); ssq += xor32f(ssq);
                if (fq == 0) xch[(ai * 128 + wr * 64 + m * 16 + fr) * 4 + wc] = ssq; }
        asm volatile("s_waitcnt lgkmcnt(0)" ::: "memory"); __builtin_amdgcn_s_barrier(); asm volatile("" ::: "memory");
        if (wc == 0 && fq == 0) {
#pragma unroll
            for (int ai = 0; ai < 2; ++ai)
#pragma unroll
                for (int m = 0; m < 4; ++m) { const int r = ai * 128 + wr * 64 + m * 16 + fr; const f32x4 p = *(const LAS f32x4*)(xch + r * 4); rsq[(size_t)(u.pm * 256 + r) * 8 + u.pn] = (p[0] + p[1]) + (p[2] + p[3]); } }
    }
};
__device__ __forceinline__ float rstd_of(float ssq) { return rsqrtf(ssq * (1.f / DM) + EPS); }
__device__ __forceinline__ float rstd_row(const float* rs8, int row) { const f32x4 a = *(const f32x4*)(rs8 + (size_t)row * 8), b = *(const f32x4*)(rs8 + (size_t)row * 8 + 4); return rstd_of(((a.x + a.y) + (a.z + a.w)) + ((b.x + b.y) + (b.z + b.w))); }
struct EpiStoreF32Rows {
    float* O; int ldc; const float* rs;
    __device__ __forceinline__ void operator()(EPI_ARGS) const {
        float* base = O + u.coff + (size_t)(wr * 64 + fr) * ldc + wc * 32 + 8 * fq; const int rp = u.pm * 256 + wr * 64 + fr;
#pragma unroll
        for (int ai = 0; ai < 2; ++ai)
#pragma unroll
            for (int m = 0; m < 4; ++m) { float* rowp = base + (size_t)(ai * 128 + m * 16) * ldc; const float r_ = rstd_row(rs, rp + ai * 128 + m * 16);
#pragma unroll
                for (int bj = 0; bj < 2; ++bj) { *(f32x4*)(rowp + bj * 128) = acc[ai][bj][m][0] * r_; *(f32x4*)(rowp + bj * 128 + 4) = acc[ai][bj][m][1] * r_; } }
    }
};
struct EpiSoftmaxP {
    bf16* P; int ldc; const float* rs; LAS float* xch;
    __device__ __forceinline__ void operator()(f32x4 (&acc)[2][2][4][2], const pg8::Unit& u, int wr, int wc, int fr, int fq) const {
#pragma unroll
        for (int ai = 0; ai < 2; ++ai)
#pragma unroll
            for (int m = 0; m < 4; ++m) { const int r = ai * 128 + wr * 64 + m * 16 + fr; const float r_ = rstd_row(rs, u.pm * 256 + r); float mx = -INFINITY;
#pragma unroll
                for (int bj = 0; bj < 2; ++bj)
#pragma unroll
                    for (int n = 0; n < 2; ++n) { acc[ai][bj][m][n] = acc[ai][bj][m][n] * r_;
#pragma unroll
                        for (int j = 0; j < 4; ++j) mx = fmaxf(mx, acc[ai][bj][m][n][j]); }
                mx = fmaxf(mx, xor16f(mx)); mx = fmaxf(mx, xor32f(mx)); if (fq == 0) xch[r * 4 + wc] = mx; }
        asm volatile("s_waitcnt lgkmcnt(0)" ::: "memory"); __builtin_amdgcn_s_barrier(); asm volatile("" ::: "memory");
#pragma unroll
        for (int ai = 0; ai < 2; ++ai)
#pragma unroll
            for (int m = 0; m < 4; ++m) { const int r = ai * 128 + wr * 64 + m * 16 + fr; const f32x4 mv = *(const LAS f32x4*)(xch + r * 4); const float mx = fmaxf(fmaxf(mv[0], mv[1]), fmaxf(mv[2], mv[3])); float sm_ = 0.f;
#pragma unroll
                for (int bj = 0; bj < 2; ++bj)
#pragma unroll
                    for (int n = 0; n < 2; ++n)
#pragma unroll
                        for (int j = 0; j < 4; ++j) { const float e = __expf(acc[ai][bj][m][n][j] - mx); acc[ai][bj][m][n][j] = e; sm_ += e; }
                sm_ += xor16f(sm_); sm_ += xor32f(sm_); if (fq == 0) xch[1024 + r * 4 + wc] = sm_; }
        asm volatile("s_waitcnt lgkmcnt(0)" ::: "memory"); __builtin_amdgcn_s_barrier(); asm volatile("" ::: "memory");
        bf16* base = P + u.coff + (size_t)(wr * 64 + fr) * ldc + wc * 32 + 8 * fq;
#pragma unroll
        for (int ai = 0; ai < 2; ++ai)
#pragma unroll
            for (int m = 0; m < 4; ++m) { const int r = ai * 128 + wr * 64 + m * 16 + fr; const f32x4 sv = *(const LAS f32x4*)(xch + 1024 + r * 4); const float inv = 1.f / ((sv[0] + sv[1]) + (sv[2] + sv[3]));
                bf16* rowp = base + (size_t)(ai * 128 + m * 16) * ldc;
#pragma unroll
                for (int bj = 0; bj < 2; ++bj) { const f32x4 v0 = acc[ai][bj][m][0] * inv, v1 = acc[ai][bj][m][1] * inv;
                    u32x4 w; w.x = pg8::cvt_pk_bf16(v0[0], v0[1]); w.y = pg8::cvt_pk_bf16(v0[2], v0[3]); w.z = pg8::cvt_pk_bf16(v1[0], v1[1]); w.w = pg8::cvt_pk_bf16(v1[2], v1[3]);
                    *(u32x4*)(rowp + bj * 128) = w; } }
    }
};
struct EpiAbIn {
    bf16* P; float* G32;
    __device__ __forceinline__ void operator()(EPI_ARGS) const {
        const int row0 = u.pm * 256 + wr * 64 + fr, col0 = u.pn * 256 + wc * 32 + 8 * fq;
#pragma unroll
        for (int ai = 0; ai < 2; ++ai)
#pragma unroll
            for (int m = 0; m < 4; ++m) { const int row = row0 + ai * 128 + m * 16; bf16* rowp = P + (size_t)row * AB_PAD + col0;
#pragma unroll
                for (int bj = 0; bj < 2; ++bj) { const f32x4 v0 = acc[ai][bj][m][0], v1 = acc[ai][bj][m][1];
                    u32x4 w; w.x = pg8::cvt_pk_bf16(v0[0], v0[1]); w.y = pg8::cvt_pk_bf16(v0[2], v0[3]); w.z = pg8::cvt_pk_bf16(v1[0], v1[1]); w.w = pg8::cvt_pk_bf16(v1[2], v1[3]);
                    *(u32x4*)(rowp + bj * 128) = w;
                    if (u.pn == 12) { float* g = G32 + (size_t)row * 256 + wc * 32 + 8 * fq + bj * 128; *(f32x4*)g = v0; *(f32x4*)(g + 4) = v1; } } }
    }
};
struct EpiLora {
    const float *w0, *a0, *k_a; const bf16 *KK, *KR; float* WD; bf16 *BV, *KP, *GG;
    __device__ __forceinline__ void operator()(EPI_ARGS) const {
        const int grp = u.pn >> 2, row0 = u.pm * 256 + wr * 64 + fr, cc0 = (u.pn & 3) * 256 + wc * 32 + 8 * fq;
#pragma unroll
        for (int ai = 0; ai < 2; ++ai)
#pragma unroll
            for (int m = 0; m < 4; ++m) { const size_t ro = (size_t)(row0 + ai * 128 + m * 16) * 1024;
#pragma unroll
                for (int bj = 0; bj < 2; ++bj) { const int cc = cc0 + bj * 128; float v[8];
#pragma unroll
                    for (int j = 0; j < 4; ++j) { v[j] = acc[ai][bj][m][0][j]; v[4 + j] = acc[ai][bj][m][1][j]; }
                    if (grp == 0) { float o[8]; const f32x4 p0 = *(const f32x4*)(w0 + cc), p1 = *(const f32x4*)(w0 + cc + 4); const float pw[8] = {p0.x, p0.y, p0.z, p0.w, p1.x, p1.y, p1.z, p1.w};
#pragma unroll
                        for (int j = 0; j < 8; ++j) o[j] = -0.6065306597126334f * sigmoidf_(pw[j] + v[j]);
                        *(f32x4*)(WD + ro + cc) = (f32x4){o[0], o[1], o[2], o[3]}; *(f32x4*)(WD + ro + cc + 4) = (f32x4){o[4], o[5], o[6], o[7]};
                    } else if (grp == 1) { float kk[8], kr[8], ob[8], ok[8];
                        unpack8(*(const u32x4*)(KK + ro + cc), kk); unpack8(*(const u32x4*)(KR + ro + cc), kr);
                        const f32x4 p0 = *(const f32x4*)(a0 + cc), p1 = *(const f32x4*)(a0 + cc + 4), q0 = *(const f32x4*)(k_a + cc), q1 = *(const f32x4*)(k_a + cc + 4);
                        const float pa[8] = {p0.x, p0.y, p0.z, p0.w, p1.x, p1.y, p1.z, p1.w}, qa[8] = {q0.x, q0.y, q0.z, q0.w, q1.x, q1.y, q1.z, q1.w};
#pragma unroll
                        for (int j = 0; j < 8; ++j) { const float a = sigmoidf_(pa[j] + v[j]); ob[j] = kk[j] * a; ok[j] = kr[j] * (1.f + (a - 1.f) * qa[j]); }
                        st16_f(BV + ro + cc, pack8f(ob)); st16_f(KP + ro + cc, pack8f(ok));
                    } else { st16_f(GG + ro + cc, pack8f(v)); } } }
    }
};
struct EpiHid {
    bf16* H; const int* rowslot; const float* rs;
    __device__ __forceinline__ void operator()(EPI_ARGS) const {
        bf16* base = H + (size_t)(u.aux + wr * 64 + fr) * FF + u.pn * 128 + wc * 32 + 8 * fq;
#pragma unroll
        for (int ai = 0; ai < 2; ++ai)
#pragma unroll
            for (int m = 0; m < 4; ++m) { float h[8]; const int r = ai * 128 + wr * 64 + m * 16 + fr; const float r_ = (r < u.pm) ? rstd_row(rs, rowslot[u.aux + r] >> 1) : 0.f;
#pragma unroll
                for (int j = 0; j < 4; ++j) { h[j] = siluf_(acc[ai][0][m][0][j] * r_) * (acc[ai][1][m][0][j] * r_); h[4 + j] = siluf_(acc[ai][0][m][1][j] * r_) * (acc[ai][1][m][1][j] * r_); }
                *(u32x4*)(base + (size_t)(ai * 128 + m * 16) * FF) = pack8f(h); }
    }
};
struct EpiMoeDown {
    const int* rowslot; const float* wts; bf16* YE;
    __device__ __forceinline__ void operator()(EPI_ARGS) const {
#pragma unroll
        for (int ai = 0; ai < 2; ++ai)
#pragma unroll
            for (int m = 0; m < 4; ++m) { const int r = ai * 128 + wr * 64 + m * 16 + fr;
                if (r < u.pm) { const int slot = rowslot[u.aux + r]; const float w = wts[slot]; bf16* rowp = YE + (size_t)slot * DM + u.pn * 256 + wc * 32 + 8 * fq;
#pragma unroll
                    for (int bj = 0; bj < 2; ++bj) { const f32x4 v0 = acc[ai][bj][m][0] * w, v1 = acc[ai][bj][m][1] * w;
                        u32x4 o; o.x = pg8::cvt_pk_bf16(v0[0], v0[1]); o.y = pg8::cvt_pk_bf16(v0[2], v0[3]); o.z = pg8::cvt_pk_bf16(v1[0], v1[1]); o.w = pg8::cvt_pk_bf16(v1[2], v1[3]);
                        *(u32x4*)(rowp + bj * 128) = o; } } }
    }
};
struct EpiNsaIn {
    bf16 *Q, *QROT, *KV6; float* GATES; const float *gate_b, *rcos, *rsin, *rs;
    __device__ __forceinline__ void operator()(EPI_ARGS) const {
        const int pn = u.pn;
#pragma unroll
        for (int ai = 0; ai < 2; ++ai)
#pragma unroll
            for (int m = 0; m < 4; ++m) { const int t = u.pm * 256 + ai * 128 + wr * 64 + m * 16 + fr, b = t >> 12, s = t & 4095; const float r_ = rstd_row(rs, t);
#pragma unroll
                for (int bj = 0; bj < 2; ++bj) { float v[8];
#pragma unroll
                    for (int j = 0; j < 4; ++j) { v[j] = acc[ai][bj][m][0][j] * r_; v[4 + j] = acc[ai][bj][m][1][j] * r_; }
                    const int d0 = wc * 32 + 8 * fq;
                    if (pn == 20) {
                        const int c = bj * 128 + d0;
                        if (c < 48) { float o[8];
#pragma unroll
                            for (int j = 0; j < 8; ++j) o[j] = sigmoidf_(v[j] + gate_b[c + j]);
                            float* g = GATES + (size_t)t * 48 + c; *(f32x4*)g = (f32x4){o[0], o[1], o[2], o[3]}; *(f32x4*)(g + 4) = (f32x4){o[4], o[5], o[6], o[7]}; }
                        continue; }
                    float vr[8];
#pragma unroll
                    for (int j = 0; j < 8; ++j) vr[j] = v[j];
                    if (wc == 0) { float pv[8];
#pragma unroll
                      for (int j = 0; j < 8; ++j) pv[j] = xor32f(v[j]);
                      const f32x4 c0 = *(const f32x4*)(rcos + s * 16 + 8 * (fq & 1)), c1 = *(const f32x4*)(rcos + s * 16 + 8 * (fq & 1) + 4), s0 = *(const f32x4*)(rsin + s * 16 + 8 * (fq & 1)), s1 = *(const f32x4*)(rsin + s * 16 + 8 * (fq & 1) + 4);
                      const float cs[8] = {c0.x, c0.y, c0.z, c0.w, c1.x, c1.y, c1.z, c1.w}, sn[8] = {s0.x, s0.y, s0.z, s0.w, s1.x, s1.y, s1.z, s1.w};
#pragma unroll
                      for (int j = 0; j < 8; ++j) vr[j] = (fq < 2) ? (v[j] * cs[j] - pv[j] * sn[j]) : (v[j] * cs[j] + pv[j] * sn[j]); }
                    if (pn < 8) { const int hh = pn * 2 + bj; const size_t o = (((size_t)(b * 16 + hh)) * SEQ + s) * 128 + d0;
                        *(u32x4*)(Q + o) = pack8f(v); *(u32x4*)(QROT + o) = pack8f(vr);
                    } else { const int i6 = (pn - 8) >> 1, g = ((pn - 8) & 1) * 2 + bj; const bool rot = (i6 == 2 || i6 == 4) && wc == 0;
                        bf16* dst = (bf16*)((unsigned char*)KV6 + (size_t)i6 * KV6_STRIDE) + (((size_t)(b * 4 + g)) * SPAD + s) * 128 + d0;
                        *(u32x4*)dst = rot ? pack8f(vr) : pack8f(v); } } }
    }
};

constexpr int MOE_CVT_TOTAL = 2 * NEXP * 3 * 512, MOE_CVT_SIDE_A = 0, MOE_CVT_SIDE_B = 24000, MOE_CVT_WG = 32, MOE_CVT_SIDE_C = 4096 * 8 * 2, MOE_CVT_SIDE_F = 1024 * 8 * 2, MOE_CVT_SIDE_G = 0  , MOE_CVT_SIDE_E = 2048 * 8 * 2, MOE_CVT_SIDE_H = 22000  ;
#define MOE_CVT_PROLOGUE_END(G_) ((G_) == 256 ? MOE_CVT_TOTAL - MOE_CVT_SIDE_A - MOE_CVT_SIDE_B - MOE_CVT_SIDE_C - MOE_CVT_SIDE_F - MOE_CVT_SIDE_G - MOE_CVT_SIDE_E - MOE_CVT_SIDE_H : MOE_CVT_TOTAL)
#define MOE_CVT_BASE_C MOE_CVT_PROLOGUE_END(256)
#define MOE_CVT_BASE_F (MOE_CVT_BASE_C + MOE_CVT_SIDE_C)
#define MOE_CVT_BASE_G (MOE_CVT_BASE_F + MOE_CVT_SIDE_F)
#define MOE_CVT_BASE_E (MOE_CVT_BASE_G + MOE_CVT_SIDE_G)
#define MOE_CVT_BASE_H (MOE_CVT_BASE_E + MOE_CVT_SIDE_E)
static_assert(MOE_CVT_BASE_E >= MOE_CVT_TOTAL / 2 && MOE_CVT_BASE_H + MOE_CVT_SIDE_H + MOE_CVT_SIDE_A + MOE_CVT_SIDE_B == MOE_CVT_TOTAL && MOE_CVT_SIDE_H % 2 == 0 && MOE_CVT_BASE_C % 2 == 0, "MoE conversion item ranges");
__device__ __forceinline__ void moe_convert_pair(const Ctx& C, int it, int lane) {
    auto ident = [](int n) { return n; };
    auto dg = [](int n) { return (n >> 7) * 256 + (n & 127); };
    auto du = [](int n) { return (n >> 7) * 256 + 128 + (n & 127); };
    const int per = 512;
    const int le = it / (3 * per), r = it % (3 * per), which = r / per, q = r % per;
    if (which == 0) { const int kb = q / 16, nb = q % 16; transpose_tiles<2>(INP(I_MOE_W_GATE) + (size_t)le * DM * FF, FF, FF, kb * 64, nb * 32, WSP(bf16, WS_W_GU) + (size_t)le * 1024 * DM, DM, dg, lane, INP(I_NORM_FFN) + (le >> 6) * DM); }
    else if (which == 1) { const int kb = q / 16, nb = q % 16; transpose_tiles<2>(INP(I_MOE_W_UP) + (size_t)le * DM * FF, FF, FF, kb * 64, nb * 32, WSP(bf16, WS_W_GU) + (size_t)le * 1024 * DM, DM, du, lane, INP(I_NORM_FFN) + (le >> 6) * DM); }
    else { const int kb = q / 64, nb = q % 64; transpose_tiles<2>(INP(I_MOE_W_DOWN) + (size_t)le * FF * DM, DM, DM, kb * 64, nb * 32, WSP(bf16, WS_W_DN) + (size_t)le * DM * FF, FF, ident, lane, nullptr); }
}
struct MoeTile { const float* W; bf16* WT; const float* ks; int ldw, ldt, k0, n0, mode; };
__device__ __forceinline__ MoeTile moe_tile_decode(const Ctx& C, int it) {
    const int per = 512, le = it / (3 * per), r = it % (3 * per), which = r / per, q = r % per; MoeTile t; t.mode = which;
    if (which < 2) { t.W = INP(which ? I_MOE_W_UP : I_MOE_W_GATE) + (size_t)le * DM * FF; t.ldw = FF; t.k0 = (q / 16) * 64; t.n0 = (q % 16) * 32; t.WT = WSP(bf16, WS_W_GU) + (size_t)le * 1024 * DM; t.ldt = DM; t.ks = INP(I_NORM_FFN) + (le >> 6) * DM; }
    else { t.W = INP(I_MOE_W_DOWN) + (size_t)le * FF * DM; t.ldw = DM; t.k0 = (q / 64) * 64; t.n0 = (q % 64) * 32; t.WT = WSP(bf16, WS_W_DN) + (size_t)le * DM * FF; t.ldt = FF; t.ks = nullptr; }
    return t;
}
__device__ __forceinline__ void moe_pair_load(const MoeTile& t, f32x4 (&v)[2][8], int lane) {
    const int g = lane >> 3, c = lane & 7;
#pragma unroll
    for (int q = 0; q < 2; ++q)
#pragma unroll
        for (int j = 0; j < 8; ++j) v[q][j] = __builtin_nontemporal_load((const f32x4*)(t.W + (size_t)(t.k0 + 8 * g + j) * t.ldw + t.n0 + 32 * q + 4 * c));
}
__device__ __forceinline__ void moe_pair_store(const MoeTile& t, const f32x4 (&v)[2][8], int lane) {
    const int g = lane >> 3, c = lane & 7; f32x4 ka = (f32x4){1.f, 1.f, 1.f, 1.f}, kb = ka;
    if (t.ks) { ka = *(const f32x4*)(t.ks + t.k0 + 8 * g); kb = *(const f32x4*)(t.ks + t.k0 + 8 * g + 4); }
#pragma unroll
    for (int q = 0; q < 2; ++q)
#pragma unroll
        for (int i = 0; i < 4; ++i) { const int nn = t.n0 + 32 * q + 4 * c + i, dr = (t.mode == 2) ? nn : ((nn >> 7) * 256 + (t.mode == 1 ? 128 : 0) + (nn & 127));
            u32x4 o; o.x = pk2(v[q][0][i] * ka.x, v[q][1][i] * ka.y); o.y = pk2(v[q][2][i] * ka.z, v[q][3][i] * ka.w); o.z = pk2(v[q][4][i] * kb.x, v[q][5][i] * kb.y); o.w = pk2(v[q][6][i] * kb.z, v[q][7][i] * kb.w);
            __builtin_nontemporal_store(o, (u32x4*)(t.WT + (size_t)dr * t.ldt + t.k0 + 8 * g)); }
}
__device__ __forceinline__ void moe_convert_items(const Ctx& C, int lo, int hi, int widx, int nworkers) {
    for (int it = lo + 2 * widx; it < hi; it += 2 * nworkers) moe_convert_pair(C, it, C.lane);
}
__device__ __forceinline__ void moe_convert_items_x2(const Ctx& C, int lo, int hi, int widx, int nworkers) {
    int it = lo + 2 * widx; const int st = 2 * nworkers;
    for (; it + st < hi; it += 2 * st) {
        f32x4 va[2][8], vb[2][8]; const MoeTile ta = moe_tile_decode(C, it), tb = moe_tile_decode(C, it + st);
        moe_pair_load(ta, va, C.lane); moe_pair_load(tb, vb, C.lane);
        moe_pair_store(ta, va, C.lane); moe_pair_store(tb, vb, C.lane);
    }
    for (; it < hi; it += st) moe_convert_pair(C, it, C.lane);
}
__device__ __forceinline__ void phase_prologue(const Ctx& C, const Args& A) {
    LAS float* scr = (LAS float*)(C.lds + C.wave * 8448);
    auto ident = [](int n) { return n; };
    transpose_matrix(C, INP(I_AB_W_IN), DM, AB_COLS, AB_PAD, WSP(bf16, WS_W_ABIN), DM, ident, scr);
    transpose_matrix(C, INP(I_AB_W_OUT), DM, DM, DM, WSP(bf16, WS_W_ABOUT), DM, ident, scr);
    transpose_matrix(C, INP(I_NSA_W_IN), DM, NSA_COLS, NSA_PAD, WSP(bf16, WS_W_NSAIN), DM, ident, scr, INP(I_NORM_MIX) + DM);
    transpose_matrix(C, INP(I_NSA_W_OUT), DM, DM, DM, WSP(bf16, WS_W_NSAOUT), DM, ident, scr);
    for (int l = 0; l < 2; ++l) {
        transpose_matrix(C, INP(I_CA_WK) + (size_t)l * DM * DM, DM, DM, DM, WSP(bf16, WS_W_CAK) + (size_t)l * DM * DM, DM, ident, scr);
        transpose_matrix(C, INP(I_CA_WV) + (size_t)l * DM * DM, DM, DM, DM, WSP(bf16, WS_W_CAV) + (size_t)l * DM * DM, DM, ident, scr);
        transpose_matrix(C, INP(I_CA_WO) + (size_t)l * DM * DM, DM, DM, DM, WSP(bf16, WS_W_CAO) + (size_t)l * DM * DM, DM, ident, scr);
    }
    for (int kv = 0; kv < 2; ++kv)
        transpose_matrix(C, INP(I_CMP_W1) + (size_t)kv * 4096 * 128, 4096, 128, 128, WSP(bf16, WS_W_CMP1) + (size_t)kv * 256 * 4096, 4096, ident, scr);
    moe_convert_items(C, 0, MOE_CVT_PROLOGUE_END(C.G), C.gw, C.ngw);
    const size_t gt = (size_t)C.bid * NTHR + C.tid, gn = (size_t)C.G * NTHR;
    { const float* src = INP(I_CA_WQ); bf16* dst = WSP(bf16, WS_W_CAQ);
      const float* gc = INP(I_NORM_CROSS);
      for (size_t i = gt; i < (size_t)2 * DM * DM / 4; i += gn) { const f32x4 v = *(const f32x4*)(src + i * 4); const float gq = gc[(i * 4) / DM]; u32x2 w; w.x = pk2(v.x * gq, v.y * gq); w.y = pk2(v.z * gq, v.w * gq); *(u32x2*)(dst + i * 4) = w; } }
    { bf16* dst = WSP(bf16, WS_W_LORA);
      for (size_t i = gt; i < (size_t)3072 * 256; i += gn) { const int n = (int)(i >> 8), k = (int)(i & 255); float v = 0.f;
          if (n < 1024) { if (k < 64) v = INP(I_RW_W_UP)[k * 1024 + n]; }
          else if (n < 2048) { if (k >= 64 && k < 128) v = INP(I_RW_A_UP)[(k - 64) * 1024 + (n - 1024)]; }
          else { if (k >= 128) v = INP(I_RW_G_UP)[(k - 128) * 1024 + (n - 2048)]; }
          dst[i] = (bf16)f2bf(v); } }
    { bf16* dst = WSP(bf16, WS_W_ROUTER);
      for (size_t i = gt; i < (size_t)2 * 256 * DM; i += gn) { const int l = (int)(i / (256 * DM)), n = (int)((i / DM) & 255), k = (int)(i % DM); float v = 0.f;
          if (n < 8) v = INP(I_MOE_WG)[((size_t)l * DM + k) * 8 + n]; else if (n < 72) v = INP(I_MOE_WE)[((size_t)l * DM + k) * 64 + (n - 8)];
          v *= INP(I_NORM_FFN)[l * DM + k];
          dst[i] = (bf16)f2bf(v); } }
    { float* rc = WSP(float, WS_TAB + TAB_ROPE_COS); float* rs = WSP(float, WS_TAB + TAB_ROPE_SIN);
      for (size_t i = gt; i < (size_t)SEQ * 16; i += gn) { const int pos = (int)(i >> 4), j = (int)(i & 15);
          const float inv = 1.0f / powf(500000.0f, (float)j / 16.0f); const float ang = (float)pos * inv; rc[i] = cosf(ang); rs[i] = sinf(ang); } }
    for (int o = C.gw; o < 256; o += C.ngw) { const int kv = o >> 7, e = o & 127; float s = 0.f;
        for (int i = C.lane; i < 4096; i += 64) s += INP(I_CMP_POS)[kv * 4096 + i] * INP(I_CMP_W1)[((size_t)kv * 4096 + i) * 128 + e];
        s = wave_sum(s); if (C.lane == 0) WSP(float, WS_TAB + TAB_CMPBIAS)[o] = s; }
    for (int r = C.gw; r < 2 * MT; r += C.ngw) { const int l = r / MT, m = r % MT;
        rms_row_bf16(INP(I_MEM) + (size_t)m * DM, INP(I_NORM_MEM) + l * DM, WSP(bf16, WS_MEMN) + ((size_t)l * MT + m) * DM, C.lane); }
    for (int r = C.gw; r < T; r += C.ngw) rms_row_bf16(INP(I_X) + (size_t)r * DM, INP(I_NORM_MIX), WSP(bf16, WS_XN) + (size_t)r * DM, C.lane);
}

struct MemProjOrder {
    int G, c;
    __device__ __forceinline__ bool next(int i, pg8::Unit& u) const {
        const int L = i * G + c; if (L >= 128) return false;
        const int pn = L & 7, pm = (L >> 3) & 3, kv = (L >> 5) & 1, l = L >> 6;
        u.pm = pm; u.pn = pn; u.aux = 0;
        u.aoff = ((long long)l * MT + pm * 256) * DM * 2;
        u.boff = ((long long)(kv ? (WS_W_CAV - WS_W_CAK) / 2 : 0) + ((long long)l * DM + pn * 256) * DM) * 2;
        u.coff = (long long)(kv ? (WS_VP - WS_KP) / 2 : 0) + ((long long)l * MT + pm * 256) * DM + pn * 256;
        return true;
    }
};
struct AbInMemOrder {
    pg8::DenseOrder d; MemProjOrder m;
    __device__ __forceinline__ bool next(int i, pg8::Unit& u) const {
        const long L = (long)i * d.G + d.c;
        if (L < (T / 256) * (AB_PAD / 256)) { int pm, pn; pg8::tile_of(L, d.nM, d.nN, pm, pn); u.pm = pm; u.pn = pn; u.aux = 0; u.aoff = (long long)WS_XN + pm * d.astep; u.boff = (long long)WS_W_ABIN + pn * d.bstep; u.coff = 0; return true; }
        pg8::Unit t; MemProjOrder mm{1 << 30, (int)(L - (T / 256) * (AB_PAD / 256))}; if (!mm.next(0, t)) return false;
        u = t; u.aux = 1; u.aoff += (long long)WS_MEMN; u.boff += (long long)WS_W_CAK; return true;
    }
};
struct EpiAbInMem { EpiAbIn a; EpiStoreBf16 m;
    __device__ __forceinline__ void operator()(EPI_ARGS) const { if (u.aux == 0) a(acc, u, wr, wc, fr, fq); else m(acc, u, wr, wc, fr, fq); } };
struct RouterOrder {
    int G, c;
    __device__ __forceinline__ bool next(int i, pg8::Unit& u) const {
        const int L = i * G + c; if (L >= 256) return false;
        const int pm = L & 63, ks = L >> 6; u.pm = pm; u.pn = 0; u.aux = ks;
        u.aoff = ((long long)pm * 256 * DM + ks * 512) * 2; u.boff = (long long)ks * 512 * 2; u.coff = ((long long)ks * T + pm * 256) * 256; return true;
    }
};
struct WktOrder {
    int G, c;
    __device__ __forceinline__ bool next(int i, pg8::Unit& u) const {
        const int L = i * G + c; if (L >= 256) return false;
        const int pn = L & 7, h = (L >> 3) & 3, b = (L >> 5) & 3, l = L >> 7;
        u.pm = 0; u.pn = pn; u.aux = 0;
        u.aoff = (((long long)l * MT + b * 256) * DM + h * 512) * 2;
        u.boff = (((long long)l * DM + pn * 256) * DM + h * 512) * 2;
        u.coff = (((long long)(l * 4 + b) * 1024) + h * 256) * DM + pn * 256;
        return true;
    }
};
struct VwtOrder {
    int G, c;
    __device__ __forceinline__ bool next(int i, pg8::Unit& u) const {
        const int L = i * G + c; if (L >= 256) return false;
        const int pm = L & 7, h = (L >> 3) & 3, b = (L >> 5) & 3, l = L >> 7;
        u.pm = pm; u.pn = 0; u.aux = 0;
        u.aoff = (((long long)l * DM + pm * 256) * DM + h * 512) * 2;
        u.boff = (((long long)l * MT + b * 256) * DM + h * 512) * 2;
        u.coff = (((long long)(l * 4 + b) * DM) + pm * 256) * 1024 + h * 256;
        return true;
    }
};
struct CrossOrder {
    int nN, G, c, ldc; long long astep, bstep, bbatch;
    __device__ __forceinline__ bool next(int i, pg8::Unit& u) const {
        int pm, pn; if (!pg8::tile_of((long)i * G + c, T / 256, nN, pm, pn)) return false;
        u.pm = pm; u.pn = pn; u.aux = 0; u.aoff = pm * astep; u.boff = (pm >> 4) * bbatch + pn * bstep; u.coff = (long long)pm * 256 * ldc + pn * 256; return true;
    }
};
struct CmpOrder {
    int G, c;
    __device__ __forceinline__ bool next(int i, pg8::Unit& u) const {
        const int L = i * G + c; if (L >= 256) return false;
        const int bg = L & 15, kv = (L >> 4) & 1, ks = L >> 5;
        u.pm = 0; u.pn = 0; u.aux = 0;
        u.aoff = (long long)kv * KV6_STRIDE + ((long long)bg * SPAD * 128 + ks * 512) * 2;
        u.boff = ((long long)kv * 256 * 4096 + ks * 512) * 2;
        u.coff = ((long long)(ks * 2 + kv) * 16 + bg) * 65536;
        return true;
    }
};
struct MoeOrder {
    const LAS int* tab; int npn, G, c, which;
    __device__ __forceinline__ bool next(int i, pg8::Unit& u) const {
        const int L = i * G + c, ntile = tab[64]; if (L >= ntile * npn) return false;
        const int tix = L / npn, pn = L % npn; int e = 0;
        for (int k = 32; k >= 1; k >>= 1) if (e + k < 64 && tab[e + k] <= tix) e += k;
        while (tab[e + 1] <= tix) ++e;
        const int mt = tix - tab[e], cnt = tab[65 + e], row0 = tab[129 + e] + mt * 256;
        u.pm = min(256, cnt - mt * 256); u.pn = pn; u.aux = row0;
        if (which == 0) { u.aoff = 0; u.boff = ((long long)e * 1024 + pn * 256) * DM * 2; }
        else { u.aoff = (long long)row0 * FF * 2; u.boff = ((long long)e * DM + pn * 256) * FF * 2; }
        u.coff = 0; return true;
    }
};
__device__ __forceinline__ void moe_build_table(const Ctx& C, const unsigned* cnt, LAS int* tab) {
    if (C.tid == 0) { int ts = 0, off = 0;
        for (int e = 0; e < 64; ++e) { const int n = (int)cnt[e]; tab[e] = ts; tab[65 + e] = n; tab[129 + e] = off; const int nt = (n + 255) >> 8; ts += nt; off += nt * 256; }
        tab[64] = ts; }
    __syncthreads();
}

__device__ __forceinline__ float log_sigmoidf_(float x) { return fminf(x, 0.f) - log1pf(__expf(-fabsf(x))); }
__device__ __forceinline__ void phase_mixer_prep(const Ctx& C, const Args& A) {
    const bf16* PAB = ARP(bf16, A_PAB); const float* G32 = ARP(float, A_GF32);
    bf16 *QM = ARP(bf16, A_QM), *KM = ARP(bf16, A_KM), *RR = ARP(bf16, A_RR), *KR = ARP(bf16, A_KR), *VR = ARP(bf16, A_VR), *KK = ARP(bf16, A_KK), *LIN = ARP(bf16, A_LIN);
    float *IG = ARP(float, A_IG), *LF = ARP(float, A_LF);
    const float *cw = INP(I_ML_CONV_W), *cb = INP(I_ML_CONV_B), *gb = INP(I_ML_GATE_B), *mu = INP(I_RW_MU), *k_k = INP(I_RW_K_K);
    const int lane = C.lane;
    for (int t = C.gw; t < T; t += C.ngw) {
        const int b = t >> 12, s = t & 4095; const bf16* P = PAB + (size_t)t * AB_PAD; const bf16* PR = P + ML_COLS;
        u32x4 cx[2][4], pc[7], pq[7]; const u32x4 z4 = (u32x4){0u, 0u, 0u, 0u};
#pragma unroll
        for (int it = 0; it < 2; ++it)
#pragma unroll
            for (int tap = 0; tap < 4; ++tap) { const int back = 3 - tap; cx[it][tap] = z4; if (s >= back) cx[it][tap] = *(const u32x4*)(P - (size_t)back * AB_PAD + (lane + 64 * it) * 8); }
#pragma unroll
        for (int it = 0; it < 7; ++it) { const int chunk = lane + 64 * it; pc[it] = z4; pq[it] = z4;
            if (chunk < 416) { pc[it] = *(const u32x4*)(PR + chunk * 8); if (s > 0) pq[it] = *(const u32x4*)(PR - AB_PAD + chunk * 8); } }
#pragma unroll
        for (int it = 0; it < 2; ++it) { const int c = (lane + 64 * it) * 8; float y[8];
            { const f32x4 b0 = *(const f32x4*)(cb + c), b1 = *(const f32x4*)(cb + c + 4); y[0] = b0.x; y[1] = b0.y; y[2] = b0.z; y[3] = b0.w; y[4] = b1.x; y[5] = b1.y; y[6] = b1.z; y[7] = b1.w; }
#pragma unroll
            for (int tap = 0; tap < 4; ++tap) { float xv[8]; unpack8(cx[it][tap], xv);
                const f32x4 w0 = *(const f32x4*)(cw + tap * 1024 + c), w1 = *(const f32x4*)(cw + tap * 1024 + c + 4);
                y[0] += xv[0] * w0.x; y[1] += xv[1] * w0.y; y[2] += xv[2] * w0.z; y[3] += xv[3] * w0.w; y[4] += xv[4] * w1.x; y[5] += xv[5] * w1.y; y[6] += xv[6] * w1.z; y[7] += xv[7] * w1.w; }
#pragma unroll
            for (int j = 0; j < 8; ++j) y[j] = siluf_(y[j]);
            if (c < 512) *(u32x4*)(QM + (size_t)t * 512 + c) = pack8f(y); else *(u32x4*)(KM + (size_t)t * 512 + c - 512) = pack8f(y); }
        if (lane < 8) { const float g = G32[(size_t)t * 256 + lane] + gb[lane];
            if (lane < 4) IG[(size_t)(b * 4 + lane) * SEQ + s] = g; else LF[(size_t)(b * 4 + lane - 4) * SEQ + s] = log_sigmoidf_(g); }
#pragma unroll
        for (int it = 0; it < 7; ++it) { const int chunk = lane + 64 * it; if (chunk >= 416) break; const int cc = chunk * 8;
            float p[8], pp[8], mx[8]; unpack8(pc[it], p); unpack8(pq[it], pp);
            { const f32x4 m0 = *(const f32x4*)(mu + cc), m1 = *(const f32x4*)(mu + cc + 4); const float mf[8] = {m0.x, m0.y, m0.z, m0.w, m1.x, m1.y, m1.z, m1.w};
#pragma unroll
              for (int j = 0; j < 8; ++j) mx[j] = p[j] + (pp[j] - p[j]) * mf[j]; }
            if (it < 2) *(u32x4*)(RR + (size_t)t * 1024 + cc) = pack8f(mx);
            else if (it < 4) { const int ck = cc - 1024; *(u32x4*)(KR + (size_t)t * 1024 + ck) = pack8f(mx);
                float kk[8], ss = 0.f; const f32x4 q0 = *(const f32x4*)(k_k + ck), q1 = *(const f32x4*)(k_k + ck + 4); const float kf[8] = {q0.x, q0.y, q0.z, q0.w, q1.x, q1.y, q1.z, q1.w};
#pragma unroll
                for (int j = 0; j < 8; ++j) { kk[j] = mx[j] * kf[j]; ss += kk[j] * kk[j]; }
                ss += DPPF(ss, DPP_XOR1); ss += DPPF(ss, DPP_XOR2); ss += DPPF(ss, DPP_HMIRROR);
                const float rn = rsqrtf(ss + 1e-12f);
#pragma unroll
                for (int j = 0; j < 8; ++j) kk[j] *= rn;
                *(u32x4*)(KK + (size_t)t * 1024 + ck) = pack8f(kk); }
            else if (it < 6) *(u32x4*)(VR + (size_t)t * 1024 + cc - 2048) = pack8f(mx);
            else { float o[8];
#pragma unroll
                for (int j = 0; j < 8; ++j) o[j] = (lane < 8) ? tanhf(mx[j]) : ((lane < 16) ? mx[j] : sigmoidf_(mx[j]));
                *(u32x4*)(LIN + (size_t)t * 256 + lane * 8) = pack8f(o); } }
    }
}

__device__ __forceinline__ void rwkv_scan_unit(const Ctx& C, const Args& A, int bh) {
    const int b = bh >> 4, h = bh & 15, w = C.wave, lane = C.lane, tid = C.tid;
    LAS float* IN = (LAS float*)C.lds;
    LAS float* PART = IN + 2 * 6 * 1024;
    LAS float* YP = PART + 2 * 8 * 64;
    const float* WD = ARP(float, A_WD); const bf16 *KKg = ARP(bf16, A_KK), *BV = ARP(bf16, A_BV), *KP = ARP(bf16, A_KP), *RR = ARP(bf16, A_RR), *VR = ARP(bf16, A_VR), *GG = ARP(bf16, A_GG);
    bf16* YCAT = ARP(bf16, A_YCAT);
    const float *r_k = INP(I_RW_R_K), *ln_w = INP(I_RW_LN_W), *ln_b = INP(I_RW_LN_B);
    const int li = tid >> 5, lch = (tid & 31) * 2;
    const size_t gbase = ((size_t)b * SEQ) * 1024 + h * 64 + lch;
    f32x2 rw; unsigned rk, rb, rp, rr_, rv;
#define RW_LOAD(grp) do { const size_t o = gbase + (size_t)((grp) * 16 + li) * 1024; rw = *(const f32x2*)(WD + o); rk = *(const unsigned*)(KKg + o); rb = *(const unsigned*)(BV + o); \
        rp = *(const unsigned*)(KP + o); rr_ = *(const unsigned*)(RR + o); rv = *(const unsigned*)(VR + o); } while (0)
#define RW_STORE(buf) do { LAS float* d = IN + (buf) * 6144 + li * 64 + lch; *(LAS f32x2*)(d) = rw; *(LAS f32x2*)(d + 1024) = (f32x2){lo_bf(rk), hi_bf(rk)}; *(LAS f32x2*)(d + 2048) = (f32x2){lo_bf(rb), hi_bf(rb)}; \
        *(LAS f32x2*)(d + 3072) = (f32x2){lo_bf(rp), hi_bf(rp)}; *(LAS f32x2*)(d + 4096) = (f32x2){lo_bf(rr_), hi_bf(rr_)}; *(LAS f32x2*)(d + 5120) = (f32x2){lo_bf(rv), hi_bf(rv)}; } while (0)
    float st[8];
#pragma unroll
    for (int j = 0; j < 8; ++j) st[j] = 0.f;
    __syncthreads();
    RW_LOAD(0); RW_STORE(0); __syncthreads();
    for (int grp = 0; grp < SEQ / 16; ++grp) {
        const int buf = grp & 1; const LAS float* I0 = IN + buf * 6144;
        if (grp + 1 < SEQ / 16) RW_LOAD(grp + 1);
        for (int i = 0; i < 16; ++i) {
            const LAS float* q = I0 + i * 64 + 8 * w;
            const f32x4 w0 = *(const LAS f32x4*)(q), w1 = *(const LAS f32x4*)(q + 4), k0 = *(const LAS f32x4*)(q + 1024), k1 = *(const LAS f32x4*)(q + 1028);
            const f32x4 b0 = *(const LAS f32x4*)(q + 2048), b1 = *(const LAS f32x4*)(q + 2052), p0 = *(const LAS f32x4*)(q + 3072), p1 = *(const LAS f32x4*)(q + 3076);
            const f32x4 r0 = *(const LAS f32x4*)(q + 4096), r1 = *(const LAS f32x4*)(q + 4100); const float vv = I0[5120 + i * 64 + lane];
            float skp = 0.f;
#pragma unroll
            for (int j = 0; j < 4; ++j) skp += st[j] * k0[j] + st[4 + j] * k1[j];
            PART[(i & 1) * 512 + w * 64 + lane] = skp;
            LDS_WAIT(); __builtin_amdgcn_s_barrier(); asm volatile("" ::: "memory");
            float sk = 0.f;
#pragma unroll
            for (int ww = 0; ww < 8; ++ww) sk += PART[(i & 1) * 512 + ww * 64 + lane];
            float yp = 0.f;
#pragma unroll
            for (int j = 0; j < 4; ++j) { st[j] = st[j] * w0[j] - sk * b0[j] + vv * p0[j]; st[4 + j] = st[4 + j] * w1[j] - sk * b1[j] + vv * p1[j]; yp += st[j] * r0[j] + st[4 + j] * r1[j]; }
            YP[i * 512 + w * 64 + lane] = yp;
        }
        if (grp + 1 < SEQ / 16) RW_STORE(buf ^ 1);
        __syncthreads();
#pragma unroll
        for (int q = 0; q < 2; ++q) { const int i = 2 * w + q; float y = 0.f;
#pragma unroll
            for (int ww = 0; ww < 8; ++ww) y += YP[i * 512 + ww * 64 + lane];
            const float mean = wave_sum(y) * (1.f / 64.f), dv = y - mean, var = wave_sum(dv * dv) * (1.f / 64.f);
            const int ch = h * 64 + lane; const float yn = dv * rsqrtf(var + 64e-5f) * ln_w[ch] + ln_b[ch];
            const float bonus = wave_sum(I0[4096 + i * 64 + lane] * I0[3072 + i * 64 + lane] * r_k[ch]) * I0[5120 + i * 64 + lane];
            const size_t tt = (size_t)b * SEQ + grp * 16 + i;
            const float g = bf2f(GG[tt * 1024 + ch]);
            YCAT[tt * DM + 1024 + ch] = (bf16)f2bf((yn + bonus) * g); }
    }
#undef RW_LOAD
#undef RW_STORE
    __syncthreads();
}

__device__ __forceinline__ f32x4 lds_mma(const LAS bf16* Am, int lda, const LAS bf16* Bt, int ldb, int tm, int tn, int K, int lane, f32x4 acc) {
    const LAS bf16* ap = Am + (tm * 16 + (lane & 15)) * lda + (lane >> 4) * 8;
    const LAS bf16* bp = Bt + (tn * 16 + (lane & 15)) * ldb + (lane >> 4) * 8;
    for (int k = 0; k < K; k += 32) { const bf16x8 a = *(const LAS bf16x8*)(ap + k); const bf16x8 bb = *(const LAS bf16x8*)(bp + k);
        acc = __builtin_amdgcn_mfma_f32_16x16x32_bf16(bb, a, acc, 0, 0, 0); }
    return acc;
}

constexpr int RP = 72;
__device__ __forceinline__ void st4_bf16(LAS bf16* p, f32x4 v) { u32x2 w; w.x = pk2(v[0], v[1]); w.y = pk2(v[2], v[3]); *(LAS u32x2*)p = w; }
__device__ __forceinline__ void st4_bf16_T(LAS bf16* base, int row, int col0, f32x4 v) {
#pragma unroll
    for (int j = 0; j < 4; ++j) base[(col0 + j) * RP + row] = (bf16)f2bf(v[j]);
}
__device__ __forceinline__ void st4_bf16_g(bf16* p, f32x4 v) { u32x2 w; w.x = pk2(v[0], v[1]); w.y = pk2(v[2], v[3]); *(u32x2*)p = w; }
__device__ __forceinline__ void tri_inverse_diag32(const LAS float* Cf, LAS bf16* Tm, LAS bf16* T00T, int lane) {
    const int hb = lane >> 5, j = lane & 31; const LAS float* Cb_ = Cf + hb * (32 * 64 + 32); float Tr[32];
#pragma unroll
    for (int t = 0; t < 32; ++t) { float acc0 = (t == j) ? 1.f : 0.f, acc1 = 0.f, acc2 = 0.f, acc3 = 0.f;
#pragma unroll
        for (int s4 = 0; s4 < (t + 3) / 4; ++s4) { const f32x4 cv = *(const LAS f32x4*)(Cb_ + t * 64 + s4 * 4);
            if (s4 * 4 + 0 < t) acc0 -= cv[0] * Tr[s4 * 4 + 0]; if (s4 * 4 + 1 < t) acc1 -= cv[1] * Tr[s4 * 4 + 1];
            if (s4 * 4 + 2 < t) acc2 -= cv[2] * Tr[s4 * 4 + 2]; if (s4 * 4 + 3 < t) acc3 -= cv[3] * Tr[s4 * 4 + 3]; }
        Tr[t] = (acc0 + acc1) + (acc2 + acc3); Tm[(32 * hb + t) * RP + 32 * hb + j] = (bf16)f2bf(Tr[t]); __builtin_amdgcn_sched_barrier(0); }
    if (hb == 0) {
#pragma unroll
        for (int q = 0; q < 4; ++q) *(LAS u32x4*)(T00T + j * 40 + 8 * q) = pack8f(Tr + 8 * q); }
    { const int t = lane >> 1, h = lane & 1; const u32x4 z = (u32x4){0u, 0u, 0u, 0u}; *(LAS u32x4*)(Tm + t * RP + 32 + 16 * h) = z; *(LAS u32x4*)(Tm + t * RP + 32 + 16 * h + 8) = z; }
}
__device__ __forceinline__ void rwkv_prep_units(const Ctx& C, bool side_cvt) {
    int unit = C.bid; if (unit >= 4096) return;
    const int w = C.wave;
    LAS float* F = (LAS float*)C.lds;
    LAS float* EGL = F + 4096;
    LAS bf16* B0 = (LAS bf16*)(EGL + 64 + 512);
    LAS bf16 *Kt = B0, *Rt = B0 + 64 * RP, *Kb = B0 + 2 * 64 * RP, *Bb = B0 + 3 * 64 * RP, *KtT = B0 + 4 * 64 * RP, *KhT = B0 + 5 * 64 * RP, *BhT = B0 + 6 * 64 * RP,
             *VcT = B0 + 7 * 64 * RP, *Am = B0 + 8 * 64 * RP, *Q1 = B0 + 9 * 64 * RP, *Q2 = B0 + 10 * 64 * RP;
    LAS bf16 *Tm = Kt, *AVT = Kb, *WmT = Bb, *UT = Am;
    LAS bf16 *C10b = (LAS bf16*)(C.lds + LDS_AUX), *T00T = C10b + 32 * 40, *XT = T00T + 32 * 40;
    const float* WD = ARP(float, A_WD); const bf16 *KKg = ARP(bf16, A_KK), *BV = ARP(bf16, A_BV), *KP = ARP(bf16, A_KP), *RR = ARP(bf16, A_RR), *VR = ARP(bf16, A_VR);
    f32x4 lw0, lw1; u32x4 rk, rb, rp, rr, rv;
#define RWP_LOAD(u_) do { const int bh_ = (u_) >> 6, c_ = (u_) & 63; const size_t go_ = ((size_t)(bh_ >> 4) * SEQ + c_ * 64 + (C.tid >> 3)) * 1024 + (bh_ & 15) * 64 + (C.tid & 7) * 8; \
        lw0 = *(const f32x4*)(WD + go_); lw1 = *(const f32x4*)(WD + go_ + 4); rk = *(const u32x4*)(KKg + go_); rb = *(const u32x4*)(BV + go_); rp = *(const u32x4*)(KP + go_); rr = *(const u32x4*)(RR + go_); rv = *(const u32x4*)(VR + go_); } while (0)
    RWP_LOAD(unit);
  for (;;) {
    int tid = C.tid; asm volatile("" : "+v"(tid));
    const int lane = tid & 63, t = tid >> 3, c8 = (tid & 7) * 8;
    bf16 *GM = ARP(bf16, A_RWM) + (size_t)unit * 4096, *GN = ARP(bf16, A_RWN) + (size_t)unit * 4096, *GRW = ARP(bf16, A_RWRW) + (size_t)unit * 4096, *GYL = ARP(bf16, A_RWYL) + (size_t)unit * 4096;
    __syncthreads();
    *(LAS f32x4*)(F + t * 64 + c8) = lw0; *(LAS f32x4*)(F + t * 64 + c8 + 4) = lw1;
    __syncthreads();
    { float g = 0.f;
#pragma unroll
      for (int i = 0; i < 8; ++i) { g += F[(8 * w + i) * 64 + lane]; F[(8 * w + i) * 64 + lane] = g; }
      EGL[64 + w * 64 + lane] = g; }
    __syncthreads();
    { float off = 0.f;
      for (int ww = 0; ww < w; ++ww) off += EGL[64 + ww * 64 + lane];
#pragma unroll
      for (int i = 0; i < 8; ++i) F[(8 * w + i) * 64 + lane] += off; }
    __syncthreads();
    { float G[8], Gm[8], GL[8], kkf[8], bf_[8], kpf[8], rf[8], vf[8];
#pragma unroll
      for (int j = 0; j < 8; ++j) { G[j] = F[t * 64 + c8 + j]; Gm[j] = t > 0 ? F[(t - 1) * 64 + c8 + j] : 0.f; GL[j] = F[63 * 64 + c8 + j]; }
      unpack8(rk, kkf); unpack8(rb, bf_); unpack8(rp, kpf); unpack8(rr, rf); unpack8(rv, vf);
      float okt[8], ort[8], okb[8], obb[8];
#pragma unroll
      for (int j = 0; j < 8; ++j) { const float e1 = __expf(Gm[j]), e2 = __expf(G[j]), e3 = __expf(-G[j]), e4 = __expf(GL[j] - G[j]);
          okt[j] = kkf[j] * e1; ort[j] = rf[j] * e2; okb[j] = kpf[j] * e3; obb[j] = bf_[j] * e3;
          KtT[(c8 + j) * RP + t] = (bf16)f2bf(okt[j]); KhT[(c8 + j) * RP + t] = (bf16)f2bf(kpf[j] * e4); BhT[(c8 + j) * RP + t] = (bf16)f2bf(bf_[j] * e4);
          VcT[(c8 + j) * RP + t] = (bf16)f2bf(vf[j]);
          if (t == 63) EGL[c8 + j] = e2; }
      *(LAS u32x4*)(Kt + t * RP + c8) = pack8f(okt); *(LAS u32x4*)(Rt + t * RP + c8) = pack8f(ort); *(LAS u32x4*)(Kb + t * RP + c8) = pack8f(okb); *(LAS u32x4*)(Bb + t * RP + c8) = pack8f(obb); }
    const int next_unit = unit + C.G; if (next_unit < 4096) RWP_LOAD(next_unit);
    f32x4 cvv[2][8]; MoeTile mt = moe_tile_decode(C, MOE_CVT_BASE_C + (unit * 8 + w) * 2);
    if (side_cvt) moe_pair_load(mt, cvv, lane);
    __syncthreads();
    const int tm = w >> 1, tn0 = (w & 1) * 2, row = tm * 16 + (lane & 15), cq = 4 * (lane >> 4); const f32x4 z4 = (f32x4){0.f, 0.f, 0.f, 0.f};
#pragma unroll
    for (int q = 0; q < 2; ++q) { const int tn = tn0 + q, col = tn * 16 + cq;
        f32x4 a = lds_mma(Kt, RP, Kb, RP, tm, tn, 64, lane, z4), cc = lds_mma(Kt, RP, Bb, RP, tm, tn, 64, lane, z4), q1 = lds_mma(Rt, RP, Kb, RP, tm, tn, 64, lane, z4), q2 = lds_mma(Rt, RP, Bb, RP, tm, tn, 64, lane, z4);
#pragma unroll
        for (int j = 0; j < 4; ++j) { const bool lo_ = (col + j) < row, le_ = (col + j) <= row; a[j] = lo_ ? a[j] : 0.f; cc[j] = lo_ ? cc[j] : 0.f; q1[j] = le_ ? q1[j] : 0.f; q2[j] = le_ ? q2[j] : 0.f; }
        st4_bf16(Am + row * RP + col, a); st4_bf16(Q1 + row * RP + col, q1); st4_bf16(Q2 + row * RP + col, q2); *(LAS f32x4*)(F + row * 64 + col) = cc;
        if (row >= 32 && col < 32) st4_bf16(C10b + (row - 32) * 40 + col, cc); }
    __syncthreads();
    if (w == 0) tri_inverse_diag32(F, Tm, T00T, lane);
    else { for (int tile = w - 1; tile < 16; tile += 7) { const int am = tile >> 2, an = tile & 3; const f32x4 av = lds_mma(Am, RP, VcT, RP, am, an, 64, lane, z4); st4_bf16_T(AVT, am * 16 + (lane & 15), an * 16 + cq, av); } }
    __syncthreads();
    if (w < 4) { const int bm = w >> 1, bn = w & 1; const f32x4 x = lds_mma(C10b, 40, T00T, 40, bm, bn, 32, lane, z4);
#pragma unroll
        for (int j = 0; j < 4; ++j) XT[(bn * 16 + cq + j) * 40 + bm * 16 + (lane & 15)] = (bf16)f2bf(x[j]); }
    __syncthreads();
    if (w < 4) { const int bm = w >> 1, bn = w & 1; const f32x4 x = lds_mma(Tm + 32 * RP + 32, RP, XT, 40, bm, bn, 32, lane, z4);
        st4_bf16(Tm + (32 + bm * 16 + (lane & 15)) * RP + bn * 16 + cq, (f32x4){-x[0], -x[1], -x[2], -x[3]}); }
    if (side_cvt) moe_pair_store(mt, cvv, lane);
    __syncthreads();
#pragma unroll
    for (int q = 0; q < 2; ++q) { const int tn = tn0 + q, col = tn * 16 + cq;
        const f32x4 wm = lds_mma(Tm, RP, KtT, RP, tm, tn, 64, lane, z4), uu = lds_mma(Tm, RP, AVT, RP, tm, tn, 64, lane, z4);
        st4_bf16_T(WmT, row, col, wm); st4_bf16_T(UT, row, col, uu); }
    __syncthreads();
#pragma unroll
    for (int q = 0; q < 2; ++q) { const int tn = tn0 + q, col = tn * 16 + cq;
        { f32x4 p = lds_mma(Q2, RP, WmT, RP, tm, tn, 64, lane, z4); const u32x2 rw_ = *(const LAS u32x2*)(Rt + row * RP + col);
          st4_bf16_g(GRW + row * 64 + col, (f32x4){lo_bf(rw_.x) - p[0], hi_bf(rw_.x) - p[1], lo_bf(rw_.y) - p[2], hi_bf(rw_.y) - p[3]}); }
        { const f32x4 p1 = lds_mma(Q1, RP, VcT, RP, tm, tn, 64, lane, z4), p2 = lds_mma(Q2, RP, UT, RP, tm, tn, 64, lane, z4); st4_bf16_g(GYL + row * 64 + col, p1 - p2); }
        { f32x4 p = lds_mma(BhT, RP, WmT, RP, tm, tn, 64, lane, z4);
#pragma unroll
          for (int j = 0; j < 4; ++j) p[j] = ((col + j) == row ? EGL[row] : 0.f) - p[j];
          st4_bf16_g(GM + row * 64 + col, p); }
        { const f32x4 p1 = lds_mma(KhT, RP, VcT, RP, tm, tn, 64, lane, z4), p2 = lds_mma(BhT, RP, UT, RP, tm, tn, 64, lane, z4); st4_bf16_g(GN + row * 64 + col, p1 - p2); } }
    if (next_unit >= 4096) break; unit = next_unit;
  }
#undef RWP_LOAD
}
__device__ __forceinline__ void rwkv_scan_slice(const Ctx& C, int item) {
    const int bh = item >> 2, v0 = (item & 3) * 16, b = bh >> 4, h = bh & 15, lane = C.lane, w = C.wave;
    LAS bf16* SH = (LAS bf16*)C.lds;
    LAS bf16* SL = SH + 2 * 16 * RP;
    const bf16 *GM = ARP(bf16, A_RWM) + (size_t)bh * 64 * 4096, *GN = ARP(bf16, A_RWN) + (size_t)bh * 64 * 4096, *GRW = ARP(bf16, A_RWRW) + (size_t)bh * 64 * 4096, *GYL = ARP(bf16, A_RWYL) + (size_t)bh * 64 * 4096;
    bf16* YRAW = ARP(bf16, A_KR);
    const bool is_state = w >= 4; const int tm = w & 3, row = tm * 16 + (lane & 15), cq = 4 * (lane >> 4), kq = (lane >> 4) * 8;
    const bf16* GA = is_state ? GM : GRW; const bf16* GB = is_state ? GN : GYL;
    f32x4 st = (f32x4){0.f, 0.f, 0.f, 0.f};
    bf16x8 a0, a1, b0, b1; u32x2 addA, addB;
#define RWS_LOAD(cc_, X0, X1, XA) do { const size_t uo_ = (size_t)(cc_) * 4096; X0 = *(const bf16x8*)(GA + uo_ + row * 64 + kq); X1 = *(const bf16x8*)(GA + uo_ + row * 64 + 32 + kq); XA = *(const u32x2*)(GB + uo_ + row * 64 + v0 + cq); } while (0)
#define RWS_STEP(c_, X0, X1, XA) do { \
        LAS bf16* sh = SH + ((c_) & 1) * 16 * RP; LAS bf16* sl = SL + ((c_) & 1) * 16 * RP; \
        if (is_state) { _Pragma("unroll") for (int j = 0; j < 4; ++j) { const float s_ = st[j]; const unsigned hb = f2bf(s_); sh[(cq + j) * RP + row] = (bf16)hb; sl[(cq + j) * RP + row] = (bf16)f2bf(s_ - __uint_as_float(hb << 16)); } } \
        LDS_WAIT(); __builtin_amdgcn_s_barrier(); asm volatile("" ::: "memory"); \
        const LAS bf16* bh_ = sh + (lane & 15) * RP + kq; const LAS bf16* bl_ = sl + (lane & 15) * RP + kq; \
        const bf16x8 h0 = *(const LAS bf16x8*)bh_, h1 = *(const LAS bf16x8*)(bh_ + 32), l0 = *(const LAS bf16x8*)bl_, l1 = *(const LAS bf16x8*)(bl_ + 32); \
        f32x4 acc = (f32x4){lo_bf(XA.x), hi_bf(XA.x), lo_bf(XA.y), hi_bf(XA.y)}; \
        acc = __builtin_amdgcn_mfma_f32_16x16x32_bf16(h0, X0, acc, 0, 0, 0); acc = __builtin_amdgcn_mfma_f32_16x16x32_bf16(h1, X1, acc, 0, 0, 0); \
        acc = __builtin_amdgcn_mfma_f32_16x16x32_bf16(l0, X0, acc, 0, 0, 0); acc = __builtin_amdgcn_mfma_f32_16x16x32_bf16(l1, X1, acc, 0, 0, 0); \
        if ((c_) + 2 < 64) RWS_LOAD((c_) + 2, X0, X1, XA); \
        if (is_state) st = acc; \
        else st4_bf16_g(YRAW + ((size_t)b * SEQ + (c_) * 64 + row) * 1024 + h * 64 + v0 + cq, acc); } while (0)
    RWS_LOAD(0, a0, a1, addA); RWS_LOAD(1, b0, b1, addB);
    __syncthreads();
    for (int c = 0; c < 64; c += 2) { RWS_STEP(c, a0, a1, addA); RWS_STEP(c + 1, b0, b1, addB); }
#undef RWS_LOAD
#undef RWS_STEP
    __syncthreads();
}
__device__ __forceinline__ float sum8(float v) { v += DPPF(v, DPP_XOR1); v += DPPF(v, DPP_XOR2); v += DPPF(v, DPP_HMIRROR); return v; }
__device__ __forceinline__ void rwkv_out_items(const Ctx& C) {
    const bf16 *YRAW = ARP(bf16, A_KR), *KP = ARP(bf16, A_KP), *RR = ARP(bf16, A_RR), *VR = ARP(bf16, A_VR), *GG = ARP(bf16, A_GG); bf16* YCAT = ARP(bf16, A_YCAT);
    const float *r_k = INP(I_RW_R_K), *ln_w = INP(I_RW_LN_W), *ln_b = INP(I_RW_LN_B); const int lane = C.lane;
    for (int tt = C.gw; tt < T; tt += C.ngw) {
#pragma unroll
        for (int j = 0; j < 2; ++j) { const int ch = (j * 64 + lane) * 8; const size_t o = (size_t)tt * 1024 + ch;
            float y[8], rr[8], kp[8], vr[8], gg[8]; unpack8(*(const u32x4*)(YRAW + o), y); unpack8(*(const u32x4*)(RR + o), rr); unpack8(*(const u32x4*)(KP + o), kp); unpack8(*(const u32x4*)(VR + o), vr); unpack8(*(const u32x4*)(GG + o), gg);
            const f32x4 rk0 = *(const f32x4*)(r_k + ch), rk1 = *(const f32x4*)(r_k + ch + 4), lw0 = *(const f32x4*)(ln_w + ch), lw1 = *(const f32x4*)(ln_w + ch + 4), lb0 = *(const f32x4*)(ln_b + ch), lb1 = *(const f32x4*)(ln_b + ch + 4);
            const float rkf[8] = {rk0.x, rk0.y, rk0.z, rk0.w, rk1.x, rk1.y, rk1.z, rk1.w}, lwf[8] = {lw0.x, lw0.y, lw0.z, lw0.w, lw1.x, lw1.y, lw1.z, lw1.w}, lbf[8] = {lb0.x, lb0.y, lb0.z, lb0.w, lb1.x, lb1.y, lb1.z, lb1.w};
            float s1 = 0.f, sb = 0.f;
#pragma unroll
            for (int q = 0; q < 8; ++q) { s1 += y[q]; sb += rr[q] * kp[q] * rkf[q]; }
            const float mean = sum8(s1) * (1.f / 64.f), bonus = sum8(sb); float s2 = 0.f;
#pragma unroll
            for (int q = 0; q < 8; ++q) { y[q] -= mean; s2 += y[q] * y[q]; }
            const float rstd = rsqrtf(sum8(s2) * (1.f / 64.f) + 64e-5f); float o8[8];
#pragma unroll
            for (int q = 0; q < 8; ++q) o8[q] = (y[q] * rstd * lwf[q] + lbf[q] + bonus * vr[q]) * gg[q];
            st16_f(YCAT + (size_t)tt * DM + 1024 + ch, pack8f(o8)); }
    }
}
constexpr int MLE = 272;
__device__ __forceinline__ void ml_gate_scan(const Ctx& C, int bh4) {
    const float *IG = ARP(float, A_IG) + (size_t)bh4 * SEQ, *LFp = ARP(float, A_LF) + (size_t)bh4 * SEQ; float *AAg = ARP(float, A_MLA) + (size_t)bh4 * SEQ, *MXg = ARP(float, A_MLM) + (size_t)bh4 * SEQ;
    const int lane = C.lane, p0 = lane * 64; float tot = 0.f;
    for (int i = 0; i < 64; i += 4) { const f32x4 f = *(const f32x4*)(LFp + p0 + i); tot += (f.x + f.y) + (f.z + f.w); }
    float inc = tot;
#pragma unroll
    for (int o = 1; o < 64; o <<= 1) { const float n = __shfl_up(inc, o); if (lane >= o) inc += n; }
    float F = inc - tot, mloc = -INFINITY; f32x4 av[16];
#pragma unroll
    for (int i = 0; i < 16; ++i) { const f32x4 f = *(const f32x4*)(LFp + p0 + 4 * i), g = *(const f32x4*)(IG + p0 + 4 * i); f32x4 a;
        F += f.x; a.x = g.x - F; F += f.y; a.y = g.y - F; F += f.z; a.z = g.z - F; F += f.w; a.w = g.w - F;
        *(f32x4*)(AAg + p0 + 4 * i) = a; av[i] = a; mloc = fmaxf(fmaxf(mloc, fmaxf(a.x, a.y)), fmaxf(a.z, a.w)); }
    float minc = mloc;
#pragma unroll
    for (int o = 1; o < 64; o <<= 1) { const float n = __shfl_up(minc, o); if (lane >= o) minc = fmaxf(minc, n); }
    float run = __shfl_up(minc, 1); if (lane == 0) run = 0.f; run = fmaxf(run, 0.f);
#pragma unroll
    for (int i = 0; i < 16; ++i) { const f32x4 a = av[i]; f32x4 m;
        run = fmaxf(run, a.x); m.x = run; run = fmaxf(run, a.y); m.y = run; run = fmaxf(run, a.z); m.z = run; run = fmaxf(run, a.w); m.w = run;
        *(f32x4*)(MXg + p0 + 4 * i) = m; }
}
__device__ __forceinline__ void ml_intra_unit(const Ctx& C, int unit, bool side_cvt) {
    int tid = C.tid; asm volatile("" : "+v"(tid));
    const int bh4 = unit >> 6, c = unit & 63, b = bh4 >> 2, h = bh4 & 3, w = C.wave, lane = tid & 63, t0 = c * 64;
    LAS bf16* Qs = (LAS bf16*)C.lds;
    LAS bf16* Ks = Qs + 64 * 136;
    LAS bf16* KwT = Ks + 64 * 136;
    LAS bf16* VtE = KwT + 128 * 72;
    LAS bf16* Ps = VtE + MLE * 72;
    LAS float* AAs = (LAS float*)(Ps + 64 * 72);
    const bf16 *QM = ARP(bf16, A_QM), *KM = ARP(bf16, A_KM), *PAB = ARP(bf16, A_PAB);
    const float *AAg = ARP(float, A_MLA) + (size_t)bh4 * SEQ + t0, *MXg = ARP(float, A_MLM) + (size_t)bh4 * SEQ + t0;
    bf16* NUMI = ARP(bf16, A_MLNUM) + (size_t)unit * 64 * MLE; bf16* KVT = ARP(bf16, A_MLKV) + (size_t)unit * MLE * 128;
    const size_t tok0 = (size_t)b * SEQ + t0;
    u32x4 rq[2], rk[2], rv[4];
#pragma unroll
    for (int k = 0; k < 2; ++k) { const int idx = tid + 512 * k, r = idx >> 4, c8 = (idx & 15) * 8; const size_t o = (tok0 + r) * 512 + h * 128 + c8; rq[k] = *(const u32x4*)(QM + o); rk[k] = *(const u32x4*)(KM + o); }
#pragma unroll
    for (int k = 0; k < 4; ++k) { const int idx = tid + 512 * k, r = idx >> 5, e8 = (idx & 31) * 8; rv[k] = *(const u32x4*)(PAB + (tok0 + r) * AB_PAD + 1024 + h * 256 + e8); }
    const float Mc2 = MXg[63];
    f32x4 cvv[2][8]; MoeTile mt = moe_tile_decode(C, MOE_CVT_BASE_F + (unit * 8 + w) * 2); if (side_cvt) moe_pair_load(mt, cvv, lane);
    __syncthreads();
    if (tid < 64) { AAs[tid] = AAg[tid]; AAs[64 + tid] = MXg[tid]; }
    for (int i = tid; i < 16 * 72; i += NTHR) VtE[256 * 72 + i] = (i < 72) ? (bf16)0x3f80 : (bf16)0;
#pragma unroll
    for (int k = 0; k < 2; ++k) { const int idx = tid + 512 * k, r = idx >> 4, c8 = (idx & 15) * 8;
        *(LAS u32x4*)(Qs + r * 136 + c8) = rq[k]; *(LAS u32x4*)(Ks + r * 136 + c8) = rk[k];
        float kf[8]; unpack8(rk[k], kf); const float wk = __expf(AAg[r] - Mc2);
#pragma unroll
        for (int j = 0; j < 8; ++j) KwT[(c8 + j) * 72 + r] = (bf16)f2bf(kf[j] * wk); }
#pragma unroll
    for (int k = 0; k < 4; ++k) { const int idx = tid + 512 * k, r = idx >> 5, e8 = (idx & 31) * 8; const unsigned wv[4] = {rv[k].x, rv[k].y, rv[k].z, rv[k].w};
#pragma unroll
        for (int j = 0; j < 4; ++j) { VtE[(e8 + 2 * j) * 72 + r] = (bf16)(wv[j] & 0xffff); VtE[(e8 + 2 * j + 1) * 72 + r] = (bf16)(wv[j] >> 16); } }
    __syncthreads();
#pragma unroll
    for (int q = 0; q < 2; ++q) { const int tile = 2 * w + q, tm = tile >> 2, tn = tile & 3; const int t = tm * 16 + (lane & 15), l0 = tn * 16 + 4 * (lane >> 4);
        f32x4 s = (f32x4){0.f, 0.f, 0.f, 0.f};
        if (tn <= tm) s = lds_mma(Qs, 136, Ks, 136, tm, tn, 128, lane, s);
        const float mxt = AAs[64 + t]; float pvv[4];
#pragma unroll
        for (int j = 0; j < 4; ++j) { const int l = l0 + j; pvv[j] = (l <= t) ? s[j] * __expf(AAs[l] - mxt) : 0.f; }
        u32x2 pw; pw.x = pk2(pvv[0], pvv[1]); pw.y = pk2(pvv[2], pvv[3]); *(LAS u32x2*)(Ps + t * 72 + l0) = pw; }
    { const int tn = w;
      for (int tm = 0; tm < 17; ++tm) { const f32x4 kv = lds_mma(VtE, 72, KwT, 72, tm, tn, 64, lane, (f32x4){0.f, 0.f, 0.f, 0.f}); const int e = tm * 16 + (lane & 15);
          if (e <= 256) st4_bf16_g(KVT + (size_t)e * 128 + tn * 16 + 4 * (lane >> 4), kv); } }
    __syncthreads();
    { const int tm = w >> 1, t = tm * 16 + (lane & 15);
      for (int tn = (w & 1); tn < 17; tn += 2) { const f32x4 nv = lds_mma(Ps, 72, VtE, 72, tm, tn, 64, lane, (f32x4){0.f, 0.f, 0.f, 0.f}); st4_bf16_g(NUMI + (size_t)t * MLE + tn * 16 + 4 * (lane >> 4), nv); } }
    if (side_cvt) moe_pair_store(mt, cvv, lane);
}
__device__ __forceinline__ void ml_state_scan(const Ctx& C, int first_block, int nblocks) {
    const float* MXg = ARP(float, A_MLM); bf16* KVT = ARP(bf16, A_MLKV);
    constexpr int NPAIR = 16 * 257 * 64;
    const int nthr = nblocks * NTHR, g0 = (C.bid - first_block) * NTHR + C.tid;
    unsigned eoff[3], moff[3]; f32x2 cst[3]; float mprev[3]; bool ev[3];
#pragma unroll
    for (int k = 0; k < 3; ++k) { const int pi = g0 + k * nthr; ev[k] = pi < NPAIR; const int bh4 = ev[k] ? pi / (257 * 64) : 0, r = ev[k] ? pi - bh4 * (257 * 64) : 0;
        eoff[k] = (unsigned)(bh4 * 64 * MLE * 128 + 2 * r); moff[k] = (unsigned)(bh4 * SEQ); cst[k] = (f32x2){0.f, 0.f}; mprev[k] = 0.f; }
    for (int c0 = 0; c0 < 64; c0 += 8) {
        unsigned kvw[3][8]; float mn[3][8];
#pragma unroll
        for (int k = 0; k < 3; ++k)
#pragma unroll
            for (int j = 0; j < 8; ++j) { kvw[k][j] = 0u; mn[k][j] = 0.f; if (ev[k]) { kvw[k][j] = *(const unsigned*)(KVT + eoff[k] + (unsigned)(c0 + j) * (MLE * 128)); mn[k][j] = MXg[moff[k] + (c0 + j) * 64 + 63]; } }
#pragma unroll
        for (int j = 0; j < 8; ++j)
#pragma unroll
            for (int k = 0; k < 3; ++k) if (ev[k]) { *(unsigned*)(KVT + eoff[k] + (unsigned)(c0 + j) * (MLE * 128)) = pk2(cst[k].x, cst[k].y);
                const float dc = __expf(mprev[k] - mn[k][j]); cst[k].x = dc * cst[k].x + lo_bf(kvw[k][j]); cst[k].y = dc * cst[k].y + hi_bf(kvw[k][j]); mprev[k] = mn[k][j]; } }
}
__device__ __forceinline__ void ml_out_unit(const Ctx& C, int unit, bool side_cvt) {
    int tid = C.tid; asm volatile("" : "+v"(tid));
    const int bh4 = unit >> 6, c = unit & 63, b = bh4 >> 2, h = bh4 & 3, w = C.wave, lane = tid & 63, t0 = c * 64;
    LAS bf16* Qs = (LAS bf16*)C.lds;
    LAS bf16* CTs = Qs + 64 * 136;
    const bf16 *QM = ARP(bf16, A_QM), *PAB = ARP(bf16, A_PAB), *NUMI = ARP(bf16, A_MLNUM) + (size_t)unit * 64 * MLE, *KVT = ARP(bf16, A_MLKV) + (size_t)unit * MLE * 128; bf16* YCAT = ARP(bf16, A_YCAT);
    const float *IG = ARP(float, A_IG) + (size_t)bh4 * SEQ + t0, *AAg = ARP(float, A_MLA) + (size_t)bh4 * SEQ + t0, *MXg = ARP(float, A_MLM) + (size_t)bh4 * SEQ + t0;
    const size_t tok0 = (size_t)b * SEQ + t0;
    u32x4 rq[2], rc[9];
#pragma unroll
    for (int k = 0; k < 2; ++k) { const int idx = tid + 512 * k, r = idx >> 4, c8 = (idx & 15) * 8; rq[k] = *(const u32x4*)(QM + (tok0 + r) * 512 + h * 128 + c8); }
#pragma unroll
    for (int k = 0; k < 9; ++k) { const int idx = tid + 512 * k, e = idx >> 4, c8 = (idx & 15) * 8; rc[k] = (u32x4){0u, 0u, 0u, 0u}; if (e <= 256) rc[k] = *(const u32x4*)(KVT + (size_t)e * 128 + c8); }
    const float Mc = c ? MXg[-1] : 0.f;
    f32x4 cvv[2][8]; MoeTile mt = moe_tile_decode(C, MOE_CVT_BASE_G + (unit * 8 + w) * 2); if (side_cvt) moe_pair_load(mt, cvv, lane);
    __syncthreads();
#pragma unroll
    for (int k = 0; k < 2; ++k) { const int idx = tid + 512 * k, r = idx >> 4, c8 = (idx & 15) * 8; *(LAS u32x4*)(Qs + r * 136 + c8) = rq[k]; }
#pragma unroll
    for (int k = 0; k < 9; ++k) { const int idx = tid + 512 * k, e = idx >> 4, c8 = (idx & 15) * 8; if (e < MLE) *(LAS u32x4*)(CTs + e * 136 + c8) = rc[k]; }
    __syncthreads();
    const int tm = w >> 1, t = tm * 16 + (lane & 15), cq = 4 * (lane >> 4); const size_t tt = tok0 + t; const float scale = 0.08838834764831845f;
    const float wst = __expf(Mc - MXg[t]), mrow = IG[t] - AAg[t] + MXg[t];
    float inv;
    { const f32x4 a2 = lds_mma(Qs, 136, CTs, 136, tm, 16, 128, lane, (f32x4){0.f, 0.f, 0.f, 0.f}); const float di = bf2f(NUMI[(size_t)t * MLE + 256]);
      float den = (lane < 16) ? (di + a2[0] * wst) * scale : 0.f; den += xor16f(den); den += xor32f(den);
      inv = 1.f / fmaxf(fabsf(den), __expf(-mrow)); }
    for (int tn = (w & 1); tn < 16; tn += 2) { const f32x4 a2 = lds_mma(Qs, 136, CTs, 136, tm, tn, 128, lane, (f32x4){0.f, 0.f, 0.f, 0.f});
        const u32x2 ni = *(const u32x2*)(NUMI + (size_t)t * MLE + tn * 16 + cq); const u32x2 og = *(const u32x2*)(PAB + tt * AB_PAD + 2048 + h * 256 + tn * 16 + cq);
        const float n0 = (lo_bf(ni.x) + a2[0] * wst) * scale * inv, n1 = (hi_bf(ni.x) + a2[1] * wst) * scale * inv, n2 = (lo_bf(ni.y) + a2[2] * wst) * scale * inv, n3 = (hi_bf(ni.y) + a2[3] * wst) * scale * inv;
        u32x2 o; o.x = pk2(sigmoidf_(lo_bf(og.x)) * n0, sigmoidf_(hi_bf(og.x)) * n1); o.y = pk2(sigmoidf_(lo_bf(og.y)) * n2, sigmoidf_(hi_bf(og.y)) * n3);
        st8_f(YCAT + tt * DM + h * 256 + tn * 16 + cq, o); }
    if (side_cvt) moe_pair_store(mt, cvv, lane);
}

__device__ __forceinline__ void mlstm_unit(const Ctx& C, const Args& A, int unit) {
    const int bh = unit >> 3, dvs = unit & 7, b = bh >> 2, h = bh & 3, w = C.wave, lane = C.lane, tid = C.tid;
    LAS float* AA = (LAS float*)C.lds;
    LAS float* MX = AA + 4096;
    LAS bf16* Qs = (LAS bf16*)(MX + 4096);
    LAS bf16* Ks = Qs + 64 * 136;
    LAS bf16* KwT = Ks + 64 * 136;
    LAS bf16* Vt = KwT + 128 * 72;
    LAS bf16* Ps = Vt + 48 * 72;
    LAS bf16* CT = Ps + 64 * 72;
    LAS float* NUM = (LAS float*)(CT + 48 * 136);
    const float *IG = ARP(float, A_IG) + (size_t)bh * SEQ, *LFp = ARP(float, A_LF) + (size_t)bh * SEQ;
    const bf16 *QM = ARP(bf16, A_QM), *KM = ARP(bf16, A_KM), *PAB = ARP(bf16, A_PAB); bf16* YCAT = ARP(bf16, A_YCAT);
    __syncthreads();
    if (w == 0) { float carryF = 0.f, carryM = 0.f;
        for (int c = 0; c < 64; ++c) { const int p = c * 64 + lane; float f = LFp[p];
#pragma unroll
            for (int o = 1; o < 64; o <<= 1) { const float n = __shfl_up(f, o); if (lane >= o) f += n; }
            f += carryF; const float a = IG[p] - f; float m = a;
#pragma unroll
            for (int o = 1; o < 64; o <<= 1) { const float n = __shfl_up(m, o); if (lane >= o) m = fmaxf(m, n); }
            m = fmaxf(m, carryM); AA[p] = a; MX[p] = m; carryF = __shfl(f, 63); carryM = __shfl(m, 63); } }
    for (int i = tid; i < 48 * 72; i += NTHR) { const int r = i / 72; Vt[i] = (r == 32) ? (bf16)0x3f80 : (bf16)0; }
    for (int i = tid; i < 48 * 136; i += NTHR) CT[i] = 0;
    f32x4 accC[3];
#pragma unroll
    for (int k = 0; k < 3; ++k) accC[k] = (f32x4){0.f, 0.f, 0.f, 0.f};
    const size_t tok0 = (size_t)b * SEQ;
    u32x4 rq[2], rk[2], rv;
#define ML_LOAD(c) do { _Pragma("unroll") for (int k = 0; k < 2; ++k) { const int idx = tid + 512 * k, r = idx >> 4, c8 = (idx & 15) * 8; const size_t o = (tok0 + (c) * 64 + r) * 512 + h * 128 + c8; \
            rq[k] = *(const u32x4*)(QM + o); rk[k] = *(const u32x4*)(KM + o); } \
        if (tid < 256) rv = *(const u32x4*)(PAB + (tok0 + (c) * 64 + (tid >> 2)) * AB_PAD + 1024 + h * 256 + dvs * 32 + (tid & 3) * 8); } while (0)
    ML_LOAD(0);
    __syncthreads();
    const float scale = 0.08838834764831845f;
    for (int c = 0; c < 64; ++c) {
        const int t0 = c * 64; const float Mc = c ? MX[t0 - 1] : 0.f, Mc2 = MX[t0 + 63];
#pragma unroll
        for (int k = 0; k < 2; ++k) { const int idx = tid + 512 * k, r = idx >> 4, c8 = (idx & 15) * 8;
            *(LAS u32x4*)(Qs + r * 136 + c8) = rq[k]; *(LAS u32x4*)(Ks + r * 136 + c8) = rk[k];
            float kf[8]; unpack8(rk[k], kf); const float wk = __expf(AA[t0 + r] - Mc2);
#pragma unroll
            for (int j = 0; j < 8; ++j) KwT[(c8 + j) * 72 + r] = (bf16)f2bf(kf[j] * wk); }
        if (tid < 256) { const int r = tid >> 2, e8 = (tid & 3) * 8; const unsigned wv[4] = {rv.x, rv.y, rv.z, rv.w};
#pragma unroll
            for (int j = 0; j < 4; ++j) { Vt[(e8 + 2 * j) * 72 + r] = (bf16)(wv[j] & 0xffff); Vt[(e8 + 2 * j + 1) * 72 + r] = (bf16)(wv[j] >> 16); } }
        if (c + 1 < 64) ML_LOAD(c + 1);
        __syncthreads();
#pragma unroll
        for (int q = 0; q < 2; ++q) { const int tile = 2 * w + q, tm = tile >> 2, tn = tile & 3; const int t = tm * 16 + (lane & 15), l0 = tn * 16 + 4 * (lane >> 4);
            f32x4 s = (f32x4){0.f, 0.f, 0.f, 0.f};
            if (tn <= tm) s = lds_mma(Qs, 136, Ks, 136, tm, tn, 128, lane, s);
            const float mxt = MX[t0 + t]; float pvv[4];
#pragma unroll
            for (int j = 0; j < 4; ++j) { const int l = l0 + j; pvv[j] = (l <= t) ? s[j] * __expf(AA[t0 + l] - mxt) : 0.f; }
            u32x2 pw; pw.x = pk2(pvv[0], pvv[1]); pw.y = pk2(pvv[2], pvv[3]); *(LAS u32x2*)(Ps + t * 72 + l0) = pw; }
        __syncthreads();
        for (int tile = w; tile < 12; tile += 8) { const int tm = tile / 3, tn = tile % 3; const int t = tm * 16 + (lane & 15);
            f32x4 a1 = lds_mma(Ps, 72, Vt, 72, tm, tn, 64, lane, (f32x4){0.f, 0.f, 0.f, 0.f});
            f32x4 a2 = lds_mma(Qs, 136, CT, 136, tm, tn, 128, lane, (f32x4){0.f, 0.f, 0.f, 0.f});
            const float wst = __expf(Mc - MX[t0 + t]);
            *(LAS f32x4*)(NUM + t * 48 + tn * 16 + 4 * (lane >> 4)) = (a1 + a2 * wst) * scale; }
        __syncthreads();
        { const int t = tid >> 3, e4 = (tid & 7) * 4; const size_t tt = tok0 + t0 + t;
          const float den = NUM[t * 48 + 32], mrow = IG[t0 + t] - AA[t0 + t] + MX[t0 + t];
          const float inv = 1.f / fmaxf(fabsf(den), __expf(-mrow));
          const f32x4 nv = *(const LAS f32x4*)(NUM + t * 48 + e4);
          const u32x2 og = *(const u32x2*)(PAB + tt * AB_PAD + 2048 + h * 256 + dvs * 32 + e4);
          u32x2 o; o.x = pk2(sigmoidf_(lo_bf(og.x)) * nv[0] * inv, sigmoidf_(hi_bf(og.x)) * nv[1] * inv); o.y = pk2(sigmoidf_(lo_bf(og.y)) * nv[2] * inv, sigmoidf_(hi_bf(og.y)) * nv[3] * inv);
          *(u32x2*)(YCAT + tt * DM + h * 256 + dvs * 32 + e4) = o; }
        { const float decay = __expf(Mc - Mc2);
#pragma unroll
          for (int tm = 0; tm < 3; ++tm) { accC[tm] = lds_mma(Vt, 72, KwT, 72, tm, w, 64, lane, accC[tm] * decay);
              u32x2 cw; cw.x = pk2(accC[tm][0], accC[tm][1]); cw.y = pk2(accC[tm][2], accC[tm][3]);
              *(LAS u32x2*)(CT + (tm * 16 + (lane & 15)) * 136 + w * 16 + 4 * (lane >> 4)) = cw; } }
        __syncthreads();
    }
#undef ML_LOAD
}

__device__ __forceinline__ void phase_rowstat(const Ctx& C) {
    const bf16* XR = WSP(bf16, WS_XR); float* RS = WSP(float, WS_TAB + TAB_RSTD);
    for (int r = C.gw; r < T; r += C.ngw) { const u32x4* xr = (const u32x4*)(XR + (size_t)r * DM); float s = 0.f;
#pragma unroll
        for (int j = 0; j < 4; ++j) { float f[8]; unpack8(xr[j * 64 + C.lane], f);
#pragma unroll
            for (int q = 0; q < 8; ++q) s += f[q] * f[q]; }
        s = wave_sum(s); if (C.lane == 0) RS[r] = rsqrtf(s * (1.f / DM) + EPS); }
}
__device__ __forceinline__ void phase_softmax256(const Ctx& C) {
    const float* SC = ARP(float, A_SC); bf16* PC = ARP(bf16, A_PC);
    for (int it = C.gw; it < T * 4; it += C.ngw) { const size_t o = (size_t)it * 256 + C.lane * 4;
        const f32x4 v = *(const f32x4*)(SC + o); const float m = wave_max(fmaxf(fmaxf(v.x, v.y), fmaxf(v.z, v.w)));
        const float e0 = __expf(v.x - m), e1 = __expf(v.y - m), e2 = __expf(v.z - m), e3 = __expf(v.w - m);
        const float inv = 1.f / wave_sum(e0 + e1 + e2 + e3);
        u32x2 w; w.x = pk2(e0 * inv, e1 * inv); w.y = pk2(e2 * inv, e3 * inv); *(u32x2*)(PC + o) = w; }
}
constexpr int MOE_NB = 256, MOE_TPB = T / MOE_NB;
__device__ __forceinline__ void phase_route(const Ctx& C, const Args& A, int l) {
    const float* LG = ARP(float, A_XS); constexpr size_t PL = (size_t)T * 256;     int* EID = ARP(int, A_EID); float* WTS = ARP(float, A_WTS); int* LRANK = ARP(int, A_LRANK); int* BH = ARP(int, A_BHIST);
    const float *bg = INP(I_MOE_BG) + l * 8, *be = INP(I_MOE_BE) + l * 64;
    LAS int* hist = (LAS int*)(C.lds + LDS_AUX);
    for (int bk = C.bid; bk < MOE_NB; bk += C.G) {
        __syncthreads();
        if (C.tid < 64) hist[C.tid] = 0;
        __syncthreads();
        if (C.tid < MOE_TPB) { const int t = bk * MOE_TPB + C.tid; const float* L = LG + (size_t)t * 256;
            float lg[8], mx = -INFINITY; int grp = 0;
#pragma unroll
            for (int g = 0; g < 8; ++g) { lg[g] = ((L[g] + L[PL + g]) + (L[2 * PL + g] + L[3 * PL + g])) + bg[g]; if (lg[g] > mx) { mx = lg[g]; grp = g; } }
            float se = 0.f;
#pragma unroll
            for (int g = 0; g < 8; ++g) se += __expf(lg[g] - mx);
            const float pgrp = 1.f / se;
            float l1 = -INFINITY, l2 = -INFINITY; int i1 = 0, i2 = 0;
            for (int j = 0; j < 8; ++j) { const int x = 8 + grp * 8 + j; const float v = ((L[x] + L[PL + x]) + (L[2 * PL + x] + L[3 * PL + x])) + be[grp * 8 + j];
                if (v > l1) { l2 = l1; i2 = i1; l1 = v; i1 = j; } else if (v > l2) { l2 = v; i2 = j; } }
            const float w1 = 1.f / (1.f + __expf(l2 - l1)), w2 = 1.f - w1;
            const int e1 = grp * 8 + i1, e2 = grp * 8 + i2;
            EID[2 * t] = e1; EID[2 * t + 1] = e2; WTS[2 * t] = pgrp * w1; WTS[2 * t + 1] = pgrp * w2;
            LRANK[2 * t] = atomicAdd((int*)(hist + e1), 1); LRANK[2 * t + 1] = atomicAdd((int*)(hist + e2), 1); }
        __syncthreads();
        if (C.tid < 64) BH[bk * 64 + C.tid] = hist[C.tid];
    }
}
__device__ __forceinline__ void phase_gather(const Ctx& C, int l) {
    LAS int* tab = (LAS int*)(C.lds + LDS_AUX);
    const int* BH = ARP(int, A_BHIST); const int* EID = ARP(int, A_EID); const int* LRANK = ARP(int, A_LRANK); int* ROWSLOT = ARP(int, A_ROWSLOT); const bf16* XNp = WSP(bf16, WS_XR); bf16* XS = ARP(bf16, A_XS);
    unsigned* cnt = WSP(unsigned, WS_CTL) + CW_MOE_CNT + l * 64;
    for (int bk = C.bid; bk < MOE_NB; bk += C.G) {
        __syncthreads();
        if (C.tid < 64) { int tot = 0, before = 0;
            for (int q = 0; q < MOE_NB; ++q) { const int v = BH[q * 64 + C.tid]; tot += v; if (q < bk) before += v; }
            tab[C.tid] = tot; tab[64 + C.tid] = before; if (bk == 0) cnt[C.tid] = (unsigned)tot; }
        __syncthreads();
        if (C.tid == 0) { int off = 0; for (int e = 0; e < 64; ++e) { const int n = tab[e]; tab[e] = off; off += ((n + 255) >> 8) << 8; } }
        __syncthreads();
        if (C.tid < 2 * MOE_TPB) { const int a = bk * 2 * MOE_TPB + C.tid, e = EID[a], pos = tab[e] + tab[64 + e] + LRANK[a]; tab[128 + C.tid] = pos; ROWSLOT[pos] = a; }
        __syncthreads();
    }
}
__device__ __forceinline__ void phase_combine_norm(const Ctx& C, const float* gain, float* OUT) {
    bf16* XR = WSP(bf16, WS_XR); const bf16* YE = ARP(bf16, A_YE); float* RS = WSP(float, WS_RSQ) + (size_t)4 * T * 8; const int lane = C.lane;
    for (int t = C.gw; t < T; t += C.ngw) { bf16* xr = XR + (size_t)t * DM; const bf16* y0 = YE + (size_t)(2 * t) * DM; const bf16* y1 = y0 + DM;
        float v[4][8]; float s = 0.f; u32x4 rx[4], ra[4], rb[4];
#pragma unroll
        for (int j = 0; j < 4; ++j) { const int o = (j * 64 + lane) * 8; rx[j] = *(const u32x4*)(xr + o); ra[j] = *(const u32x4*)(y0 + o); rb[j] = *(const u32x4*)(y1 + o); }
#pragma unroll
        for (int j = 0; j < 4; ++j) { const int o = (j * 64 + lane) * 8; float a[8], b0[8]; unpack8(rx[j], v[j]); unpack8(ra[j], a); unpack8(rb[j], b0);
#pragma unroll
            for (int q = 0; q < 8; ++q) v[j][q] += a[q] + b0[q];
            if (!OUT) { const u32x4 w = pack8f(v[j]); *(u32x4*)(xr + o) = w; unpack8(w, v[j]); }
#pragma unroll
            for (int q = 0; q < 8; ++q) s += v[j][q] * v[j][q]; }
        const float ssq = wave_sum(s), rstd = rstd_of(ssq);
        if (!OUT) { if (lane < 8) RS[(size_t)t * 8 + lane] = (lane == 0) ? ssq : 0.f; }
        else {
#pragma unroll
            for (int j = 0; j < 4; ++j) { const int o = (j * 64 + lane) * 8; const f32x4 g0 = *(const f32x4*)(gain + o), g1 = *(const f32x4*)(gain + o + 4);
                *(f32x4*)(OUT + (size_t)t * DM + o) = (f32x4){v[j][0] * rstd * g0.x, v[j][1] * rstd * g0.y, v[j][2] * rstd * g0.z, v[j][3] * rstd * g0.w};
                *(f32x4*)(OUT + (size_t)t * DM + o + 4) = (f32x4){v[j][4] * rstd * g1.x, v[j][5] * rstd * g1.y, v[j][6] * rstd * g1.z, v[j][7] * rstd * g1.w}; } }
    }
}

__device__ __forceinline__ float gelu_tanh(float x) { return 0.5f * x * (1.f + tanhf(0.7978845608028654f * (x + 0.044715f * x * x * x))); }
__device__ __forceinline__ void phase_cmp_finish(const Ctx& C, const Args& A) {
    const float* CP = ARP(float, A_CPART); const float* bias = WSP(float, WS_TAB + TAB_CMPBIAS); const float* w2 = INP(I_CMP_W2);
    LAS float* hid = (LAS float*)C.lds + C.wave * 128; const int lane = C.lane;
    for (int it = C.gw; it < 2 * 16 * 256; it += C.ngw) { const int j = it & 255, bg = (it >> 8) & 15, kv = it >> 12;
        bf16* dst = ARP(bf16, kv ? A_VCMP : A_KCMP) + ((size_t)bg * 256 + j) * 128;
        bf16* dstT = ARP(bf16, A_VCT) + (size_t)bg * 128 * 256 + j;
        if (j == 255) { dst[lane] = 0; dst[lane + 64] = 0; if (kv) { dstT[(size_t)lane * 256] = 0; dstT[(size_t)(lane + 64) * 256] = 0; } continue; }
        float h0 = bias[kv * 128 + lane], h1 = bias[kv * 128 + 64 + lane];
#pragma unroll
        for (int ks = 0; ks < 8; ++ks) { const float* p = CP + ((size_t)((ks * 2 + kv) * 16 + bg) * 256 + j) * 256; h0 += p[lane]; h1 += p[64 + lane]; }
        hid[lane] = gelu_tanh(h0); hid[64 + lane] = gelu_tanh(h1); LDS_WAIT(); asm volatile("" ::: "memory");
        float o0 = 0.f, o1 = 0.f; const float* W = w2 + (size_t)kv * 128 * 128;
        for (int e = 0; e < 128; ++e) { const float hv = hid[e]; o0 += hv * W[e * 128 + lane]; o1 += hv * W[e * 128 + 64 + lane]; }
        dst[lane] = (bf16)f2bf(o0); dst[lane + 64] = (bf16)f2bf(o1); if (kv) { dstT[(size_t)lane * 256] = (bf16)f2bf(o0); dstT[(size_t)(lane + 64) * 256] = (bf16)f2bf(o1); } LDS_WAIT(); asm volatile("" ::: "memory"); }
}
__device__ __forceinline__ void phase_cmp_attn(const Ctx& C) {
    const bf16 *Q = ARP(bf16, A_Q), *KC = ARP(bf16, A_KCMP), *VC = ARP(bf16, A_VCMP); const float* GATES = ARP(float, A_GATES);
    float* OACC = ARP(float, A_OACC); unsigned long long* SELM = ARP(unsigned long long, A_SELMASK);
    LAS float* qs = (LAS float*)C.lds + C.wave * 1536;
    LAS float* ps = qs + 512; const int lane = C.lane; const float scale = 0.08838834764831845f;
    for (int it = C.gw; it < T * 4; it += C.ngw) { const int t = it >> 2, g = it & 3, b = t >> 12, s = t & 4095;
        const int nvalid = (s >= 31) ? ((s - 31) >> 4) + 1 : 0;
#pragma unroll
        for (int r = 0; r < 4; ++r) { const bf16* qp = Q + (((size_t)(b * 16 + g * 4 + r)) * SEQ + s) * 128; qs[r * 128 + lane] = bf2f(qp[lane]); qs[r * 128 + 64 + lane] = bf2f(qp[64 + lane]); }
        LDS_WAIT(); asm volatile("" ::: "memory");
        float sc[4][4];
#pragma unroll
        for (int i = 0; i < 4; ++i) { const int j = lane + 64 * i;
#pragma unroll
            for (int r = 0; r < 4; ++r) sc[r][i] = 0.f;
            if (j < nvalid) { const bf16* kp = KC + ((size_t)(b * 4 + g) * 256 + j) * 128;
                for (int d8 = 0; d8 < 16; ++d8) { float kf[8]; unpack8(*(const u32x4*)(kp + d8 * 8), kf);
#pragma unroll
                    for (int r = 0; r < 4; ++r) { float a = 0.f;
#pragma unroll
                        for (int jj = 0; jj < 8; ++jj) a += qs[r * 128 + d8 * 8 + jj] * kf[jj];
                        sc[r][i] += a; } } } }
#pragma unroll
        for (int r = 0; r < 4; ++r) { float m = -INFINITY;
#pragma unroll
            for (int i = 0; i < 4; ++i) if (lane + 64 * i < nvalid) m = fmaxf(m, sc[r][i] * scale);
            m = wave_max(m); if (!(m > -INFINITY)) m = 0.f; float e[4], sum = 0.f;
#pragma unroll
            for (int i = 0; i < 4; ++i) { e[i] = (lane + 64 * i < nvalid) ? __expf(sc[r][i] * scale - m) : 0.f; sum += e[i]; }
            sum = wave_sum(sum); const float inv = sum > 0.f ? 1.f / sum : 1.f;
#pragma unroll
            for (int i = 0; i < 4; ++i) ps[r * 256 + lane + 64 * i] = e[i] * inv; }
        LDS_WAIT(); asm volatile("" ::: "memory");
        float o[4][2];
#pragma unroll
        for (int r = 0; r < 4; ++r) { o[r][0] = 0.f; o[r][1] = 0.f; }
        for (int j = 0; j < nvalid; ++j) { const bf16* vp = VC + ((size_t)(b * 4 + g) * 256 + j) * 128; const float v0 = bf2f(vp[lane]), v1 = bf2f(vp[64 + lane]);
#pragma unroll
            for (int r = 0; r < 4; ++r) { const float p = ps[r * 256 + j]; o[r][0] += p * v0; o[r][1] += p * v1; } }
#pragma unroll
        for (int r = 0; r < 4; ++r) { const float gt = GATES[(size_t)t * 48 + g * 4 + r]; float* op = OACC + (size_t)t * DM + (g * 4 + r) * 128; op[lane] = gt * o[r][0]; op[64 + lane] = gt * o[r][1]; }
        float imp = 0.f;
#pragma unroll
        for (int r = 0; r < 4; ++r) { const LAS float* p = ps + r * 256; const int j0 = 4 * lane;
            imp += (j0 > 0 ? 0.5f * p[j0 - 1] : 0.f) + p[j0] + p[j0 + 1] + p[j0 + 2] + 0.5f * p[j0 + 3]; }
        const int cur = s >> 6; float score;
        if (lane == 0 || lane == cur || lane == cur - 1) score = INFINITY; else score = (lane <= cur) ? imp : -INFINITY;
        int rank = 0;
        for (int o2 = 0; o2 < 64; ++o2) { const float so = __int_as_float(__builtin_amdgcn_readlane(__float_as_int(score), o2)); rank += (so > score || (so == score && o2 < lane)) ? 1 : 0; }
        const unsigned long long m = __ballot(rank < 16 && score > -INFINITY);
        if (lane == 0) SELM[(size_t)t * 4 + g] = m;
        LDS_WAIT(); asm volatile("" ::: "memory");
    }
}
struct NaiveAttnState { float m[4], l[4], o[4][2]; };
__device__ __forceinline__ void naive_tile(NaiveAttnState& S, const LAS float* qs, LAS float* pt, const bf16* Kt, const bf16* Vt_, int key0, bool valid, int lane) {
    float sc[4] = {0.f, 0.f, 0.f, 0.f}; const float scale = 0.08838834764831845f;
    if (valid) { const bf16* kp = Kt + (size_t)(key0 + lane) * 128;
        for (int d8 = 0; d8 < 16; ++d8) { float kf[8]; unpack8(*(const u32x4*)(kp + d8 * 8), kf);
#pragma unroll
            for (int r = 0; r < 4; ++r) { float a = 0.f;
#pragma unroll
                for (int jj = 0; jj < 8; ++jj) a += qs[r * 128 + d8 * 8 + jj] * kf[jj];
                sc[r] += a; } } }
    const unsigned long long vm = __ballot(valid);
    if (vm == 0ull) return;
#pragma unroll
    for (int r = 0; r < 4; ++r) { const float sv = valid ? sc[r] * scale : -INFINITY; const float mt = wave_max(sv), mn = fmaxf(S.m[r], mt);
        const float alpha = __expf(S.m[r] - mn), p = valid ? __expf(sv - mn) : 0.f;
        S.l[r] = S.l[r] * alpha + wave_sum(p); S.o[r][0] *= alpha; S.o[r][1] *= alpha; S.m[r] = mn; pt[r * 64 + lane] = p; }
    LDS_WAIT(); asm volatile("" ::: "memory");
    for (int k = 0; k < 64; ++k) { if (!((vm >> k) & 1ull)) continue; const bf16* vp = Vt_ + (size_t)(key0 + k) * 128; const float v0 = bf2f(vp[lane]), v1 = bf2f(vp[64 + lane]);
#pragma unroll
        for (int r = 0; r < 4; ++r) { const float p = pt[r * 64 + k]; S.o[r][0] += p * v0; S.o[r][1] += p * v1; } }
    LDS_WAIT(); asm volatile("" ::: "memory");
}
__device__ __forceinline__ void phase_selwin_naive(const Ctx& C, bf16* OCAT) {
    const bf16* QR = ARP(bf16, A_QROT); const float* GATES = ARP(float, A_GATES); const float* OACC = ARP(float, A_OACC);
    const unsigned long long* SELM = ARP(const unsigned long long, A_SELMASK);
    const bf16* KS = (const bf16*)(C.ws + WS_ARENA + A_KV6 + 2 * KV6_STRIDE); const bf16* VS = (const bf16*)(C.ws + WS_ARENA + A_KV6 + 3 * KV6_STRIDE);
    const bf16* KW = (const bf16*)(C.ws + WS_ARENA + A_KV6 + 4 * KV6_STRIDE); const bf16* VW = (const bf16*)(C.ws + WS_ARENA + A_KV6 + 5 * KV6_STRIDE);
    LAS float* qs = (LAS float*)C.lds + C.wave * 768; LAS float* pt = qs + 512; const int lane = C.lane;
    for (int it = C.gw; it < T * 4; it += C.ngw) { const int t = it >> 2, g = it & 3, b = t >> 12, s = t & 4095; const size_t slab = (size_t)(b * 4 + g) * SPAD * 128;
#pragma unroll
        for (int r = 0; r < 4; ++r) { const bf16* qp = QR + (((size_t)(b * 16 + g * 4 + r)) * SEQ + s) * 128; qs[r * 128 + lane] = bf2f(qp[lane]); qs[r * 128 + 64 + lane] = bf2f(qp[64 + lane]); }
        LDS_WAIT(); asm volatile("" ::: "memory");
        float res[4][2];
#pragma unroll
        for (int r = 0; r < 4; ++r) { res[r][0] = OACC[(size_t)t * DM + (g * 4 + r) * 128 + lane]; res[r][1] = OACC[(size_t)t * DM + (g * 4 + r) * 128 + 64 + lane]; }
        { NaiveAttnState S;
#pragma unroll
          for (int r = 0; r < 4; ++r) { S.m[r] = -1e30f; S.l[r] = 0.f; S.o[r][0] = 0.f; S.o[r][1] = 0.f; }
          const unsigned long long m = SELM[(size_t)t * 4 + g];
          for (int blk = 0; blk <= (s >> 6); ++blk) if ((m >> blk) & 1ull) naive_tile(S, qs, pt, KS + slab, VS + slab, blk * 64, blk * 64 + lane <= s, lane);
#pragma unroll
          for (int r = 0; r < 4; ++r) { const float gt = GATES[(size_t)t * 48 + 16 + g * 4 + r], inv = S.l[r] > 0.f ? 1.f / S.l[r] : 0.f; res[r][0] += gt * S.o[r][0] * inv; res[r][1] += gt * S.o[r][1] * inv; } }
        { NaiveAttnState S;
#pragma unroll
          for (int r = 0; r < 4; ++r) { S.m[r] = -1e30f; S.l[r] = 0.f; S.o[r][0] = 0.f; S.o[r][1] = 0.f; }
          const int lo = s - 511 > 0 ? s - 511 : 0;
          for (int k0 = lo & ~63; k0 <= s; k0 += 64) naive_tile(S, qs, pt, KW + slab, VW + slab, k0, (k0 + lane >= lo) && (k0 + lane <= s), lane);
#pragma unroll
          for (int r = 0; r < 4; ++r) { const float gt = GATES[(size_t)t * 48 + 32 + g * 4 + r], inv = S.l[r] > 0.f ? 1.f / S.l[r] : 0.f; res[r][0] += gt * S.o[r][0] * inv; res[r][1] += gt * S.o[r][1] * inv; } }
#pragma unroll
        for (int r = 0; r < 4; ++r) { bf16* op = OCAT + (size_t)t * DM + (g * 4 + r) * 128; op[lane] = (bf16)f2bf(res[r][0]); op[64 + lane] = (bf16)f2bf(res[r][1]); }
    }
}


__device__ __forceinline__ void phase_cmp_attn_mma(const Ctx& C, bool side_cvt) {
    const bf16 *Q = ARP(bf16, A_Q), *KC = ARP(bf16, A_KCMP), *VCT = ARP(bf16, A_VCT); const float* GATES = ARP(float, A_GATES);
    float* OACC = ARP(float, A_OACC); unsigned long long* SELM = ARP(unsigned long long, A_SELMASK);
    LAS bf16* Qs = (LAS bf16*)C.lds;
    LAS bf16* Ks = Qs + 128 * 136;
    LAS bf16* Pm = (LAS bf16*)C.lds;
    LAS bf16* Vt = Pm + 128 * 264;
    const int w = C.wave; const float scale = 0.08838834764831845f;
    for (int it = C.bid; it < 2048; it += C.G) { int tid = C.tid; asm volatile("" : "+v"(tid)); const int lane = tid & 63;     const int bg = it >> 7, tt = ((it / C.G) & 1) ? 127 - (it & 127) : (it & 127), b = bg >> 2, g = bg & 3, t0 = tt * 32;
        const int nv = t0 / 16 + 1 > 255 ? 255 : ((t0 + 31 >= 31) ? t0 / 16 + 1 : 0);
        const int nct = (nv + 15) >> 4, kmax = ((nv + 31) >> 5) << 5;
        f32x4 cvv[2][8]; MoeTile mt = moe_tile_decode(C, MOE_CVT_BASE_E + (it * 8 + w) * 2); if (side_cvt) moe_pair_load(mt, cvv, lane);
        __syncthreads();
#pragma unroll
        for (int k = 0; k < 4; ++k) { const int idx = tid + 512 * k, row = idx >> 4, c8 = (idx & 15) * 8, r = row >> 5, tl = row & 31;
            *(LAS u32x4*)(Qs + row * 136 + c8) = *(const u32x4*)(Q + (((size_t)(b * 16 + g * 4 + r)) * SEQ + t0 + tl) * 128 + c8); }
        { u32x4 tk[8];
#pragma unroll
          for (int k = 0; k < 8; ++k) { const int idx = tid + 512 * k, row = idx >> 4, c8 = (idx & 15) * 8; tk[k] = (u32x4){0u, 0u, 0u, 0u};
              if (row < nct * 16) tk[k] = *(const u32x4*)(KC + ((size_t)bg * 256 + row) * 128 + c8); }
#pragma unroll
          for (int k = 0; k < 8; ++k) { const int idx = tid + 512 * k, row = idx >> 4, c8 = (idx & 15) * 8; *(LAS u32x4*)(Ks + row * 136 + c8) = tk[k]; } }
        __syncthreads();
        f32x4 sacc[16];
        { bf16x8 qa[4];
#pragma unroll
          for (int k = 0; k < 4; ++k) qa[k] = *(const LAS bf16x8*)(Qs + (w * 16 + (lane & 15)) * 136 + (lane >> 4) * 8 + 32 * k);
#pragma unroll
          for (int ct = 0; ct < 16; ++ct) { sacc[ct] = (f32x4){0.f, 0.f, 0.f, 0.f};
              if (ct < nct) { const LAS bf16* bp = Ks + (ct * 16 + (lane & 15)) * 136 + (lane >> 4) * 8;
#pragma unroll
                  for (int k = 0; k < 4; ++k) sacc[ct] = __builtin_amdgcn_mfma_f32_16x16x32_bf16(*(const LAS bf16x8*)(bp + 32 * k), qa[k], sacc[ct], 0, 0, 0); } } }
        const int trow = t0 + (w & 1) * 16 + (lane & 15);
        const int nvr = (trow >= 31) ? ((trow - 31) >> 4) + 1 : 0;
        float m = -INFINITY;
#pragma unroll
        for (int ct = 0; ct < 16; ++ct)
#pragma unroll
            for (int j = 0; j < 4; ++j) { const int key = ct * 16 + 4 * (lane >> 4) + j; const float v = (key < nvr) ? sacc[ct][j] * scale : -INFINITY; sacc[ct][j] = v; m = fmaxf(m, v); }
        m = fmaxf(m, xor16f(m)); m = fmaxf(m, xor32f(m)); if (!(m > -INFINITY)) m = 0.f;
        float sum = 0.f;
#pragma unroll
        for (int ct = 0; ct < 16; ++ct)
#pragma unroll
            for (int j = 0; j < 4; ++j) { const float e = __expf(sacc[ct][j] - m); sacc[ct][j] = e; sum += e; }
        sum += xor16f(sum); sum += xor32f(sum);
        const float inv = sum > 0.f ? 1.f / sum : 1.f;
        __syncthreads();
#pragma unroll
        for (int ct = 0; ct < 16; ++ct) if (ct * 16 < kmax) { u32x2 pw; pw.x = pk2(sacc[ct][0] * inv, sacc[ct][1] * inv); pw.y = pk2(sacc[ct][2] * inv, sacc[ct][3] * inv);
            *(LAS u32x2*)(Pm + (w * 16 + (lane & 15)) * 264 + ct * 16 + 4 * (lane >> 4)) = pw; }
        { u32x4 tv[8];
#pragma unroll
          for (int k = 0; k < 8; ++k) { const int idx = tid + 512 * k, d = idx >> 5, j8 = (idx & 31) * 8; tv[k] = (u32x4){0u, 0u, 0u, 0u};
              if (j8 < kmax) tv[k] = *(const u32x4*)(VCT + ((size_t)bg * 128 + d) * 256 + j8); }
#pragma unroll
          for (int k = 0; k < 8; ++k) { const int idx = tid + 512 * k, d = idx >> 5, j8 = (idx & 31) * 8; *(LAS u32x4*)(Vt + d * 264 + j8) = tv[k]; } }
        __syncthreads();
        { const int r = w >> 1, tl = (w & 1) * 16 + (lane & 15), t = b * SEQ + t0 + tl, hh = g * 4 + r; const float gt = GATES[(size_t)t * 48 + hh];
          float* op = OACC + (size_t)t * DM + hh * 128 + 4 * (lane >> 4);
          bf16x8 pa[8];
#pragma unroll
          for (int k = 0; k < 8; ++k) { pa[k] = (bf16x8){0, 0, 0, 0, 0, 0, 0, 0}; if (k * 32 < kmax) pa[k] = *(const LAS bf16x8*)(Pm + (w * 16 + (lane & 15)) * 264 + (lane >> 4) * 8 + 32 * k); }
#pragma unroll
          for (int dt = 0; dt < 8; ++dt) { f32x4 o = (f32x4){0.f, 0.f, 0.f, 0.f}; const LAS bf16* bp = Vt + (dt * 16 + (lane & 15)) * 264 + (lane >> 4) * 8;
#pragma unroll
              for (int k = 0; k < 8; ++k) if (k * 32 < kmax) o = __builtin_amdgcn_mfma_f32_16x16x32_bf16(*(const LAS bf16x8*)(bp + 32 * k), pa[k], o, 0, 0, 0);
              *(f32x4*)(op + dt * 16) = o * gt; } }
        { float score[4]; const int cur = (t0 + w * 4) >> 6;
#pragma unroll
          for (int q = 0; q < 4; ++q) { const int tl = w * 4 + q; float imp = 0.f;
            if (kmax > 0) {
#pragma unroll
                for (int r = 0; r < 4; ++r) { const LAS bf16* p = Pm + (r * 32 + tl) * 264; const int j0 = 4 * lane;
                    if (j0 < kmax) { const u32x2 pw = *(const LAS u32x2*)(p + j0); imp += lo_bf(pw.x) + hi_bf(pw.x) + lo_bf(pw.y) + 0.5f * hi_bf(pw.y); if (j0 > 0) imp += 0.5f * bf2f(p[j0 - 1]); } } }
            if (lane == 0 || lane == cur || lane == cur - 1) score[q] = INFINITY; else score[q] = (lane <= cur) ? imp : -INFINITY; }
          int rank[4] = {0, 0, 0, 0};
          for (int o2 = 0; o2 <= cur; ++o2) {
#pragma unroll
              for (int q = 0; q < 4; ++q) { const float so = __int_as_float(__builtin_amdgcn_readlane(__float_as_int(score[q]), o2)); rank[q] += (so > score[q] || (so == score[q] && o2 < lane)) ? 1 : 0; } }
#pragma unroll
          for (int q = 0; q < 4; ++q) { const unsigned long long mk = __ballot(rank[q] < 16 && score[q] > -INFINITY);
              if (lane == 0) SELM[(size_t)(b * SEQ + t0 + w * 4 + q) * 4 + g] = mk; } }
        if (side_cvt) moe_pair_store(mt, cvv, lane);
    }
    __syncthreads();
}

namespace swa {
constexpr int D = 128, NW = 8, QBLK = 32, KVBLK = 64, QB = NW * QBLK;
constexpr int SHM_V = KVBLK * D * 2, SHM_K = KVBLK * D * 2;
constexpr int LDS_BYTES = 2 * SHM_V + 2 * SHM_K + NW * 64 * 4;
constexpr float SCALE = 0.08838834764831845f, THR = 8.f;
typedef short s16x4 __attribute__((ext_vector_type(4)));
typedef float f32x16 __attribute__((ext_vector_type(16)));
#define KSWZ(row, colB) ((row) * 256 + ((colB) ^ (((row) & 7) << 4)))
#define SBAR() __builtin_amdgcn_sched_barrier(0)
__device__ __forceinline__ int v_st(int k, int c) { const int kk = (k & ~0xC) | ((k & 4) << 1) | ((k & 8) >> 1); return ((kk >> 3) * 4 + (c >> 5)) * 512 + ((kk & 7) * 32 + (c & 31)) * 2; }
__device__ __forceinline__ int v_rd_base(int lane) { return ((lane & 3) << 3) | (((lane >> 2) & 3) << 6) | (((lane >> 4) & 1) << 5) | (((lane >> 5) & 1) << 8); }
constexpr int v_rd_off(int d0, int ks, int half) { return d0 * 512 + ks * 4096 + half * 2048; }
__device__ __forceinline__ int crow(int r, int hi) { return (r & 3) + 8 * (r >> 2) + 4 * hi; }
__device__ __forceinline__ unsigned cvtpk(float lo, float hi) { unsigned r; asm volatile("v_cvt_pk_bf16_f32 %0, %1, %2" : "=v"(r) : "v"(lo), "v"(hi)); return r; }
__device__ __forceinline__ bf16x8 load8(const bf16* p) { return *reinterpret_cast<const bf16x8*>(p); }
__device__ __forceinline__ void mask_tile(f32x16& p0, f32x16& p1, int dq, unsigned W) {
    const float NEG = -__builtin_inff();
    asm volatile("" : "+v"(dq));
#pragma unroll
    for (int r = 0; r < 16; ++r) { const int c = (r & 3) + 8 * (r >> 2);
        if ((unsigned)(dq - c) >= W) p0[r] = NEG;
        if ((unsigned)(dq - c - 32) >= W) p1[r] = NEG; }
}
__device__ __forceinline__ void mask_all(f32x16& p0, f32x16& p1, bool on) {
    const float NEG = -__builtin_inff();
#pragma unroll
    for (int r = 0; r < 16; ++r) { p0[r] = on ? p0[r] : NEG; p1[r] = on ? p1[r] : NEG; }
}
__device__ __forceinline__ void partialSM(f32x16& p0, f32x16& p1, float& m_reg, float& mn, float& alpha) {
    float pmax = p0[0]; for (int r = 1; r < 16; ++r) pmax = fmaxf(pmax, p0[r]); for (int r = 0; r < 16; ++r) pmax = fmaxf(pmax, p1[r]);
    { auto rr = __builtin_amdgcn_permlane32_swap(__float_as_uint(pmax), __float_as_uint(pmax), false, false);
      pmax = fmaxf(__uint_as_float(rr[0]), __uint_as_float(rr[1])); }
    constexpr float C2 = 1.4426950408889634f * SCALE;
    if (__builtin_expect(__all((pmax - m_reg) * SCALE <= THR), 1)) { mn = m_reg; alpha = 1.f; }
    else { mn = fmaxf(m_reg, pmax); alpha = __builtin_amdgcn_exp2f((m_reg - mn) * C2); m_reg = mn; }
    const float mnL = -mn * C2;
    for (int r = 0; r < 16; ++r) p0[r] = fmaf(p0[r], C2, mnL); for (int r = 0; r < 16; ++r) p1[r] = fmaf(p1[r], C2, mnL);
    for (int r = 0; r < 16; ++r) p0[r] = __builtin_amdgcn_exp2f(p0[r]);
}
__device__ __forceinline__ void finishSM(f32x16& p0, f32x16& p1, float alpha, float& l_reg, bf16x8& pa0, bf16x8& pa1, bf16x8& pa2, bf16x8& pa3) {
    for (int r = 0; r < 16; ++r) p1[r] = __builtin_amdgcn_exp2f(p1[r]);
    float ps = 0; for (int r = 0; r < 16; ++r) ps += p0[r]; for (int r = 0; r < 16; ++r) ps += p1[r];
    { auto rr = __builtin_amdgcn_permlane32_swap(__float_as_uint(ps), __float_as_uint(ps), false, false);
      ps = __uint_as_float(rr[0]) + __uint_as_float(rr[1]); }
    l_reg = l_reg * alpha + ps;
#define PK4(P, B_, OUT) do { unsigned a0 = cvtpk(P[B_+0], P[B_+1]), a1 = cvtpk(P[B_+2], P[B_+3]);                          \
        unsigned b0 = cvtpk(P[B_+4], P[B_+5]), b1 = cvtpk(P[B_+6], P[B_+7]);                                             \
        auto r0 = __builtin_amdgcn_permlane32_swap(a0, b0, false, false); auto r1 = __builtin_amdgcn_permlane32_swap(a1, b1, false, false); \
        u32x4 w = {r0[0], r1[0], r0[1], r1[1]}; OUT = *reinterpret_cast<bf16x8*>(&w); } while (0)
    PK4(p0, 0, pa0); PK4(p0, 8, pa1); PK4(p1, 0, pa2); PK4(p1, 8, pa3);
#undef PK4
}
template <int KB>
__device__ __forceinline__ void qkt(f32x16& p0, f32x16& p1, const char* K_lds, int r32, int hi, const bf16x8* qr) {
    p0 = f32x16{}; p1 = f32x16{};
    const char* kb[4];
#pragma unroll
    for (int dd = 0; dd < 4; ++dd) kb[dd] = K_lds + KB * SHM_K + KSWZ(r32, (dd * 16 + hi * 8) * 2);
#pragma unroll
    for (int d0 = 0; d0 < 8; ++d0) { const char* a = kb[d0 & 3] + (d0 >> 2) * 128;
        bf16x8 b0 = *reinterpret_cast<const bf16x8*>(a);
        bf16x8 b1 = *reinterpret_cast<const bf16x8*>(a + 32 * 256);
        p0 = __builtin_amdgcn_mfma_f32_32x32x16_bf16(b0, qr[d0], p0, 0, 0, 0);
        p1 = __builtin_amdgcn_mfma_f32_32x32x16_bf16(b1, qr[d0], p1, 0, 0, 0); }
}
template <int VB>
__device__ __forceinline__ void pv_tile(f32x16* o, int vb0, bf16x8 pa0, bf16x8 pa1, bf16x8 pa2, bf16x8 pa3) {
#define TRRD(dst, off) asm volatile("ds_read_b64_tr_b16 %0, %1 offset:%2" : "=&v"(dst) : "v"(vb0), "i"(off) : "memory")
#define PV_D0(d0) do { s16x4 l0, l1, l2, l3, h0, h1, h2, h3; constexpr int b_ = VB * SHM_V + v_rd_off(d0, 0, 0);   \
        TRRD(l0, b_); TRRD(h0, b_ + 2048); TRRD(l1, b_ + 4096); TRRD(h1, b_ + 6144); TRRD(l2, b_ + 8192); TRRD(h2, b_ + 10240); TRRD(l3, b_ + 12288); TRRD(h3, b_ + 14336); \
        asm volatile("s_waitcnt lgkmcnt(0)" ::: "memory"); SBAR();   \
        o[d0] = __builtin_amdgcn_mfma_f32_32x32x16_bf16(pa0, (bf16x8){l0[0], l0[1], l0[2], l0[3], h0[0], h0[1], h0[2], h0[3]}, o[d0], 0, 0, 0);   \
        o[d0] = __builtin_amdgcn_mfma_f32_32x32x16_bf16(pa1, (bf16x8){l1[0], l1[1], l1[2], l1[3], h1[0], h1[1], h1[2], h1[3]}, o[d0], 0, 0, 0);   \
        o[d0] = __builtin_amdgcn_mfma_f32_32x32x16_bf16(pa2, (bf16x8){l2[0], l2[1], l2[2], l2[3], h2[0], h2[1], h2[2], h2[3]}, o[d0], 0, 0, 0);   \
        o[d0] = __builtin_amdgcn_mfma_f32_32x32x16_bf16(pa3, (bf16x8){l3[0], l3[1], l3[2], l3[3], h3[0], h3[1], h3[2], h3[3]}, o[d0], 0, 0, 0); } while (0)
    PV_D0(0); PV_D0(1); PV_D0(2); PV_D0(3);
#undef PV_D0
#undef TRRD
}
struct BlockRef { const bf16* Q; const bf16* K; const bf16* V; int P0, tok0, hh; };
struct Seam { bf16x8 qr[8]; bf16x8 st_v0, st_v1, st_k0, st_k1; };
__device__ __forceinline__ int swa_jlo(int P0, int W) { const int lowk = P0 - W + 1; return lowk > 0 ? lowk / KVBLK : 0; }
#define ROW(p, k0, rr) ((p) + (size_t)((k0) + (rr)) * D + sc)
#define VMW() asm volatile("s_waitcnt vmcnt(0)" ::: "memory")
#define VMWN(n) asm volatile("s_waitcnt vmcnt(%0)" :: "i"(n) : "memory")
#define SLOAD_H(Kp, Vp, k0) do { S.st_v0 = load8(ROW(Vp, k0, sr)); S.st_v1 = load8(ROW(Vp, k0, 32 + sr));              \
                         S.st_k0 = load8(ROW(Kp, k0, sr)); S.st_k1 = load8(ROW(Kp, k0, 32 + sr)); } while (0)
#define SWRITE_HK(bf) do { *(bf16x8*)(K_lds + (bf) * SHM_K + kws) = S.st_k0; *(bf16x8*)(K_lds + (bf) * SHM_K + kws + 32 * 256) = S.st_k1; } while (0)
#define SWRITE_HV(bf) do { *(bf16x8*)(V_lds + (bf) * SHM_V + vst0) = S.st_v0; *(bf16x8*)(V_lds + (bf) * SHM_V + vst1) = S.st_v1; } while (0)
#define SWRITE_H(bf) do { SWRITE_HV(bf); SWRITE_HK(bf); } while (0)
__device__ __forceinline__ int lane_id() { return (int)__builtin_amdgcn_mbcnt_hi(~0u, __builtin_amdgcn_mbcnt_lo(~0u, 0u)); }
__device__ __forceinline__ void prime(const BlockRef& cur, int W, char* lds, Seam& S, int wid) {
    (void)wid; const int tid = threadIdx.x, lane = tid & 63, r32 = lane & 31, hi = lane >> 5;
    const int sr = tid >> 4, sc = (tid & 15) * 8, kws = KSWZ(sr, sc * 2); char* K_lds = lds + 2 * SHM_V;
    const int kb0 = swa_jlo(cur.P0, W) * KVBLK;
    for (int d0 = 0; d0 < 8; ++d0) S.qr[d0] = load8(cur.Q + (size_t)(wid * QBLK + r32) * D + d0 * 16 + hi * 8);
    SLOAD_H(cur.K, cur.V, kb0); VMW(); SWRITE_HK(0);
    __syncthreads();
}
template <bool SEL, int MODE>
__device__ __forceinline__ void block(const BlockRef& cur, const BlockRef& nxt, int skv, int W, char* lds, Seam& S,
                                      const unsigned long long* SELM, const float* GATES, int gate_off, float* OACC, bf16* OCAT, int wid) {
    (void)wid; const int tid = threadIdx.x, lane = tid & 63, r32 = lane & 31, hi = lane >> 5;
    const int j_lo = swa_jlo(cur.P0, W);
    int j_hi = (cur.P0 + QB - 1) / KVBLK + 1; if (j_hi > skv / KVBLK) j_hi = skv / KVBLK;
    const int NT = j_hi - j_lo;
    const int kbn = swa_jlo(nxt.P0, W) * KVBLK;
    const int qlo = cur.P0 + wid * QBLK, qm = qlo + r32 - 4 * hi;
    char* V_lds = lds; char* K_lds = lds + 2 * SHM_V;
    float* ws = (float*)(lds + 2 * SHM_V + 2 * SHM_K) + wid * 64; float* li_l = ws, * al_l = ws + 32;
    float m_reg = -1e30f, l_reg = 0; f32x16 o[4] = {};
    const int sr = tid >> 4, sc = (tid & 15) * 8, vst0 = v_st(sr, sc), vst1 = vst0 + 8192  , kws = KSWZ(sr, sc * 2);
    const int vb0 = (int)(uintptr_t)V_lds + v_rd_base(lane);
    const bf16* Kh = cur.K; const bf16* Vh = cur.V;
    unsigned long long* selt = (unsigned long long*)(lds + LDS_BYTES) + wid * 32;
    if (SEL) { if (hi == 0) selt[r32] = SELM[(size_t)(cur.tok0 + wid * QBLK + r32) * 4 + (cur.hh >> 2)]; }
#define RESC(a) do { if (__any((a) < 1.f)) { if (hi == 0) al_l[r32] = (a); asm volatile("s_waitcnt lgkmcnt(0)" ::: "memory");              \
                     for (int d_ = 0; d_ < 4; ++d_) for (int r = 0; r < 16; ++r) o[d_][r] *= al_l[crow(r, hi)]; } } while (0)
#define KBASE(t) ((j_lo + (t)) * KVBLK)
#define MASKT(P0_, P1_, t) do { const int kb_ = KBASE(t); if (kb_ + KVBLK - 1 > qlo || kb_ <= qlo + QBLK - 1 - W) mask_tile(P0_, P1_, qm - kb_, (unsigned)W); \
                                if (SEL) { const unsigned long long sm_ = selt[r32]; mask_all(P0_, P1_, ((sm_ >> (j_lo + (t))) & 1ull) != 0ull); } } while (0)
    constexpr int NQL = 8;
#define SEAM_K0() do { VMWN(NQL); SWRITE_HK(0); SBAR(); } while (0)
    f32x16 pA0, pA1, pB0, pB1; float mnA, mnB, alA, alB; bf16x8 pa0, pa1, pa2, pa3;
    SWRITE_HV(0); SBAR();
    if (NT > 1) { SLOAD_H(Kh, Vh, KBASE(1)); }
    SBAR(); qkt<0>(pA0, pA1, K_lds, r32, hi, S.qr);
    MASKT(pA0, pA1, 0); partialSM(pA0, pA1, m_reg, mnA, alA);
    if (NT > 1) { VMW(); SWRITE_H(1); }
    __syncthreads();
#define HALF_STEP(PX0, PX1, mnX, alX, PY0, PY1, alY, t, KB, VB, SB) do {                                                      \
        SBAR(); qkt<KB>(PX0, PX1, K_lds, r32, hi, S.qr);                                             \
        finishSM(PY0, PY1, alY, l_reg, pa0, pa1, pa2, pa3); SBAR();                                                           \
        if ((t) + 1 < NT) { SLOAD_H(Kh, Vh, KBASE((t) + 1)); SBAR(); }                                               \
        pv_tile<VB>(o, vb0, pa0, pa1, pa2, pa3); MASKT(PX0, PX1, (t)); partialSM(PX0, PX1, m_reg, mnX, alX);                                        \
        __syncthreads();                                                                                                      \
        if ((t) + 1 < NT) { VMW(); SWRITE_H(SB); }                                                                          \
        RESC(alX); __syncthreads(); } while (0)
    for (int t = 1; t + 1 < NT; t += 2) {
        HALF_STEP(pB0, pB1, mnB, alB, pA0, pA1, alA, t, 1, 0, 0);
        HALF_STEP(pA0, pA1, mnA, alA, pB0, pB1, alB, t + 1, 0, 1, 1);
    }
    const bool even = (NT & 1) == 0;
    if (even) { SBAR(); qkt<1>(pB0, pB1, K_lds, r32, hi, S.qr); SBAR(); }
    SLOAD_H(nxt.K, nxt.V, kbn); SBAR();
#pragma unroll
    for (int d0 = 0; d0 < 8; ++d0) S.qr[d0] = load8(nxt.Q + (size_t)(wid * QBLK + r32) * D + d0 * 16 + hi * 8);
    SBAR();
    finishSM(pA0, pA1, alA, l_reg, pa0, pa1, pa2, pa3); SBAR();
    pv_tile<0>(o, vb0, pa0, pa1, pa2, pa3);
    if (even) { MASKT(pB0, pB1, NT - 1); partialSM(pB0, pB1, m_reg, mnB, alB); __syncthreads(); RESC(alB);
        finishSM(pB0, pB1, alB, l_reg, pa0, pa1, pa2, pa3); SBAR(); pv_tile<1>(o, vb0, pa0, pa1, pa2, pa3); }
    SBAR(); SEAM_K0();
    if (hi == 0) li_l[r32] = l_reg; asm volatile("s_waitcnt lgkmcnt(0)" ::: "memory");
    { const int le = lane_id(), r32e = le & 31, hie = le >> 5;
      const int tokw = cur.tok0 + wid * QBLK; const float* gp = GATES + (size_t)tokw * 48 + gate_off + cur.hh;
      float* op = OACC + (size_t)tokw * DM + cur.hh * 128; bf16* cp = OCAT + (size_t)tokw * DM + cur.hh * 128;
#pragma unroll
      for (int r = 0; r < 16; ++r) { const int orow = crow(r, hie);
        const float sc_ = gp[orow * 48] * __builtin_amdgcn_rcpf(li_l[orow]);
        const unsigned ob = (unsigned)(orow * DM + r32e);
#pragma unroll
        for (int d0 = 0; d0 < 4; ++d0) { const float v = op[ob + d0 * 32] + o[d0][r] * sc_;
            if (MODE == 0) ((unsigned*)op)[ob + d0 * 32] = __float_as_uint(v);
            else cp[ob + d0 * 32] = (bf16)(cvtpk(v, v) & 0xffffu); } } }
    __syncthreads();
#undef RESC
#undef KBASE
#undef MASKT
#undef SEAM_K0
#undef HALF_STEP
}
#undef ROW
#undef VMW
#undef VMWN
#undef SLOAD_H
#undef SWRITE_HK
#undef SWRITE_HV
#undef SWRITE_H
__device__ __forceinline__ int swa_nramp(int nqb, int W) { const int t = W - 1; const int n = t < 0 ? 0 : t / QB + 1; return n > nqb ? nqb : n; }
struct SwaItem { int bh, qb0, qb1; };
__device__ __forceinline__ SwaItem swa_decode(int L, int nqb, int nx, int nramp) {
    SwaItem it; it.bh = L / nx; const int x = L - it.bh * nx; const int ns = nqb - nramp;
    if (x < ns) { it.qb0 = it.qb1 = nqb - 1 - x; } else { it.qb0 = x - ns; it.qb1 = nramp - 1 - it.qb0; }
    return it;
}
template <bool SEL, int MODE>
__device__ __forceinline__ void phase(int wid, char* lds, const bf16* Q, const bf16* K, const bf16* V, int W, const unsigned long long* SELM, const float* GATES, int gate_off, float* OACC, bf16* OCAT) {
    constexpr int nqb = SEQ / QB;
    const int nramp = swa_nramp(nqb, W), nx = (nramp + 1) / 2 + (nqb - nramp), total = nx * BATCH * 16, stride = gridDim.x;
    int L = blockIdx.x; if (L >= total) return;
    auto mkref = [&](const SwaItem& it, int pass) { const int qb = pass ? it.qb1 : it.qb0, b = it.bh >> 4, hh = it.bh & 15; BlockRef r;
        r.Q = Q + ((size_t)it.bh * SEQ + (size_t)qb * QB) * D; r.K = K + (size_t)(b * 4 + (hh >> 2)) * SPAD * D; r.V = V + (size_t)(b * 4 + (hh >> 2)) * SPAD * D;
        r.P0 = qb * QB; r.tok0 = b * SEQ + qb * QB; r.hh = hh; return r; };
    SwaItem it = swa_decode(L, nqb, nx, nramp); int pass = 0;
    BlockRef cur = mkref(it, 0);
    Seam S;
    __syncthreads();
    prime(cur, W, lds, S, wid);
    for (;;) {
        const bool more_pass = pass == 0 && it.qb1 != it.qb0, more_item = L + stride < total, last = !more_pass && !more_item;
        SwaItem itn = it; int passn = pass + 1, Ln = L;
        if (!more_pass) { passn = 0; Ln = more_item ? L + stride : L; itn = swa_decode(Ln, nqb, nx, nramp); }
        const BlockRef nxt = last ? cur : mkref(itn, passn);
        block<SEL, MODE>(cur, nxt, SEQ, W, lds, S, SELM, GATES, gate_off, OACC, OCAT, wid);
        if (last) break;
        cur = nxt; it = itn; pass = passn; L = Ln;
    }
}
#undef KSWZ
#undef SBAR
}

#ifndef REPEAT_PHASE
#define REPEAT_PHASE -1
#endif
#ifndef PROBE_LO
#define PROBE_LO 22
#define PROBE_HI 22
#define PROBE_SCALE 0.1f
#endif
#ifndef PROBE
#define PROBE 0
#endif
__device__ __forceinline__ void probe_compare(const Ctx& C, const bf16* Xa, const bf16* Xb, size_t n) {
    float se = 0.f, sr = 0.f;
    for (size_t i = (size_t)C.bid * NTHR + C.tid; i < n; i += (size_t)C.G * NTHR) { const float a = bf2f(Xa[i]), b = bf2f(Xb[i]); se += (a - b) * (a - b); sr += b * b; }
    se = wave_sum(se); sr = wave_sum(sr);
    if (C.lane == 0) { atomicAdd(WSP(float, WS_CTL) + CW_PROBE, se); atomicAdd(WSP(float, WS_CTL) + CW_PROBE + 1, sr); }
}
#ifndef MK_SPLIT
#define MK_SPLIT 0
#endif
constexpr int N_PHASES = 39;
#define COMMON_PHASES(l, pb) \
      \
      \
    if (IN(pb + 1)) { FRESH_TID(); pg8::Gemm g{WSP(bf16, WS_XR), WSP(bf16, WS_WKT) + (size_t)l * 4 * 1024 * DM, DM, DM, DM}; \
                      CrossOrder S{4, G, c, 1024, (long long)256 * DM * 2, (long long)256 * DM * 2, (long long)1024 * DM * 2}; EpiSoftmaxP E{ARP(bf16, A_PC), 1024, WSP(float, WS_RSQ) + (size_t)(2 * l) * T * 8, (LAS float*)(C.lds + LDS_AUX)}; pg8::gemm_phase(L, g, S, E, C.tid); } SEAM(pb + 1); \
      \
    if (IN(pb + 3)) { FRESH_TID(); pg8::Gemm g{ARP(bf16, A_PC), WSP(bf16, WS_VWT) + (size_t)l * 4 * DM * 1024, 1024, 1024, 1024}; \
                      CrossOrder S{8, G, c, DM, (long long)256 * 1024 * 2, (long long)256 * 1024 * 2, (long long)DM * 1024 * 2}; EpiResidT<false> E{WSP(bf16, WS_XR), WSP(bf16, WS_XR), DM, WSP(float, WS_RSQ) + (size_t)(2 * l + 1) * T * 8, (LAS float*)(C.lds + LDS_AUX)}; pg8::gemm_phase(L, g, S, E, C.tid); } SEAM(pb + 3); \
      \
      \
    if (IN(pb + 5)) { FRESH_TID(); pg8::Gemm g{WSP(bf16, WS_XR), WSP(bf16, WS_W_ROUTER) + (size_t)l * 256 * DM, DM, DM, 512}; RouterOrder S{G, c}; EpiStoreF32Rows E{ARP(float, A_XS), 256, WSP(float, WS_RSQ) + (size_t)(2 * l + 1) * T * 8};     pg8::gemm_phase(L, g, S, E, C.tid); } SEAM(pb + 5); \
    if (IN(pb + 6)) { FRESH_TID(); phase_route(C, A, l); } SEAM(pb + 6); \
    if (IN(pb + 7)) { FRESH_TID(); phase_gather(C, l); } SEAM(pb + 7); \
    if (IN(pb + 8)) { FRESH_TID(); const bool side_ = (l == 0) && (G == 256) && MOE_CVT_SIDE_H > 0; const int Gm_ = side_ ? G - MOE_CVT_WG : G; \
                      if (side_ && c >= Gm_) moe_convert_items_x2(C, MOE_CVT_BASE_H, MOE_CVT_BASE_H + MOE_CVT_SIDE_H, (c - Gm_) * NWAVES + C.wave, MOE_CVT_WG * NWAVES); else { \
                      LAS int* tab = (LAS int*)(C.lds + LDS_AUX); moe_build_table(C, ctl + CW_MOE_CNT + l * 64, tab); \
                      pg8::Gemm g{WSP(bf16, WS_XR), WSP(bf16, WS_W_GU) + (size_t)l * NEXP * 1024 * DM, DM, DM, DM}; MoeOrder S{tab, 4, Gm_, c, 0}; EpiHid E{ARP(bf16, A_HID), ARP(int, A_ROWSLOT), WSP(float, WS_RSQ) + (size_t)(2 * l + 1) * T * 8}; \
                      LAS int* rc = tab + 256; { pg8::Unit u_; const int* rs_ = ARP(int, A_ROWSLOT); for (int i_ = 0; i_ < 12 && S.next(i_, u_); ++i_) if (C.tid < 256) rc[i_ * 256 + C.tid] = (C.tid < u_.pm) ? (rs_[u_.aux + C.tid] >> 1) : 0; } __syncthreads(); \
                      pg8::gemm_phase<EpiHid, MoeOrder, true>(L, g, S, E, C.tid, rc); } } SEAM(pb + 8); \
    if (IN(pb + 9)) { FRESH_TID(); LAS int* tab = (LAS int*)(C.lds + LDS_AUX); moe_build_table(C, ctl + CW_MOE_CNT + l * 64, tab); \
                      pg8::Gemm g{ARP(bf16, A_HID), WSP(bf16, WS_W_DN) + (size_t)l * NEXP * DM * FF, FF, FF, FF}; MoeOrder S{tab, 8, G, c, 1}; EpiMoeDown E{ARP(int, A_ROWSLOT), ARP(float, A_WTS), ARP(bf16, A_YE)}; pg8::gemm_phase(L, g, S, E, C.tid); } SEAM(pb + 9); \
    if (IN(pb + 10)) { FRESH_TID(); if (l == 0) phase_combine_norm(C, nullptr, nullptr); else phase_combine_norm(C, INP(I_NORM_FINAL), ((float*)INP(N_INPUTS))); } \
    if (l == 0) SEAM(pb + 10);

__global__ void __launch_bounds__(NTHR, 2) mk_fwd(Args args) {
    extern __shared__ __attribute__((aligned(16))) unsigned char lds_raw[];
    Ctx C; C.lds = (LAS unsigned char*)lds_raw; C.tid = threadIdx.x; C.lane = C.tid & 63; C.wave = __builtin_amdgcn_readfirstlane(C.tid >> 6);
    C.G = gridDim.x; C.bid = blockIdx.x; C.gw = C.bid * NWAVES + C.wave; C.ngw = C.G * NWAVES; C.ws = args.ws;
    const Args& A = args; (void)A;
    volatile LAS unsigned* MISC = (volatile LAS unsigned*)(C.lds + LDS_MISC);
    if (C.tid < 64) MISC[C.tid] = 0u;
    if (C.tid <= N_INPUTS) ((LAS unsigned long long*)(C.lds + LDS_PTAB))[C.tid] = (C.tid < N_INPUTS) ? (unsigned long long)args.in[C.tid < N_INPUTS ? C.tid : 0] : (unsigned long long)args.out;
    __syncthreads();
    unsigned* ctl = WSP(unsigned, WS_CTL);
    const int lo = args.ph_lo, hi = args.ph_hi;
    XcdBarrier bar; bar.bar = ctl + CW_BAR; bar.x = 0; bar.st = MISC + 8;
    if (hi - lo > 1) bar = xcd_barrier_post(ctl + CW_BAR, MISC + 8);
#ifndef ONLY_PHASE
#define ONLY_PHASE -1
#endif
#define FRESH_TID() do { int t_ = threadIdx.x; asm volatile("" : "+v"(t_)); C.tid = t_; C.lane = t_ & 63; } while (0)
#define IN(k) ((ONLY_PHASE < 0 || ONLY_PHASE == (k)) && lo <= (k) && (k) < hi)
#if PROBE == 2
    unsigned long long tA_ = 0, tB_ = 0;
    if (PROBE_LO == 0) tA_ = __builtin_amdgcn_s_memrealtime();
#define SEAM(k) do { if (IN(k) && IN((k) + 1)) xcd_barrier(bar); if ((k) == PROBE_LO - 1) tA_ = __builtin_amdgcn_s_memrealtime(); if ((k) == PROBE_HI) tB_ = __builtin_amdgcn_s_memrealtime(); } while (0)
#else
#define SEAM(k) do { if (IN(k) && IN((k) + 1)) xcd_barrier(bar); } while (0)
#endif
    LAS unsigned char* L = C.lds;
    const int c = C.bid, G = C.G;

    if (IN(0)) { FRESH_TID(); for (int rep = 0; rep < (REPEAT_PHASE == 0 ? 2 : 1); ++rep) phase_prologue(C, A); } SEAM(0);
    if (IN(3)) { FRESH_TID(); const bool side = (G == 256) && MOE_CVT_SIDE_A > 0; const int Gg = side ? G - MOE_CVT_WG : G;
                 if (c < Gg) { pg8::Gemm g{(const bf16*)C.ws, (const bf16*)C.ws, DM, DM, DM}; AbInMemOrder S; S.d.init(T, AB_PAD, DM, DM, AB_PAD, Gg, c); S.m = MemProjOrder{Gg, c};
                               EpiAbInMem E{EpiAbIn{ARP(bf16, A_PAB), ARP(float, A_GF32)}, EpiStoreBf16{WSP(bf16, WS_KP), DM, 1.f}}; pg8::gemm_phase(L, g, S, E, C.tid); }
                 else moe_convert_items(C, MOE_CVT_TOTAL - MOE_CVT_SIDE_A - MOE_CVT_SIDE_B, MOE_CVT_TOTAL - MOE_CVT_SIDE_B, (c - Gg) * NWAVES + C.wave, MOE_CVT_WG * NWAVES); } SEAM(3);
    if (IN(4)) { FRESH_TID(); phase_mixer_prep(C, A); } SEAM(4);
    if (IN(5)) { FRESH_TID(); if (C.bid < 16 && C.wave == 0) ml_gate_scan(C, C.bid);
                 pg8::Gemm g{ARP(bf16, A_LIN), WSP(bf16, WS_W_LORA), 256, 256, 256}; pg8::DenseOrder S; S.init(T, 3072, 256, 256, 3072, G, c);
                 EpiLora E{INP(I_RW_W0), INP(I_RW_A0), INP(I_RW_K_A), ARP(bf16, A_KK), ARP(bf16, A_KR), ARP(float, A_WD), ARP(bf16, A_BV), ARP(bf16, A_KP), ARP(bf16, A_GG)}; pg8::gemm_phase(L, g, S, E, C.tid);
                 { pg8::Gemm g2{WSP(bf16, WS_KP), WSP(bf16, WS_W_CAQ), DM, DM, 512}; WktOrder S2{G, c}; EpiStoreBf16 E2{WSP(bf16, WS_WKT), DM, 0.04419417382415922f}; pg8::gemm_phase(L, g2, S2, E2, C.tid); }
                 { pg8::Gemm g3{WSP(bf16, WS_W_CAO), WSP(bf16, WS_VP), DM, DM, 512}; VwtOrder S3{G, c}; EpiStoreBf16 E3{WSP(bf16, WS_VWT), 1024, 1.f}; pg8::gemm_phase(L, g3, S3, E3, C.tid); } } SEAM(5);
    if (IN(6)) { FRESH_TID(); rwkv_prep_units(C, G == 256); for (int it = C.bid; it < 1024; it += G) ml_intra_unit(C, it, G == 256); } SEAM(6);
    if (IN(7)) { FRESH_TID(); for (int it = C.bid; it < 256; it += G) rwkv_scan_slice(C, it); ml_state_scan(C, 0, G); } SEAM(7);
    if (IN(8)) { FRESH_TID(); for (int it = C.bid; it < 1024; it += G) ml_out_unit(C, it, (G == 256) && MOE_CVT_SIDE_G > 0); rwkv_out_items(C); } SEAM(8);
    if (IN(9)) { FRESH_TID(); pg8::Gemm g{ARP(bf16, A_YCAT), WSP(bf16, WS_W_ABOUT), DM, DM, DM}; pg8::DenseOrder S; S.init(T, DM, DM, DM, DM, G, c); EpiResidT<true> E{INP(I_X), WSP(bf16, WS_XR), DM, WSP(float, WS_RSQ), (LAS float*)(C.lds + LDS_AUX)}; pg8::gemm_phase(L, g, S, E, C.tid); } SEAM(9);
    COMMON_PHASES(0, 10)
    if (IN(21)) { FRESH_TID(); const bool side = (G == 256); const int Gg = side ? G - MOE_CVT_WG : G;
                  if (c >= Gg) moe_convert_items_x2(C, MOE_CVT_TOTAL - MOE_CVT_SIDE_B, MOE_CVT_TOTAL, (c - Gg) * NWAVES + C.wave, MOE_CVT_WG * NWAVES); else {
                  pg8::Gemm g{WSP(bf16, WS_XR), WSP(bf16, WS_W_NSAIN), DM, DM, DM}; pg8::DenseOrder S; S.init(T, NSA_PAD, DM, DM, NSA_PAD, Gg, c);
                  EpiNsaIn E{ARP(bf16, A_Q), ARP(bf16, A_QROT), ARP(bf16, A_KV6), ARP(float, A_GATES), INP(I_NSA_GATE_B), WSP(float, WS_TAB + TAB_ROPE_COS), WSP(float, WS_TAB + TAB_ROPE_SIN), WSP(float, WS_RSQ) + (size_t)4 * T * 8}; pg8::gemm_phase(L, g, S, E, C.tid); } } SEAM(21);
    if (IN(22)) { FRESH_TID(); pg8::Gemm g{ARP(bf16, A_KV6), WSP(bf16, WS_W_CMP1), 2048, 4096, 512}; CmpOrder S{G, c}; EpiStoreF32 E{ARP(float, A_CPART), 256}; pg8::gemm_phase(L, g, S, E, C.tid); } SEAM(22);
    if (IN(23)) { FRESH_TID(); phase_cmp_finish(C, A); } SEAM(23);
    if (IN(24)) { FRESH_TID(); for (int rep = 0; rep < (REPEAT_PHASE == 24 ? 2 : 1); ++rep) phase_cmp_attn_mma(C, G == 256); } SEAM(24);
#if PROBE == 1
    if (IN(25)) { FRESH_TID(); phase_selwin_naive(C, ARP(bf16, A_OCATREF)); xcd_barrier(bar); }
#endif
    if (IN(25)) { FRESH_TID(); swa::phase<true, 0>(C.wave, (char*)lds_raw, ARP(bf16, A_QROT), (const bf16*)(C.ws + WS_ARENA + A_KV6 + 2 * KV6_STRIDE), (const bf16*)(C.ws + WS_ARENA + A_KV6 + 3 * KV6_STRIDE), SEQ,
                                      ARP(const unsigned long long, A_SELMASK), ARP(float, A_GATES), 16, ARP(float, A_OACC), ARP(bf16, A_OCAT)); } SEAM(25);
    if (IN(26)) { FRESH_TID(); swa::phase<false, 1>(C.wave, (char*)lds_raw, ARP(bf16, A_QROT), (const bf16*)(C.ws + WS_ARENA + A_KV6 + 4 * KV6_STRIDE), (const bf16*)(C.ws + WS_ARENA + A_KV6 + 5 * KV6_STRIDE), 512,
                                       ARP(const unsigned long long, A_SELMASK), ARP(float, A_GATES), 32, ARP(float, A_OACC), ARP(bf16, A_OCAT)); } SEAM(26);
#if PROBE == 1
    if (IN(26)) { FRESH_TID(); probe_compare(C, ARP(bf16, A_OCAT), ARP(bf16, A_OCATREF), (size_t)T * DM); }
#endif
    { int t2 = C.wave * 64 + swa::lane_id(); asm volatile("" : "+v"(t2)); C.tid = t2 & 511; C.lane = t2 & 63; }
    if (IN(27)) { FRESH_TID(); pg8::Gemm g{ARP(bf16, A_OCAT), WSP(bf16, WS_W_NSAOUT), DM, DM, DM}; pg8::DenseOrder S; S.init(T, DM, DM, DM, DM, G, c); EpiResidT<false> E{WSP(bf16, WS_XR), WSP(bf16, WS_XR), DM, WSP(float, WS_RSQ) + (size_t)2 * T * 8, (LAS float*)(C.lds + LDS_AUX)}; pg8::gemm_phase(L, g, S, E, C.tid); } SEAM(27);
    COMMON_PHASES(1, 28)
#if PROBE == 2
    xcd_barrier(bar);
    if (C.bid == 0 && C.tid == 0) ((float*)INP(N_INPUTS))[0] = (float)(tB_ - tA_) * (0.01f * PROBE_SCALE);
#elif PROBE
    xcd_barrier(bar);
    if (C.bid == 0 && C.tid == 0) { const float se = __hip_atomic_load((float*)(ctl + CW_PROBE), __ATOMIC_RELAXED, __HIP_MEMORY_SCOPE_AGENT), sr = __hip_atomic_load((float*)(ctl + CW_PROBE + 1), __ATOMIC_RELAXED, __HIP_MEMORY_SCOPE_AGENT);
        ((float*)INP(N_INPUTS))[0] = 1e6f * sqrtf(se / fmaxf(sr, 1e-30f)); }
#endif
#undef IN
#undef SEAM
}

extern "C" void kernel_launch(void* const* d_in, const int* in_sizes, int n_in, void* d_out, int out_size, void* d_ws, size_t ws_size, hipStream_t stream) {
    static int grid = 0;
    if (grid == 0) {
        if (n_in != N_INPUTS || out_size != T * DM || ws_size < WS_END) { fprintf(stderr, "kernel_launch: unexpected shapes (n_in %d, out %d, ws %zu, need %zu)\n", n_in, out_size, ws_size, (size_t)WS_END); grid = -1; return; }
        int dev = 0, cus = 0, per_cu = 0;
        if (hipGetDevice(&dev) != hipSuccess || hipDeviceGetAttribute(&cus, hipDeviceAttributeMultiprocessorCount, dev) != hipSuccess) { grid = -1; return; }
        if (hipFuncSetAttribute((const void*)mk_fwd, hipFuncAttributeMaxDynamicSharedMemorySize, LDS_BYTES) != hipSuccess) { fprintf(stderr, "kernel_launch: hipFuncSetAttribute failed\n"); grid = -1; return; }
        if (hipOccupancyMaxActiveBlocksPerMultiprocessor(&per_cu, (const void*)mk_fwd, NTHR, LDS_BYTES) != hipSuccess || per_cu < 1) fprintf(stderr, "kernel_launch: occupancy query says %d\n", per_cu);
        (void)hipGetLastError();
        grid = cus;
    }
    if (grid < 0) return;
    (void)hipMemsetAsync((char*)d_ws + WS_CTL, 0, CTL_BYTES, stream);
    Args a{};
    for (int i = 0; i < N_INPUTS; ++i) a.in[i] = (const float*)d_in[i];
    a.out = (float*)d_out; a.ws = (unsigned char*)d_ws;
#if MK_SPLIT
    for (int p = 0; p < N_PHASES; ++p) { a.ph_lo = p; a.ph_hi = p + 1; hipLaunchKernelGGL(mk_fwd, dim3(grid), dim3(NTHR), LDS_BYTES, stream, a); }
#else
    a.ph_lo = 0; a.ph_hi = N_PHASES; hipLaunchKernelGGL(mk_fwd, dim3(grid), dim3(NTHR), LDS_BYTES, stream, a);
#endif
}
```

```cpp
#include <hip/hip_runtime.h>
#include <cstdio>
#include <cstdint>

#define LAS __attribute__((address_space(3)))
#define GAS __attribute__((address_space(1)))
typedef unsigned short bf16;
typedef short bf16x8 __attribute__((ext_vector_type(8)));
typedef float f32x4 __attribute__((ext_vector_type(4)));
typedef float f32x2 __attribute__((ext_vector_type(2)));
typedef unsigned u32x4 __attribute__((ext_vector_type(4)));
typedef unsigned u32x2 __attribute__((ext_vector_type(2)));

constexpr int BATCH = 4, SEQ = 4096, DM = 2048, T = BATCH * SEQ, MEMT = 256, MT = BATCH * MEMT;
constexpr float EPS = 1e-6f;
constexpr int ML_COLS = 3080, RW_COLS = 3328, AB_COLS = 6408, AB_PAD = 6656;
constexpr int NSA_COLS = 5168, NSA_PAD = 5376;
constexpr int NEXP = 64, FF = 512;
constexpr int XS_ROWS = 49152;
constexpr int SPAD = SEQ + 64;

enum { I_X = 0, I_MEM, I_NORM_MIX, I_NORM_CROSS, I_NORM_MEM, I_NORM_FFN, I_NORM_FINAL, I_AB_W_IN, I_ML_CONV_W, I_ML_CONV_B, I_ML_GATE_B,
       I_RW_MU, I_RW_W0, I_RW_W_UP, I_RW_A0, I_RW_A_UP, I_RW_G_UP, I_RW_K_K, I_RW_K_A, I_RW_R_K, I_RW_LN_W, I_RW_LN_B, I_AB_W_OUT,
       I_NSA_W_IN, I_NSA_GATE_B, I_CMP_POS, I_CMP_W1, I_CMP_W2, I_NSA_W_OUT, I_CA_WQ, I_CA_WK, I_CA_WV, I_CA_WO,
       I_MOE_WG, I_MOE_BG, I_MOE_WE, I_MOE_BE, I_MOE_W_GATE, I_MOE_W_UP, I_MOE_W_DOWN, N_INPUTS };

constexpr size_t MiB = (size_t)1 << 20;
constexpr size_t WS_CTL = 0, CTL_BYTES = 1 * MiB;
constexpr size_t WS_TAB = 1 * MiB;
constexpr size_t WS_W_ABIN = 3 * MiB;
constexpr size_t WS_W_ABOUT = WS_W_ABIN + 26 * MiB;
constexpr size_t WS_W_LORA = WS_W_ABOUT + 8 * MiB;
constexpr size_t WS_W_NSAIN = WS_W_LORA + 2 * MiB;
constexpr size_t WS_W_NSAOUT = WS_W_NSAIN + 21 * MiB;
constexpr size_t WS_W_CMP1 = WS_W_NSAOUT + 8 * MiB;
constexpr size_t WS_W_CAQ = WS_W_CMP1 + 4 * MiB;
constexpr size_t WS_W_CAK = WS_W_CAQ + 16 * MiB;
constexpr size_t WS_W_CAV = WS_W_CAK + 16 * MiB;
constexpr size_t WS_W_CAO = WS_W_CAV + 16 * MiB;
constexpr size_t WS_W_ROUTER = WS_W_CAO + 16 * MiB;
constexpr size_t WS_W_GU = WS_W_ROUTER + 2 * MiB;
constexpr size_t WS_W_DN = WS_W_GU + 512 * MiB;
constexpr size_t WS_MEMN = WS_W_DN + 256 * MiB;
constexpr size_t WS_KP = WS_MEMN + 8 * MiB;
constexpr size_t WS_VP = WS_KP + 8 * MiB;
constexpr size_t WS_WKT = WS_VP + 8 * MiB;
constexpr size_t WS_VWT = WS_WKT + 32 * MiB;
constexpr size_t WS_XR = WS_VWT + 32 * MiB;
constexpr size_t WS_RSQ = WS_XR + 64 * MiB;
constexpr size_t WS_XN = WS_XR + 128 * MiB;
constexpr size_t WS_ARENA = WS_XN + 64 * MiB;
constexpr size_t A_PAB = 0;
constexpr size_t A_GF32 = A_PAB + 208 * MiB;
constexpr size_t A_QM = A_GF32 + 16 * MiB;
constexpr size_t A_KM = A_QM + 16 * MiB;
constexpr size_t A_IG = A_KM + 16 * MiB;
constexpr size_t A_LF = A_IG + 1 * MiB;
constexpr size_t A_MLA = A_LF + 256 * 1024, A_MLM = A_LF + 512 * 1024;
constexpr size_t A_RR = A_LF + 1 * MiB;
constexpr size_t A_KR = A_RR + 32 * MiB;
constexpr size_t A_VR = A_KR + 32 * MiB;
constexpr size_t A_KK = A_VR + 32 * MiB;
constexpr size_t A_LIN = A_KK + 32 * MiB;
constexpr size_t A_WD = A_LIN + 8 * MiB;
constexpr size_t A_BV = A_WD + 64 * MiB;
constexpr size_t A_KP = A_BV + 32 * MiB;
constexpr size_t A_GG = A_KP + 32 * MiB;
constexpr size_t A_YCAT = A_GG + 32 * MiB;
constexpr size_t A_RWM = A_YCAT + 64 * MiB;
constexpr size_t A_RWN = A_RWM + 32 * MiB, A_RWRW = A_RWN + 32 * MiB, A_RWYL = A_RWRW + 32 * MiB;
constexpr size_t A_MLKV = A_RWYL + 32 * MiB;
constexpr size_t A_MLNUM = A_MLKV + 68 * MiB;
constexpr size_t A_END0 = A_MLNUM + 34 * MiB;
constexpr size_t A_SC = 0;
constexpr size_t A_PC = A_SC + 64 * MiB;
constexpr size_t A_LOGIT = 0;
constexpr size_t A_EID = A_LOGIT + 16 * MiB;
constexpr size_t A_WTS = A_EID + 1 * MiB;
constexpr size_t A_ROWSLOT = A_WTS + 1 * MiB;
constexpr size_t A_LRANK = A_ROWSLOT + 256 * 1024, A_BHIST = A_ROWSLOT + 512 * 1024;
constexpr size_t A_XS = A_ROWSLOT + 1 * MiB;
constexpr size_t A_HID = A_XS + 192 * MiB;
constexpr size_t A_YE = A_HID + 48 * MiB;
constexpr size_t A_END2 = A_YE + 128 * MiB;
constexpr size_t A_Q = 0;
constexpr size_t A_QROT = A_Q + 64 * MiB;
constexpr size_t A_KV6 = A_QROT + 64 * MiB;
constexpr size_t KV6_STRIDE = 17 * MiB;
constexpr size_t A_GATES = A_KV6 + 6 * KV6_STRIDE;
constexpr size_t A_CPART = A_GATES + 4 * MiB;
constexpr size_t A_KCMP = A_CPART + 64 * MiB;
constexpr size_t A_VCMP = A_KCMP + 1 * MiB;
constexpr size_t A_SELMASK = A_VCMP + 1 * MiB;
constexpr size_t A_OACC = A_SELMASK + 1 * MiB;
constexpr size_t A_OCAT = A_OACC + 128 * MiB;
constexpr size_t A_OCATREF = A_OCAT + 64 * MiB;
constexpr size_t A_VCT = A_OCATREF + 64 * MiB;
constexpr size_t A_END3 = A_VCT + 1 * MiB;
constexpr size_t ARENA_BYTES = 860 * MiB;
static_assert(A_END0 <= ARENA_BYTES && A_END2 <= ARENA_BYTES && A_END3 <= ARENA_BYTES, "arena");
constexpr size_t WS_END = WS_ARENA + ARENA_BYTES;
static_assert(WS_END <= (size_t)2048 * MiB, "workspace");
constexpr size_t TAB_ROPE_COS = 0, TAB_ROPE_SIN = 256 * 1024, TAB_CMPBIAS = 512 * 1024, TAB_RSTD = 1024 * 1024;
constexpr int CW_BAR = 4096;
constexpr int CW_MOE_CNT = 16384;
constexpr int CW_MOE_CUR = 16384 + 256;
constexpr int CW_PROBE = 32768;
constexpr int CW_RSQ = 65536;

__device__ __forceinline__ float bf2f(bf16 v) { return __uint_as_float((unsigned)v << 16); }
__device__ __forceinline__ unsigned f2bf(float f) { unsigned u = __float_as_uint(f); return (u + 0x7fffu + ((u >> 16) & 1u)) >> 16; }
__device__ __forceinline__ unsigned pk2(float lo, float hi) { return f2bf(lo) | (f2bf(hi) << 16); }
__device__ __forceinline__ float lo_bf(unsigned w) { return __uint_as_float(w << 16); }
__device__ __forceinline__ float hi_bf(unsigned w) { return __uint_as_float(w & 0xffff0000u); }
__device__ __forceinline__ float sigmoidf_(float x) { return 1.f / (1.f + __expf(-x)); }
__device__ __forceinline__ float siluf_(float x) { return x / (1.f + __expf(-x)); }
#define DPPF(v, ctrl) __int_as_float(__builtin_amdgcn_update_dpp(0, __float_as_int(v), (ctrl), 0xf, 0xf, true))
#define DPP_XOR1 0xB1
#define DPP_XOR2 0x4E
#define DPP_HMIRROR 0x141
#define DPP_MIRROR 0x140
__device__ __forceinline__ float xor16f(float v) { const unsigned u = __float_as_uint(v); auto r = __builtin_amdgcn_permlane16_swap(u, u, false, false); return __uint_as_float(r[0] ^ r[1] ^ u); }
__device__ __forceinline__ float xor32f(float v) { const unsigned u = __float_as_uint(v); auto r = __builtin_amdgcn_permlane32_swap(u, u, false, false); return __uint_as_float(r[0] ^ r[1] ^ u); }
__device__ __forceinline__ float wave_sum(float v) {
    v += DPPF(v, DPP_XOR1); v += DPPF(v, DPP_XOR2); v += DPPF(v, DPP_HMIRROR); v += DPPF(v, DPP_MIRROR); v += xor16f(v); v += xor32f(v); return v;
}
__device__ __forceinline__ float wave_max(float v) {
    v = fmaxf(v, DPPF(v, DPP_XOR1)); v = fmaxf(v, DPPF(v, DPP_XOR2)); v = fmaxf(v, DPPF(v, DPP_HMIRROR)); v = fmaxf(v, DPPF(v, DPP_MIRROR)); v = fmaxf(v, xor16f(v)); v = fmaxf(v, xor32f(v)); return v;
}
__device__ __forceinline__ void unpack8(u32x4 w, float* f) {
    f[0] = lo_bf(w.x); f[1] = hi_bf(w.x); f[2] = lo_bf(w.y); f[3] = hi_bf(w.y); f[4] = lo_bf(w.z); f[5] = hi_bf(w.z); f[6] = lo_bf(w.w); f[7] = hi_bf(w.w);
}
__device__ __forceinline__ void st16_f(void* p, u32x4 w) { *(f32x4*)p = __builtin_bit_cast(f32x4, w); }
__device__ __forceinline__ void st8_f(void* p, u32x2 w) { *(f32x2*)p = __builtin_bit_cast(f32x2, w); }
__device__ __forceinline__ u32x4 pack8f(const float* f) { u32x4 w; w.x = pk2(f[0], f[1]); w.y = pk2(f[2], f[3]); w.z = pk2(f[4], f[5]); w.w = pk2(f[6], f[7]); return w; }

namespace pg8 {
constexpr int BM = 256, BK = 64, HALF = 128, HTB = HALF * BK * 2, STAGE_BYTES = 8 * HTB, NXCD = 8, WGM = 8;
__host__ __device__ __forceinline__ int lds_byte(int r, int c) { const int st = (r >> 4) * 2 + (c >> 5), rr = r & 15, cc = c & 31, ob = rr * 64 + cc * 2; return st * 1024 + (ob ^ (((ob >> 9) & 1) << 5)); }
__host__ __device__ __forceinline__ void stage_rc(int b, int& R, int& C) { const int st = b / 1024, sb = b % 1024, swz = sb ^ (((sb >> 9) & 1) << 5); R = (st >> 1) * 16 + swz / 64; C = (st & 1) * 32 + (swz % 64) / 2; }
__host__ __device__ __forceinline__ int perm32(int rho) { const int n = rho >> 4, i = rho & 15; return 8 * (i >> 2) + 4 * n + (i & 3); }

struct Unit { long long aoff, boff, coff; int pm, pn, aux; };
struct Gemm { const bf16* A; const bf16* Bt; int lda, ldb, K; };

__device__ __forceinline__ bool tile_of(long L, int nM, int nN, int& pm, int& pn) {
    const int nwg = nM * nN; if (L >= nwg) return false;
    int wgid = (int)L; { const int q = nwg / NXCD, r = nwg % NXCD, xcd = wgid % NXCD, off = wgid / NXCD; wgid = (xcd < r ? xcd * (q + 1) : r * (q + 1) + (xcd - r) * q) + off; }
    const int nig = WGM * nN, gid = wgid / nig, fm = gid * WGM, gsz = (nM - fm) < WGM ? (nM - fm) : WGM;
    pm = fm + ((wgid % nig) % gsz); pn = (wgid % nig) / gsz; return true;
}
struct DenseOrder {
    int nM, nN, G, c, ldc; long long astep, bstep;
    __device__ void init(int M, int N, int lda, int ldb, int ldc_, int G_, int c_) { nM = M / BM; nN = N / BM; G = G_; c = c_; ldc = ldc_; astep = (long long)BM * lda * 2; bstep = (long long)BM * ldb * 2; }
    __device__ __forceinline__ bool next(int i, Unit& u) const {
        int pm, pn; if (!tile_of((long)i * G + c, nM, nN, pm, pn)) return false;
        u.pm = pm; u.pn = pn; u.aux = 0; u.aoff = pm * astep; u.boff = pn * bstep; u.coff = (long long)pm * BM * ldc + pn * BM; return true;
    }
};

__device__ __forceinline__ unsigned cvt_pk_bf16(float lo, float hi) { unsigned r; asm volatile("v_cvt_pk_bf16_f32 %0, %1, %2" : "=v"(r) : "v"(lo), "v"(hi)); return r; }

template <class Epi, class Sched, bool GATHER = false>
__device__ __forceinline__ void gemm_phase(LAS unsigned char* lds, const Gemm g, const Sched& S, const Epi& E, int tid_, const LAS int* rowcache = nullptr) {
    __builtin_assume(tid_ >= 0 && tid_ < 512); const int tid = tid_, wid = __builtin_amdgcn_readfirstlane(tid >> 6), lane = tid & 63, wr = wid >> 2, wc = wid & 3, fr = lane & 15, fq = lane >> 4;
    int nt = g.K / BK; asm volatile("" : "+s"(nt));
    const size_t kstep = (size_t)(BK * 2);
    const size_t hstepA = (size_t)HALF * g.lda * 2, hstepB = (size_t)HALF * g.ldb * 2;
    unsigned vA0[2], vA1[2], vN0[2], vN1[2], voffB[2]; int Rr[2], Cb[2];
#pragma unroll
    for (int i = 0; i < 2; ++i) { int R, C; stage_rc(tid * 16 + i * 8192, R, C); const int Rb = (R & ~31) + perm32(R & 31); Rr[i] = R; Cb[i] = C * 2;
        vA0[i] = (unsigned)(R * g.lda + C) * 2u; vA1[i] = vA0[i] + (unsigned)hstepA; vN0[i] = vA0[i]; vN1[i] = vA1[i]; voffB[i] = (unsigned)(Rb * g.ldb + C) * 2u; }
#define PG8_GATHER(d0, d1, ui_) do { _Pragma("unroll") for (int _i = 0; _i < 2; ++_i) { d0[_i] = (unsigned)(rowcache[(ui_) * 256 + Rr[_i]] * g.lda * 2 + Cb[_i]); d1[_i] = (unsigned)(rowcache[(ui_) * 256 + 128 + Rr[_i]] * g.lda * 2 + Cb[_i]); } } while (0)
    if (GATHER) PG8_GATHER(vA0, vA1, 0);
    const unsigned ldsw = (unsigned)wid * 1024u;
    const int aoff = lds_byte(wr * 64 + fr, fq * 8), boff = lds_byte(wc * 32 + fr, fq * 8);
#define PG8_SA(b, h) (((b) * 2 + (h)) * HTB)
#define PG8_SB(b, h) ((4 + (b) * 2 + (h)) * HTB)
#define PG8_STAGE(bufoff, gbase, voff) do { _Pragma("unroll") for (int _i = 0; _i < 2; ++_i) \
        __builtin_amdgcn_global_load_lds((const unsigned*)((const char*)(gbase) + (voff)[_i]), (LAS unsigned*)(lds + (bufoff) + ldsw + _i * 8192), 16, 0, 0); } while (0)
#define PG8_LDA(dst, b, h) do { _Pragma("unroll") for (int m = 0; m < 4; ++m) _Pragma("unroll") for (int k = 0; k < 2; ++k) dst[m][k] = *(const LAS bf16x8*)(lds + PG8_SA(b, h) + aoff + m * 2048 + k * 1024); } while (0)
#define PG8_LDB(dst, b, h) do { _Pragma("unroll") for (int n = 0; n < 2; ++n) _Pragma("unroll") for (int k = 0; k < 2; ++k) dst[n][k] = *(const LAS bf16x8*)(lds + PG8_SB(b, h) + boff + n * 2048 + k * 1024); } while (0)
#define PG8_MMA(ai, bj, At, Bt) do { __builtin_amdgcn_s_setprio(1); _Pragma("unroll") for (int m = 0; m < 4; ++m) _Pragma("unroll") for (int n = 0; n < 2; ++n) _Pragma("unroll") for (int k = 0; k < 2; ++k) \
        acc[ai][bj][m][n] = __builtin_amdgcn_mfma_f32_16x16x32_bf16(Bt[n][k], At[m][k], acc[ai][bj][m][n], 0, 0, 0); __builtin_amdgcn_s_setprio(0); } while (0)
#define PG8_WAIT_V(n) asm volatile("s_waitcnt vmcnt(" #n ")" ::: "memory")
#define PG8_WAIT_L(n) asm volatile("s_waitcnt lgkmcnt(" #n ")" ::: "memory")
#define PG8_BAR __builtin_amdgcn_s_barrier()
#define PG8_SCHED __builtin_amdgcn_sched_barrier(0)
    Unit cur, nxt; int ui = 0;
    if (!S.next(0, cur)) return;
    f32x4 acc[2][2][4][2];
#pragma unroll
    for (int a = 0; a < 2; ++a)
#pragma unroll
        for (int b = 0; b < 2; ++b)
#pragma unroll
            for (int m = 0; m < 4; ++m)
#pragma unroll
                for (int n = 0; n < 2; ++n) acc[a][b][m][n] = (f32x4){0.f, 0.f, 0.f, 0.f};
    bf16x8 At[4][2], B0[2][2], B1[2][2];
    const char* cA = (const char*)g.A + cur.aoff; const char* cB = (const char*)g.Bt + cur.boff;
    PG8_STAGE(PG8_SB(0, 0), cB, voffB); PG8_STAGE(PG8_SB(0, 1), cB + hstepB, voffB); PG8_STAGE(PG8_SA(0, 0), cA, vA0); PG8_STAGE(PG8_SA(0, 1), cA, vA1);
    if (wr == 1) PG8_BAR;
    PG8_WAIT_V(2); PG8_BAR;
    PG8_STAGE(PG8_SB(1, 0), cB + kstep, voffB); PG8_STAGE(PG8_SA(1, 0), cA + kstep, vA0); PG8_STAGE(PG8_SB(1, 1), cB + hstepB + kstep, voffB);
    PG8_WAIT_V(6); PG8_BAR;
    for (;;) {
        const bool has_next = S.next(ui + 1, nxt);
        const char* nA = has_next ? (const char*)g.A + nxt.aoff : cA; const char* nB = has_next ? (const char*)g.Bt + nxt.boff : cB;
        if (GATHER) { if (has_next) PG8_GATHER(vN0, vN1, ui + 1); else { vN0[0] = vA0[0]; vN0[1] = vA0[1]; vN1[0] = vA1[0]; vN1[1] = vA1[1]; } }
        for (int t = 0; t < nt; t += 2) {
            const bool last = (t == nt - 2);
            const char* a1 = cA + (size_t)(t + 1) * kstep;
            const char* a2 = last ? nA : cA + (size_t)(t + 2) * kstep; const char* b2 = last ? nB : cB + (size_t)(t + 2) * kstep;
            const char* a3 = a2 + kstep; const char* b3 = b2 + kstep;
            unsigned w0[2], w1[2];
            if (GATHER) { w0[0] = last ? vN0[0] : vA0[0]; w0[1] = last ? vN0[1] : vA0[1]; w1[0] = last ? vN1[0] : vA1[0]; w1[1] = last ? vN1[1] : vA1[1]; } else { w0[0] = vA0[0]; w0[1] = vA0[1]; w1[0] = vA1[0]; w1[1] = vA1[1]; }
            PG8_LDB(B0, 0, 0); PG8_LDB(B1, 0, 1); PG8_SCHED; PG8_LDA(At, 0, 0); PG8_STAGE(PG8_SA(1, 1), a1, vA1);
            PG8_WAIT_V(8); PG8_WAIT_L(0); PG8_BAR; PG8_MMA(0, 0, At, B0); PG8_MMA(0, 1, At, B1); PG8_BAR; PG8_SCHED;
            PG8_LDA(At, 0, 1); PG8_STAGE(PG8_SB(0, 0), b2, voffB); PG8_STAGE(PG8_SB(0, 1), b2 + hstepB, voffB); PG8_STAGE(PG8_SA(0, 0), a2, w0);
            PG8_WAIT_V(8); PG8_WAIT_L(0); PG8_BAR; PG8_MMA(1, 0, At, B0); PG8_MMA(1, 1, At, B1); PG8_BAR; PG8_SCHED;
            PG8_LDB(B0, 1, 0); PG8_LDB(B1, 1, 1); PG8_SCHED; PG8_LDA(At, 1, 0); PG8_STAGE(PG8_SA(0, 1), a2, w1);
            PG8_WAIT_V(8); PG8_WAIT_L(0); PG8_BAR; PG8_MMA(0, 0, At, B0); PG8_MMA(0, 1, At, B1); PG8_BAR; PG8_SCHED;
            PG8_LDA(At, 1, 1); PG8_STAGE(PG8_SB(1, 0), b3, voffB); PG8_STAGE(PG8_SB(1, 1), b3 + hstepB, voffB); PG8_STAGE(PG8_SA(1, 0), a3, w0);
            PG8_WAIT_V(8); PG8_WAIT_L(0); PG8_BAR; PG8_MMA(1, 0, At, B0); PG8_MMA(1, 1, At, B1); PG8_BAR; PG8_SCHED;
        }
        if (wr == 0) PG8_BAR;
        E(acc, cur, wr, wc, fr, fq);
        if (!has_next) break;
#pragma unroll
        for (int a = 0; a < 2; ++a)
#pragma unroll
            for (int b = 0; b < 2; ++b)
#pragma unroll
                for (int m = 0; m < 4; ++m)
#pragma unroll
                    for (int n = 0; n < 2; ++n) acc[a][b][m][n] = (f32x4){0.f, 0.f, 0.f, 0.f};
        cur = nxt; cA = nA; cB = nB; ++ui;
        if (GATHER) { vA0[0] = vN0[0]; vA0[1] = vN0[1]; vA1[0] = vN1[0]; vA1[1] = vN1[1]; }
        if (wr == 1) PG8_BAR;
    }
    PG8_WAIT_V(0);
    PG8_BAR;
#undef PG8_SA
#undef PG8_SB
#undef PG8_STAGE
#undef PG8_GATHER
#undef PG8_LDA
#undef PG8_LDB
#undef PG8_MMA
#undef PG8_WAIT_V
#undef PG8_WAIT_L
#undef PG8_BAR
#undef PG8_SCHED
}
}

#define XB_TMO      128
#define XB_XCNT(j)  (256  + 64 * (j))
#define XB_XSUB(j)  (1280 + 64 * (j))
#define XB_XGEN(j)  (2304 + 64 * (j))
#define XB_TOP      3328
#define XB_TOPGEN   3392
#define XCD_BAR_WORDS 3456
#define XB_SPIN_CAP (1u << 22)
__device__ __forceinline__ unsigned xb_ld(unsigned* p)              { return __hip_atomic_load(p, __ATOMIC_RELAXED, __HIP_MEMORY_SCOPE_AGENT); }
__device__ __forceinline__ unsigned xb_add(unsigned* p, unsigned v) { return __hip_atomic_fetch_add(p, v, __ATOMIC_RELAXED, __HIP_MEMORY_SCOPE_AGENT); }
__device__ __forceinline__ unsigned xb_xcc_id() { return (unsigned)__builtin_amdgcn_s_getreg((3 << 11) | 20) & 0xFu; }
#define XB_SPIN(cond, bar) do { unsigned _sp = 0; while (cond) { __builtin_amdgcn_s_sleep(1); \
    if ((++_sp & 255u) == 0u) { if (xb_ld(&(bar)[XB_TMO])) break; if (_sp > XB_SPIN_CAP) { atomicAdd(&(bar)[XB_TMO], 1u); break; } } } } while (0)
struct XcdBarrier { unsigned* bar; unsigned x; volatile LAS unsigned* st; };
__device__ __forceinline__ XcdBarrier xcd_barrier_post(unsigned* bar, volatile LAS unsigned* st) {
    XcdBarrier b; b.bar = bar; b.x = xb_xcc_id(); b.st = st;
    if (threadIdx.x == 0) (void)xb_add(&bar[XB_XCNT(b.x)], 1u);
    return b;
}
__device__ __forceinline__ void xcd_barrier_complete(unsigned* bar, unsigned x, unsigned& nloc, unsigned& nx) {
    const unsigned G = gridDim.x * gridDim.y * gridDim.z;
    unsigned sum, cnt, mine, sp = 0u;
    for (;;) {
        sum = 0u; cnt = 0u; mine = 0u;
#pragma unroll
        for (unsigned j = 0; j < 16; ++j) { const unsigned c = xb_ld(&bar[XB_XCNT(j)]); sum += c; cnt += (c > 0u) ? 1u : 0u; mine = (j == x) ? c : mine; }
        if (sum == G) break;
        __builtin_amdgcn_s_sleep(1);
        if ((++sp & 255u) == 0u) { if (xb_ld(&bar[XB_TMO])) break; if (sp > XB_SPIN_CAP) { atomicAdd(&bar[XB_TMO], 1u); break; } }
    }
    nloc = mine > 0u ? mine : 1u; nx = cnt > 0u ? cnt : 1u;
}
__device__ __forceinline__ void xcd_barrier(const XcdBarrier& b) {
    asm volatile("s_waitcnt vmcnt(0)" ::: "memory");
    __syncthreads();
    if (threadIdx.x == 0) {
        unsigned* bar = b.bar;
        __builtin_amdgcn_s_waitcnt(0);
        unsigned nloc = b.st[0], nx = b.st[1];
        if (nloc == 0u) { xcd_barrier_complete(bar, b.x, nloc, nx); b.st[0] = nloc; b.st[1] = nx; }
        const unsigned old = xb_add(&bar[XB_XSUB(b.x)], 1u);
        const unsigned gen = old / nloc;
        if (old + 1u == (gen + 1u) * nloc) {
            __builtin_amdgcn_fence(__ATOMIC_RELEASE, "agent");
            asm volatile("s_waitcnt vmcnt(0)" ::: "memory");
            const unsigned og = xb_add(&bar[XB_TOP], 1u);
            const unsigned tg = og / nx;
            if (og + 1u == (tg + 1u) * nx) xb_add(&bar[XB_TOPGEN], 1u);
            else XB_SPIN(xb_ld(&bar[XB_TOPGEN]) == tg, bar);
            __builtin_amdgcn_fence(__ATOMIC_ACQUIRE, "agent");
            xb_add(&bar[XB_XGEN(b.x)], 1u);
            asm volatile("s_waitcnt vmcnt(0)" ::: "memory");
        } else {
            XB_SPIN(xb_ld(&bar[XB_XGEN(b.x)]) == gen, bar);
            __builtin_amdgcn_fence(__ATOMIC_ACQUIRE, "agent");
            asm volatile("s_waitcnt vmcnt(0)" ::: "memory");
        }
    }
    __syncthreads();
}

constexpr int NWAVES = 8, NTHR = 512;
constexpr int LDS_MAIN = 131072;
constexpr int LDS_AUX = 131072, LDS_AUX_BYTES = 16384;
constexpr int LDS_MISC = LDS_AUX + LDS_AUX_BYTES;
constexpr int LDS_PTAB = LDS_MISC + 256;
constexpr int LDS_BYTES = LDS_MISC + 1024;
struct Args { const float* in[N_INPUTS]; float* out; unsigned char* ws; int ph_lo, ph_hi; };

struct Ctx {
    LAS unsigned char* lds;
    int tid, lane, wave, G, bid, gw, ngw;
    unsigned char* ws;
};
__device__ __forceinline__ const float* lds_inp(LAS unsigned char* lds, int i) {
    const LAS unsigned* p = (const LAS unsigned*)(lds + LDS_PTAB) + 2 * i;
    const unsigned lo = __builtin_amdgcn_readfirstlane(p[0]), hi = __builtin_amdgcn_readfirstlane(p[1]);
    return (const float*)(const GAS float*)(((unsigned long long)hi << 32) | lo);
}
#define INP(i) lds_inp(C.lds, (i))
#define WSP(T_, off) ((T_*)(C.ws + (off)))
#define ARP(T_, off) ((T_*)(C.ws + WS_ARENA + (off)))
#define LDS_WAIT() asm volatile("s_waitcnt lgkmcnt(0)" ::: "memory")

__device__ __forceinline__ void rms_row_bf16(const float* xrow, const float* gain, bf16* orow, int lane) {
    f32x4 v[8]; float s = 0.f;
#pragma unroll
    for (int j = 0; j < 8; ++j) { v[j] = *(const f32x4*)(xrow + (j * 64 + lane) * 4); s += v[j].x * v[j].x + v[j].y * v[j].y + v[j].z * v[j].z + v[j].w * v[j].w; }
    const float rstd = rsqrtf(wave_sum(s) * (1.f / DM) + EPS);
#pragma unroll
    for (int j = 0; j < 8; ++j) { const f32x4 g = *(const f32x4*)(gain + (j * 64 + lane) * 4);
        u32x2 w; w.x = pk2(v[j].x * rstd * g.x, v[j].y * rstd * g.y); w.y = pk2(v[j].z * rstd * g.z, v[j].w * rstd * g.w);
        *(u32x2*)(orow + (j * 64 + lane) * 4) = w; }
}

template <int NT, class F>
__device__ __forceinline__ void transpose_tiles(const float* W, int ldw, int nvalid, int k0, int n0, bf16* WT, int ldt, F drow, int lane, const float* kscale) {
    const int g = lane >> 3, c = lane & 7; f32x4 v[NT][8];
#pragma unroll
    for (int q = 0; q < NT; ++q) { const int n = n0 + 32 * q + 4 * c; const bool ok = n < nvalid;
#pragma unroll
        for (int j = 0; j < 8; ++j) v[q][j] = ok ? *(const f32x4*)(W + (size_t)(k0 + 8 * g + j) * ldw + n) : (f32x4){0.f, 0.f, 0.f, 0.f}; }
    f32x4 ka = (f32x4){1.f, 1.f, 1.f, 1.f}, kb = ka;
    if (kscale) { ka = *(const f32x4*)(kscale + k0 + 8 * g); kb = *(const f32x4*)(kscale + k0 + 8 * g + 4); }
#pragma unroll
    for (int q = 0; q < NT; ++q) { const int n = n0 + 32 * q + 4 * c;
#pragma unroll
        for (int i = 0; i < 4; ++i) { u32x4 o; o.x = pk2(v[q][0][i] * ka.x, v[q][1][i] * ka.y); o.y = pk2(v[q][2][i] * ka.z, v[q][3][i] * ka.w); o.z = pk2(v[q][4][i] * kb.x, v[q][5][i] * kb.y); o.w = pk2(v[q][6][i] * kb.z, v[q][7][i] * kb.w);
            *(u32x4*)(WT + (size_t)drow(n + i) * ldt + k0 + 8 * g) = o; } }
}
template <class F>
__device__ __forceinline__ void transpose_tile(const float* W, int ldw, int nvalid, int k0, int n0, bf16* WT, int ldt, F drow, LAS float* scr, int lane, const float* kscale = nullptr) {
    (void)scr; transpose_tiles<1>(W, ldw, nvalid, k0, n0, WT, ldt, drow, lane, kscale);
}
template <class F>
__device__ __forceinline__ void transpose_matrix(const Ctx& C, const float* W, int K, int N, int Npad, bf16* WT, int ldt, F drow, LAS float* scr, const float* kscale = nullptr) {
    const int nblk = Npad / 32, items = (K / 64) * nblk;
    for (int it = C.gw; it < items; it += C.ngw) { const int kb = it / nblk, nb = it % nblk; transpose_tile(W, N, N, kb * 64, nb * 32, WT, ldt, drow, scr, C.lane, kscale); }
}

#define EPI_ARGS const f32x4 (&acc)[2][2][4][2], const pg8::Unit& u, int wr, int wc, int fr, int fq
struct EpiStoreBf16 {
    bf16* O; int ldc; float scale;
    __device__ __forceinline__ void operator()(EPI_ARGS) const {
        bf16* base = O + u.coff + (size_t)(wr * 64 + fr) * ldc + wc * 32 + 8 * fq;
#pragma unroll
        for (int ai = 0; ai < 2; ++ai)
#pragma unroll
            for (int m = 0; m < 4; ++m) { bf16* rowp = base + (size_t)(ai * 128 + m * 16) * ldc;
#pragma unroll
                for (int bj = 0; bj < 2; ++bj) { const f32x4 v0 = acc[ai][bj][m][0] * scale, v1 = acc[ai][bj][m][1] * scale;
                    u32x4 w; w.x = pg8::cvt_pk_bf16(v0[0], v0[1]); w.y = pg8::cvt_pk_bf16(v0[2], v0[3]); w.z = pg8::cvt_pk_bf16(v1[0], v1[1]); w.w = pg8::cvt_pk_bf16(v1[2], v1[3]);
                    *(u32x4*)(rowp + bj * 128) = w; } }
    }
};
struct EpiStoreF32 {
    float* O; int ldc;
    __device__ __forceinline__ void operator()(EPI_ARGS) const {
        float* base = O + u.coff + (size_t)(wr * 64 + fr) * ldc + wc * 32 + 8 * fq;
#pragma unroll
        for (int ai = 0; ai < 2; ++ai)
#pragma unroll
            for (int m = 0; m < 4; ++m) { float* rowp = base + (size_t)(ai * 128 + m * 16) * ldc;
#pragma unroll
                for (int bj = 0; bj < 2; ++bj) { *(f32x4*)(rowp + bj * 128) = acc[ai][bj][m][0]; *(f32x4*)(rowp + bj * 128 + 4) = acc[ai][bj][m][1]; } }
    }
};
template <bool BASE_F32> struct EpiResidT {
    const void* base; bf16* out; int ldc; float* rsq; LAS float* xch;
    __device__ __forceinline__ void operator()(EPI_ARGS) const {
        const size_t o0 = (size_t)u.coff + (size_t)(wr * 64 + fr) * ldc + wc * 32 + 8 * fq;
        u32x4 braw[BASE_F32 ? 1 : 16];
        if (!BASE_F32) {
#pragma unroll
            for (int ai = 0; ai < 2; ++ai)
#pragma unroll
                for (int m = 0; m < 4; ++m)
#pragma unroll
                    for (int bj = 0; bj < 2; ++bj) braw[(ai * 4 + m) * 2 + bj] = *(const u32x4*)((const bf16*)base + o0 + (size_t)(ai * 128 + m * 16) * ldc + bj * 128); }
#pragma unroll
        for (int ai = 0; ai < 2; ++ai)
#pragma unroll
            for (int m = 0; m < 4; ++m) { const size_t o = o0 + (size_t)(ai * 128 + m * 16) * ldc; float ssq = 0.f;
#pragma unroll
                for (int bj = 0; bj < 2; ++bj) { float bv[8];
                    if (BASE_F32) { const f32x4 b0 = *(const f32x4*)((const float*)base + o + bj * 128), b1 = *(const f32x4*)((const float*)base + o + bj * 128 + 4);
                        bv[0] = b0[0]; bv[1] = b0[1]; bv[2] = b0[2]; bv[3] = b0[3]; bv[4] = b1[0]; bv[5] = b1[1]; bv[6] = b1[2]; bv[7] = b1[3]; }
                    else unpack8(braw[BASE_F32 ? 0 : (ai * 4 + m) * 2 + bj], bv);
#pragma unroll
                    for (int j = 0; j < 4; ++j) { bv[j] += acc[ai][bj][m][0][j]; bv[4 + j] += acc[ai][bj][m][1][j]; }
                    const u32x4 w = pack8f(bv); *(u32x4*)(out + o + bj * 128) = w; float rf[8]; unpack8(w, rf);
#pragma unroll
                    for (int j = 0; j < 8; ++j) ssq += rf[j] * rf[j]; }
                ssq += xor16f(ssq); ssq += xor32f(ssq);
                if (fq == 0) xch[(ai * 128 + wr * 64 + m * 16 + fr) * 4 + wc] = ssq; }
        asm volatile("s_waitcnt lgkmcnt(0)" ::: "memory"); __builtin_amdgcn_s_barrier(); asm volatile("" ::: "memory");
        if (wc == 0 && fq == 0) {
#pragma unroll
            for (int ai = 0; ai < 2; ++ai)
#pragma unroll
                for (int m = 0; m < 4; ++m) { const int r = ai * 128 + wr * 64 + m * 16 + fr; const f32x4 p = *(const LAS f32x4*)(xch + r * 4); rsq[(size_t)(u.pm * 256 + r) * 8 + u.pn] = (p[0] + p[1]) + (p[2] + p[3]); } }
    }
};
__device__ __forceinline__ float rstd_of(float ssq) { return rsqrtf(ssq * (1.f / DM) + EPS); }
__device__ __forceinline__ float rstd_row(const float* rs8, int row) { const f32x4 a = *(const f32x4*)(rs8 + (size_t)row * 8), b = *(const f32x4*)(rs8 + (size_t)row * 8 + 4); return rstd_of(((a.x + a.y) + (a.z + a.w)) + ((b.x + b.y) + (b.z + b.w))); }
struct EpiStoreF32Rows {
    float* O; int ldc; const float* rs;
    __device__ __forceinline__ void operator()(EPI_ARGS) const {
        float* base = O + u.coff + (size_t)(wr * 64 + fr) * ldc + wc * 32 + 8 * fq; const int rp = u.pm * 256 + wr * 64 + fr;
#pragma unroll
        for (int ai = 0; ai < 2; ++ai)
#pragma unroll
            for (int m = 0; m < 4; ++m) { float* rowp = base + (size_t)(ai * 128 + m * 16) * ldc; const float r_ = rstd_row(rs, rp + ai * 128 + m * 16);
#pragma unroll
                for (int bj = 0; bj < 2; ++bj) { *(f32x4*)(rowp + bj * 128) = acc[ai][bj][m][0] * r_; *(f32x4*)(rowp + bj * 128 + 4) = acc[ai][bj][m][1] * r_; } }
    }
};
struct EpiSoftmaxP {
    bf16* P; int ldc; const float* rs; LAS float* xch;
    __device__ __forceinline__ void operator()(f32x4 (&acc)[2][2][4][2], const pg8::Unit& u, int wr, int wc, int fr, int fq) const {
#pragma unroll
        for (int ai = 0; ai < 2; ++ai)
#pragma unroll
            for (int m = 0; m < 4; ++m) { const int r = ai * 128 + wr * 64 + m * 16 + fr; const float r_ = rstd_row(rs, u.pm * 256 + r); float mx = -INFINITY;
#pragma unroll
                for (int bj = 0; bj < 2; ++bj)
#pragma unroll
                    for (int n = 0; n < 2; ++n) { acc[ai][bj][m][n] = acc[ai][bj][m][n] * r_;
#pragma unroll
                        for (int j = 0; j < 4; ++j) mx = fmaxf(mx, acc[ai][bj][m][n][j]); }
                mx = fmaxf(mx, xor16f(mx)); mx = fmaxf(mx, xor32f(mx)); if (fq == 0) xch[r * 4 + wc] = mx; }
        asm volatile("s_waitcnt lgkmcnt(0)" ::: "memory"); __builtin_amdgcn_s_barrier(); asm volatile("" ::: "memory");
#pragma unroll
        for (int ai = 0; ai < 2; ++ai)
#pragma unroll
            for (int m = 0; m < 4; ++m) { const int r = ai * 128 + wr * 64 + m * 16 + fr; const f32x4 mv = *(const LAS f32x4*)(xch + r * 4); const float mx = fmaxf(fmaxf(mv[0], mv[1]), fmaxf(mv[2], mv[3])); float sm_ = 0.f;
#pragma unroll
                for (int bj = 0; bj < 2; ++bj)
#pragma unroll
                    for (int n = 0; n < 2; ++n)
#pragma unroll
                        for (int j = 0; j < 4; ++j) { const float e = __expf(acc[ai][bj][m][n][j] - mx); acc[ai][bj][m][n][j] = e; sm_ += e; }
                sm_ += xor16f(sm_); sm_ += xor32f(sm_); if (fq == 0) xch[1024 + r * 4 + wc] = sm_; }
        asm volatile("s_waitcnt lgkmcnt(0)" ::: "memory"); __builtin_amdgcn_s_barrier(); asm volatile("" ::: "memory");
        bf16* base = P + u.coff + (size_t)(wr * 64 + fr) * ldc + wc * 32 + 8 * fq;
#pragma unroll
        for (int ai = 0; ai < 2; ++ai)
#pragma unroll
            for (int m = 0; m < 4; ++m) { const int r = ai * 128 + wr * 64 + m * 16 + fr; const f32x4 sv = *(const LAS f32x4*)(xch + 1024 + r * 4); const float inv = 1.f / ((sv[0] + sv[1]) + (sv[2] + sv[3]));
                bf16* rowp = base + (size_t)(ai * 128 + m * 16) * ldc;
#pragma unroll
                for (int bj = 0; bj < 2; ++bj) { const f32x4 v0 = acc[ai][bj][m][0] * inv, v1 = acc[ai][bj][m][1] * inv;
                    u32x4 w; w.x = pg8::cvt_pk_bf16(v0[0], v0[1]); w.y = pg8::cvt_pk_bf16(v0[2], v0[3]); w.z = pg8::cvt_pk_bf16(v1[0], v1[1]); w.w = pg8::cvt_pk_bf16(v1[2], v1[3]);
                    *(u32x4*)(rowp + bj * 128) = w; } }
    }
};
struct EpiAbIn {
    bf16* P; float* G32;
    __device__ __forceinline__ void operator()(EPI_ARGS) const {
        const int row0 = u.pm * 256 + wr * 64 + fr, col0 = u.pn * 256 + wc * 32 + 8 * fq;
#pragma unroll
        for (int ai = 0; ai < 2; ++ai)
#pragma unroll
            for (int m = 0; m < 4; ++m) { const int row = row0 + ai * 128 + m * 16; bf16* rowp = P + (size_t)row * AB_PAD + col0;
#pragma unroll
                for (int bj = 0; bj < 2; ++bj) { const f32x4 v0 = acc[ai][bj][m][0], v1 = acc[ai][bj][m][1];
                    u32x4 w; w.x = pg8::cvt_pk_bf16(v0[0], v0[1]); w.y = pg8::cvt_pk_bf16(v0[2], v0[3]); w.z = pg8::cvt_pk_bf16(v1[0], v1[1]); w.w = pg8::cvt_pk_bf16(v1[2], v1[3]);
                    *(u32x4*)(rowp + bj * 128) = w;
                    if (u.pn == 12) { float* g = G32 + (size_t)row * 256 + wc * 32 + 8 * fq + bj * 128; *(f32x4*)g = v0; *(f32x4*)(g + 4) = v1; } } }
    }
};
struct EpiLora {
    const float *w0, *a0, *k_a; const bf16 *KK, *KR; float* WD; bf16 *BV, *KP, *GG;
    __device__ __forceinline__ void operator()(EPI_ARGS) const {
        const int grp = u.pn >> 2, row0 = u.pm * 256 + wr * 64 + fr, cc0 = (u.pn & 3) * 256 + wc * 32 + 8 * fq;
#pragma unroll
        for (int ai = 0; ai < 2; ++ai)
#pragma unroll
            for (int m = 0; m < 4; ++m) { const size_t ro = (size_t)(row0 + ai * 128 + m * 16) * 1024;
#pragma unroll
                for (int bj = 0; bj < 2; ++bj) { const int cc = cc0 + bj * 128; float v[8];
#pragma unroll
                    for (int j = 0; j < 4; ++j) { v[j] = acc[ai][bj][m][0][j]; v[4 + j] = acc[ai][bj][m][1][j]; }
                    if (grp == 0) { float o[8]; const f32x4 p0 = *(const f32x4*)(w0 + cc), p1 = *(const f32x4*)(w0 + cc + 4); const float pw[8] = {p0.x, p0.y, p0.z, p0.w, p1.x, p1.y, p1.z, p1.w};
#pragma unroll
                        for (int j = 0; j < 8; ++j) o[j] = -0.6065306597126334f * sigmoidf_(pw[j] + v[j]);
                        *(f32x4*)(WD + ro + cc) = (f32x4){o[0], o[1], o[2], o[3]}; *(f32x4*)(WD + ro + cc + 4) = (f32x4){o[4], o[5], o[6], o[7]};
                    } else if (grp == 1) { float kk[8], kr[8], ob[8], ok[8];
                        unpack8(*(const u32x4*)(KK + ro + cc), kk); unpack8(*(const u32x4*)(KR + ro + cc), kr);
                        const f32x4 p0 = *(const f32x4*)(a0 + cc), p1 = *(const f32x4*)(a0 + cc + 4), q0 = *(const f32x4*)(k_a + cc), q1 = *(const f32x4*)(k_a + cc + 4);
                        const float pa[8] = {p0.x, p0.y, p0.z, p0.w, p1.x, p1.y, p1.z, p1.w}, qa[8] = {q0.x, q0.y, q0.z, q0.w, q1.x, q1.y, q1.z, q1.w};
#pragma unroll
                        for (int j = 0; j < 8; ++j) { const float a = sigmoidf_(pa[j] + v[j]); ob[j] = kk[j] * a; ok[j] = kr[j] * (1.f + (a - 1.f) * qa[j]); }
                        st16_f(BV + ro + cc, pack8f(ob)); st16_f(KP + ro + cc, pack8f(ok));
                    } else { st16_f(GG + ro + cc, pack8f(v)); } } }
    }
};
struct EpiHid {
    bf16* H; const int* rowslot; const float* rs;
    __device__ __forceinline__ void operator()(EPI_ARGS) const {
        bf16* base = H + (size_t)(u.aux + wr * 64 + fr) * FF + u.pn * 128 + wc * 32 + 8 * fq;
#pragma unroll
        for (int ai = 0; ai < 2; ++ai)
#pragma unroll
            for (int m = 0; m < 4; ++m) { float h[8]; const int r = ai * 128 + wr * 64 + m * 16 + fr; const float r_ = (r < u.pm) ? rstd_row(rs, rowslot[u.aux + r] >> 1) : 0.f;
#pragma unroll
                for (int j = 0; j < 4; ++j) { h[j] = siluf_(acc[ai][0][m][0][j] * r_) * (acc[ai][1][m][0][j] * r_); h[4 + j] = siluf_(acc[ai][0][m][1][j] * r_) * (acc[ai][1][m][1][j] * r_); }
                *(u32x4*)(base + (size_t)(ai * 128 + m * 16) * FF) = pack8f(h); }
    }
};
struct EpiMoeDown {
    const int* rowslot; const float* wts; bf16* YE;
    __device__ __forceinline__ void operator()(EPI_ARGS) const {
#pragma unroll
        for (int ai = 0; ai < 2; ++ai)
#pragma unroll
            for (int m = 0; m < 4; ++m) { const int r = ai * 128 + wr * 64 + m * 16 + fr;
                if (r < u.pm) { const int slot = rowslot[u.aux + r]; const float w = wts[slot]; bf16* rowp = YE + (size_t)slot * DM + u.pn * 256 + wc * 32 + 8 * fq;
#pragma unroll
                    for (int bj = 0; bj < 2; ++bj) { const f32x4 v0 = acc[ai][bj][m][0] * w, v1 = acc[ai][bj][m][1] * w;
                        u32x4 o; o.x = pg8::cvt_pk_bf16(v0[0], v0[1]); o.y = pg8::cvt_pk_bf16(v0[2], v0[3]); o.z = pg8::cvt_pk_bf16(v1[0], v1[1]); o.w = pg8::cvt_pk_bf16(v1[2], v1[3]);
                        *(u32x4*)(rowp + bj * 128) = o; } } }
    }
};
struct EpiNsaIn {
    bf16 *Q, *QROT, *KV6; float* GATES; const float *gate_b, *rcos, *rsin, *rs;
    __device__ __forceinline__ void operator()(EPI_ARGS) const {
        const int pn = u.pn;
#pragma unroll
        for (int ai = 0; ai < 2; ++ai)
#pragma unroll
            for (int m = 0; m < 4; ++m) { const int t = u.pm * 256 + ai * 128 + wr * 64 + m * 16 + fr, b = t >> 12, s = t & 4095; const float r_ = rstd_row(rs, t);
#pragma unroll
                for (int bj = 0; bj < 2; ++bj) { float v[8];
#pragma unroll
                    for (int j = 0; j < 4; ++j) { v[j] = acc[ai][bj][m][0][j] * r_; v[4 + j] = acc[ai][bj][m][1][j] * r_; }
                    const int d0 = wc * 32 + 8 * fq;
                    if (pn == 20) {
                        const int c = bj * 128 + d0;
                        if (c < 48) { float o[8];
#pragma unroll
                            for (int j = 0; j < 8; ++j) o[j] = sigmoidf_(v[j] + gate_b[c + j]);
                            float* g = GATES + (size_t)t * 48 + c; *(f32x4*)g = (f32x4){o[0], o[1], o[2], o[3]}; *(f32x4*)(g + 4) = (f32x4){o[4], o[5], o[6], o[7]}; }
                        continue; }
                    float vr[8];
#pragma unroll
                    for (int j = 0; j < 8; ++j) vr[j] = v[j];
                    if (wc == 0) { float pv[8];
#pragma unroll
                      for (int j = 0; j < 8; ++j) pv[j] = xor32f(v[j]);
                      const f32x4 c0 = *(const f32x4*)(rcos + s * 16 + 8 * (fq & 1)), c1 = *(const f32x4*)(rcos + s * 16 + 8 * (fq & 1) + 4), s0 = *(const f32x4*)(rsin + s * 16 + 8 * (fq & 1)), s1 = *(const f32x4*)(rsin + s * 16 + 8 * (fq & 1) + 4);
                      const float cs[8] = {c0.x, c0.y, c0.z, c0.w, c1.x, c1.y, c1.z, c1.w}, sn[8] = {s0.x, s0.y, s0.z, s0.w, s1.x, s1.y, s1.z, s1.w};
#pragma unroll
                      for (int j = 0; j < 8; ++j) vr[j] = (fq < 2) ? (v[j] * cs[j] - pv[j] * sn[j]) : (v[j] * cs[j] + pv[j] * sn[j]); }
                    if (pn < 8) { const int hh = pn * 2 + bj; const size_t o = (((size_t)(b * 16 + hh)) * SEQ + s) * 128 + d0;
                        *(u32x4*)(Q + o) = pack8f(v); *(u32x4*)(QROT + o) = pack8f(vr);
                    } else { const int i6 = (pn - 8) >> 1, g = ((pn - 8) & 1) * 2 + bj; const bool rot = (i6 == 2 || i6 == 4) && wc == 0;
                        bf16* dst = (bf16*)((unsigned char*)KV6 + (size_t)i6 * KV6_STRIDE) + (((size_t)(b * 4 + g)) * SPAD + s) * 128 + d0;
                        *(u32x4*)dst = rot ? pack8f(vr) : pack8f(v); } } }
    }
};

constexpr int MOE_CVT_TOTAL = 2 * NEXP * 3 * 512, MOE_CVT_SIDE_A = 0, MOE_CVT_SIDE_B = 26000, MOE_CVT_WG = 32, MOE_CVT_SIDE_C = 4096 * 8 * 2, MOE_CVT_SIDE_F = 1024 * 8 * 2, MOE_CVT_SIDE_G = 0  , MOE_CVT_SIDE_E = 2048 * 8 * 2, MOE_CVT_SIDE_H2 = 10000  , MOE_CVT_SIDE_H = 22000  ;
#define MOE_CVT_PROLOGUE_END(G_) ((G_) == 256 ? MOE_CVT_TOTAL - MOE_CVT_SIDE_A - MOE_CVT_SIDE_B - MOE_CVT_SIDE_C - MOE_CVT_SIDE_F - MOE_CVT_SIDE_G - MOE_CVT_SIDE_E - MOE_CVT_SIDE_H - MOE_CVT_SIDE_H2 : MOE_CVT_TOTAL)
#define MOE_CVT_BASE_C MOE_CVT_PROLOGUE_END(256)
#define MOE_CVT_BASE_F (MOE_CVT_BASE_C + MOE_CVT_SIDE_C)
#define MOE_CVT_BASE_G (MOE_CVT_BASE_F + MOE_CVT_SIDE_F)
#define MOE_CVT_BASE_E (MOE_CVT_BASE_G + MOE_CVT_SIDE_G)
#define MOE_CVT_BASE_H (MOE_CVT_BASE_E + MOE_CVT_SIDE_E)
#define MOE_CVT_BASE_H2 (MOE_CVT_BASE_H + MOE_CVT_SIDE_H)
static_assert(MOE_CVT_BASE_E >= MOE_CVT_TOTAL / 2 && MOE_CVT_BASE_H2 + MOE_CVT_SIDE_H2 + MOE_CVT_SIDE_A + MOE_CVT_SIDE_B == MOE_CVT_TOTAL && MOE_CVT_SIDE_H % 2 == 0 && MOE_CVT_SIDE_H2 % 2 == 0 && MOE_CVT_BASE_C % 2 == 0, "MoE conversion item ranges");
__device__ __forceinline__ void moe_convert_pair(const Ctx& C, int it, int lane) {
    auto ident = [](int n) { return n; };
    auto dg = [](int n) { return (n >> 7) * 256 + (n & 127); };
    auto du = [](int n) { return (n >> 7) * 256 + 128 + (n & 127); };
    const int per = 512;
    const int le = it / (3 * per), r = it % (3 * per), which = r / per, q = r % per;
    if (which == 0) { const int kb = q / 16, nb = q % 16; transpose_tiles<2>(INP(I_MOE_W_GATE) + (size_t)le * DM * FF, FF, FF, kb * 64, nb * 32, WSP(bf16, WS_W_GU) + (size_t)le * 1024 * DM, DM, dg, lane, INP(I_NORM_FFN) + (le >> 6) * DM); }
    else if (which == 1) { const int kb = q / 16, nb = q % 16; transpose_tiles<2>(INP(I_MOE_W_UP) + (size_t)le * DM * FF, FF, FF, kb * 64, nb * 32, WSP(bf16, WS_W_GU) + (size_t)le * 1024 * DM, DM, du, lane, INP(I_NORM_FFN) + (le >> 6) * DM); }
    else { const int kb = q / 64, nb = q % 64; transpose_tiles<2>(INP(I_MOE_W_DOWN) + (size_t)le * FF * DM, DM, DM, kb * 64, nb * 32, WSP(bf16, WS_W_DN) + (size_t)le * DM * FF, FF, ident, lane, nullptr); }
}
struct MoeTile { const float* W; bf16* WT; const float* ks; int ldw, ldt, k0, n0, mode; };
__device__ __forceinline__ MoeTile moe_tile_decode(const Ctx& C, int it) {
    const int per = 512, le = it / (3 * per), r = it % (3 * per), which = r / per, q = r % per; MoeTile t; t.mode = which;
    if (which < 2) { t.W = INP(which ? I_MOE_W_UP : I_MOE_W_GATE) + (size_t)le * DM * FF; t.ldw = FF; t.k0 = (q / 16) * 64; t.n0 = (q % 16) * 32; t.WT = WSP(bf16, WS_W_GU) + (size_t)le * 1024 * DM; t.ldt = DM; t.ks = INP(I_NORM_FFN) + (le >> 6) * DM; }
    else { t.W = INP(I_MOE_W_DOWN) + (size_t)le * FF * DM; t.ldw = DM; t.k0 = (q / 64) * 64; t.n0 = (q % 64) * 32; t.WT = WSP(bf16, WS_W_DN) + (size_t)le * DM * FF; t.ldt = FF; t.ks = nullptr; }
    return t;
}
__device__ __forceinline__ void moe_pair_load(const MoeTile& t, f32x4 (&v)[2][8], int lane) {
    const int g = lane >> 3, c = lane & 7;
#pragma unroll
    for (int q = 0; q < 2; ++q)
#pragma unroll
        for (int j = 0; j < 8; ++j) v[q][j] = __builtin_nontemporal_load((const f32x4*)(t.W + (size_t)(t.k0 + 8 * g + j) * t.ldw + t.n0 + 32 * q + 4 * c));
}
__device__ __forceinline__ void moe_pair_store(const MoeTile& t, const f32x4 (&v)[2][8], int lane) {
    const int g = lane >> 3, c = lane & 7; f32x4 ka = (f32x4){1.f, 1.f, 1.f, 1.f}, kb = ka;
    if (t.ks) { ka = *(const f32x4*)(t.ks + t.k0 + 8 * g); kb = *(const f32x4*)(t.ks + t.k0 + 8 * g + 4); }
#pragma unroll
    for (int q = 0; q < 2; ++q)
#pragma unroll
        for (int i = 0; i < 4; ++i) { const int nn = t.n0 + 32 * q + 4 * c + i, dr = (t.mode == 2) ? nn : ((nn >> 7) * 256 + (t.mode == 1 ? 128 : 0) + (nn & 127));
            u32x4 o; o.x = pk2(v[q][0][i] * ka.x, v[q][1][i] * ka.y); o.y = pk2(v[q][2][i] * ka.z, v[q][3][i] * ka.w); o.z = pk2(v[q][4][i] * kb.x, v[q][5][i] * kb.y); o.w = pk2(v[q][6][i] * kb.z, v[q][7][i] * kb.w);
            __builtin_nontemporal_store(o, (u32x4*)(t.WT + (size_t)dr * t.ldt + t.k0 + 8 * g)); }
}
__device__ __forceinline__ void moe_convert_items(const Ctx& C, int lo, int hi, int widx, int nworkers) {
    for (int it = lo + 2 * widx; it < hi; it += 2 * nworkers) moe_convert_pair(C, it, C.lane);
}
__device__ __forceinline__ void moe_convert_items_x2(const Ctx& C, int lo, int hi, int widx, int nworkers) {
    int it = lo + 2 * widx; const int st = 2 * nworkers;
    for (; it + st < hi; it += 2 * st) {
        f32x4 va[2][8], vb[2][8]; const MoeTile ta = moe_tile_decode(C, it), tb = moe_tile_decode(C, it + st);
        moe_pair_load(ta, va, C.lane); moe_pair_load(tb, vb, C.lane);
        moe_pair_store(ta, va, C.lane); moe_pair_store(tb, vb, C.lane);
    }
    for (; it < hi; it += st) moe_convert_pair(C, it, C.lane);
}
__device__ __forceinline__ void phase_prologue(const Ctx& C, const Args& A) {
    LAS float* scr = (LAS float*)(C.lds + C.wave * 8448);
    auto ident = [](int n) { return n; };
    transpose_matrix(C, INP(I_AB_W_IN), DM, AB_COLS, AB_PAD, WSP(bf16, WS_W_ABIN), DM, ident, scr);
    transpose_matrix(C, INP(I_AB_W_OUT), DM, DM, DM, WSP(bf16, WS_W_ABOUT), DM, ident, scr);
    transpose_matrix(C, INP(I_NSA_W_IN), DM, NSA_COLS, NSA_PAD, WSP(bf16, WS_W_NSAIN), DM, ident, scr, INP(I_NORM_MIX) + DM);
    transpose_matrix(C, INP(I_NSA_W_OUT), DM, DM, DM, WSP(bf16, WS_W_NSAOUT), DM, ident, scr);
    for (int l = 0; l < 2; ++l) {
        transpose_matrix(C, INP(I_CA_WK) + (size_t)l * DM * DM, DM, DM, DM, WSP(bf16, WS_W_CAK) + (size_t)l * DM * DM, DM, ident, scr);
        transpose_matrix(C, INP(I_CA_WV) + (size_t)l * DM * DM, DM, DM, DM, WSP(bf16, WS_W_CAV) + (size_t)l * DM * DM, DM, ident, scr);
        transpose_matrix(C, INP(I_CA_WO) + (size_t)l * DM * DM, DM, DM, DM, WSP(bf16, WS_W_CAO) + (size_t)l * DM * DM, DM, ident, scr);
    }
    for (int kv = 0; kv < 2; ++kv)
        transpose_matrix(C, INP(I_CMP_W1) + (size_t)kv * 4096 * 128, 4096, 128, 128, WSP(bf16, WS_W_CMP1) + (size_t)kv * 256 * 4096, 4096, ident, scr);
    moe_convert_items(C, 0, MOE_CVT_PROLOGUE_END(C.G), C.gw, C.ngw);
    const size_t gt = (size_t)C.bid * NTHR + C.tid, gn = (size_t)C.G * NTHR;
    { const float* src = INP(I_CA_WQ); bf16* dst = WSP(bf16, WS_W_CAQ);
      const float* gc = INP(I_NORM_CROSS);
      for (size_t i = gt; i < (size_t)2 * DM * DM / 4; i += gn) { const f32x4 v = *(const f32x4*)(src + i * 4); const float gq = gc[(i * 4) / DM]; u32x2 w; w.x = pk2(v.x * gq, v.y * gq); w.y = pk2(v.z * gq, v.w * gq); *(u32x2*)(dst + i * 4) = w; } }
    { bf16* dst = WSP(bf16, WS_W_LORA);
      for (size_t i = gt; i < (size_t)3072 * 256; i += gn) { const int n = (int)(i >> 8), k = (int)(i & 255); float v = 0.f;
          if (n < 1024) { if (k < 64) v = INP(I_RW_W_UP)[k * 1024 + n]; }
          else if (n < 2048) { if (k >= 64 && k < 128) v = INP(I_RW_A_UP)[(k - 64) * 1024 + (n - 1024)]; }
          else { if (k >= 128) v = INP(I_RW_G_UP)[(k - 128) * 1024 + (n - 2048)]; }
          dst[i] = (bf16)f2bf(v); } }
    { bf16* dst = WSP(bf16, WS_W_ROUTER);
      for (size_t i = gt; i < (size_t)2 * 256 * DM; i += gn) { const int l = (int)(i / (256 * DM)), n = (int)((i / DM) & 255), k = (int)(i % DM); float v = 0.f;
          if (n < 8) v = INP(I_MOE_WG)[((size_t)l * DM + k) * 8 + n]; else if (n < 72) v = INP(I_MOE_WE)[((size_t)l * DM + k) * 64 + (n - 8)];
          v *= INP(I_NORM_FFN)[l * DM + k];
          dst[i] = (bf16)f2bf(v); } }
    { float* rc = WSP(float, WS_TAB + TAB_ROPE_COS); float* rs = WSP(float, WS_TAB + TAB_ROPE_SIN);
      for (size_t i = gt; i < (size_t)SEQ * 16; i += gn) { const int pos = (int)(i >> 4), j = (int)(i & 15);
          const float inv = 1.0f / powf(500000.0f, (float)j / 16.0f); const float ang = (float)pos * inv; rc[i] = cosf(ang); rs[i] = sinf(ang); } }
    for (int o = C.gw; o < 256; o += C.ngw) { const int kv = o >> 7, e = o & 127; float s = 0.f;
        for (int i = C.lane; i < 4096; i += 64) s += INP(I_CMP_POS)[kv * 4096 + i] * INP(I_CMP_W1)[((size_t)kv * 4096 + i) * 128 + e];
        s = wave_sum(s); if (C.lane == 0) WSP(float, WS_TAB + TAB_CMPBIAS)[o] = s; }
    for (int r = C.gw; r < 2 * MT; r += C.ngw) { const int l = r / MT, m = r % MT;
        rms_row_bf16(INP(I_MEM) + (size_t)m * DM, INP(I_NORM_MEM) + l * DM, WSP(bf16, WS_MEMN) + ((size_t)l * MT + m) * DM, C.lane); }
    for (int r = C.gw; r < T; r += C.ngw) rms_row_bf16(INP(I_X) + (size_t)r * DM, INP(I_NORM_MIX), WSP(bf16, WS_XN) + (size_t)r * DM, C.lane);
}

struct MemProjOrder {
    int G, c;
    __device__ __forceinline__ bool next(int i, pg8::Unit& u) const {
        const int L = i * G + c; if (L >= 128) return false;
        const int pn = L & 7, pm = (L >> 3) & 3, kv = (L >> 5) & 1, l = L >> 6;
        u.pm = pm; u.pn = pn; u.aux = 0;
        u.aoff = ((long long)l * MT + pm * 256) * DM * 2;
        u.boff = ((long long)(kv ? (WS_W_CAV - WS_W_CAK) / 2 : 0) + ((long long)l * DM + pn * 256) * DM) * 2;
        u.coff = (long long)(kv ? (WS_VP - WS_KP) / 2 : 0) + ((long long)l * MT + pm * 256) * DM + pn * 256;
        return true;
    }
};
struct AbInMemOrder {
    pg8::DenseOrder d; MemProjOrder m;
    __device__ __forceinline__ bool next(int i, pg8::Unit& u) const {
        const long L = (long)i * d.G + d.c;
        if (L < (T / 256) * (AB_PAD / 256)) { int pm, pn; pg8::tile_of(L, d.nM, d.nN, pm, pn); u.pm = pm; u.pn = pn; u.aux = 0; u.aoff = (long long)WS_XN + pm * d.astep; u.boff = (long long)WS_W_ABIN + pn * d.bstep; u.coff = 0; return true; }
        pg8::Unit t; MemProjOrder mm{1 << 30, (int)(L - (T / 256) * (AB_PAD / 256))}; if (!mm.next(0, t)) return false;
        u = t; u.aux = 1; u.aoff += (long long)WS_MEMN; u.boff += (long long)WS_W_CAK; return true;
    }
};
struct EpiAbInMem { EpiAbIn a; EpiStoreBf16 m;
    __device__ __forceinline__ void operator()(EPI_ARGS) const { if (u.aux == 0) a(acc, u, wr, wc, fr, fq); else m(acc, u, wr, wc, fr, fq); } };
struct RouterOrder {
    int G, c;
    __device__ __forceinline__ bool next(int i, pg8::Unit& u) const {
        const int L = i * G + c; if (L >= 256) return false;
        const int pm = L & 63, ks = L >> 6; u.pm = pm; u.pn = 0; u.aux = ks;
        u.aoff = ((long long)pm * 256 * DM + ks * 512) * 2; u.boff = (long long)ks * 512 * 2; u.coff = ((long long)ks * T + pm * 256) * 256; return true;
    }
};
struct WktOrder {
    int G, c;
    __device__ __forceinline__ bool next(int i, pg8::Unit& u) const {
        const int L = i * G + c; if (L >= 256) return false;
        const int pn = L & 7, h = (L >> 3) & 3, b = (L >> 5) & 3, l = L >> 7;
        u.pm = 0; u.pn = pn; u.aux = 0;
        u.aoff = (((long long)l * MT + b * 256) * DM + h * 512) * 2;
        u.boff = (((long long)l * DM + pn * 256) * DM + h * 512) * 2;
        u.coff = (((long long)(l * 4 + b) * 1024) + h * 256) * DM + pn * 256;
        return true;
    }
};
struct VwtOrder {
    int G, c;
    __device__ __forceinline__ bool next(int i, pg8::Unit& u) const {
        const int L = i * G + c; if (L >= 256) return false;
        const int pm = L & 7, h = (L >> 3) & 3, b = (L >> 5) & 3, l = L >> 7;
        u.pm = pm; u.pn = 0; u.aux = 0;
        u.aoff = (((long long)l * DM + pm * 256) * DM + h * 512) * 2;
        u.boff = (((long long)l * MT + b * 256) * DM + h * 512) * 2;
        u.coff = (((long long)(l * 4 + b) * DM) + pm * 256) * 1024 + h * 256;
        return true;
    }
};
struct CrossOrder {
    int nN, G, c, ldc; long long astep, bstep, bbatch;
    __device__ __forceinline__ bool next(int i, pg8::Unit& u) const {
        int pm, pn; if (!pg8::tile_of((long)i * G + c, T / 256, nN, pm, pn)) return false;
        u.pm = pm; u.pn = pn; u.aux = 0; u.aoff = pm * astep; u.boff = (pm >> 4) * bbatch + pn * bstep; u.coff = (long long)pm * 256 * ldc + pn * 256; return true;
    }
};
struct CmpOrder {
    int G, c;
    __device__ __forceinline__ bool next(int i, pg8::Unit& u) const {
        const int L = i * G + c; if (L >= 256) return false;
        const int bg = L & 15, kv = (L >> 4) & 1, ks = L >> 5;
        u.pm = 0; u.pn = 0; u.aux = 0;
        u.aoff = (long long)kv * KV6_STRIDE + ((long long)bg * SPAD * 128 + ks * 512) * 2;
        u.boff = ((long long)kv * 256 * 4096 + ks * 512) * 2;
        u.coff = ((long long)(ks * 2 + kv) * 16 + bg) * 65536;
        return true;
    }
};
struct MoeOrder {
    const LAS int* tab; int npn, G, c, which;
    __device__ __forceinline__ bool next(int i, pg8::Unit& u) const {
        const int L = i * G + c, ntile = tab[64]; if (L >= ntile * npn) return false;
        const int tix = L / npn, pn = L % npn; int e = 0;
        for (int k = 32; k >= 1; k >>= 1) if (e + k < 64 && tab[e + k] <= tix) e += k;
        while (tab[e + 1] <= tix) ++e;
        const int mt = tix - tab[e], cnt = tab[65 + e], row0 = tab[129 + e] + mt * 256;
        u.pm = min(256, cnt - mt * 256); u.pn = pn; u.aux = row0;
        if (which == 0) { u.aoff = 0; u.boff = ((long long)e * 1024 + pn * 256) * DM * 2; }
        else { u.aoff = (long long)row0 * FF * 2; u.boff = ((long long)e * DM + pn * 256) * FF * 2; }
        u.coff = 0; return true;
    }
};
__device__ __forceinline__ void moe_build_table(const Ctx& C, const unsigned* cnt, LAS int* tab) {
    if (C.tid == 0) { int ts = 0, off = 0;
        for (int e = 0; e < 64; ++e) { const int n = (int)cnt[e]; tab[e] = ts; tab[65 + e] = n; tab[129 + e] = off; const int nt = (n + 255) >> 8; ts += nt; off += nt * 256; }
        tab[64] = ts; }
    __syncthreads();
}

__device__ __forceinline__ float log_sigmoidf_(float x) { return fminf(x, 0.f) - log1pf(__expf(-fabsf(x))); }
__device__ __forceinline__ void phase_mixer_prep(const Ctx& C, const Args& A) {
    const bf16* PAB = ARP(bf16, A_PAB); const float* G32 = ARP(float, A_GF32);
    bf16 *QM = ARP(bf16, A_QM), *KM = ARP(bf16, A_KM), *RR = ARP(bf16, A_RR), *KR = ARP(bf16, A_KR), *VR = ARP(bf16, A_VR), *KK = ARP(bf16, A_KK), *LIN = ARP(bf16, A_LIN);
    float *IG = ARP(float, A_IG), *LF = ARP(float, A_LF);
    const float *cw = INP(I_ML_CONV_W), *cb = INP(I_ML_CONV_B), *gb = INP(I_ML_GATE_B), *mu = INP(I_RW_MU), *k_k = INP(I_RW_K_K);
    const int lane = C.lane;
    for (int t = C.gw; t < T; t += C.ngw) {
        const int b = t >> 12, s = t & 4095; const bf16* P = PAB + (size_t)t * AB_PAD; const bf16* PR = P + ML_COLS;
        u32x4 cx[2][4], pc[7], pq[7]; const u32x4 z4 = (u32x4){0u, 0u, 0u, 0u};
#pragma unroll
        for (int it = 0; it < 2; ++it)
#pragma unroll
            for (int tap = 0; tap < 4; ++tap) { const int back = 3 - tap; cx[it][tap] = z4; if (s >= back) cx[it][tap] = *(const u32x4*)(P - (size_t)back * AB_PAD + (lane + 64 * it) * 8); }
#pragma unroll
        for (int it = 0; it < 7; ++it) { const int chunk = lane + 64 * it; pc[it] = z4; pq[it] = z4;
            if (chunk < 416) { pc[it] = *(const u32x4*)(PR + chunk * 8); if (s > 0) pq[it] = *(const u32x4*)(PR - AB_PAD + chunk * 8); } }
#pragma unroll
        for (int it = 0; it < 2; ++it) { const int c = (lane + 64 * it) * 8; float y[8];
            { const f32x4 b0 = *(const f32x4*)(cb + c), b1 = *(const f32x4*)(cb + c + 4); y[0] = b0.x; y[1] = b0.y; y[2] = b0.z; y[3] = b0.w; y[4] = b1.x; y[5] = b1.y; y[6] = b1.z; y[7] = b1.w; }
#pragma unroll
            for (int tap = 0; tap < 4; ++tap) { float xv[8]; unpack8(cx[it][tap], xv);
                const f32x4 w0 = *(const f32x4*)(cw + tap * 1024 + c), w1 = *(const f32x4*)(cw + tap * 1024 + c + 4);
                y[0] += xv[0] * w0.x; y[1] += xv[1] * w0.y; y[2] += xv[2] * w0.z; y[3] += xv[3] * w0.w; y[4] += xv[4] * w1.x; y[5] += xv[5] * w1.y; y[6] += xv[6] * w1.z; y[7] += xv[7] * w1.w; }
#pragma unroll
            for (int j = 0; j < 8; ++j) y[j] = siluf_(y[j]);
            if (c < 512) *(u32x4*)(QM + (size_t)t * 512 + c) = pack8f(y); else *(u32x4*)(KM + (size_t)t * 512 + c - 512) = pack8f(y); }
        if (lane < 8) { const float g = G32[(size_t)t * 256 + lane] + gb[lane];
            if (lane < 4) IG[(size_t)(b * 4 + lane) * SEQ + s] = g; else LF[(size_t)(b * 4 + lane - 4) * SEQ + s] = log_sigmoidf_(g); }
#pragma unroll
        for (int it = 0; it < 7; ++it) { const int chunk = lane + 64 * it; if (chunk >= 416) break; const int cc = chunk * 8;
            float p[8], pp[8], mx[8]; unpack8(pc[it], p); unpack8(pq[it], pp);
            { const f32x4 m0 = *(const f32x4*)(mu + cc), m1 = *(const f32x4*)(mu + cc + 4); const float mf[8] = {m0.x, m0.y, m0.z, m0.w, m1.x, m1.y, m1.z, m1.w};
#pragma unroll
              for (int j = 0; j < 8; ++j) mx[j] = p[j] + (pp[j] - p[j]) * mf[j]; }
            if (it < 2) *(u32x4*)(RR + (size_t)t * 1024 + cc) = pack8f(mx);
            else if (it < 4) { const int ck = cc - 1024; *(u32x4*)(KR + (size_t)t * 1024 + ck) = pack8f(mx);
                float kk[8], ss = 0.f; const f32x4 q0 = *(const f32x4*)(k_k + ck), q1 = *(const f32x4*)(k_k + ck + 4); const float kf[8] = {q0.x, q0.y, q0.z, q0.w, q1.x, q1.y, q1.z, q1.w};
#pragma unroll
                for (int j = 0; j < 8; ++j) { kk[j] = mx[j] * kf[j]; ss += kk[j] * kk[j]; }
                ss += DPPF(ss, DPP_XOR1); ss += DPPF(ss, DPP_XOR2); ss += DPPF(ss, DPP_HMIRROR);
                const float rn = rsqrtf(ss + 1e-12f);
#pragma unroll
                for (int j = 0; j < 8; ++j) kk[j] *= rn;
                *(u32x4*)(KK + (size_t)t * 1024 + ck) = pack8f(kk); }
            else if (it < 6) *(u32x4*)(VR + (size_t)t * 1024 + cc - 2048) = pack8f(mx);
            else { float o[8];
#pragma unroll
                for (int j = 0; j < 8; ++j) o[j] = (lane < 8) ? tanhf(mx[j]) : ((lane < 16) ? mx[j] : sigmoidf_(mx[j]));
                *(u32x4*)(LIN + (size_t)t * 256 + lane * 8) = pack8f(o); } }
    }
}

__device__ __forceinline__ void rwkv_scan_unit(const Ctx& C, const Args& A, int bh) {
    const int b = bh >> 4, h = bh & 15, w = C.wave, lane = C.lane, tid = C.tid;
    LAS float* IN = (LAS float*)C.lds;
    LAS float* PART = IN + 2 * 6 * 1024;
    LAS float* YP = PART + 2 * 8 * 64;
    const float* WD = ARP(float, A_WD); const bf16 *KKg = ARP(bf16, A_KK), *BV = ARP(bf16, A_BV), *KP = ARP(bf16, A_KP), *RR = ARP(bf16, A_RR), *VR = ARP(bf16, A_VR), *GG = ARP(bf16, A_GG);
    bf16* YCAT = ARP(bf16, A_YCAT);
    const float *r_k = INP(I_RW_R_K), *ln_w = INP(I_RW_LN_W), *ln_b = INP(I_RW_LN_B);
    const int li = tid >> 5, lch = (tid & 31) * 2;
    const size_t gbase = ((size_t)b * SEQ) * 1024 + h * 64 + lch;
    f32x2 rw; unsigned rk, rb, rp, rr_, rv;
#define RW_LOAD(grp) do { const size_t o = gbase + (size_t)((grp) * 16 + li) * 1024; rw = *(const f32x2*)(WD + o); rk = *(const unsigned*)(KKg + o); rb = *(const unsigned*)(BV + o); \
        rp = *(const unsigned*)(KP + o); rr_ = *(const unsigned*)(RR + o); rv = *(const unsigned*)(VR + o); } while (0)
#define RW_STORE(buf) do { LAS float* d = IN + (buf) * 6144 + li * 64 + lch; *(LAS f32x2*)(d) = rw; *(LAS f32x2*)(d + 1024) = (f32x2){lo_bf(rk), hi_bf(rk)}; *(LAS f32x2*)(d + 2048) = (f32x2){lo_bf(rb), hi_bf(rb)}; \
        *(LAS f32x2*)(d + 3072) = (f32x2){lo_bf(rp), hi_bf(rp)}; *(LAS f32x2*)(d + 4096) = (f32x2){lo_bf(rr_), hi_bf(rr_)}; *(LAS f32x2*)(d + 5120) = (f32x2){lo_bf(rv), hi_bf(rv)}; } while (0)
    float st[8];
#pragma unroll
    for (int j = 0; j < 8; ++j) st[j] = 0.f;
    __syncthreads();
    RW_LOAD(0); RW_STORE(0); __syncthreads();
    for (int grp = 0; grp < SEQ / 16; ++grp) {
        const int buf = grp & 1; const LAS float* I0 = IN + buf * 6144;
        if (grp + 1 < SEQ / 16) RW_LOAD(grp + 1);
        for (int i = 0; i < 16; ++i) {
            const LAS float* q = I0 + i * 64 + 8 * w;
            const f32x4 w0 = *(const LAS f32x4*)(q), w1 = *(const LAS f32x4*)(q + 4), k0 = *(const LAS f32x4*)(q + 1024), k1 = *(const LAS f32x4*)(q + 1028);
            const f32x4 b0 = *(const LAS f32x4*)(q + 2048), b1 = *(const LAS f32x4*)(q + 2052), p0 = *(const LAS f32x4*)(q + 3072), p1 = *(const LAS f32x4*)(q + 3076);
            const f32x4 r0 = *(const LAS f32x4*)(q + 4096), r1 = *(const LAS f32x4*)(q + 4100); const float vv = I0[5120 + i * 64 + lane];
            float skp = 0.f;
#pragma unroll
            for (int j = 0; j < 4; ++j) skp += st[j] * k0[j] + st[4 + j] * k1[j];
            PART[(i & 1) * 512 + w * 64 + lane] = skp;
            LDS_WAIT(); __builtin_amdgcn_s_barrier(); asm volatile("" ::: "memory");
            float sk = 0.f;
#pragma unroll
            for (int ww = 0; ww < 8; ++ww) sk += PART[(i & 1) * 512 + ww * 64 + lane];
            float yp = 0.f;
#pragma unroll
            for (int j = 0; j < 4; ++j) { st[j] = st[j] * w0[j] - sk * b0[j] + vv * p0[j]; st[4 + j] = st[4 + j] * w1[j] - sk * b1[j] + vv * p1[j]; yp += st[j] * r0[j] + st[4 + j] * r1[j]; }
            YP[i * 512 + w * 64 + lane] = yp;
        }
        if (grp + 1 < SEQ / 16) RW_STORE(buf ^ 1);
        __syncthreads();
#pragma unroll
        for (int q = 0; q < 2; ++q) { const int i = 2 * w + q; float y = 0.f;
#pragma unroll
            for (int ww = 0; ww < 8; ++ww) y += YP[i * 512 + ww * 64 + lane];
            const float mean = wave_sum(y) * (1.f / 64.f), dv = y - mean, var = wave_sum(dv * dv) * (1.f / 64.f);
            const int ch = h * 64 + lane; const float yn = dv * rsqrtf(var + 64e-5f) * ln_w[ch] + ln_b[ch];
            const float bonus = wave_sum(I0[4096 + i * 64 + lane] * I0[3072 + i * 64 + lane] * r_k[ch]) * I0[5120 + i * 64 + lane];
            const size_t tt = (size_t)b * SEQ + grp * 16 + i;
            const float g = bf2f(GG[tt * 1024 + ch]);
            YCAT[tt * DM + 1024 + ch] = (bf16)f2bf((yn + bonus) * g); }
    }
#undef RW_LOAD
#undef RW_STORE
    __syncthreads();
}

__device__ __forceinline__ f32x4 lds_mma(const LAS bf16* Am, int lda, const LAS bf16* Bt, int ldb, int tm, int tn, int K, int lane, f32x4 acc) {
    const LAS bf16* ap = Am + (tm * 16 + (lane & 15)) * lda + (lane >> 4) * 8;
    const LAS bf16* bp = Bt + (tn * 16 + (lane & 15)) * ldb + (lane >> 4) * 8;
    for (int k = 0; k < K; k += 32) { const bf16x8 a = *(const LAS bf16x8*)(ap + k); const bf16x8 bb = *(const LAS bf16x8*)(bp + k);
        acc = __builtin_amdgcn_mfma_f32_16x16x32_bf16(bb, a, acc, 0, 0, 0); }
    return acc;
}

constexpr int RP = 72;
__device__ __forceinline__ void st4_bf16(LAS bf16* p, f32x4 v) { u32x2 w; w.x = pk2(v[0], v[1]); w.y = pk2(v[2], v[3]); *(LAS u32x2*)p = w; }
__device__ __forceinline__ void st4_bf16_T(LAS bf16* base, int row, int col0, f32x4 v) {
#pragma unroll
    for (int j = 0; j < 4; ++j) base[(col0 + j) * RP + row] = (bf16)f2bf(v[j]);
}
__device__ __forceinline__ void st4_bf16_g(bf16* p, f32x4 v) { u32x2 w; w.x = pk2(v[0], v[1]); w.y = pk2(v[2], v[3]); *(u32x2*)p = w; }
__device__ __forceinline__ void tri_inverse_diag32(const LAS float* Cf, LAS bf16* Tm, LAS bf16* T00T, int lane) {
    const int hb = lane >> 5, j = lane & 31; const LAS float* Cb_ = Cf + hb * (32 * 64 + 32); float Tr[32];
#pragma unroll
    for (int t = 0; t < 32; ++t) { float acc0 = (t == j) ? 1.f : 0.f, acc1 = 0.f, acc2 = 0.f, acc3 = 0.f;
#pragma unroll
        for (int s4 = 0; s4 < (t + 3) / 4; ++s4) { const f32x4 cv = *(const LAS f32x4*)(Cb_ + t * 64 + s4 * 4);
            if (s4 * 4 + 0 < t) acc0 -= cv[0] * Tr[s4 * 4 + 0]; if (s4 * 4 + 1 < t) acc1 -= cv[1] * Tr[s4 * 4 + 1];
            if (s4 * 4 + 2 < t) acc2 -= cv[2] * Tr[s4 * 4 + 2]; if (s4 * 4 + 3 < t) acc3 -= cv[3] * Tr[s4 * 4 + 3]; }
        Tr[t] = (acc0 + acc1) + (acc2 + acc3); Tm[(32 * hb + t) * RP + 32 * hb + j] = (bf16)f2bf(Tr[t]); __builtin_amdgcn_sched_barrier(0); }
    if (hb == 0) {
#pragma unroll
        for (int q = 0; q < 4; ++q) *(LAS u32x4*)(T00T + j * 40 + 8 * q) = pack8f(Tr + 8 * q); }
    { const int t = lane >> 1, h = lane & 1; const u32x4 z = (u32x4){0u, 0u, 0u, 0u}; *(LAS u32x4*)(Tm + t * RP + 32 + 16 * h) = z; *(LAS u32x4*)(Tm + t * RP + 32 + 16 * h + 8) = z; }
}
__device__ __forceinline__ void rwkv_prep_units(const Ctx& C, bool side_cvt) {
    int unit = C.bid; if (unit >= 4096) return;
    const int w = C.wave;
    LAS float* F = (LAS float*)C.lds;
    LAS float* EGL = F + 4096;
    LAS bf16* B0 = (LAS bf16*)(EGL + 64 + 512);
    LAS bf16 *Kt = B0, *Rt = B0 + 64 * RP, *Kb = B0 + 2 * 64 * RP, *Bb = B0 + 3 * 64 * RP, *KtT = B0 + 4 * 64 * RP, *KhT = B0 + 5 * 64 * RP, *BhT = B0 + 6 * 64 * RP,
             *VcT = B0 + 7 * 64 * RP, *Am = B0 + 8 * 64 * RP, *Q1 = B0 + 9 * 64 * RP, *Q2 = B0 + 10 * 64 * RP;
    LAS bf16 *Tm = Kt, *AVT = Kb, *WmT = Bb, *UT = Am;
    LAS bf16 *C10b = (LAS bf16*)(C.lds + LDS_AUX), *T00T = C10b + 32 * 40, *XT = T00T + 32 * 40;
    const float* WD = ARP(float, A_WD); const bf16 *KKg = ARP(bf16, A_KK), *BV = ARP(bf16, A_BV), *KP = ARP(bf16, A_KP), *RR = ARP(bf16, A_RR), *VR = ARP(bf16, A_VR);
    f32x4 lw0, lw1; u32x4 rk, rb, rp, rr, rv;
#define RWP_LOAD(u_) do { const int bh_ = (u_) >> 6, c_ = (u_) & 63; const size_t go_ = ((size_t)(bh_ >> 4) * SEQ + c_ * 64 + (C.tid >> 3)) * 1024 + (bh_ & 15) * 64 + (C.tid & 7) * 8; \
        lw0 = *(const f32x4*)(WD + go_); lw1 = *(const f32x4*)(WD + go_ + 4); rk = *(const u32x4*)(KKg + go_); rb = *(const u32x4*)(BV + go_); rp = *(const u32x4*)(KP + go_); rr = *(const u32x4*)(RR + go_); rv = *(const u32x4*)(VR + go_); } while (0)
    RWP_LOAD(unit);
  for (;;) {
    int tid = C.tid; asm volatile("" : "+v"(tid));
    const int lane = tid & 63, t = tid >> 3, c8 = (tid & 7) * 8;
    bf16 *GM = ARP(bf16, A_RWM) + (size_t)unit * 4096, *GN = ARP(bf16, A_RWN) + (size_t)unit * 4096, *GRW = ARP(bf16, A_RWRW) + (size_t)unit * 4096, *GYL = ARP(bf16, A_RWYL) + (size_t)unit * 4096;
    __syncthreads();
    *(LAS f32x4*)(F + t * 64 + c8) = lw0; *(LAS f32x4*)(F + t * 64 + c8 + 4) = lw1;
    __syncthreads();
    { float g = 0.f;
#pragma unroll
      for (int i = 0; i < 8; ++i) { g += F[(8 * w + i) * 64 + lane]; F[(8 * w + i) * 64 + lane] = g; }
      EGL[64 + w * 64 + lane] = g; }
    __syncthreads();
    { float off = 0.f;
      for (int ww = 0; ww < w; ++ww) off += EGL[64 + ww * 64 + lane];
#pragma unroll
      for (int i = 0; i < 8; ++i) F[(8 * w + i) * 64 + lane] += off; }
    __syncthreads();
    { float G[8], Gm[8], GL[8], kkf[8], bf_[8], kpf[8], rf[8], vf[8];
#pragma unroll
      for (int j = 0; j < 8; ++j) { G[j] = F[t * 64 + c8 + j]; Gm[j] = t > 0 ? F[(t - 1) * 64 + c8 + j] : 0.f; GL[j] = F[63 * 64 + c8 + j]; }
      unpack8(rk, kkf); unpack8(rb, bf_); unpack8(rp, kpf); unpack8(rr, rf); unpack8(rv, vf);
      float okt[8], ort[8], okb[8], obb[8];
#pragma unroll
      for (int j = 0; j < 8; ++j) { const float e1 = __expf(Gm[j]), e2 = __expf(G[j]), e3 = __expf(-G[j]), e4 = __expf(GL[j] - G[j]);
          okt[j] = kkf[j] * e1; ort[j] = rf[j] * e2; okb[j] = kpf[j] * e3; obb[j] = bf_[j] * e3;
          KtT[(c8 + j) * RP + t] = (bf16)f2bf(okt[j]); KhT[(c8 + j) * RP + t] = (bf16)f2bf(kpf[j] * e4); BhT[(c8 + j) * RP + t] = (bf16)f2bf(bf_[j] * e4);
          VcT[(c8 + j) * RP + t] = (bf16)f2bf(vf[j]);
          if (t == 63) EGL[c8 + j] = e2; }
      *(LAS u32x4*)(Kt + t * RP + c8) = pack8f(okt); *(LAS u32x4*)(Rt + t * RP + c8) = pack8f(ort); *(LAS u32x4*)(Kb + t * RP + c8) = pack8f(okb); *(LAS u32x4*)(Bb + t * RP + c8) = pack8f(obb); }
    const int next_unit = unit + C.G; if (next_unit < 4096) RWP_LOAD(next_unit);
    f32x4 cvv[2][8]; MoeTile mt = moe_tile_decode(C, MOE_CVT_BASE_C + (unit * 8 + w) * 2);
    if (side_cvt) moe_pair_load(mt, cvv, lane);
    __syncthreads();
    const int tm = w >> 1, tn0 = (w & 1) * 2, row = tm * 16 + (lane & 15), cq = 4 * (lane >> 4); const f32x4 z4 = (f32x4){0.f, 0.f, 0.f, 0.f};
#pragma unroll
    for (int q = 0; q < 2; ++q) { const int tn = tn0 + q, col = tn * 16 + cq;
        f32x4 a = lds_mma(Kt, RP, Kb, RP, tm, tn, 64, lane, z4), cc = lds_mma(Kt, RP, Bb, RP, tm, tn, 64, lane, z4), q1 = lds_mma(Rt, RP, Kb, RP, tm, tn, 64, lane, z4), q2 = lds_mma(Rt, RP, Bb, RP, tm, tn, 64, lane, z4);
#pragma unroll
        for (int j = 0; j < 4; ++j) { const bool lo_ = (col + j) < row, le_ = (col + j) <= row; a[j] = lo_ ? a[j] : 0.f; cc[j] = lo_ ? cc[j] : 0.f; q1[j] = le_ ? q1[j] : 0.f; q2[j] = le_ ? q2[j] : 0.f; }
        st4_bf16(Am + row * RP + col, a); st4_bf16(Q1 + row * RP + col, q1); st4_bf16(Q2 + row * RP + col, q2); *(LAS f32x4*)(F + row * 64 + col) = cc;
        if (row >= 32 && col < 32) st4_bf16(C10b + (row - 32) * 40 + col, cc); }
    __syncthreads();
    if (w == 0) tri_inverse_diag32(F, Tm, T00T, lane);
    else { for (int tile = w - 1; tile < 16; tile += 7) { const int am = tile >> 2, an = tile & 3; const f32x4 av = lds_mma(Am, RP, VcT, RP, am, an, 64, lane, z4); st4_bf16_T(AVT, am * 16 + (lane & 15), an * 16 + cq, av); } }
    __syncthreads();
    if (w < 4) { const int bm = w >> 1, bn = w & 1; const f32x4 x = lds_mma(C10b, 40, T00T, 40, bm, bn, 32, lane, z4);
#pragma unroll
        for (int j = 0; j < 4; ++j) XT[(bn * 16 + cq + j) * 40 + bm * 16 + (lane & 15)] = (bf16)f2bf(x[j]); }
    __syncthreads();
    if (w < 4) { const int bm = w >> 1, bn = w & 1; const f32x4 x = lds_mma(Tm + 32 * RP + 32, RP, XT, 40, bm, bn, 32, lane, z4);
        st4_bf16(Tm + (32 + bm * 16 + (lane & 15)) * RP + bn * 16 + cq, (f32x4){-x[0], -x[1], -x[2], -x[3]}); }
    if (side_cvt) moe_pair_store(mt, cvv, lane);
    __syncthreads();
#pragma unroll
    for (int q = 0; q < 2; ++q) { const int tn = tn0 + q, col = tn * 16 + cq;
        const f32x4 wm = lds_mma(Tm, RP, KtT, RP, tm, tn, 64, lane, z4), uu = lds_mma(Tm, RP, AVT, RP, tm, tn, 64, lane, z4);
        st4_bf16_T(WmT, row, col, wm); st4_bf16_T(UT, row, col, uu); }
    __syncthreads();
#pragma unroll
    for (int q = 0; q < 2; ++q) { const int tn = tn0 + q, col = tn * 16 + cq;
        { f32x4 p = lds_mma(Q2, RP, WmT, RP, tm, tn, 64, lane, z4); const u32x2 rw_ = *(const LAS u32x2*)(Rt + row * RP + col);
          st4_bf16_g(GRW + row * 64 + col, (f32x4){lo_bf(rw_.x) - p[0], hi_bf(rw_.x) - p[1], lo_bf(rw_.y) - p[2], hi_bf(rw_.y) - p[3]}); }
        { const f32x4 p1 = lds_mma(Q1, RP, VcT, RP, tm, tn, 64, lane, z4), p2 = lds_mma(Q2, RP, UT, RP, tm, tn, 64, lane, z4); st4_bf16_g(GYL + row * 64 + col, p1 - p2); }
        { f32x4 p = lds_mma(BhT, RP, WmT, RP, tm, tn, 64, lane, z4);
#pragma unroll
          for (int j = 0; j < 4; ++j) p[j] = ((col + j) == row ? EGL[row] : 0.f) - p[j];
          st4_bf16_g(GM + row * 64 + col, p); }
        { const f32x4 p1 = lds_mma(KhT, RP, VcT, RP, tm, tn, 64, lane, z4), p2 = lds_mma(BhT, RP, UT, RP, tm, tn, 64, lane, z4); st4_bf16_g(GN + row * 64 + col, p1 - p2); } }
    if (next_unit >= 4096) break; unit = next_unit;
  }
#undef RWP_LOAD
}
__device__ __forceinline__ void rwkv_scan_slice(const Ctx& C, int item) {
    const int bh = item >> 2, v0 = (item & 3) * 16, b = bh >> 4, h = bh & 15, lane = C.lane, w = C.wave;
    LAS bf16* SH = (LAS bf16*)C.lds;
    LAS bf16* SL = SH + 2 * 16 * RP;
    const bf16 *GM = ARP(bf16, A_RWM) + (size_t)bh * 64 * 4096, *GN = ARP(bf16, A_RWN) + (size_t)bh * 64 * 4096, *GRW = ARP(bf16, A_RWRW) + (size_t)bh * 64 * 4096, *GYL = ARP(bf16, A_RWYL) + (size_t)bh * 64 * 4096;
    bf16* YRAW = ARP(bf16, A_KR);
    const bool is_state = w >= 4; const int tm = w & 3, row = tm * 16 + (lane & 15), cq = 4 * (lane >> 4), kq = (lane >> 4) * 8;
    const bf16* GA = is_state ? GM : GRW; const bf16* GB = is_state ? GN : GYL;
    f32x4 st = (f32x4){0.f, 0.f, 0.f, 0.f};
    bf16x8 a0, a1, b0, b1; u32x2 addA, addB;
#define RWS_LOAD(cc_, X0, X1, XA) do { const size_t uo_ = (size_t)(cc_) * 4096; X0 = *(const bf16x8*)(GA + uo_ + row * 64 + kq); X1 = *(const bf16x8*)(GA + uo_ + row * 64 + 32 + kq); XA = *(const u32x2*)(GB + uo_ + row * 64 + v0 + cq); } while (0)
#define RWS_STEP(c_, X0, X1, XA) do { \
        LAS bf16* sh = SH + ((c_) & 1) * 16 * RP; LAS bf16* sl = SL + ((c_) & 1) * 16 * RP; \
        if (is_state) { _Pragma("unroll") for (int j = 0; j < 4; ++j) { const float s_ = st[j]; const unsigned hb = f2bf(s_); sh[(cq + j) * RP + row] = (bf16)hb; sl[(cq + j) * RP + row] = (bf16)f2bf(s_ - __uint_as_float(hb << 16)); } } \
        LDS_WAIT(); __builtin_amdgcn_s_barrier(); asm volatile("" ::: "memory"); \
        const LAS bf16* bh_ = sh + (lane & 15) * RP + kq; const LAS bf16* bl_ = sl + (lane & 15) * RP + kq; \
        const bf16x8 h0 = *(const LAS bf16x8*)bh_, h1 = *(const LAS bf16x8*)(bh_ + 32), l0 = *(const LAS bf16x8*)bl_, l1 = *(const LAS bf16x8*)(bl_ + 32); \
        f32x4 acc = (f32x4){lo_bf(XA.x), hi_bf(XA.x), lo_bf(XA.y), hi_bf(XA.y)}; \
        acc = __builtin_amdgcn_mfma_f32_16x16x32_bf16(h0, X0, acc, 0, 0, 0); acc = __builtin_amdgcn_mfma_f32_16x16x32_bf16(h1, X1, acc, 0, 0, 0); \
        acc = __builtin_amdgcn_mfma_f32_16x16x32_bf16(l0, X0, acc, 0, 0, 0); acc = __builtin_amdgcn_mfma_f32_16x16x32_bf16(l1, X1, acc, 0, 0, 0); \
        if ((c_) + 2 < 64) RWS_LOAD((c_) + 2, X0, X1, XA); \
        if (is_state) st = acc; \
        else st4_bf16_g(YRAW + ((size_t)b * SEQ + (c_) * 64 + row) * 1024 + h * 64 + v0 + cq, acc); } while (0)
    RWS_LOAD(0, a0, a1, addA); RWS_LOAD(1, b0, b1, addB);
    __syncthreads();
    for (int c = 0; c < 64; c += 2) { RWS_STEP(c, a0, a1, addA); RWS_STEP(c + 1, b0, b1, addB); }
#undef RWS_LOAD
#undef RWS_STEP
    __syncthreads();
}
__device__ __forceinline__ float sum8(float v) { v += DPPF(v, DPP_XOR1); v += DPPF(v, DPP_XOR2); v += DPPF(v, DPP_HMIRROR); return v; }
__device__ __forceinline__ void rwkv_out_items(const Ctx& C) {
    const bf16 *YRAW = ARP(bf16, A_KR), *KP = ARP(bf16, A_KP), *RR = ARP(bf16, A_RR), *VR = ARP(bf16, A_VR), *GG = ARP(bf16, A_GG); bf16* YCAT = ARP(bf16, A_YCAT);
    const float *r_k = INP(I_RW_R_K), *ln_w = INP(I_RW_LN_W), *ln_b = INP(I_RW_LN_B); const int lane = C.lane;
    for (int tt = C.gw; tt < T; tt += C.ngw) {
#pragma unroll
        for (int j = 0; j < 2; ++j) { const int ch = (j * 64 + lane) * 8; const size_t o = (size_t)tt * 1024 + ch;
            float y[8], rr[8], kp[8], vr[8], gg[8]; unpack8(*(const u32x4*)(YRAW + o), y); unpack8(*(const u32x4*)(RR + o), rr); unpack8(*(const u32x4*)(KP + o), kp); unpack8(*(const u32x4*)(VR + o), vr); unpack8(*(const u32x4*)(GG + o), gg);
            const f32x4 rk0 = *(const f32x4*)(r_k + ch), rk1 = *(const f32x4*)(r_k + ch + 4), lw0 = *(const f32x4*)(ln_w + ch), lw1 = *(const f32x4*)(ln_w + ch + 4), lb0 = *(const f32x4*)(ln_b + ch), lb1 = *(const f32x4*)(ln_b + ch + 4);
            const float rkf[8] = {rk0.x, rk0.y, rk0.z, rk0.w, rk1.x, rk1.y, rk1.z, rk1.w}, lwf[8] = {lw0.x, lw0.y, lw0.z, lw0.w, lw1.x, lw1.y, lw1.z, lw1.w}, lbf[8] = {lb0.x, lb0.y, lb0.z, lb0.w, lb1.x, lb1.y, lb1.z, lb1.w};
            float s1 = 0.f, sb = 0.f;
#pragma unroll
            for (int q = 0; q < 8; ++q) { s1 += y[q]; sb += rr[q] * kp[q] * rkf[q]; }
            const float mean = sum8(s1) * (1.f / 64.f), bonus = sum8(sb); float s2 = 0.f;
#pragma unroll
            for (int q = 0; q < 8; ++q) { y[q] -= mean; s2 += y[q] * y[q]; }
            const float rstd = rsqrtf(sum8(s2) * (1.f / 64.f) + 64e-5f); float o8[8];
#pragma unroll
            for (int q = 0; q < 8; ++q) o8[q] = (y[q] * rstd * lwf[q] + lbf[q] + bonus * vr[q]) * gg[q];
            st16_f(YCAT + (size_t)tt * DM + 1024 + ch, pack8f(o8)); }
    }
}
constexpr int MLE = 272;
__device__ __forceinline__ void ml_gate_scan(const Ctx& C, int bh4) {
    const float *IG = ARP(float, A_IG) + (size_t)bh4 * SEQ, *LFp = ARP(float, A_LF) + (size_t)bh4 * SEQ; float *AAg = ARP(float, A_MLA) + (size_t)bh4 * SEQ, *MXg = ARP(float, A_MLM) + (size_t)bh4 * SEQ;
    const int lane = C.lane, p0 = lane * 64; float tot = 0.f;
    for (int i = 0; i < 64; i += 4) { const f32x4 f = *(const f32x4*)(LFp + p0 + i); tot += (f.x + f.y) + (f.z + f.w); }
    float inc = tot;
#pragma unroll
    for (int o = 1; o < 64; o <<= 1) { const float n = __shfl_up(inc, o); if (lane >= o) inc += n; }
    float F = inc - tot, mloc = -INFINITY; f32x4 av[16];
#pragma unroll
    for (int i = 0; i < 16; ++i) { const f32x4 f = *(const f32x4*)(LFp + p0 + 4 * i), g = *(const f32x4*)(IG + p0 + 4 * i); f32x4 a;
        F += f.x; a.x = g.x - F; F += f.y; a.y = g.y - F; F += f.z; a.z = g.z - F; F += f.w; a.w = g.w - F;
        *(f32x4*)(AAg + p0 + 4 * i) = a; av[i] = a; mloc = fmaxf(fmaxf(mloc, fmaxf(a.x, a.y)), fmaxf(a.z, a.w)); }
    float minc = mloc;
#pragma unroll
    for (int o = 1; o < 64; o <<= 1) { const float n = __shfl_up(minc, o); if (lane >= o) minc = fmaxf(minc, n); }
    float run = __shfl_up(minc, 1); if (lane == 0) run = 0.f; run = fmaxf(run, 0.f);
#pragma unroll
    for (int i = 0; i < 16; ++i) { const f32x4 a = av[i]; f32x4 m;
        run = fmaxf(run, a.x); m.x = run; run = fmaxf(run, a.y); m.y = run; run = fmaxf(run, a.z); m.z = run; run = fmaxf(run, a.w); m.w = run;
        *(f32x4*)(MXg + p0 + 4 * i) = m; }
}
__device__ __forceinline__ void ml_intra_unit(const Ctx& C, int unit, bool side_cvt) {
    int tid = C.tid; asm volatile("" : "+v"(tid));
    const int bh4 = unit >> 6, c = unit & 63, b = bh4 >> 2, h = bh4 & 3, w = C.wave, lane = tid & 63, t0 = c * 64;
    LAS bf16* Qs = (LAS bf16*)C.lds;
    LAS bf16* Ks = Qs + 64 * 136;
    LAS bf16* KwT = Ks + 64 * 136;
    LAS bf16* VtE = KwT + 128 * 72;
    LAS bf16* Ps = VtE + MLE * 72;
    LAS float* AAs = (LAS float*)(Ps + 64 * 72);
    const bf16 *QM = ARP(bf16, A_QM), *KM = ARP(bf16, A_KM), *PAB = ARP(bf16, A_PAB);
    const float *AAg = ARP(float, A_MLA) + (size_t)bh4 * SEQ + t0, *MXg = ARP(float, A_MLM) + (size_t)bh4 * SEQ + t0;
    bf16* NUMI = ARP(bf16, A_MLNUM) + (size_t)unit * 64 * MLE; bf16* KVT = ARP(bf16, A_MLKV) + (size_t)unit * MLE * 128;
    const size_t tok0 = (size_t)b * SEQ + t0;
    u32x4 rq[2], rk[2], rv[4];
#pragma unroll
    for (int k = 0; k < 2; ++k) { const int idx = tid + 512 * k, r = idx >> 4, c8 = (idx & 15) * 8; const size_t o = (tok0 + r) * 512 + h * 128 + c8; rq[k] = *(const u32x4*)(QM + o); rk[k] = *(const u32x4*)(KM + o); }
#pragma unroll
    for (int k = 0; k < 4; ++k) { const int idx = tid + 512 * k, r = idx >> 5, e8 = (idx & 31) * 8; rv[k] = *(const u32x4*)(PAB + (tok0 + r) * AB_PAD + 1024 + h * 256 + e8); }
    const float Mc2 = MXg[63];
    f32x4 cvv[2][8]; MoeTile mt = moe_tile_decode(C, MOE_CVT_BASE_F + (unit * 8 + w) * 2); if (side_cvt) moe_pair_load(mt, cvv, lane);
    __syncthreads();
    if (tid < 64) { AAs[tid] = AAg[tid]; AAs[64 + tid] = MXg[tid]; }
    for (int i = tid; i < 16 * 72; i += NTHR) VtE[256 * 72 + i] = (i < 72) ? (bf16)0x3f80 : (bf16)0;
#pragma unroll
    for (int k = 0; k < 2; ++k) { const int idx = tid + 512 * k, r = idx >> 4, c8 = (idx & 15) * 8;
        *(LAS u32x4*)(Qs + r * 136 + c8) = rq[k]; *(LAS u32x4*)(Ks + r * 136 + c8) = rk[k];
        float kf[8]; unpack8(rk[k], kf); const float wk = __expf(AAg[r] - Mc2);
#pragma unroll
        for (int j = 0; j < 8; ++j) KwT[(c8 + j) * 72 + r] = (bf16)f2bf(kf[j] * wk); }
#pragma unroll
    for (int k = 0; k < 4; ++k) { const int idx = tid + 512 * k, r = idx >> 5, e8 = (idx & 31) * 8; const unsigned wv[4] = {rv[k].x, rv[k].y, rv[k].z, rv[k].w};
#pragma unroll
        for (int j = 0; j < 4; ++j) { VtE[(e8 + 2 * j) * 72 + r] = (bf16)(wv[j] & 0xffff); VtE[(e8 + 2 * j + 1) * 72 + r] = (bf16)(wv[j] >> 16); } }
    __syncthreads();
#pragma unroll
    for (int q = 0; q < 2; ++q) { const int tile = 2 * w + q, tm = tile >> 2, tn = tile & 3; const int t = tm * 16 + (lane & 15), l0 = tn * 16 + 4 * (lane >> 4);
        f32x4 s = (f32x4){0.f, 0.f, 0.f, 0.f};
        if (tn <= tm) s = lds_mma(Qs, 136, Ks, 136, tm, tn, 128, lane, s);
        const float mxt = AAs[64 + t]; float pvv[4];
#pragma unroll
        for (int j = 0; j < 4; ++j) { const int l = l0 + j; pvv[j] = (l <= t) ? s[j] * __expf(AAs[l] - mxt) : 0.f; }
        u32x2 pw; pw.x = pk2(pvv[0], pvv[1]); pw.y = pk2(pvv[2], pvv[3]); *(LAS u32x2*)(Ps + t * 72 + l0) = pw; }
    { const int tn = w;
      for (int tm = 0; tm < 17; ++tm) { const f32x4 kv = lds_mma(VtE, 72, KwT, 72, tm, tn, 64, lane, (f32x4){0.f, 0.f, 0.f, 0.f}); const int e = tm * 16 + (lane & 15);
          if (e <= 256) st4_bf16_g(KVT + (size_t)e * 128 + tn * 16 + 4 * (lane >> 4), kv); } }
    __syncthreads();
    { const int tm = w >> 1, t = tm * 16 + (lane & 15);
      for (int tn = (w & 1); tn < 17; tn += 2) { const f32x4 nv = lds_mma(Ps, 72, VtE, 72, tm, tn, 64, lane, (f32x4){0.f, 0.f, 0.f, 0.f}); st4_bf16_g(NUMI + (size_t)t * MLE + tn * 16 + 4 * (lane >> 4), nv); } }
    if (side_cvt) moe_pair_store(mt, cvv, lane);
}
__device__ __forceinline__ void ml_state_scan(const Ctx& C, int first_block, int nblocks) {
    const float* MXg = ARP(float, A_MLM); bf16* KVT = ARP(bf16, A_MLKV);
    constexpr int NPAIR = 16 * 257 * 64;
    const int nthr = nblocks * NTHR, g0 = (C.bid - first_block) * NTHR + C.tid;
    unsigned eoff[3], moff[3]; f32x2 cst[3]; float mprev[3]; bool ev[3];
#pragma unroll
    for (int k = 0; k < 3; ++k) { const int pi = g0 + k * nthr; ev[k] = pi < NPAIR; const int bh4 = ev[k] ? pi / (257 * 64) : 0, r = ev[k] ? pi - bh4 * (257 * 64) : 0;
        eoff[k] = (unsigned)(bh4 * 64 * MLE * 128 + 2 * r); moff[k] = (unsigned)(bh4 * SEQ); cst[k] = (f32x2){0.f, 0.f}; mprev[k] = 0.f; }
    for (int c0 = 0; c0 < 64; c0 += 8) {
        unsigned kvw[3][8]; float mn[3][8];
#pragma unroll
        for (int k = 0; k < 3; ++k)
#pragma unroll
            for (int j = 0; j < 8; ++j) { kvw[k][j] = 0u; mn[k][j] = 0.f; if (ev[k]) { kvw[k][j] = *(const unsigned*)(KVT + eoff[k] + (unsigned)(c0 + j) * (MLE * 128)); mn[k][j] = MXg[moff[k] + (c0 + j) * 64 + 63]; } }
#pragma unroll
        for (int j = 0; j < 8; ++j)
#pragma unroll
            for (int k = 0; k < 3; ++k) if (ev[k]) { *(unsigned*)(KVT + eoff[k] + (unsigned)(c0 + j) * (MLE * 128)) = pk2(cst[k].x, cst[k].y);
                const float dc = __expf(mprev[k] - mn[k][j]); cst[k].x = dc * cst[k].x + lo_bf(kvw[k][j]); cst[k].y = dc * cst[k].y + hi_bf(kvw[k][j]); mprev[k] = mn[k][j]; } }
}
__device__ __forceinline__ void ml_out_unit(const Ctx& C, int unit, bool side_cvt) {
    int tid = C.tid; asm volatile("" : "+v"(tid));
    const int bh4 = unit >> 6, c = unit & 63, b = bh4 >> 2, h = bh4 & 3, w = C.wave, lane = tid & 63, t0 = c * 64;
    LAS bf16* Qs = (LAS bf16*)C.lds;
    LAS bf16* CTs = Qs + 64 * 136;
    const bf16 *QM = ARP(bf16, A_QM), *PAB = ARP(bf16, A_PAB), *NUMI = ARP(bf16, A_MLNUM) + (size_t)unit * 64 * MLE, *KVT = ARP(bf16, A_MLKV) + (size_t)unit * MLE * 128; bf16* YCAT = ARP(bf16, A_YCAT);
    const float *IG = ARP(float, A_IG) + (size_t)bh4 * SEQ + t0, *AAg = ARP(float, A_MLA) + (size_t)bh4 * SEQ + t0, *MXg = ARP(float, A_MLM) + (size_t)bh4 * SEQ + t0;
    const size_t tok0 = (size_t)b * SEQ + t0;
    u32x4 rq[2], rc[9];
#pragma unroll
    for (int k = 0; k < 2; ++k) { const int idx = tid + 512 * k, r = idx >> 4, c8 = (idx & 15) * 8; rq[k] = *(const u32x4*)(QM + (tok0 + r) * 512 + h * 128 + c8); }
#pragma unroll
    for (int k = 0; k < 9; ++k) { const int idx = tid + 512 * k, e = idx >> 4, c8 = (idx & 15) * 8; rc[k] = (u32x4){0u, 0u, 0u, 0u}; if (e <= 256) rc[k] = *(const u32x4*)(KVT + (size_t)e * 128 + c8); }
    const float Mc = c ? MXg[-1] : 0.f;
    f32x4 cvv[2][8]; MoeTile mt = moe_tile_decode(C, MOE_CVT_BASE_G + (unit * 8 + w) * 2); if (side_cvt) moe_pair_load(mt, cvv, lane);
    __syncthreads();
#pragma unroll
    for (int k = 0; k < 2; ++k) { const int idx = tid + 512 * k, r = idx >> 4, c8 = (idx & 15) * 8; *(LAS u32x4*)(Qs + r * 136 + c8) = rq[k]; }
#pragma unroll
    for (int k = 0; k < 9; ++k) { const int idx = tid + 512 * k, e = idx >> 4, c8 = (idx & 15) * 8; if (e < MLE) *(LAS u32x4*)(CTs + e * 136 + c8) = rc[k]; }
    __syncthreads();
    const int tm = w >> 1, t = tm * 16 + (lane & 15), cq = 4 * (lane >> 4); const size_t tt = tok0 + t; const float scale = 0.08838834764831845f;
    const float wst = __expf(Mc - MXg[t]), mrow = IG[t] - AAg[t] + MXg[t];
    float inv;
    { const f32x4 a2 = lds_mma(Qs, 136, CTs, 136, tm, 16, 128, lane, (f32x4){0.f, 0.f, 0.f, 0.f}); const float di = bf2f(NUMI[(size_t)t * MLE + 256]);
      float den = (lane < 16) ? (di + a2[0] * wst) * scale : 0.f; den += xor16f(den); den += xor32f(den);
      inv = 1.f / fmaxf(fabsf(den), __expf(-mrow)); }
    for (int tn = (w & 1); tn < 16; tn += 2) { const f32x4 a2 = lds_mma(Qs, 136, CTs, 136, tm, tn, 128, lane, (f32x4){0.f, 0.f, 0.f, 0.f});
        const u32x2 ni = *(const u32x2*)(NUMI + (size_t)t * MLE + tn * 16 + cq); const u32x2 og = *(const u32x2*)(PAB + tt * AB_PAD + 2048 + h * 256 + tn * 16 + cq);
        const float n0 = (lo_bf(ni.x) + a2[0] * wst) * scale * inv, n1 = (hi_bf(ni.x) + a2[1] * wst) * scale * inv, n2 = (lo_bf(ni.y) + a2[2] * wst) * scale * inv, n3 = (hi_bf(ni.y) + a2[3] * wst) * scale * inv;
        u32x2 o; o.x = pk2(sigmoidf_(lo_bf(og.x)) * n0, sigmoidf_(hi_bf(og.x)) * n1); o.y = pk2(sigmoidf_(lo_bf(og.y)) * n2, sigmoidf_(hi_bf(og.y)) * n3);
        st8_f(YCAT + tt * DM + h * 256 + tn * 16 + cq, o); }
    if (side_cvt) moe_pair_store(mt, cvv, lane);
}

__device__ __forceinline__ void mlstm_unit(const Ctx& C, const Args& A, int unit) {
    const int bh = unit >> 3, dvs = unit & 7, b = bh >> 2, h = bh & 3, w = C.wave, lane = C.lane, tid = C.tid;
    LAS float* AA = (LAS float*)C.lds;
    LAS float* MX = AA + 4096;
    LAS bf16* Qs = (LAS bf16*)(MX + 4096);
    LAS bf16* Ks = Qs + 64 * 136;
    LAS bf16* KwT = Ks + 64 * 136;
    LAS bf16* Vt = KwT + 128 * 72;
    LAS bf16* Ps = Vt + 48 * 72;
    LAS bf16* CT = Ps + 64 * 72;
    LAS float* NUM = (LAS float*)(CT + 48 * 136);
    const float *IG = ARP(float, A_IG) + (size_t)bh * SEQ, *LFp = ARP(float, A_LF) + (size_t)bh * SEQ;
    const bf16 *QM = ARP(bf16, A_QM), *KM = ARP(bf16, A_KM), *PAB = ARP(bf16, A_PAB); bf16* YCAT = ARP(bf16, A_YCAT);
    __syncthreads();
    if (w == 0) { float carryF = 0.f, carryM = 0.f;
        for (int c = 0; c < 64; ++c) { const int p = c * 64 + lane; float f = LFp[p];
#pragma unroll
            for (int o = 1; o < 64; o <<= 1) { const float n = __shfl_up(f, o); if (lane >= o) f += n; }
            f += carryF; const float a = IG[p] - f; float m = a;
#pragma unroll
            for (int o = 1; o < 64; o <<= 1) { const float n = __shfl_up(m, o); if (lane >= o) m = fmaxf(m, n); }
            m = fmaxf(m, carryM); AA[p] = a; MX[p] = m; carryF = __shfl(f, 63); carryM = __shfl(m, 63); } }
    for (int i = tid; i < 48 * 72; i += NTHR) { const int r = i / 72; Vt[i] = (r == 32) ? (bf16)0x3f80 : (bf16)0; }
    for (int i = tid; i < 48 * 136; i += NTHR) CT[i] = 0;
    f32x4 accC[3];
#pragma unroll
    for (int k = 0; k < 3; ++k) accC[k] = (f32x4){0.f, 0.f, 0.f, 0.f};
    const size_t tok0 = (size_t)b * SEQ;
    u32x4 rq[2], rk[2], rv;
#define ML_LOAD(c) do { _Pragma("unroll") for (int k = 0; k < 2; ++k) { const int idx = tid + 512 * k, r = idx >> 4, c8 = (idx & 15) * 8; const size_t o = (tok0 + (c) * 64 + r) * 512 + h * 128 + c8; \
            rq[k] = *(const u32x4*)(QM + o); rk[k] = *(const u32x4*)(KM + o); } \
        if (tid < 256) rv = *(const u32x4*)(PAB + (tok0 + (c) * 64 + (tid >> 2)) * AB_PAD + 1024 + h * 256 + dvs * 32 + (tid & 3) * 8); } while (0)
    ML_LOAD(0);
    __syncthreads();
    const float scale = 0.08838834764831845f;
    for (int c = 0; c < 64; ++c) {
        const int t0 = c * 64; const float Mc = c ? MX[t0 - 1] : 0.f, Mc2 = MX[t0 + 63];
#pragma unroll
        for (int k = 0; k < 2; ++k) { const int idx = tid + 512 * k, r = idx >> 4, c8 = (idx & 15) * 8;
            *(LAS u32x4*)(Qs + r * 136 + c8) = rq[k]; *(LAS u32x4*)(Ks + r * 136 + c8) = rk[k];
            float kf[8]; unpack8(rk[k], kf); const float wk = __expf(AA[t0 + r] - Mc2);
#pragma unroll
            for (int j = 0; j < 8; ++j) KwT[(c8 + j) * 72 + r] = (bf16)f2bf(kf[j] * wk); }
        if (tid < 256) { const int r = tid >> 2, e8 = (tid & 3) * 8; const unsigned wv[4] = {rv.x, rv.y, rv.z, rv.w};
#pragma unroll
            for (int j = 0; j < 4; ++j) { Vt[(e8 + 2 * j) * 72 + r] = (bf16)(wv[j] & 0xffff); Vt[(e8 + 2 * j + 1) * 72 + r] = (bf16)(wv[j] >> 16); } }
        if (c + 1 < 64) ML_LOAD(c + 1);
        __syncthreads();
#pragma unroll
        for (int q = 0; q < 2; ++q) { const int tile = 2 * w + q, tm = tile >> 2, tn = tile & 3; const int t = tm * 16 + (lane & 15), l0 = tn * 16 + 4 * (lane >> 4);
            f32x4 s = (f32x4){0.f, 0.f, 0.f, 0.f};
            if (tn <= tm) s = lds_mma(Qs, 136, Ks, 136, tm, tn, 128, lane, s);
            const float mxt = MX[t0 + t]; float pvv[4];
#pragma unroll
            for (int j = 0; j < 4; ++j) { const int l = l0 + j; pvv[j] = (l <= t) ? s[j] * __expf(AA[t0 + l] - mxt) : 0.f; }
            u32x2 pw; pw.x = pk2(pvv[0], pvv[1]); pw.y = pk2(pvv[2], pvv[3]); *(LAS u32x2*)(Ps + t * 72 + l0) = pw; }
        __syncthreads();
        for (int tile = w; tile < 12; tile += 8) { const int tm = tile / 3, tn = tile % 3; const int t = tm * 16 + (lane & 15);
            f32x4 a1 = lds_mma(Ps, 72, Vt, 72, tm, tn, 64, lane, (f32x4){0.f, 0.f, 0.f, 0.f});
            f32x4 a2 = lds_mma(Qs, 136, CT, 136, tm, tn, 128, lane, (f32x4){0.f, 0.f, 0.f, 0.f});
            const float wst = __expf(Mc - MX[t0 + t]);
            *(LAS f32x4*)(NUM + t * 48 + tn * 16 + 4 * (lane >> 4)) = (a1 + a2 * wst) * scale; }
        __syncthreads();
        { const int t = tid >> 3, e4 = (tid & 7) * 4; const size_t tt = tok0 + t0 + t;
          const float den = NUM[t * 48 + 32], mrow = IG[t0 + t] - AA[t0 + t] + MX[t0 + t];
          const float inv = 1.f / fmaxf(fabsf(den), __expf(-mrow));
          const f32x4 nv = *(const LAS f32x4*)(NUM + t * 48 + e4);
          const u32x2 og = *(const u32x2*)(PAB + tt * AB_PAD + 2048 + h * 256 + dvs * 32 + e4);
          u32x2 o; o.x = pk2(sigmoidf_(lo_bf(og.x)) * nv[0] * inv, sigmoidf_(hi_bf(og.x)) * nv[1] * inv); o.y = pk2(sigmoidf_(lo_bf(og.y)) * nv[2] * inv, sigmoidf_(hi_bf(og.y)) * nv[3] * inv);
          *(u32x2*)(YCAT + tt * DM + h * 256 + dvs * 32 + e4) = o; }
        { const float decay = __expf(Mc - Mc2);
#pragma unroll
          for (int tm = 0; tm < 3; ++tm) { accC[tm] = lds_mma(Vt, 72, KwT, 72, tm, w, 64, lane, accC[tm] * decay);
              u32x2 cw; cw.x = pk2(accC[tm][0], accC[tm][1]); cw.y = pk2(accC[tm][2], accC[tm][3]);
              *(LAS u32x2*)(CT + (tm * 16 + (lane & 15)) * 136 + w * 16 + 4 * (lane >> 4)) = cw; } }
        __syncthreads();
    }
#undef ML_LOAD
}

__device__ __forceinline__ void phase_rowstat(const Ctx& C) {
    const bf16* XR = WSP(bf16, WS_XR); float* RS = WSP(float, WS_TAB + TAB_RSTD);
    for (int r = C.gw; r < T; r += C.ngw) { const u32x4* xr = (const u32x4*)(XR + (size_t)r * DM); float s = 0.f;
#pragma unroll
        for (int j = 0; j < 4; ++j) { float f[8]; unpack8(xr[j * 64 + C.lane], f);
#pragma unroll
            for (int q = 0; q < 8; ++q) s += f[q] * f[q]; }
        s = wave_sum(s); if (C.lane == 0) RS[r] = rsqrtf(s * (1.f / DM) + EPS); }
}
__device__ __forceinline__ void phase_softmax256(const Ctx& C) {
    const float* SC = ARP(float, A_SC); bf16* PC = ARP(bf16, A_PC);
    for (int it = C.gw; it < T * 4; it += C.ngw) { const size_t o = (size_t)it * 256 + C.lane * 4;
        const f32x4 v = *(const f32x4*)(SC + o); const float m = wave_max(fmaxf(fmaxf(v.x, v.y), fmaxf(v.z, v.w)));
        const float e0 = __expf(v.x - m), e1 = __expf(v.y - m), e2 = __expf(v.z - m), e3 = __expf(v.w - m);
        const float inv = 1.f / wave_sum(e0 + e1 + e2 + e3);
        u32x2 w; w.x = pk2(e0 * inv, e1 * inv); w.y = pk2(e2 * inv, e3 * inv); *(u32x2*)(PC + o) = w; }
}
constexpr int MOE_NB = 256, MOE_TPB = T / MOE_NB;
__device__ __forceinline__ void phase_route(const Ctx& C, const Args& A, int l) {
    const float* LG = ARP(float, A_XS); constexpr size_t PL = (size_t)T * 256;     int* EID = ARP(int, A_EID); float* WTS = ARP(float, A_WTS); int* LRANK = ARP(int, A_LRANK); int* BH = ARP(int, A_BHIST);
    const float *bg = INP(I_MOE_BG) + l * 8, *be = INP(I_MOE_BE) + l * 64;
    LAS int* hist = (LAS int*)(C.lds + LDS_AUX);
    for (int bk = C.bid; bk < MOE_NB; bk += C.G) {
        __syncthreads();
        if (C.tid < 64) hist[C.tid] = 0;
        __syncthreads();
        if (C.tid < MOE_TPB) { const int t = bk * MOE_TPB + C.tid; const float* L = LG + (size_t)t * 256;
            float lg[8], mx = -INFINITY; int grp = 0;
#pragma unroll
            for (int g = 0; g < 8; ++g) { lg[g] = ((L[g] + L[PL + g]) + (L[2 * PL + g] + L[3 * PL + g])) + bg[g]; if (lg[g] > mx) { mx = lg[g]; grp = g; } }
            float se = 0.f;
#pragma unroll
            for (int g = 0; g < 8; ++g) se += __expf(lg[g] - mx);
            const float pgrp = 1.f / se;
            float l1 = -INFINITY, l2 = -INFINITY; int i1 = 0, i2 = 0;
            for (int j = 0; j < 8; ++j) { const int x = 8 + grp * 8 + j; const float v = ((L[x] + L[PL + x]) + (L[2 * PL + x] + L[3 * PL + x])) + be[grp * 8 + j];
                if (v > l1) { l2 = l1; i2 = i1; l1 = v; i1 = j; } else if (v > l2) { l2 = v; i2 = j; } }
            const float w1 = 1.f / (1.f + __expf(l2 - l1)), w2 = 1.f - w1;
            const int e1 = grp * 8 + i1, e2 = grp * 8 + i2;
            EID[2 * t] = e1; EID[2 * t + 1] = e2; WTS[2 * t] = pgrp * w1; WTS[2 * t + 1] = pgrp * w2;
            LRANK[2 * t] = atomicAdd((int*)(hist + e1), 1); LRANK[2 * t + 1] = atomicAdd((int*)(hist + e2), 1); }
        __syncthreads();
        if (C.tid < 64) BH[bk * 64 + C.tid] = hist[C.tid];
    }
}
__device__ __forceinline__ void phase_gather(const Ctx& C, int l) {
    LAS int* tab = (LAS int*)(C.lds + LDS_AUX);
    const int* BH = ARP(int, A_BHIST); const int* EID = ARP(int, A_EID); const int* LRANK = ARP(int, A_LRANK); int* ROWSLOT = ARP(int, A_ROWSLOT); const bf16* XNp = WSP(bf16, WS_XR); bf16* XS = ARP(bf16, A_XS);
    unsigned* cnt = WSP(unsigned, WS_CTL) + CW_MOE_CNT + l * 64;
    for (int bk = C.bid; bk < MOE_NB; bk += C.G) {
        __syncthreads();
        if (C.tid < 64) { int tot = 0, before = 0;
            for (int q = 0; q < MOE_NB; ++q) { const int v = BH[q * 64 + C.tid]; tot += v; if (q < bk) before += v; }
            tab[C.tid] = tot; tab[64 + C.tid] = before; if (bk == 0) cnt[C.tid] = (unsigned)tot; }
        __syncthreads();
        if (C.tid == 0) { int off = 0; for (int e = 0; e < 64; ++e) { const int n = tab[e]; tab[e] = off; off += ((n + 255) >> 8) << 8; } }
        __syncthreads();
        if (C.tid < 2 * MOE_TPB) { const int a = bk * 2 * MOE_TPB + C.tid, e = EID[a], pos = tab[e] + tab[64 + e] + LRANK[a]; tab[128 + C.tid] = pos; ROWSLOT[pos] = a; }
        __syncthreads();
    }
}
__device__ __forceinline__ void phase_combine_norm(const Ctx& C, const float* gain, float* OUT) {
    bf16* XR = WSP(bf16, WS_XR); const bf16* YE = ARP(bf16, A_YE); float* RS = WSP(float, WS_RSQ) + (size_t)4 * T * 8; const int lane = C.lane;
    for (int t = C.gw; t < T; t += C.ngw) { bf16* xr = XR + (size_t)t * DM; const bf16* y0 = YE + (size_t)(2 * t) * DM; const bf16* y1 = y0 + DM;
        float v[4][8]; float s = 0.f; u32x4 rx[4], ra[4], rb[4];
#pragma unroll
        for (int j = 0; j < 4; ++j) { const int o = (j * 64 + lane) * 8; rx[j] = *(const u32x4*)(xr + o); ra[j] = *(const u32x4*)(y0 + o); rb[j] = *(const u32x4*)(y1 + o); }
#pragma unroll
        for (int j = 0; j < 4; ++j) { const int o = (j * 64 + lane) * 8; float a[8], b0[8]; unpack8(rx[j], v[j]); unpack8(ra[j], a); unpack8(rb[j], b0);
#pragma unroll
            for (int q = 0; q < 8; ++q) v[j][q] += a[q] + b0[q];
            if (!OUT) { const u32x4 w = pack8f(v[j]); *(u32x4*)(xr + o) = w; unpack8(w, v[j]); }
#pragma unroll
            for (int q = 0; q < 8; ++q) s += v[j][q] * v[j][q]; }
        const float ssq = wave_sum(s), rstd = rstd_of(ssq);
        if (!OUT) { if (lane < 8) RS[(size_t)t * 8 + lane] = (lane == 0) ? ssq : 0.f; }
        else {
#pragma unroll
            for (int j = 0; j < 4; ++j) { const int o = (j * 64 + lane) * 8; const f32x4 g0 = *(const f32x4*)(gain + o), g1 = *(const f32x4*)(gain + o + 4);
                *(f32x4*)(OUT + (size_t)t * DM + o) = (f32x4){v[j][0] * rstd * g0.x, v[j][1] * rstd * g0.y, v[j][2] * rstd * g0.z, v[j][3] * rstd * g0.w};
                *(f32x4*)(OUT + (size_t)t * DM + o + 4) = (f32x4){v[j][4] * rstd * g1.x, v[j][5] * rstd * g1.y, v[j][6] * rstd * g1.z, v[j][7] * rstd * g1.w}; } }
    }
}

__device__ __forceinline__ float gelu_tanh(float x) { return 0.5f * x * (1.f + tanhf(0.7978845608028654f * (x + 0.044715f * x * x * x))); }
__device__ __forceinline__ void phase_cmp_finish(const Ctx& C, const Args& A) {
    const float* CP = ARP(float, A_CPART); const float* bias = WSP(float, WS_TAB + TAB_CMPBIAS); const float* w2 = INP(I_CMP_W2);
    LAS float* hid = (LAS float*)C.lds + C.wave * 128; const int lane = C.lane;
    for (int it = C.gw; it < 2 * 16 * 256; it += C.ngw) { const int j = it & 255, bg = (it >> 8) & 15, kv = it >> 12;
        bf16* dst = ARP(bf16, kv ? A_VCMP : A_KCMP) + ((size_t)bg * 256 + j) * 128;
        bf16* dstT = ARP(bf16, A_VCT) + (size_t)bg * 128 * 256 + j;
        if (j == 255) { dst[lane] = 0; dst[lane + 64] = 0; if (kv) { dstT[(size_t)lane * 256] = 0; dstT[(size_t)(lane + 64) * 256] = 0; } continue; }
        float h0 = bias[kv * 128 + lane], h1 = bias[kv * 128 + 64 + lane];
#pragma unroll
        for (int ks = 0; ks < 8; ++ks) { const float* p = CP + ((size_t)((ks * 2 + kv) * 16 + bg) * 256 + j) * 256; h0 += p[lane]; h1 += p[64 + lane]; }
        hid[lane] = gelu_tanh(h0); hid[64 + lane] = gelu_tanh(h1); LDS_WAIT(); asm volatile("" ::: "memory");
        float o0 = 0.f, o1 = 0.f; const float* W = w2 + (size_t)kv * 128 * 128;
        for (int e = 0; e < 128; ++e) { const float hv = hid[e]; o0 += hv * W[e * 128 + lane]; o1 += hv * W[e * 128 + 64 + lane]; }
        dst[lane] = (bf16)f2bf(o0); dst[lane + 64] = (bf16)f2bf(o1); if (kv) { dstT[(size_t)lane * 256] = (bf16)f2bf(o0); dstT[(size_t)(lane + 64) * 256] = (bf16)f2bf(o1); } LDS_WAIT(); asm volatile("" ::: "memory"); }
}
__device__ __forceinline__ void phase_cmp_attn(const Ctx& C) {
    const bf16 *Q = ARP(bf16, A_Q), *KC = ARP(bf16, A_KCMP), *VC = ARP(bf16, A_VCMP); const float* GATES = ARP(float, A_GATES);
    float* OACC = ARP(float, A_OACC); unsigned long long* SELM = ARP(unsigned long long, A_SELMASK);
    LAS float* qs = (LAS float*)C.lds + C.wave * 1536;
    LAS float* ps = qs + 512; const int lane = C.lane; const float scale = 0.08838834764831845f;
    for (int it = C.gw; it < T * 4; it += C.ngw) { const int t = it >> 2, g = it & 3, b = t >> 12, s = t & 4095;
        const int nvalid = (s >= 31) ? ((s - 31) >> 4) + 1 : 0;
#pragma unroll
        for (int r = 0; r < 4; ++r) { const bf16* qp = Q + (((size_t)(b * 16 + g * 4 + r)) * SEQ + s) * 128; qs[r * 128 + lane] = bf2f(qp[lane]); qs[r * 128 + 64 + lane] = bf2f(qp[64 + lane]); }
        LDS_WAIT(); asm volatile("" ::: "memory");
        float sc[4][4];
#pragma unroll
        for (int i = 0; i < 4; ++i) { const int j = lane + 64 * i;
#pragma unroll
            for (int r = 0; r < 4; ++r) sc[r][i] = 0.f;
            if (j < nvalid) { const bf16* kp = KC + ((size_t)(b * 4 + g) * 256 + j) * 128;
                for (int d8 = 0; d8 < 16; ++d8) { float kf[8]; unpack8(*(const u32x4*)(kp + d8 * 8), kf);
#pragma unroll
                    for (int r = 0; r < 4; ++r) { float a = 0.f;
#pragma unroll
                        for (int jj = 0; jj < 8; ++jj) a += qs[r * 128 + d8 * 8 + jj] * kf[jj];
                        sc[r][i] += a; } } } }
#pragma unroll
        for (int r = 0; r < 4; ++r) { float m = -INFINITY;
#pragma unroll
            for (int i = 0; i < 4; ++i) if (lane + 64 * i < nvalid) m = fmaxf(m, sc[r][i] * scale);
            m = wave_max(m); if (!(m > -INFINITY)) m = 0.f; float e[4], sum = 0.f;
#pragma unroll
            for (int i = 0; i < 4; ++i) { e[i] = (lane + 64 * i < nvalid) ? __expf(sc[r][i] * scale - m) : 0.f; sum += e[i]; }
            sum = wave_sum(sum); const float inv = sum > 0.f ? 1.f / sum : 1.f;
#pragma unroll
            for (int i = 0; i < 4; ++i) ps[r * 256 + lane + 64 * i] = e[i] * inv; }
        LDS_WAIT(); asm volatile("" ::: "memory");
        float o[4][2];
#pragma unroll
        for (int r = 0; r < 4; ++r) { o[r][0] = 0.f; o[r][1] = 0.f; }
        for (int j = 0; j < nvalid; ++j) { const bf16* vp = VC + ((size_t)(b * 4 + g) * 256 + j) * 128; const float v0 = bf2f(vp[lane]), v1 = bf2f(vp[64 + lane]);
#pragma unroll
            for (int r = 0; r < 4; ++r) { const float p = ps[r * 256 + j]; o[r][0] += p * v0; o[r][1] += p * v1; } }
#pragma unroll
        for (int r = 0; r < 4; ++r) { const float gt = GATES[(size_t)t * 48 + g * 4 + r]; float* op = OACC + (size_t)t * DM + (g * 4 + r) * 128; op[lane] = gt * o[r][0]; op[64 + lane] = gt * o[r][1]; }
        float imp = 0.f;
#pragma unroll
        for (int r = 0; r < 4; ++r) { const LAS float* p = ps + r * 256; const int j0 = 4 * lane;
            imp += (j0 > 0 ? 0.5f * p[j0 - 1] : 0.f) + p[j0] + p[j0 + 1] + p[j0 + 2] + 0.5f * p[j0 + 3]; }
        const int cur = s >> 6; float score;
        if (lane == 0 || lane == cur || lane == cur - 1) score = INFINITY; else score = (lane <= cur) ? imp : -INFINITY;
        int rank = 0;
        for (int o2 = 0; o2 < 64; ++o2) { const float so = __int_as_float(__builtin_amdgcn_readlane(__float_as_int(score), o2)); rank += (so > score || (so == score && o2 < lane)) ? 1 : 0; }
        const unsigned long long m = __ballot(rank < 16 && score > -INFINITY);
        if (lane == 0) SELM[(size_t)t * 4 + g] = m;
        LDS_WAIT(); asm volatile("" ::: "memory");
    }
}
struct NaiveAttnState { float m[4], l[4], o[4][2]; };
__device__ __forceinline__ void naive_tile(NaiveAttnState& S, const LAS float* qs, LAS float* pt, const bf16* Kt, const bf16* Vt_, int key0, bool valid, int lane) {
    float sc[4] = {0.f, 0.f, 0.f, 0.f}; const float scale = 0.08838834764831845f;
    if (valid) { const bf16* kp = Kt + (size_t)(key0 + lane) * 128;
        for (int d8 = 0; d8 < 16; ++d8) { float kf[8]; unpack8(*(const u32x4*)(kp + d8 * 8), kf);
#pragma unroll
            for (int r = 0; r < 4; ++r) { float a = 0.f;
#pragma unroll
                for (int jj = 0; jj < 8; ++jj) a += qs[r * 128 + d8 * 8 + jj] * kf[jj];
                sc[r] += a; } } }
    const unsigned long long vm = __ballot(valid);
    if (vm == 0ull) return;
#pragma unroll
    for (int r = 0; r < 4; ++r) { const float sv = valid ? sc[r] * scale : -INFINITY; const float mt = wave_max(sv), mn = fmaxf(S.m[r], mt);
        const float alpha = __expf(S.m[r] - mn), p = valid ? __expf(sv - mn) : 0.f;
        S.l[r] = S.l[r] * alpha + wave_sum(p); S.o[r][0] *= alpha; S.o[r][1] *= alpha; S.m[r] = mn; pt[r * 64 + lane] = p; }
    LDS_WAIT(); asm volatile("" ::: "memory");
    for (int k = 0; k < 64; ++k) { if (!((vm >> k) & 1ull)) continue; const bf16* vp = Vt_ + (size_t)(key0 + k) * 128; const float v0 = bf2f(vp[lane]), v1 = bf2f(vp[64 + lane]);
#pragma unroll
        for (int r = 0; r < 4; ++r) { const float p = pt[r * 64 + k]; S.o[r][0] += p * v0; S.o[r][1] += p * v1; } }
    LDS_WAIT(); asm volatile("" ::: "memory");
}
__device__ __forceinline__ void phase_selwin_naive(const Ctx& C, bf16* OCAT) {
    const bf16* QR = ARP(bf16, A_QROT); const float* GATES = ARP(float, A_GATES); const float* OACC = ARP(float, A_OACC);
    const unsigned long long* SELM = ARP(const unsigned long long, A_SELMASK);
    const bf16* KS = (const bf16*)(C.ws + WS_ARENA + A_KV6 + 2 * KV6_STRIDE); const bf16* VS = (const bf16*)(C.ws + WS_ARENA + A_KV6 + 3 * KV6_STRIDE);
    const bf16* KW = (const bf16*)(C.ws + WS_ARENA + A_KV6 + 4 * KV6_STRIDE); const bf16* VW = (const bf16*)(C.ws + WS_ARENA + A_KV6 + 5 * KV6_STRIDE);
    LAS float* qs = (LAS float*)C.lds + C.wave * 768; LAS float* pt = qs + 512; const int lane = C.lane;
    for (int it = C.gw; it < T * 4; it += C.ngw) { const int t = it >> 2, g = it & 3, b = t >> 12, s = t & 4095; const size_t slab = (size_t)(b * 4 + g) * SPAD * 128;
#pragma unroll
        for (int r = 0; r < 4; ++r) { const bf16* qp = QR + (((size_t)(b * 16 + g * 4 + r)) * SEQ + s) * 128; qs[r * 128 + lane] = bf2f(qp[lane]); qs[r * 128 + 64 + lane] = bf2f(qp[64 + lane]); }
        LDS_WAIT(); asm volatile("" ::: "memory");
        float res[4][2];
#pragma unroll
        for (int r = 0; r < 4; ++r) { res[r][0] = OACC[(size_t)t * DM + (g * 4 + r) * 128 + lane]; res[r][1] = OACC[(size_t)t * DM + (g * 4 + r) * 128 + 64 + lane]; }
        { NaiveAttnState S;
#pragma unroll
          for (int r = 0; r < 4; ++r) { S.m[r] = -1e30f; S.l[r] = 0.f; S.o[r][0] = 0.f; S.o[r][1] = 0.f; }
          const unsigned long long m = SELM[(size_t)t * 4 + g];
          for (int blk = 0; blk <= (s >> 6); ++blk) if ((m >> blk) & 1ull) naive_tile(S, qs, pt, KS + slab, VS + slab, blk * 64, blk * 64 + lane <= s, lane);
#pragma unroll
          for (int r = 0; r < 4; ++r) { const float gt = GATES[(size_t)t * 48 + 16 + g * 4 + r], inv = S.l[r] > 0.f ? 1.f / S.l[r] : 0.f; res[r][0] += gt * S.o[r][0] * inv; res[r][1] += gt * S.o[r][1] * inv; } }
        { NaiveAttnState S;
#pragma unroll
          for (int r = 0; r < 4; ++r) { S.m[r] = -1e30f; S.l[r] = 0.f; S.o[r][0] = 0.f; S.o[r][1] = 0.f; }
          const int lo = s - 511 > 0 ? s - 511 : 0;
          for (int k0 = lo & ~63; k0 <= s; k0 += 64) naive_tile(S, qs, pt, KW + slab, VW + slab, k0, (k0 + lane >= lo) && (k0 + lane <= s), lane);
#pragma unroll
          for (int r = 0; r < 4; ++r) { const float gt = GATES[(size_t)t * 48 + 32 + g * 4 + r], inv = S.l[r] > 0.f ? 1.f / S.l[r] : 0.f; res[r][0] += gt * S.o[r][0] * inv; res[r][1] += gt * S.o[r][1] * inv; } }
#pragma unroll
        for (int r = 0; r < 4; ++r) { bf16* op = OCAT + (size_t)t * DM + (g * 4 + r) * 128; op[lane] = (bf16)f2bf(res[r][0]); op[64 + lane] = (bf16)f2bf(res[r][1]); }
    }
}


__device__ __forceinline__ void phase_cmp_attn_mma(const Ctx& C, bool side_cvt) {
    const bf16 *Q = ARP(bf16, A_Q), *KC = ARP(bf16, A_KCMP), *VCT = ARP(bf16, A_VCT); const float* GATES = ARP(float, A_GATES);
    float* OACC = ARP(float, A_OACC); unsigned long long* SELM = ARP(unsigned long long, A_SELMASK);
    LAS bf16* Qs = (LAS bf16*)C.lds;
    LAS bf16* Ks = Qs + 128 * 136;
    LAS bf16* Pm = (LAS bf16*)C.lds;
    LAS bf16* Vt = Pm + 128 * 264;
    const int w = C.wave; const float scale = 0.08838834764831845f;
    for (int it = C.bid; it < 2048; it += C.G) { int tid = C.tid; asm volatile("" : "+v"(tid)); const int lane = tid & 63;     const int bg = it >> 7, tt = ((it / C.G) & 1) ? 127 - (it & 127) : (it & 127), b = bg >> 2, g = bg & 3, t0 = tt * 32;
        const int nv = t0 / 16 + 1 > 255 ? 255 : ((t0 + 31 >= 31) ? t0 / 16 + 1 : 0);
        const int nct = (nv + 15) >> 4, kmax = ((nv + 31) >> 5) << 5;
        f32x4 cvv[2][8]; MoeTile mt = moe_tile_decode(C, MOE_CVT_BASE_E + (it * 8 + w) * 2); if (side_cvt) moe_pair_load(mt, cvv, lane);
        __syncthreads();
#pragma unroll
        for (int k = 0; k < 4; ++k) { const int idx = tid + 512 * k, row = idx >> 4, c8 = (idx & 15) * 8, r = row >> 5, tl = row & 31;
            *(LAS u32x4*)(Qs + row * 136 + c8) = *(const u32x4*)(Q + (((size_t)(b * 16 + g * 4 + r)) * SEQ + t0 + tl) * 128 + c8); }
        { u32x4 tk[8];
#pragma unroll
          for (int k = 0; k < 8; ++k) { const int idx = tid + 512 * k, row = idx >> 4, c8 = (idx & 15) * 8; tk[k] = (u32x4){0u, 0u, 0u, 0u};
              if (row < nct * 16) tk[k] = *(const u32x4*)(KC + ((size_t)bg * 256 + row) * 128 + c8); }
#pragma unroll
          for (int k = 0; k < 8; ++k) { const int idx = tid + 512 * k, row = idx >> 4, c8 = (idx & 15) * 8; *(LAS u32x4*)(Ks + row * 136 + c8) = tk[k]; } }
        __syncthreads();
        f32x4 sacc[16];
        { bf16x8 qa[4];
#pragma unroll
          for (int k = 0; k < 4; ++k) qa[k] = *(const LAS bf16x8*)(Qs + (w * 16 + (lane & 15)) * 136 + (lane >> 4) * 8 + 32 * k);
#pragma unroll
          for (int ct = 0; ct < 16; ++ct) { sacc[ct] = (f32x4){0.f, 0.f, 0.f, 0.f};
              if (ct < nct) { const LAS bf16* bp = Ks + (ct * 16 + (lane & 15)) * 136 + (lane >> 4) * 8;
#pragma unroll
                  for (int k = 0; k < 4; ++k) sacc[ct] = __builtin_amdgcn_mfma_f32_16x16x32_bf16(*(const LAS bf16x8*)(bp + 32 * k), qa[k], sacc[ct], 0, 0, 0); } } }
        const int trow = t0 + (w & 1) * 16 + (lane & 15);
        const int nvr = (trow >= 31) ? ((trow - 31) >> 4) + 1 : 0;
        float m = -INFINITY;
#pragma unroll
        for (int ct = 0; ct < 16; ++ct)
#pragma unroll
            for (int j = 0; j < 4; ++j) { const int key = ct * 16 + 4 * (lane >> 4) + j; const float v = (key < nvr) ? sacc[ct][j] * scale : -INFINITY; sacc[ct][j] = v; m = fmaxf(m, v); }
        m = fmaxf(m, xor16f(m)); m = fmaxf(m, xor32f(m)); if (!(m > -INFINITY)) m = 0.f;
        float sum = 0.f;
#pragma unroll
        for (int ct = 0; ct < 16; ++ct)
#pragma unroll
            for (int j = 0; j < 4; ++j) { const float e = __expf(sacc[ct][j] - m); sacc[ct][j] = e; sum += e; }
        sum += xor16f(sum); sum += xor32f(sum);
        const float inv = sum > 0.f ? 1.f / sum : 1.f;
        __syncthreads();
#pragma unroll
        for (int ct = 0; ct < 16; ++ct) if (ct * 16 < kmax) { u32x2 pw; pw.x = pk2(sacc[ct][0] * inv, sacc[ct][1] * inv); pw.y = pk2(sacc[ct][2] * inv, sacc[ct][3] * inv);
            *(LAS u32x2*)(Pm + (w * 16 + (lane & 15)) * 264 + ct * 16 + 4 * (lane >> 4)) = pw; }
        { u32x4 tv[8];
#pragma unroll
          for (int k = 0; k < 8; ++k) { const int idx = tid + 512 * k, d = idx >> 5, j8 = (idx & 31) * 8; tv[k] = (u32x4){0u, 0u, 0u, 0u};
              if (j8 < kmax) tv[k] = *(const u32x4*)(VCT + ((size_t)bg * 128 + d) * 256 + j8); }
#pragma unroll
          for (int k = 0; k < 8; ++k) { const int idx = tid + 512 * k, d = idx >> 5, j8 = (idx & 31) * 8; *(LAS u32x4*)(Vt + d * 264 + j8) = tv[k]; } }
        __syncthreads();
        { const int r = w >> 1, tl = (w & 1) * 16 + (lane & 15), t = b * SEQ + t0 + tl, hh = g * 4 + r; const float gt = GATES[(size_t)t * 48 + hh];
          float* op = OACC + (size_t)t * DM + hh * 128 + 4 * (lane >> 4);
          bf16x8 pa[8];
#pragma unroll
          for (int k = 0; k < 8; ++k) { pa[k] = (bf16x8){0, 0, 0, 0, 0, 0, 0, 0}; if (k * 32 < kmax) pa[k] = *(const LAS bf16x8*)(Pm + (w * 16 + (lane & 15)) * 264 + (lane >> 4) * 8 + 32 * k); }
#pragma unroll
          for (int dt = 0; dt < 8; ++dt) { f32x4 o = (f32x4){0.f, 0.f, 0.f, 0.f}; const LAS bf16* bp = Vt + (dt * 16 + (lane & 15)) * 264 + (lane >> 4) * 8;
#pragma unroll
              for (int k = 0; k < 8; ++k) if (k * 32 < kmax) o = __builtin_amdgcn_mfma_f32_16x16x32_bf16(*(const LAS bf16x8*)(bp + 32 * k), pa[k], o, 0, 0, 0);
              *(f32x4*)(op + dt * 16) = o * gt; } }
        { float score[4]; const int cur = (t0 + w * 4) >> 6;
#pragma unroll
          for (int q = 0; q < 4; ++q) { const int tl = w * 4 + q; float imp = 0.f;
            if (kmax > 0) {
#pragma unroll
                for (int r = 0; r < 4; ++r) { const LAS bf16* p = Pm + (r * 32 + tl) * 264; const int j0 = 4 * lane;
                    if (j0 < kmax) { const u32x2 pw = *(const LAS u32x2*)(p + j0); imp += lo_bf(pw.x) + hi_bf(pw.x) + lo_bf(pw.y) + 0.5f * hi_bf(pw.y); if (j0 > 0) imp += 0.5f * bf2f(p[j0 - 1]); } } }
            if (lane == 0 || lane == cur || lane == cur - 1) score[q] = INFINITY; else score[q] = (lane <= cur) ? imp : -INFINITY; }
          int rank[4] = {0, 0, 0, 0};
          for (int o2 = 0; o2 <= cur; ++o2) {
#pragma unroll
              for (int q = 0; q < 4; ++q) { const float so = __int_as_float(__builtin_amdgcn_readlane(__float_as_int(score[q]), o2)); rank[q] += (so > score[q] || (so == score[q] && o2 < lane)) ? 1 : 0; } }
#pragma unroll
          for (int q = 0; q < 4; ++q) { const unsigned long long mk = __ballot(rank[q] < 16 && score[q] > -INFINITY);
              if (lane == 0) SELM[(size_t)(b * SEQ + t0 + w * 4 + q) * 4 + g] = mk; } }
        if (side_cvt) moe_pair_store(mt, cvv, lane);
    }
    __syncthreads();
}

namespace swa {
constexpr int D = 128, NW = 8, QBLK = 32, KVBLK = 64, QB = NW * QBLK;
constexpr int SHM_V = KVBLK * D * 2, SHM_K = KVBLK * D * 2;
constexpr int LDS_BYTES = 2 * SHM_V + 2 * SHM_K + NW * 64 * 4;
constexpr float SCALE = 0.08838834764831845f, THR = 8.f;
typedef short s16x4 __attribute__((ext_vector_type(4)));
typedef float f32x16 __attribute__((ext_vector_type(16)));
#define KSWZ(row, colB) ((row) * 256 + ((colB) ^ (((row) & 7) << 4)))
#define SBAR() __builtin_amdgcn_sched_barrier(0)
__device__ __forceinline__ int v_st(int k, int c) { const int kk = (k & ~0xC) | ((k & 4) << 1) | ((k & 8) >> 1); return ((kk >> 3) * 4 + (c >> 5)) * 512 + ((kk & 7) * 32 + (c & 31)) * 2; }
__device__ __forceinline__ int v_rd_base(int lane) { return ((lane & 3) << 3) | (((lane >> 2) & 3) << 6) | (((lane >> 4) & 1) << 5) | (((lane >> 5) & 1) << 8); }
constexpr int v_rd_off(int d0, int ks, int half) { return d0 * 512 + ks * 4096 + half * 2048; }
__device__ __forceinline__ int crow(int r, int hi) { return (r & 3) + 8 * (r >> 2) + 4 * hi; }
__device__ __forceinline__ unsigned cvtpk(float lo, float hi) { unsigned r; asm volatile("v_cvt_pk_bf16_f32 %0, %1, %2" : "=v"(r) : "v"(lo), "v"(hi)); return r; }
__device__ __forceinline__ bf16x8 load8(const bf16* p) { return *reinterpret_cast<const bf16x8*>(p); }
__device__ __forceinline__ void mask_tile(f32x16& p0, f32x16& p1, int dq, unsigned W) {
    const float NEG = -__builtin_inff();
    asm volatile("" : "+v"(dq));
#pragma unroll
    for (int r = 0; r < 16; ++r) { const int c = (r & 3) + 8 * (r >> 2);
        if ((unsigned)(dq - c) >= W) p0[r] = NEG;
        if ((unsigned)(dq - c - 32) >= W) p1[r] = NEG; }
}
__device__ __forceinline__ void mask_all(f32x16& p0, f32x16& p1, bool on) {
    const float NEG = -__builtin_inff();
#pragma unroll
    for (int r = 0; r < 16; ++r) { p0[r] = on ? p0[r] : NEG; p1[r] = on ? p1[r] : NEG; }
}
__device__ __forceinline__ void partialSM(f32x16& p0, f32x16& p1, float& m_reg, float& mn, float& alpha) {
    float pmax = p0[0]; for (int r = 1; r < 16; ++r) pmax = fmaxf(pmax, p0[r]); for (int r = 0; r < 16; ++r) pmax = fmaxf(pmax, p1[r]);
    { auto rr = __builtin_amdgcn_permlane32_swap(__float_as_uint(pmax), __float_as_uint(pmax), false, false);
      pmax = fmaxf(__uint_as_float(rr[0]), __uint_as_float(rr[1])); }
    constexpr float C2 = 1.4426950408889634f * SCALE;
    if (__builtin_expect(__all((pmax - m_reg) * SCALE <= THR), 1)) { mn = m_reg; alpha = 1.f; }
    else { mn = fmaxf(m_reg, pmax); alpha = __builtin_amdgcn_exp2f((m_reg - mn) * C2); m_reg = mn; }
    const float mnL = -mn * C2;
    for (int r = 0; r < 16; ++r) p0[r] = fmaf(p0[r], C2, mnL); for (int r = 0; r < 16; ++r) p1[r] = fmaf(p1[r], C2, mnL);
    for (int r = 0; r < 16; ++r) p0[r] = __builtin_amdgcn_exp2f(p0[r]);
}
__device__ __forceinline__ void finishSM(f32x16& p0, f32x16& p1, float alpha, float& l_reg, bf16x8& pa0, bf16x8& pa1, bf16x8& pa2, bf16x8& pa3) {
    for (int r = 0; r < 16; ++r) p1[r] = __builtin_amdgcn_exp2f(p1[r]);
    float ps = 0; for (int r = 0; r < 16; ++r) ps += p0[r]; for (int r = 0; r < 16; ++r) ps += p1[r];
    { auto rr = __builtin_amdgcn_permlane32_swap(__float_as_uint(ps), __float_as_uint(ps), false, false);
      ps = __uint_as_float(rr[0]) + __uint_as_float(rr[1]); }
    l_reg = l_reg * alpha + ps;
#define PK4(P, B_, OUT) do { unsigned a0 = cvtpk(P[B_+0], P[B_+1]), a1 = cvtpk(P[B_+2], P[B_+3]);                          \
        unsigned b0 = cvtpk(P[B_+4], P[B_+5]), b1 = cvtpk(P[B_+6], P[B_+7]);                                             \
        auto r0 = __builtin_amdgcn_permlane32_swap(a0, b0, false, false); auto r1 = __builtin_amdgcn_permlane32_swap(a1, b1, false, false); \
        u32x4 w = {r0[0], r1[0], r0[1], r1[1]}; OUT = *reinterpret_cast<bf16x8*>(&w); } while (0)
    PK4(p0, 0, pa0); PK4(p0, 8, pa1); PK4(p1, 0, pa2); PK4(p1, 8, pa3);
#undef PK4
}
template <int KB>
__device__ __forceinline__ void qkt(f32x16& p0, f32x16& p1, const char* K_lds, int r32, int hi, const bf16x8* qr) {
    p0 = f32x16{}; p1 = f32x16{};
    const char* kb[4];
#pragma unroll
    for (int dd = 0; dd < 4; ++dd) kb[dd] = K_lds + KB * SHM_K + KSWZ(r32, (dd * 16 + hi * 8) * 2);
#pragma unroll
    for (int d0 = 0; d0 < 8; ++d0) { const char* a = kb[d0 & 3] + (d0 >> 2) * 128;
        bf16x8 b0 = *reinterpret_cast<const bf16x8*>(a);
        bf16x8 b1 = *reinterpret_cast<const bf16x8*>(a + 32 * 256);
        p0 = __builtin_amdgcn_mfma_f32_32x32x16_bf16(b0, qr[d0], p0, 0, 0, 0);
        p1 = __builtin_amdgcn_mfma_f32_32x32x16_bf16(b1, qr[d0], p1, 0, 0, 0); }
}
template <int VB>
__device__ __forceinline__ void pv_tile(f32x16* o, int vb0, bf16x8 pa0, bf16x8 pa1, bf16x8 pa2, bf16x8 pa3) {
#define TRRD(dst, off) asm volatile("ds_read_b64_tr_b16 %0, %1 offset:%2" : "=&v"(dst) : "v"(vb0), "i"(off) : "memory")
#define PV_D0(d0) do { s16x4 l0, l1, l2, l3, h0, h1, h2, h3; constexpr int b_ = VB * SHM_V + v_rd_off(d0, 0, 0);   \
        TRRD(l0, b_); TRRD(h0, b_ + 2048); TRRD(l1, b_ + 4096); TRRD(h1, b_ + 6144); TRRD(l2, b_ + 8192); TRRD(h2, b_ + 10240); TRRD(l3, b_ + 12288); TRRD(h3, b_ + 14336); \
        asm volatile("s_waitcnt lgkmcnt(0)" ::: "memory"); SBAR();   \
        o[d0] = __builtin_amdgcn_mfma_f32_32x32x16_bf16(pa0, (bf16x8){l0[0], l0[1], l0[2], l0[3], h0[0], h0[1], h0[2], h0[3]}, o[d0], 0, 0, 0);   \
        o[d0] = __builtin_amdgcn_mfma_f32_32x32x16_bf16(pa1, (bf16x8){l1[0], l1[1], l1[2], l1[3], h1[0], h1[1], h1[2], h1[3]}, o[d0], 0, 0, 0);   \
        o[d0] = __builtin_amdgcn_mfma_f32_32x32x16_bf16(pa2, (bf16x8){l2[0], l2[1], l2[2], l2[3], h2[0], h2[1], h2[2], h2[3]}, o[d0], 0, 0, 0);   \
        o[d0] = __builtin_amdgcn_mfma_f32_32x32x16_bf16(pa3, (bf16x8){l3[0], l3[1], l3[2], l3[3], h3[0], h3[1], h3[2], h3[3]}, o[d0], 0, 0, 0); } while (0)
    PV_D0(0); PV_D0(1); PV_D0(2); PV_D0(3);
#undef PV_D0
#undef TRRD
}
struct BlockRef { const bf16* Q; const bf16* K; const bf16* V; int P0, tok0, hh; };
struct Seam { bf16x8 qr[8]; bf16x8 st_v0, st_v1, st_k0, st_k1; };
__device__ __forceinline__ int swa_jlo(int P0, int W) { const int lowk = P0 - W + 1; return lowk > 0 ? lowk / KVBLK : 0; }
#define ROW(p, k0, rr) ((p) + (size_t)((k0) + (rr)) * D + sc)
#define VMW() asm volatile("s_waitcnt vmcnt(0)" ::: "memory")
#define VMWN(n) asm volatile("s_waitcnt vmcnt(%0)" :: "i"(n) : "memory")
#define SLOAD_H(Kp, Vp, k0) do { S.st_v0 = load8(ROW(Vp, k0, sr)); S.st_v1 = load8(ROW(Vp, k0, 32 + sr));              \
                         S.st_k0 = load8(ROW(Kp, k0, sr)); S.st_k1 = load8(ROW(Kp, k0, 32 + sr)); } while (0)
#define SWRITE_HK(bf) do { *(bf16x8*)(K_lds + (bf) * SHM_K + kws) = S.st_k0; *(bf16x8*)(K_lds + (bf) * SHM_K + kws + 32 * 256) = S.st_k1; } while (0)
#define SWRITE_HV(bf) do { *(bf16x8*)(V_lds + (bf) * SHM_V + vst0) = S.st_v0; *(bf16x8*)(V_lds + (bf) * SHM_V + vst1) = S.st_v1; } while (0)
#define SWRITE_H(bf) do { SWRITE_HV(bf); SWRITE_HK(bf); } while (0)
__device__ __forceinline__ int lane_id() { return (int)__builtin_amdgcn_mbcnt_hi(~0u, __builtin_amdgcn_mbcnt_lo(~0u, 0u)); }
__device__ __forceinline__ void prime(const BlockRef& cur, int W, char* lds, Seam& S, int wid) {
    (void)wid; const int tid = threadIdx.x, lane = tid & 63, r32 = lane & 31, hi = lane >> 5;
    const int sr = tid >> 4, sc = (tid & 15) * 8, kws = KSWZ(sr, sc * 2); char* K_lds = lds + 2 * SHM_V;
    const int kb0 = swa_jlo(cur.P0, W) * KVBLK;
    for (int d0 = 0; d0 < 8; ++d0) S.qr[d0] = load8(cur.Q + (size_t)(wid * QBLK + r32) * D + d0 * 16 + hi * 8);
    SLOAD_H(cur.K, cur.V, kb0); VMW(); SWRITE_HK(0);
    __syncthreads();
}
template <bool SEL, int MODE>
__device__ __forceinline__ void block(const BlockRef& cur, const BlockRef& nxt, int skv, int W, char* lds, Seam& S,
                                      const unsigned long long* SELM, const float* GATES, int gate_off, float* OACC, bf16* OCAT, int wid) {
    (void)wid; const int tid = threadIdx.x, lane = tid & 63, r32 = lane & 31, hi = lane >> 5;
    const int j_lo = swa_jlo(cur.P0, W);
    int j_hi = (cur.P0 + QB - 1) / KVBLK + 1; if (j_hi > skv / KVBLK) j_hi = skv / KVBLK;
    const int NT = j_hi - j_lo;
    const int kbn = swa_jlo(nxt.P0, W) * KVBLK;
    const int qlo = cur.P0 + wid * QBLK, qm = qlo + r32 - 4 * hi;
    char* V_lds = lds; char* K_lds = lds + 2 * SHM_V;
    float* ws = (float*)(lds + 2 * SHM_V + 2 * SHM_K) + wid * 64; float* li_l = ws, * al_l = ws + 32;
    float m_reg = -1e30f, l_reg = 0; f32x16 o[4] = {};
    const int sr = tid >> 4, sc = (tid & 15) * 8, vst0 = v_st(sr, sc), vst1 = vst0 + 8192  , kws = KSWZ(sr, sc * 2);
    const int vb0 = (int)(uintptr_t)V_lds + v_rd_base(lane);
    const bf16* Kh = cur.K; const bf16* Vh = cur.V;
    unsigned long long* selt = (unsigned long long*)(lds + LDS_BYTES) + wid * 32;
    if (SEL) { if (hi == 0) selt[r32] = SELM[(size_t)(cur.tok0 + wid * QBLK + r32) * 4 + (cur.hh >> 2)]; }
#define RESC(a) do { if (__any((a) < 1.f)) { if (hi == 0) al_l[r32] = (a); asm volatile("s_waitcnt lgkmcnt(0)" ::: "memory");              \
                     for (int d_ = 0; d_ < 4; ++d_) for (int r = 0; r < 16; ++r) o[d_][r] *= al_l[crow(r, hi)]; } } while (0)
#define KBASE(t) ((j_lo + (t)) * KVBLK)
#define MASKT(P0_, P1_, t) do { const int kb_ = KBASE(t); if (kb_ + KVBLK - 1 > qlo || kb_ <= qlo + QBLK - 1 - W) mask_tile(P0_, P1_, qm - kb_, (unsigned)W); \
                                if (SEL) { const unsigned long long sm_ = selt[r32]; mask_all(P0_, P1_, ((sm_ >> (j_lo + (t))) & 1ull) != 0ull); } } while (0)
    constexpr int NQL = 8;
#define SEAM_K0() do { VMWN(NQL); SWRITE_HK(0); SBAR(); } while (0)
    f32x16 pA0, pA1, pB0, pB1; float mnA, mnB, alA, alB; bf16x8 pa0, pa1, pa2, pa3;
    SWRITE_HV(0); SBAR();
    if (NT > 1) { SLOAD_H(Kh, Vh, KBASE(1)); }
    SBAR(); qkt<0>(pA0, pA1, K_lds, r32, hi, S.qr);
    MASKT(pA0, pA1, 0); partialSM(pA0, pA1, m_reg, mnA, alA);
    if (NT > 1) { VMW(); SWRITE_H(1); }
    __syncthreads();
#define HALF_STEP(PX0, PX1, mnX, alX, PY0, PY1, alY, t, KB, VB, SB) do {                                                      \
        SBAR(); qkt<KB>(PX0, PX1, K_lds, r32, hi, S.qr);                                             \
        finishSM(PY0, PY1, alY, l_reg, pa0, pa1, pa2, pa3); SBAR();                                                           \
        if ((t) + 1 < NT) { SLOAD_H(Kh, Vh, KBASE((t) + 1)); SBAR(); }                                               \
        pv_tile<VB>(o, vb0, pa0, pa1, pa2, pa3); MASKT(PX0, PX1, (t)); partialSM(PX0, PX1, m_reg, mnX, alX);                                        \
        __syncthreads();                                                                                                      \
        if ((t) + 1 < NT) { VMW(); SWRITE_H(SB); }                                                                          \
        RESC(alX); __syncthreads(); } while (0)
    for (int t = 1; t + 1 < NT; t += 2) {
        HALF_STEP(pB0, pB1, mnB, alB, pA0, pA1, alA, t, 1, 0, 0);
        HALF_STEP(pA0, pA1, mnA, alA, pB0, pB1, alB, t + 1, 0, 1, 1);
    }
    const bool even = (NT & 1) == 0;
    if (even) { SBAR(); qkt<1>(pB0, pB1, K_lds, r32, hi, S.qr); SBAR(); }
    SLOAD_H(nxt.K, nxt.V, kbn); SBAR();
#pragma unroll
    for (int d0 = 0; d0 < 8; ++d0) S.qr[d0] = load8(nxt.Q + (size_t)(wid * QBLK + r32) * D + d0 * 16 + hi * 8);
    SBAR();
    finishSM(pA0, pA1, alA, l_reg, pa0, pa1, pa2, pa3); SBAR();
    pv_tile<0>(o, vb0, pa0, pa1, pa2, pa3);
    if (even) { MASKT(pB0, pB1, NT - 1); partialSM(pB0, pB1, m_reg, mnB, alB); __syncthreads(); RESC(alB);
        finishSM(pB0, pB1, alB, l_reg, pa0, pa1, pa2, pa3); SBAR(); pv_tile<1>(o, vb0, pa0, pa1, pa2, pa3); }
    SBAR(); SEAM_K0();
    if (hi == 0) li_l[r32] = l_reg; asm volatile("s_waitcnt lgkmcnt(0)" ::: "memory");
    { const int le = lane_id(), r32e = le & 31, hie = le >> 5;
      const int tokw = cur.tok0 + wid * QBLK; const float* gp = GATES + (size_t)tokw * 48 + gate_off + cur.hh;
      float* op = OACC + (size_t)tokw * DM + cur.hh * 128; bf16* cp = OCAT + (size_t)tokw * DM + cur.hh * 128;
#pragma unroll
      for (int r = 0; r < 16; ++r) { const int orow = crow(r, hie);
        const float sc_ = gp[orow * 48] * __builtin_amdgcn_rcpf(li_l[orow]);
        const unsigned ob = (unsigned)(orow * DM + r32e);
#pragma unroll
        for (int d0 = 0; d0 < 4; ++d0) { const float v = op[ob + d0 * 32] + o[d0][r] * sc_;
            if (MODE == 0) ((unsigned*)op)[ob + d0 * 32] = __float_as_uint(v);
            else cp[ob + d0 * 32] = (bf16)(cvtpk(v, v) & 0xffffu); } } }
    __syncthreads();
#undef RESC
#undef KBASE
#undef MASKT
#undef SEAM_K0
#undef HALF_STEP
}
#undef ROW
#undef VMW
#undef VMWN
#undef SLOAD_H
#undef SWRITE_HK
#undef SWRITE_HV
#undef SWRITE_H
__device__ __forceinline__ int swa_nramp(int nqb, int W) { const int t = W - 1; const int n = t < 0 ? 0 : t / QB + 1; return n > nqb ? nqb : n; }
struct SwaItem { int bh, qb0, qb1; };
__device__ __forceinline__ SwaItem swa_decode(int L, int nqb, int nx, int nramp) {
    SwaItem it; it.bh = L / nx; const int x = L - it.bh * nx; const int ns = nqb - nramp;
    if (x < ns) { it.qb0 = it.qb1 = nqb - 1 - x; } else { it.qb0 = x - ns; it.qb1 = nramp - 1 - it.qb0; }
    return it;
}
template <bool SEL, int MODE>
__device__ __forceinline__ void phase(int wid, char* lds, const bf16* Q, const bf16* K, const bf16* V, int W, const unsigned long long* SELM, const float* GATES, int gate_off, float* OACC, bf16* OCAT) {
    constexpr int nqb = SEQ / QB;
    const int nramp = swa_nramp(nqb, W), nx = (nramp + 1) / 2 + (nqb - nramp), total = nx * BATCH * 16, stride = gridDim.x;
    int L = blockIdx.x; if (L >= total) return;
    auto mkref = [&](const SwaItem& it, int pass) { const int qb = pass ? it.qb1 : it.qb0, b = it.bh >> 4, hh = it.bh & 15; BlockRef r;
        r.Q = Q + ((size_t)it.bh * SEQ + (size_t)qb * QB) * D; r.K = K + (size_t)(b * 4 + (hh >> 2)) * SPAD * D; r.V = V + (size_t)(b * 4 + (hh >> 2)) * SPAD * D;
        r.P0 = qb * QB; r.tok0 = b * SEQ + qb * QB; r.hh = hh; return r; };
    SwaItem it = swa_decode(L, nqb, nx, nramp); int pass = 0;
    BlockRef cur = mkref(it, 0);
    Seam S;
    __syncthreads();
    prime(cur, W, lds, S, wid);
    for (;;) {
        const bool more_pass = pass == 0 && it.qb1 != it.qb0, more_item = L + stride < total, last = !more_pass && !more_item;
        SwaItem itn = it; int passn = pass + 1, Ln = L;
        if (!more_pass) { passn = 0; Ln = more_item ? L + stride : L; itn = swa_decode(Ln, nqb, nx, nramp); }
        const BlockRef nxt = last ? cur : mkref(itn, passn);
        block<SEL, MODE>(cur, nxt, SEQ, W, lds, S, SELM, GATES, gate_off, OACC, OCAT, wid);
        if (last) break;
        cur = nxt; it = itn; pass = passn; L = Ln;
    }
}
#undef KSWZ
#undef SBAR
}

#ifndef REPEAT_PHASE
#define REPEAT_PHASE -1
#endif
#ifndef PROBE_LO
#define PROBE_LO 22
#define PROBE_HI 22
#define PROBE_SCALE 0.1f
#endif
#ifndef PROBE
#define PROBE 0
#endif
__device__ __forceinline__ void probe_compare(const Ctx& C, const bf16* Xa, const bf16* Xb, size_t n) {
    float se = 0.f, sr = 0.f;
    for (size_t i = (size_t)C.bid * NTHR + C.tid; i < n; i += (size_t)C.G * NTHR) { const float a = bf2f(Xa[i]), b = bf2f(Xb[i]); se += (a - b) * (a - b); sr += b * b; }
    se = wave_sum(se); sr = wave_sum(sr);
    if (C.lane == 0) { atomicAdd(WSP(float, WS_CTL) + CW_PROBE, se); atomicAdd(WSP(float, WS_CTL) + CW_PROBE + 1, sr); }
}
#ifndef MK_SPLIT
#define MK_SPLIT 0
#endif
constexpr int N_PHASES = 39;
#define COMMON_PHASES(l, pb) \
      \
      \
    if (IN(pb + 1)) { FRESH_TID(); pg8::Gemm g{WSP(bf16, WS_XR), WSP(bf16, WS_WKT) + (size_t)l * 4 * 1024 * DM, DM, DM, DM}; \
                      CrossOrder S{4, G, c, 1024, (long long)256 * DM * 2, (long long)256 * DM * 2, (long long)1024 * DM * 2}; EpiSoftmaxP E{ARP(bf16, A_PC), 1024, WSP(float, WS_RSQ) + (size_t)(2 * l) * T * 8, (LAS float*)(C.lds + LDS_AUX)}; pg8::gemm_phase(L, g, S, E, C.tid); } SEAM(pb + 1); \
      \
    if (IN(pb + 3)) { FRESH_TID(); pg8::Gemm g{ARP(bf16, A_PC), WSP(bf16, WS_VWT) + (size_t)l * 4 * DM * 1024, 1024, 1024, 1024}; \
                      CrossOrder S{8, G, c, DM, (long long)256 * 1024 * 2, (long long)256 * 1024 * 2, (long long)DM * 1024 * 2}; EpiResidT<false> E{WSP(bf16, WS_XR), WSP(bf16, WS_XR), DM, WSP(float, WS_RSQ) + (size_t)(2 * l + 1) * T * 8, (LAS float*)(C.lds + LDS_AUX)}; pg8::gemm_phase(L, g, S, E, C.tid); } SEAM(pb + 3); \
      \
      \
    if (IN(pb + 5)) { FRESH_TID(); pg8::Gemm g{WSP(bf16, WS_XR), WSP(bf16, WS_W_ROUTER) + (size_t)l * 256 * DM, DM, DM, 512}; RouterOrder S{G, c}; EpiStoreF32Rows E{ARP(float, A_XS), 256, WSP(float, WS_RSQ) + (size_t)(2 * l + 1) * T * 8};     pg8::gemm_phase(L, g, S, E, C.tid); } SEAM(pb + 5); \
    if (IN(pb + 6)) { FRESH_TID(); phase_route(C, A, l); } SEAM(pb + 6); \
    if (IN(pb + 7)) { FRESH_TID(); phase_gather(C, l); } SEAM(pb + 7); \
    if (IN(pb + 8)) { FRESH_TID(); const bool side_ = (l == 0) && (G == 256) && MOE_CVT_SIDE_H > 0; const int Gm_ = side_ ? G - MOE_CVT_WG : G; \
                      if (side_ && c >= Gm_) moe_convert_items_x2(C, MOE_CVT_BASE_H, MOE_CVT_BASE_H + MOE_CVT_SIDE_H, (c - Gm_) * NWAVES + C.wave, MOE_CVT_WG * NWAVES); else { \
                      LAS int* tab = (LAS int*)(C.lds + LDS_AUX); moe_build_table(C, ctl + CW_MOE_CNT + l * 64, tab); \
                      pg8::Gemm g{WSP(bf16, WS_XR), WSP(bf16, WS_W_GU) + (size_t)l * NEXP * 1024 * DM, DM, DM, DM}; MoeOrder S{tab, 4, Gm_, c, 0}; EpiHid E{ARP(bf16, A_HID), ARP(int, A_ROWSLOT), WSP(float, WS_RSQ) + (size_t)(2 * l + 1) * T * 8}; \
                      LAS int* rc = tab + 256; { pg8::Unit u_; const int* rs_ = ARP(int, A_ROWSLOT); for (int i_ = 0; i_ < 12 && S.next(i_, u_); ++i_) if (C.tid < 256) rc[i_ * 256 + C.tid] = (C.tid < u_.pm) ? (rs_[u_.aux + C.tid] >> 1) : 0; } __syncthreads(); \
                      pg8::gemm_phase<EpiHid, MoeOrder, true>(L, g, S, E, C.tid, rc); } } SEAM(pb + 8); \
    if (IN(pb + 9)) { FRESH_TID(); const bool side_ = (l == 0) && (G == 256) && MOE_CVT_SIDE_H2 > 0; const int Gm_ = side_ ? G - MOE_CVT_WG : G; \
                      if (side_ && c >= Gm_) moe_convert_items_x2(C, MOE_CVT_BASE_H2, MOE_CVT_BASE_H2 + MOE_CVT_SIDE_H2, (c - Gm_) * NWAVES + C.wave, MOE_CVT_WG * NWAVES); else { \
                      LAS int* tab = (LAS int*)(C.lds + LDS_AUX); moe_build_table(C, ctl + CW_MOE_CNT + l * 64, tab); \
                      pg8::Gemm g{ARP(bf16, A_HID), WSP(bf16, WS_W_DN) + (size_t)l * NEXP * DM * FF, FF, FF, FF}; MoeOrder S{tab, 8, Gm_, c, 1}; EpiMoeDown E{ARP(int, A_ROWSLOT), ARP(float, A_WTS), ARP(bf16, A_YE)}; pg8::gemm_phase(L, g, S, E, C.tid); } } SEAM(pb + 9); \
    if (IN(pb + 10)) { FRESH_TID(); if (l == 0) phase_combine_norm(C, nullptr, nullptr); else phase_combine_norm(C, INP(I_NORM_FINAL), ((float*)INP(N_INPUTS))); } \
    if (l == 0) SEAM(pb + 10);

__global__ void __launch_bounds__(NTHR, 2) mk_fwd(Args args) {
    extern __shared__ __attribute__((aligned(16))) unsigned char lds_raw[];
    Ctx C; C.lds = (LAS unsigned char*)lds_raw; C.tid = threadIdx.x; C.lane = C.tid & 63; C.wave = __builtin_amdgcn_readfirstlane(C.tid >> 6);
    C.G = gridDim.x; C.bid = blockIdx.x; C.gw = C.bid * NWAVES + C.wave; C.ngw = C.G * NWAVES; C.ws = args.ws;
    const Args& A = args; (void)A;
    volatile LAS unsigned* MISC = (volatile LAS unsigned*)(C.lds + LDS_MISC);
    if (C.tid < 64) MISC[C.tid] = 0u;
    if (C.tid <= N_INPUTS) ((LAS unsigned long long*)(C.lds + LDS_PTAB))[C.tid] = (C.tid < N_INPUTS) ? (unsigned long long)args.in[C.tid < N_INPUTS ? C.tid : 0] : (unsigned long long)args.out;
    __syncthreads();
    unsigned* ctl = WSP(unsigned, WS_CTL);
    const int lo = args.ph_lo, hi = args.ph_hi;
    XcdBarrier bar; bar.bar = ctl + CW_BAR; bar.x = 0; bar.st = MISC + 8;
    if (hi - lo > 1) bar = xcd_barrier_post(ctl + CW_BAR, MISC + 8);
#ifndef ONLY_PHASE
#define ONLY_PHASE -1
#endif
#define FRESH_TID() do { int t_ = threadIdx.x; asm volatile("" : "+v"(t_)); C.tid = t_; C.lane = t_ & 63; } while (0)
#define IN(k) ((ONLY_PHASE < 0 || ONLY_PHASE == (k)) && lo <= (k) && (k) < hi)
#if PROBE == 2
    unsigned long long tA_ = 0, tB_ = 0;
    if (PROBE_LO == 0) tA_ = __builtin_amdgcn_s_memrealtime();
#define SEAM(k) do { if (IN(k) && IN((k) + 1)) xcd_barrier(bar); if ((k) == PROBE_LO - 1) tA_ = __builtin_amdgcn_s_memrealtime(); if ((k) == PROBE_HI) tB_ = __builtin_amdgcn_s_memrealtime(); } while (0)
#else
#define SEAM(k) do { if (IN(k) && IN((k) + 1)) xcd_barrier(bar); } while (0)
#endif
    LAS unsigned char* L = C.lds;
    const int c = C.bid, G = C.G;

    if (IN(0)) { FRESH_TID(); for (int rep = 0; rep < (REPEAT_PHASE == 0 ? 2 : 1); ++rep) phase_prologue(C, A); } SEAM(0);
    if (IN(3)) { FRESH_TID(); const bool side = (G == 256) && MOE_CVT_SIDE_A > 0; const int Gg = side ? G - MOE_CVT_WG : G;
                 if (c < Gg) { pg8::Gemm g{(const bf16*)C.ws, (const bf16*)C.ws, DM, DM, DM}; AbInMemOrder S; S.d.init(T, AB_PAD, DM, DM, AB_PAD, Gg, c); S.m = MemProjOrder{Gg, c};
                               EpiAbInMem E{EpiAbIn{ARP(bf16, A_PAB), ARP(float, A_GF32)}, EpiStoreBf16{WSP(bf16, WS_KP), DM, 1.f}}; pg8::gemm_phase(L, g, S, E, C.tid); }
                 else moe_convert_items(C, MOE_CVT_TOTAL - MOE_CVT_SIDE_A - MOE_CVT_SIDE_B, MOE_CVT_TOTAL - MOE_CVT_SIDE_B, (c - Gg) * NWAVES + C.wave, MOE_CVT_WG * NWAVES); } SEAM(3);
    if (IN(4)) { FRESH_TID(); phase_mixer_prep(C, A); } SEAM(4);
    if (IN(5)) { FRESH_TID(); if (C.bid < 16 && C.wave == 0) ml_gate_scan(C, C.bid);
                 pg8::Gemm g{ARP(bf16, A_LIN), WSP(bf16, WS_W_LORA), 256, 256, 256}; pg8::DenseOrder S; S.init(T, 3072, 256, 256, 3072, G, c);
                 EpiLora E{INP(I_RW_W0), INP(I_RW_A0), INP(I_RW_K_A), ARP(bf16, A_KK), ARP(bf16, A_KR), ARP(float, A_WD), ARP(bf16, A_BV), ARP(bf16, A_KP), ARP(bf16, A_GG)}; pg8::gemm_phase(L, g, S, E, C.tid);
                 { pg8::Gemm g2{WSP(bf16, WS_KP), WSP(bf16, WS_W_CAQ), DM, DM, 512}; WktOrder S2{G, c}; EpiStoreBf16 E2{WSP(bf16, WS_WKT), DM, 0.04419417382415922f}; pg8::gemm_phase(L, g2, S2, E2, C.tid); }
                 { pg8::Gemm g3{WSP(bf16, WS_W_CAO), WSP(bf16, WS_VP), DM, DM, 512}; VwtOrder S3{G, c}; EpiStoreBf16 E3{WSP(bf16, WS_VWT), 1024, 1.f}; pg8::gemm_phase(L, g3, S3, E3, C.tid); } } SEAM(5);
    if (IN(6)) { FRESH_TID(); rwkv_prep_units(C, G == 256); for (int it = C.bid; it < 1024; it += G) ml_intra_unit(C, it, G == 256); } SEAM(6);
    if (IN(7)) { FRESH_TID(); for (int it = C.bid; it < 256; it += G) rwkv_scan_slice(C, it); ml_state_scan(C, 0, G); } SEAM(7);
    if (IN(8)) { FRESH_TID(); for (int it = C.bid; it < 1024; it += G) ml_out_unit(C, it, (G == 256) && MOE_CVT_SIDE_G > 0); rwkv_out_items(C); } SEAM(8);
    if (IN(9)) { FRESH_TID(); pg8::Gemm g{ARP(bf16, A_YCAT), WSP(bf16, WS_W_ABOUT), DM, DM, DM}; pg8::DenseOrder S; S.init(T, DM, DM, DM, DM, G, c); EpiResidT<true> E{INP(I_X), WSP(bf16, WS_XR), DM, WSP(float, WS_RSQ), (LAS float*)(C.lds + LDS_AUX)}; pg8::gemm_phase(L, g, S, E, C.tid); } SEAM(9);
    COMMON_PHASES(0, 10)
    if (IN(21)) { FRESH_TID(); const bool side = (G == 256); const int Gg = side ? G - MOE_CVT_WG : G;
                  if (c >= Gg) moe_convert_items_x2(C, MOE_CVT_TOTAL - MOE_CVT_SIDE_B, MOE_CVT_TOTAL, (c - Gg) * NWAVES + C.wave, MOE_CVT_WG * NWAVES); else {
                  pg8::Gemm g{WSP(bf16, WS_XR), WSP(bf16, WS_W_NSAIN), DM, DM, DM}; pg8::DenseOrder S; S.init(T, NSA_PAD, DM, DM, NSA_PAD, Gg, c);
                  EpiNsaIn E{ARP(bf16, A_Q), ARP(bf16, A_QROT), ARP(bf16, A_KV6), ARP(float, A_GATES), INP(I_NSA_GATE_B), WSP(float, WS_TAB + TAB_ROPE_COS), WSP(float, WS_TAB + TAB_ROPE_SIN), WSP(float, WS_RSQ) + (size_t)4 * T * 8}; pg8::gemm_phase(L, g, S, E, C.tid); } } SEAM(21);
    if (IN(22)) { FRESH_TID(); pg8::Gemm g{ARP(bf16, A_KV6), WSP(bf16, WS_W_CMP1), 2048, 4096, 512}; CmpOrder S{G, c}; EpiStoreF32 E{ARP(float, A_CPART), 256}; pg8::gemm_phase(L, g, S, E, C.tid); } SEAM(22);
    if (IN(23)) { FRESH_TID(); phase_cmp_finish(C, A); } SEAM(23);
    if (IN(24)) { FRESH_TID(); for (int rep = 0; rep < (REPEAT_PHASE == 24 ? 2 : 1); ++rep) phase_cmp_attn_mma(C, G == 256); } SEAM(24);
#if PROBE == 1
    if (IN(25)) { FRESH_TID(); phase_selwin_naive(C, ARP(bf16, A_OCATREF)); xcd_barrier(bar); }
#endif
    if (IN(25)) { FRESH_TID(); swa::phase<true, 0>(C.wave, (char*)lds_raw, ARP(bf16, A_QROT), (const bf16*)(C.ws + WS_ARENA + A_KV6 + 2 * KV6_STRIDE), (const bf16*)(C.ws + WS_ARENA + A_KV6 + 3 * KV6_STRIDE), SEQ,
                                      ARP(const unsigned long long, A_SELMASK), ARP(float, A_GATES), 16, ARP(float, A_OACC), ARP(bf16, A_OCAT)); } SEAM(25);
    if (IN(26)) { FRESH_TID(); swa::phase<false, 1>(C.wave, (char*)lds_raw, ARP(bf16, A_QROT), (const bf16*)(C.ws + WS_ARENA + A_KV6 + 4 * KV6_STRIDE), (const bf16*)(C.ws + WS_ARENA + A_KV6 + 5 * KV6_STRIDE), 512,
                                       ARP(const unsigned long long, A_SELMASK), ARP(float, A_GATES), 32, ARP(float, A_OACC), ARP(bf16, A_OCAT)); } SEAM(26);
#if PROBE == 1
    if (IN(26)) { FRESH_TID(); probe_compare(C, ARP(bf16, A_OCAT), ARP(bf16, A_OCATREF), (size_t)T * DM); }
#endif
    { int t2 = C.wave * 64 + swa::lane_id(); asm volatile("" : "+v"(t2)); C.tid = t2 & 511; C.lane = t2 & 63; }
    if (IN(27)) { FRESH_TID(); pg8::Gemm g{ARP(bf16, A_OCAT), WSP(bf16, WS_W_NSAOUT), DM, DM, DM}; pg8::DenseOrder S; S.init(T, DM, DM, DM, DM, G, c); EpiResidT<false> E{WSP(bf16, WS_XR), WSP(bf16, WS_XR), DM, WSP(float, WS_RSQ) + (size_t)2 * T * 8, (LAS float*)(C.lds + LDS_AUX)}; pg8::gemm_phase(L, g, S, E, C.tid); } SEAM(27);
    COMMON_PHASES(1, 28)
#if PROBE == 2
    xcd_barrier(bar);
    if (C.bid == 0 && C.tid == 0) ((float*)INP(N_INPUTS))[0] = (float)(tB_ - tA_) * (0.01f * PROBE_SCALE);
#elif PROBE
    xcd_barrier(bar);
    if (C.bid == 0 && C.tid == 0) { const float se = __hip_atomic_load((float*)(ctl + CW_PROBE), __ATOMIC_RELAXED, __HIP_MEMORY_SCOPE_AGENT), sr = __hip_atomic_load((float*)(ctl + CW_PROBE + 1), __ATOMIC_RELAXED, __HIP_MEMORY_SCOPE_AGENT);
        ((float*)INP(N_INPUTS))[0] = 1e6f * sqrtf(se / fmaxf(sr, 1e-30f)); }
#endif
#undef IN
#undef SEAM
}

extern "C" void kernel_launch(void* const* d_in, const int* in_sizes, int n_in, void* d_out, int out_size, void* d_ws, size_t ws_size, hipStream_t stream) {
    static int grid = 0;
    if (grid == 0) {
        if (n_in != N_INPUTS || out_size != T * DM || ws_size < WS_END) { fprintf(stderr, "kernel_launch: unexpected shapes (n_in %d, out %d, ws %zu, need %zu)\n", n_in, out_size, ws_size, (size_t)WS_END); grid = -1; return; }
        int dev = 0, cus = 0, per_cu = 0;
        if (hipGetDevice(&dev) != hipSuccess || hipDeviceGetAttribute(&cus, hipDeviceAttributeMultiprocessorCount, dev) != hipSuccess) { grid = -1; return; }
        if (hipFuncSetAttribute((const void*)mk_fwd, hipFuncAttributeMaxDynamicSharedMemorySize, LDS_BYTES) != hipSuccess) { fprintf(stderr, "kernel_launch: hipFuncSetAttribute failed\n"); grid = -1; return; }
        if (hipOccupancyMaxActiveBlocksPerMultiprocessor(&per_cu, (const void*)mk_fwd, NTHR, LDS_BYTES) != hipSuccess || per_cu < 1) fprintf(stderr, "kernel_launch: occupancy query says %d\n", per_cu);
        (void)hipGetLastError();
        grid = cus;
    }
    if (grid < 0) return;
    (void)hipMemsetAsync((char*)d_ws + WS_CTL, 0, CTL_BYTES, stream);
    Args a{};
    for (int i = 0; i < N_INPUTS; ++i) a.in[i] = (const float*)d_in[i];
    a.out = (float*)d_out; a.ws = (unsigned char*)d_ws;
#if MK_SPLIT
    for (int p = 0; p < N_PHASES; ++p) { a.ph_lo = p; a.ph_hi = p + 1; hipLaunchKernelGGL(mk_fwd, dim3(grid), dim3(NTHR), LDS_BYTES, stream, a); }
#else
    a.ph_lo = 0; a.ph_hi = N_PHASES; hipLaunchKernelGGL(mk_fwd, dim3(grid), dim3(NTHR), LDS_BYTES, stream, a);
#endif
}
```

```cpp
#include <hip/hip_runtime.h>
#include <cstdio>
#include <cstdint>

#define LAS __attribute__((address_space(3)))
#define GAS __attribute__((address_space(1)))
typedef unsigned short bf16;
typedef short bf16x8 __attribute__((ext_vector_type(8)));
typedef float f32x4 __attribute__((ext_vector_type(4)));
typedef float f32x2 __attribute__((ext_vector_type(2)));
typedef unsigned u32x4 __attribute__((ext_vector_type(4)));
typedef unsigned u32x2 __attribute__((ext_vector_type(2)));

constexpr int BATCH = 4, SEQ = 4096, DM = 2048, T = BATCH * SEQ, MEMT = 256, MT = BATCH * MEMT;
constexpr float EPS = 1e-6f;
constexpr int ML_COLS = 3080, RW_COLS = 3328, AB_COLS = 6408, AB_PAD = 6656;
constexpr int NSA_COLS = 5168, NSA_PAD = 5376;
constexpr int NEXP = 64, FF = 512;
constexpr int XS_ROWS = 49152;
constexpr int SPAD = SEQ + 64;

enum { I_X = 0, I_MEM, I_NORM_MIX, I_NORM_CROSS, I_NORM_MEM, I_NORM_FFN, I_NORM_FINAL, I_AB_W_IN, I_ML_CONV_W, I_ML_CONV_B, I_ML_GATE_B,
       I_RW_MU, I_RW_W0, I_RW_W_UP, I_RW_A0, I_RW_A_UP, I_RW_G_UP, I_RW_K_K, I_RW_K_A, I_RW_R_K, I_RW_LN_W, I_RW_LN_B, I_AB_W_OUT,
       I_NSA_W_IN, I_NSA_GATE_B, I_CMP_POS, I_CMP_W1, I_CMP_W2, I_NSA_W_OUT, I_CA_WQ, I_CA_WK, I_CA_WV, I_CA_WO,
       I_MOE_WG, I_MOE_BG, I_MOE_WE, I_MOE_BE, I_MOE_W_GATE, I_MOE_W_UP, I_MOE_W_DOWN, N_INPUTS };

constexpr size_t MiB = (size_t)1 << 20;
constexpr size_t WS_CTL = 0, CTL_BYTES = 1 * MiB;
constexpr size_t WS_TAB = 1 * MiB;
constexpr size_t WS_W_ABIN = 3 * MiB;
constexpr size_t WS_W_ABOUT = WS_W_ABIN + 26 * MiB;
constexpr size_t WS_W_LORA = WS_W_ABOUT + 8 * MiB;
constexpr size_t WS_W_NSAIN = WS_W_LORA + 2 * MiB;
constexpr size_t WS_W_NSAOUT = WS_W_NSAIN + 21 * MiB;
constexpr size_t WS_W_CMP1 = WS_W_NSAOUT + 8 * MiB;
constexpr size_t WS_W_CAQ = WS_W_CMP1 + 4 * MiB;
constexpr size_t WS_W_CAK = WS_W_CAQ + 16 * MiB;
constexpr size_t WS_W_CAV = WS_W_CAK + 16 * MiB;
constexpr size_t WS_W_CAO = WS_W_CAV + 16 * MiB;
constexpr size_t WS_W_ROUTER = WS_W_CAO + 16 * MiB;
constexpr size_t WS_W_GU = WS_W_ROUTER + 2 * MiB;
constexpr size_t WS_W_DN = WS_W_GU + 512 * MiB;
constexpr size_t WS_MEMN = WS_W_DN + 256 * MiB;
constexpr size_t WS_KP = WS_MEMN + 8 * MiB;
constexpr size_t WS_VP = WS_KP + 8 * MiB;
constexpr size_t WS_WKT = WS_VP + 8 * MiB;
constexpr size_t WS_VWT = WS_WKT + 32 * MiB;
constexpr size_t WS_XR = WS_VWT + 32 * MiB;
constexpr size_t WS_RSQ = WS_XR + 64 * MiB;
constexpr size_t WS_XN = WS_XR + 128 * MiB;
constexpr size_t WS_ARENA = WS_XN + 64 * MiB;
constexpr size_t A_PAB = 0;
constexpr size_t A_GF32 = A_PAB + 208 * MiB;
constexpr size_t A_QM = A_GF32 + 16 * MiB;
constexpr size_t A_KM = A_QM + 16 * MiB;
constexpr size_t A_IG = A_KM + 16 * MiB;
constexpr size_t A_LF = A_IG + 1 * MiB;
constexpr size_t A_MLA = A_LF + 256 * 1024, A_MLM = A_LF + 512 * 1024;
constexpr size_t A_RR = A_LF + 1 * MiB;
constexpr size_t A_KR = A_RR + 32 * MiB;
constexpr size_t A_VR = A_KR + 32 * MiB;
constexpr size_t A_KK = A_VR + 32 * MiB;
constexpr size_t A_LIN = A_KK + 32 * MiB;
constexpr size_t A_WD = A_LIN + 8 * MiB;
constexpr size_t A_BV = A_WD + 64 * MiB;
constexpr size_t A_KP = A_BV + 32 * MiB;
constexpr size_t A_GG = A_KP + 32 * MiB;
constexpr size_t A_YCAT = A_GG + 32 * MiB;
constexpr size_t A_RWM = A_YCAT + 64 * MiB;
constexpr size_t A_RWN = A_RWM + 32 * MiB, A_RWRW = A_RWN + 32 * MiB, A_RWYL = A_RWRW + 32 * MiB;
constexpr size_t A_MLKV = A_RWYL + 32 * MiB;
constexpr size_t A_MLNUM = A_MLKV + 68 * MiB;
constexpr size_t A_END0 = A_MLNUM + 34 * MiB;
constexpr size_t A_SC = 0;
constexpr size_t A_PC = A_SC + 64 * MiB;
constexpr size_t A_LOGIT = 0;
constexpr size_t A_EID = A_LOGIT + 16 * MiB;
constexpr size_t A_WTS = A_EID + 1 * MiB;
constexpr size_t A_ROWSLOT = A_WTS + 1 * MiB;
constexpr size_t A_LRANK = A_ROWSLOT + 256 * 1024, A_BHIST = A_ROWSLOT + 512 * 1024;
constexpr size_t A_XS = A_ROWSLOT + 1 * MiB;
constexpr size_t A_HID = A_XS + 192 * MiB;
constexpr size_t A_YE = A_HID + 48 * MiB;
constexpr size_t A_END2 = A_YE + 128 * MiB;
constexpr size_t A_Q = 0;
constexpr size_t A_QROT = A_Q + 64 * MiB;
constexpr size_t A_KV6 = A_QROT + 64 * MiB;
constexpr size_t KV6_STRIDE = 17 * MiB;
constexpr size_t A_GATES = A_KV6 + 6 * KV6_STRIDE;
constexpr size_t A_CPART = A_GATES + 4 * MiB;
constexpr size_t A_KCMP = A_CPART + 64 * MiB;
constexpr size_t A_VCMP = A_KCMP + 1 * MiB;
constexpr size_t A_SELMASK = A_VCMP + 1 * MiB;
constexpr size_t A_OACC = A_SELMASK + 1 * MiB;
constexpr size_t A_OCAT = A_OACC + 128 * MiB;
constexpr size_t A_OCATREF = A_OCAT + 64 * MiB;
constexpr size_t A_VCT = A_OCATREF + 64 * MiB;
constexpr size_t A_END3 = A_VCT + 1 * MiB;
constexpr size_t ARENA_BYTES = 860 * MiB;
static_assert(A_END0 <= ARENA_BYTES && A_END2 <= ARENA_BYTES && A_END3 <= ARENA_BYTES, "arena");
constexpr size_t WS_END = WS_ARENA + ARENA_BYTES;
static_assert(WS_END <= (size_t)2048 * MiB, "workspace");
constexpr size_t TAB_ROPE_COS = 0, TAB_ROPE_SIN = 256 * 1024, TAB_CMPBIAS = 512 * 1024, TAB_RSTD = 1024 * 1024;
constexpr int CW_BAR = 4096;
constexpr int CW_MOE_CNT = 16384;
constexpr int CW_MOE_CUR = 16384 + 256;
constexpr int CW_PROBE = 32768;
constexpr int CW_RSQ = 65536;

__device__ __forceinline__ float bf2f(bf16 v) { return __uint_as_float((unsigned)v << 16); }
__device__ __forceinline__ unsigned f2bf(float f) { unsigned u = __float_as_uint(f); return (u + 0x7fffu + ((u >> 16) & 1u)) >> 16; }
__device__ __forceinline__ unsigned pk2(float lo, float hi) { return f2bf(lo) | (f2bf(hi) << 16); }
__device__ __forceinline__ float lo_bf(unsigned w) { return __uint_as_float(w << 16); }
__device__ __forceinline__ float hi_bf(unsigned w) { return __uint_as_float(w & 0xffff0000u); }
__device__ __forceinline__ float sigmoidf_(float x) { return 1.f / (1.f + __expf(-x)); }
__device__ __forceinline__ float siluf_(float x) { return x / (1.f + __expf(-x)); }
#define DPPF(v, ctrl) __int_as_float(__builtin_amdgcn_update_dpp(0, __float_as_int(v), (ctrl), 0xf, 0xf, true))
#define DPP_XOR1 0xB1
#define DPP_XOR2 0x4E
#define DPP_HMIRROR 0x141
#define DPP_MIRROR 0x140
__device__ __forceinline__ float xor16f(float v) { const unsigned u = __float_as_uint(v); auto r = __builtin_amdgcn_permlane16_swap(u, u, false, false); return __uint_as_float(r[0] ^ r[1] ^ u); }
__device__ __forceinline__ float xor32f(float v) { const unsigned u = __float_as_uint(v); auto r = __builtin_amdgcn_permlane32_swap(u, u, false, false); return __uint_as_float(r[0] ^ r[1] ^ u); }
__device__ __forceinline__ float wave_sum(float v) {
    v += DPPF(v, DPP_XOR1); v += DPPF(v, DPP_XOR2); v += DPPF(v, DPP_HMIRROR); v += DPPF(v, DPP_MIRROR); v += xor16f(v); v += xor32f(v); return v;
}
__device__ __forceinline__ float wave_max(float v) {
    v = fmaxf(v, DPPF(v, DPP_XOR1)); v = fmaxf(v, DPPF(v, DPP_XOR2)); v = fmaxf(v, DPPF(v, DPP_HMIRROR)); v = fmaxf(v, DPPF(v, DPP_MIRROR)); v = fmaxf(v, xor16f(v)); v = fmaxf(v, xor32f(v)); return v;
}
__device__ __forceinline__ void unpack8(u32x4 w, float* f) {
    f[0] = lo_bf(w.x); f[1] = hi_bf(w.x); f[2] = lo_bf(w.y); f[3] = hi_bf(w.y); f[4] = lo_bf(w.z); f[5] = hi_bf(w.z); f[6] = lo_bf(w.w); f[7] = hi_bf(w.w);
}
__device__ __forceinline__ void st16_f(void* p, u32x4 w) { *(f32x4*)p = __builtin_bit_cast(f32x4, w); }
__device__ __forceinline__ void st8_f(void* p, u32x2 w) { *(f32x2*)p = __builtin_bit_cast(f32x2, w); }
__device__ __forceinline__ u32x4 pack8f(const float* f) { u32x4 w; w.x = pk2(f[0], f[1]); w.y = pk2(f[2], f[3]); w.z = pk2(f[4], f[5]); w.w = pk2(f[6], f[7]); return w; }

namespace pg8 {
constexpr int BM = 256, BK = 64, HALF = 128, HTB = HALF * BK * 2, STAGE_BYTES = 8 * HTB, NXCD = 8, WGM = 8;
__host__ __device__ __forceinline__ int lds_byte(int r, int c) { const int st = (r >> 4) * 2 + (c >> 5), rr = r & 15, cc = c & 31, ob = rr * 64 + cc * 2; return st * 1024 + (ob ^ (((ob >> 9) & 1) << 5)); }
__host__ __device__ __forceinline__ void stage_rc(int b, int& R, int& C) { const int st = b / 1024, sb = b % 1024, swz = sb ^ (((sb >> 9) & 1) << 5); R = (st >> 1) * 16 + swz / 64; C = (st & 1) * 32 + (swz % 64) / 2; }
__host__ __device__ __forceinline__ int perm32(int rho) { const int n = rho >> 4, i = rho & 15; return 8 * (i >> 2) + 4 * n + (i & 3); }

struct Unit { long long aoff, boff, coff; int pm, pn, aux; };
struct Gemm { const bf16* A; const bf16* Bt; int lda, ldb, K; };

__device__ __forceinline__ bool tile_of(long L, int nM, int nN, int& pm, int& pn) {
    const int nwg = nM * nN; if (L >= nwg) return false;
    int wgid = (int)L; { const int q = nwg / NXCD, r = nwg % NXCD, xcd = wgid % NXCD, off = wgid / NXCD; wgid = (xcd < r ? xcd * (q + 1) : r * (q + 1) + (xcd - r) * q) + off; }
    const int nig = WGM * nN, gid = wgid / nig, fm = gid * WGM, gsz = (nM - fm) < WGM ? (nM - fm) : WGM;
    pm = fm + ((wgid % nig) % gsz); pn = (wgid % nig) / gsz; return true;
}
struct DenseOrder {
    int nM, nN, G, c, ldc; long long astep, bstep;
    __device__ void init(int M, int N, int lda, int ldb, int ldc_, int G_, int c_) { nM = M / BM; nN = N / BM; G = G_; c = c_; ldc = ldc_; astep = (long long)BM * lda * 2; bstep = (long long)BM * ldb * 2; }
    __device__ __forceinline__ bool next(int i, Unit& u) const {
        int pm, pn; if (!tile_of((long)i * G + c, nM, nN, pm, pn)) return false;
        u.pm = pm; u.pn = pn; u.aux = 0; u.aoff = pm * astep; u.boff = pn * bstep; u.coff = (long long)pm * BM * ldc + pn * BM; return true;
    }
};

__device__ __forceinline__ unsigned cvt_pk_bf16(float lo, float hi) { unsigned r; asm volatile("v_cvt_pk_bf16_f32 %0, %1, %2" : "=v"(r) : "v"(lo), "v"(hi)); return r; }

template <class Epi, class Sched, bool GATHER = false>
__device__ __forceinline__ void gemm_phase(LAS unsigned char* lds, const Gemm g, const Sched& S, const Epi& E, int tid_, const LAS int* rowcache = nullptr) {
    __builtin_assume(tid_ >= 0 && tid_ < 512); const int tid = tid_, wid = __builtin_amdgcn_readfirstlane(tid >> 6), lane = tid & 63, wr = wid >> 2, wc = wid & 3, fr = lane & 15, fq = lane >> 4;
    int nt = g.K / BK; asm volatile("" : "+s"(nt));
    const size_t kstep = (size_t)(BK * 2);
    const size_t hstepA = (size_t)HALF * g.lda * 2, hstepB = (size_t)HALF * g.ldb * 2;
    unsigned vA0[2], vA1[2], vN0[2], vN1[2], voffB[2]; int Rr[2], Cb[2];
#pragma unroll
    for (int i = 0; i < 2; ++i) { int R, C; stage_rc(tid * 16 + i * 8192, R, C); const int Rb = (R & ~31) + perm32(R & 31); Rr[i] = R; Cb[i] = C * 2;
        vA0[i] = (unsigned)(R * g.lda + C) * 2u; vA1[i] = vA0[i] + (unsigned)hstepA; vN0[i] = vA0[i]; vN1[i] = vA1[i]; voffB[i] = (unsigned)(Rb * g.ldb + C) * 2u; }
#define PG8_GATHER(d0, d1, ui_) do { _Pragma("unroll") for (int _i = 0; _i < 2; ++_i) { d0[_i] = (unsigned)(rowcache[(ui_) * 256 + Rr[_i]] * g.lda * 2 + Cb[_i]); d1[_i] = (unsigned)(rowcache[(ui_) * 256 + 128 + Rr[_i]] * g.lda * 2 + Cb[_i]); } } while (0)
    if (GATHER) PG8_GATHER(vA0, vA1, 0);
    const unsigned ldsw = (unsigned)wid * 1024u;
    const int aoff = lds_byte(wr * 64 + fr, fq * 8), boff = lds_byte(wc * 32 + fr, fq * 8);
#define PG8_SA(b, h) (((b) * 2 + (h)) * HTB)
#define PG8_SB(b, h) ((4 + (b) * 2 + (h)) * HTB)
#define PG8_STAGE(bufoff, gbase, voff) do { _Pragma("unroll") for (int _i = 0; _i < 2; ++_i) \
        __builtin_amdgcn_global_load_lds((const unsigned*)((const char*)(gbase) + (voff)[_i]), (LAS unsigned*)(lds + (bufoff) + ldsw + _i * 8192), 16, 0, 0); } while (0)
#define PG8_LDA(dst, b, h) do { _Pragma("unroll") for (int m = 0; m < 4; ++m) _Pragma("unroll") for (int k = 0; k < 2; ++k) dst[m][k] = *(const LAS bf16x8*)(lds + PG8_SA(b, h) + aoff + m * 2048 + k * 1024); } while (0)
#define PG8_LDB(dst, b, h) do { _Pragma("unroll") for (int n = 0; n < 2; ++n) _Pragma("unroll") for (int k = 0; k < 2; ++k) dst[n][k] = *(const LAS bf16x8*)(lds + PG8_SB(b, h) + boff + n * 2048 + k * 1024); } while (0)
#define PG8_MMA(ai, bj, At, Bt) do { __builtin_amdgcn_s_setprio(1); _Pragma("unroll") for (int m = 0; m < 4; ++m) _Pragma("unroll") for (int n = 0; n < 2; ++n) _Pragma("unroll") for (int k = 0; k < 2; ++k) \
        acc[ai][bj][m][n] = __builtin_amdgcn_mfma_f32_16x16x32_bf16(Bt[n][k], At[m][k], acc[ai][bj][m][n], 0, 0, 0); __builtin_amdgcn_s_setprio(0); } while (0)
#define PG8_WAIT_V(n) asm volatile("s_waitcnt vmcnt(" #n ")" ::: "memory")
#define PG8_WAIT_L(n) asm volatile("s_waitcnt lgkmcnt(" #n ")" ::: "memory")
#define PG8_BAR __builtin_amdgcn_s_barrier()
#define PG8_SCHED __builtin_amdgcn_sched_barrier(0)
    Unit cur, nxt; int ui = 0;
    if (!S.next(0, cur)) return;
    f32x4 acc[2][2][4][2];
#pragma unroll
    for (int a = 0; a < 2; ++a)
#pragma unroll
        for (int b = 0; b < 2; ++b)
#pragma unroll
            for (int m = 0; m < 4; ++m)
#pragma unroll
                for (int n = 0; n < 2; ++n) acc[a][b][m][n] = (f32x4){0.f, 0.f, 0.f, 0.f};
    bf16x8 At[4][2], B0[2][2], B1[2][2];
    const char* cA = (const char*)g.A + cur.aoff; const char* cB = (const char*)g.Bt + cur.boff;
    PG8_STAGE(PG8_SB(0, 0), cB, voffB); PG8_STAGE(PG8_SB(0, 1), cB + hstepB, voffB); PG8_STAGE(PG8_SA(0, 0), cA, vA0); PG8_STAGE(PG8_SA(0, 1), cA, vA1);
    if (wr == 1) PG8_BAR;
    PG8_WAIT_V(2); PG8_BAR;
    PG8_STAGE(PG8_SB(1, 0), cB + kstep, voffB); PG8_STAGE(PG8_SA(1, 0), cA + kstep, vA0); PG8_STAGE(PG8_SB(1, 1), cB + hstepB + kstep, voffB);
    PG8_WAIT_V(6); PG8_BAR;
    for (;;) {
        const bool has_next = S.next(ui + 1, nxt);
        const char* nA = has_next ? (const char*)g.A + nxt.aoff : cA; const char* nB = has_next ? (const char*)g.Bt + nxt.boff : cB;
        if (GATHER) { if (has_next) PG8_GATHER(vN0, vN1, ui + 1); else { vN0[0] = vA0[0]; vN0[1] = vA0[1]; vN1[0] = vA1[0]; vN1[1] = vA1[1]; } }
        for (int t = 0; t < nt; t += 2) {
            const bool last = (t == nt - 2);
            const char* a1 = cA + (size_t)(t + 1) * kstep;
            const char* a2 = last ? nA : cA + (size_t)(t + 2) * kstep; const char* b2 = last ? nB : cB + (size_t)(t + 2) * kstep;
            const char* a3 = a2 + kstep; const char* b3 = b2 + kstep;
            unsigned w0[2], w1[2];
            if (GATHER) { w0[0] = last ? vN0[0] : vA0[0]; w0[1] = last ? vN0[1] : vA0[1]; w1[0] = last ? vN1[0] : vA1[0]; w1[1] = last ? vN1[1] : vA1[1]; } else { w0[0] = vA0[0]; w0[1] = vA0[1]; w1[0] = vA1[0]; w1[1] = vA1[1]; }
            PG8_LDB(B0, 0, 0); PG8_LDB(B1, 0, 1); PG8_SCHED; PG8_LDA(At, 0, 0); PG8_STAGE(PG8_SA(1, 1), a1, vA1);
            PG8_WAIT_V(8); PG8_WAIT_L(0); PG8_BAR; PG8_MMA(0, 0, At, B0); PG8_MMA(0, 1, At, B1); PG8_BAR; PG8_SCHED;
            PG8_LDA(At, 0, 1); PG8_STAGE(PG8_SB(0, 0), b2, voffB); PG8_STAGE(PG8_SB(0, 1), b2 + hstepB, voffB); PG8_STAGE(PG8_SA(0, 0), a2, w0);
            PG8_WAIT_V(8); PG8_WAIT_L(0); PG8_BAR; PG8_MMA(1, 0, At, B0); PG8_MMA(1, 1, At, B1); PG8_BAR; PG8_SCHED;
            PG8_LDB(B0, 1, 0); PG8_LDB(B1, 1, 1); PG8_SCHED; PG8_LDA(At, 1, 0); PG8_STAGE(PG8_SA(0, 1), a2, w1);
            PG8_WAIT_V(8); PG8_WAIT_L(0); PG8_BAR; PG8_MMA(0, 0, At, B0); PG8_MMA(0, 1, At, B1); PG8_BAR; PG8_SCHED;
            PG8_LDA(At, 1, 1); PG8_STAGE(PG8_SB(1, 0), b3, voffB); PG8_STAGE(PG8_SB(1, 1), b3 + hstepB, voffB); PG8_STAGE(PG8_SA(1, 0), a3, w0);
            PG8_WAIT_V(8); PG8_WAIT_L(0); PG8_BAR; PG8_MMA(1, 0, At, B0); PG8_MMA(1, 1, At, B1); PG8_BAR; PG8_SCHED;
        }
        if (wr == 0) PG8_BAR;
        E(acc, cur, wr, wc, fr, fq);
        if (!has_next) break;
#pragma unroll
        for (int a = 0; a < 2; ++a)
#pragma unroll
            for (int b = 0; b < 2; ++b)
#pragma unroll
                for (int m = 0; m < 4; ++m)
#pragma unroll
                    for (int n = 0; n < 2; ++n) acc[a][b][m][n] = (f32x4){0.f, 0.f, 0.f, 0.f};
        cur = nxt; cA = nA; cB = nB; ++ui;
        if (GATHER) { vA0[0] = vN0[0]; vA0[1] = vN0[1]; vA1[0] = vN1[0]; vA1[1] = vN1[1]; }
        if (wr == 1) PG8_BAR;
    }
    PG8_WAIT_V(0);
    PG8_BAR;
#undef PG8_SA
#undef PG8_SB
#undef PG8_STAGE
#undef PG8_GATHER
#undef PG8_LDA
#undef PG8_LDB
#undef PG8_MMA
#undef PG8_WAIT_V
#undef PG8_WAIT_L
#undef PG8_BAR
#undef PG8_SCHED
}
}

#define XB_TMO      128
#define XB_XCNT(j)  (256  + 64 * (j))
#define XB_XSUB(j)  (1280 + 64 * (j))
#define XB_XGEN(j)  (2304 + 64 * (j))
#define XB_TOP      3328
#define XB_TOPGEN   3392
#define XCD_BAR_WORDS 3456
#define XB_SPIN_CAP (1u << 22)
__device__ __forceinline__ unsigned xb_ld(unsigned* p)              { return __hip_atomic_load(p, __ATOMIC_RELAXED, __HIP_MEMORY_SCOPE_AGENT); }
__device__ __forceinline__ unsigned xb_add(unsigned* p, unsigned v) { return __hip_atomic_fetch_add(p, v, __ATOMIC_RELAXED, __HIP_MEMORY_SCOPE_AGENT); }
__device__ __forceinline__ unsigned xb_xcc_id() { return (unsigned)__builtin_amdgcn_s_getreg((3 << 11) | 20) & 0xFu; }
#define XB_SPIN(cond, bar) do { unsigned _sp = 0; while (cond) { __builtin_amdgcn_s_sleep(1); \
    if ((++_sp & 255u) == 0u) { if (xb_ld(&(bar)[XB_TMO])) break; if (_sp > XB_SPIN_CAP) { atomicAdd(&(bar)[XB_TMO], 1u); break; } } } } while (0)
struct XcdBarrier { unsigned* bar; unsigned x; volatile LAS unsigned* st; };
__device__ __forceinline__ XcdBarrier xcd_barrier_post(unsigned* bar, volatile LAS unsigned* st) {
    XcdBarrier b; b.bar = bar; b.x = xb_xcc_id(); b.st = st;
    if (threadIdx.x == 0) (void)xb_add(&bar[XB_XCNT(b.x)], 1u);
    return b;
}
__device__ __forceinline__ void xcd_barrier_complete(unsigned* bar, unsigned x, unsigned& nloc, unsigned& nx) {
    const unsigned G = gridDim.x * gridDim.y * gridDim.z;
    unsigned sum, cnt, mine, sp = 0u;
    for (;;) {
        sum = 0u; cnt = 0u; mine = 0u;
#pragma unroll
        for (unsigned j = 0; j < 16; ++j) { const unsigned c = xb_ld(&bar[XB_XCNT(j)]); sum += c; cnt += (c > 0u) ? 1u : 0u; mine = (j == x) ? c : mine; }
        if (sum == G) break;
        __builtin_amdgcn_s_sleep(1);
        if ((++sp & 255u) == 0u) { if (xb_ld(&bar[XB_TMO])) break; if (sp > XB_SPIN_CAP) { atomicAdd(&bar[XB_TMO], 1u); break; } }
    }
    nloc = mine > 0u ? mine : 1u; nx = cnt > 0u ? cnt : 1u;
}
__device__ __forceinline__ void xcd_barrier(const XcdBarrier& b) {
    asm volatile("s_waitcnt vmcnt(0)" ::: "memory");
    __syncthreads();
    if (threadIdx.x == 0) {
        unsigned* bar = b.bar;
        __builtin_amdgcn_s_waitcnt(0);
        unsigned nloc = b.st[0], nx = b.st[1];
        if (nloc == 0u) { xcd_barrier_complete(bar, b.x, nloc, nx); b.st[0] = nloc; b.st[1] = nx; }
        const unsigned old = xb_add(&bar[XB_XSUB(b.x)], 1u);
        const unsigned gen = old / nloc;
        if (old + 1u == (gen + 1u) * nloc) {
            __builtin_amdgcn_fence(__ATOMIC_RELEASE, "agent");
            asm volatile("s_waitcnt vmcnt(0)" ::: "memory");
            const unsigned og = xb_add(&bar[XB_TOP], 1u);
            const unsigned tg = og / nx;
            if (og + 1u == (tg + 1u) * nx) xb_add(&bar[XB_TOPGEN], 1u);
            else XB_SPIN(xb_ld(&bar[XB_TOPGEN]) == tg, bar);
            __builtin_amdgcn_fence(__ATOMIC_ACQUIRE, "agent");
            xb_add(&bar[XB_XGEN(b.x)], 1u);
            asm volatile("s_waitcnt vmcnt(0)" ::: "memory");
        } else {
            XB_SPIN(xb_ld(&bar[XB_XGEN(b.x)]) == gen, bar);
            __builtin_amdgcn_fence(__ATOMIC_ACQUIRE, "agent");
            asm volatile("s_waitcnt vmcnt(0)" ::: "memory");
        }
    }
    __syncthreads();
}

constexpr int NWAVES = 8, NTHR = 512;
constexpr int LDS_MAIN = 131072;
constexpr int LDS_AUX = 131072, LDS_AUX_BYTES = 16384;
constexpr int LDS_MISC = LDS_AUX + LDS_AUX_BYTES;
constexpr int LDS_PTAB = LDS_MISC + 256;
constexpr int LDS_BYTES = LDS_MISC + 1024;
struct Args { const float* in[N_INPUTS]; float* out; unsigned char* ws; int ph_lo, ph_hi; };

struct Ctx {
    LAS unsigned char* lds;
    int tid, lane, wave, G, bid, gw, ngw;
    unsigned char* ws;
};
__device__ __forceinline__ const float* lds_inp(LAS unsigned char* lds, int i) {
    const LAS unsigned* p = (const LAS unsigned*)(lds + LDS_PTAB) + 2 * i;
    const unsigned lo = __builtin_amdgcn_readfirstlane(p[0]), hi = __builtin_amdgcn_readfirstlane(p[1]);
    return (const float*)(const GAS float*)(((unsigned long long)hi << 32) | lo);
}
#define INP(i) lds_inp(C.lds, (i))
#define WSP(T_, off) ((T_*)(C.ws + (off)))
#define ARP(T_, off) ((T_*)(C.ws + WS_ARENA + (off)))
#define LDS_WAIT() asm volatile("s_waitcnt lgkmcnt(0)" ::: "memory")

__device__ __forceinline__ void rms_row_bf16(const float* xrow, const float* gain, bf16* orow, int lane) {
    f32x4 v[8]; float s = 0.f;
#pragma unroll
    for (int j = 0; j < 8; ++j) { v[j] = *(const f32x4*)(xrow + (j * 64 + lane) * 4); s += v[j].x * v[j].x + v[j].y * v[j].y + v[j].z * v[j].z + v[j].w * v[j].w; }
    const float rstd = rsqrtf(wave_sum(s) * (1.f / DM) + EPS);
#pragma unroll
    for (int j = 0; j < 8; ++j) { const f32x4 g = *(const f32x4*)(gain + (j * 64 + lane) * 4);
        u32x2 w; w.x = pk2(v[j].x * rstd * g.x, v[j].y * rstd * g.y); w.y = pk2(v[j].z * rstd * g.z, v[j].w * rstd * g.w);
        *(u32x2*)(orow + (j * 64 + lane) * 4) = w; }
}

template <int NT, class F>
__device__ __forceinline__ void transpose_tiles(const float* W, int ldw, int nvalid, int k0, int n0, bf16* WT, int ldt, F drow, int lane, const float* kscale) {
    const int g = lane >> 3, c = lane & 7; f32x4 v[NT][8];
#pragma unroll
    for (int q = 0; q < NT; ++q) { const int n = n0 + 32 * q + 4 * c; const bool ok = n < nvalid;
#pragma unroll
        for (int j = 0; j < 8; ++j) v[q][j] = ok ? *(const f32x4*)(W + (size_t)(k0 + 8 * g + j) * ldw + n) : (f32x4){0.f, 0.f, 0.f, 0.f}; }
    f32x4 ka = (f32x4){1.f, 1.f, 1.f, 1.f}, kb = ka;
    if (kscale) { ka = *(const f32x4*)(kscale + k0 + 8 * g); kb = *(const f32x4*)(kscale + k0 + 8 * g + 4); }
#pragma unroll
    for (int q = 0; q < NT; ++q) { const int n = n0 + 32 * q + 4 * c;
#pragma unroll
        for (int i = 0; i < 4; ++i) { u32x4 o; o.x = pk2(v[q][0][i] * ka.x, v[q][1][i] * ka.y); o.y = pk2(v[q][2][i] * ka.z, v[q][3][i] * ka.w); o.z = pk2(v[q][4][i] * kb.x, v[q][5][i] * kb.y); o.w = pk2(v[q][6][i] * kb.z, v[q][7][i] * kb.w);
            *(u32x4*)(WT + (size_t)drow(n + i) * ldt + k0 + 8 * g) = o; } }
}
template <class F>
__device__ __forceinline__ void transpose_tile(const float* W, int ldw, int nvalid, int k0, int n0, bf16* WT, int ldt, F drow, LAS float* scr, int lane, const float* kscale = nullptr) {
    (void)scr; transpose_tiles<1>(W, ldw, nvalid, k0, n0, WT, ldt, drow, lane, kscale);
}
template <class F>
__device__ __forceinline__ void transpose_matrix(const Ctx& C, const float* W, int K, int N, int Npad, bf16* WT, int ldt, F drow, LAS float* scr, const float* kscale = nullptr) {
    const int nblk = Npad / 32, items = (K / 64) * nblk;
    for (int it = C.gw; it < items; it += C.ngw) { const int kb = it / nblk, nb = it % nblk; transpose_tile(W, N, N, kb * 64, nb * 32, WT, ldt, drow, scr, C.lane, kscale); }
}

#define EPI_ARGS const f32x4 (&acc)[2][2][4][2], const pg8::Unit& u, int wr, int wc, int fr, int fq
struct EpiStoreBf16 {
    bf16* O; int ldc; float scale;
    __device__ __forceinline__ void operator()(EPI_ARGS) const {
        bf16* base = O + u.coff + (size_t)(wr * 64 + fr) * ldc + wc * 32 + 8 * fq;
#pragma unroll
        for (int ai = 0; ai < 2; ++ai)
#pragma unroll
            for (int m = 0; m < 4; ++m) { bf16* rowp = base + (size_t)(ai * 128 + m * 16) * ldc;
#pragma unroll
                for (int bj = 0; bj < 2; ++bj) { const f32x4 v0 = acc[ai][bj][m][0] * scale, v1 = acc[ai][bj][m][1] * scale;
                    u32x4 w; w.x = pg8::cvt_pk_bf16(v0[0], v0[1]); w.y = pg8::cvt_pk_bf16(v0[2], v0[3]); w.z = pg8::cvt_pk_bf16(v1[0], v1[1]); w.w = pg8::cvt_pk_bf16(v1[2], v1[3]);
                    *(u32x4*)(rowp + bj * 128) = w; } }
    }
};
struct EpiStoreF32 {
    float* O; int ldc;
    __device__ __forceinline__ void operator()(EPI_ARGS) const {
        float* base = O + u.coff + (size_t)(wr * 64 + fr) * ldc + wc * 32 + 8 * fq;
#pragma unroll
        for (int ai = 0; ai < 2; ++ai)
#pragma unroll
            for (int m = 0; m < 4; ++m) { float* rowp = base + (size_t)(ai * 128 + m * 16) * ldc;
#pragma unroll
                for (int bj = 0; bj < 2; ++bj) { *(f32x4*)(rowp + bj * 128) = acc[ai][bj][m][0]; *(f32x4*)(rowp + bj * 128 + 4) = acc[ai][bj][m][1]; } }
    }
};
template <bool BASE_F32> struct EpiResidT {
    const void* base; bf16* out; int ldc; float* rsq; LAS float* xch;
    __device__ __forceinline__ void operator()(EPI_ARGS) const {
        const size_t o0 = (size_t)u.coff + (size_t)(wr * 64 + fr) * ldc + wc * 32 + 8 * fq;
        u32x4 braw[BASE_F32 ? 1 : 16];
        if (!BASE_F32) {
#pragma unroll
            for (int ai = 0; ai < 2; ++ai)
#pragma unroll
                for (int m = 0; m < 4; ++m)
#pragma unroll
                    for (int bj = 0; bj < 2; ++bj) braw[(ai * 4 + m) * 2 + bj] = *(const u32x4*)((const bf16*)base + o0 + (size_t)(ai * 128 + m * 16) * ldc + bj * 128); }
#pragma unroll
        for (int ai = 0; ai < 2; ++ai)
#pragma unroll
            for (int m = 0; m < 4; ++m) { const size_t o = o0 + (size_t)(ai * 128 + m * 16) * ldc; float ssq = 0.f;
#pragma unroll
                for (int bj = 0; bj < 2; ++bj) { float bv[8];
                    if (BASE_F32) { const f32x4 b0 = *(const f32x4*)((const float*)base + o + bj * 128), b1 = *(const f32x4*)((const float*)base + o + bj * 128 + 4);
                        bv[0] = b0[0]; bv[1] = b0[1]; bv[2] = b0[2]; bv[3] = b0[3]; bv[4] = b1[0]; bv[5] = b1[1]; bv[6] = b1[2]; bv[7] = b1[3]; }
                    else unpack8(braw[BASE_F32 ? 0 : (ai * 4 + m) * 2 + bj], bv);
#pragma unroll
                    for (int j = 0; j < 4; ++j) { bv[j] += acc[ai][bj][m][0][j]; bv[4 + j] += acc[ai][bj][m][1][j]; }
                    const u32x4 w = pack8f(bv); *(u32x4*)(out + o + bj * 128) = w; float rf[8]; unpack8(w, rf);
#pragma unroll
                    for (int j = 0; j < 8; ++j) ssq += rf[j] * rf[j]; }
                ssq += xor16f(ssq); ssq += xor32f(ssq);
                if (fq == 0) xch[(ai * 128 + wr * 64 + m * 16 + fr) * 4 + wc] = ssq; }
        asm volatile("s_waitcnt lgkmcnt(0)" ::: "memory"); __builtin_amdgcn_s_barrier(); asm volatile("" ::: "memory");
        if (wc == 0 && fq == 0) {
#pragma unroll
            for (int ai = 0; ai < 2; ++ai)
#pragma unroll
                for (int m = 0; m < 4; ++m) { const int r = ai * 128 + wr * 64 + m * 16 + fr; const f32x4 p = *(const LAS f32x4*)(xch + r * 4); rsq[(size_t)(u.pm * 256 + r) * 8 + u.pn] = (p[0] + p[1]) + (p[2] + p[3]); } }
    }
};
__device__ __forceinline__ float rstd_of(float ssq) { return rsqrtf(ssq * (1.f / DM) + EPS); }
__device__ __forceinline__ float rstd_row(const float* rs8, int row) { const f32x4 a = *(const f32x4*)(rs8 + (size_t)row * 8), b = *(const f32x4*)(rs8 + (size_t)row * 8 + 4); return rstd_of(((a.x + a.y) + (a.z + a.w)) + ((b.x + b.y) + (b.z + b.w))); }
struct EpiStoreF32Rows {
    float* O; int ldc; const float* rs;
    __device__ __forceinline__ void operator()(EPI_ARGS) const {
        float* base = O + u.coff + (size_t)(wr * 64 + fr) * ldc + wc * 32 + 8 * fq; const int rp = u.pm * 256 + wr * 64 + fr;
#pragma unroll
        for (int ai = 0; ai < 2; ++ai)
#pragma unroll
            for (int m = 0; m < 4; ++m) { float* rowp = base + (size_t)(ai * 128 + m * 16) * ldc; const float r_ = rstd_row(rs, rp + ai * 128 + m * 16);
#pragma unroll
                for (int bj = 0; bj < 2; ++bj) { *(f32x4*)(rowp + bj * 128) = acc[ai][bj][m][0] * r_; *(f32x4*)(rowp + bj * 128 + 4) = acc[ai][bj][m][1] * r_; } }
    }
};
struct EpiSoftmaxP {
    bf16* P; int ldc; const float* rs; LAS float* xch;
    __device__ __forceinline__ void operator()(f32x4 (&acc)[2][2][4][2], const pg8::Unit& u, int wr, int wc, int fr, int fq) const {
#pragma unroll
        for (int ai = 0; ai < 2; ++ai)
#pragma unroll
            for (int m = 0; m < 4; ++m) { const int r = ai * 128 + wr * 64 + m * 16 + fr; const float r_ = rstd_row(rs, u.pm * 256 + r); float mx = -INFINITY;
#pragma unroll
                for (int bj = 0; bj < 2; ++bj)
#pragma unroll
                    for (int n = 0; n < 2; ++n) { acc[ai][bj][m][n] = acc[ai][bj][m][n] * r_;
#pragma unroll
                        for (int j = 0; j < 4; ++j) mx = fmaxf(mx, acc[ai][bj][m][n][j]); }
                mx = fmaxf(mx, xor16f(mx)); mx = fmaxf(mx, xor32f(mx)); if (fq == 0) xch[r * 4 + wc] = mx; }
        asm volatile("s_waitcnt lgkmcnt(0)" ::: "memory"); __builtin_amdgcn_s_barrier(); asm volatile("" ::: "memory");
#pragma unroll
        for (int ai = 0; ai < 2; ++ai)
#pragma unroll
            for (int m = 0; m < 4; ++m) { const int r = ai * 128 + wr * 64 + m * 16 + fr; const f32x4 mv = *(const LAS f32x4*)(xch + r * 4); const float mx = fmaxf(fmaxf(mv[0], mv[1]), fmaxf(mv[2], mv[3])); float sm_ = 0.f;
#pragma unroll
                for (int bj = 0; bj < 2; ++bj)
#pragma unroll
                    for (int n = 0; n < 2; ++n)
#pragma unroll
                        for (int j = 0; j < 4; ++j) { const float e = __expf(acc[ai][bj][m][n][j] - mx); acc[ai][bj][m][n][j] = e; sm_ += e; }
                sm_ += xor16f(sm_); sm_ += xor32f(sm_); if (fq == 0) xch[1024 + r * 4 + wc] = sm_; }
        asm volatile("s_waitcnt lgkmcnt(0)" ::: "memory"); __builtin_amdgcn_s_barrier(); asm volatile("" ::: "memory");
        bf16* base = P + u.coff + (size_t)(wr * 64 + fr) * ldc + wc * 32 + 8 * fq;
#pragma unroll
        for (int ai = 0; ai < 2; ++ai)
#pragma unroll
            for (int m = 0; m < 4; ++m) { const int r = ai * 128 + wr * 64 + m * 16 + fr; const f32x4 sv = *(const LAS f32x4*)(xch + 1024 + r * 4); const float inv = 1.f / ((sv[0] + sv[1]) + (sv[2] + sv[3]));
                bf16* rowp = base + (size_t)(ai * 128 + m * 16) * ldc;
#pragma unroll
                for (int bj = 0; bj < 2; ++bj) { const f32x4 v0 = acc[ai][bj][m][0] * inv, v1 = acc[ai][bj][m][1] * inv;
                    u32x4 w; w.x = pg8::cvt_pk_bf16(v0[0], v0[1]); w.y = pg8::cvt_pk_bf16(v0[2], v0[3]); w.z = pg8::cvt_pk_bf16(v1[0], v1[1]); w.w = pg8::cvt_pk_bf16(v1[2], v1[3]);
                    *(u32x4*)(rowp + bj * 128) = w; } }
    }
};
struct EpiAbIn {
    bf16* P; float* G32;
    __device__ __forceinline__ void operator()(EPI_ARGS) const {
        const int row0 = u.pm * 256 + wr * 64 + fr, col0 = u.pn * 256 + wc * 32 + 8 * fq;
#pragma unroll
        for (int ai = 0; ai < 2; ++ai)
#pragma unroll
            for (int m = 0; m < 4; ++m) { const int row = row0 + ai * 128 + m * 16; bf16* rowp = P + (size_t)row * AB_PAD + col0;
#pragma unroll
                for (int bj = 0; bj < 2; ++bj) { const f32x4 v0 = acc[ai][bj][m][0], v1 = acc[ai][bj][m][1];
                    u32x4 w; w.x = pg8::cvt_pk_bf16(v0[0], v0[1]); w.y = pg8::cvt_pk_bf16(v0[2], v0[3]); w.z = pg8::cvt_pk_bf16(v1[0], v1[1]); w.w = pg8::cvt_pk_bf16(v1[2], v1[3]);
                    *(u32x4*)(rowp + bj * 128) = w;
                    if (u.pn == 12) { float* g = G32 + (size_t)row * 256 + wc * 32 + 8 * fq + bj * 128; *(f32x4*)g = v0; *(f32x4*)(g + 4) = v1; } } }
    }
};
struct EpiLora {
    const float *w0, *a0, *k_a; const bf16 *KK, *KR; float* WD; bf16 *BV, *KP, *GG;
    __device__ __forceinline__ void operator()(EPI_ARGS) const {
        const int grp = u.pn >> 2, row0 = u.pm * 256 + wr * 64 + fr, cc0 = (u.pn & 3) * 256 + wc * 32 + 8 * fq;
#pragma unroll
        for (int ai = 0; ai < 2; ++ai)
#pragma unroll
            for (int m = 0; m < 4; ++m) { const size_t ro = (size_t)(row0 + ai * 128 + m * 16) * 1024;
#pragma unroll
                for (int bj = 0; bj < 2; ++bj) { const int cc = cc0 + bj * 128; float v[8];
#pragma unroll
                    for (int j = 0; j < 4; ++j) { v[j] = acc[ai][bj][m][0][j]; v[4 + j] = acc[ai][bj][m][1][j]; }
                    if (grp == 0) { float o[8]; const f32x4 p0 = *(const f32x4*)(w0 + cc), p1 = *(const f32x4*)(w0 + cc + 4); const float pw[8] = {p0.x, p0.y, p0.z, p0.w, p1.x, p1.y, p1.z, p1.w};
#pragma unroll
                        for (int j = 0; j < 8; ++j) o[j] = -0.6065306597126334f * sigmoidf_(pw[j] + v[j]);
                        *(f32x4*)(WD + ro + cc) = (f32x4){o[0], o[1], o[2], o[3]}; *(f32x4*)(WD + ro + cc + 4) = (f32x4){o[4], o[5], o[6], o[7]};
                    } else if (grp == 1) { float kk[8], kr[8], ob[8], ok[8];
                        unpack8(*(const u32x4*)(KK + ro + cc), kk); unpack8(*(const u32x4*)(KR + ro + cc), kr);
                        const f32x4 p0 = *(const f32x4*)(a0 + cc), p1 = *(const f32x4*)(a0 + cc + 4), q0 = *(const f32x4*)(k_a + cc), q1 = *(const f32x4*)(k_a + cc + 4);
                        const float pa[8] = {p0.x, p0.y, p0.z, p0.w, p1.x, p1.y, p1.z, p1.w}, qa[8] = {q0.x, q0.y, q0.z, q0.w, q1.x, q1.y, q1.z, q1.w};
#pragma unroll
                        for (int j = 0; j < 8; ++j) { const float a = sigmoidf_(pa[j] + v[j]); ob[j] = kk[j] * a; ok[j] = kr[j] * (1.f + (a - 1.f) * qa[j]); }
                        st16_f(BV + ro + cc, pack8f(ob)); st16_f(KP + ro + cc, pack8f(ok));
                    } else { st16_f(GG + ro + cc, pack8f(v)); } } }
    }
};
struct EpiHid {
    bf16* H; const int* rowslot; const float* rs;
    __device__ __forceinline__ void operator()(EPI_ARGS) const {
        bf16* base = H + (size_t)(u.aux + wr * 64 + fr) * FF + u.pn * 128 + wc * 32 + 8 * fq;
#pragma unroll
        for (int ai = 0; ai < 2; ++ai)
#pragma unroll
            for (int m = 0; m < 4; ++m) { float h[8]; const int r = ai * 128 + wr * 64 + m * 16 + fr; const float r_ = (r < u.pm) ? rstd_row(rs, rowslot[u.aux + r] >> 1) : 0.f;
#pragma unroll
                for (int j = 0; j < 4; ++j) { h[j] = siluf_(acc[ai][0][m][0][j] * r_) * (acc[ai][1][m][0][j] * r_); h[4 + j] = siluf_(acc[ai][0][m][1][j] * r_) * (acc[ai][1][m][1][j] * r_); }
                *(u32x4*)(base + (size_t)(ai * 128 + m * 16) * FF) = pack8f(h); }
    }
};
struct EpiMoeDown {
    const int* rowslot; const float* wts; bf16* YE;
    __device__ __forceinline__ void operator()(EPI_ARGS) const {
#pragma unroll
        for (int ai = 0; ai < 2; ++ai)
#pragma unroll
            for (int m = 0; m < 4; ++m) { const int r = ai * 128 + wr * 64 + m * 16 + fr;
                if (r < u.pm) { const int slot = rowslot[u.aux + r]; const float w = wts[slot]; bf16* rowp = YE + (size_t)slot * DM + u.pn * 256 + wc * 32 + 8 * fq;
#pragma unroll
                    for (int bj = 0; bj < 2; ++bj) { const f32x4 v0 = acc[ai][bj][m][0] * w, v1 = acc[ai][bj][m][1] * w;
                        u32x4 o; o.x = pg8::cvt_pk_bf16(v0[0], v0[1]); o.y = pg8::cvt_pk_bf16(v0[2], v0[3]); o.z = pg8::cvt_pk_bf16(v1[0], v1[1]); o.w = pg8::cvt_pk_bf16(v1[2], v1[3]);
                        *(u32x4*)(rowp + bj * 128) = o; } } }
    }
};
struct EpiNsaIn {
    bf16 *Q, *QROT, *KV6; float* GATES; const float *gate_b, *rcos, *rsin, *rs;
    __device__ __forceinline__ void operator()(EPI_ARGS) const {
        const int pn = u.pn;
#pragma unroll
        for (int ai = 0; ai < 2; ++ai)
#pragma unroll
            for (int m = 0; m < 4; ++m) { const int t = u.pm * 256 + ai * 128 + wr * 64 + m * 16 + fr, b = t >> 12, s = t & 4095; const float r_ = rstd_row(rs, t);
#pragma unroll
                for (int bj = 0; bj < 2; ++bj) { float v[8];
#pragma unroll
                    for (int j = 0; j < 4; ++j) { v[j] = acc[ai][bj][m][0][j] * r_; v[4 + j] = acc[ai][bj][m][1][j] * r_; }
                    const int d0 = wc * 32 + 8 * fq;
                    if (pn == 20) {
                        const int c = bj * 128 + d0;
                        if (c < 48) { float o[8];
#pragma unroll
                            for (int j = 0; j < 8; ++j) o[j] = sigmoidf_(v[j] + gate_b[c + j]);
                            float* g = GATES + (size_t)t * 48 + c; *(f32x4*)g = (f32x4){o[0], o[1], o[2], o[3]}; *(f32x4*)(g + 4) = (f32x4){o[4], o[5], o[6], o[7]}; }
                        continue; }
                    float vr[8];
#pragma unroll
                    for (int j = 0; j < 8; ++j) vr[j] = v[j];
                    if (wc == 0) { float pv[8];
#pragma unroll
                      for (int j = 0; j < 8; ++j) pv[j] = xor32f(v[j]);
                      const f32x4 c0 = *(const f32x4*)(rcos + s * 16 + 8 * (fq & 1)), c1 = *(const f32x4*)(rcos + s * 16 + 8 * (fq & 1) + 4), s0 = *(const f32x4*)(rsin + s * 16 + 8 * (fq & 1)), s1 = *(const f32x4*)(rsin + s * 16 + 8 * (fq & 1) + 4);
                      const float cs[8] = {c0.x, c0.y, c0.z, c0.w, c1.x, c1.y, c1.z, c1.w}, sn[8] = {s0.x, s0.y, s0.z, s0.w, s1.x, s1.y, s1.z, s1.w};
#pragma unroll
                      for (int j = 0; j < 8; ++j) vr[j] = (fq < 2) ? (v[j] * cs[j] - pv[j] * sn[j]) : (v[j] * cs[j] + pv[j] * sn[j]); }
                    if (pn < 8) { const int hh = pn * 2 + bj; const size_t o = (((size_t)(b * 16 + hh)) * SEQ + s) * 128 + d0;
                        *(u32x4*)(Q + o) = pack8f(v); *(u32x4*)(QROT + o) = pack8f(vr);
                    } else { const int i6 = (pn - 8) >> 1, g = ((pn - 8) & 1) * 2 + bj; const bool rot = (i6 == 2 || i6 == 4) && wc == 0;
                        bf16* dst = (bf16*)((unsigned char*)KV6 + (size_t)i6 * KV6_STRIDE) + (((size_t)(b * 4 + g)) * SPAD + s) * 128 + d0;
                        *(u32x4*)dst = rot ? pack8f(vr) : pack8f(v); } } }
    }
};

constexpr int MOE_CVT_TOTAL = 2 * NEXP * 3 * 512, MOE_CVT_SIDE_A = 0, MOE_CVT_SIDE_B = 28000, MOE_CVT_WG = 32, MOE_CVT_SIDE_C = 4096 * 8 * 2, MOE_CVT_SIDE_F = 1024 * 8 * 2, MOE_CVT_SIDE_G = 0  , MOE_CVT_SIDE_E = 2048 * 8 * 2, MOE_CVT_SIDE_H2 = 13000  , MOE_CVT_SIDE_H = 22000  ;
#define MOE_CVT_PROLOGUE_END(G_) ((G_) == 256 ? MOE_CVT_TOTAL - MOE_CVT_SIDE_A - MOE_CVT_SIDE_B - MOE_CVT_SIDE_C - MOE_CVT_SIDE_F - MOE_CVT_SIDE_G - MOE_CVT_SIDE_E - MOE_CVT_SIDE_H - MOE_CVT_SIDE_H2 : MOE_CVT_TOTAL)
#define MOE_CVT_BASE_C MOE_CVT_PROLOGUE_END(256)
#define MOE_CVT_BASE_F (MOE_CVT_BASE_C + MOE_CVT_SIDE_C)
#define MOE_CVT_BASE_G (MOE_CVT_BASE_F + MOE_CVT_SIDE_F)
#define MOE_CVT_BASE_E (MOE_CVT_BASE_G + MOE_CVT_SIDE_G)
#define MOE_CVT_BASE_H (MOE_CVT_BASE_E + MOE_CVT_SIDE_E)
#define MOE_CVT_BASE_H2 (MOE_CVT_BASE_H + MOE_CVT_SIDE_H)
static_assert(MOE_CVT_BASE_E >= MOE_CVT_TOTAL / 2 && MOE_CVT_BASE_H2 + MOE_CVT_SIDE_H2 + MOE_CVT_SIDE_A + MOE_CVT_SIDE_B == MOE_CVT_TOTAL && MOE_CVT_SIDE_H % 2 == 0 && MOE_CVT_SIDE_H2 % 2 == 0 && MOE_CVT_BASE_C % 2 == 0, "MoE conversion item ranges");
__device__ __forceinline__ void moe_convert_pair(const Ctx& C, int it, int lane) {
    auto ident = [](int n) { return n; };
    auto dg = [](int n) { return (n >> 7) * 256 + (n & 127); };
    auto du = [](int n) { return (n >> 7) * 256 + 128 + (n & 127); };
    const int per = 512;
    const int le = it / (3 * per), r = it % (3 * per), which = r / per, q = r % per;
    if (which == 0) { const int kb = q / 16, nb = q % 16; transpose_tiles<2>(INP(I_MOE_W_GATE) + (size_t)le * DM * FF, FF, FF, kb * 64, nb * 32, WSP(bf16, WS_W_GU) + (size_t)le * 1024 * DM, DM, dg, lane, INP(I_NORM_FFN) + (le >> 6) * DM); }
    else if (which == 1) { const int kb = q / 16, nb = q % 16; transpose_tiles<2>(INP(I_MOE_W_UP) + (size_t)le * DM * FF, FF, FF, kb * 64, nb * 32, WSP(bf16, WS_W_GU) + (size_t)le * 1024 * DM, DM, du, lane, INP(I_NORM_FFN) + (le >> 6) * DM); }
    else { const int kb = q / 64, nb = q % 64; transpose_tiles<2>(INP(I_MOE_W_DOWN) + (size_t)le * FF * DM, DM, DM, kb * 64, nb * 32, WSP(bf16, WS_W_DN) + (size_t)le * DM * FF, FF, ident, lane, nullptr); }
}
struct MoeTile { const float* W; bf16* WT; const float* ks; int ldw, ldt, k0, n0, mode; };
__device__ __forceinline__ MoeTile moe_tile_decode(const Ctx& C, int it) {
    const int per = 512, le = it / (3 * per), r = it % (3 * per), which = r / per, q = r % per; MoeTile t; t.mode = which;
    if (which < 2) { t.W = INP(which ? I_MOE_W_UP : I_MOE_W_GATE) + (size_t)le * DM * FF; t.ldw = FF; t.k0 = (q / 16) * 64; t.n0 = (q % 16) * 32; t.WT = WSP(bf16, WS_W_GU) + (size_t)le * 1024 * DM; t.ldt = DM; t.ks = INP(I_NORM_FFN) + (le >> 6) * DM; }
    else { t.W = INP(I_MOE_W_DOWN) + (size_t)le * FF * DM; t.ldw = DM; t.k0 = (q / 64) * 64; t.n0 = (q % 64) * 32; t.WT = WSP(bf16, WS_W_DN) + (size_t)le * DM * FF; t.ldt = FF; t.ks = nullptr; }
    return t;
}
__device__ __forceinline__ void moe_pair_load(const MoeTile& t, f32x4 (&v)[2][8], int lane) {
    const int g = lane >> 3, c = lane & 7;
#pragma unroll
    for (int q = 0; q < 2; ++q)
#pragma unroll
        for (int j = 0; j < 8; ++j) v[q][j] = __builtin_nontemporal_load((const f32x4*)(t.W + (size_t)(t.k0 + 8 * g + j) * t.ldw + t.n0 + 32 * q + 4 * c));
}
__device__ __forceinline__ void moe_pair_store(const MoeTile& t, const f32x4 (&v)[2][8], int lane) {
    const int g = lane >> 3, c = lane & 7; f32x4 ka = (f32x4){1.f, 1.f, 1.f, 1.f}, kb = ka;
    if (t.ks) { ka = *(const f32x4*)(t.ks + t.k0 + 8 * g); kb = *(const f32x4*)(t.ks + t.k0 + 8 * g + 4); }
#pragma unroll
    for (int q = 0; q < 2; ++q)
#pragma unroll
        for (int i = 0; i < 4; ++i) { const int nn = t.n0 + 32 * q + 4 * c + i, dr = (t.mode == 2) ? nn : ((nn >> 7) * 256 + (t.mode == 1 ? 128 : 0) + (nn & 127));
            u32x4 o; o.x = pk2(v[q][0][i] * ka.x, v[q][1][i] * ka.y); o.y = pk2(v[q][2][i] * ka.z, v[q][3][i] * ka.w); o.z = pk2(v[q][4][i] * kb.x, v[q][5][i] * kb.y); o.w = pk2(v[q][6][i] * kb.z, v[q][7][i] * kb.w);
            __builtin_nontemporal_store(o, (u32x4*)(t.WT + (size_t)dr * t.ldt + t.k0 + 8 * g)); }
}
__device__ __forceinline__ void moe_convert_items(const Ctx& C, int lo, int hi, int widx, int nworkers) {
    for (int it = lo + 2 * widx; it < hi; it += 2 * nworkers) moe_convert_pair(C, it, C.lane);
}
__device__ __forceinline__ void moe_convert_items_x2(const Ctx& C, int lo, int hi, int widx, int nworkers) {
    int it = lo + 2 * widx; const int st = 2 * nworkers;
    for (; it + st < hi; it += 2 * st) {
        f32x4 va[2][8], vb[2][8]; const MoeTile ta = moe_tile_decode(C, it), tb = moe_tile_decode(C, it + st);
        moe_pair_load(ta, va, C.lane); moe_pair_load(tb, vb, C.lane);
        moe_pair_store(ta, va, C.lane); moe_pair_store(tb, vb, C.lane);
    }
    for (; it < hi; it += st) moe_convert_pair(C, it, C.lane);
}
__device__ __forceinline__ void phase_prologue(const Ctx& C, const Args& A) {
    LAS float* scr = (LAS float*)(C.lds + C.wave * 8448);
    auto ident = [](int n) { return n; };
    transpose_matrix(C, INP(I_AB_W_IN), DM, AB_COLS, AB_PAD, WSP(bf16, WS_W_ABIN), DM, ident, scr);
    transpose_matrix(C, INP(I_AB_W_OUT), DM, DM, DM, WSP(bf16, WS_W_ABOUT), DM, ident, scr);
    transpose_matrix(C, INP(I_NSA_W_IN), DM, NSA_COLS, NSA_PAD, WSP(bf16, WS_W_NSAIN), DM, ident, scr, INP(I_NORM_MIX) + DM);
    transpose_matrix(C, INP(I_NSA_W_OUT), DM, DM, DM, WSP(bf16, WS_W_NSAOUT), DM, ident, scr);
    for (int l = 0; l < 2; ++l) {
        transpose_matrix(C, INP(I_CA_WK) + (size_t)l * DM * DM, DM, DM, DM, WSP(bf16, WS_W_CAK) + (size_t)l * DM * DM, DM, ident, scr);
        transpose_matrix(C, INP(I_CA_WV) + (size_t)l * DM * DM, DM, DM, DM, WSP(bf16, WS_W_CAV) + (size_t)l * DM * DM, DM, ident, scr);
        transpose_matrix(C, INP(I_CA_WO) + (size_t)l * DM * DM, DM, DM, DM, WSP(bf16, WS_W_CAO) + (size_t)l * DM * DM, DM, ident, scr);
    }
    for (int kv = 0; kv < 2; ++kv)
        transpose_matrix(C, INP(I_CMP_W1) + (size_t)kv * 4096 * 128, 4096, 128, 128, WSP(bf16, WS_W_CMP1) + (size_t)kv * 256 * 4096, 4096, ident, scr);
    moe_convert_items(C, 0, MOE_CVT_PROLOGUE_END(C.G), C.gw, C.ngw);
    const size_t gt = (size_t)C.bid * NTHR + C.tid, gn = (size_t)C.G * NTHR;
    { const float* src = INP(I_CA_WQ); bf16* dst = WSP(bf16, WS_W_CAQ);
      const float* gc = INP(I_NORM_CROSS);
      for (size_t i = gt; i < (size_t)2 * DM * DM / 4; i += gn) { const f32x4 v = *(const f32x4*)(src + i * 4); const float gq = gc[(i * 4) / DM]; u32x2 w; w.x = pk2(v.x * gq, v.y * gq); w.y = pk2(v.z * gq, v.w * gq); *(u32x2*)(dst + i * 4) = w; } }
    { bf16* dst = WSP(bf16, WS_W_LORA);
      for (size_t i = gt; i < (size_t)3072 * 256; i += gn) { const int n = (int)(i >> 8), k = (int)(i & 255); float v = 0.f;
          if (n < 1024) { if (k < 64) v = INP(I_RW_W_UP)[k * 1024 + n]; }
          else if (n < 2048) { if (k >= 64 && k < 128) v = INP(I_RW_A_UP)[(k - 64) * 1024 + (n - 1024)]; }
          else { if (k >= 128) v = INP(I_RW_G_UP)[(k - 128) * 1024 + (n - 2048)]; }
          dst[i] = (bf16)f2bf(v); } }
    { bf16* dst = WSP(bf16, WS_W_ROUTER);
      for (size_t i = gt; i < (size_t)2 * 256 * DM; i += gn) { const int l = (int)(i / (256 * DM)), n = (int)((i / DM) & 255), k = (int)(i % DM); float v = 0.f;
          if (n < 8) v = INP(I_MOE_WG)[((size_t)l * DM + k) * 8 + n]; else if (n < 72) v = INP(I_MOE_WE)[((size_t)l * DM + k) * 64 + (n - 8)];
          v *= INP(I_NORM_FFN)[l * DM + k];
          dst[i] = (bf16)f2bf(v); } }
    { float* rc = WSP(float, WS_TAB + TAB_ROPE_COS); float* rs = WSP(float, WS_TAB + TAB_ROPE_SIN);
      for (size_t i = gt; i < (size_t)SEQ * 16; i += gn) { const int pos = (int)(i >> 4), j = (int)(i & 15);
          const float inv = 1.0f / powf(500000.0f, (float)j / 16.0f); const float ang = (float)pos * inv; rc[i] = cosf(ang); rs[i] = sinf(ang); } }
    for (int o = C.gw; o < 256; o += C.ngw) { const int kv = o >> 7, e = o & 127; float s = 0.f;
        for (int i = C.lane; i < 4096; i += 64) s += INP(I_CMP_POS)[kv * 4096 + i] * INP(I_CMP_W1)[((size_t)kv * 4096 + i) * 128 + e];
        s = wave_sum(s); if (C.lane == 0) WSP(float, WS_TAB + TAB_CMPBIAS)[o] = s; }
    for (int r = C.gw; r < 2 * MT; r += C.ngw) { const int l = r / MT, m = r % MT;
        rms_row_bf16(INP(I_MEM) + (size_t)m * DM, INP(I_NORM_MEM) + l * DM, WSP(bf16, WS_MEMN) + ((size_t)l * MT + m) * DM, C.lane); }
    for (int r = C.gw; r < T; r += C.ngw) rms_row_bf16(INP(I_X) + (size_t)r * DM, INP(I_NORM_MIX), WSP(bf16, WS_XN) + (size_t)r * DM, C.lane);
}

struct MemProjOrder {
    int G, c;
    __device__ __forceinline__ bool next(int i, pg8::Unit& u) const {
        const int L = i * G + c; if (L >= 128) return false;
        const int pn = L & 7, pm = (L >> 3) & 3, kv = (L >> 5) & 1, l = L >> 6;
        u.pm = pm; u.pn = pn; u.aux = 0;
        u.aoff = ((long long)l * MT + pm * 256) * DM * 2;
        u.boff = ((long long)(kv ? (WS_W_CAV - WS_W_CAK) / 2 : 0) + ((long long)l * DM + pn * 256) * DM) * 2;
        u.coff = (long long)(kv ? (WS_VP - WS_KP) / 2 : 0) + ((long long)l * MT + pm * 256) * DM + pn * 256;
        return true;
    }
};
struct AbInMemOrder {
    pg8::DenseOrder d; MemProjOrder m;
    __device__ __forceinline__ bool next(int i, pg8::Unit& u) const {
        const long L = (long)i * d.G + d.c;
        if (L < (T / 256) * (AB_PAD / 256)) { int pm, pn; pg8::tile_of(L, d.nM, d.nN, pm, pn); u.pm = pm; u.pn = pn; u.aux = 0; u.aoff = (long long)WS_XN + pm * d.astep; u.boff = (long long)WS_W_ABIN + pn * d.bstep; u.coff = 0; return true; }
        pg8::Unit t; MemProjOrder mm{1 << 30, (int)(L - (T / 256) * (AB_PAD / 256))}; if (!mm.next(0, t)) return false;
        u = t; u.aux = 1; u.aoff += (long long)WS_MEMN; u.boff += (long long)WS_W_CAK; return true;
    }
};
struct EpiAbInMem { EpiAbIn a; EpiStoreBf16 m;
    __device__ __forceinline__ void operator()(EPI_ARGS) const { if (u.aux == 0) a(acc, u, wr, wc, fr, fq); else m(acc, u, wr, wc, fr, fq); } };
struct RouterOrder {
    int G, c;
    __device__ __forceinline__ bool next(int i, pg8::Unit& u) const {
        const int L = i * G + c; if (L >= 256) return false;
        const int pm = L & 63, ks = L >> 6; u.pm = pm; u.pn = 0; u.aux = ks;
        u.aoff = ((long long)pm * 256 * DM + ks * 512) * 2; u.boff = (long long)ks * 512 * 2; u.coff = ((long long)ks * T + pm * 256) * 256; return true;
    }
};
struct WktOrder {
    int G, c;
    __device__ __forceinline__ bool next(int i, pg8::Unit& u) const {
        const int L = i * G + c; if (L >= 256) return false;
        const int pn = L & 7, h = (L >> 3) & 3, b = (L >> 5) & 3, l = L >> 7;
        u.pm = 0; u.pn = pn; u.aux = 0;
        u.aoff = (((long long)l * MT + b * 256) * DM + h * 512) * 2;
        u.boff = (((long long)l * DM + pn * 256) * DM + h * 512) * 2;
        u.coff = (((long long)(l * 4 + b) * 1024) + h * 256) * DM + pn * 256;
        return true;
    }
};
struct VwtOrder {
    int G, c;
    __device__ __forceinline__ bool next(int i, pg8::Unit& u) const {
        const int L = i * G + c; if (L >= 256) return false;
        const int pm = L & 7, h = (L >> 3) & 3, b = (L >> 5) & 3, l = L >> 7;
        u.pm = pm; u.pn = 0; u.aux = 0;
        u.aoff = (((long long)l * DM + pm * 256) * DM + h * 512) * 2;
        u.boff = (((long long)l * MT + b * 256) * DM + h * 512) * 2;
        u.coff = (((long long)(l * 4 + b) * DM) + pm * 256) * 1024 + h * 256;
        return true;
    }
};
struct CrossOrder {
    int nN, G, c, ldc; long long astep, bstep, bbatch;
    __device__ __forceinline__ bool next(int i, pg8::Unit& u) const {
        int pm, pn; if (!pg8::tile_of((long)i * G + c, T / 256, nN, pm, pn)) return false;
        u.pm = pm; u.pn = pn; u.aux = 0; u.aoff = pm * astep; u.boff = (pm >> 4) * bbatch + pn * bstep; u.coff = (long long)pm * 256 * ldc + pn * 256; return true;
    }
};
struct CmpOrder {
    int G, c;
    __device__ __forceinline__ bool next(int i, pg8::Unit& u) const {
        const int L = i * G + c; if (L >= 256) return false;
        const int bg = L & 15, kv = (L >> 4) & 1, ks = L >> 5;
        u.pm = 0; u.pn = 0; u.aux = 0;
        u.aoff = (long long)kv * KV6_STRIDE + ((long long)bg * SPAD * 128 + ks * 512) * 2;
        u.boff = ((long long)kv * 256 * 4096 + ks * 512) * 2;
        u.coff = ((long long)(ks * 2 + kv) * 16 + bg) * 65536;
        return true;
    }
};
struct MoeOrder {
    const LAS int* tab; int npn, G, c, which;
    __device__ __forceinline__ bool next(int i, pg8::Unit& u) const {
        const int L = i * G + c, ntile = tab[64]; if (L >= ntile * npn) return false;
        const int tix = L / npn, pn = L % npn; int e = 0;
        for (int k = 32; k >= 1; k >>= 1) if (e + k < 64 && tab[e + k] <= tix) e += k;
        while (tab[e + 1] <= tix) ++e;
        const int mt = tix - tab[e], cnt = tab[65 + e], row0 = tab[129 + e] + mt * 256;
        u.pm = min(256, cnt - mt * 256); u.pn = pn; u.aux = row0;
        if (which == 0) { u.aoff = 0; u.boff = ((long long)e * 1024 + pn * 256) * DM * 2; }
        else { u.aoff = (long long)row0 * FF * 2; u.boff = ((long long)e * DM + pn * 256) * FF * 2; }
        u.coff = 0; return true;
    }
};
__device__ __forceinline__ void moe_build_table(const Ctx& C, const unsigned* cnt, LAS int* tab) {
    if (C.tid == 0) { int ts = 0, off = 0;
        for (int e = 0; e < 64; ++e) { const int n = (int)cnt[e]; tab[e] = ts; tab[65 + e] = n; tab[129 + e] = off; const int nt = (n + 255) >> 8; ts += nt; off += nt * 256; }
        tab[64] = ts; }
    __syncthreads();
}

__device__ __forceinline__ float log_sigmoidf_(float x) { return fminf(x, 0.f) - log1pf(__expf(-fabsf(x))); }
__device__ __forceinline__ void phase_mixer_prep(const Ctx& C, const Args& A) {
    const bf16* PAB = ARP(bf16, A_PAB); const float* G32 = ARP(float, A_GF32);
    bf16 *QM = ARP(bf16, A_QM), *KM = ARP(bf16, A_KM), *RR = ARP(bf16, A_RR), *KR = ARP(bf16, A_KR), *VR = ARP(bf16, A_VR), *KK = ARP(bf16, A_KK), *LIN = ARP(bf16, A_LIN);
    float *IG = ARP(float, A_IG), *LF = ARP(float, A_LF);
    const float *cw = INP(I_ML_CONV_W), *cb = INP(I_ML_CONV_B), *gb = INP(I_ML_GATE_B), *mu = INP(I_RW_MU), *k_k = INP(I_RW_K_K);
    const int lane = C.lane;
    for (int t = C.gw; t < T; t += C.ngw) {
        const int b = t >> 12, s = t & 4095; const bf16* P = PAB + (size_t)t * AB_PAD; const bf16* PR = P + ML_COLS;
        u32x4 cx[2][4], pc[7], pq[7]; const u32x4 z4 = (u32x4){0u, 0u, 0u, 0u};
#pragma unroll
        for (int it = 0; it < 2; ++it)
#pragma unroll
            for (int tap = 0; tap < 4; ++tap) { const int back = 3 - tap; cx[it][tap] = z4; if (s >= back) cx[it][tap] = *(const u32x4*)(P - (size_t)back * AB_PAD + (lane + 64 * it) * 8); }
#pragma unroll
        for (int it = 0; it < 7; ++it) { const int chunk = lane + 64 * it; pc[it] = z4; pq[it] = z4;
            if (chunk < 416) { pc[it] = *(const u32x4*)(PR + chunk * 8); if (s > 0) pq[it] = *(const u32x4*)(PR - AB_PAD + chunk * 8); } }
#pragma unroll
        for (int it = 0; it < 2; ++it) { const int c = (lane + 64 * it) * 8; float y[8];
            { const f32x4 b0 = *(const f32x4*)(cb + c), b1 = *(const f32x4*)(cb + c + 4); y[0] = b0.x; y[1] = b0.y; y[2] = b0.z; y[3] = b0.w; y[4] = b1.x; y[5] = b1.y; y[6] = b1.z; y[7] = b1.w; }
#pragma unroll
            for (int tap = 0; tap < 4; ++tap) { float xv[8]; unpack8(cx[it][tap], xv);
                const f32x4 w0 = *(const f32x4*)(cw + tap * 1024 + c), w1 = *(const f32x4*)(cw + tap * 1024 + c + 4);
                y[0] += xv[0] * w0.x; y[1] += xv[1] * w0.y; y[2] += xv[2] * w0.z; y[3] += xv[3] * w0.w; y[4] += xv[4] * w1.x; y[5] += xv[5] * w1.y; y[6] += xv[6] * w1.z; y[7] += xv[7] * w1.w; }
#pragma unroll
            for (int j = 0; j < 8; ++j) y[j] = siluf_(y[j]);
            if (c < 512) *(u32x4*)(QM + (size_t)t * 512 + c) = pack8f(y); else *(u32x4*)(KM + (size_t)t * 512 + c - 512) = pack8f(y); }
        if (lane < 8) { const float g = G32[(size_t)t * 256 + lane] + gb[lane];
            if (lane < 4) IG[(size_t)(b * 4 + lane) * SEQ + s] = g; else LF[(size_t)(b * 4 + lane - 4) * SEQ + s] = log_sigmoidf_(g); }
#pragma unroll
        for (int it = 0; it < 7; ++it) { const int chunk = lane + 64 * it; if (chunk >= 416) break; const int cc = chunk * 8;
            float p[8], pp[8], mx[8]; unpack8(pc[it], p); unpack8(pq[it], pp);
            { const f32x4 m0 = *(const f32x4*)(mu + cc), m1 = *(const f32x4*)(mu + cc + 4); const float mf[8] = {m0.x, m0.y, m0.z, m0.w, m1.x, m1.y, m1.z, m1.w};
#pragma unroll
              for (int j = 0; j < 8; ++j) mx[j] = p[j] + (pp[j] - p[j]) * mf[j]; }
            if (it < 2) *(u32x4*)(RR + (size_t)t * 1024 + cc) = pack8f(mx);
            else if (it < 4) { const int ck = cc - 1024; *(u32x4*)(KR + (size_t)t * 1024 + ck) = pack8f(mx);
                float kk[8], ss = 0.f; const f32x4 q0 = *(const f32x4*)(k_k + ck), q1 = *(const f32x4*)(k_k + ck + 4); const float kf[8] = {q0.x, q0.y, q0.z, q0.w, q1.x, q1.y, q1.z, q1.w};
#pragma unroll
                for (int j = 0; j < 8; ++j) { kk[j] = mx[j] * kf[j]; ss += kk[j] * kk[j]; }
                ss += DPPF(ss, DPP_XOR1); ss += DPPF(ss, DPP_XOR2); ss += DPPF(ss, DPP_HMIRROR);
                const float rn = rsqrtf(ss + 1e-12f);
#pragma unroll
                for (int j = 0; j < 8; ++j) kk[j] *= rn;
                *(u32x4*)(KK + (size_t)t * 1024 + ck) = pack8f(kk); }
            else if (it < 6) *(u32x4*)(VR + (size_t)t * 1024 + cc - 2048) = pack8f(mx);
            else { float o[8];
#pragma unroll
                for (int j = 0; j < 8; ++j) o[j] = (lane < 8) ? tanhf(mx[j]) : ((lane < 16) ? mx[j] : sigmoidf_(mx[j]));
                *(u32x4*)(LIN + (size_t)t * 256 + lane * 8) = pack8f(o); } }
    }
}

__device__ __forceinline__ void rwkv_scan_unit(const Ctx& C, const Args& A, int bh) {
    const int b = bh >> 4, h = bh & 15, w = C.wave, lane = C.lane, tid = C.tid;
    LAS float* IN = (LAS float*)C.lds;
    LAS float* PART = IN + 2 * 6 * 1024;
    LAS float* YP = PART + 2 * 8 * 64;
    const float* WD = ARP(float, A_WD); const bf16 *KKg = ARP(bf16, A_KK), *BV = ARP(bf16, A_BV), *KP = ARP(bf16, A_KP), *RR = ARP(bf16, A_RR), *VR = ARP(bf16, A_VR), *GG = ARP(bf16, A_GG);
    bf16* YCAT = ARP(bf16, A_YCAT);
    const float *r_k = INP(I_RW_R_K), *ln_w = INP(I_RW_LN_W), *ln_b = INP(I_RW_LN_B);
    const int li = tid >> 5, lch = (tid & 31) * 2;
    const size_t gbase = ((size_t)b * SEQ) * 1024 + h * 64 + lch;
    f32x2 rw; unsigned rk, rb, rp, rr_, rv;
#define RW_LOAD(grp) do { const size_t o = gbase + (size_t)((grp) * 16 + li) * 1024; rw = *(const f32x2*)(WD + o); rk = *(const unsigned*)(KKg + o); rb = *(const unsigned*)(BV + o); \
        rp = *(const unsigned*)(KP + o); rr_ = *(const unsigned*)(RR + o); rv = *(const unsigned*)(VR + o); } while (0)
#define RW_STORE(buf) do { LAS float* d = IN + (buf) * 6144 + li * 64 + lch; *(LAS f32x2*)(d) = rw; *(LAS f32x2*)(d + 1024) = (f32x2){lo_bf(rk), hi_bf(rk)}; *(LAS f32x2*)(d + 2048) = (f32x2){lo_bf(rb), hi_bf(rb)}; \
        *(LAS f32x2*)(d + 3072) = (f32x2){lo_bf(rp), hi_bf(rp)}; *(LAS f32x2*)(d + 4096) = (f32x2){lo_bf(rr_), hi_bf(rr_)}; *(LAS f32x2*)(d + 5120) = (f32x2){lo_bf(rv), hi_bf(rv)}; } while (0)
    float st[8];
#pragma unroll
    for (int j = 0; j < 8; ++j) st[j] = 0.f;
    __syncthreads();
    RW_LOAD(0); RW_STORE(0); __syncthreads();
    for (int grp = 0; grp < SEQ / 16; ++grp) {
        const int buf = grp & 1; const LAS float* I0 = IN + buf * 6144;
        if (grp + 1 < SEQ / 16) RW_LOAD(grp + 1);
        for (int i = 0; i < 16; ++i) {
            const LAS float* q = I0 + i * 64 + 8 * w;
            const f32x4 w0 = *(const LAS f32x4*)(q), w1 = *(const LAS f32x4*)(q + 4), k0 = *(const LAS f32x4*)(q + 1024), k1 = *(const LAS f32x4*)(q + 1028);
            const f32x4 b0 = *(const LAS f32x4*)(q + 2048), b1 = *(const LAS f32x4*)(q + 2052), p0 = *(const LAS f32x4*)(q + 3072), p1 = *(const LAS f32x4*)(q + 3076);
            const f32x4 r0 = *(const LAS f32x4*)(q + 4096), r1 = *(const LAS f32x4*)(q + 4100); const float vv = I0[5120 + i * 64 + lane];
            float skp = 0.f;
#pragma unroll
            for (int j = 0; j < 4; ++j) skp += st[j] * k0[j] + st[4 + j] * k1[j];
            PART[(i & 1) * 512 + w * 64 + lane] = skp;
            LDS_WAIT(); __builtin_amdgcn_s_barrier(); asm volatile("" ::: "memory");
            float sk = 0.f;
#pragma unroll
            for (int ww = 0; ww < 8; ++ww) sk += PART[(i & 1) * 512 + ww * 64 + lane];
            float yp = 0.f;
#pragma unroll
            for (int j = 0; j < 4; ++j) { st[j] = st[j] * w0[j] - sk * b0[j] + vv * p0[j]; st[4 + j] = st[4 + j] * w1[j] - sk * b1[j] + vv * p1[j]; yp += st[j] * r0[j] + st[4 + j] * r1[j]; }
            YP[i * 512 + w * 64 + lane] = yp;
        }
        if (grp + 1 < SEQ / 16) RW_STORE(buf ^ 1);
        __syncthreads();
#pragma unroll
        for (int q = 0; q < 2; ++q) { const int i = 2 * w + q; float y = 0.f;
#pragma unroll
            for (int ww = 0; ww < 8; ++ww) y += YP[i * 512 + ww * 64 + lane];
            const float mean = wave_sum(y) * (1.f / 64.f), dv = y - mean, var = wave_sum(dv * dv) * (1.f / 64.f);
            const int ch = h * 64 + lane; const float yn = dv * rsqrtf(var + 64e-5f) * ln_w[ch] + ln_b[ch];
            const float bonus = wave_sum(I0[4096 + i * 64 + lane] * I0[3072 + i * 64 + lane] * r_k[ch]) * I0[5120 + i * 64 + lane];
            const size_t tt = (size_t)b * SEQ + grp * 16 + i;
            const float g = bf2f(GG[tt * 1024 + ch]);
            YCAT[tt * DM + 1024 + ch] = (bf16)f2bf((yn + bonus) * g); }
    }
#undef RW_LOAD
#undef RW_STORE
    __syncthreads();
}

__device__ __forceinline__ f32x4 lds_mma(const LAS bf16* Am, int lda, const LAS bf16* Bt, int ldb, int tm, int tn, int K, int lane, f32x4 acc) {
    const LAS bf16* ap = Am + (tm * 16 + (lane & 15)) * lda + (lane >> 4) * 8;
    const LAS bf16* bp = Bt + (tn * 16 + (lane & 15)) * ldb + (lane >> 4) * 8;
    for (int k = 0; k < K; k += 32) { const bf16x8 a = *(const LAS bf16x8*)(ap + k); const bf16x8 bb = *(const LAS bf16x8*)(bp + k);
        acc = __builtin_amdgcn_mfma_f32_16x16x32_bf16(bb, a, acc, 0, 0, 0); }
    return acc;
}

constexpr int RP = 72;
__device__ __forceinline__ void st4_bf16(LAS bf16* p, f32x4 v) { u32x2 w; w.x = pk2(v[0], v[1]); w.y = pk2(v[2], v[3]); *(LAS u32x2*)p = w; }
__device__ __forceinline__ void st4_bf16_T(LAS bf16* base, int row, int col0, f32x4 v) {
#pragma unroll
    for (int j = 0; j < 4; ++j) base[(col0 + j) * RP + row] = (bf16)f2bf(v[j]);
}
__device__ __forceinline__ void st4_bf16_g(bf16* p, f32x4 v) { u32x2 w; w.x = pk2(v[0], v[1]); w.y = pk2(v[2], v[3]); *(u32x2*)p = w; }
__device__ __forceinline__ void tri_inverse_diag32(const LAS float* Cf, LAS bf16* Tm, LAS bf16* T00T, int lane) {
    const int hb = lane >> 5, j = lane & 31; const LAS float* Cb_ = Cf + hb * (32 * 64 + 32); float Tr[32];
#pragma unroll
    for (int t = 0; t < 32; ++t) { float acc0 = (t == j) ? 1.f : 0.f, acc1 = 0.f, acc2 = 0.f, acc3 = 0.f;
#pragma unroll
        for (int s4 = 0; s4 < (t + 3) / 4; ++s4) { const f32x4 cv = *(const LAS f32x4*)(Cb_ + t * 64 + s4 * 4);
            if (s4 * 4 + 0 < t) acc0 -= cv[0] * Tr[s4 * 4 + 0]; if (s4 * 4 + 1 < t) acc1 -= cv[1] * Tr[s4 * 4 + 1];
            if (s4 * 4 + 2 < t) acc2 -= cv[2] * Tr[s4 * 4 + 2]; if (s4 * 4 + 3 < t) acc3 -= cv[3] * Tr[s4 * 4 + 3]; }
        Tr[t] = (acc0 + acc1) + (acc2 + acc3); Tm[(32 * hb + t) * RP + 32 * hb + j] = (bf16)f2bf(Tr[t]); __builtin_amdgcn_sched_barrier(0); }
    if (hb == 0) {
#pragma unroll
        for (int q = 0; q < 4; ++q) *(LAS u32x4*)(T00T + j * 40 + 8 * q) = pack8f(Tr + 8 * q); }
    { const int t = lane >> 1, h = lane & 1; const u32x4 z = (u32x4){0u, 0u, 0u, 0u}; *(LAS u32x4*)(Tm + t * RP + 32 + 16 * h) = z; *(LAS u32x4*)(Tm + t * RP + 32 + 16 * h + 8) = z; }
}
__device__ __forceinline__ void rwkv_prep_units(const Ctx& C, bool side_cvt) {
    int unit = C.bid; if (unit >= 4096) return;
    const int w = C.wave;
    LAS float* F = (LAS float*)C.lds;
    LAS float* EGL = F + 4096;
    LAS bf16* B0 = (LAS bf16*)(EGL + 64 + 512);
    LAS bf16 *Kt = B0, *Rt = B0 + 64 * RP, *Kb = B0 + 2 * 64 * RP, *Bb = B0 + 3 * 64 * RP, *KtT = B0 + 4 * 64 * RP, *KhT = B0 + 5 * 64 * RP, *BhT = B0 + 6 * 64 * RP,
             *VcT = B0 + 7 * 64 * RP, *Am = B0 + 8 * 64 * RP, *Q1 = B0 + 9 * 64 * RP, *Q2 = B0 + 10 * 64 * RP;
    LAS bf16 *Tm = Kt, *AVT = Kb, *WmT = Bb, *UT = Am;
    LAS bf16 *C10b = (LAS bf16*)(C.lds + LDS_AUX), *T00T = C10b + 32 * 40, *XT = T00T + 32 * 40;
    const float* WD = ARP(float, A_WD); const bf16 *KKg = ARP(bf16, A_KK), *BV = ARP(bf16, A_BV), *KP = ARP(bf16, A_KP), *RR = ARP(bf16, A_RR), *VR = ARP(bf16, A_VR);
    f32x4 lw0, lw1; u32x4 rk, rb, rp, rr, rv;
#define RWP_LOAD(u_) do { const int bh_ = (u_) >> 6, c_ = (u_) & 63; const size_t go_ = ((size_t)(bh_ >> 4) * SEQ + c_ * 64 + (C.tid >> 3)) * 1024 + (bh_ & 15) * 64 + (C.tid & 7) * 8; \
        lw0 = *(const f32x4*)(WD + go_); lw1 = *(const f32x4*)(WD + go_ + 4); rk = *(const u32x4*)(KKg + go_); rb = *(const u32x4*)(BV + go_); rp = *(const u32x4*)(KP + go_); rr = *(const u32x4*)(RR + go_); rv = *(const u32x4*)(VR + go_); } while (0)
    RWP_LOAD(unit);
  for (;;) {
    int tid = C.tid; asm volatile("" : "+v"(tid));
    const int lane = tid & 63, t = tid >> 3, c8 = (tid & 7) * 8;
    bf16 *GM = ARP(bf16, A_RWM) + (size_t)unit * 4096, *GN = ARP(bf16, A_RWN) + (size_t)unit * 4096, *GRW = ARP(bf16, A_RWRW) + (size_t)unit * 4096, *GYL = ARP(bf16, A_RWYL) + (size_t)unit * 4096;
    __syncthreads();
    *(LAS f32x4*)(F + t * 64 + c8) = lw0; *(LAS f32x4*)(F + t * 64 + c8 + 4) = lw1;
    __syncthreads();
    { float g = 0.f;
#pragma unroll
      for (int i = 0; i < 8; ++i) { g += F[(8 * w + i) * 64 + lane]; F[(8 * w + i) * 64 + lane] = g; }
      EGL[64 + w * 64 + lane] = g; }
    __syncthreads();
    { float off = 0.f;
      for (int ww = 0; ww < w; ++ww) off += EGL[64 + ww * 64 + lane];
#pragma unroll
      for (int i = 0; i < 8; ++i) F[(8 * w + i) * 64 + lane] += off; }
    __syncthreads();
    { float G[8], Gm[8], GL[8], kkf[8], bf_[8], kpf[8], rf[8], vf[8];
#pragma unroll
      for (int j = 0; j < 8; ++j) { G[j] = F[t * 64 + c8 + j]; Gm[j] = t > 0 ? F[(t - 1) * 64 + c8 + j] : 0.f; GL[j] = F[63 * 64 + c8 + j]; }
      unpack8(rk, kkf); unpack8(rb, bf_); unpack8(rp, kpf); unpack8(rr, rf); unpack8(rv, vf);
      float okt[8], ort[8], okb[8], obb[8];
#pragma unroll
      for (int j = 0; j < 8; ++j) { const float e1 = __expf(Gm[j]), e2 = __expf(G[j]), e3 = __expf(-G[j]), e4 = __expf(GL[j] - G[j]);
          okt[j] = kkf[j] * e1; ort[j] = rf[j] * e2; okb[j] = kpf[j] * e3; obb[j] = bf_[j] * e3;
          KtT[(c8 + j) * RP + t] = (bf16)f2bf(okt[j]); KhT[(c8 + j) * RP + t] = (bf16)f2bf(kpf[j] * e4); BhT[(c8 + j) * RP + t] = (bf16)f2bf(bf_[j] * e4);
          VcT[(c8 + j) * RP + t] = (bf16)f2bf(vf[j]);
          if (t == 63) EGL[c8 + j] = e2; }
      *(LAS u32x4*)(Kt + t * RP + c8) = pack8f(okt); *(LAS u32x4*)(Rt + t * RP + c8) = pack8f(ort); *(LAS u32x4*)(Kb + t * RP + c8) = pack8f(okb); *(LAS u32x4*)(Bb + t * RP + c8) = pack8f(obb); }
    const int next_unit = unit + C.G; if (next_unit < 4096) RWP_LOAD(next_unit);
    f32x4 cvv[2][8]; MoeTile mt = moe_tile_decode(C, MOE_CVT_BASE_C + (unit * 8 + w) * 2);
    if (side_cvt) moe_pair_load(mt, cvv, lane);
    __syncthreads();
    const int tm = w >> 1, tn0 = (w & 1) * 2, row = tm * 16 + (lane & 15), cq = 4 * (lane >> 4); const f32x4 z4 = (f32x4){0.f, 0.f, 0.f, 0.f};
#pragma unroll
    for (int q = 0; q < 2; ++q) { const int tn = tn0 + q, col = tn * 16 + cq;
        f32x4 a = lds_mma(Kt, RP, Kb, RP, tm, tn, 64, lane, z4), cc = lds_mma(Kt, RP, Bb, RP, tm, tn, 64, lane, z4), q1 = lds_mma(Rt, RP, Kb, RP, tm, tn, 64, lane, z4), q2 = lds_mma(Rt, RP, Bb, RP, tm, tn, 64, lane, z4);
#pragma unroll
        for (int j = 0; j < 4; ++j) { const bool lo_ = (col + j) < row, le_ = (col + j) <= row; a[j] = lo_ ? a[j] : 0.f; cc[j] = lo_ ? cc[j] : 0.f; q1[j] = le_ ? q1[j] : 0.f; q2[j] = le_ ? q2[j] : 0.f; }
        st4_bf16(Am + row * RP + col, a); st4_bf16(Q1 + row * RP + col, q1); st4_bf16(Q2 + row * RP + col, q2); *(LAS f32x4*)(F + row * 64 + col) = cc;
        if (row >= 32 && col < 32) st4_bf16(C10b + (row - 32) * 40 + col, cc); }
    __syncthreads();
    if (w == 0) tri_inverse_diag32(F, Tm, T00T, lane);
    else { for (int tile = w - 1; tile < 16; tile += 7) { const int am = tile >> 2, an = tile & 3; const f32x4 av = lds_mma(Am, RP, VcT, RP, am, an, 64, lane, z4); st4_bf16_T(AVT, am * 16 + (lane & 15), an * 16 + cq, av); } }
    __syncthreads();
    if (w < 4) { const int bm = w >> 1, bn = w & 1; const f32x4 x = lds_mma(C10b, 40, T00T, 40, bm, bn, 32, lane, z4);
#pragma unroll
        for (int j = 0; j < 4; ++j) XT[(bn * 16 + cq + j) * 40 + bm * 16 + (lane & 15)] = (bf16)f2bf(x[j]); }
    __syncthreads();
    if (w < 4) { const int bm = w >> 1, bn = w & 1; const f32x4 x = lds_mma(Tm + 32 * RP + 32, RP, XT, 40, bm, bn, 32, lane, z4);
        st4_bf16(Tm + (32 + bm * 16 + (lane & 15)) * RP + bn * 16 + cq, (f32x4){-x[0], -x[1], -x[2], -x[3]}); }
    if (side_cvt) moe_pair_store(mt, cvv, lane);
    __syncthreads();
#pragma unroll
    for (int q = 0; q < 2; ++q) { const int tn = tn0 + q, col = tn * 16 + cq;
        const f32x4 wm = lds_mma(Tm, RP, KtT, RP, tm, tn, 64, lane, z4), uu = lds_mma(Tm, RP, AVT, RP, tm, tn, 64, lane, z4);
        st4_bf16_T(WmT, row, col, wm); st4_bf16_T(UT, row, col, uu); }
    __syncthreads();
#pragma unroll
    for (int q = 0; q < 2; ++q) { const int tn = tn0 + q, col = tn * 16 + cq;
        { f32x4 p = lds_mma(Q2, RP, WmT, RP, tm, tn, 64, lane, z4); const u32x2 rw_ = *(const LAS u32x2*)(Rt + row * RP + col);
          st4_bf16_g(GRW + row * 64 + col, (f32x4){lo_bf(rw_.x) - p[0], hi_bf(rw_.x) - p[1], lo_bf(rw_.y) - p[2], hi_bf(rw_.y) - p[3]}); }
        { const f32x4 p1 = lds_mma(Q1, RP, VcT, RP, tm, tn, 64, lane, z4), p2 = lds_mma(Q2, RP, UT, RP, tm, tn, 64, lane, z4); st4_bf16_g(GYL + row * 64 + col, p1 - p2); }
        { f32x4 p = lds_mma(BhT, RP, WmT, RP, tm, tn, 64, lane, z4);
#pragma unroll
          for (int j = 0; j < 4; ++j) p[j] = ((col + j) == row ? EGL[row] : 0.f) - p[j];
          st4_bf16_g(GM + row * 64 + col, p); }
        { const f32x4 p1 = lds_mma(KhT, RP, VcT, RP, tm, tn, 64, lane, z4), p2 = lds_mma(BhT, RP, UT, RP, tm, tn, 64, lane, z4); st4_bf16_g(GN + row * 64 + col, p1 - p2); } }
    if (next_unit >= 4096) break; unit = next_unit;
  }
#undef RWP_LOAD
}
__device__ __forceinline__ void rwkv_scan_slice(const Ctx& C, int item) {
    const int bh = item >> 2, v0 = (item & 3) * 16, b = bh >> 4, h = bh & 15, lane = C.lane, w = C.wave;
    LAS bf16* SH = (LAS bf16*)C.lds;
    LAS bf16* SL = SH + 2 * 16 * RP;
    const bf16 *GM = ARP(bf16, A_RWM) + (size_t)bh * 64 * 4096, *GN = ARP(bf16, A_RWN) + (size_t)bh * 64 * 4096, *GRW = ARP(bf16, A_RWRW) + (size_t)bh * 64 * 4096, *GYL = ARP(bf16, A_RWYL) + (size_t)bh * 64 * 4096;
    bf16* YRAW = ARP(bf16, A_KR);
    const bool is_state = w >= 4; const int tm = w & 3, row = tm * 16 + (lane & 15), cq = 4 * (lane >> 4), kq = (lane >> 4) * 8;
    const bf16* GA = is_state ? GM : GRW; const bf16* GB = is_state ? GN : GYL;
    f32x4 st = (f32x4){0.f, 0.f, 0.f, 0.f};
    bf16x8 a0, a1, b0, b1; u32x2 addA, addB;
#define RWS_LOAD(cc_, X0, X1, XA) do { const size_t uo_ = (size_t)(cc_) * 4096; X0 = *(const bf16x8*)(GA + uo_ + row * 64 + kq); X1 = *(const bf16x8*)(GA + uo_ + row * 64 + 32 + kq); XA = *(const u32x2*)(GB + uo_ + row * 64 + v0 + cq); } while (0)
#define RWS_STEP(c_, X0, X1, XA) do { \
        LAS bf16* sh = SH + ((c_) & 1) * 16 * RP; LAS bf16* sl = SL + ((c_) & 1) * 16 * RP; \
        if (is_state) { _Pragma("unroll") for (int j = 0; j < 4; ++j) { const float s_ = st[j]; const unsigned hb = f2bf(s_); sh[(cq + j) * RP + row] = (bf16)hb; sl[(cq + j) * RP + row] = (bf16)f2bf(s_ - __uint_as_float(hb << 16)); } } \
        LDS_WAIT(); __builtin_amdgcn_s_barrier(); asm volatile("" ::: "memory"); \
        const LAS bf16* bh_ = sh + (lane & 15) * RP + kq; const LAS bf16* bl_ = sl + (lane & 15) * RP + kq; \
        const bf16x8 h0 = *(const LAS bf16x8*)bh_, h1 = *(const LAS bf16x8*)(bh_ + 32), l0 = *(const LAS bf16x8*)bl_, l1 = *(const LAS bf16x8*)(bl_ + 32); \
        f32x4 acc = (f32x4){lo_bf(XA.x), hi_bf(XA.x), lo_bf(XA.y), hi_bf(XA.y)}; \
        acc = __builtin_amdgcn_mfma_f32_16x16x32_bf16(h0, X0, acc, 0, 0, 0); acc = __builtin_amdgcn_mfma_f32_16x16x32_bf16(h1, X1, acc, 0, 0, 0); \
        acc = __builtin_amdgcn_mfma_f32_16x16x32_bf16(l0, X0, acc, 0, 0, 0); acc = __builtin_amdgcn_mfma_f32_16x16x32_bf16(l1, X1, acc, 0, 0, 0); \
        if ((c_) + 2 < 64) RWS_LOAD((c_) + 2, X0, X1, XA); \
        if (is_state) st = acc; \
        else st4_bf16_g(YRAW + ((size_t)b * SEQ + (c_) * 64 + row) * 1024 + h * 64 + v0 + cq, acc); } while (0)
    RWS_LOAD(0, a0, a1, addA); RWS_LOAD(1, b0, b1, addB);
    __syncthreads();
    for (int c = 0; c < 64; c += 2) { RWS_STEP(c, a0, a1, addA); RWS_STEP(c + 1, b0, b1, addB); }
#undef RWS_LOAD
#undef RWS_STEP
    __syncthreads();
}
__device__ __forceinline__ float sum8(float v) { v += DPPF(v, DPP_XOR1); v += DPPF(v, DPP_XOR2); v += DPPF(v, DPP_HMIRROR); return v; }
__device__ __forceinline__ void rwkv_out_items(const Ctx& C) {
    const bf16 *YRAW = ARP(bf16, A_KR), *KP = ARP(bf16, A_KP), *RR = ARP(bf16, A_RR), *VR = ARP(bf16, A_VR), *GG = ARP(bf16, A_GG); bf16* YCAT = ARP(bf16, A_YCAT);
    const float *r_k = INP(I_RW_R_K), *ln_w = INP(I_RW_LN_W), *ln_b = INP(I_RW_LN_B); const int lane = C.lane;
    for (int tt = C.gw; tt < T; tt += C.ngw) {
#pragma unroll
        for (int j = 0; j < 2; ++j) { const int ch = (j * 64 + lane) * 8; const size_t o = (size_t)tt * 1024 + ch;
            float y[8], rr[8], kp[8], vr[8], gg[8]; unpack8(*(const u32x4*)(YRAW + o), y); unpack8(*(const u32x4*)(RR + o), rr); unpack8(*(const u32x4*)(KP + o), kp); unpack8(*(const u32x4*)(VR + o), vr); unpack8(*(const u32x4*)(GG + o), gg);
            const f32x4 rk0 = *(const f32x4*)(r_k + ch), rk1 = *(const f32x4*)(r_k + ch + 4), lw0 = *(const f32x4*)(ln_w + ch), lw1 = *(const f32x4*)(ln_w + ch + 4), lb0 = *(const f32x4*)(ln_b + ch), lb1 = *(const f32x4*)(ln_b + ch + 4);
            const float rkf[8] = {rk0.x, rk0.y, rk0.z, rk0.w, rk1.x, rk1.y, rk1.z, rk1.w}, lwf[8] = {lw0.x, lw0.y, lw0.z, lw0.w, lw1.x, lw1.y, lw1.z, lw1.w}, lbf[8] = {lb0.x, lb0.y, lb0.z, lb0.w, lb1.x, lb1.y, lb1.z, lb1.w};
            float s1 = 0.f, sb = 0.f;
#pragma unroll
            for (int q = 0; q < 8; ++q) { s1 += y[q]; sb += rr[q] * kp[q] * rkf[q]; }
            const float mean = sum8(s1) * (1.f / 64.f), bonus = sum8(sb); float s2 = 0.f;
#pragma unroll
            for (int q = 0; q < 8; ++q) { y[q] -= mean; s2 += y[q] * y[q]; }
            const float rstd = rsqrtf(sum8(s2) * (1.f / 64.f) + 64e-5f); float o8[8];
#pragma unroll
            for (int q = 0; q < 8; ++q) o8[q] = (y[q] * rstd * lwf[q] + lbf[q] + bonus * vr[q]) * gg[q];
            st16_f(YCAT + (size_t)tt * DM + 1024 + ch, pack8f(o8)); }
    }
}
constexpr int MLE = 272;
__device__ __forceinline__ void ml_gate_scan(const Ctx& C, int bh4) {
    const float *IG = ARP(float, A_IG) + (size_t)bh4 * SEQ, *LFp = ARP(float, A_LF) + (size_t)bh4 * SEQ; float *AAg = ARP(float, A_MLA) + (size_t)bh4 * SEQ, *MXg = ARP(float, A_MLM) + (size_t)bh4 * SEQ;
    const int lane = C.lane, p0 = lane * 64; float tot = 0.f;
    for (int i = 0; i < 64; i += 4) { const f32x4 f = *(const f32x4*)(LFp + p0 + i); tot += (f.x + f.y) + (f.z + f.w); }
    float inc = tot;
#pragma unroll
    for (int o = 1; o < 64; o <<= 1) { const float n = __shfl_up(inc, o); if (lane >= o) inc += n; }
    float F = inc - tot, mloc = -INFINITY; f32x4 av[16];
#pragma unroll
    for (int i = 0; i < 16; ++i) { const f32x4 f = *(const f32x4*)(LFp + p0 + 4 * i), g = *(const f32x4*)(IG + p0 + 4 * i); f32x4 a;
        F += f.x; a.x = g.x - F; F += f.y; a.y = g.y - F; F += f.z; a.z = g.z - F; F += f.w; a.w = g.w - F;
        *(f32x4*)(AAg + p0 + 4 * i) = a; av[i] = a; mloc = fmaxf(fmaxf(mloc, fmaxf(a.x, a.y)), fmaxf(a.z, a.w)); }
    float minc = mloc;
#pragma unroll
    for (int o = 1; o < 64; o <<= 1) { const float n = __shfl_up(minc, o); if (lane >= o) minc = fmaxf(minc, n); }
    float run = __shfl_up(minc, 1); if (lane == 0) run = 0.f; run = fmaxf(run, 0.f);
#pragma unroll
    for (int i = 0; i < 16; ++i) { const f32x4 a = av[i]; f32x4 m;
        run = fmaxf(run, a.x); m.x = run; run = fmaxf(run, a.y); m.y = run; run = fmaxf(run, a.z); m.z = run; run = fmaxf(run, a.w); m.w = run;
        *(f32x4*)(MXg + p0 + 4 * i) = m; }
}
__device__ __forceinline__ void ml_intra_unit(const Ctx& C, int unit, bool side_cvt) {
    int tid = C.tid; asm volatile("" : "+v"(tid));
    const int bh4 = unit >> 6, c = unit & 63, b = bh4 >> 2, h = bh4 & 3, w = C.wave, lane = tid & 63, t0 = c * 64;
    LAS bf16* Qs = (LAS bf16*)C.lds;
    LAS bf16* Ks = Qs + 64 * 136;
    LAS bf16* KwT = Ks + 64 * 136;
    LAS bf16* VtE = KwT + 128 * 72;
    LAS bf16* Ps = VtE + MLE * 72;
    LAS float* AAs = (LAS float*)(Ps + 64 * 72);
    const bf16 *QM = ARP(bf16, A_QM), *KM = ARP(bf16, A_KM), *PAB = ARP(bf16, A_PAB);
    const float *AAg = ARP(float, A_MLA) + (size_t)bh4 * SEQ + t0, *MXg = ARP(float, A_MLM) + (size_t)bh4 * SEQ + t0;
    bf16* NUMI = ARP(bf16, A_MLNUM) + (size_t)unit * 64 * MLE; bf16* KVT = ARP(bf16, A_MLKV) + (size_t)unit * MLE * 128;
    const size_t tok0 = (size_t)b * SEQ + t0;
    u32x4 rq[2], rk[2], rv[4];
#pragma unroll
    for (int k = 0; k < 2; ++k) { const int idx = tid + 512 * k, r = idx >> 4, c8 = (idx & 15) * 8; const size_t o = (tok0 + r) * 512 + h * 128 + c8; rq[k] = *(const u32x4*)(QM + o); rk[k] = *(const u32x4*)(KM + o); }
#pragma unroll
    for (int k = 0; k < 4; ++k) { const int idx = tid + 512 * k, r = idx >> 5, e8 = (idx & 31) * 8; rv[k] = *(const u32x4*)(PAB + (tok0 + r) * AB_PAD + 1024 + h * 256 + e8); }
    const float Mc2 = MXg[63];
    f32x4 cvv[2][8]; MoeTile mt = moe_tile_decode(C, MOE_CVT_BASE_F + (unit * 8 + w) * 2); if (side_cvt) moe_pair_load(mt, cvv, lane);
    __syncthreads();
    if (tid < 64) { AAs[tid] = AAg[tid]; AAs[64 + tid] = MXg[tid]; }
    for (int i = tid; i < 16 * 72; i += NTHR) VtE[256 * 72 + i] = (i < 72) ? (bf16)0x3f80 : (bf16)0;
#pragma unroll
    for (int k = 0; k < 2; ++k) { const int idx = tid + 512 * k, r = idx >> 4, c8 = (idx & 15) * 8;
        *(LAS u32x4*)(Qs + r * 136 + c8) = rq[k]; *(LAS u32x4*)(Ks + r * 136 + c8) = rk[k];
        float kf[8]; unpack8(rk[k], kf); const float wk = __expf(AAg[r] - Mc2);
#pragma unroll
        for (int j = 0; j < 8; ++j) KwT[(c8 + j) * 72 + r] = (bf16)f2bf(kf[j] * wk); }
#pragma unroll
    for (int k = 0; k < 4; ++k) { const int idx = tid + 512 * k, r = idx >> 5, e8 = (idx & 31) * 8; const unsigned wv[4] = {rv[k].x, rv[k].y, rv[k].z, rv[k].w};
#pragma unroll
        for (int j = 0; j < 4; ++j) { VtE[(e8 + 2 * j) * 72 + r] = (bf16)(wv[j] & 0xffff); VtE[(e8 + 2 * j + 1) * 72 + r] = (bf16)(wv[j] >> 16); } }
    __syncthreads();
#pragma unroll
    for (int q = 0; q < 2; ++q) { const int tile = 2 * w + q, tm = tile >> 2, tn = tile & 3; const int t = tm * 16 + (lane & 15), l0 = tn * 16 + 4 * (lane >> 4);
        f32x4 s = (f32x4){0.f, 0.f, 0.f, 0.f};
        if (tn <= tm) s = lds_mma(Qs, 136, Ks, 136, tm, tn, 128, lane, s);
        const float mxt = AAs[64 + t]; float pvv[4];
#pragma unroll
        for (int j = 0; j < 4; ++j) { const int l = l0 + j; pvv[j] = (l <= t) ? s[j] * __expf(AAs[l] - mxt) : 0.f; }
        u32x2 pw; pw.x = pk2(pvv[0], pvv[1]); pw.y = pk2(pvv[2], pvv[3]); *(LAS u32x2*)(Ps + t * 72 + l0) = pw; }
    { const int tn = w;
      for (int tm = 0; tm < 17; ++tm) { const f32x4 kv = lds_mma(VtE, 72, KwT, 72, tm, tn, 64, lane, (f32x4){0.f, 0.f, 0.f, 0.f}); const int e = tm * 16 + (lane & 15);
          if (e <= 256) st4_bf16_g(KVT + (size_t)e * 128 + tn * 16 + 4 * (lane >> 4), kv); } }
    __syncthreads();
    { const int tm = w >> 1, t = tm * 16 + (lane & 15);
      for (int tn = (w & 1); tn < 17; tn += 2) { const f32x4 nv = lds_mma(Ps, 72, VtE, 72, tm, tn, 64, lane, (f32x4){0.f, 0.f, 0.f, 0.f}); st4_bf16_g(NUMI + (size_t)t * MLE + tn * 16 + 4 * (lane >> 4), nv); } }
    if (side_cvt) moe_pair_store(mt, cvv, lane);
}
__device__ __forceinline__ void ml_state_scan(const Ctx& C, int first_block, int nblocks) {
    const float* MXg = ARP(float, A_MLM); bf16* KVT = ARP(bf16, A_MLKV);
    constexpr int NPAIR = 16 * 257 * 64;
    const int nthr = nblocks * NTHR, g0 = (C.bid - first_block) * NTHR + C.tid;
    unsigned eoff[3], moff[3]; f32x2 cst[3]; float mprev[3]; bool ev[3];
#pragma unroll
    for (int k = 0; k < 3; ++k) { const int pi = g0 + k * nthr; ev[k] = pi < NPAIR; const int bh4 = ev[k] ? pi / (257 * 64) : 0, r = ev[k] ? pi - bh4 * (257 * 64) : 0;
        eoff[k] = (unsigned)(bh4 * 64 * MLE * 128 + 2 * r); moff[k] = (unsigned)(bh4 * SEQ); cst[k] = (f32x2){0.f, 0.f}; mprev[k] = 0.f; }
    for (int c0 = 0; c0 < 64; c0 += 8) {
        unsigned kvw[3][8]; float mn[3][8];
#pragma unroll
        for (int k = 0; k < 3; ++k)
#pragma unroll
            for (int j = 0; j < 8; ++j) { kvw[k][j] = 0u; mn[k][j] = 0.f; if (ev[k]) { kvw[k][j] = *(const unsigned*)(KVT + eoff[k] + (unsigned)(c0 + j) * (MLE * 128)); mn[k][j] = MXg[moff[k] + (c0 + j) * 64 + 63]; } }
#pragma unroll
        for (int j = 0; j < 8; ++j)
#pragma unroll
            for (int k = 0; k < 3; ++k) if (ev[k]) { *(unsigned*)(KVT + eoff[k] + (unsigned)(c0 + j) * (MLE * 128)) = pk2(cst[k].x, cst[k].y);
                const float dc = __expf(mprev[k] - mn[k][j]); cst[k].x = dc * cst[k].x + lo_bf(kvw[k][j]); cst[k].y = dc * cst[k].y + hi_bf(kvw[k][j]); mprev[k] = mn[k][j]; } }
}
__device__ __forceinline__ void ml_out_unit(const Ctx& C, int unit, bool side_cvt) {
    int tid = C.tid; asm volatile("" : "+v"(tid));
    const int bh4 = unit >> 6, c = unit & 63, b = bh4 >> 2, h = bh4 & 3, w = C.wave, lane = tid & 63, t0 = c * 64;
    LAS bf16* Qs = (LAS bf16*)C.lds;
    LAS bf16* CTs = Qs + 64 * 136;
    const bf16 *QM = ARP(bf16, A_QM), *PAB = ARP(bf16, A_PAB), *NUMI = ARP(bf16, A_MLNUM) + (size_t)unit * 64 * MLE, *KVT = ARP(bf16, A_MLKV) + (size_t)unit * MLE * 128; bf16* YCAT = ARP(bf16, A_YCAT);
    const float *IG = ARP(float, A_IG) + (size_t)bh4 * SEQ + t0, *AAg = ARP(float, A_MLA) + (size_t)bh4 * SEQ + t0, *MXg = ARP(float, A_MLM) + (size_t)bh4 * SEQ + t0;
    const size_t tok0 = (size_t)b * SEQ + t0;
    u32x4 rq[2], rc[9];
#pragma unroll
    for (int k = 0; k < 2; ++k) { const int idx = tid + 512 * k, r = idx >> 4, c8 = (idx & 15) * 8; rq[k] = *(const u32x4*)(QM + (tok0 + r) * 512 + h * 128 + c8); }
#pragma unroll
    for (int k = 0; k < 9; ++k) { const int idx = tid + 512 * k, e = idx >> 4, c8 = (idx & 15) * 8; rc[k] = (u32x4){0u, 0u, 0u, 0u}; if (e <= 256) rc[k] = *(const u32x4*)(KVT + (size_t)e * 128 + c8); }
    const float Mc = c ? MXg[-1] : 0.f;
    f32x4 cvv[2][8]; MoeTile mt = moe_tile_decode(C, MOE_CVT_BASE_G + (unit * 8 + w) * 2); if (side_cvt) moe_pair_load(mt, cvv, lane);
    __syncthreads();
#pragma unroll
    for (int k = 0; k < 2; ++k) { const int idx = tid + 512 * k, r = idx >> 4, c8 = (idx & 15) * 8; *(LAS u32x4*)(Qs + r * 136 + c8) = rq[k]; }
#pragma unroll
    for (int k = 0; k < 9; ++k) { const int idx = tid + 512 * k, e = idx >> 4, c8 = (idx & 15) * 8; if (e < MLE) *(LAS u32x4*)(CTs + e * 136 + c8) = rc[k]; }
    __syncthreads();
    const int tm = w >> 1, t = tm * 16 + (lane & 15), cq = 4 * (lane >> 4); const size_t tt = tok0 + t; const float scale = 0.08838834764831845f;
    const float wst = __expf(Mc - MXg[t]), mrow = IG[t] - AAg[t] + MXg[t];
    float inv;
    { const f32x4 a2 = lds_mma(Qs, 136, CTs, 136, tm, 16, 128, lane, (f32x4){0.f, 0.f, 0.f, 0.f}); const float di = bf2f(NUMI[(size_t)t * MLE + 256]);
      float den = (lane < 16) ? (di + a2[0] * wst) * scale : 0.f; den += xor16f(den); den += xor32f(den);
      inv = 1.f / fmaxf(fabsf(den), __expf(-mrow)); }
    for (int tn = (w & 1); tn < 16; tn += 2) { const f32x4 a2 = lds_mma(Qs, 136, CTs, 136, tm, tn, 128, lane, (f32x4){0.f, 0.f, 0.f, 0.f});
        const u32x2 ni = *(const u32x2*)(NUMI + (size_t)t * MLE + tn * 16 + cq); const u32x2 og = *(const u32x2*)(PAB + tt * AB_PAD + 2048 + h * 256 + tn * 16 + cq);
        const float n0 = (lo_bf(ni.x) + a2[0] * wst) * scale * inv, n1 = (hi_bf(ni.x) + a2[1] * wst) * scale * inv, n2 = (lo_bf(ni.y) + a2[2] * wst) * scale * inv, n3 = (hi_bf(ni.y) + a2[3] * wst) * scale * inv;
        u32x2 o; o.x = pk2(sigmoidf_(lo_bf(og.x)) * n0, sigmoidf_(hi_bf(og.x)) * n1); o.y = pk2(sigmoidf_(lo_bf(og.y)) * n2, sigmoidf_(hi_bf(og.y)) * n3);
        st8_f(YCAT + tt * DM + h * 256 + tn * 16 + cq, o); }
    if (side_cvt) moe_pair_store(mt, cvv, lane);
}

__device__ __forceinline__ void mlstm_unit(const Ctx& C, const Args& A, int unit) {
    const int bh = unit >> 3, dvs = unit & 7, b = bh >> 2, h = bh & 3, w = C.wave, lane = C.lane, tid = C.tid;
    LAS float* AA = (LAS float*)C.lds;
    LAS float* MX = AA + 4096;
    LAS bf16* Qs = (LAS bf16*)(MX + 4096);
    LAS bf16* Ks = Qs + 64 * 136;
    LAS bf16* KwT = Ks + 64 * 136;
    LAS bf16* Vt = KwT + 128 * 72;
    LAS bf16* Ps = Vt + 48 * 72;
    LAS bf16* CT = Ps + 64 * 72;
    LAS float* NUM = (LAS float*)(CT + 48 * 136);
    const float *IG = ARP(float, A_IG) + (size_t)bh * SEQ, *LFp = ARP(float, A_LF) + (size_t)bh * SEQ;
    const bf16 *QM = ARP(bf16, A_QM), *KM = ARP(bf16, A_KM), *PAB = ARP(bf16, A_PAB); bf16* YCAT = ARP(bf16, A_YCAT);
    __syncthreads();
    if (w == 0) { float carryF = 0.f, carryM = 0.f;
        for (int c = 0; c < 64; ++c) { const int p = c * 64 + lane; float f = LFp[p];
#pragma unroll
            for (int o = 1; o < 64; o <<= 1) { const float n = __shfl_up(f, o); if (lane >= o) f += n; }
            f += carryF; const float a = IG[p] - f; float m = a;
#pragma unroll
            for (int o = 1; o < 64; o <<= 1) { const float n = __shfl_up(m, o); if (lane >= o) m = fmaxf(m, n); }
            m = fmaxf(m, carryM); AA[p] = a; MX[p] = m; carryF = __shfl(f, 63); carryM = __shfl(m, 63); } }
    for (int i = tid; i < 48 * 72; i += NTHR) { const int r = i / 72; Vt[i] = (r == 32) ? (bf16)0x3f80 : (bf16)0; }
    for (int i = tid; i < 48 * 136; i += NTHR) CT[i] = 0;
    f32x4 accC[3];
#pragma unroll
    for (int k = 0; k < 3; ++k) accC[k] = (f32x4){0.f, 0.f, 0.f, 0.f};
    const size_t tok0 = (size_t)b * SEQ;
    u32x4 rq[2], rk[2], rv;
#define ML_LOAD(c) do { _Pragma("unroll") for (int k = 0; k < 2; ++k) { const int idx = tid + 512 * k, r = idx >> 4, c8 = (idx & 15) * 8; const size_t o = (tok0 + (c) * 64 + r) * 512 + h * 128 + c8; \
            rq[k] = *(const u32x4*)(QM + o); rk[k] = *(const u32x4*)(KM + o); } \
        if (tid < 256) rv = *(const u32x4*)(PAB + (tok0 + (c) * 64 + (tid >> 2)) * AB_PAD + 1024 + h * 256 + dvs * 32 + (tid & 3) * 8); } while (0)
    ML_LOAD(0);
    __syncthreads();
    const float scale = 0.08838834764831845f;
    for (int c = 0; c < 64; ++c) {
        const int t0 = c * 64; const float Mc = c ? MX[t0 - 1] : 0.f, Mc2 = MX[t0 + 63];
#pragma unroll
        for (int k = 0; k < 2; ++k) { const int idx = tid + 512 * k, r = idx >> 4, c8 = (idx & 15) * 8;
            *(LAS u32x4*)(Qs + r * 136 + c8) = rq[k]; *(LAS u32x4*)(Ks + r * 136 + c8) = rk[k];
            float kf[8]; unpack8(rk[k], kf); const float wk = __expf(AA[t0 + r] - Mc2);
#pragma unroll
            for (int j = 0; j < 8; ++j) KwT[(c8 + j) * 72 + r] = (bf16)f2bf(kf[j] * wk); }
        if (tid < 256) { const int r = tid >> 2, e8 = (tid & 3) * 8; const unsigned wv[4] = {rv.x, rv.y, rv.z, rv.w};
#pragma unroll
            for (int j = 0; j < 4; ++j) { Vt[(e8 + 2 * j) * 72 + r] = (bf16)(wv[j] & 0xffff); Vt[(e8 + 2 * j + 1) * 72 + r] = (bf16)(wv[j] >> 16); } }
        if (c + 1 < 64) ML_LOAD(c + 1);
        __syncthreads();
#pragma unroll
        for (int q = 0; q < 2; ++q) { const int tile = 2 * w + q, tm = tile >> 2, tn = tile & 3; const int t = tm * 16 + (lane & 15), l0 = tn * 16 + 4 * (lane >> 4);
            f32x4 s = (f32x4){0.f, 0.f, 0.f, 0.f};
            if (tn <= tm) s = lds_mma(Qs, 136, Ks, 136, tm, tn, 128, lane, s);
            const float mxt = MX[t0 + t]; float pvv[4];
#pragma unroll
            for (int j = 0; j < 4; ++j) { const int l = l0 + j; pvv[j] = (l <= t) ? s[j] * __expf(AA[t0 + l] - mxt) : 0.f; }
            u32x2 pw; pw.x = pk2(pvv[0], pvv[1]); pw.y = pk2(pvv[2], pvv[3]); *(LAS u32x2*)(Ps + t * 72 + l0) = pw; }
        __syncthreads();
        for (int tile = w; tile < 12; tile += 8) { const int tm = tile / 3, tn = tile % 3; const int t = tm * 16 + (lane & 15);
            f32x4 a1 = lds_mma(Ps, 72, Vt, 72, tm, tn, 64, lane, (f32x4){0.f, 0.f, 0.f, 0.f});
            f32x4 a2 = lds_mma(Qs, 136, CT, 136, tm, tn, 128, lane, (f32x4){0.f, 0.f, 0.f, 0.f});
            const float wst = __expf(Mc - MX[t0 + t]);
            *(LAS f32x4*)(NUM + t * 48 + tn * 16 + 4 * (lane >> 4)) = (a1 + a2 * wst) * scale; }
        __syncthreads();
        { const int t = tid >> 3, e4 = (tid & 7) * 4; const size_t tt = tok0 + t0 + t;
          const float den = NUM[t * 48 + 32], mrow = IG[t0 + t] - AA[t0 + t] + MX[t0 + t];
          const float inv = 1.f / fmaxf(fabsf(den), __expf(-mrow));
          const f32x4 nv = *(const LAS f32x4*)(NUM + t * 48 + e4);
          const u32x2 og = *(const u32x2*)(PAB + tt * AB_PAD + 2048 + h * 256 + dvs * 32 + e4);
          u32x2 o; o.x = pk2(sigmoidf_(lo_bf(og.x)) * nv[0] * inv, sigmoidf_(hi_bf(og.x)) * nv[1] * inv); o.y = pk2(sigmoidf_(lo_bf(og.y)) * nv[2] * inv, sigmoidf_(hi_bf(og.y)) * nv[3] * inv);
          *(u32x2*)(YCAT + tt * DM + h * 256 + dvs * 32 + e4) = o; }
        { const float decay = __expf(Mc - Mc2);
#pragma unroll
          for (int tm = 0; tm < 3; ++tm) { accC[tm] = lds_mma(Vt, 72, KwT, 72, tm, w, 64, lane, accC[tm] * decay);
              u32x2 cw; cw.x = pk2(accC[tm][0], accC[tm][1]); cw.y = pk2(accC[tm][2], accC[tm][3]);
              *(LAS u32x2*)(CT + (tm * 16 + (lane & 15)) * 136 + w * 16 + 4 * (lane >> 4)) = cw; } }
        __syncthreads();
    }
#undef ML_LOAD
}

__device__ __forceinline__ void phase_rowstat(const Ctx& C) {
    const bf16* XR = WSP(bf16, WS_XR); float* RS = WSP(float, WS_TAB + TAB_RSTD);
    for (int r = C.gw; r < T; r += C.ngw) { const u32x4* xr = (const u32x4*)(XR + (size_t)r * DM); float s = 0.f;
#pragma unroll
        for (int j = 0; j < 4; ++j) { float f[8]; unpack8(xr[j * 64 + C.lane], f);
#pragma unroll
            for (int q = 0; q < 8; ++q) s += f[q] * f[q]; }
        s = wave_sum(s); if (C.lane == 0) RS[r] = rsqrtf(s * (1.f / DM) + EPS); }
}
__device__ __forceinline__ void phase_softmax256(const Ctx& C) {
    const float* SC = ARP(float, A_SC); bf16* PC = ARP(bf16, A_PC);
    for (int it = C.gw; it < T * 4; it += C.ngw) { const size_t o = (size_t)it * 256 + C.lane * 4;
        const f32x4 v = *(const f32x4*)(SC + o); const float m = wave_max(fmaxf(fmaxf(v.x, v.y), fmaxf(v.z, v.w)));
        const float e0 = __expf(v.x - m), e1 = __expf(v.y - m), e2 = __expf(v.z - m), e3 = __expf(v.w - m);
        const float inv = 1.f / wave_sum(e0 + e1 + e2 + e3);
        u32x2 w; w.x = pk2(e0 * inv, e1 * inv); w.y = pk2(e2 * inv, e3 * inv); *(u32x2*)(PC + o) = w; }
}
constexpr int MOE_NB = 256, MOE_TPB = T / MOE_NB;
__device__ __forceinline__ void phase_route(const Ctx& C, const Args& A, int l) {
    const float* LG = ARP(float, A_XS); constexpr size_t PL = (size_t)T * 256;     int* EID = ARP(int, A_EID); float* WTS = ARP(float, A_WTS); int* LRANK = ARP(int, A_LRANK); int* BH = ARP(int, A_BHIST);
    const float *bg = INP(I_MOE_BG) + l * 8, *be = INP(I_MOE_BE) + l * 64;
    LAS int* hist = (LAS int*)(C.lds + LDS_AUX);
    for (int bk = C.bid; bk < MOE_NB; bk += C.G) {
        __syncthreads();
        if (C.tid < 64) hist[C.tid] = 0;
        __syncthreads();
        if (C.tid < MOE_TPB) { const int t = bk * MOE_TPB + C.tid; const float* L = LG + (size_t)t * 256;
            float lg[8], mx = -INFINITY; int grp = 0;
#pragma unroll
            for (int g = 0; g < 8; ++g) { lg[g] = ((L[g] + L[PL + g]) + (L[2 * PL + g] + L[3 * PL + g])) + bg[g]; if (lg[g] > mx) { mx = lg[g]; grp = g; } }
            float se = 0.f;
#pragma unroll
            for (int g = 0; g < 8; ++g) se += __expf(lg[g] - mx);
            const float pgrp = 1.f / se;
            float l1 = -INFINITY, l2 = -INFINITY; int i1 = 0, i2 = 0;
            for (int j = 0; j < 8; ++j) { const int x = 8 + grp * 8 + j; const float v = ((L[x] + L[PL + x]) + (L[2 * PL + x] + L[3 * PL + x])) + be[grp * 8 + j];
                if (v > l1) { l2 = l1; i2 = i1; l1 = v; i1 = j; } else if (v > l2) { l2 = v; i2 = j; } }
            const float w1 = 1.f / (1.f + __expf(l2 - l1)), w2 = 1.f - w1;
            const int e1 = grp * 8 + i1, e2 = grp * 8 + i2;
            EID[2 * t] = e1; EID[2 * t + 1] = e2; WTS[2 * t] = pgrp * w1; WTS[2 * t + 1] = pgrp * w2;
            LRANK[2 * t] = atomicAdd((int*)(hist + e1), 1); LRANK[2 * t + 1] = atomicAdd((int*)(hist + e2), 1); }
        __syncthreads();
        if (C.tid < 64) BH[bk * 64 + C.tid] = hist[C.tid];
    }
}
__device__ __forceinline__ void phase_gather(const Ctx& C, int l) {
    LAS int* tab = (LAS int*)(C.lds + LDS_AUX);
    const int* BH = ARP(int, A_BHIST); const int* EID = ARP(int, A_EID); const int* LRANK = ARP(int, A_LRANK); int* ROWSLOT = ARP(int, A_ROWSLOT); const bf16* XNp = WSP(bf16, WS_XR); bf16* XS = ARP(bf16, A_XS);
    unsigned* cnt = WSP(unsigned, WS_CTL) + CW_MOE_CNT + l * 64;
    for (int bk = C.bid; bk < MOE_NB; bk += C.G) {
        __syncthreads();
        if (C.tid < 64) { int tot = 0, before = 0;
            for (int q = 0; q < MOE_NB; ++q) { const int v = BH[q * 64 + C.tid]; tot += v; if (q < bk) before += v; }
            tab[C.tid] = tot; tab[64 + C.tid] = before; if (bk == 0) cnt[C.tid] = (unsigned)tot; }
        __syncthreads();
        if (C.tid == 0) { int off = 0; for (int e = 0; e < 64; ++e) { const int n = tab[e]; tab[e] = off; off += ((n + 255) >> 8) << 8; } }
        __syncthreads();
        if (C.tid < 2 * MOE_TPB) { const int a = bk * 2 * MOE_TPB + C.tid, e = EID[a], pos = tab[e] + tab[64 + e] + LRANK[a]; tab[128 + C.tid] = pos; ROWSLOT[pos] = a; }
        __syncthreads();
    }
}
__device__ __forceinline__ void phase_combine_norm(const Ctx& C, const float* gain, float* OUT) {
    bf16* XR = WSP(bf16, WS_XR); const bf16* YE = ARP(bf16, A_YE); float* RS = WSP(float, WS_RSQ) + (size_t)4 * T * 8; const int lane = C.lane;
    for (int t = C.gw; t < T; t += C.ngw) { bf16* xr = XR + (size_t)t * DM; const bf16* y0 = YE + (size_t)(2 * t) * DM; const bf16* y1 = y0 + DM;
        float v[4][8]; float s = 0.f; u32x4 rx[4], ra[4], rb[4];
#pragma unroll
        for (int j = 0; j < 4; ++j) { const int o = (j * 64 + lane) * 8; rx[j] = *(const u32x4*)(xr + o); ra[j] = *(const u32x4*)(y0 + o); rb[j] = *(const u32x4*)(y1 + o); }
#pragma unroll
        for (int j = 0; j < 4; ++j) { const int o = (j * 64 + lane) * 8; float a[8], b0[8]; unpack8(rx[j], v[j]); unpack8(ra[j], a); unpack8(rb[j], b0);
#pragma unroll
            for (int q = 0; q < 8; ++q) v[j][q] += a[q] + b0[q];
            if (!OUT) { const u32x4 w = pack8f(v[j]); *(u32x4*)(xr + o) = w; unpack8(w, v[j]); }
#pragma unroll
            for (int q = 0; q < 8; ++q) s += v[j][q] * v[j][q]; }
        const float ssq = wave_sum(s), rstd = rstd_of(ssq);
        if (!OUT) { if (lane < 8) RS[(size_t)t * 8 + lane] = (lane == 0) ? ssq : 0.f; }
        else {
#pragma unroll
            for (int j = 0; j < 4; ++j) { const int o = (j * 64 + lane) * 8; const f32x4 g0 = *(const f32x4*)(gain + o), g1 = *(const f32x4*)(gain + o + 4);
                *(f32x4*)(OUT + (size_t)t * DM + o) = (f32x4){v[j][0] * rstd * g0.x, v[j][1] * rstd * g0.y, v[j][2] * rstd * g0.z, v[j][3] * rstd * g0.w};
                *(f32x4*)(OUT + (size_t)t * DM + o + 4) = (f32x4){v[j][4] * rstd * g1.x, v[j][5] * rstd * g1.y, v[j][6] * rstd * g1.z, v[j][7] * rstd * g1.w}; } }
    }
}

__device__ __forceinline__ float gelu_tanh(float x) { return 0.5f * x * (1.f + tanhf(0.7978845608028654f * (x + 0.044715f * x * x * x))); }
__device__ __forceinline__ void phase_cmp_finish(const Ctx& C, const Args& A) {
    const float* CP = ARP(float, A_CPART); const float* bias = WSP(float, WS_TAB + TAB_CMPBIAS); const float* w2 = INP(I_CMP_W2);
    LAS float* hid = (LAS float*)C.lds + C.wave * 128; const int lane = C.lane;
    for (int it = C.gw; it < 2 * 16 * 256; it += C.ngw) { const int j = it & 255, bg = (it >> 8) & 15, kv = it >> 12;
        bf16* dst = ARP(bf16, kv ? A_VCMP : A_KCMP) + ((size_t)bg * 256 + j) * 128;
        bf16* dstT = ARP(bf16, A_VCT) + (size_t)bg * 128 * 256 + j;
        if (j == 255) { dst[lane] = 0; dst[lane + 64] = 0; if (kv) { dstT[(size_t)lane * 256] = 0; dstT[(size_t)(lane + 64) * 256] = 0; } continue; }
        float h0 = bias[kv * 128 + lane], h1 = bias[kv * 128 + 64 + lane];
#pragma unroll
        for (int ks = 0; ks < 8; ++ks) { const float* p = CP + ((size_t)((ks * 2 + kv) * 16 + bg) * 256 + j) * 256; h0 += p[lane]; h1 += p[64 + lane]; }
        hid[lane] = gelu_tanh(h0); hid[64 + lane] = gelu_tanh(h1); LDS_WAIT(); asm volatile("" ::: "memory");
        float o0 = 0.f, o1 = 0.f; const float* W = w2 + (size_t)kv * 128 * 128;
        for (int e = 0; e < 128; ++e) { const float hv = hid[e]; o0 += hv * W[e * 128 + lane]; o1 += hv * W[e * 128 + 64 + lane]; }
        dst[lane] = (bf16)f2bf(o0); dst[lane + 64] = (bf16)f2bf(o1); if (kv) { dstT[(size_t)lane * 256] = (bf16)f2bf(o0); dstT[(size_t)(lane + 64) * 256] = (bf16)f2bf(o1); } LDS_WAIT(); asm volatile("" ::: "memory"); }
}
__device__ __forceinline__ void phase_cmp_attn(const Ctx& C) {
    const bf16 *Q = ARP(bf16, A_Q), *KC = ARP(bf16, A_KCMP), *VC = ARP(bf16, A_VCMP); const float* GATES = ARP(float, A_GATES);
    float* OACC = ARP(float, A_OACC); unsigned long long* SELM = ARP(unsigned long long, A_SELMASK);
    LAS float* qs = (LAS float*)C.lds + C.wave * 1536;
    LAS float* ps = qs + 512; const int lane = C.lane; const float scale = 0.08838834764831845f;
    for (int it = C.gw; it < T * 4; it += C.ngw) { const int t = it >> 2, g = it & 3, b = t >> 12, s = t & 4095;
        const int nvalid = (s >= 31) ? ((s - 31) >> 4) + 1 : 0;
#pragma unroll
        for (int r = 0; r < 4; ++r) { const bf16* qp = Q + (((size_t)(b * 16 + g * 4 + r)) * SEQ + s) * 128; qs[r * 128 + lane] = bf2f(qp[lane]); qs[r * 128 + 64 + lane] = bf2f(qp[64 + lane]); }
        LDS_WAIT(); asm volatile("" ::: "memory");
        float sc[4][4];
#pragma unroll
        for (int i = 0; i < 4; ++i) { const int j = lane + 64 * i;
#pragma unroll
            for (int r = 0; r < 4; ++r) sc[r][i] = 0.f;
            if (j < nvalid) { const bf16* kp = KC + ((size_t)(b * 4 + g) * 256 + j) * 128;
                for (int d8 = 0; d8 < 16; ++d8) { float kf[8]; unpack8(*(const u32x4*)(kp + d8 * 8), kf);
#pragma unroll
                    for (int r = 0; r < 4; ++r) { float a = 0.f;
#pragma unroll
                        for (int jj = 0; jj < 8; ++jj) a += qs[r * 128 + d8 * 8 + jj] * kf[jj];
                        sc[r][i] += a; } } } }
#pragma unroll
        for (int r = 0; r < 4; ++r) { float m = -INFINITY;
#pragma unroll
            for (int i = 0; i < 4; ++i) if (lane + 64 * i < nvalid) m = fmaxf(m, sc[r][i] * scale);
            m = wave_max(m); if (!(m > -INFINITY)) m = 0.f; float e[4], sum = 0.f;
#pragma unroll
            for (int i = 0; i < 4; ++i) { e[i] = (lane + 64 * i < nvalid) ? __expf(sc[r][i] * scale - m) : 0.f; sum += e[i]; }
            sum = wave_sum(sum); const float inv = sum > 0.f ? 1.f / sum : 1.f;
#pragma unroll
            for (int i = 0; i < 4; ++i) ps[r * 256 + lane + 64 * i] = e[i] * inv; }
        LDS_WAIT(); asm volatile("" ::: "memory");
        float o[4][2];
#pragma unroll
        for (int r = 0; r < 4; ++r) { o[r][0] = 0.f; o[r][1] = 0.f; }
        for (int j = 0; j < nvalid; ++j) { const bf16* vp = VC + ((size_t)(b * 4 + g) * 256 + j) * 128; const float v0 = bf2f(vp[lane]), v1 = bf2f(vp[64 + lane]);
#pragma unroll
            for (int r = 0; r < 4; ++r) { const float p = ps[r * 256 + j]; o[r][0] += p * v0; o[r][1] += p * v1; } }
#pragma unroll
        for (int r = 0; r < 4; ++r) { const float gt = GATES[(size_t)t * 48 + g * 4 + r]; float* op = OACC + (size_t)t * DM + (g * 4 + r) * 128; op[lane] = gt * o[r][0]; op[64 + lane] = gt * o[r][1]; }
        float imp = 0.f;
#pragma unroll
        for (int r = 0; r < 4; ++r) { const LAS float* p = ps + r * 256; const int j0 = 4 * lane;
            imp += (j0 > 0 ? 0.5f * p[j0 - 1] : 0.f) + p[j0] + p[j0 + 1] + p[j0 + 2] + 0.5f * p[j0 + 3]; }
        const int cur = s >> 6; float score;
        if (lane == 0 || lane == cur || lane == cur - 1) score = INFINITY; else score = (lane <= cur) ? imp : -INFINITY;
        int rank = 0;
        for (int o2 = 0; o2 < 64; ++o2) { const float so = __int_as_float(__builtin_amdgcn_readlane(__float_as_int(score), o2)); rank += (so > score || (so == score && o2 < lane)) ? 1 : 0; }
        const unsigned long long m = __ballot(rank < 16 && score > -INFINITY);
        if (lane == 0) SELM[(size_t)t * 4 + g] = m;
        LDS_WAIT(); asm volatile("" ::: "memory");
    }
}
struct NaiveAttnState { float m[4], l[4], o[4][2]; };
__device__ __forceinline__ void naive_tile(NaiveAttnState& S, const LAS float* qs, LAS float* pt, const bf16* Kt, const bf16* Vt_, int key0, bool valid, int lane) {
    float sc[4] = {0.f, 0.f, 0.f, 0.f}; const float scale = 0.08838834764831845f;
    if (valid) { const bf16* kp = Kt + (size_t)(key0 + lane) * 128;
        for (int d8 = 0; d8 < 16; ++d8) { float kf[8]; unpack8(*(const u32x4*)(kp + d8 * 8), kf);
#pragma unroll
            for (int r = 0; r < 4; ++r) { float a = 0.f;
#pragma unroll
                for (int jj = 0; jj < 8; ++jj) a += qs[r * 128 + d8 * 8 + jj] * kf[jj];
                sc[r] += a; } } }
    const unsigned long long vm = __ballot(valid);
    if (vm == 0ull) return;
#pragma unroll
    for (int r = 0; r < 4; ++r) { const float sv = valid ? sc[r] * scale : -INFINITY; const float mt = wave_max(sv), mn = fmaxf(S.m[r], mt);
        const float alpha = __expf(S.m[r] - mn), p = valid ? __expf(sv - mn) : 0.f;
        S.l[r] = S.l[r] * alpha + wave_sum(p); S.o[r][0] *= alpha; S.o[r][1] *= alpha; S.m[r] = mn; pt[r * 64 + lane] = p; }
    LDS_WAIT(); asm volatile("" ::: "memory");
    for (int k = 0; k < 64; ++k) { if (!((vm >> k) & 1ull)) continue; const bf16* vp = Vt_ + (size_t)(key0 + k) * 128; const float v0 = bf2f(vp[lane]), v1 = bf2f(vp[64 + lane]);
#pragma unroll
        for (int r = 0; r < 4; ++r) { const float p = pt[r * 64 + k]; S.o[r][0] += p * v0; S.o[r][1] += p * v1; } }
    LDS_WAIT(); asm volatile("" ::: "memory");
}
__device__ __forceinline__ void phase_selwin_naive(const Ctx& C, bf16* OCAT) {
    const bf16* QR = ARP(bf16, A_QROT); const float* GATES = ARP(float, A_GATES); const float* OACC = ARP(float, A_OACC);
    const unsigned long long* SELM = ARP(const unsigned long long, A_SELMASK);
    const bf16* KS = (const bf16*)(C.ws + WS_ARENA + A_KV6 + 2 * KV6_STRIDE); const bf16* VS = (const bf16*)(C.ws + WS_ARENA + A_KV6 + 3 * KV6_STRIDE);
    const bf16* KW = (const bf16*)(C.ws + WS_ARENA + A_KV6 + 4 * KV6_STRIDE); const bf16* VW = (const bf16*)(C.ws + WS_ARENA + A_KV6 + 5 * KV6_STRIDE);
    LAS float* qs = (LAS float*)C.lds + C.wave * 768; LAS float* pt = qs + 512; const int lane = C.lane;
    for (int it = C.gw; it < T * 4; it += C.ngw) { const int t = it >> 2, g = it & 3, b = t >> 12, s = t & 4095; const size_t slab = (size_t)(b * 4 + g) * SPAD * 128;
#pragma unroll
        for (int r = 0; r < 4; ++r) { const bf16* qp = QR + (((size_t)(b * 16 + g * 4 + r)) * SEQ + s) * 128; qs[r * 128 + lane] = bf2f(qp[lane]); qs[r * 128 + 64 + lane] = bf2f(qp[64 + lane]); }
        LDS_WAIT(); asm volatile("" ::: "memory");
        float res[4][2];
#pragma unroll
        for (int r = 0; r < 4; ++r) { res[r][0] = OACC[(size_t)t * DM + (g * 4 + r) * 128 + lane]; res[r][1] = OACC[(size_t)t * DM + (g * 4 + r) * 128 + 64 + lane]; }
        { NaiveAttnState S;
#pragma unroll
          for (int r = 0; r < 4; ++r) { S.m[r] = -1e30f; S.l[r] = 0.f; S.o[r][0] = 0.f; S.o[r][1] = 0.f; }
          const unsigned long long m = SELM[(size_t)t * 4 + g];
          for (int blk = 0; blk <= (s >> 6); ++blk) if ((m >> blk) & 1ull) naive_tile(S, qs, pt, KS + slab, VS + slab, blk * 64, blk * 64 + lane <= s, lane);
#pragma unroll
          for (int r = 0; r < 4; ++r) { const float gt = GATES[(size_t)t * 48 + 16 + g * 4 + r], inv = S.l[r] > 0.f ? 1.f / S.l[r] : 0.f; res[r][0] += gt * S.o[r][0] * inv; res[r][1] += gt * S.o[r][1] * inv; } }
        { NaiveAttnState S;
#pragma unroll
          for (int r = 0; r < 4; ++r) { S.m[r] = -1e30f; S.l[r] = 0.f; S.o[r][0] = 0.f; S.o[r][1] = 0.f; }
          const int lo = s - 511 > 0 ? s - 511 : 0;
          for (int k0 = lo & ~63; k0 <= s; k0 += 64) naive_tile(S, qs, pt, KW + slab, VW + slab, k0, (k0 + lane >= lo) && (k0 + lane <= s), lane);
#pragma unroll
          for (int r = 0; r < 4; ++r) { const float gt = GATES[(size_t)t * 48 + 32 + g * 4 + r], inv = S.l[r] > 0.f ? 1.f / S.l[r] : 0.f; res[r][0] += gt * S.o[r][0] * inv; res[r][1] += gt * S.o[r][1] * inv; } }
#pragma unroll
        for (int r = 0; r < 4; ++r) { bf16* op = OCAT + (size_t)t * DM + (g * 4 + r) * 128; op[lane] = (bf16)f2bf(res[r][0]); op[64 + lane] = (bf16)f2bf(res[r][1]); }
    }
}


__device__ __forceinline__ void phase_cmp_attn_mma(const Ctx& C, bool side_cvt) {
    const bf16 *Q = ARP(bf16, A_Q), *KC = ARP(bf16, A_KCMP), *VCT = ARP(bf16, A_VCT); const float* GATES = ARP(float, A_GATES);
    float* OACC = ARP(float, A_OACC); unsigned long long* SELM = ARP(unsigned long long, A_SELMASK);
    LAS bf16* Qs = (LAS bf16*)C.lds;
    LAS bf16* Ks = Qs + 128 * 136;
    LAS bf16* Pm = (LAS bf16*)C.lds;
    LAS bf16* Vt = Pm + 128 * 264;
    const int w = C.wave; const float scale = 0.08838834764831845f;
    for (int it = C.bid; it < 2048; it += C.G) { int tid = C.tid; asm volatile("" : "+v"(tid)); const int lane = tid & 63;     const int bg = it >> 7, tt = ((it / C.G) & 1) ? 127 - (it & 127) : (it & 127), b = bg >> 2, g = bg & 3, t0 = tt * 32;
        const int nv = t0 / 16 + 1 > 255 ? 255 : ((t0 + 31 >= 31) ? t0 / 16 + 1 : 0);
        const int nct = (nv + 15) >> 4, kmax = ((nv + 31) >> 5) << 5;
        f32x4 cvv[2][8]; MoeTile mt = moe_tile_decode(C, MOE_CVT_BASE_E + (it * 8 + w) * 2); if (side_cvt) moe_pair_load(mt, cvv, lane);
        __syncthreads();
#pragma unroll
        for (int k = 0; k < 4; ++k) { const int idx = tid + 512 * k, row = idx >> 4, c8 = (idx & 15) * 8, r = row >> 5, tl = row & 31;
            *(LAS u32x4*)(Qs + row * 136 + c8) = *(const u32x4*)(Q + (((size_t)(b * 16 + g * 4 + r)) * SEQ + t0 + tl) * 128 + c8); }
        { u32x4 tk[8];
#pragma unroll
          for (int k = 0; k < 8; ++k) { const int idx = tid + 512 * k, row = idx >> 4, c8 = (idx & 15) * 8; tk[k] = (u32x4){0u, 0u, 0u, 0u};
              if (row < nct * 16) tk[k] = *(const u32x4*)(KC + ((size_t)bg * 256 + row) * 128 + c8); }
#pragma unroll
          for (int k = 0; k < 8; ++k) { const int idx = tid + 512 * k, row = idx >> 4, c8 = (idx & 15) * 8; *(LAS u32x4*)(Ks + row * 136 + c8) = tk[k]; } }
        __syncthreads();
        f32x4 sacc[16];
        { bf16x8 qa[4];
#pragma unroll
          for (int k = 0; k < 4; ++k) qa[k] = *(const LAS bf16x8*)(Qs + (w * 16 + (lane & 15)) * 136 + (lane >> 4) * 8 + 32 * k);
#pragma unroll
          for (int ct = 0; ct < 16; ++ct) { sacc[ct] = (f32x4){0.f, 0.f, 0.f, 0.f};
              if (ct < nct) { const LAS bf16* bp = Ks + (ct * 16 + (lane & 15)) * 136 + (lane >> 4) * 8;
#pragma unroll
                  for (int k = 0; k < 4; ++k) sacc[ct] = __builtin_amdgcn_mfma_f32_16x16x32_bf16(*(const LAS bf16x8*)(bp + 32 * k), qa[k], sacc[ct], 0, 0, 0); } } }
        const int trow = t0 + (w & 1) * 16 + (lane & 15);
        const int nvr = (trow >= 31) ? ((trow - 31) >> 4) + 1 : 0;
        float m = -INFINITY;
#pragma unroll
        for (int ct = 0; ct < 16; ++ct)
#pragma unroll
            for (int j = 0; j < 4; ++j) { const int key = ct * 16 + 4 * (lane >> 4) + j; const float v = (key < nvr) ? sacc[ct][j] * scale : -INFINITY; sacc[ct][j] = v; m = fmaxf(m, v); }
        m = fmaxf(m, xor16f(m)); m = fmaxf(m, xor32f(m)); if (!(m > -INFINITY)) m = 0.f;
        float sum = 0.f;
#pragma unroll
        for (int ct = 0; ct < 16; ++ct)
#pragma unroll
            for (int j = 0; j < 4; ++j) { const float e = __expf(sacc[ct][j] - m); sacc[ct][j] = e; sum += e; }
        sum += xor16f(sum); sum += xor32f(sum);
        const float inv = sum > 0.f ? 1.f / sum : 1.f;
        __syncthreads();
#pragma unroll
        for (int ct = 0; ct < 16; ++ct) if (ct * 16 < kmax) { u32x2 pw; pw.x = pk2(sacc[ct][0] * inv, sacc[ct][1] * inv); pw.y = pk2(sacc[ct][2] * inv, sacc[ct][3] * inv);
            *(LAS u32x2*)(Pm + (w * 16 + (lane & 15)) * 264 + ct * 16 + 4 * (lane >> 4)) = pw; }
        { u32x4 tv[8];
#pragma unroll
          for (int k = 0; k < 8; ++k) { const int idx = tid + 512 * k, d = idx >> 5, j8 = (idx & 31) * 8; tv[k] = (u32x4){0u, 0u, 0u, 0u};
              if (j8 < kmax) tv[k] = *(const u32x4*)(VCT + ((size_t)bg * 128 + d) * 256 + j8); }
#pragma unroll
          for (int k = 0; k < 8; ++k) { const int idx = tid + 512 * k, d = idx >> 5, j8 = (idx & 31) * 8; *(LAS u32x4*)(Vt + d * 264 + j8) = tv[k]; } }
        __syncthreads();
        { const int r = w >> 1, tl = (w & 1) * 16 + (lane & 15), t = b * SEQ + t0 + tl, hh = g * 4 + r; const float gt = GATES[(size_t)t * 48 + hh];
          float* op = OACC + (size_t)t * DM + hh * 128 + 4 * (lane >> 4);
          bf16x8 pa[8];
#pragma unroll
          for (int k = 0; k < 8; ++k) { pa[k] = (bf16x8){0, 0, 0, 0, 0, 0, 0, 0}; if (k * 32 < kmax) pa[k] = *(const LAS bf16x8*)(Pm + (w * 16 + (lane & 15)) * 264 + (lane >> 4) * 8 + 32 * k); }
#pragma unroll
          for (int dt = 0; dt < 8; ++dt) { f32x4 o = (f32x4){0.f, 0.f, 0.f, 0.f}; const LAS bf16* bp = Vt + (dt * 16 + (lane & 15)) * 264 + (lane >> 4) * 8;
#pragma unroll
              for (int k = 0; k < 8; ++k) if (k * 32 < kmax) o = __builtin_amdgcn_mfma_f32_16x16x32_bf16(*(const LAS bf16x8*)(bp + 32 * k), pa[k], o, 0, 0, 0);
              *(f32x4*)(op + dt * 16) = o * gt; } }
        { float score[4]; const int cur = (t0 + w * 4) >> 6;
#pragma unroll
          for (int q = 0; q < 4; ++q) { const int tl = w * 4 + q; float imp = 0.f;
            if (kmax > 0) {
#pragma unroll
                for (int r = 0; r < 4; ++r) { const LAS bf16* p = Pm + (r * 32 + tl) * 264; const int j0 = 4 * lane;
                    if (j0 < kmax) { const u32x2 pw = *(const LAS u32x2*)(p + j0); imp += lo_bf(pw.x) + hi_bf(pw.x) + lo_bf(pw.y) + 0.5f * hi_bf(pw.y); if (j0 > 0) imp += 0.5f * bf2f(p[j0 - 1]); } } }
            if (lane == 0 || lane == cur || lane == cur - 1) score[q] = INFINITY; else score[q] = (lane <= cur) ? imp : -INFINITY; }
          int rank[4] = {0, 0, 0, 0};
          for (int o2 = 0; o2 <= cur; ++o2) {
#pragma unroll
              for (int q = 0; q < 4; ++q) { const float so = __int_as_float(__builtin_amdgcn_readlane(__float_as_int(score[q]), o2)); rank[q] += (so > score[q] || (so == score[q] && o2 < lane)) ? 1 : 0; } }
#pragma unroll
          for (int q = 0; q < 4; ++q) { const unsigned long long mk = __ballot(rank[q] < 16 && score[q] > -INFINITY);
              if (lane == 0) SELM[(size_t)(b * SEQ + t0 + w * 4 + q) * 4 + g] = mk; } }
        if (side_cvt) moe_pair_store(mt, cvv, lane);
    }
    __syncthreads();
}

namespace swa {
constexpr int D = 128, NW = 8, QBLK = 32, KVBLK = 64, QB = NW * QBLK;
constexpr int SHM_V = KVBLK * D * 2, SHM_K = KVBLK * D * 2;
constexpr int LDS_BYTES = 2 * SHM_V + 2 * SHM_K + NW * 64 * 4;
constexpr float SCALE = 0.08838834764831845f, THR = 8.f;
typedef short s16x4 __attribute__((ext_vector_type(4)));
typedef float f32x16 __attribute__((ext_vector_type(16)));
#define KSWZ(row, colB) ((row) * 256 + ((colB) ^ (((row) & 7) << 4)))
#define SBAR() __builtin_amdgcn_sched_barrier(0)
__device__ __forceinline__ int v_st(int k, int c) { const int kk = (k & ~0xC) | ((k & 4) << 1) | ((k & 8) >> 1); return ((kk >> 3) * 4 + (c >> 5)) * 512 + ((kk & 7) * 32 + (c & 31)) * 2; }
__device__ __forceinline__ int v_rd_base(int lane) { return ((lane & 3) << 3) | (((lane >> 2) & 3) << 6) | (((lane >> 4) & 1) << 5) | (((lane >> 5) & 1) << 8); }
constexpr int v_rd_off(int d0, int ks, int half) { return d0 * 512 + ks * 4096 + half * 2048; }
__device__ __forceinline__ int crow(int r, int hi) { return (r & 3) + 8 * (r >> 2) + 4 * hi; }
__device__ __forceinline__ unsigned cvtpk(float lo, float hi) { unsigned r; asm volatile("v_cvt_pk_bf16_f32 %0, %1, %2" : "=v"(r) : "v"(lo), "v"(hi)); return r; }
__device__ __forceinline__ bf16x8 load8(const bf16* p) { return *reinterpret_cast<const bf16x8*>(p); }
__device__ __forceinline__ void mask_tile(f32x16& p0, f32x16& p1, int dq, unsigned W) {
    const float NEG = -__builtin_inff();
    asm volatile("" : "+v"(dq));
#pragma unroll
    for (int r = 0; r < 16; ++r) { const int c = (r & 3) + 8 * (r >> 2);
        if ((unsigned)(dq - c) >= W) p0[r] = NEG;
        if ((unsigned)(dq - c - 32) >= W) p1[r] = NEG; }
}
__device__ __forceinline__ void mask_all(f32x16& p0, f32x16& p1, bool on) {
    const float NEG = -__builtin_inff();
#pragma unroll
    for (int r = 0; r < 16; ++r) { p0[r] = on ? p0[r] : NEG; p1[r] = on ? p1[r] : NEG; }
}
__device__ __forceinline__ void partialSM(f32x16& p0, f32x16& p1, float& m_reg, float& mn, float& alpha) {
    float pmax = p0[0]; for (int r = 1; r < 16; ++r) pmax = fmaxf(pmax, p0[r]); for (int r = 0; r < 16; ++r) pmax = fmaxf(pmax, p1[r]);
    { auto rr = __builtin_amdgcn_permlane32_swap(__float_as_uint(pmax), __float_as_uint(pmax), false, false);
      pmax = fmaxf(__uint_as_float(rr[0]), __uint_as_float(rr[1])); }
    constexpr float C2 = 1.4426950408889634f * SCALE;
    if (__builtin_expect(__all((pmax - m_reg) * SCALE <= THR), 1)) { mn = m_reg; alpha = 1.f; }
    else { mn = fmaxf(m_reg, pmax); alpha = __builtin_amdgcn_exp2f((m_reg - mn) * C2); m_reg = mn; }
    const float mnL = -mn * C2;
    for (int r = 0; r < 16; ++r) p0[r] = fmaf(p0[r], C2, mnL); for (int r = 0; r < 16; ++r) p1[r] = fmaf(p1[r], C2, mnL);
    for (int r = 0; r < 16; ++r) p0[r] = __builtin_amdgcn_exp2f(p0[r]);
}
__device__ __forceinline__ void finishSM(f32x16& p0, f32x16& p1, float alpha, float& l_reg, bf16x8& pa0, bf16x8& pa1, bf16x8& pa2, bf16x8& pa3) {
    for (int r = 0; r < 16; ++r) p1[r] = __builtin_amdgcn_exp2f(p1[r]);
    float ps = 0; for (int r = 0; r < 16; ++r) ps += p0[r]; for (int r = 0; r < 16; ++r) ps += p1[r];
    { auto rr = __builtin_amdgcn_permlane32_swap(__float_as_uint(ps), __float_as_uint(ps), false, false);
      ps = __uint_as_float(rr[0]) + __uint_as_float(rr[1]); }
    l_reg = l_reg * alpha + ps;
#define PK4(P, B_, OUT) do { unsigned a0 = cvtpk(P[B_+0], P[B_+1]), a1 = cvtpk(P[B_+2], P[B_+3]);                          \
        unsigned b0 = cvtpk(P[B_+4], P[B_+5]), b1 = cvtpk(P[B_+6], P[B_+7]);                                             \
        auto r0 = __builtin_amdgcn_permlane32_swap(a0, b0, false, false); auto r1 = __builtin_amdgcn_permlane32_swap(a1, b1, false, false); \
        u32x4 w = {r0[0], r1[0], r0[1], r1[1]}; OUT = *reinterpret_cast<bf16x8*>(&w); } while (0)
    PK4(p0, 0, pa0); PK4(p0, 8, pa1); PK4(p1, 0, pa2); PK4(p1, 8, pa3);
#undef PK4
}
template <int KB>
__device__ __forceinline__ void qkt(f32x16& p0, f32x16& p1, const char* K_lds, int r32, int hi, const bf16x8* qr) {
    p0 = f32x16{}; p1 = f32x16{};
    const char* kb[4];
#pragma unroll
    for (int dd = 0; dd < 4; ++dd) kb[dd] = K_lds + KB * SHM_K + KSWZ(r32, (dd * 16 + hi * 8) * 2);
#pragma unroll
    for (int d0 = 0; d0 < 8; ++d0) { const char* a = kb[d0 & 3] + (d0 >> 2) * 128;
        bf16x8 b0 = *reinterpret_cast<const bf16x8*>(a);
        bf16x8 b1 = *reinterpret_cast<const bf16x8*>(a + 32 * 256);
        p0 = __builtin_amdgcn_mfma_f32_32x32x16_bf16(b0, qr[d0], p0, 0, 0, 0);
        p1 = __builtin_amdgcn_mfma_f32_32x32x16_bf16(b1, qr[d0], p1, 0, 0, 0); }
}
template <int VB>
__device__ __forceinline__ void pv_tile(f32x16* o, int vb0, bf16x8 pa0, bf16x8 pa1, bf16x8 pa2, bf16x8 pa3) {
#define TRRD(dst, off) asm volatile("ds_read_b64_tr_b16 %0, %1 offset:%2" : "=&v"(dst) : "v"(vb0), "i"(off) : "memory")
#define PV_D0(d0) do { s16x4 l0, l1, l2, l3, h0, h1, h2, h3; constexpr int b_ = VB * SHM_V + v_rd_off(d0, 0, 0);   \
        TRRD(l0, b_); TRRD(h0, b_ + 2048); TRRD(l1, b_ + 4096); TRRD(h1, b_ + 6144); TRRD(l2, b_ + 8192); TRRD(h2, b_ + 10240); TRRD(l3, b_ + 12288); TRRD(h3, b_ + 14336); \
        asm volatile("s_waitcnt lgkmcnt(0)" ::: "memory"); SBAR();   \
        o[d0] = __builtin_amdgcn_mfma_f32_32x32x16_bf16(pa0, (bf16x8){l0[0], l0[1], l0[2], l0[3], h0[0], h0[1], h0[2], h0[3]}, o[d0], 0, 0, 0);   \
        o[d0] = __builtin_amdgcn_mfma_f32_32x32x16_bf16(pa1, (bf16x8){l1[0], l1[1], l1[2], l1[3], h1[0], h1[1], h1[2], h1[3]}, o[d0], 0, 0, 0);   \
        o[d0] = __builtin_amdgcn_mfma_f32_32x32x16_bf16(pa2, (bf16x8){l2[0], l2[1], l2[2], l2[3], h2[0], h2[1], h2[2], h2[3]}, o[d0], 0, 0, 0);   \
        o[d0] = __builtin_amdgcn_mfma_f32_32x32x16_bf16(pa3, (bf16x8){l3[0], l3[1], l3[2], l3[3], h3[0], h3[1], h3[2], h3[3]}, o[d0], 0, 0, 0); } while (0)
    PV_D0(0); PV_D0(1); PV_D0(2); PV_D0(3);
#undef PV_D0
#undef TRRD
}
struct BlockRef { const bf16* Q; const bf16* K; const bf16* V; int P0, tok0, hh; };
struct Seam { bf16x8 qr[8]; bf16x8 st_v0, st_v1, st_k0, st_k1; };
__device__ __forceinline__ int swa_jlo(int P0, int W) { const int lowk = P0 - W + 1; return lowk > 0 ? lowk / KVBLK : 0; }
#define ROW(p, k0, rr) ((p) + (size_t)((k0) + (rr)) * D + sc)
#define VMW() asm volatile("s_waitcnt vmcnt(0)" ::: "memory")
#define VMWN(n) asm volatile("s_waitcnt vmcnt(%0)" :: "i"(n) : "memory")
#define SLOAD_H(Kp, Vp, k0) do { S.st_v0 = load8(ROW(Vp, k0, sr)); S.st_v1 = load8(ROW(Vp, k0, 32 + sr));              \
                         S.st_k0 = load8(ROW(Kp, k0, sr)); S.st_k1 = load8(ROW(Kp, k0, 32 + sr)); } while (0)
#define SWRITE_HK(bf) do { *(bf16x8*)(K_lds + (bf) * SHM_K + kws) = S.st_k0; *(bf16x8*)(K_lds + (bf) * SHM_K + kws + 32 * 256) = S.st_k1; } while (0)
#define SWRITE_HV(bf) do { *(bf16x8*)(V_lds + (bf) * SHM_V + vst0) = S.st_v0; *(bf16x8*)(V_lds + (bf) * SHM_V + vst1) = S.st_v1; } while (0)
#define SWRITE_H(bf) do { SWRITE_HV(bf); SWRITE_HK(bf); } while (0)
__device__ __forceinline__ int lane_id() { return (int)__builtin_amdgcn_mbcnt_hi(~0u, __builtin_amdgcn_mbcnt_lo(~0u, 0u)); }
__device__ __forceinline__ void prime(const BlockRef& cur, int W, char* lds, Seam& S, int wid) {
    (void)wid; const int tid = threadIdx.x, lane = tid & 63, r32 = lane & 31, hi = lane >> 5;
    const int sr = tid >> 4, sc = (tid & 15) * 8, kws = KSWZ(sr, sc * 2); char* K_lds = lds + 2 * SHM_V;
    const int kb0 = swa_jlo(cur.P0, W) * KVBLK;
    for (int d0 = 0; d0 < 8; ++d0) S.qr[d0] = load8(cur.Q + (size_t)(wid * QBLK + r32) * D + d0 * 16 + hi * 8);
    SLOAD_H(cur.K, cur.V, kb0); VMW(); SWRITE_HK(0);
    __syncthreads();
}
template <bool SEL, int MODE>
__device__ __forceinline__ void block(const BlockRef& cur, const BlockRef& nxt, int skv, int W, char* lds, Seam& S,
                                      const unsigned long long* SELM, const float* GATES, int gate_off, float* OACC, bf16* OCAT, int wid) {
    (void)wid; const int tid = threadIdx.x, lane = tid & 63, r32 = lane & 31, hi = lane >> 5;
    const int j_lo = swa_jlo(cur.P0, W);
    int j_hi = (cur.P0 + QB - 1) / KVBLK + 1; if (j_hi > skv / KVBLK) j_hi = skv / KVBLK;
    const int NT = j_hi - j_lo;
    const int kbn = swa_jlo(nxt.P0, W) * KVBLK;
    const int qlo = cur.P0 + wid * QBLK, qm = qlo + r32 - 4 * hi;
    char* V_lds = lds; char* K_lds = lds + 2 * SHM_V;
    float* ws = (float*)(lds + 2 * SHM_V + 2 * SHM_K) + wid * 64; float* li_l = ws, * al_l = ws + 32;
    float m_reg = -1e30f, l_reg = 0; f32x16 o[4] = {};
    const int sr = tid >> 4, sc = (tid & 15) * 8, vst0 = v_st(sr, sc), vst1 = vst0 + 8192  , kws = KSWZ(sr, sc * 2);
    const int vb0 = (int)(uintptr_t)V_lds + v_rd_base(lane);
    const bf16* Kh = cur.K; const bf16* Vh = cur.V;
    unsigned long long* selt = (unsigned long long*)(lds + LDS_BYTES) + wid * 32;
    if (SEL) { if (hi == 0) selt[r32] = SELM[(size_t)(cur.tok0 + wid * QBLK + r32) * 4 + (cur.hh >> 2)]; }
#define RESC(a) do { if (__any((a) < 1.f)) { if (hi == 0) al_l[r32] = (a); asm volatile("s_waitcnt lgkmcnt(0)" ::: "memory");              \
                     for (int d_ = 0; d_ < 4; ++d_) for (int r = 0; r < 16; ++r) o[d_][r] *= al_l[crow(r, hi)]; } } while (0)
#define KBASE(t) ((j_lo + (t)) * KVBLK)
#define MASKT(P0_, P1_, t) do { const int kb_ = KBASE(t); if (kb_ + KVBLK - 1 > qlo || kb_ <= qlo + QBLK - 1 - W) mask_tile(P0_, P1_, qm - kb_, (unsigned)W); \
                                if (SEL) { const unsigned long long sm_ = selt[r32]; mask_all(P0_, P1_, ((sm_ >> (j_lo + (t))) & 1ull) != 0ull); } } while (0)
    constexpr int NQL = 8;
#define SEAM_K0() do { VMWN(NQL); SWRITE_HK(0); SBAR(); } while (0)
    f32x16 pA0, pA1, pB0, pB1; float mnA, mnB, alA, alB; bf16x8 pa0, pa1, pa2, pa3;
    SWRITE_HV(0); SBAR();
    if (NT > 1) { SLOAD_H(Kh, Vh, KBASE(1)); }
    SBAR(); qkt<0>(pA0, pA1, K_lds, r32, hi, S.qr);
    MASKT(pA0, pA1, 0); partialSM(pA0, pA1, m_reg, mnA, alA);
    if (NT > 1) { VMW(); SWRITE_H(1); }
    __syncthreads();
#define HALF_STEP(PX0, PX1, mnX, alX, PY0, PY1, alY, t, KB, VB, SB) do {                                                      \
        SBAR(); qkt<KB>(PX0, PX1, K_lds, r32, hi, S.qr);                                             \
        finishSM(PY0, PY1, alY, l_reg, pa0, pa1, pa2, pa3); SBAR();                                                           \
        if ((t) + 1 < NT) { SLOAD_H(Kh, Vh, KBASE((t) + 1)); SBAR(); }                                               \
        pv_tile<VB>(o, vb0, pa0, pa1, pa2, pa3); MASKT(PX0, PX1, (t)); partialSM(PX0, PX1, m_reg, mnX, alX);                                        \
        __syncthreads();                                                                                                      \
        if ((t) + 1 < NT) { VMW(); SWRITE_H(SB); }                                                                          \
        RESC(alX); __syncthreads(); } while (0)
    for (int t = 1; t + 1 < NT; t += 2) {
        HALF_STEP(pB0, pB1, mnB, alB, pA0, pA1, alA, t, 1, 0, 0);
        HALF_STEP(pA0, pA1, mnA, alA, pB0, pB1, alB, t + 1, 0, 1, 1);
    }
    const bool even = (NT & 1) == 0;
    if (even) { SBAR(); qkt<1>(pB0, pB1, K_lds, r32, hi, S.qr); SBAR(); }
    SLOAD_H(nxt.K, nxt.V, kbn); SBAR();
#pragma unroll
    for (int d0 = 0; d0 < 8; ++d0) S.qr[d0] = load8(nxt.Q + (size_t)(wid * QBLK + r32) * D + d0 * 16 + hi * 8);
    SBAR();
    finishSM(pA0, pA1, alA, l_reg, pa0, pa1, pa2, pa3); SBAR();
    pv_tile<0>(o, vb0, pa0, pa1, pa2, pa3);
    if (even) { MASKT(pB0, pB1, NT - 1); partialSM(pB0, pB1, m_reg, mnB, alB); __syncthreads(); RESC(alB);
        finishSM(pB0, pB1, alB, l_reg, pa0, pa1, pa2, pa3); SBAR(); pv_tile<1>(o, vb0, pa0, pa1, pa2, pa3); }
    SBAR(); SEAM_K0();
    if (hi == 0) li_l[r32] = l_reg; asm volatile("s_waitcnt lgkmcnt(0)" ::: "memory");
    { const int le = lane_id(), r32e = le & 31, hie = le >> 5;
      const int tokw = cur.tok0 + wid * QBLK; const float* gp = GATES + (size_t)tokw * 48 + gate_off + cur.hh;
      float* op = OACC + (size_t)tokw * DM + cur.hh * 128; bf16* cp = OCAT + (size_t)tokw * DM + cur.hh * 128;
#pragma unroll
      for (int r = 0; r < 16; ++r) { const int orow = crow(r, hie);
        const float sc_ = gp[orow * 48] * __builtin_amdgcn_rcpf(li_l[orow]);
        const unsigned ob = (unsigned)(orow * DM + r32e);
#pragma unroll
        for (int d0 = 0; d0 < 4; ++d0) { const float v = op[ob + d0 * 32] + o[d0][r] * sc_;
            if (MODE == 0) ((unsigned*)op)[ob + d0 * 32] = __float_as_uint(v);
            else cp[ob + d0 * 32] = (bf16)(cvtpk(v, v) & 0xffffu); } } }
    __syncthreads();
#undef RESC
#undef KBASE
#undef MASKT
#undef SEAM_K0
#undef HALF_STEP
}
#undef ROW
#undef VMW
#undef VMWN
#undef SLOAD_H
#undef SWRITE_HK
#undef SWRITE_HV
#undef SWRITE_H
__device__ __forceinline__ int swa_nramp(int nqb, int W) { const int t = W - 1; const int n = t < 0 ? 0 : t / QB + 1; return n > nqb ? nqb : n; }
struct SwaItem { int bh, qb0, qb1; };
__device__ __forceinline__ SwaItem swa_decode(int L, int nqb, int nx, int nramp) {
    SwaItem it; it.bh = L / nx; const int x = L - it.bh * nx; const int ns = nqb - nramp;
    if (x < ns) { it.qb0 = it.qb1 = nqb - 1 - x; } else { it.qb0 = x - ns; it.qb1 = nramp - 1 - it.qb0; }
    return it;
}
template <bool SEL, int MODE>
__device__ __forceinline__ void phase(int wid, char* lds, const bf16* Q, const bf16* K, const bf16* V, int W, const unsigned long long* SELM, const float* GATES, int gate_off, float* OACC, bf16* OCAT) {
    constexpr int nqb = SEQ / QB;
    const int nramp = swa_nramp(nqb, W), nx = (nramp + 1) / 2 + (nqb - nramp), total = nx * BATCH * 16, stride = gridDim.x;
    int L = blockIdx.x; if (L >= total) return;
    auto mkref = [&](const SwaItem& it, int pass) { const int qb = pass ? it.qb1 : it.qb0, b = it.bh >> 4, hh = it.bh & 15; BlockRef r;
        r.Q = Q + ((size_t)it.bh * SEQ + (size_t)qb * QB) * D; r.K = K + (size_t)(b * 4 + (hh >> 2)) * SPAD * D; r.V = V + (size_t)(b * 4 + (hh >> 2)) * SPAD * D;
        r.P0 = qb * QB; r.tok0 = b * SEQ + qb * QB; r.hh = hh; return r; };
    SwaItem it = swa_decode(L, nqb, nx, nramp); int pass = 0;
    BlockRef cur = mkref(it, 0);
    Seam S;
    __syncthreads();
    prime(cur, W, lds, S, wid);
    for (;;) {
        const bool more_pass = pass == 0 && it.qb1 != it.qb0, more_item = L + stride < total, last = !more_pass && !more_item;
        SwaItem itn = it; int passn = pass + 1, Ln = L;
        if (!more_pass) { passn = 0; Ln = more_item ? L + stride : L; itn = swa_decode(Ln, nqb, nx, nramp); }
        const BlockRef nxt = last ? cur : mkref(itn, passn);
        block<SEL, MODE>(cur, nxt, SEQ, W, lds, S, SELM, GATES, gate_off, OACC, OCAT, wid);
        if (last) break;
        cur = nxt; it = itn; pass = passn; L = Ln;
    }
}
#undef KSWZ
#undef SBAR
}

#ifndef REPEAT_PHASE
#define REPEAT_PHASE -1
#endif
#ifndef PROBE_LO
#define PROBE_LO 22
#define PROBE_HI 22
#define PROBE_SCALE 0.1f
#endif
#ifndef PROBE
#define PROBE 0
#endif
__device__ __forceinline__ void probe_compare(const Ctx& C, const bf16* Xa, const bf16* Xb, size_t n) {
    float se = 0.f, sr = 0.f;
    for (size_t i = (size_t)C.bid * NTHR + C.tid; i < n; i += (size_t)C.G * NTHR) { const float a = bf2f(Xa[i]), b = bf2f(Xb[i]); se += (a - b) * (a - b); sr += b * b; }
    se = wave_sum(se); sr = wave_sum(sr);
    if (C.lane == 0) { atomicAdd(WSP(float, WS_CTL) + CW_PROBE, se); atomicAdd(WSP(float, WS_CTL) + CW_PROBE + 1, sr); }
}
#ifndef MK_SPLIT
#define MK_SPLIT 0
#endif
constexpr int N_PHASES = 39;
#define COMMON_PHASES(l, pb) \
      \
      \
    if (IN(pb + 1)) { FRESH_TID(); pg8::Gemm g{WSP(bf16, WS_XR), WSP(bf16, WS_WKT) + (size_t)l * 4 * 1024 * DM, DM, DM, DM}; \
                      CrossOrder S{4, G, c, 1024, (long long)256 * DM * 2, (long long)256 * DM * 2, (long long)1024 * DM * 2}; EpiSoftmaxP E{ARP(bf16, A_PC), 1024, WSP(float, WS_RSQ) + (size_t)(2 * l) * T * 8, (LAS float*)(C.lds + LDS_AUX)}; pg8::gemm_phase(L, g, S, E, C.tid); } SEAM(pb + 1); \
      \
    if (IN(pb + 3)) { FRESH_TID(); pg8::Gemm g{ARP(bf16, A_PC), WSP(bf16, WS_VWT) + (size_t)l * 4 * DM * 1024, 1024, 1024, 1024}; \
                      CrossOrder S{8, G, c, DM, (long long)256 * 1024 * 2, (long long)256 * 1024 * 2, (long long)DM * 1024 * 2}; EpiResidT<false> E{WSP(bf16, WS_XR), WSP(bf16, WS_XR), DM, WSP(float, WS_RSQ) + (size_t)(2 * l + 1) * T * 8, (LAS float*)(C.lds + LDS_AUX)}; pg8::gemm_phase(L, g, S, E, C.tid); } SEAM(pb + 3); \
      \
      \
    if (IN(pb + 5)) { FRESH_TID(); pg8::Gemm g{WSP(bf16, WS_XR), WSP(bf16, WS_W_ROUTER) + (size_t)l * 256 * DM, DM, DM, 512}; RouterOrder S{G, c}; EpiStoreF32Rows E{ARP(float, A_XS), 256, WSP(float, WS_RSQ) + (size_t)(2 * l + 1) * T * 8};     pg8::gemm_phase(L, g, S, E, C.tid); } SEAM(pb + 5); \
    if (IN(pb + 6)) { FRESH_TID(); phase_route(C, A, l); } SEAM(pb + 6); \
    if (IN(pb + 7)) { FRESH_TID(); phase_gather(C, l); } SEAM(pb + 7); \
    if (IN(pb + 8)) { FRESH_TID(); const bool side_ = (l == 0) && (G == 256) && MOE_CVT_SIDE_H > 0; const int Gm_ = side_ ? G - MOE_CVT_WG : G; \
                      if (side_ && c >= Gm_) moe_convert_items_x2(C, MOE_CVT_BASE_H, MOE_CVT_BASE_H + MOE_CVT_SIDE_H, (c - Gm_) * NWAVES + C.wave, MOE_CVT_WG * NWAVES); else { \
                      LAS int* tab = (LAS int*)(C.lds + LDS_AUX); moe_build_table(C, ctl + CW_MOE_CNT + l * 64, tab); \
                      pg8::Gemm g{WSP(bf16, WS_XR), WSP(bf16, WS_W_GU) + (size_t)l * NEXP * 1024 * DM, DM, DM, DM}; MoeOrder S{tab, 4, Gm_, c, 0}; EpiHid E{ARP(bf16, A_HID), ARP(int, A_ROWSLOT), WSP(float, WS_RSQ) + (size_t)(2 * l + 1) * T * 8}; \
                      LAS int* rc = tab + 256; { pg8::Unit u_; const int* rs_ = ARP(int, A_ROWSLOT); for (int i_ = 0; i_ < 12 && S.next(i_, u_); ++i_) if (C.tid < 256) rc[i_ * 256 + C.tid] = (C.tid < u_.pm) ? (rs_[u_.aux + C.tid] >> 1) : 0; } __syncthreads(); \
                      pg8::gemm_phase<EpiHid, MoeOrder, true>(L, g, S, E, C.tid, rc); } } SEAM(pb + 8); \
    if (IN(pb + 9)) { FRESH_TID(); const bool side_ = (l == 0) && (G == 256) && MOE_CVT_SIDE_H2 > 0; const int Gm_ = side_ ? G - MOE_CVT_WG : G; \
                      if (side_ && c >= Gm_) moe_convert_items_x2(C, MOE_CVT_BASE_H2, MOE_CVT_BASE_H2 + MOE_CVT_SIDE_H2, (c - Gm_) * NWAVES + C.wave, MOE_CVT_WG * NWAVES); else { \
                      LAS int* tab = (LAS int*)(C.lds + LDS_AUX); moe_build_table(C, ctl + CW_MOE_CNT + l * 64, tab); \
                      pg8::Gemm g{ARP(bf16, A_HID), WSP(bf16, WS_W_DN) + (size_t)l * NEXP * DM * FF, FF, FF, FF}; MoeOrder S{tab, 8, Gm_, c, 1}; EpiMoeDown E{ARP(int, A_ROWSLOT), ARP(float, A_WTS), ARP(bf16, A_YE)}; pg8::gemm_phase(L, g, S, E, C.tid); } } SEAM(pb + 9); \
    if (IN(pb + 10)) { FRESH_TID(); if (l == 0) phase_combine_norm(C, nullptr, nullptr); else phase_combine_norm(C, INP(I_NORM_FINAL), ((float*)INP(N_INPUTS))); } \
    if (l == 0) SEAM(pb + 10);

__global__ void __launch_bounds__(NTHR, 2) mk_fwd(Args args) {
    extern __shared__ __attribute__((aligned(16))) unsigned char lds_raw[];
    Ctx C; C.lds = (LAS unsigned char*)lds_raw; C.tid = threadIdx.x; C.lane = C.tid & 63; C.wave = __builtin_amdgcn_readfirstlane(C.tid >> 6);
    C.G = gridDim.x; C.bid = blockIdx.x; C.gw = C.bid * NWAVES + C.wave; C.ngw = C.G * NWAVES; C.ws = args.ws;
    const Args& A = args; (void)A;
    volatile LAS unsigned* MISC = (volatile LAS unsigned*)(C.lds + LDS_MISC);
    if (C.tid < 64) MISC[C.tid] = 0u;
    if (C.tid <= N_INPUTS) ((LAS unsigned long long*)(C.lds + LDS_PTAB))[C.tid] = (C.tid < N_INPUTS) ? (unsigned long long)args.in[C.tid < N_INPUTS ? C.tid : 0] : (unsigned long long)args.out;
    __syncthreads();
    unsigned* ctl = WSP(unsigned, WS_CTL);
    const int lo = args.ph_lo, hi = args.ph_hi;
    XcdBarrier bar; bar.bar = ctl + CW_BAR; bar.x = 0; bar.st = MISC + 8;
    if (hi - lo > 1) bar = xcd_barrier_post(ctl + CW_BAR, MISC + 8);
#ifndef ONLY_PHASE
#define ONLY_PHASE -1
#endif
#define FRESH_TID() do { int t_ = threadIdx.x; asm volatile("" : "+v"(t_)); C.tid = t_; C.lane = t_ & 63; } while (0)
#define IN(k) ((ONLY_PHASE < 0 || ONLY_PHASE == (k)) && lo <= (k) && (k) < hi)
#if PROBE == 2
    unsigned long long tA_ = 0, tB_ = 0;
    if (PROBE_LO == 0) tA_ = __builtin_amdgcn_s_memrealtime();
#define SEAM(k) do { if (IN(k) && IN((k) + 1)) xcd_barrier(bar); if ((k) == PROBE_LO - 1) tA_ = __builtin_amdgcn_s_memrealtime(); if ((k) == PROBE_HI) tB_ = __builtin_amdgcn_s_memrealtime(); } while (0)
#else
#define SEAM(k) do { if (IN(k) && IN((k) + 1)) xcd_barrier(bar); } while (0)
#endif
    LAS unsigned char* L = C.lds;
    const int c = C.bid, G = C.G;

    if (IN(0)) { FRESH_TID(); for (int rep = 0; rep < (REPEAT_PHASE == 0 ? 2 : 1); ++rep) phase_prologue(C, A); } SEAM(0);
    if (IN(3)) { FRESH_TID(); const bool side = (G == 256) && MOE_CVT_SIDE_A > 0; const int Gg = side ? G - MOE_CVT_WG : G;
                 if (c < Gg) { pg8::Gemm g{(const bf16*)C.ws, (const bf16*)C.ws, DM, DM, DM}; AbInMemOrder S; S.d.init(T, AB_PAD, DM, DM, AB_PAD, Gg, c); S.m = MemProjOrder{Gg, c};
                               EpiAbInMem E{EpiAbIn{ARP(bf16, A_PAB), ARP(float, A_GF32)}, EpiStoreBf16{WSP(bf16, WS_KP), DM, 1.f}}; pg8::gemm_phase(L, g, S, E, C.tid); }
                 else moe_convert_items(C, MOE_CVT_TOTAL - MOE_CVT_SIDE_A - MOE_CVT_SIDE_B, MOE_CVT_TOTAL - MOE_CVT_SIDE_B, (c - Gg) * NWAVES + C.wave, MOE_CVT_WG * NWAVES); } SEAM(3);
    if (IN(4)) { FRESH_TID(); phase_mixer_prep(C, A); } SEAM(4);
    if (IN(5)) { FRESH_TID(); if (C.bid < 16 && C.wave == 0) ml_gate_scan(C, C.bid);
                 pg8::Gemm g{ARP(bf16, A_LIN), WSP(bf16, WS_W_LORA), 256, 256, 256}; pg8::DenseOrder S; S.init(T, 3072, 256, 256, 3072, G, c);
                 EpiLora E{INP(I_RW_W0), INP(I_RW_A0), INP(I_RW_K_A), ARP(bf16, A_KK), ARP(bf16, A_KR), ARP(float, A_WD), ARP(bf16, A_BV), ARP(bf16, A_KP), ARP(bf16, A_GG)}; pg8::gemm_phase(L, g, S, E, C.tid);
                 { pg8::Gemm g2{WSP(bf16, WS_KP), WSP(bf16, WS_W_CAQ), DM, DM, 512}; WktOrder S2{G, c}; EpiStoreBf16 E2{WSP(bf16, WS_WKT), DM, 0.04419417382415922f}; pg8::gemm_phase(L, g2, S2, E2, C.tid); }
                 { pg8::Gemm g3{WSP(bf16, WS_W_CAO), WSP(bf16, WS_VP), DM, DM, 512}; VwtOrder S3{G, c}; EpiStoreBf16 E3{WSP(bf16, WS_VWT), 1024, 1.f}; pg8::gemm_phase(L, g3, S3, E3, C.tid); } } SEAM(5);
    if (IN(6)) { FRESH_TID(); rwkv_prep_units(C, G == 256); for (int it = C.bid; it < 1024; it += G) ml_intra_unit(C, it, G == 256); } SEAM(6);
    if (IN(7)) { FRESH_TID(); for (int it = C.bid; it < 256; it += G) rwkv_scan_slice(C, it); ml_state_scan(C, 0, G); } SEAM(7);
    if (IN(8)) { FRESH_TID(); for (int it = C.bid; it < 1024; it += G) ml_out_unit(C, it, (G == 256) && MOE_CVT_SIDE_G > 0); rwkv_out_items(C); } SEAM(8);
    if (IN(9)) { FRESH_TID(); pg8::Gemm g{ARP(bf16, A_YCAT), WSP(bf16, WS_W_ABOUT), DM, DM, DM}; pg8::DenseOrder S; S.init(T, DM, DM, DM, DM, G, c); EpiResidT<true> E{INP(I_X), WSP(bf16, WS_XR), DM, WSP(float, WS_RSQ), (LAS float*)(C.lds + LDS_AUX)}; pg8::gemm_phase(L, g, S, E, C.tid); } SEAM(9);
    COMMON_PHASES(0, 10)
    if (IN(21)) { FRESH_TID(); const bool side = (G == 256); const int Gg = side ? G - MOE_CVT_WG : G;
                  if (c >= Gg) moe_convert_items_x2(C, MOE_CVT_TOTAL - MOE_CVT_SIDE_B, MOE_CVT_TOTAL, (c - Gg) * NWAVES + C.wave, MOE_CVT_WG * NWAVES); else {
                  pg8::Gemm g{WSP(bf16, WS_XR), WSP(bf16, WS_W_NSAIN), DM, DM, DM}; pg8::DenseOrder S; S.init(T, NSA_PAD, DM, DM, NSA_PAD, Gg, c);
                  EpiNsaIn E{ARP(bf16, A_Q), ARP(bf16, A_QROT), ARP(bf16, A_KV6), ARP(float, A_GATES), INP(I_NSA_GATE_B), WSP(float, WS_TAB + TAB_ROPE_COS), WSP(float, WS_TAB + TAB_ROPE_SIN), WSP(float, WS_RSQ) + (size_t)4 * T * 8}; pg8::gemm_phase(L, g, S, E, C.tid); } } SEAM(21);
    if (IN(22)) { FRESH_TID(); pg8::Gemm g{ARP(bf16, A_KV6), WSP(bf16, WS_W_CMP1), 2048, 4096, 512}; CmpOrder S{G, c}; EpiStoreF32 E{ARP(float, A_CPART), 256}; pg8::gemm_phase(L, g, S, E, C.tid); } SEAM(22);
    if (IN(23)) { FRESH_TID(); phase_cmp_finish(C, A); } SEAM(23);
    if (IN(24)) { FRESH_TID(); for (int rep = 0; rep < (REPEAT_PHASE == 24 ? 2 : 1); ++rep) phase_cmp_attn_mma(C, G == 256); } SEAM(24);
#if PROBE == 1
    if (IN(25)) { FRESH_TID(); phase_selwin_naive(C, ARP(bf16, A_OCATREF)); xcd_barrier(bar); }
#endif
    if (IN(25)) { FRESH_TID(); swa::phase<true, 0>(C.wave, (char*)lds_raw, ARP(bf16, A_QROT), (const bf16*)(C.ws + WS_ARENA + A_KV6 + 2 * KV6_STRIDE), (const bf16*)(C.ws + WS_ARENA + A_KV6 + 3 * KV6_STRIDE), SEQ,
                                      ARP(const unsigned long long, A_SELMASK), ARP(float, A_GATES), 16, ARP(float, A_OACC), ARP(bf16, A_OCAT)); } SEAM(25);
    if (IN(26)) { FRESH_TID(); swa::phase<false, 1>(C.wave, (char*)lds_raw, ARP(bf16, A_QROT), (const bf16*)(C.ws + WS_ARENA + A_KV6 + 4 * KV6_STRIDE), (const bf16*)(C.ws + WS_ARENA + A_KV6 + 5 * KV6_STRIDE), 512,
                                       ARP(const unsigned long long, A_SELMASK), ARP(float, A_GATES), 32, ARP(float, A_OACC), ARP(bf16, A_OCAT)); } SEAM(26);
#if PROBE == 1
    if (IN(26)) { FRESH_TID(); probe_compare(C, ARP(bf16, A_OCAT), ARP(bf16, A_OCATREF), (size_t)T * DM); }
#endif
    { int t2 = C.wave * 64 + swa::lane_id(); asm volatile("" : "+v"(t2)); C.tid = t2 & 511; C.lane = t2 & 63; }
    if (IN(27)) { FRESH_TID(); pg8::Gemm g{ARP(bf16, A_OCAT), WSP(bf16, WS_W_NSAOUT), DM, DM, DM}; pg8::DenseOrder S; S.init(T, DM, DM, DM, DM, G, c); EpiResidT<false> E{WSP(bf16, WS_XR), WSP(bf16, WS_XR), DM, WSP(float, WS_RSQ) + (size_t)2 * T * 8, (LAS float*)(C.lds + LDS_AUX)}; pg8::gemm_phase(L, g, S, E, C.tid); } SEAM(27);
    COMMON_PHASES(1, 28)
#if PROBE == 2
    xcd_barrier(bar);
    if (C.bid == 0 && C.tid == 0) ((float*)INP(N_INPUTS))[0] = (float)(tB_ - tA_) * (0.01f * PROBE_SCALE);
#elif PROBE
    xcd_barrier(bar);
    if (C.bid == 0 && C.tid == 0) { const float se = __hip_atomic_load((float*)(ctl + CW_PROBE), __ATOMIC_RELAXED, __HIP_MEMORY_SCOPE_AGENT), sr = __hip_atomic_load((float*)(ctl + CW_PROBE + 1), __ATOMIC_RELAXED, __HIP_MEMORY_SCOPE_AGENT);
        ((float*)INP(N_INPUTS))[0] = 1e6f * sqrtf(se / fmaxf(sr, 1e-30f)); }
#endif
#undef IN
#undef SEAM
}

extern "C" void kernel_launch(void* const* d_in, const int* in_sizes, int n_in, void* d_out, int out_size, void* d_ws, size_t ws_size, hipStream_t stream) {
    static int grid = 0;
    if (grid == 0) {
        if (n_in != N_INPUTS || out_size != T * DM || ws_size < WS_END) { fprintf(stderr, "kernel_launch: unexpected shapes (n_in %d, out %d, ws %zu, need %zu)\n", n_in, out_size, ws_size, (size_t)WS_END); grid = -1; return; }
        int dev = 0, cus = 0, per_cu = 0;
        if (hipGetDevice(&dev) != hipSuccess || hipDeviceGetAttribute(&cus, hipDeviceAttributeMultiprocessorCount, dev) != hipSuccess) { grid = -1; return; }
        if (hipFuncSetAttribute((const void*)mk_fwd, hipFuncAttributeMaxDynamicSharedMemorySize, LDS_BYTES) != hipSuccess) { fprintf(stderr, "kernel_launch: hipFuncSetAttribute failed\n"); grid = -1; return; }
        if (hipOccupancyMaxActiveBlocksPerMultiprocessor(&per_cu, (const void*)mk_fwd, NTHR, LDS_BYTES) != hipSuccess || per_cu < 1) fprintf(stderr, "kernel_launch: occupancy query says %d\n", per_cu);
        (void)hipGetLastError();
        grid = cus;
    }
    if (grid < 0) return;
    (void)hipMemsetAsync((char*)d_ws + WS_CTL, 0, CTL_BYTES, stream);
    Args a{};
    for (int i = 0; i < N_INPUTS; ++i) a.in[i] = (const float*)d_in[i];
    a.out = (float*)d_out; a.ws = (unsigned char*)d_ws;
#if MK_SPLIT
    for (int p = 0; p < N_PHASES; ++p) { a.ph_lo = p; a.ph_hi = p + 1; hipLaunchKernelGGL(mk_fwd, dim3(grid), dim3(NTHR), LDS_BYTES, stream, a); }
#else
    a.ph_lo = 0; a.ph_hi = N_PHASES; hipLaunchKernelGGL(mk_fwd, dim3(grid), dim3(NTHR), LDS_BYTES, stream, a);
#endif
}
```

```cpp
#include <hip/hip_runtime.h>
#include <cstdio>
#include <cstdint>

#define LAS __attribute__((address_space(3)))
#define GAS __attribute__((address_space(1)))
typedef unsigned short bf16;
typedef short bf16x8 __attribute__((ext_vector_type(8)));
typedef float f32x4 __attribute__((ext_vector_type(4)));
typedef float f32x2 __attribute__((ext_vector_type(2)));
typedef unsigned u32x4 __attribute__((ext_vector_type(4)));
typedef unsigned u32x2 __attribute__((ext_vector_type(2)));

constexpr int BATCH = 4, SEQ = 4096, DM = 2048, T = BATCH * SEQ, MEMT = 256, MT = BATCH * MEMT;
constexpr float EPS = 1e-6f;
constexpr int ML_COLS = 3080, RW_COLS = 3328, AB_COLS = 6408, AB_PAD = 6656;
constexpr int NSA_COLS = 5168, NSA_PAD = 5376;
constexpr int NEXP = 64, FF = 512;
constexpr int XS_ROWS = 49152;
constexpr int SPAD = SEQ + 64;

enum { I_X = 0, I_MEM, I_NORM_MIX, I_NORM_CROSS, I_NORM_MEM, I_NORM_FFN, I_NORM_FINAL, I_AB_W_IN, I_ML_CONV_W, I_ML_CONV_B, I_ML_GATE_B,
       I_RW_MU, I_RW_W0, I_RW_W_UP, I_RW_A0, I_RW_A_UP, I_RW_G_UP, I_RW_K_K, I_RW_K_A, I_RW_R_K, I_RW_LN_W, I_RW_LN_B, I_AB_W_OUT,
       I_NSA_W_IN, I_NSA_GATE_B, I_CMP_POS, I_CMP_W1, I_CMP_W2, I_NSA_W_OUT, I_CA_WQ, I_CA_WK, I_CA_WV, I_CA_WO,
       I_MOE_WG, I_MOE_BG, I_MOE_WE, I_MOE_BE, I_MOE_W_GATE, I_MOE_W_UP, I_MOE_W_DOWN, N_INPUTS };

constexpr size_t MiB = (size_t)1 << 20;
constexpr size_t WS_CTL = 0, CTL_BYTES = 1 * MiB;
constexpr size_t WS_TAB = 1 * MiB;
constexpr size_t WS_W_ABIN = 3 * MiB;
constexpr size_t WS_W_ABOUT = WS_W_ABIN + 26 * MiB;
constexpr size_t WS_W_LORA = WS_W_ABOUT + 8 * MiB;
constexpr size_t WS_W_NSAIN = WS_W_LORA + 2 * MiB;
constexpr size_t WS_W_NSAOUT = WS_W_NSAIN + 21 * MiB;
constexpr size_t WS_W_CMP1 = WS_W_NSAOUT + 8 * MiB;
constexpr size_t WS_W_CAQ = WS_W_CMP1 + 4 * MiB;
constexpr size_t WS_W_CAK = WS_W_CAQ + 16 * MiB;
constexpr size_t WS_W_CAV = WS_W_CAK + 16 * MiB;
constexpr size_t WS_W_CAO = WS_W_CAV + 16 * MiB;
constexpr size_t WS_W_ROUTER = WS_W_CAO + 16 * MiB;
constexpr size_t WS_W_GU = WS_W_ROUTER + 2 * MiB;
constexpr size_t WS_W_DN = WS_W_GU + 512 * MiB;
constexpr size_t WS_MEMN = WS_W_DN + 256 * MiB;
constexpr size_t WS_KP = WS_MEMN + 8 * MiB;
constexpr size_t WS_VP = WS_KP + 8 * MiB;
constexpr size_t WS_WKT = WS_VP + 8 * MiB;
constexpr size_t WS_VWT = WS_WKT + 32 * MiB;
constexpr size_t WS_XR = WS_VWT + 32 * MiB;
constexpr size_t WS_RSQ = WS_XR + 64 * MiB;
constexpr size_t WS_XN = WS_XR + 128 * MiB;
constexpr size_t WS_ARENA = WS_XN + 64 * MiB;
constexpr size_t A_PAB = 0;
constexpr size_t A_GF32 = A_PAB + 208 * MiB;
constexpr size_t A_QM = A_GF32 + 16 * MiB;
constexpr size_t A_KM = A_QM + 16 * MiB;
constexpr size_t A_IG = A_KM + 16 * MiB;
constexpr size_t A_LF = A_IG + 1 * MiB;
constexpr size_t A_MLA = A_LF + 256 * 1024, A_MLM = A_LF + 512 * 1024;
constexpr size_t A_RR = A_LF + 1 * MiB;
constexpr size_t A_KR = A_RR + 32 * MiB;
constexpr size_t A_VR = A_KR + 32 * MiB;
constexpr size_t A_KK = A_VR + 32 * MiB;
constexpr size_t A_LIN = A_KK + 32 * MiB;
constexpr size_t A_WD = A_LIN + 8 * MiB;
constexpr size_t A_BV = A_WD + 64 * MiB;
constexpr size_t A_KP = A_BV + 32 * MiB;
constexpr size_t A_GG = A_KP + 32 * MiB;
constexpr size_t A_YCAT = A_GG + 32 * MiB;
constexpr size_t A_RWM = A_YCAT + 64 * MiB;
constexpr size_t A_RWN = A_RWM + 32 * MiB, A_RWRW = A_RWN + 32 * MiB, A_RWYL = A_RWRW + 32 * MiB;
constexpr size_t A_MLKV = A_RWYL + 32 * MiB;
constexpr size_t A_MLNUM = A_MLKV + 68 * MiB;
constexpr size_t A_END0 = A_MLNUM + 34 * MiB;
constexpr size_t A_SC = 0;
constexpr size_t A_PC = A_SC + 64 * MiB;
constexpr size_t A_LOGIT = 0;
constexpr size_t A_EID = A_LOGIT + 16 * MiB;
constexpr size_t A_WTS = A_EID + 1 * MiB;
constexpr size_t A_ROWSLOT = A_WTS + 1 * MiB;
constexpr size_t A_LRANK = A_ROWSLOT + 256 * 1024, A_BHIST = A_ROWSLOT + 512 * 1024;
constexpr size_t A_XS = A_ROWSLOT + 1 * MiB;
constexpr size_t A_HID = A_XS + 192 * MiB;
constexpr size_t A_YE = A_HID + 48 * MiB;
constexpr size_t A_END2 = A_YE + 128 * MiB;
constexpr size_t A_Q = 0;
constexpr size_t A_QROT = A_Q + 64 * MiB;
constexpr size_t A_KV6 = A_QROT + 64 * MiB;
constexpr size_t KV6_STRIDE = 17 * MiB;
constexpr size_t A_GATES = A_KV6 + 6 * KV6_STRIDE;
constexpr size_t A_CPART = A_GATES + 4 * MiB;
constexpr size_t A_KCMP = A_CPART + 64 * MiB;
constexpr size_t A_VCMP = A_KCMP + 1 * MiB;
constexpr size_t A_SELMASK = A_VCMP + 1 * MiB;
constexpr size_t A_OACC = A_SELMASK + 1 * MiB;
constexpr size_t A_OCAT = A_OACC + 128 * MiB;
constexpr size_t A_OCATREF = A_OCAT + 64 * MiB;
constexpr size_t A_VCT = A_OCATREF + 64 * MiB;
constexpr size_t A_END3 = A_VCT + 1 * MiB;
constexpr size_t ARENA_BYTES = 860 * MiB;
static_assert(A_END0 <= ARENA_BYTES && A_END2 <= ARENA_BYTES && A_END3 <= ARENA_BYTES, "arena");
constexpr size_t WS_END = WS_ARENA + ARENA_BYTES;
static_assert(WS_END <= (size_t)2048 * MiB, "workspace");
constexpr size_t TAB_ROPE_COS = 0, TAB_ROPE_SIN = 256 * 1024, TAB_CMPBIAS = 512 * 1024, TAB_RSTD = 1024 * 1024;
constexpr int CW_BAR = 4096;
constexpr int CW_MOE_CNT = 16384;
constexpr int CW_MOE_CUR = 16384 + 256;
constexpr int CW_PROBE = 32768;
constexpr int CW_RSQ = 65536;

__device__ __forceinline__ float bf2f(bf16 v) { return __uint_as_float((unsigned)v << 16); }
__device__ __forceinline__ unsigned f2bf(float f) { unsigned u = __float_as_uint(f); return (u + 0x7fffu + ((u >> 16) & 1u)) >> 16; }
__device__ __forceinline__ unsigned pk2(float lo, float hi) { return f2bf(lo) | (f2bf(hi) << 16); }
__device__ __forceinline__ float lo_bf(unsigned w) { return __uint_as_float(w << 16); }
__device__ __forceinline__ float hi_bf(unsigned w) { return __uint_as_float(w & 0xffff0000u); }
__device__ __forceinline__ float sigmoidf_(float x) { return 1.f / (1.f + __expf(-x)); }
__device__ __forceinline__ float siluf_(float x) { return x / (1.f + __expf(-x)); }
#define DPPF(v, ctrl) __int_as_float(__builtin_amdgcn_update_dpp(0, __float_as_int(v), (ctrl), 0xf, 0xf, true))
#define DPP_XOR1 0xB1
#define DPP_XOR2 0x4E
#define DPP_HMIRROR 0x141
#define DPP_MIRROR 0x140
__device__ __forceinline__ float xor16f(float v) { const unsigned u = __float_as_uint(v); auto r = __builtin_amdgcn_permlane16_swap(u, u, false, false); return __uint_as_float(r[0] ^ r[1] ^ u); }
__device__ __forceinline__ float xor32f(float v) { const unsigned u = __float_as_uint(v); auto r = __builtin_amdgcn_permlane32_swap(u, u, false, false); return __uint_as_float(r[0] ^ r[1] ^ u); }
__device__ __forceinline__ float wave_sum(float v) {
    v += DPPF(v, DPP_XOR1); v += DPPF(v, DPP_XOR2); v += DPPF(v, DPP_HMIRROR); v += DPPF(v, DPP_MIRROR); v += xor16f(v); v += xor32f(v); return v;
}
__device__ __forceinline__ float wave_max(float v) {
    v = fmaxf(v, DPPF(v, DPP_XOR1)); v = fmaxf(v, DPPF(v, DPP_XOR2)); v = fmaxf(v, DPPF(v, DPP_HMIRROR)); v = fmaxf(v, DPPF(v, DPP_MIRROR)); v = fmaxf(v, xor16f(v)); v = fmaxf(v, xor32f(v)); return v;
}
__device__ __forceinline__ void unpack8(u32x4 w, float* f) {
    f[0] = lo_bf(w.x); f[1] = hi_bf(w.x); f[2] = lo_bf(w.y); f[3] = hi_bf(w.y); f[4] = lo_bf(w.z); f[5] = hi_bf(w.z); f[6] = lo_bf(w.w); f[7] = hi_bf(w.w);
}
__device__ __forceinline__ void st16_f(void* p, u32x4 w) { *(f32x4*)p = __builtin_bit_cast(f32x4, w); }
__device__ __forceinline__ void st8_f(void* p, u32x2 w) { *(f32x2*)p = __builtin_bit_cast(f32x2, w); }
__device__ __forceinline__ u32x4 pack8f(const float* f) { u32x4 w; w.x = pk2(f[0], f[1]); w.y = pk2(f[2], f[3]); w.z = pk2(f[4], f[5]); w.w = pk2(f[6], f[7]); return w; }

namespace pg8 {
constexpr int BM = 256, BK = 64, HALF = 128, HTB = HALF * BK * 2, STAGE_BYTES = 8 * HTB, NXCD = 8, WGM = 8;
__host__ __device__ __forceinline__ int lds_byte(int r, int c) { const int st = (r >> 4) * 2 + (c >> 5), rr = r & 15, cc = c & 31, ob = rr * 64 + cc * 2; return st * 1024 + (ob ^ (((ob >> 9) & 1) << 5)); }
__host__ __device__ __forceinline__ void stage_rc(int b, int& R, int& C) { const int st = b / 1024, sb = b % 1024, swz = sb ^ (((sb >> 9) & 1) << 5); R = (st >> 1) * 16 + swz / 64; C = (st & 1) * 32 + (swz % 64) / 2; }
__host__ __device__ __forceinline__ int perm32(int rho) { const int n = rho >> 4, i = rho & 15; return 8 * (i >> 2) + 4 * n + (i & 3); }

struct Unit { long long aoff, boff, coff; int pm, pn, aux; };
struct Gemm { const bf16* A; const bf16* Bt; int lda, ldb, K; };

__device__ __forceinline__ bool tile_of(long L, int nM, int nN, int& pm, int& pn) {
    const int nwg = nM * nN; if (L >= nwg) return false;
    int wgid = (int)L; { const int q = nwg / NXCD, r = nwg % NXCD, xcd = wgid % NXCD, off = wgid / NXCD; wgid = (xcd < r ? xcd * (q + 1) : r * (q + 1) + (xcd - r) * q) + off; }
    const int nig = WGM * nN, gid = wgid / nig, fm = gid * WGM, gsz = (nM - fm) < WGM ? (nM - fm) : WGM;
    pm = fm + ((wgid % nig) % gsz); pn = (wgid % nig) / gsz; return true;
}
struct DenseOrder {
    int nM, nN, G, c, ldc; long long astep, bstep;
    __device__ void init(int M, int N, int lda, int ldb, int ldc_, int G_, int c_) { nM = M / BM; nN = N / BM; G = G_; c = c_; ldc = ldc_; astep = (long long)BM * lda * 2; bstep = (long long)BM * ldb * 2; }
    __device__ __forceinline__ bool next(int i, Unit& u) const {
        int pm, pn; if (!tile_of((long)i * G + c, nM, nN, pm, pn)) return false;
        u.pm = pm; u.pn = pn; u.aux = 0; u.aoff = pm * astep; u.boff = pn * bstep; u.coff = (long long)pm * BM * ldc + pn * BM; return true;
    }
};

__device__ __forceinline__ unsigned cvt_pk_bf16(float lo, float hi) { unsigned r; asm volatile("v_cvt_pk_bf16_f32 %0, %1, %2" : "=v"(r) : "v"(lo), "v"(hi)); return r; }

template <class Epi, class Sched, bool GATHER = false>
__device__ __forceinline__ void gemm_phase(LAS unsigned char* lds, const Gemm g, const Sched& S, const Epi& E, int tid_, const LAS int* rowcache = nullptr) {
    __builtin_assume(tid_ >= 0 && tid_ < 512); const int tid = tid_, wid = __builtin_amdgcn_readfirstlane(tid >> 6), lane = tid & 63, wr = wid >> 2, wc = wid & 3, fr = lane & 15, fq = lane >> 4;
    int nt = g.K / BK; asm volatile("" : "+s"(nt));
    const size_t kstep = (size_t)(BK * 2);
    const size_t hstepA = (size_t)HALF * g.lda * 2, hstepB = (size_t)HALF * g.ldb * 2;
    unsigned vA0[2], vA1[2], vN0[2], vN1[2], voffB[2]; int Rr[2], Cb[2];
#pragma unroll
    for (int i = 0; i < 2; ++i) { int R, C; stage_rc(tid * 16 + i * 8192, R, C); const int Rb = (R & ~31) + perm32(R & 31); Rr[i] = R; Cb[i] = C * 2;
        vA0[i] = (unsigned)(R * g.lda + C) * 2u; vA1[i] = vA0[i] + (unsigned)hstepA; vN0[i] = vA0[i]; vN1[i] = vA1[i]; voffB[i] = (unsigned)(Rb * g.ldb + C) * 2u; }
#define PG8_GATHER(d0, d1, ui_) do { _Pragma("unroll") for (int _i = 0; _i < 2; ++_i) { d0[_i] = (unsigned)(rowcache[(ui_) * 256 + Rr[_i]] * g.lda * 2 + Cb[_i]); d1[_i] = (unsigned)(rowcache[(ui_) * 256 + 128 + Rr[_i]] * g.lda * 2 + Cb[_i]); } } while (0)
    if (GATHER) PG8_GATHER(vA0, vA1, 0);
    const unsigned ldsw = (unsigned)wid * 1024u;
    const int aoff = lds_byte(wr * 64 + fr, fq * 8), boff = lds_byte(wc * 32 + fr, fq * 8);
#define PG8_SA(b, h) (((b) * 2 + (h)) * HTB)
#define PG8_SB(b, h) ((4 + (b) * 2 + (h)) * HTB)
#define PG8_STAGE(bufoff, gbase, voff) do { _Pragma("unroll") for (int _i = 0; _i < 2; ++_i) \
        __builtin_amdgcn_global_load_lds((const unsigned*)((const char*)(gbase) + (voff)[_i]), (LAS unsigned*)(lds + (bufoff) + ldsw + _i * 8192), 16, 0, 0); } while (0)
#define PG8_LDA(dst, b, h) do { _Pragma("unroll") for (int m = 0; m < 4; ++m) _Pragma("unroll") for (int k = 0; k < 2; ++k) dst[m][k] = *(const LAS bf16x8*)(lds + PG8_SA(b, h) + aoff + m * 2048 + k * 1024); } while (0)
#define PG8_LDB(dst, b, h) do { _Pragma("unroll") for (int n = 0; n < 2; ++n) _Pragma("unroll") for (int k = 0; k < 2; ++k) dst[n][k] = *(const LAS bf16x8*)(lds + PG8_SB(b, h) + boff + n * 2048 + k * 1024); } while (0)
#define PG8_MMA(ai, bj, At, Bt) do { __builtin_amdgcn_s_setprio(1); _Pragma("unroll") for (int m = 0; m < 4; ++m) _Pragma("unroll") for (int n = 0; n < 2; ++n) _Pragma("unroll") for (int k = 0; k < 2; ++k) \
        acc[ai][bj][m][n] = __builtin_amdgcn_mfma_f32_16x16x32_bf16(Bt[n][k], At[m][k], acc[ai][bj][m][n], 0, 0, 0); __builtin_amdgcn_s_setprio(0); } while (0)
#define PG8_WAIT_V(n) asm volatile("s_waitcnt vmcnt(" #n ")" ::: "memory")
#define PG8_WAIT_L(n) asm volatile("s_waitcnt lgkmcnt(" #n ")" ::: "memory")
#define PG8_BAR __builtin_amdgcn_s_barrier()
#define PG8_SCHED __builtin_amdgcn_sched_barrier(0)
    Unit cur, nxt; int ui = 0;
    if (!S.next(0, cur)) return;
    f32x4 acc[2][2][4][2];
#pragma unroll
    for (int a = 0; a < 2; ++a)
#pragma unroll
        for (int b = 0; b < 2; ++b)
#pragma unroll
            for (int m = 0; m < 4; ++m)
#pragma unroll
                for (int n = 0; n < 2; ++n) acc[a][b][m][n] = (f32x4){0.f, 0.f, 0.f, 0.f};
    bf16x8 At[4][2], B0[2][2], B1[2][2];
    const char* cA = (const char*)g.A + cur.aoff; const char* cB = (const char*)g.Bt + cur.boff;
    PG8_STAGE(PG8_SB(0, 0), cB, voffB); PG8_STAGE(PG8_SB(0, 1), cB + hstepB, voffB); PG8_STAGE(PG8_SA(0, 0), cA, vA0); PG8_STAGE(PG8_SA(0, 1), cA, vA1);
    if (wr == 1) PG8_BAR;
    PG8_WAIT_V(2); PG8_BAR;
    PG8_STAGE(PG8_SB(1, 0), cB + kstep, voffB); PG8_STAGE(PG8_SA(1, 0), cA + kstep, vA0); PG8_STAGE(PG8_SB(1, 1), cB + hstepB + kstep, voffB);
    PG8_WAIT_V(6); PG8_BAR;
    for (;;) {
        const bool has_next = S.next(ui + 1, nxt);
        const char* nA = has_next ? (const char*)g.A + nxt.aoff : cA; const char* nB = has_next ? (const char*)g.Bt + nxt.boff : cB;
        if (GATHER) { if (has_next) PG8_GATHER(vN0, vN1, ui + 1); else { vN0[0] = vA0[0]; vN0[1] = vA0[1]; vN1[0] = vA1[0]; vN1[1] = vA1[1]; } }
        for (int t = 0; t < nt; t += 2) {
            const bool last = (t == nt - 2);
            const char* a1 = cA + (size_t)(t + 1) * kstep;
            const char* a2 = last ? nA : cA + (size_t)(t + 2) * kstep; const char* b2 = last ? nB : cB + (size_t)(t + 2) * kstep;
            const char* a3 = a2 + kstep; const char* b3 = b2 + kstep;
            unsigned w0[2], w1[2];
            if (GATHER) { w0[0] = last ? vN0[0] : vA0[0]; w0[1] = last ? vN0[1] : vA0[1]; w1[0] = last ? vN1[0] : vA1[0]; w1[1] = last ? vN1[1] : vA1[1]; } else { w0[0] = vA0[0]; w0[1] = vA0[1]; w1[0] = vA1[0]; w1[1] = vA1[1]; }
            PG8_LDB(B0, 0, 0); PG8_LDB(B1, 0, 1); PG8_SCHED; PG8_LDA(At, 0, 0); PG8_STAGE(PG8_SA(1, 1), a1, vA1);
            PG8_WAIT_V(8); PG8_WAIT_L(0); PG8_BAR; PG8_MMA(0, 0, At, B0); PG8_MMA(0, 1, At, B1); PG8_BAR; PG8_SCHED;
            PG8_LDA(At, 0, 1); PG8_STAGE(PG8_SB(0, 0), b2, voffB); PG8_STAGE(PG8_SB(0, 1), b2 + hstepB, voffB); PG8_STAGE(PG8_SA(0, 0), a2, w0);
            PG8_WAIT_V(8); PG8_WAIT_L(0); PG8_BAR; PG8_MMA(1, 0, At, B0); PG8_MMA(1, 1, At, B1); PG8_BAR; PG8_SCHED;
            PG8_LDB(B0, 1, 0); PG8_LDB(B1, 1, 1); PG8_SCHED; PG8_LDA(At, 1, 0); PG8_STAGE(PG8_SA(0, 1), a2, w1);
            PG8_WAIT_V(8); PG8_WAIT_L(0); PG8_BAR; PG8_MMA(0, 0, At, B0); PG8_MMA(0, 1, At, B1); PG8_BAR; PG8_SCHED;
            PG8_LDA(At, 1, 1); PG8_STAGE(PG8_SB(1, 0), b3, voffB); PG8_STAGE(PG8_SB(1, 1), b3 + hstepB, voffB); PG8_STAGE(PG8_SA(1, 0), a3, w0);
            PG8_WAIT_V(8); PG8_WAIT_L(0); PG8_BAR; PG8_MMA(1, 0, At, B0); PG8_MMA(1, 1, At, B1); PG8_BAR; PG8_SCHED;
        }
        if (wr == 0) PG8_BAR;
        E(acc, cur, wr, wc, fr, fq);
        if (!has_next) break;
#pragma unroll
        for (int a = 0; a < 2; ++a)
#pragma unroll
            for (int b = 0; b < 2; ++b)
#pragma unroll
                for (int m = 0; m < 4; ++m)
#pragma unroll
                    for (int n = 0; n < 2; ++n) acc[a][b][m][n] = (f32x4){0.f, 0.f, 0.f, 0.f};
        cur = nxt; cA = nA; cB = nB; ++ui;
        if (GATHER) { vA0[0] = vN0[0]; vA0[1] = vN0[1]; vA1[0] = vN1[0]; vA1[1] = vN1[1]; }
        if (wr == 1) PG8_BAR;
    }
    PG8_WAIT_V(0);
    PG8_BAR;
#undef PG8_SA
#undef PG8_SB
#undef PG8_STAGE
#undef PG8_GATHER
#undef PG8_LDA
#undef PG8_LDB
#undef PG8_MMA
#undef PG8_WAIT_V
#undef PG8_WAIT_L
#undef PG8_BAR
#undef PG8_SCHED
}
}

#define XB_TMO      128
#define XB_XCNT(j)  (256  + 64 * (j))
#define XB_XSUB(j)  (1280 + 64 * (j))
#define XB_XGEN(j)  (2304 + 64 * (j))
#define XB_TOP      3328
#define XB_TOPGEN   3392
#define XCD_BAR_WORDS 3456
#define XB_SPIN_CAP (1u << 22)
__device__ __forceinline__ unsigned xb_ld(unsigned* p)              { return __hip_atomic_load(p, __ATOMIC_RELAXED, __HIP_MEMORY_SCOPE_AGENT); }
__device__ __forceinline__ unsigned xb_add(unsigned* p, unsigned v) { return __hip_atomic_fetch_add(p, v, __ATOMIC_RELAXED, __HIP_MEMORY_SCOPE_AGENT); }
__device__ __forceinline__ unsigned xb_xcc_id() { return (unsigned)__builtin_amdgcn_s_getreg((3 << 11) | 20) & 0xFu; }
#define XB_SPIN(cond, bar) do { unsigned _sp = 0; while (cond) { __builtin_amdgcn_s_sleep(1); \
    if ((++_sp & 255u) == 0u) { if (xb_ld(&(bar)[XB_TMO])) break; if (_sp > XB_SPIN_CAP) { atomicAdd(&(bar)[XB_TMO], 1u); break; } } } } while (0)
struct XcdBarrier { unsigned* bar; unsigned x; volatile LAS unsigned* st; };
__device__ __forceinline__ XcdBarrier xcd_barrier_post(unsigned* bar, volatile LAS unsigned* st) {
    XcdBarrier b; b.bar = bar; b.x = xb_xcc_id(); b.st = st;
    if (threadIdx.x == 0) (void)xb_add(&bar[XB_XCNT(b.x)], 1u);
    return b;
}
__device__ __forceinline__ void xcd_barrier_complete(unsigned* bar, unsigned x, unsigned& nloc, unsigned& nx) {
    const unsigned G = gridDim.x * gridDim.y * gridDim.z;
    unsigned sum, cnt, mine, sp = 0u;
    for (;;) {
        sum = 0u; cnt = 0u; mine = 0u;
#pragma unroll
        for (unsigned j = 0; j < 16; ++j) { const unsigned c = xb_ld(&bar[XB_XCNT(j)]); sum += c; cnt += (c > 0u) ? 1u : 0u; mine = (j == x) ? c : mine; }
        if (sum == G) break;
        __builtin_amdgcn_s_sleep(1);
        if ((++sp & 255u) == 0u) { if (xb_ld(&bar[XB_TMO])) break; if (sp > XB_SPIN_CAP) { atomicAdd(&bar[XB_TMO], 1u); break; } }
    }
    nloc = mine > 0u ? mine : 1u; nx = cnt > 0u ? cnt : 1u;
}
__device__ __forceinline__ void xcd_barrier(const XcdBarrier& b) {
    asm volatile("s_waitcnt vmcnt(0)" ::: "memory");
    __syncthreads();
    if (threadIdx.x == 0) {
        unsigned* bar = b.bar;
        __builtin_amdgcn_s_waitcnt(0);
        unsigned nloc = b.st[0], nx = b.st[1];
        if (nloc == 0u) { xcd_barrier_complete(bar, b.x, nloc, nx); b.st[0] = nloc; b.st[1] = nx; }
        const unsigned old = xb_add(&bar[XB_XSUB(b.x)], 1u);
        const unsigned gen = old / nloc;
        if (old + 1u == (gen + 1u) * nloc) {
            __builtin_amdgcn_fence(__ATOMIC_RELEASE, "agent");
            asm volatile("s_waitcnt vmcnt(0)" ::: "memory");
            const unsigned og = xb_add(&bar[XB_TOP], 1u);
            const unsigned tg = og / nx;
            if (og + 1u == (tg + 1u) * nx) xb_add(&bar[XB_TOPGEN], 1u);
            else XB_SPIN(xb_ld(&bar[XB_TOPGEN]) == tg, bar);
            __builtin_amdgcn_fence(__ATOMIC_ACQUIRE, "agent");
            xb_add(&bar[XB_XGEN(b.x)], 1u);
            asm volatile("s_waitcnt vmcnt(0)" ::: "memory");
        } else {
            XB_SPIN(xb_ld(&bar[XB_XGEN(b.x)]) == gen, bar);
            __builtin_amdgcn_fence(__ATOMIC_ACQUIRE, "agent");
            asm volatile("s_waitcnt vmcnt(0)" ::: "memory");
        }
    }
    __syncthreads();
}

constexpr int NWAVES = 8, NTHR = 512;
constexpr int LDS_MAIN = 131072;
constexpr int LDS_AUX = 131072, LDS_AUX_BYTES = 16384;
constexpr int LDS_MISC = LDS_AUX + LDS_AUX_BYTES;
constexpr int LDS_PTAB = LDS_MISC + 256;
constexpr int LDS_BYTES = LDS_MISC + 1024;
struct Args { const float* in[N_INPUTS]; float* out; unsigned char* ws; int ph_lo, ph_hi; };

struct Ctx {
    LAS unsigned char* lds;
    int tid, lane, wave, G, bid, gw, ngw;
    unsigned char* ws;
};
__device__ __forceinline__ const float* lds_inp(LAS unsigned char* lds, int i) {
    const LAS unsigned* p = (const LAS unsigned*)(lds + LDS_PTAB) + 2 * i;
    const unsigned lo = __builtin_amdgcn_readfirstlane(p[0]), hi = __builtin_amdgcn_readfirstlane(p[1]);
    return (const float*)(const GAS float*)(((unsigned long long)hi << 32) | lo);
}
#define INP(i) lds_inp(C.lds, (i))
#define WSP(T_, off) ((T_*)(C.ws + (off)))
#define ARP(T_, off) ((T_*)(C.ws + WS_ARENA + (off)))
#define LDS_WAIT() asm volatile("s_waitcnt lgkmcnt(0)" ::: "memory")

__device__ __forceinline__ void rms_row_bf16(const float* xrow, const float* gain, bf16* orow, int lane) {
    f32x4 v[8]; float s = 0.f;
#pragma unroll
    for (int j = 0; j < 8; ++j) { v[j] = *(const f32x4*)(xrow + (j * 64 + lane) * 4); s += v[j].x * v[j].x + v[j].y * v[j].y + v[j].z * v[j].z + v[j].w * v[j].w; }
    const float rstd = rsqrtf(wave_sum(s) * (1.f / DM) + EPS);
#pragma unroll
    for (int j = 0; j < 8; ++j) { const f32x4 g = *(const f32x4*)(gain + (j * 64 + lane) * 4);
        u32x2 w; w.x = pk2(v[j].x * rstd * g.x, v[j].y * rstd * g.y); w.y = pk2(v[j].z * rstd * g.z, v[j].w * rstd * g.w);
        *(u32x2*)(orow + (j * 64 + lane) * 4) = w; }
}

template <int NT, class F>
__device__ __forceinline__ void transpose_tiles(const float* W, int ldw, int nvalid, int k0, int n0, bf16* WT, int ldt, F drow, int lane, const float* kscale) {
    const int g = lane >> 3, c = lane & 7; f32x4 v[NT][8];
#pragma unroll
    for (int q = 0; q < NT; ++q) { const int n = n0 + 32 * q + 4 * c; const bool ok = n < nvalid;
#pragma unroll
        for (int j = 0; j < 8; ++j) v[q][j] = ok ? *(const f32x4*)(W + (size_t)(k0 + 8 * g + j) * ldw + n) : (f32x4){0.f, 0.f, 0.f, 0.f}; }
    f32x4 ka = (f32x4){1.f, 1.f, 1.f, 1.f}, kb = ka;
    if (kscale) { ka = *(const f32x4*)(kscale + k0 + 8 * g); kb = *(const f32x4*)(kscale + k0 + 8 * g + 4); }
#pragma unroll
    for (int q = 0; q < NT; ++q) { const int n = n0 + 32 * q + 4 * c;
#pragma unroll
        for (int i = 0; i < 4; ++i) { u32x4 o; o.x = pk2(v[q][0][i] * ka.x, v[q][1][i] * ka.y); o.y = pk2(v[q][2][i] * ka.z, v[q][3][i] * ka.w); o.z = pk2(v[q][4][i] * kb.x, v[q][5][i] * kb.y); o.w = pk2(v[q][6][i] * kb.z, v[q][7][i] * kb.w);
            *(u32x4*)(WT + (size_t)drow(n + i) * ldt + k0 + 8 * g) = o; } }
}
template <class F>
__device__ __forceinline__ void transpose_tile(const float* W, int ldw, int nvalid, int k0, int n0, bf16* WT, int ldt, F drow, LAS float* scr, int lane, const float* kscale = nullptr) {
    (void)scr; transpose_tiles<1>(W, ldw, nvalid, k0, n0, WT, ldt, drow, lane, kscale);
}
template <class F>
__device__ __forceinline__ void transpose_matrix(const Ctx& C, const float* W, int K, int N, int Npad, bf16* WT, int ldt, F drow, LAS float* scr, const float* kscale = nullptr) {
    const int nblk = Npad / 32, items = (K / 64) * nblk;
    for (int it = C.gw; it < items; it += C.ngw) { const int kb = it / nblk, nb = it % nblk; transpose_tile(W, N, N, kb * 64, nb * 32, WT, ldt, drow, scr, C.lane, kscale); }
}

#define EPI_ARGS const f32x4 (&acc)[2][2][4][2], const pg8::Unit& u, int wr, int wc, int fr, int fq
struct EpiStoreBf16 {
    bf16* O; int ldc; float scale;
    __device__ __forceinline__ void operator()(EPI_ARGS) const {
        bf16* base = O + u.coff + (size_t)(wr * 64 + fr) * ldc + wc * 32 + 8 * fq;
#pragma unroll
        for (int ai = 0; ai < 2; ++ai)
#pragma unroll
            for (int m = 0; m < 4; ++m) { bf16* rowp = base + (size_t)(ai * 128 + m * 16) * ldc;
#pragma unroll
                for (int bj = 0; bj < 2; ++bj) { const f32x4 v0 = acc[ai][bj][m][0] * scale, v1 = acc[ai][bj][m][1] * scale;
                    u32x4 w; w.x = pg8::cvt_pk_bf16(v0[0], v0[1]); w.y = pg8::cvt_pk_bf16(v0[2], v0[3]); w.z = pg8::cvt_pk_bf16(v1[0], v1[1]); w.w = pg8::cvt_pk_bf16(v1[2], v1[3]);
                    *(u32x4*)(rowp + bj * 128) = w; } }
    }
};
struct EpiStoreF32 {
    float* O; int ldc;
    __device__ __forceinline__ void operator()(EPI_ARGS) const {
        float* base = O + u.coff + (size_t)(wr * 64 + fr) * ldc + wc * 32 + 8 * fq;
#pragma unroll
        for (int ai = 0; ai < 2; ++ai)
#pragma unroll
            for (int m = 0; m < 4; ++m) { float* rowp = base + (size_t)(ai * 128 + m * 16) * ldc;
#pragma unroll
                for (int bj = 0; bj < 2; ++bj) { *(f32x4*)(rowp + bj * 128) = acc[ai][bj][m][0]; *(f32x4*)(rowp + bj * 128 + 4) = acc[ai][bj][m][1]; } }
    }
};
template <bool BASE_F32> struct EpiResidT {
    const void* base; bf16* out; int ldc; float* rsq; LAS float* xch;
    __device__ __forceinline__ void operator()(EPI_ARGS) const {
        const size_t o0 = (size_t)u.coff + (size_t)(wr * 64 + fr) * ldc + wc * 32 + 8 * fq;
        u32x4 braw[BASE_F32 ? 1 : 16];
        if (!BASE_F32) {
#pragma unroll
            for (int ai = 0; ai < 2; ++ai)
#pragma unroll
                for (int m = 0; m < 4; ++m)
#pragma unroll
                    for (int bj = 0; bj < 2; ++bj) braw[(ai * 4 + m) * 2 + bj] = *(const u32x4*)((const bf16*)base + o0 + (size_t)(ai * 128 + m * 16) * ldc + bj * 128); }
#pragma unroll
        for (int ai = 0; ai < 2; ++ai)
#pragma unroll
            for (int m = 0; m < 4; ++m) { const size_t o = o0 + (size_t)(ai * 128 + m * 16) * ldc; float ssq = 0.f;
#pragma unroll
                for (int bj = 0; bj < 2; ++bj) { float bv[8];
                    if (BASE_F32) { const f32x4 b0 = *(const f32x4*)((const float*)base + o + bj * 128), b1 = *(const f32x4*)((const float*)base + o + bj * 128 + 4);
                        bv[0] = b0[0]; bv[1] = b0[1]; bv[2] = b0[2]; bv[3] = b0[3]; bv[4] = b1[0]; bv[5] = b1[1]; bv[6] = b1[2]; bv[7] = b1[3]; }
                    else unpack8(braw[BASE_F32 ? 0 : (ai * 4 + m) * 2 + bj], bv);
#pragma unroll
                    for (int j = 0; j < 4; ++j) { bv[j] += acc[ai][bj][m][0][j]; bv[4 + j] += acc[ai][bj][m][1][j]; }
                    const u32x4 w = pack8f(bv); *(u32x4*)(out + o + bj * 128) = w; float rf[8]; unpack8(w, rf);
#pragma unroll
                    for (int j = 0; j < 8; ++j) ssq += rf[j] * rf[j]; }
                ssq += xor16f(ssq); ssq += xor32f(ssq);
                if (fq == 0) xch[(ai * 128 + wr * 64 + m * 16 + fr) * 4 + wc] = ssq; }
        asm volatile("s_waitcnt lgkmcnt(0)" ::: "memory"); __builtin_amdgcn_s_barrier(); asm volatile("" ::: "memory");
        if (wc == 0 && fq == 0) {
#pragma unroll
            for (int ai = 0; ai < 2; ++ai)
#pragma unroll
                for (int m = 0; m < 4; ++m) { const int r = ai * 128 + wr * 64 + m * 16 + fr; const f32x4 p = *(const LAS f32x4*)(xch + r * 4); rsq[(size_t)(u.pm * 256 + r) * 8 + u.pn] = (p[0] + p[1]) + (p[2] + p[3]); } }
    }
};
__device__ __forceinline__ float rstd_of(float ssq) { return rsqrtf(ssq * (1.f / DM) + EPS); }
__device__ __forceinline__ float rstd_row(const float* rs8, int row) { const f32x4 a = *(const f32x4*)(rs8 + (size_t)row * 8), b = *(const f32x4*)(rs8 + (size_t)row * 8 + 4); return rstd_of(((a.x + a.y) + (a.z + a.w)) + ((b.x + b.y) + (b.z + b.w))); }
struct EpiStoreF32Rows {
    float* O; int ldc; const float* rs;
    __device__ __forceinline__ void operator()(EPI_ARGS) const {
        float* base = O + u.coff + (size_t)(wr * 64 + fr) * ldc + wc * 32 + 8 * fq; const int rp = u.pm * 256 + wr * 64 + fr;
#pragma unroll
        for (int ai = 0; ai < 2; ++ai)
#pragma unroll
            for (int m = 0; m < 4; ++m) { float* rowp = base + (size_t)(ai * 128 + m * 16) * ldc; const float r_ = rstd_row(rs, rp + ai * 128 + m * 16);
#pragma unroll
                for (int bj = 0; bj < 2; ++bj) { *(f32x4*)(rowp + bj * 128) = acc[ai][bj][m][0] * r_; *(f32x4*)(rowp + bj * 128 + 4) = acc[ai][bj][m][1] * r_; } }
    }
};
struct EpiSoftmaxP {
    bf16* P; int ldc; const float* rs; LAS float* xch;
    __device__ __forceinline__ void operator()(f32x4 (&acc)[2][2][4][2], const pg8::Unit& u, int wr, int wc, int fr, int fq) const {
#pragma unroll
        for (int ai = 0; ai < 2; ++ai)
#pragma unroll
            for (int m = 0; m < 4; ++m) { const int r = ai * 128 + wr * 64 + m * 16 + fr; const float r_ = rstd_row(rs, u.pm * 256 + r); float mx = -INFINITY;
#pragma unroll
                for (int bj = 0; bj < 2; ++bj)
#pragma unroll
                    for (int n = 0; n < 2; ++n) { acc[ai][bj][m][n] = acc[ai][bj][m][n] * r_;
#pragma unroll
                        for (int j = 0; j < 4; ++j) mx = fmaxf(mx, acc[ai][bj][m][n][j]); }
                mx = fmaxf(mx, xor16f(mx)); mx = fmaxf(mx, xor32f(mx)); if (fq == 0) xch[r * 4 + wc] = mx; }
        asm volatile("s_waitcnt lgkmcnt(0)" ::: "memory"); __builtin_amdgcn_s_barrier(); asm volatile("" ::: "memory");
#pragma unroll
        for (int ai = 0; ai < 2; ++ai)
#pragma unroll
            for (int m = 0; m < 4; ++m) { const int r = ai * 128 + wr * 64 + m * 16 + fr; const f32x4 mv = *(const LAS f32x4*)(xch + r * 4); const float mx = fmaxf(fmaxf(mv[0], mv[1]), fmaxf(mv[2], mv[3])); float sm_ = 0.f;
#pragma unroll
                for (int bj = 0; bj < 2; ++bj)
#pragma unroll
                    for (int n = 0; n < 2; ++n)
#pragma unroll
                        for (int j = 0; j < 4; ++j) { const float e = __expf(acc[ai][bj][m][n][j] - mx); acc[ai][bj][m][n][j] = e; sm_ += e; }
                sm_ += xor16f(sm_); sm_ += xor32f(sm_); if (fq == 0) xch[1024 + r * 4 + wc] = sm_; }
        asm volatile("s_waitcnt lgkmcnt(0)" ::: "memory"); __builtin_amdgcn_s_barrier(); asm volatile("" ::: "memory");
        bf16* base = P + u.coff + (size_t)(wr * 64 + fr) * ldc + wc * 32 + 8 * fq;
#pragma unroll
        for (int ai = 0; ai < 2; ++ai)
#pragma unroll
            for (int m = 0; m < 4; ++m) { const int r = ai * 128 + wr * 64 + m * 16 + fr; const f32x4 sv = *(const LAS f32x4*)(xch + 1024 + r * 4); const float inv = 1.f / ((sv[0] + sv[1]) + (sv[2] + sv[3]));
                bf16* rowp = base + (size_t)(ai * 128 + m * 16) * ldc;
#pragma unroll
                for (int bj = 0; bj < 2; ++bj) { const f32x4 v0 = acc[ai][bj][m][0] * inv, v1 = acc[ai][bj][m][1] * inv;
                    u32x4 w; w.x = pg8::cvt_pk_bf16(v0[0], v0[1]); w.y = pg8::cvt_pk_bf16(v0[2], v0[3]); w.z = pg8::cvt_pk_bf16(v1[0], v1[1]); w.w = pg8::cvt_pk_bf16(v1[2], v1[3]);
                    *(u32x4*)(rowp + bj * 128) = w; } }
    }
};
struct EpiAbIn {
    bf16* P; float* G32;
    __device__ __forceinline__ void operator()(EPI_ARGS) const {
        const int row0 = u.pm * 256 + wr * 64 + fr, col0 = u.pn * 256 + wc * 32 + 8 * fq;
#pragma unroll
        for (int ai = 0; ai < 2; ++ai)
#pragma unroll
            for (int m = 0; m < 4; ++m) { const int row = row0 + ai * 128 + m * 16; bf16* rowp = P + (size_t)row * AB_PAD + col0;
#pragma unroll
                for (int bj = 0; bj < 2; ++bj) { const f32x4 v0 = acc[ai][bj][m][0], v1 = acc[ai][bj][m][1];
                    u32x4 w; w.x = pg8::cvt_pk_bf16(v0[0], v0[1]); w.y = pg8::cvt_pk_bf16(v0[2], v0[3]); w.z = pg8::cvt_pk_bf16(v1[0], v1[1]); w.w = pg8::cvt_pk_bf16(v1[2], v1[3]);
                    *(u32x4*)(rowp + bj * 128) = w;
                    if (u.pn == 12) { float* g = G32 + (size_t)row * 256 + wc * 32 + 8 * fq + bj * 128; *(f32x4*)g = v0; *(f32x4*)(g + 4) = v1; } } }
    }
};
struct EpiLora {
    const float *w0, *a0, *k_a; const bf16 *KK, *KR; float* WD; bf16 *BV, *KP, *GG;
    __device__ __forceinline__ void operator()(EPI_ARGS) const {
        const int grp = u.pn >> 2, row0 = u.pm * 256 + wr * 64 + fr, cc0 = (u.pn & 3) * 256 + wc * 32 + 8 * fq;
#pragma unroll
        for (int ai = 0; ai < 2; ++ai)
#pragma unroll
            for (int m = 0; m < 4; ++m) { const size_t ro = (size_t)(row0 + ai * 128 + m * 16) * 1024;
#pragma unroll
                for (int bj = 0; bj < 2; ++bj) { const int cc = cc0 + bj * 128; float v[8];
#pragma unroll
                    for (int j = 0; j < 4; ++j) { v[j] = acc[ai][bj][m][0][j]; v[4 + j] = acc[ai][bj][m][1][j]; }
                    if (grp == 0) { float o[8]; const f32x4 p0 = *(const f32x4*)(w0 + cc), p1 = *(const f32x4*)(w0 + cc + 4); const float pw[8] = {p0.x, p0.y, p0.z, p0.w, p1.x, p1.y, p1.z, p1.w};
#pragma unroll
                        for (int j = 0; j < 8; ++j) o[j] = -0.6065306597126334f * sigmoidf_(pw[j] + v[j]);
                        *(f32x4*)(WD + ro + cc) = (f32x4){o[0], o[1], o[2], o[3]}; *(f32x4*)(WD + ro + cc + 4) = (f32x4){o[4], o[5], o[6], o[7]};
                    } else if (grp == 1) { float kk[8], kr[8], ob[8], ok[8];
                        unpack8(*(const u32x4*)(KK + ro + cc), kk); unpack8(*(const u32x4*)(KR + ro + cc), kr);
                        const f32x4 p0 = *(const f32x4*)(a0 + cc), p1 = *(const f32x4*)(a0 + cc + 4), q0 = *(const f32x4*)(k_a + cc), q1 = *(const f32x4*)(k_a + cc + 4);
                        const float pa[8] = {p0.x, p0.y, p0.z, p0.w, p1.x, p1.y, p1.z, p1.w}, qa[8] = {q0.x, q0.y, q0.z, q0.w, q1.x, q1.y, q1.z, q1.w};
#pragma unroll
                        for (int j = 0; j < 8; ++j) { const float a = sigmoidf_(pa[j] + v[j]); ob[j] = kk[j] * a; ok[j] = kr[j] * (1.f + (a - 1.f) * qa[j]); }
                        st16_f(BV + ro + cc, pack8f(ob)); st16_f(KP + ro + cc, pack8f(ok));
                    } else { st16_f(GG + ro + cc, pack8f(v)); } } }
    }
};
struct EpiHid {
    bf16* H; const int* rowslot; const float* rs;
    __device__ __forceinline__ void operator()(EPI_ARGS) const {
        bf16* base = H + (size_t)(u.aux + wr * 64 + fr) * FF + u.pn * 128 + wc * 32 + 8 * fq;
#pragma unroll
        for (int ai = 0; ai < 2; ++ai)
#pragma unroll
            for (int m = 0; m < 4; ++m) { float h[8]; const int r = ai * 128 + wr * 64 + m * 16 + fr; const float r_ = (r < u.pm) ? rstd_row(rs, rowslot[u.aux + r] >> 1) : 0.f;
#pragma unroll
                for (int j = 0; j < 4; ++j) { h[j] = siluf_(acc[ai][0][m][0][j] * r_) * (acc[ai][1][m][0][j] * r_); h[4 + j] = siluf_(acc[ai][0][m][1][j] * r_) * (acc[ai][1][m][1][j] * r_); }
                *(u32x4*)(base + (size_t)(ai * 128 + m * 16) * FF) = pack8f(h); }
    }
};
struct EpiMoeDown {
    const int* rowslot; const float* wts; bf16* YE;
    __device__ __forceinline__ void operator()(EPI_ARGS) const {
#pragma unroll
        for (int ai = 0; ai < 2; ++ai)
#pragma unroll
            for (int m = 0; m < 4; ++m) { const int r = ai * 128 + wr * 64 + m * 16 + fr;
                if (r < u.pm) { const int slot = rowslot[u.aux + r]; const float w = wts[slot]; bf16* rowp = YE + (size_t)slot * DM + u.pn * 256 + wc * 32 + 8 * fq;
#pragma unroll
                    for (int bj = 0; bj < 2; ++bj) { const f32x4 v0 = acc[ai][bj][m][0] * w, v1 = acc[ai][bj][m][1] * w;
                        u32x4 o; o.x = pg8::cvt_pk_bf16(v0[0], v0[1]); o.y = pg8::cvt_pk_bf16(v0[2], v0[3]); o.z = pg8::cvt_pk_bf16(v1[0], v1[1]); o.w = pg8::cvt_pk_bf16(v1[2], v1[3]);
                        *(u32x4*)(rowp + bj * 128) = o; } } }
    }
};
struct EpiNsaIn {
    bf16 *Q, *QROT, *KV6; float* GATES; const float *gate_b, *rcos, *rsin, *rs;
    __device__ __forceinline__ void operator()(EPI_ARGS) const {
        const int pn = u.pn;
#pragma unroll
        for (int ai = 0; ai < 2; ++ai)
#pragma unroll
            for (int m = 0; m < 4; ++m) { const int t = u.pm * 256 + ai * 128 + wr * 64 + m * 16 + fr, b = t >> 12, s = t & 4095; const float r_ = rstd_row(rs, t);
#pragma unroll
                for (int bj = 0; bj < 2; ++bj) { float v[8];
#pragma unroll
                    for (int j = 0; j < 4; ++j) { v[j] = acc[ai][bj][m][0][j] * r_; v[4 + j] = acc[ai][bj][m][1][j] * r_; }
                    const int d0 = wc * 32 + 8 * fq;
                    if (pn == 20) {
                        const int c = bj * 128 + d0;
                        if (c < 48) { float o[8];
#pragma unroll
                            for (int j = 0; j < 8; ++j) o[j] = sigmoidf_(v[j] + gate_b[c + j]);
                            float* g = GATES + (size_t)t * 48 + c; *(f32x4*)g = (f32x4){o[0], o[1], o[2], o[3]}; *(f32x4*)(g + 4) = (f32x4){o[4], o[5], o[6], o[7]}; }
                        continue; }
                    float vr[8];
#pragma unroll
                    for (int j = 0; j < 8; ++j) vr[j] = v[j];
                    if (wc == 0) { float pv[8];
#pragma unroll
                      for (int j = 0; j < 8; ++j) pv[j] = xor32f(v[j]);
                      const f32x4 c0 = *(const f32x4*)(rcos + s * 16 + 8 * (fq & 1)), c1 = *(const f32x4*)(rcos + s * 16 + 8 * (fq & 1) + 4), s0 = *(const f32x4*)(rsin + s * 16 + 8 * (fq & 1)), s1 = *(const f32x4*)(rsin + s * 16 + 8 * (fq & 1) + 4);
                      const float cs[8] = {c0.x, c0.y, c0.z, c0.w, c1.x, c1.y, c1.z, c1.w}, sn[8] = {s0.x, s0.y, s0.z, s0.w, s1.x, s1.y, s1.z, s1.w};
#pragma unroll
                      for (int j = 0; j < 8; ++j) vr[j] = (fq < 2) ? (v[j] * cs[j] - pv[j] * sn[j]) : (v[j] * cs[j] + pv[j] * sn[j]); }
                    if (pn < 8) { const int hh = pn * 2 + bj; const size_t o = (((size_t)(b * 16 + hh)) * SEQ + s) * 128 + d0;
                        *(u32x4*)(Q + o) = pack8f(v); *(u32x4*)(QROT + o) = pack8f(vr);
                    } else { const int i6 = (pn - 8) >> 1, g = ((pn - 8) & 1) * 2 + bj; const bool rot = (i6 == 2 || i6 == 4) && wc == 0;
                        bf16* dst = (bf16*)((unsigned char*)KV6 + (size_t)i6 * KV6_STRIDE) + (((size_t)(b * 4 + g)) * SPAD + s) * 128 + d0;
                        *(u32x4*)dst = rot ? pack8f(vr) : pack8f(v); } } }
    }
};

constexpr int MOE_CVT_TOTAL = 2 * NEXP * 3 * 512, MOE_CVT_SIDE_A = 0, MOE_CVT_SIDE_B = 28000, MOE_CVT_WG = 32, MOE_CVT_SIDE_C = 4096 * 8 * 2, MOE_CVT_SIDE_F = 1024 * 8 * 2, MOE_CVT_SIDE_G = 0  , MOE_CVT_SIDE_E = 2048 * 8 * 2, MOE_CVT_SIDE_H2 = 13000  , MOE_CVT_SIDE_H = 22000  ;
#define MOE_CVT_PROLOGUE_END(G_) ((G_) == 256 ? MOE_CVT_TOTAL - MOE_CVT_SIDE_A - MOE_CVT_SIDE_B - MOE_CVT_SIDE_C - MOE_CVT_SIDE_F - MOE_CVT_SIDE_G - MOE_CVT_SIDE_E - MOE_CVT_SIDE_H - MOE_CVT_SIDE_H2 : MOE_CVT_TOTAL)
#define MOE_CVT_BASE_C MOE_CVT_PROLOGUE_END(256)
#define MOE_CVT_BASE_F (MOE_CVT_BASE_C + MOE_CVT_SIDE_C)
#define MOE_CVT_BASE_G (MOE_CVT_BASE_F + MOE_CVT_SIDE_F)
#define MOE_CVT_BASE_E (MOE_CVT_BASE_G + MOE_CVT_SIDE_G)
#define MOE_CVT_BASE_H (MOE_CVT_BASE_E + MOE_CVT_SIDE_E)
#define MOE_CVT_BASE_H2 (MOE_CVT_BASE_H + MOE_CVT_SIDE_H)
static_assert(MOE_CVT_BASE_E >= MOE_CVT_TOTAL / 2 && MOE_CVT_BASE_H2 + MOE_CVT_SIDE_H2 + MOE_CVT_SIDE_A + MOE_CVT_SIDE_B == MOE_CVT_TOTAL && MOE_CVT_SIDE_H % 2 == 0 && MOE_CVT_SIDE_H2 % 2 == 0 && MOE_CVT_BASE_C % 2 == 0, "MoE conversion item ranges");
__device__ __forceinline__ void moe_convert_pair(const Ctx& C, int it, int lane) {
    auto ident = [](int n) { return n; };
    auto dg = [](int n) { return (n >> 7) * 256 + (n & 127); };
    auto du = [](int n) { return (n >> 7) * 256 + 128 + (n & 127); };
    const int per = 512;
    const int le = it / (3 * per), r = it % (3 * per), which = r / per, q = r % per;
    if (which == 0) { const int kb = q / 16, nb = q % 16; transpose_tiles<2>(INP(I_MOE_W_GATE) + (size_t)le * DM * FF, FF, FF, kb * 64, nb * 32, WSP(bf16, WS_W_GU) + (size_t)le * 1024 * DM, DM, dg, lane, INP(I_NORM_FFN) + (le >> 6) * DM); }
    else if (which == 1) { const int kb = q / 16, nb = q % 16; transpose_tiles<2>(INP(I_MOE_W_UP) + (size_t)le * DM * FF, FF, FF, kb * 64, nb * 32, WSP(bf16, WS_W_GU) + (size_t)le * 1024 * DM, DM, du, lane, INP(I_NORM_FFN) + (le >> 6) * DM); }
    else { const int kb = q / 64, nb = q % 64; transpose_tiles<2>(INP(I_MOE_W_DOWN) + (size_t)le * FF * DM, DM, DM, kb * 64, nb * 32, WSP(bf16, WS_W_DN) + (size_t)le * DM * FF, FF, ident, lane, nullptr); }
}
struct MoeTile { const float* W; bf16* WT; const float* ks; int ldw, ldt, k0, n0, mode; };
__device__ __forceinline__ MoeTile moe_tile_decode(const Ctx& C, int it) {
    const int per = 512, le = it / (3 * per), r = it % (3 * per), which = r / per, q = r % per; MoeTile t; t.mode = which;
    if (which < 2) { t.W = INP(which ? I_MOE_W_UP : I_MOE_W_GATE) + (size_t)le * DM * FF; t.ldw = FF; t.k0 = (q / 16) * 64; t.n0 = (q % 16) * 32; t.WT = WSP(bf16, WS_W_GU) + (size_t)le * 1024 * DM; t.ldt = DM; t.ks = INP(I_NORM_FFN) + (le >> 6) * DM; }
    else { t.W = INP(I_MOE_W_DOWN) + (size_t)le * FF * DM; t.ldw = DM; t.k0 = (q / 64) * 64; t.n0 = (q % 64) * 32; t.WT = WSP(bf16, WS_W_DN) + (size_t)le * DM * FF; t.ldt = FF; t.ks = nullptr; }
    return t;
}
__device__ __forceinline__ void moe_pair_load(const MoeTile& t, f32x4 (&v)[2][8], int lane) {
    const int g = lane >> 3, c = lane & 7;
#pragma unroll
    for (int q = 0; q < 2; ++q)
#pragma unroll
        for (int j = 0; j < 8; ++j) v[q][j] = __builtin_nontemporal_load((const f32x4*)(t.W + (size_t)(t.k0 + 8 * g + j) * t.ldw + t.n0 + 32 * q + 4 * c));
}
__device__ __forceinline__ void moe_pair_store(const MoeTile& t, const f32x4 (&v)[2][8], int lane) {
    const int g = lane >> 3, c = lane & 7; f32x4 ka = (f32x4){1.f, 1.f, 1.f, 1.f}, kb = ka;
    if (t.ks) { ka = *(const f32x4*)(t.ks + t.k0 + 8 * g); kb = *(const f32x4*)(t.ks + t.k0 + 8 * g + 4); }
#pragma unroll
    for (int q = 0; q < 2; ++q)
#pragma unroll
        for (int i = 0; i < 4; ++i) { const int nn = t.n0 + 32 * q + 4 * c + i, dr = (t.mode == 2) ? nn : ((nn >> 7) * 256 + (t.mode == 1 ? 128 : 0) + (nn & 127));
            u32x4 o; o.x = pk2(v[q][0][i] * ka.x, v[q][1][i] * ka.y); o.y = pk2(v[q][2][i] * ka.z, v[q][3][i] * ka.w); o.z = pk2(v[q][4][i] * kb.x, v[q][5][i] * kb.y); o.w = pk2(v[q][6][i] * kb.z, v[q][7][i] * kb.w);
            __builtin_nontemporal_store(o, (u32x4*)(t.WT + (size_t)dr * t.ldt + t.k0 + 8 * g)); }
}
__device__ __forceinline__ void moe_convert_items(const Ctx& C, int lo, int hi, int widx, int nworkers) {
    for (int it = lo + 2 * widx; it < hi; it += 2 * nworkers) moe_convert_pair(C, it, C.lane);
}
__device__ __forceinline__ void moe_convert_items_x2(const Ctx& C, int lo, int hi, int widx, int nworkers) {
    int it = lo + 2 * widx; const int st = 2 * nworkers;
    for (; it + st < hi; it += 2 * st) {
        f32x4 va[2][8], vb[2][8]; const MoeTile ta = moe_tile_decode(C, it), tb = moe_tile_decode(C, it + st);
        moe_pair_load(ta, va, C.lane); moe_pair_load(tb, vb, C.lane);
        moe_pair_store(ta, va, C.lane); moe_pair_store(tb, vb, C.lane);
    }
    for (; it < hi; it += st) moe_convert_pair(C, it, C.lane);
}
__device__ __forceinline__ void phase_prologue(const Ctx& C, const Args& A) {
    LAS float* scr = (LAS float*)(C.lds + C.wave * 8448);
    auto ident = [](int n) { return n; };
    transpose_matrix(C, INP(I_AB_W_IN), DM, AB_COLS, AB_PAD, WSP(bf16, WS_W_ABIN), DM, ident, scr);
    transpose_matrix(C, INP(I_AB_W_OUT), DM, DM, DM, WSP(bf16, WS_W_ABOUT), DM, ident, scr);
    transpose_matrix(C, INP(I_NSA_W_IN), DM, NSA_COLS, NSA_PAD, WSP(bf16, WS_W_NSAIN), DM, ident, scr, INP(I_NORM_MIX) + DM);
    transpose_matrix(C, INP(I_NSA_W_OUT), DM, DM, DM, WSP(bf16, WS_W_NSAOUT), DM, ident, scr);
    for (int l = 0; l < 2; ++l) {
        transpose_matrix(C, INP(I_CA_WK) + (size_t)l * DM * DM, DM, DM, DM, WSP(bf16, WS_W_CAK) + (size_t)l * DM * DM, DM, ident, scr);
        transpose_matrix(C, INP(I_CA_WV) + (size_t)l * DM * DM, DM, DM, DM, WSP(bf16, WS_W_CAV) + (size_t)l * DM * DM, DM, ident, scr);
        transpose_matrix(C, INP(I_CA_WO) + (size_t)l * DM * DM, DM, DM, DM, WSP(bf16, WS_W_CAO) + (size_t)l * DM * DM, DM, ident, scr);
    }
    for (int kv = 0; kv < 2; ++kv)
        transpose_matrix(C, INP(I_CMP_W1) + (size_t)kv * 4096 * 128, 4096, 128, 128, WSP(bf16, WS_W_CMP1) + (size_t)kv * 256 * 4096, 4096, ident, scr);
    moe_convert_items(C, 0, MOE_CVT_PROLOGUE_END(C.G), C.gw, C.ngw);
    const size_t gt = (size_t)C.bid * NTHR + C.tid, gn = (size_t)C.G * NTHR;
    { const float* src = INP(I_CA_WQ); bf16* dst = WSP(bf16, WS_W_CAQ);
      const float* gc = INP(I_NORM_CROSS);
      for (size_t i = gt; i < (size_t)2 * DM * DM / 4; i += gn) { const f32x4 v = *(const f32x4*)(src + i * 4); const float gq = gc[(i * 4) / DM]; u32x2 w; w.x = pk2(v.x * gq, v.y * gq); w.y = pk2(v.z * gq, v.w * gq); *(u32x2*)(dst + i * 4) = w; } }
    { bf16* dst = WSP(bf16, WS_W_LORA);
      for (size_t i = gt; i < (size_t)3072 * 256; i += gn) { const int n = (int)(i >> 8), k = (int)(i & 255); float v = 0.f;
          if (n < 1024) { if (k < 64) v = INP(I_RW_W_UP)[k * 1024 + n]; }
          else if (n < 2048) { if (k >= 64 && k < 128) v = INP(I_RW_A_UP)[(k - 64) * 1024 + (n - 1024)]; }
          else { if (k >= 128) v = INP(I_RW_G_UP)[(k - 128) * 1024 + (n - 2048)]; }
          dst[i] = (bf16)f2bf(v); } }
    { bf16* dst = WSP(bf16, WS_W_ROUTER);
      for (size_t i = gt; i < (size_t)2 * 256 * DM; i += gn) { const int l = (int)(i / (256 * DM)), n = (int)((i / DM) & 255), k = (int)(i % DM); float v = 0.f;
          if (n < 8) v = INP(I_MOE_WG)[((size_t)l * DM + k) * 8 + n]; else if (n < 72) v = INP(I_MOE_WE)[((size_t)l * DM + k) * 64 + (n - 8)];
          v *= INP(I_NORM_FFN)[l * DM + k];
          dst[i] = (bf16)f2bf(v); } }
    { float* rc = WSP(float, WS_TAB + TAB_ROPE_COS); float* rs = WSP(float, WS_TAB + TAB_ROPE_SIN);
      for (size_t i = gt; i < (size_t)SEQ * 16; i += gn) { const int pos = (int)(i >> 4), j = (int)(i & 15);
          const float inv = 1.0f / powf(500000.0f, (float)j / 16.0f); const float ang = (float)pos * inv; rc[i] = cosf(ang); rs[i] = sinf(ang); } }
    for (int w_ = C.gw; w_ < 2048; w_ += C.ngw) { const int o = w_ & 255, part = w_ >> 8, kv = o >> 7, e = o & 127; float s = 0.f;
#pragma unroll
        for (int j = 0; j < 8; ++j) { const int i = part * 512 + j * 64 + C.lane; s += INP(I_CMP_POS)[kv * 4096 + i] * INP(I_CMP_W1)[((size_t)kv * 4096 + i) * 128 + e]; }
        s = wave_sum(s); if (C.lane == 0) WSP(float, WS_TAB + TAB_CMPBIAS)[part * 256 + o] = s; }
    for (int r = C.gw; r < 2 * MT; r += C.ngw) { const int l = r / MT, m = r % MT;
        rms_row_bf16(INP(I_MEM) + (size_t)m * DM, INP(I_NORM_MEM) + l * DM, WSP(bf16, WS_MEMN) + ((size_t)l * MT + m) * DM, C.lane); }
    for (int r = C.gw; r < T; r += C.ngw) rms_row_bf16(INP(I_X) + (size_t)r * DM, INP(I_NORM_MIX), WSP(bf16, WS_XN) + (size_t)r * DM, C.lane);
}

struct MemProjOrder {
    int G, c;
    __device__ __forceinline__ bool next(int i, pg8::Unit& u) const {
        const int L = i * G + c; if (L >= 128) return false;
        const int pn = L & 7, pm = (L >> 3) & 3, kv = (L >> 5) & 1, l = L >> 6;
        u.pm = pm; u.pn = pn; u.aux = 0;
        u.aoff = ((long long)l * MT + pm * 256) * DM * 2;
        u.boff = ((long long)(kv ? (WS_W_CAV - WS_W_CAK) / 2 : 0) + ((long long)l * DM + pn * 256) * DM) * 2;
        u.coff = (long long)(kv ? (WS_VP - WS_KP) / 2 : 0) + ((long long)l * MT + pm * 256) * DM + pn * 256;
        return true;
    }
};
struct AbInMemOrder {
    pg8::DenseOrder d; MemProjOrder m;
    __device__ __forceinline__ bool next(int i, pg8::Unit& u) const {
        const long L = (long)i * d.G + d.c;
        if (L < (T / 256) * (AB_PAD / 256)) { int pm, pn; pg8::tile_of(L, d.nM, d.nN, pm, pn); u.pm = pm; u.pn = pn; u.aux = 0; u.aoff = (long long)WS_XN + pm * d.astep; u.boff = (long long)WS_W_ABIN + pn * d.bstep; u.coff = 0; return true; }
        pg8::Unit t; MemProjOrder mm{1 << 30, (int)(L - (T / 256) * (AB_PAD / 256))}; if (!mm.next(0, t)) return false;
        u = t; u.aux = 1; u.aoff += (long long)WS_MEMN; u.boff += (long long)WS_W_CAK; return true;
    }
};
struct EpiAbInMem { EpiAbIn a; EpiStoreBf16 m;
    __device__ __forceinline__ void operator()(EPI_ARGS) const { if (u.aux == 0) a(acc, u, wr, wc, fr, fq); else m(acc, u, wr, wc, fr, fq); } };
struct RouterOrder {
    int G, c;
    __device__ __forceinline__ bool next(int i, pg8::Unit& u) const {
        const int L = i * G + c; if (L >= 256) return false;
        const int pm = L & 63, ks = L >> 6; u.pm = pm; u.pn = 0; u.aux = ks;
        u.aoff = ((long long)pm * 256 * DM + ks * 512) * 2; u.boff = (long long)ks * 512 * 2; u.coff = ((long long)ks * T + pm * 256) * 256; return true;
    }
};
struct WktOrder {
    int G, c;
    __device__ __forceinline__ bool next(int i, pg8::Unit& u) const {
        const int L = i * G + c; if (L >= 256) return false;
        const int pn = L & 7, h = (L >> 3) & 3, b = (L >> 5) & 3, l = L >> 7;
        u.pm = 0; u.pn = pn; u.aux = 0;
        u.aoff = (((long long)l * MT + b * 256) * DM + h * 512) * 2;
        u.boff = (((long long)l * DM + pn * 256) * DM + h * 512) * 2;
        u.coff = (((long long)(l * 4 + b) * 1024) + h * 256) * DM + pn * 256;
        return true;
    }
};
struct VwtOrder {
    int G, c;
    __device__ __forceinline__ bool next(int i, pg8::Unit& u) const {
        const int L = i * G + c; if (L >= 256) return false;
        const int pm = L & 7, h = (L >> 3) & 3, b = (L >> 5) & 3, l = L >> 7;
        u.pm = pm; u.pn = 0; u.aux = 0;
        u.aoff = (((long long)l * DM + pm * 256) * DM + h * 512) * 2;
        u.boff = (((long long)l * MT + b * 256) * DM + h * 512) * 2;
        u.coff = (((long long)(l * 4 + b) * DM) + pm * 256) * 1024 + h * 256;
        return true;
    }
};
struct CrossOrder {
    int nN, G, c, ldc; long long astep, bstep, bbatch;
    __device__ __forceinline__ bool next(int i, pg8::Unit& u) const {
        int pm, pn; if (!pg8::tile_of((long)i * G + c, T / 256, nN, pm, pn)) return false;
        u.pm = pm; u.pn = pn; u.aux = 0; u.aoff = pm * astep; u.boff = (pm >> 4) * bbatch + pn * bstep; u.coff = (long long)pm * 256 * ldc + pn * 256; return true;
    }
};
struct CmpOrder {
    int G, c;
    __device__ __forceinline__ bool next(int i, pg8::Unit& u) const {
        const int L = i * G + c; if (L >= 256) return false;
        const int bg = L & 15, kv = (L >> 4) & 1, ks = L >> 5;
        u.pm = 0; u.pn = 0; u.aux = 0;
        u.aoff = (long long)kv * KV6_STRIDE + ((long long)bg * SPAD * 128 + ks * 512) * 2;
        u.boff = ((long long)kv * 256 * 4096 + ks * 512) * 2;
        u.coff = ((long long)(ks * 2 + kv) * 16 + bg) * 65536;
        return true;
    }
};
struct MoeOrder {
    const LAS int* tab; int npn, G, c, which;
    __device__ __forceinline__ bool next(int i, pg8::Unit& u) const {
        const int L = i * G + c, ntile = tab[64]; if (L >= ntile * npn) return false;
        const int tix = L / npn, pn = L % npn; int e = 0;
        for (int k = 32; k >= 1; k >>= 1) if (e + k < 64 && tab[e + k] <= tix) e += k;
        while (tab[e + 1] <= tix) ++e;
        const int mt = tix - tab[e], cnt = tab[65 + e], row0 = tab[129 + e] + mt * 256;
        u.pm = min(256, cnt - mt * 256); u.pn = pn; u.aux = row0;
        if (which == 0) { u.aoff = 0; u.boff = ((long long)e * 1024 + pn * 256) * DM * 2; }
        else { u.aoff = (long long)row0 * FF * 2; u.boff = ((long long)e * DM + pn * 256) * FF * 2; }
        u.coff = 0; return true;
    }
};
__device__ __forceinline__ void moe_build_table(const Ctx& C, const unsigned* cnt, LAS int* tab) {
    if (C.tid == 0) { int ts = 0, off = 0;
        for (int e = 0; e < 64; ++e) { const int n = (int)cnt[e]; tab[e] = ts; tab[65 + e] = n; tab[129 + e] = off; const int nt = (n + 255) >> 8; ts += nt; off += nt * 256; }
        tab[64] = ts; }
    __syncthreads();
}

__device__ __forceinline__ float log_sigmoidf_(float x) { return fminf(x, 0.f) - log1pf(__expf(-fabsf(x))); }
__device__ __forceinline__ void phase_mixer_prep(const Ctx& C, const Args& A) {
    const bf16* PAB = ARP(bf16, A_PAB); const float* G32 = ARP(float, A_GF32);
    bf16 *QM = ARP(bf16, A_QM), *KM = ARP(bf16, A_KM), *RR = ARP(bf16, A_RR), *KR = ARP(bf16, A_KR), *VR = ARP(bf16, A_VR), *KK = ARP(bf16, A_KK), *LIN = ARP(bf16, A_LIN);
    float *IG = ARP(float, A_IG), *LF = ARP(float, A_LF);
    const float *cw = INP(I_ML_CONV_W), *cb = INP(I_ML_CONV_B), *gb = INP(I_ML_GATE_B), *mu = INP(I_RW_MU), *k_k = INP(I_RW_K_K);
    const int lane = C.lane;
    for (int t = C.gw; t < T; t += C.ngw) {
        const int b = t >> 12, s = t & 4095; const bf16* P = PAB + (size_t)t * AB_PAD; const bf16* PR = P + ML_COLS;
        u32x4 cx[2][4], pc[7], pq[7]; const u32x4 z4 = (u32x4){0u, 0u, 0u, 0u};
#pragma unroll
        for (int it = 0; it < 2; ++it)
#pragma unroll
            for (int tap = 0; tap < 4; ++tap) { const int back = 3 - tap; cx[it][tap] = z4; if (s >= back) cx[it][tap] = *(const u32x4*)(P - (size_t)back * AB_PAD + (lane + 64 * it) * 8); }
#pragma unroll
        for (int it = 0; it < 7; ++it) { const int chunk = lane + 64 * it; pc[it] = z4; pq[it] = z4;
            if (chunk < 416) { pc[it] = *(const u32x4*)(PR + chunk * 8); if (s > 0) pq[it] = *(const u32x4*)(PR - AB_PAD + chunk * 8); } }
#pragma unroll
        for (int it = 0; it < 2; ++it) { const int c = (lane + 64 * it) * 8; float y[8];
            { const f32x4 b0 = *(const f32x4*)(cb + c), b1 = *(const f32x4*)(cb + c + 4); y[0] = b0.x; y[1] = b0.y; y[2] = b0.z; y[3] = b0.w; y[4] = b1.x; y[5] = b1.y; y[6] = b1.z; y[7] = b1.w; }
#pragma unroll
            for (int tap = 0; tap < 4; ++tap) { float xv[8]; unpack8(cx[it][tap], xv);
                const f32x4 w0 = *(const f32x4*)(cw + tap * 1024 + c), w1 = *(const f32x4*)(cw + tap * 1024 + c + 4);
                y[0] += xv[0] * w0.x; y[1] += xv[1] * w0.y; y[2] += xv[2] * w0.z; y[3] += xv[3] * w0.w; y[4] += xv[4] * w1.x; y[5] += xv[5] * w1.y; y[6] += xv[6] * w1.z; y[7] += xv[7] * w1.w; }
#pragma unroll
            for (int j = 0; j < 8; ++j) y[j] = siluf_(y[j]);
            if (c < 512) *(u32x4*)(QM + (size_t)t * 512 + c) = pack8f(y); else *(u32x4*)(KM + (size_t)t * 512 + c - 512) = pack8f(y); }
        if (lane < 8) { const float g = G32[(size_t)t * 256 + lane] + gb[lane];
            if (lane < 4) IG[(size_t)(b * 4 + lane) * SEQ + s] = g; else LF[(size_t)(b * 4 + lane - 4) * SEQ + s] = log_sigmoidf_(g); }
#pragma unroll
        for (int it = 0; it < 7; ++it) { const int chunk = lane + 64 * it; if (chunk >= 416) break; const int cc = chunk * 8;
            float p[8], pp[8], mx[8]; unpack8(pc[it], p); unpack8(pq[it], pp);
            { const f32x4 m0 = *(const f32x4*)(mu + cc), m1 = *(const f32x4*)(mu + cc + 4); const float mf[8] = {m0.x, m0.y, m0.z, m0.w, m1.x, m1.y, m1.z, m1.w};
#pragma unroll
              for (int j = 0; j < 8; ++j) mx[j] = p[j] + (pp[j] - p[j]) * mf[j]; }
            if (it < 2) *(u32x4*)(RR + (size_t)t * 1024 + cc) = pack8f(mx);
            else if (it < 4) { const int ck = cc - 1024; *(u32x4*)(KR + (size_t)t * 1024 + ck) = pack8f(mx);
                float kk[8], ss = 0.f; const f32x4 q0 = *(const f32x4*)(k_k + ck), q1 = *(const f32x4*)(k_k + ck + 4); const float kf[8] = {q0.x, q0.y, q0.z, q0.w, q1.x, q1.y, q1.z, q1.w};
#pragma unroll
                for (int j = 0; j < 8; ++j) { kk[j] = mx[j] * kf[j]; ss += kk[j] * kk[j]; }
                ss += DPPF(ss, DPP_XOR1); ss += DPPF(ss, DPP_XOR2); ss += DPPF(ss, DPP_HMIRROR);
                const float rn = rsqrtf(ss + 1e-12f);
#pragma unroll
                for (int j = 0; j < 8; ++j) kk[j] *= rn;
                *(u32x4*)(KK + (size_t)t * 1024 + ck) = pack8f(kk); }
            else if (it < 6) *(u32x4*)(VR + (size_t)t * 1024 + cc - 2048) = pack8f(mx);
            else { float o[8];
#pragma unroll
                for (int j = 0; j < 8; ++j) o[j] = (lane < 8) ? tanhf(mx[j]) : ((lane < 16) ? mx[j] : sigmoidf_(mx[j]));
                *(u32x4*)(LIN + (size_t)t * 256 + lane * 8) = pack8f(o); } }
    }
}

__device__ __forceinline__ void rwkv_scan_unit(const Ctx& C, const Args& A, int bh) {
    const int b = bh >> 4, h = bh & 15, w = C.wave, lane = C.lane, tid = C.tid;
    LAS float* IN = (LAS float*)C.lds;
    LAS float* PART = IN + 2 * 6 * 1024;
    LAS float* YP = PART + 2 * 8 * 64;
    const float* WD = ARP(float, A_WD); const bf16 *KKg = ARP(bf16, A_KK), *BV = ARP(bf16, A_BV), *KP = ARP(bf16, A_KP), *RR = ARP(bf16, A_RR), *VR = ARP(bf16, A_VR), *GG = ARP(bf16, A_GG);
    bf16* YCAT = ARP(bf16, A_YCAT);
    const float *r_k = INP(I_RW_R_K), *ln_w = INP(I_RW_LN_W), *ln_b = INP(I_RW_LN_B);
    const int li = tid >> 5, lch = (tid & 31) * 2;
    const size_t gbase = ((size_t)b * SEQ) * 1024 + h * 64 + lch;
    f32x2 rw; unsigned rk, rb, rp, rr_, rv;
#define RW_LOAD(grp) do { const size_t o = gbase + (size_t)((grp) * 16 + li) * 1024; rw = *(const f32x2*)(WD + o); rk = *(const unsigned*)(KKg + o); rb = *(const unsigned*)(BV + o); \
        rp = *(const unsigned*)(KP + o); rr_ = *(const unsigned*)(RR + o); rv = *(const unsigned*)(VR + o); } while (0)
#define RW_STORE(buf) do { LAS float* d = IN + (buf) * 6144 + li * 64 + lch; *(LAS f32x2*)(d) = rw; *(LAS f32x2*)(d + 1024) = (f32x2){lo_bf(rk), hi_bf(rk)}; *(LAS f32x2*)(d + 2048) = (f32x2){lo_bf(rb), hi_bf(rb)}; \
        *(LAS f32x2*)(d + 3072) = (f32x2){lo_bf(rp), hi_bf(rp)}; *(LAS f32x2*)(d + 4096) = (f32x2){lo_bf(rr_), hi_bf(rr_)}; *(LAS f32x2*)(d + 5120) = (f32x2){lo_bf(rv), hi_bf(rv)}; } while (0)
    float st[8];
#pragma unroll
    for (int j = 0; j < 8; ++j) st[j] = 0.f;
    __syncthreads();
    RW_LOAD(0); RW_STORE(0); __syncthreads();
    for (int grp = 0; grp < SEQ / 16; ++grp) {
        const int buf = grp & 1; const LAS float* I0 = IN + buf * 6144;
        if (grp + 1 < SEQ / 16) RW_LOAD(grp + 1);
        for (int i = 0; i < 16; ++i) {
            const LAS float* q = I0 + i * 64 + 8 * w;
            const f32x4 w0 = *(const LAS f32x4*)(q), w1 = *(const LAS f32x4*)(q + 4), k0 = *(const LAS f32x4*)(q + 1024), k1 = *(const LAS f32x4*)(q + 1028);
            const f32x4 b0 = *(const LAS f32x4*)(q + 2048), b1 = *(const LAS f32x4*)(q + 2052), p0 = *(const LAS f32x4*)(q + 3072), p1 = *(const LAS f32x4*)(q + 3076);
            const f32x4 r0 = *(const LAS f32x4*)(q + 4096), r1 = *(const LAS f32x4*)(q + 4100); const float vv = I0[5120 + i * 64 + lane];
            float skp = 0.f;
#pragma unroll
            for (int j = 0; j < 4; ++j) skp += st[j] * k0[j] + st[4 + j] * k1[j];
            PART[(i & 1) * 512 + w * 64 + lane] = skp;
            LDS_WAIT(); __builtin_amdgcn_s_barrier(); asm volatile("" ::: "memory");
            float sk = 0.f;
#pragma unroll
            for (int ww = 0; ww < 8; ++ww) sk += PART[(i & 1) * 512 + ww * 64 + lane];
            float yp = 0.f;
#pragma unroll
            for (int j = 0; j < 4; ++j) { st[j] = st[j] * w0[j] - sk * b0[j] + vv * p0[j]; st[4 + j] = st[4 + j] * w1[j] - sk * b1[j] + vv * p1[j]; yp += st[j] * r0[j] + st[4 + j] * r1[j]; }
            YP[i * 512 + w * 64 + lane] = yp;
        }
        if (grp + 1 < SEQ / 16) RW_STORE(buf ^ 1);
        __syncthreads();
#pragma unroll
        for (int q = 0; q < 2; ++q) { const int i = 2 * w + q; float y = 0.f;
#pragma unroll
            for (int ww = 0; ww < 8; ++ww) y += YP[i * 512 + ww * 64 + lane];
            const float mean = wave_sum(y) * (1.f / 64.f), dv = y - mean, var = wave_sum(dv * dv) * (1.f / 64.f);
            const int ch = h * 64 + lane; const float yn = dv * rsqrtf(var + 64e-5f) * ln_w[ch] + ln_b[ch];
            const float bonus = wave_sum(I0[4096 + i * 64 + lane] * I0[3072 + i * 64 + lane] * r_k[ch]) * I0[5120 + i * 64 + lane];
            const size_t tt = (size_t)b * SEQ + grp * 16 + i;
            const float g = bf2f(GG[tt * 1024 + ch]);
            YCAT[tt * DM + 1024 + ch] = (bf16)f2bf((yn + bonus) * g); }
    }
#undef RW_LOAD
#undef RW_STORE
    __syncthreads();
}

__device__ __forceinline__ f32x4 lds_mma(const LAS bf16* Am, int lda, const LAS bf16* Bt, int ldb, int tm, int tn, int K, int lane, f32x4 acc) {
    const LAS bf16* ap = Am + (tm * 16 + (lane & 15)) * lda + (lane >> 4) * 8;
    const LAS bf16* bp = Bt + (tn * 16 + (lane & 15)) * ldb + (lane >> 4) * 8;
    for (int k = 0; k < K; k += 32) { const bf16x8 a = *(const LAS bf16x8*)(ap + k); const bf16x8 bb = *(const LAS bf16x8*)(bp + k);
        acc = __builtin_amdgcn_mfma_f32_16x16x32_bf16(bb, a, acc, 0, 0, 0); }
    return acc;
}

constexpr int RP = 72;
__device__ __forceinline__ void st4_bf16(LAS bf16* p, f32x4 v) { u32x2 w; w.x = pk2(v[0], v[1]); w.y = pk2(v[2], v[3]); *(LAS u32x2*)p = w; }
__device__ __forceinline__ void st4_bf16_T(LAS bf16* base, int row, int col0, f32x4 v) {
#pragma unroll
    for (int j = 0; j < 4; ++j) base[(col0 + j) * RP + row] = (bf16)f2bf(v[j]);
}
__device__ __forceinline__ void st4_bf16_g(bf16* p, f32x4 v) { u32x2 w; w.x = pk2(v[0], v[1]); w.y = pk2(v[2], v[3]); *(u32x2*)p = w; }
__device__ __forceinline__ void tri_inverse_diag32(const LAS float* Cf, LAS bf16* Tm, LAS bf16* T00T, int lane) {
    const int hb = lane >> 5, j = lane & 31; const LAS float* Cb_ = Cf + hb * (32 * 64 + 32); float Tr[32];
#pragma unroll
    for (int t = 0; t < 32; ++t) { float acc0 = (t == j) ? 1.f : 0.f, acc1 = 0.f, acc2 = 0.f, acc3 = 0.f;
#pragma unroll
        for (int s4 = 0; s4 < (t + 3) / 4; ++s4) { const f32x4 cv = *(const LAS f32x4*)(Cb_ + t * 64 + s4 * 4);
            if (s4 * 4 + 0 < t) acc0 -= cv[0] * Tr[s4 * 4 + 0]; if (s4 * 4 + 1 < t) acc1 -= cv[1] * Tr[s4 * 4 + 1];
            if (s4 * 4 + 2 < t) acc2 -= cv[2] * Tr[s4 * 4 + 2]; if (s4 * 4 + 3 < t) acc3 -= cv[3] * Tr[s4 * 4 + 3]; }
        Tr[t] = (acc0 + acc1) + (acc2 + acc3); Tm[(32 * hb + t) * RP + 32 * hb + j] = (bf16)f2bf(Tr[t]); __builtin_amdgcn_sched_barrier(0); }
    if (hb == 0) {
#pragma unroll
        for (int q = 0; q < 4; ++q) *(LAS u32x4*)(T00T + j * 40 + 8 * q) = pack8f(Tr + 8 * q); }
    { const int t = lane >> 1, h = lane & 1; const u32x4 z = (u32x4){0u, 0u, 0u, 0u}; *(LAS u32x4*)(Tm + t * RP + 32 + 16 * h) = z; *(LAS u32x4*)(Tm + t * RP + 32 + 16 * h + 8) = z; }
}
__device__ __forceinline__ void rwkv_prep_units(const Ctx& C, bool side_cvt) {
    int unit = C.bid; if (unit >= 4096) return;
    const int w = C.wave;
    LAS float* F = (LAS float*)C.lds;
    LAS float* EGL = F + 4096;
    LAS bf16* B0 = (LAS bf16*)(EGL + 64 + 512);
    LAS bf16 *Kt = B0, *Rt = B0 + 64 * RP, *Kb = B0 + 2 * 64 * RP, *Bb = B0 + 3 * 64 * RP, *KtT = B0 + 4 * 64 * RP, *KhT = B0 + 5 * 64 * RP, *BhT = B0 + 6 * 64 * RP,
             *VcT = B0 + 7 * 64 * RP, *Am = B0 + 8 * 64 * RP, *Q1 = B0 + 9 * 64 * RP, *Q2 = B0 + 10 * 64 * RP;
    LAS bf16 *Tm = Kt, *AVT = Kb, *WmT = Bb, *UT = Am;
    LAS bf16 *C10b = (LAS bf16*)(C.lds + LDS_AUX), *T00T = C10b + 32 * 40, *XT = T00T + 32 * 40;
    const float* WD = ARP(float, A_WD); const bf16 *KKg = ARP(bf16, A_KK), *BV = ARP(bf16, A_BV), *KP = ARP(bf16, A_KP), *RR = ARP(bf16, A_RR), *VR = ARP(bf16, A_VR);
    f32x4 lw0, lw1; u32x4 rk, rb, rp, rr, rv;
#define RWP_LOAD(u_) do { const int bh_ = (u_) >> 6, c_ = (u_) & 63; const size_t go_ = ((size_t)(bh_ >> 4) * SEQ + c_ * 64 + (C.tid >> 3)) * 1024 + (bh_ & 15) * 64 + (C.tid & 7) * 8; \
        lw0 = *(const f32x4*)(WD + go_); lw1 = *(const f32x4*)(WD + go_ + 4); rk = *(const u32x4*)(KKg + go_); rb = *(const u32x4*)(BV + go_); rp = *(const u32x4*)(KP + go_); rr = *(const u32x4*)(RR + go_); rv = *(const u32x4*)(VR + go_); } while (0)
    RWP_LOAD(unit);
  for (;;) {
    int tid = C.tid; asm volatile("" : "+v"(tid));
    const int lane = tid & 63, t = tid >> 3, c8 = (tid & 7) * 8;
    bf16 *GM = ARP(bf16, A_RWM) + (size_t)unit * 4096, *GN = ARP(bf16, A_RWN) + (size_t)unit * 4096, *GRW = ARP(bf16, A_RWRW) + (size_t)unit * 4096, *GYL = ARP(bf16, A_RWYL) + (size_t)unit * 4096;
    __syncthreads();
    *(LAS f32x4*)(F + t * 64 + c8) = lw0; *(LAS f32x4*)(F + t * 64 + c8 + 4) = lw1;
    __syncthreads();
    { float g = 0.f;
#pragma unroll
      for (int i = 0; i < 8; ++i) { g += F[(8 * w + i) * 64 + lane]; F[(8 * w + i) * 64 + lane] = g; }
      EGL[64 + w * 64 + lane] = g; }
    __syncthreads();
    { float off = 0.f;
      for (int ww = 0; ww < w; ++ww) off += EGL[64 + ww * 64 + lane];
#pragma unroll
      for (int i = 0; i < 8; ++i) F[(8 * w + i) * 64 + lane] += off; }
    __syncthreads();
    { float G[8], Gm[8], GL[8], kkf[8], bf_[8], kpf[8], rf[8], vf[8];
#pragma unroll
      for (int j = 0; j < 8; ++j) { G[j] = F[t * 64 + c8 + j]; Gm[j] = t > 0 ? F[(t - 1) * 64 + c8 + j] : 0.f; GL[j] = F[63 * 64 + c8 + j]; }
      unpack8(rk, kkf); unpack8(rb, bf_); unpack8(rp, kpf); unpack8(rr, rf); unpack8(rv, vf);
      float okt[8], ort[8], okb[8], obb[8];
#pragma unroll
      for (int j = 0; j < 8; ++j) { const float e1 = __expf(Gm[j]), e2 = __expf(G[j]), e3 = __expf(-G[j]), e4 = __expf(GL[j] - G[j]);
          okt[j] = kkf[j] * e1; ort[j] = rf[j] * e2; okb[j] = kpf[j] * e3; obb[j] = bf_[j] * e3;
          KtT[(c8 + j) * RP + t] = (bf16)f2bf(okt[j]); KhT[(c8 + j) * RP + t] = (bf16)f2bf(kpf[j] * e4); BhT[(c8 + j) * RP + t] = (bf16)f2bf(bf_[j] * e4);
          VcT[(c8 + j) * RP + t] = (bf16)f2bf(vf[j]);
          if (t == 63) EGL[c8 + j] = e2; }
      *(LAS u32x4*)(Kt + t * RP + c8) = pack8f(okt); *(LAS u32x4*)(Rt + t * RP + c8) = pack8f(ort); *(LAS u32x4*)(Kb + t * RP + c8) = pack8f(okb); *(LAS u32x4*)(Bb + t * RP + c8) = pack8f(obb); }
    const int next_unit = unit + C.G; if (next_unit < 4096) RWP_LOAD(next_unit);
    f32x4 cvv[2][8]; MoeTile mt = moe_tile_decode(C, MOE_CVT_BASE_C + (unit * 8 + w) * 2);
    if (side_cvt) moe_pair_load(mt, cvv, lane);
    __syncthreads();
    const int tm = w >> 1, tn0 = (w & 1) * 2, row = tm * 16 + (lane & 15), cq = 4 * (lane >> 4); const f32x4 z4 = (f32x4){0.f, 0.f, 0.f, 0.f};
#pragma unroll
    for (int q = 0; q < 2; ++q) { const int tn = tn0 + q, col = tn * 16 + cq;
        f32x4 a = lds_mma(Kt, RP, Kb, RP, tm, tn, 64, lane, z4), cc = lds_mma(Kt, RP, Bb, RP, tm, tn, 64, lane, z4), q1 = lds_mma(Rt, RP, Kb, RP, tm, tn, 64, lane, z4), q2 = lds_mma(Rt, RP, Bb, RP, tm, tn, 64, lane, z4);
#pragma unroll
        for (int j = 0; j < 4; ++j) { const bool lo_ = (col + j) < row, le_ = (col + j) <= row; a[j] = lo_ ? a[j] : 0.f; cc[j] = lo_ ? cc[j] : 0.f; q1[j] = le_ ? q1[j] : 0.f; q2[j] = le_ ? q2[j] : 0.f; }
        st4_bf16(Am + row * RP + col, a); st4_bf16(Q1 + row * RP + col, q1); st4_bf16(Q2 + row * RP + col, q2); *(LAS f32x4*)(F + row * 64 + col) = cc;
        if (row >= 32 && col < 32) st4_bf16(C10b + (row - 32) * 40 + col, cc); }
    __syncthreads();
    if (w == 0) tri_inverse_diag32(F, Tm, T00T, lane);
    else { for (int tile = w - 1; tile < 16; tile += 7) { const int am = tile >> 2, an = tile & 3; const f32x4 av = lds_mma(Am, RP, VcT, RP, am, an, 64, lane, z4); st4_bf16_T(AVT, am * 16 + (lane & 15), an * 16 + cq, av); } }
    __syncthreads();
    if (w < 4) { const int bm = w >> 1, bn = w & 1; const f32x4 x = lds_mma(C10b, 40, T00T, 40, bm, bn, 32, lane, z4);
#pragma unroll
        for (int j = 0; j < 4; ++j) XT[(bn * 16 + cq + j) * 40 + bm * 16 + (lane & 15)] = (bf16)f2bf(x[j]); }
    __syncthreads();
    if (w < 4) { const int bm = w >> 1, bn = w & 1; const f32x4 x = lds_mma(Tm + 32 * RP + 32, RP, XT, 40, bm, bn, 32, lane, z4);
        st4_bf16(Tm + (32 + bm * 16 + (lane & 15)) * RP + bn * 16 + cq, (f32x4){-x[0], -x[1], -x[2], -x[3]}); }
    if (side_cvt) moe_pair_store(mt, cvv, lane);
    __syncthreads();
#pragma unroll
    for (int q = 0; q < 2; ++q) { const int tn = tn0 + q, col = tn * 16 + cq;
        const f32x4 wm = lds_mma(Tm, RP, KtT, RP, tm, tn, 64, lane, z4), uu = lds_mma(Tm, RP, AVT, RP, tm, tn, 64, lane, z4);
        st4_bf16_T(WmT, row, col, wm); st4_bf16_T(UT, row, col, uu); }
    __syncthreads();
#pragma unroll
    for (int q = 0; q < 2; ++q) { const int tn = tn0 + q, col = tn * 16 + cq;
        { f32x4 p = lds_mma(Q2, RP, WmT, RP, tm, tn, 64, lane, z4); const u32x2 rw_ = *(const LAS u32x2*)(Rt + row * RP + col);
          st4_bf16_g(GRW + row * 64 + col, (f32x4){lo_bf(rw_.x) - p[0], hi_bf(rw_.x) - p[1], lo_bf(rw_.y) - p[2], hi_bf(rw_.y) - p[3]}); }
        { const f32x4 p1 = lds_mma(Q1, RP, VcT, RP, tm, tn, 64, lane, z4), p2 = lds_mma(Q2, RP, UT, RP, tm, tn, 64, lane, z4); st4_bf16_g(GYL + row * 64 + col, p1 - p2); }
        { f32x4 p = lds_mma(BhT, RP, WmT, RP, tm, tn, 64, lane, z4);
#pragma unroll
          for (int j = 0; j < 4; ++j) p[j] = ((col + j) == row ? EGL[row] : 0.f) - p[j];
          st4_bf16_g(GM + row * 64 + col, p); }
        { const f32x4 p1 = lds_mma(KhT, RP, VcT, RP, tm, tn, 64, lane, z4), p2 = lds_mma(BhT, RP, UT, RP, tm, tn, 64, lane, z4); st4_bf16_g(GN + row * 64 + col, p1 - p2); } }
    if (next_unit >= 4096) break; unit = next_unit;
  }
#undef RWP_LOAD
}
__device__ __forceinline__ void rwkv_scan_slice(const Ctx& C, int item) {
    const int bh = item >> 2, v0 = (item & 3) * 16, b = bh >> 4, h = bh & 15, lane = C.lane, w = C.wave;
    LAS bf16* SH = (LAS bf16*)C.lds;
    LAS bf16* SL = SH + 2 * 16 * RP;
    const bf16 *GM = ARP(bf16, A_RWM) + (size_t)bh * 64 * 4096, *GN = ARP(bf16, A_RWN) + (size_t)bh * 64 * 4096, *GRW = ARP(bf16, A_RWRW) + (size_t)bh * 64 * 4096, *GYL = ARP(bf16, A_RWYL) + (size_t)bh * 64 * 4096;
    bf16* YRAW = ARP(bf16, A_KR);
    const bool is_state = w >= 4; const int tm = w & 3, row = tm * 16 + (lane & 15), cq = 4 * (lane >> 4), kq = (lane >> 4) * 8;
    const bf16* GA = is_state ? GM : GRW; const bf16* GB = is_state ? GN : GYL;
    f32x4 st = (f32x4){0.f, 0.f, 0.f, 0.f};
    bf16x8 a0, a1, b0, b1; u32x2 addA, addB;
#define RWS_LOAD(cc_, X0, X1, XA) do { const size_t uo_ = (size_t)(cc_) * 4096; X0 = *(const bf16x8*)(GA + uo_ + row * 64 + kq); X1 = *(const bf16x8*)(GA + uo_ + row * 64 + 32 + kq); XA = *(const u32x2*)(GB + uo_ + row * 64 + v0 + cq); } while (0)
#define RWS_STEP(c_, X0, X1, XA) do { \
        LAS bf16* sh = SH + ((c_) & 1) * 16 * RP; LAS bf16* sl = SL + ((c_) & 1) * 16 * RP; \
        if (is_state) { _Pragma("unroll") for (int j = 0; j < 4; ++j) { const float s_ = st[j]; const unsigned hb = f2bf(s_); sh[(cq + j) * RP + row] = (bf16)hb; sl[(cq + j) * RP + row] = (bf16)f2bf(s_ - __uint_as_float(hb << 16)); } } \
        LDS_WAIT(); __builtin_amdgcn_s_barrier(); asm volatile("" ::: "memory"); \
        const LAS bf16* bh_ = sh + (lane & 15) * RP + kq; const LAS bf16* bl_ = sl + (lane & 15) * RP + kq; \
        const bf16x8 h0 = *(const LAS bf16x8*)bh_, h1 = *(const LAS bf16x8*)(bh_ + 32), l0 = *(const LAS bf16x8*)bl_, l1 = *(const LAS bf16x8*)(bl_ + 32); \
        f32x4 acc = (f32x4){lo_bf(XA.x), hi_bf(XA.x), lo_bf(XA.y), hi_bf(XA.y)}; \
        acc = __builtin_amdgcn_mfma_f32_16x16x32_bf16(h0, X0, acc, 0, 0, 0); acc = __builtin_amdgcn_mfma_f32_16x16x32_bf16(h1, X1, acc, 0, 0, 0); \
        acc = __builtin_amdgcn_mfma_f32_16x16x32_bf16(l0, X0, acc, 0, 0, 0); acc = __builtin_amdgcn_mfma_f32_16x16x32_bf16(l1, X1, acc, 0, 0, 0); \
        if ((c_) + 2 < 64) RWS_LOAD((c_) + 2, X0, X1, XA); \
        if (is_state) st = acc; \
        else st4_bf16_g(YRAW + ((size_t)b * SEQ + (c_) * 64 + row) * 1024 + h * 64 + v0 + cq, acc); } while (0)
    RWS_LOAD(0, a0, a1, addA); RWS_LOAD(1, b0, b1, addB);
    __syncthreads();
    for (int c = 0; c < 64; c += 2) { RWS_STEP(c, a0, a1, addA); RWS_STEP(c + 1, b0, b1, addB); }
#undef RWS_LOAD
#undef RWS_STEP
    __syncthreads();
}
__device__ __forceinline__ float sum8(float v) { v += DPPF(v, DPP_XOR1); v += DPPF(v, DPP_XOR2); v += DPPF(v, DPP_HMIRROR); return v; }
__device__ __forceinline__ void rwkv_out_items(const Ctx& C) {
    const bf16 *YRAW = ARP(bf16, A_KR), *KP = ARP(bf16, A_KP), *RR = ARP(bf16, A_RR), *VR = ARP(bf16, A_VR), *GG = ARP(bf16, A_GG); bf16* YCAT = ARP(bf16, A_YCAT);
    const float *r_k = INP(I_RW_R_K), *ln_w = INP(I_RW_LN_W), *ln_b = INP(I_RW_LN_B); const int lane = C.lane;
    for (int tt = C.gw; tt < T; tt += C.ngw) {
#pragma unroll
        for (int j = 0; j < 2; ++j) { const int ch = (j * 64 + lane) * 8; const size_t o = (size_t)tt * 1024 + ch;
            float y[8], rr[8], kp[8], vr[8], gg[8]; unpack8(*(const u32x4*)(YRAW + o), y); unpack8(*(const u32x4*)(RR + o), rr); unpack8(*(const u32x4*)(KP + o), kp); unpack8(*(const u32x4*)(VR + o), vr); unpack8(*(const u32x4*)(GG + o), gg);
            const f32x4 rk0 = *(const f32x4*)(r_k + ch), rk1 = *(const f32x4*)(r_k + ch + 4), lw0 = *(const f32x4*)(ln_w + ch), lw1 = *(const f32x4*)(ln_w + ch + 4), lb0 = *(const f32x4*)(ln_b + ch), lb1 = *(const f32x4*)(ln_b + ch + 4);
            const float rkf[8] = {rk0.x, rk0.y, rk0.z, rk0.w, rk1.x, rk1.y, rk1.z, rk1.w}, lwf[8] = {lw0.x, lw0.y, lw0.z, lw0.w, lw1.x, lw1.y, lw1.z, lw1.w}, lbf[8] = {lb0.x, lb0.y, lb0.z, lb0.w, lb1.x, lb1.y, lb1.z, lb1.w};
            float s1 = 0.f, sb = 0.f;
#pragma unroll
            for (int q = 0; q < 8; ++q) { s1 += y[q]; sb += rr[q] * kp[q] * rkf[q]; }
            const float mean = sum8(s1) * (1.f / 64.f), bonus = sum8(sb); float s2 = 0.f;
#pragma unroll
            for (int q = 0; q < 8; ++q) { y[q] -= mean; s2 += y[q] * y[q]; }
            const float rstd = rsqrtf(sum8(s2) * (1.f / 64.f) + 64e-5f); float o8[8];
#pragma unroll
            for (int q = 0; q < 8; ++q) o8[q] = (y[q] * rstd * lwf[q] + lbf[q] + bonus * vr[q]) * gg[q];
            st16_f(YCAT + (size_t)tt * DM + 1024 + ch, pack8f(o8)); }
    }
}
constexpr int MLE = 272;
__device__ __forceinline__ void ml_gate_scan(const Ctx& C, int bh4) {
    const float *IG = ARP(float, A_IG) + (size_t)bh4 * SEQ, *LFp = ARP(float, A_LF) + (size_t)bh4 * SEQ; float *AAg = ARP(float, A_MLA) + (size_t)bh4 * SEQ, *MXg = ARP(float, A_MLM) + (size_t)bh4 * SEQ;
    const int lane = C.lane, p0 = lane * 64; float tot = 0.f;
    for (int i = 0; i < 64; i += 4) { const f32x4 f = *(const f32x4*)(LFp + p0 + i); tot += (f.x + f.y) + (f.z + f.w); }
    float inc = tot;
#pragma unroll
    for (int o = 1; o < 64; o <<= 1) { const float n = __shfl_up(inc, o); if (lane >= o) inc += n; }
    float F = inc - tot, mloc = -INFINITY; f32x4 av[16];
#pragma unroll
    for (int i = 0; i < 16; ++i) { const f32x4 f = *(const f32x4*)(LFp + p0 + 4 * i), g = *(const f32x4*)(IG + p0 + 4 * i); f32x4 a;
        F += f.x; a.x = g.x - F; F += f.y; a.y = g.y - F; F += f.z; a.z = g.z - F; F += f.w; a.w = g.w - F;
        *(f32x4*)(AAg + p0 + 4 * i) = a; av[i] = a; mloc = fmaxf(fmaxf(mloc, fmaxf(a.x, a.y)), fmaxf(a.z, a.w)); }
    float minc = mloc;
#pragma unroll
    for (int o = 1; o < 64; o <<= 1) { const float n = __shfl_up(minc, o); if (lane >= o) minc = fmaxf(minc, n); }
    float run = __shfl_up(minc, 1); if (lane == 0) run = 0.f; run = fmaxf(run, 0.f);
#pragma unroll
    for (int i = 0; i < 16; ++i) { const f32x4 a = av[i]; f32x4 m;
        run = fmaxf(run, a.x); m.x = run; run = fmaxf(run, a.y); m.y = run; run = fmaxf(run, a.z); m.z = run; run = fmaxf(run, a.w); m.w = run;
        *(f32x4*)(MXg + p0 + 4 * i) = m; }
}
__device__ __forceinline__ void ml_intra_unit(const Ctx& C, int unit, bool side_cvt) {
    int tid = C.tid; asm volatile("" : "+v"(tid));
    const int bh4 = unit >> 6, c = unit & 63, b = bh4 >> 2, h = bh4 & 3, w = C.wave, lane = tid & 63, t0 = c * 64;
    LAS bf16* Qs = (LAS bf16*)C.lds;
    LAS bf16* Ks = Qs + 64 * 136;
    LAS bf16* KwT = Ks + 64 * 136;
    LAS bf16* VtE = KwT + 128 * 72;
    LAS bf16* Ps = VtE + MLE * 72;
    LAS float* AAs = (LAS float*)(Ps + 64 * 72);
    const bf16 *QM = ARP(bf16, A_QM), *KM = ARP(bf16, A_KM), *PAB = ARP(bf16, A_PAB);
    const float *AAg = ARP(float, A_MLA) + (size_t)bh4 * SEQ + t0, *MXg = ARP(float, A_MLM) + (size_t)bh4 * SEQ + t0;
    bf16* NUMI = ARP(bf16, A_MLNUM) + (size_t)unit * 64 * MLE; bf16* KVT = ARP(bf16, A_MLKV) + (size_t)unit * MLE * 128;
    const size_t tok0 = (size_t)b * SEQ + t0;
    u32x4 rq[2], rk[2], rv[4];
#pragma unroll
    for (int k = 0; k < 2; ++k) { const int idx = tid + 512 * k, r = idx >> 4, c8 = (idx & 15) * 8; const size_t o = (tok0 + r) * 512 + h * 128 + c8; rq[k] = *(const u32x4*)(QM + o); rk[k] = *(const u32x4*)(KM + o); }
#pragma unroll
    for (int k = 0; k < 4; ++k) { const int idx = tid + 512 * k, r = idx >> 5, e8 = (idx & 31) * 8; rv[k] = *(const u32x4*)(PAB + (tok0 + r) * AB_PAD + 1024 + h * 256 + e8); }
    const float Mc2 = MXg[63];
    f32x4 cvv[2][8]; MoeTile mt = moe_tile_decode(C, MOE_CVT_BASE_F + (unit * 8 + w) * 2); if (side_cvt) moe_pair_load(mt, cvv, lane);
    __syncthreads();
    if (tid < 64) { AAs[tid] = AAg[tid]; AAs[64 + tid] = MXg[tid]; }
    for (int i = tid; i < 16 * 72; i += NTHR) VtE[256 * 72 + i] = (i < 72) ? (bf16)0x3f80 : (bf16)0;
#pragma unroll
    for (int k = 0; k < 2; ++k) { const int idx = tid + 512 * k, r = idx >> 4, c8 = (idx & 15) * 8;
        *(LAS u32x4*)(Qs + r * 136 + c8) = rq[k]; *(LAS u32x4*)(Ks + r * 136 + c8) = rk[k];
        float kf[8]; unpack8(rk[k], kf); const float wk = __expf(AAg[r] - Mc2);
#pragma unroll
        for (int j = 0; j < 8; ++j) KwT[(c8 + j) * 72 + r] = (bf16)f2bf(kf[j] * wk); }
#pragma unroll
    for (int k = 0; k < 4; ++k) { const int idx = tid + 512 * k, r = idx >> 5, e8 = (idx & 31) * 8; const unsigned wv[4] = {rv[k].x, rv[k].y, rv[k].z, rv[k].w};
#pragma unroll
        for (int j = 0; j < 4; ++j) { VtE[(e8 + 2 * j) * 72 + r] = (bf16)(wv[j] & 0xffff); VtE[(e8 + 2 * j + 1) * 72 + r] = (bf16)(wv[j] >> 16); } }
    __syncthreads();
#pragma unroll
    for (int q = 0; q < 2; ++q) { const int tile = 2 * w + q, tm = tile >> 2, tn = tile & 3; const int t = tm * 16 + (lane & 15), l0 = tn * 16 + 4 * (lane >> 4);
        f32x4 s = (f32x4){0.f, 0.f, 0.f, 0.f};
        if (tn <= tm) s = lds_mma(Qs, 136, Ks, 136, tm, tn, 128, lane, s);
        const float mxt = AAs[64 + t]; float pvv[4];
#pragma unroll
        for (int j = 0; j < 4; ++j) { const int l = l0 + j; pvv[j] = (l <= t) ? s[j] * __expf(AAs[l] - mxt) : 0.f; }
        u32x2 pw; pw.x = pk2(pvv[0], pvv[1]); pw.y = pk2(pvv[2], pvv[3]); *(LAS u32x2*)(Ps + t * 72 + l0) = pw; }
    { const int tn = w;
      for (int tm = 0; tm < 17; ++tm) { const f32x4 kv = lds_mma(VtE, 72, KwT, 72, tm, tn, 64, lane, (f32x4){0.f, 0.f, 0.f, 0.f}); const int e = tm * 16 + (lane & 15);
          if (e <= 256) st4_bf16_g(KVT + (size_t)e * 128 + tn * 16 + 4 * (lane >> 4), kv); } }
    __syncthreads();
    { const int tm = w >> 1, t = tm * 16 + (lane & 15);
      for (int tn = (w & 1); tn < 17; tn += 2) { const f32x4 nv = lds_mma(Ps, 72, VtE, 72, tm, tn, 64, lane, (f32x4){0.f, 0.f, 0.f, 0.f}); st4_bf16_g(NUMI + (size_t)t * MLE + tn * 16 + 4 * (lane >> 4), nv); } }
    if (side_cvt) moe_pair_store(mt, cvv, lane);
}
__device__ __forceinline__ void ml_state_scan(const Ctx& C, int first_block, int nblocks) {
    const float* MXg = ARP(float, A_MLM); bf16* KVT = ARP(bf16, A_MLKV);
    constexpr int NPAIR = 16 * 257 * 64;
    const int nthr = nblocks * NTHR, g0 = (C.bid - first_block) * NTHR + C.tid;
    unsigned eoff[3], moff[3]; f32x2 cst[3]; float mprev[3]; bool ev[3];
#pragma unroll
    for (int k = 0; k < 3; ++k) { const int pi = g0 + k * nthr; ev[k] = pi < NPAIR; const int bh4 = ev[k] ? pi / (257 * 64) : 0, r = ev[k] ? pi - bh4 * (257 * 64) : 0;
        eoff[k] = (unsigned)(bh4 * 64 * MLE * 128 + 2 * r); moff[k] = (unsigned)(bh4 * SEQ); cst[k] = (f32x2){0.f, 0.f}; mprev[k] = 0.f; }
    for (int c0 = 0; c0 < 64; c0 += 8) {
        unsigned kvw[3][8]; float mn[3][8];
#pragma unroll
        for (int k = 0; k < 3; ++k)
#pragma unroll
            for (int j = 0; j < 8; ++j) { kvw[k][j] = 0u; mn[k][j] = 0.f; if (ev[k]) { kvw[k][j] = *(const unsigned*)(KVT + eoff[k] + (unsigned)(c0 + j) * (MLE * 128)); mn[k][j] = MXg[moff[k] + (c0 + j) * 64 + 63]; } }
#pragma unroll
        for (int j = 0; j < 8; ++j)
#pragma unroll
            for (int k = 0; k < 3; ++k) if (ev[k]) { *(unsigned*)(KVT + eoff[k] + (unsigned)(c0 + j) * (MLE * 128)) = pk2(cst[k].x, cst[k].y);
                const float dc = __expf(mprev[k] - mn[k][j]); cst[k].x = dc * cst[k].x + lo_bf(kvw[k][j]); cst[k].y = dc * cst[k].y + hi_bf(kvw[k][j]); mprev[k] = mn[k][j]; } }
}
__device__ __forceinline__ void ml_out_unit(const Ctx& C, int unit, bool side_cvt) {
    int tid = C.tid; asm volatile("" : "+v"(tid));
    const int bh4 = unit >> 6, c = unit & 63, b = bh4 >> 2, h = bh4 & 3, w = C.wave, lane = tid & 63, t0 = c * 64;
    LAS bf16* Qs = (LAS bf16*)C.lds;
    LAS bf16* CTs = Qs + 64 * 136;
    const bf16 *QM = ARP(bf16, A_QM), *PAB = ARP(bf16, A_PAB), *NUMI = ARP(bf16, A_MLNUM) + (size_t)unit * 64 * MLE, *KVT = ARP(bf16, A_MLKV) + (size_t)unit * MLE * 128; bf16* YCAT = ARP(bf16, A_YCAT);
    const float *IG = ARP(float, A_IG) + (size_t)bh4 * SEQ + t0, *AAg = ARP(float, A_MLA) + (size_t)bh4 * SEQ + t0, *MXg = ARP(float, A_MLM) + (size_t)bh4 * SEQ + t0;
    const size_t tok0 = (size_t)b * SEQ + t0;
    u32x4 rq[2], rc[9];
#pragma unroll
    for (int k = 0; k < 2; ++k) { const int idx = tid + 512 * k, r = idx >> 4, c8 = (idx & 15) * 8; rq[k] = *(const u32x4*)(QM + (tok0 + r) * 512 + h * 128 + c8); }
#pragma unroll
    for (int k = 0; k < 9; ++k) { const int idx = tid + 512 * k, e = idx >> 4, c8 = (idx & 15) * 8; rc[k] = (u32x4){0u, 0u, 0u, 0u}; if (e <= 256) rc[k] = *(const u32x4*)(KVT + (size_t)e * 128 + c8); }
    const float Mc = c ? MXg[-1] : 0.f;
    f32x4 cvv[2][8]; MoeTile mt = moe_tile_decode(C, MOE_CVT_BASE_G + (unit * 8 + w) * 2); if (side_cvt) moe_pair_load(mt, cvv, lane);
    __syncthreads();
#pragma unroll
    for (int k = 0; k < 2; ++k) { const int idx = tid + 512 * k, r = idx >> 4, c8 = (idx & 15) * 8; *(LAS u32x4*)(Qs + r * 136 + c8) = rq[k]; }
#pragma unroll
    for (int k = 0; k < 9; ++k) { const int idx = tid + 512 * k, e = idx >> 4, c8 = (idx & 15) * 8; if (e < MLE) *(LAS u32x4*)(CTs + e * 136 + c8) = rc[k]; }
    __syncthreads();
    const int tm = w >> 1, t = tm * 16 + (lane & 15), cq = 4 * (lane >> 4); const size_t tt = tok0 + t; const float scale = 0.08838834764831845f;
    const float wst = __expf(Mc - MXg[t]), mrow = IG[t] - AAg[t] + MXg[t];
    float inv;
    { const f32x4 a2 = lds_mma(Qs, 136, CTs, 136, tm, 16, 128, lane, (f32x4){0.f, 0.f, 0.f, 0.f}); const float di = bf2f(NUMI[(size_t)t * MLE + 256]);
      float den = (lane < 16) ? (di + a2[0] * wst) * scale : 0.f; den += xor16f(den); den += xor32f(den);
      inv = 1.f / fmaxf(fabsf(den), __expf(-mrow)); }
    for (int tn = (w & 1); tn < 16; tn += 2) { const f32x4 a2 = lds_mma(Qs, 136, CTs, 136, tm, tn, 128, lane, (f32x4){0.f, 0.f, 0.f, 0.f});
        const u32x2 ni = *(const u32x2*)(NUMI + (size_t)t * MLE + tn * 16 + cq); const u32x2 og = *(const u32x2*)(PAB + tt * AB_PAD + 2048 + h * 256 + tn * 16 + cq);
        const float n0 = (lo_bf(ni.x) + a2[0] * wst) * scale * inv, n1 = (hi_bf(ni.x) + a2[1] * wst) * scale * inv, n2 = (lo_bf(ni.y) + a2[2] * wst) * scale * inv, n3 = (hi_bf(ni.y) + a2[3] * wst) * scale * inv;
        u32x2 o; o.x = pk2(sigmoidf_(lo_bf(og.x)) * n0, sigmoidf_(hi_bf(og.x)) * n1); o.y = pk2(sigmoidf_(lo_bf(og.y)) * n2, sigmoidf_(hi_bf(og.y)) * n3);
        st8_f(YCAT + tt * DM + h * 256 + tn * 16 + cq, o); }
    if (side_cvt) moe_pair_store(mt, cvv, lane);
}

__device__ __forceinline__ void mlstm_unit(const Ctx& C, const Args& A, int unit) {
    const int bh = unit >> 3, dvs = unit & 7, b = bh >> 2, h = bh & 3, w = C.wave, lane = C.lane, tid = C.tid;
    LAS float* AA = (LAS float*)C.lds;
    LAS float* MX = AA + 4096;
    LAS bf16* Qs = (LAS bf16*)(MX + 4096);
    LAS bf16* Ks = Qs + 64 * 136;
    LAS bf16* KwT = Ks + 64 * 136;
    LAS bf16* Vt = KwT + 128 * 72;
    LAS bf16* Ps = Vt + 48 * 72;
    LAS bf16* CT = Ps + 64 * 72;
    LAS float* NUM = (LAS float*)(CT + 48 * 136);
    const float *IG = ARP(float, A_IG) + (size_t)bh * SEQ, *LFp = ARP(float, A_LF) + (size_t)bh * SEQ;
    const bf16 *QM = ARP(bf16, A_QM), *KM = ARP(bf16, A_KM), *PAB = ARP(bf16, A_PAB); bf16* YCAT = ARP(bf16, A_YCAT);
    __syncthreads();
    if (w == 0) { float carryF = 0.f, carryM = 0.f;
        for (int c = 0; c < 64; ++c) { const int p = c * 64 + lane; float f = LFp[p];
#pragma unroll
            for (int o = 1; o < 64; o <<= 1) { const float n = __shfl_up(f, o); if (lane >= o) f += n; }
            f += carryF; const float a = IG[p] - f; float m = a;
#pragma unroll
            for (int o = 1; o < 64; o <<= 1) { const float n = __shfl_up(m, o); if (lane >= o) m = fmaxf(m, n); }
            m = fmaxf(m, carryM); AA[p] = a; MX[p] = m; carryF = __shfl(f, 63); carryM = __shfl(m, 63); } }
    for (int i = tid; i < 48 * 72; i += NTHR) { const int r = i / 72; Vt[i] = (r == 32) ? (bf16)0x3f80 : (bf16)0; }
    for (int i = tid; i < 48 * 136; i += NTHR) CT[i] = 0;
    f32x4 accC[3];
#pragma unroll
    for (int k = 0; k < 3; ++k) accC[k] = (f32x4){0.f, 0.f, 0.f, 0.f};
    const size_t tok0 = (size_t)b * SEQ;
    u32x4 rq[2], rk[2], rv;
#define ML_LOAD(c) do { _Pragma("unroll") for (int k = 0; k < 2; ++k) { const int idx = tid + 512 * k, r = idx >> 4, c8 = (idx & 15) * 8; const size_t o = (tok0 + (c) * 64 + r) * 512 + h * 128 + c8; \
            rq[k] = *(const u32x4*)(QM + o); rk[k] = *(const u32x4*)(KM + o); } \
        if (tid < 256) rv = *(const u32x4*)(PAB + (tok0 + (c) * 64 + (tid >> 2)) * AB_PAD + 1024 + h * 256 + dvs * 32 + (tid & 3) * 8); } while (0)
    ML_LOAD(0);
    __syncthreads();
    const float scale = 0.08838834764831845f;
    for (int c = 0; c < 64; ++c) {
        const int t0 = c * 64; const float Mc = c ? MX[t0 - 1] : 0.f, Mc2 = MX[t0 + 63];
#pragma unroll
        for (int k = 0; k < 2; ++k) { const int idx = tid + 512 * k, r = idx >> 4, c8 = (idx & 15) * 8;
            *(LAS u32x4*)(Qs + r * 136 + c8) = rq[k]; *(LAS u32x4*)(Ks + r * 136 + c8) = rk[k];
            float kf[8]; unpack8(rk[k], kf); const float wk = __expf(AA[t0 + r] - Mc2);
#pragma unroll
            for (int j = 0; j < 8; ++j) KwT[(c8 + j) * 72 + r] = (bf16)f2bf(kf[j] * wk); }
        if (tid < 256) { const int r = tid >> 2, e8 = (tid & 3) * 8; const unsigned wv[4] = {rv.x, rv.y, rv.z, rv.w};
#pragma unroll
            for (int j = 0; j < 4; ++j) { Vt[(e8 + 2 * j) * 72 + r] = (bf16)(wv[j] & 0xffff); Vt[(e8 + 2 * j + 1) * 72 + r] = (bf16)(wv[j] >> 16); } }
        if (c + 1 < 64) ML_LOAD(c + 1);
        __syncthreads();
#pragma unroll
        for (int q = 0; q < 2; ++q) { const int tile = 2 * w + q, tm = tile >> 2, tn = tile & 3; const int t = tm * 16 + (lane & 15), l0 = tn * 16 + 4 * (lane >> 4);
            f32x4 s = (f32x4){0.f, 0.f, 0.f, 0.f};
            if (tn <= tm) s = lds_mma(Qs, 136, Ks, 136, tm, tn, 128, lane, s);
            const float mxt = MX[t0 + t]; float pvv[4];
#pragma unroll
            for (int j = 0; j < 4; ++j) { const int l = l0 + j; pvv[j] = (l <= t) ? s[j] * __expf(AA[t0 + l] - mxt) : 0.f; }
            u32x2 pw; pw.x = pk2(pvv[0], pvv[1]); pw.y = pk2(pvv[2], pvv[3]); *(LAS u32x2*)(Ps + t * 72 + l0) = pw; }
        __syncthreads();
        for (int tile = w; tile < 12; tile += 8) { const int tm = tile / 3, tn = tile % 3; const int t = tm * 16 + (lane & 15);
            f32x4 a1 = lds_mma(Ps, 72, Vt, 72, tm, tn, 64, lane, (f32x4){0.f, 0.f, 0.f, 0.f});
            f32x4 a2 = lds_mma(Qs, 136, CT, 136, tm, tn, 128, lane, (f32x4){0.f, 0.f, 0.f, 0.f});
            const float wst = __expf(Mc - MX[t0 + t]);
            *(LAS f32x4*)(NUM + t * 48 + tn * 16 + 4 * (lane >> 4)) = (a1 + a2 * wst) * scale; }
        __syncthreads();
        { const int t = tid >> 3, e4 = (tid & 7) * 4; const size_t tt = tok0 + t0 + t;
          const float den = NUM[t * 48 + 32], mrow = IG[t0 + t] - AA[t0 + t] + MX[t0 + t];
          const float inv = 1.f / fmaxf(fabsf(den), __expf(-mrow));
          const f32x4 nv = *(const LAS f32x4*)(NUM + t * 48 + e4);
          const u32x2 og = *(const u32x2*)(PAB + tt * AB_PAD + 2048 + h * 256 + dvs * 32 + e4);
          u32x2 o; o.x = pk2(sigmoidf_(lo_bf(og.x)) * nv[0] * inv, sigmoidf_(hi_bf(og.x)) * nv[1] * inv); o.y = pk2(sigmoidf_(lo_bf(og.y)) * nv[2] * inv, sigmoidf_(hi_bf(og.y)) * nv[3] * inv);
          *(u32x2*)(YCAT + tt * DM + h * 256 + dvs * 32 + e4) = o; }
        { const float decay = __expf(Mc - Mc2);
#pragma unroll
          for (int tm = 0; tm < 3; ++tm) { accC[tm] = lds_mma(Vt, 72, KwT, 72, tm, w, 64, lane, accC[tm] * decay);
              u32x2 cw; cw.x = pk2(accC[tm][0], accC[tm][1]); cw.y = pk2(accC[tm][2], accC[tm][3]);
              *(LAS u32x2*)(CT + (tm * 16 + (lane & 15)) * 136 + w * 16 + 4 * (lane >> 4)) = cw; } }
        __syncthreads();
    }
#undef ML_LOAD
}

__device__ __forceinline__ void phase_rowstat(const Ctx& C) {
    const bf16* XR = WSP(bf16, WS_XR); float* RS = WSP(float, WS_TAB + TAB_RSTD);
    for (int r = C.gw; r < T; r += C.ngw) { const u32x4* xr = (const u32x4*)(XR + (size_t)r * DM); float s = 0.f;
#pragma unroll
        for (int j = 0; j < 4; ++j) { float f[8]; unpack8(xr[j * 64 + C.lane], f);
#pragma unroll
            for (int q = 0; q < 8; ++q) s += f[q] * f[q]; }
        s = wave_sum(s); if (C.lane == 0) RS[r] = rsqrtf(s * (1.f / DM) + EPS); }
}
__device__ __forceinline__ void phase_softmax256(const Ctx& C) {
    const float* SC = ARP(float, A_SC); bf16* PC = ARP(bf16, A_PC);
    for (int it = C.gw; it < T * 4; it += C.ngw) { const size_t o = (size_t)it * 256 + C.lane * 4;
        const f32x4 v = *(const f32x4*)(SC + o); const float m = wave_max(fmaxf(fmaxf(v.x, v.y), fmaxf(v.z, v.w)));
        const float e0 = __expf(v.x - m), e1 = __expf(v.y - m), e2 = __expf(v.z - m), e3 = __expf(v.w - m);
        const float inv = 1.f / wave_sum(e0 + e1 + e2 + e3);
        u32x2 w; w.x = pk2(e0 * inv, e1 * inv); w.y = pk2(e2 * inv, e3 * inv); *(u32x2*)(PC + o) = w; }
}
constexpr int MOE_NB = 256, MOE_TPB = T / MOE_NB;
__device__ __forceinline__ void phase_route(const Ctx& C, const Args& A, int l) {
    const float* LG = ARP(float, A_XS); constexpr size_t PL = (size_t)T * 256;     int* EID = ARP(int, A_EID); float* WTS = ARP(float, A_WTS); int* LRANK = ARP(int, A_LRANK); int* BH = ARP(int, A_BHIST);
    const float *bg = INP(I_MOE_BG) + l * 8, *be = INP(I_MOE_BE) + l * 64;
    LAS int* hist = (LAS int*)(C.lds + LDS_AUX);
    for (int bk = C.bid; bk < MOE_NB; bk += C.G) {
        __syncthreads();
        if (C.tid < 64) hist[C.tid] = 0;
        __syncthreads();
        if (C.tid < MOE_TPB) { const int t = bk * MOE_TPB + C.tid; const float* L = LG + (size_t)t * 256;
            float lg[8], mx = -INFINITY; int grp = 0;
#pragma unroll
            for (int g = 0; g < 8; ++g) { lg[g] = ((L[g] + L[PL + g]) + (L[2 * PL + g] + L[3 * PL + g])) + bg[g]; if (lg[g] > mx) { mx = lg[g]; grp = g; } }
            float se = 0.f;
#pragma unroll
            for (int g = 0; g < 8; ++g) se += __expf(lg[g] - mx);
            const float pgrp = 1.f / se;
            float l1 = -INFINITY, l2 = -INFINITY; int i1 = 0, i2 = 0;
            for (int j = 0; j < 8; ++j) { const int x = 8 + grp * 8 + j; const float v = ((L[x] + L[PL + x]) + (L[2 * PL + x] + L[3 * PL + x])) + be[grp * 8 + j];
                if (v > l1) { l2 = l1; i2 = i1; l1 = v; i1 = j; } else if (v > l2) { l2 = v; i2 = j; } }
            const float w1 = 1.f / (1.f + __expf(l2 - l1)), w2 = 1.f - w1;
            const int e1 = grp * 8 + i1, e2 = grp * 8 + i2;
            EID[2 * t] = e1; EID[2 * t + 1] = e2; WTS[2 * t] = pgrp * w1; WTS[2 * t + 1] = pgrp * w2;
            LRANK[2 * t] = atomicAdd((int*)(hist + e1), 1); LRANK[2 * t + 1] = atomicAdd((int*)(hist + e2), 1); }
        __syncthreads();
        if (C.tid < 64) BH[bk * 64 + C.tid] = hist[C.tid];
    }
}
__device__ __forceinline__ void phase_gather(const Ctx& C, int l) {
    LAS int* tab = (LAS int*)(C.lds + LDS_AUX);
    const int* BH = ARP(int, A_BHIST); const int* EID = ARP(int, A_EID); const int* LRANK = ARP(int, A_LRANK); int* ROWSLOT = ARP(int, A_ROWSLOT); const bf16* XNp = WSP(bf16, WS_XR); bf16* XS = ARP(bf16, A_XS);
    unsigned* cnt = WSP(unsigned, WS_CTL) + CW_MOE_CNT + l * 64;
    for (int bk = C.bid; bk < MOE_NB; bk += C.G) {
        __syncthreads();
        if (C.tid < 64) { int tot = 0, before = 0;
            for (int q = 0; q < MOE_NB; ++q) { const int v = BH[q * 64 + C.tid]; tot += v; if (q < bk) before += v; }
            tab[C.tid] = tot; tab[64 + C.tid] = before; if (bk == 0) cnt[C.tid] = (unsigned)tot; }
        __syncthreads();
        if (C.tid == 0) { int off = 0; for (int e = 0; e < 64; ++e) { const int n = tab[e]; tab[e] = off; off += ((n + 255) >> 8) << 8; } }
        __syncthreads();
        if (C.tid < 2 * MOE_TPB) { const int a = bk * 2 * MOE_TPB + C.tid, e = EID[a], pos = tab[e] + tab[64 + e] + LRANK[a]; tab[128 + C.tid] = pos; ROWSLOT[pos] = a; }
        __syncthreads();
    }
}
__device__ __forceinline__ void phase_combine_norm(const Ctx& C, const float* gain, float* OUT) {
    bf16* XR = WSP(bf16, WS_XR); const bf16* YE = ARP(bf16, A_YE); float* RS = WSP(float, WS_RSQ) + (size_t)4 * T * 8; const int lane = C.lane;
    for (int t = C.gw; t < T; t += C.ngw) { bf16* xr = XR + (size_t)t * DM; const bf16* y0 = YE + (size_t)(2 * t) * DM; const bf16* y1 = y0 + DM;
        float v[4][8]; float s = 0.f; u32x4 rx[4], ra[4], rb[4];
#pragma unroll
        for (int j = 0; j < 4; ++j) { const int o = (j * 64 + lane) * 8; rx[j] = *(const u32x4*)(xr + o); ra[j] = *(const u32x4*)(y0 + o); rb[j] = *(const u32x4*)(y1 + o); }
#pragma unroll
        for (int j = 0; j < 4; ++j) { const int o = (j * 64 + lane) * 8; float a[8], b0[8]; unpack8(rx[j], v[j]); unpack8(ra[j], a); unpack8(rb[j], b0);
#pragma unroll
            for (int q = 0; q < 8; ++q) v[j][q] += a[q] + b0[q];
            if (!OUT) { const u32x4 w = pack8f(v[j]); *(u32x4*)(xr + o) = w; unpack8(w, v[j]); }
#pragma unroll
            for (int q = 0; q < 8; ++q) s += v[j][q] * v[j][q]; }
        const float ssq = wave_sum(s), rstd = rstd_of(ssq);
        if (!OUT) { if (lane < 8) RS[(size_t)t * 8 + lane] = (lane == 0) ? ssq : 0.f; }
        else {
#pragma unroll
            for (int j = 0; j < 4; ++j) { const int o = (j * 64 + lane) * 8; const f32x4 g0 = *(const f32x4*)(gain + o), g1 = *(const f32x4*)(gain + o + 4);
                *(f32x4*)(OUT + (size_t)t * DM + o) = (f32x4){v[j][0] * rstd * g0.x, v[j][1] * rstd * g0.y, v[j][2] * rstd * g0.z, v[j][3] * rstd * g0.w};
                *(f32x4*)(OUT + (size_t)t * DM + o + 4) = (f32x4){v[j][4] * rstd * g1.x, v[j][5] * rstd * g1.y, v[j][6] * rstd * g1.z, v[j][7] * rstd * g1.w}; } }
    }
}

__device__ __forceinline__ float gelu_tanh(float x) { return 0.5f * x * (1.f + tanhf(0.7978845608028654f * (x + 0.044715f * x * x * x))); }
__device__ __forceinline__ void phase_cmp_finish(const Ctx& C, const Args& A) {
    const float* CP = ARP(float, A_CPART); const float* bias = WSP(float, WS_TAB + TAB_CMPBIAS); const float* w2 = INP(I_CMP_W2);
    LAS float* hid = (LAS float*)C.lds + C.wave * 128; const int lane = C.lane;
    for (int it = C.gw; it < 2 * 16 * 256; it += C.ngw) { const int j = it & 255, bg = (it >> 8) & 15, kv = it >> 12;
        bf16* dst = ARP(bf16, kv ? A_VCMP : A_KCMP) + ((size_t)bg * 256 + j) * 128;
        bf16* dstT = ARP(bf16, A_VCT) + (size_t)bg * 128 * 256 + j;
        if (j == 255) { dst[lane] = 0; dst[lane + 64] = 0; if (kv) { dstT[(size_t)lane * 256] = 0; dstT[(size_t)(lane + 64) * 256] = 0; } continue; }
        float h0 = 0.f, h1 = 0.f;
#pragma unroll
        for (int part = 0; part < 8; ++part) { h0 += bias[part * 256 + kv * 128 + lane]; h1 += bias[part * 256 + kv * 128 + 64 + lane]; }
#pragma unroll
        for (int ks = 0; ks < 8; ++ks) { const float* p = CP + ((size_t)((ks * 2 + kv) * 16 + bg) * 256 + j) * 256; h0 += p[lane]; h1 += p[64 + lane]; }
        hid[lane] = gelu_tanh(h0); hid[64 + lane] = gelu_tanh(h1); LDS_WAIT(); asm volatile("" ::: "memory");
        float o0 = 0.f, o1 = 0.f; const float* W = w2 + (size_t)kv * 128 * 128;
        for (int e = 0; e < 128; ++e) { const float hv = hid[e]; o0 += hv * W[e * 128 + lane]; o1 += hv * W[e * 128 + 64 + lane]; }
        dst[lane] = (bf16)f2bf(o0); dst[lane + 64] = (bf16)f2bf(o1); if (kv) { dstT[(size_t)lane * 256] = (bf16)f2bf(o0); dstT[(size_t)(lane + 64) * 256] = (bf16)f2bf(o1); } LDS_WAIT(); asm volatile("" ::: "memory"); }
}
__device__ __forceinline__ void phase_cmp_attn(const Ctx& C) {
    const bf16 *Q = ARP(bf16, A_Q), *KC = ARP(bf16, A_KCMP), *VC = ARP(bf16, A_VCMP); const float* GATES = ARP(float, A_GATES);
    float* OACC = ARP(float, A_OACC); unsigned long long* SELM = ARP(unsigned long long, A_SELMASK);
    LAS float* qs = (LAS float*)C.lds + C.wave * 1536;
    LAS float* ps = qs + 512; const int lane = C.lane; const float scale = 0.08838834764831845f;
    for (int it = C.gw; it < T * 4; it += C.ngw) { const int t = it >> 2, g = it & 3, b = t >> 12, s = t & 4095;
        const int nvalid = (s >= 31) ? ((s - 31) >> 4) + 1 : 0;
#pragma unroll
        for (int r = 0; r < 4; ++r) { const bf16* qp = Q + (((size_t)(b * 16 + g * 4 + r)) * SEQ + s) * 128; qs[r * 128 + lane] = bf2f(qp[lane]); qs[r * 128 + 64 + lane] = bf2f(qp[64 + lane]); }
        LDS_WAIT(); asm volatile("" ::: "memory");
        float sc[4][4];
#pragma unroll
        for (int i = 0; i < 4; ++i) { const int j = lane + 64 * i;
#pragma unroll
            for (int r = 0; r < 4; ++r) sc[r][i] = 0.f;
            if (j < nvalid) { const bf16* kp = KC + ((size_t)(b * 4 + g) * 256 + j) * 128;
                for (int d8 = 0; d8 < 16; ++d8) { float kf[8]; unpack8(*(const u32x4*)(kp + d8 * 8), kf);
#pragma unroll
                    for (int r = 0; r < 4; ++r) { float a = 0.f;
#pragma unroll
                        for (int jj = 0; jj < 8; ++jj) a += qs[r * 128 + d8 * 8 + jj] * kf[jj];
                        sc[r][i] += a; } } } }
#pragma unroll
        for (int r = 0; r < 4; ++r) { float m = -INFINITY;
#pragma unroll
            for (int i = 0; i < 4; ++i) if (lane + 64 * i < nvalid) m = fmaxf(m, sc[r][i] * scale);
            m = wave_max(m); if (!(m > -INFINITY)) m = 0.f; float e[4], sum = 0.f;
#pragma unroll
            for (int i = 0; i < 4; ++i) { e[i] = (lane + 64 * i < nvalid) ? __expf(sc[r][i] * scale - m) : 0.f; sum += e[i]; }
            sum = wave_sum(sum); const float inv = sum > 0.f ? 1.f / sum : 1.f;
#pragma unroll
            for (int i = 0; i < 4; ++i) ps[r * 256 + lane + 64 * i] = e[i] * inv; }
        LDS_WAIT(); asm volatile("" ::: "memory");
        float o[4][2];
#pragma unroll
        for (int r = 0; r < 4; ++r) { o[r][0] = 0.f; o[r][1] = 0.f; }
        for (int j = 0; j < nvalid; ++j) { const bf16* vp = VC + ((size_t)(b * 4 + g) * 256 + j) * 128; const float v0 = bf2f(vp[lane]), v1 = bf2f(vp[64 + lane]);
#pragma unroll
            for (int r = 0; r < 4; ++r) { const float p = ps[r * 256 + j]; o[r][0] += p * v0; o[r][1] += p * v1; } }
#pragma unroll
        for (int r = 0; r < 4; ++r) { const float gt = GATES[(size_t)t * 48 + g * 4 + r]; float* op = OACC + (size_t)t * DM + (g * 4 + r) * 128; op[lane] = gt * o[r][0]; op[64 + lane] = gt * o[r][1]; }
        float imp = 0.f;
#pragma unroll
        for (int r = 0; r < 4; ++r) { const LAS float* p = ps + r * 256; const int j0 = 4 * lane;
            imp += (j0 > 0 ? 0.5f * p[j0 - 1] : 0.f) + p[j0] + p[j0 + 1] + p[j0 + 2] + 0.5f * p[j0 + 3]; }
        const int cur = s >> 6; float score;
        if (lane == 0 || lane == cur || lane == cur - 1) score = INFINITY; else score = (lane <= cur) ? imp : -INFINITY;
        int rank = 0;
        for (int o2 = 0; o2 < 64; ++o2) { const float so = __int_as_float(__builtin_amdgcn_readlane(__float_as_int(score), o2)); rank += (so > score || (so == score && o2 < lane)) ? 1 : 0; }
        const unsigned long long m = __ballot(rank < 16 && score > -INFINITY);
        if (lane == 0) SELM[(size_t)t * 4 + g] = m;
        LDS_WAIT(); asm volatile("" ::: "memory");
    }
}
struct NaiveAttnState { float m[4], l[4], o[4][2]; };
__device__ __forceinline__ void naive_tile(NaiveAttnState& S, const LAS float* qs, LAS float* pt, const bf16* Kt, const bf16* Vt_, int key0, bool valid, int lane) {
    float sc[4] = {0.f, 0.f, 0.f, 0.f}; const float scale = 0.08838834764831845f;
    if (valid) { const bf16* kp = Kt + (size_t)(key0 + lane) * 128;
        for (int d8 = 0; d8 < 16; ++d8) { float kf[8]; unpack8(*(const u32x4*)(kp + d8 * 8), kf);
#pragma unroll
            for (int r = 0; r < 4; ++r) { float a = 0.f;
#pragma unroll
                for (int jj = 0; jj < 8; ++jj) a += qs[r * 128 + d8 * 8 + jj] * kf[jj];
                sc[r] += a; } } }
    const unsigned long long vm = __ballot(valid);
    if (vm == 0ull) return;
#pragma unroll
    for (int r = 0; r < 4; ++r) { const float sv = valid ? sc[r] * scale : -INFINITY; const float mt = wave_max(sv), mn = fmaxf(S.m[r], mt);
        const float alpha = __expf(S.m[r] - mn), p = valid ? __expf(sv - mn) : 0.f;
        S.l[r] = S.l[r] * alpha + wave_sum(p); S.o[r][0] *= alpha; S.o[r][1] *= alpha; S.m[r] = mn; pt[r * 64 + lane] = p; }
    LDS_WAIT(); asm volatile("" ::: "memory");
    for (int k = 0; k < 64; ++k) { if (!((vm >> k) & 1ull)) continue; const bf16* vp = Vt_ + (size_t)(key0 + k) * 128; const float v0 = bf2f(vp[lane]), v1 = bf2f(vp[64 + lane]);
#pragma unroll
        for (int r = 0; r < 4; ++r) { const float p = pt[r * 64 + k]; S.o[r][0] += p * v0; S.o[r][1] += p * v1; } }
    LDS_WAIT(); asm volatile("" ::: "memory");
}
__device__ __forceinline__ void phase_selwin_naive(const Ctx& C, bf16* OCAT) {
    const bf16* QR = ARP(bf16, A_QROT); const float* GATES = ARP(float, A_GATES); const float* OACC = ARP(float, A_OACC);
    const unsigned long long* SELM = ARP(const unsigned long long, A_SELMASK);
    const bf16* KS = (const bf16*)(C.ws + WS_ARENA + A_KV6 + 2 * KV6_STRIDE); const bf16* VS = (const bf16*)(C.ws + WS_ARENA + A_KV6 + 3 * KV6_STRIDE);
    const bf16* KW = (const bf16*)(C.ws + WS_ARENA + A_KV6 + 4 * KV6_STRIDE); const bf16* VW = (const bf16*)(C.ws + WS_ARENA + A_KV6 + 5 * KV6_STRIDE);
    LAS float* qs = (LAS float*)C.lds + C.wave * 768; LAS float* pt = qs + 512; const int lane = C.lane;
    for (int it = C.gw; it < T * 4; it += C.ngw) { const int t = it >> 2, g = it & 3, b = t >> 12, s = t & 4095; const size_t slab = (size_t)(b * 4 + g) * SPAD * 128;
#pragma unroll
        for (int r = 0; r < 4; ++r) { const bf16* qp = QR + (((size_t)(b * 16 + g * 4 + r)) * SEQ + s) * 128; qs[r * 128 + lane] = bf2f(qp[lane]); qs[r * 128 + 64 + lane] = bf2f(qp[64 + lane]); }
        LDS_WAIT(); asm volatile("" ::: "memory");
        float res[4][2];
#pragma unroll
        for (int r = 0; r < 4; ++r) { res[r][0] = OACC[(size_t)t * DM + (g * 4 + r) * 128 + lane]; res[r][1] = OACC[(size_t)t * DM + (g * 4 + r) * 128 + 64 + lane]; }
        { NaiveAttnState S;
#pragma unroll
          for (int r = 0; r < 4; ++r) { S.m[r] = -1e30f; S.l[r] = 0.f; S.o[r][0] = 0.f; S.o[r][1] = 0.f; }
          const unsigned long long m = SELM[(size_t)t * 4 + g];
          for (int blk = 0; blk <= (s >> 6); ++blk) if ((m >> blk) & 1ull) naive_tile(S, qs, pt, KS + slab, VS + slab, blk * 64, blk * 64 + lane <= s, lane);
#pragma unroll
          for (int r = 0; r < 4; ++r) { const float gt = GATES[(size_t)t * 48 + 16 + g * 4 + r], inv = S.l[r] > 0.f ? 1.f / S.l[r] : 0.f; res[r][0] += gt * S.o[r][0] * inv; res[r][1] += gt * S.o[r][1] * inv; } }
        { NaiveAttnState S;
#pragma unroll
          for (int r = 0; r < 4; ++r) { S.m[r] = -1e30f; S.l[r] = 0.f; S.o[r][0] = 0.f; S.o[r][1] = 0.f; }
          const int lo = s - 511 > 0 ? s - 511 : 0;
          for (int k0 = lo & ~63; k0 <= s; k0 += 64) naive_tile(S, qs, pt, KW + slab, VW + slab, k0, (k0 + lane >= lo) && (k0 + lane <= s), lane);
#pragma unroll
          for (int r = 0; r < 4; ++r) { const float gt = GATES[(size_t)t * 48 + 32 + g * 4 + r], inv = S.l[r] > 0.f ? 1.f / S.l[r] : 0.f; res[r][0] += gt * S.o[r][0] * inv; res[r][1] += gt * S.o[r][1] * inv; } }
#pragma unroll
        for (int r = 0; r < 4; ++r) { bf16* op = OCAT + (size_t)t * DM + (g * 4 + r) * 128; op[lane] = (bf16)f2bf(res[r][0]); op[64 + lane] = (bf16)f2bf(res[r][1]); }
    }
}


__device__ __forceinline__ void phase_cmp_attn_mma(const Ctx& C, bool side_cvt) {
    const bf16 *Q = ARP(bf16, A_Q), *KC = ARP(bf16, A_KCMP), *VCT = ARP(bf16, A_VCT); const float* GATES = ARP(float, A_GATES);
    float* OACC = ARP(float, A_OACC); unsigned long long* SELM = ARP(unsigned long long, A_SELMASK);
    LAS bf16* Qs = (LAS bf16*)C.lds;
    LAS bf16* Ks = Qs + 128 * 136;
    LAS bf16* Pm = (LAS bf16*)C.lds;
    LAS bf16* Vt = Pm + 128 * 264;
    const int w = C.wave; const float scale = 0.08838834764831845f;
    for (int it = C.bid; it < 2048; it += C.G) { int tid = C.tid; asm volatile("" : "+v"(tid)); const int lane = tid & 63;     const int bg = it >> 7, tt = ((it / C.G) & 1) ? 127 - (it & 127) : (it & 127), b = bg >> 2, g = bg & 3, t0 = tt * 32;
        const int nv = t0 / 16 + 1 > 255 ? 255 : ((t0 + 31 >= 31) ? t0 / 16 + 1 : 0);
        const int nct = (nv + 15) >> 4, kmax = ((nv + 31) >> 5) << 5;
        f32x4 cvv[2][8]; MoeTile mt = moe_tile_decode(C, MOE_CVT_BASE_E + (it * 8 + w) * 2); if (side_cvt) moe_pair_load(mt, cvv, lane);
        __syncthreads();
#pragma unroll
        for (int k = 0; k < 4; ++k) { const int idx = tid + 512 * k, row = idx >> 4, c8 = (idx & 15) * 8, r = row >> 5, tl = row & 31;
            *(LAS u32x4*)(Qs + row * 136 + c8) = *(const u32x4*)(Q + (((size_t)(b * 16 + g * 4 + r)) * SEQ + t0 + tl) * 128 + c8); }
        { u32x4 tk[8];
#pragma unroll
          for (int k = 0; k < 8; ++k) { const int idx = tid + 512 * k, row = idx >> 4, c8 = (idx & 15) * 8; tk[k] = (u32x4){0u, 0u, 0u, 0u};
              if (row < nct * 16) tk[k] = *(const u32x4*)(KC + ((size_t)bg * 256 + row) * 128 + c8); }
#pragma unroll
          for (int k = 0; k < 8; ++k) { const int idx = tid + 512 * k, row = idx >> 4, c8 = (idx & 15) * 8; *(LAS u32x4*)(Ks + row * 136 + c8) = tk[k]; } }
        __syncthreads();
        f32x4 sacc[16];
        { bf16x8 qa[4];
#pragma unroll
          for (int k = 0; k < 4; ++k) qa[k] = *(const LAS bf16x8*)(Qs + (w * 16 + (lane & 15)) * 136 + (lane >> 4) * 8 + 32 * k);
#pragma unroll
          for (int ct = 0; ct < 16; ++ct) { sacc[ct] = (f32x4){0.f, 0.f, 0.f, 0.f};
              if (ct < nct) { const LAS bf16* bp = Ks + (ct * 16 + (lane & 15)) * 136 + (lane >> 4) * 8;
#pragma unroll
                  for (int k = 0; k < 4; ++k) sacc[ct] = __builtin_amdgcn_mfma_f32_16x16x32_bf16(*(const LAS bf16x8*)(bp + 32 * k), qa[k], sacc[ct], 0, 0, 0); } } }
        const int trow = t0 + (w & 1) * 16 + (lane & 15);
        const int nvr = (trow >= 31) ? ((trow - 31) >> 4) + 1 : 0;
        float m = -INFINITY;
#pragma unroll
        for (int ct = 0; ct < 16; ++ct)
#pragma unroll
            for (int j = 0; j < 4; ++j) { const int key = ct * 16 + 4 * (lane >> 4) + j; const float v = (key < nvr) ? sacc[ct][j] * scale : -INFINITY; sacc[ct][j] = v; m = fmaxf(m, v); }
        m = fmaxf(m, xor16f(m)); m = fmaxf(m, xor32f(m)); if (!(m > -INFINITY)) m = 0.f;
        float sum = 0.f;
#pragma unroll
        for (int ct = 0; ct < 16; ++ct)
#pragma unroll
            for (int j = 0; j < 4; ++j) { const float e = __expf(sacc[ct][j] - m); sacc[ct][j] = e; sum += e; }
        sum += xor16f(sum); sum += xor32f(sum);
        const float inv = sum > 0.f ? 1.f / sum : 1.f;
        __syncthreads();
#pragma unroll
        for (int ct = 0; ct < 16; ++ct) if (ct * 16 < kmax) { u32x2 pw; pw.x = pk2(sacc[ct][0] * inv, sacc[ct][1] * inv); pw.y = pk2(sacc[ct][2] * inv, sacc[ct][3] * inv);
            *(LAS u32x2*)(Pm + (w * 16 + (lane & 15)) * 264 + ct * 16 + 4 * (lane >> 4)) = pw; }
        { u32x4 tv[8];
#pragma unroll
          for (int k = 0; k < 8; ++k) { const int idx = tid + 512 * k, d = idx >> 5, j8 = (idx & 31) * 8; tv[k] = (u32x4){0u, 0u, 0u, 0u};
              if (j8 < kmax) tv[k] = *(const u32x4*)(VCT + ((size_t)bg * 128 + d) * 256 + j8); }
#pragma unroll
          for (int k = 0; k < 8; ++k) { const int idx = tid + 512 * k, d = idx >> 5, j8 = (idx & 31) * 8; *(LAS u32x4*)(Vt + d * 264 + j8) = tv[k]; } }
        __syncthreads();
        { const int r = w >> 1, tl = (w & 1) * 16 + (lane & 15), t = b * SEQ + t0 + tl, hh = g * 4 + r; const float gt = GATES[(size_t)t * 48 + hh];
          float* op = OACC + (size_t)t * DM + hh * 128 + 4 * (lane >> 4);
          bf16x8 pa[8];
#pragma unroll
          for (int k = 0; k < 8; ++k) { pa[k] = (bf16x8){0, 0, 0, 0, 0, 0, 0, 0}; if (k * 32 < kmax) pa[k] = *(const LAS bf16x8*)(Pm + (w * 16 + (lane & 15)) * 264 + (lane >> 4) * 8 + 32 * k); }
#pragma unroll
          for (int dt = 0; dt < 8; ++dt) { f32x4 o = (f32x4){0.f, 0.f, 0.f, 0.f}; const LAS bf16* bp = Vt + (dt * 16 + (lane & 15)) * 264 + (lane >> 4) * 8;
#pragma unroll
              for (int k = 0; k < 8; ++k) if (k * 32 < kmax) o = __builtin_amdgcn_mfma_f32_16x16x32_bf16(*(const LAS bf16x8*)(bp + 32 * k), pa[k], o, 0, 0, 0);
              *(f32x4*)(op + dt * 16) = o * gt; } }
        { float score[4]; const int cur = (t0 + w * 4) >> 6;
#pragma unroll
          for (int q = 0; q < 4; ++q) { const int tl = w * 4 + q; float imp = 0.f;
            if (kmax > 0) {
#pragma unroll
                for (int r = 0; r < 4; ++r) { const LAS bf16* p = Pm + (r * 32 + tl) * 264; const int j0 = 4 * lane;
                    if (j0 < kmax) { const u32x2 pw = *(const LAS u32x2*)(p + j0); imp += lo_bf(pw.x) + hi_bf(pw.x) + lo_bf(pw.y) + 0.5f * hi_bf(pw.y); if (j0 > 0) imp += 0.5f * bf2f(p[j0 - 1]); } } }
            if (lane == 0 || lane == cur || lane == cur - 1) score[q] = INFINITY; else score[q] = (lane <= cur) ? imp : -INFINITY; }
          int rank[4] = {0, 0, 0, 0};
          for (int o2 = 0; o2 <= cur; ++o2) {
#pragma unroll
              for (int q = 0; q < 4; ++q) { const float so = __int_as_float(__builtin_amdgcn_readlane(__float_as_int(score[q]), o2)); rank[q] += (so > score[q] || (so == score[q] && o2 < lane)) ? 1 : 0; } }
#pragma unroll
          for (int q = 0; q < 4; ++q) { const unsigned long long mk = __ballot(rank[q] < 16 && score[q] > -INFINITY);
              if (lane == 0) SELM[(size_t)(b * SEQ + t0 + w * 4 + q) * 4 + g] = mk; } }
        if (side_cvt) moe_pair_store(mt, cvv, lane);
    }
    __syncthreads();
}

namespace swa {
constexpr int D = 128, NW = 8, QBLK = 32, KVBLK = 64, QB = NW * QBLK;
constexpr int SHM_V = KVBLK * D * 2, SHM_K = KVBLK * D * 2;
constexpr int LDS_BYTES = 2 * SHM_V + 2 * SHM_K + NW * 64 * 4;
constexpr float SCALE = 0.08838834764831845f, THR = 8.f;
typedef short s16x4 __attribute__((ext_vector_type(4)));
typedef float f32x16 __attribute__((ext_vector_type(16)));
#define KSWZ(row, colB) ((row) * 256 + ((colB) ^ (((row) & 7) << 4)))
#define SBAR() __builtin_amdgcn_sched_barrier(0)
__device__ __forceinline__ int v_st(int k, int c) { const int kk = (k & ~0xC) | ((k & 4) << 1) | ((k & 8) >> 1); return ((kk >> 3) * 4 + (c >> 5)) * 512 + ((kk & 7) * 32 + (c & 31)) * 2; }
__device__ __forceinline__ int v_rd_base(int lane) { return ((lane & 3) << 3) | (((lane >> 2) & 3) << 6) | (((lane >> 4) & 1) << 5) | (((lane >> 5) & 1) << 8); }
constexpr int v_rd_off(int d0, int ks, int half) { return d0 * 512 + ks * 4096 + half * 2048; }
__device__ __forceinline__ int crow(int r, int hi) { return (r & 3) + 8 * (r >> 2) + 4 * hi; }
__device__ __forceinline__ unsigned cvtpk(float lo, float hi) { unsigned r; asm volatile("v_cvt_pk_bf16_f32 %0, %1, %2" : "=v"(r) : "v"(lo), "v"(hi)); return r; }
__device__ __forceinline__ bf16x8 load8(const bf16* p) { return *reinterpret_cast<const bf16x8*>(p); }
__device__ __forceinline__ void mask_tile(f32x16& p0, f32x16& p1, int dq, unsigned W) {
    const float NEG = -__builtin_inff();
    asm volatile("" : "+v"(dq));
#pragma unroll
    for (int r = 0; r < 16; ++r) { const int c = (r & 3) + 8 * (r >> 2);
        if ((unsigned)(dq - c) >= W) p0[r] = NEG;
        if ((unsigned)(dq - c - 32) >= W) p1[r] = NEG; }
}
__device__ __forceinline__ void mask_all(f32x16& p0, f32x16& p1, bool on) {
    const float NEG = -__builtin_inff();
#pragma unroll
    for (int r = 0; r < 16; ++r) { p0[r] = on ? p0[r] : NEG; p1[r] = on ? p1[r] : NEG; }
}
__device__ __forceinline__ void partialSM(f32x16& p0, f32x16& p1, float& m_reg, float& mn, float& alpha) {
    float pmax = p0[0]; for (int r = 1; r < 16; ++r) pmax = fmaxf(pmax, p0[r]); for (int r = 0; r < 16; ++r) pmax = fmaxf(pmax, p1[r]);
    { auto rr = __builtin_amdgcn_permlane32_swap(__float_as_uint(pmax), __float_as_uint(pmax), false, false);
      pmax = fmaxf(__uint_as_float(rr[0]), __uint_as_float(rr[1])); }
    constexpr float C2 = 1.4426950408889634f * SCALE;
    if (__builtin_expect(__all((pmax - m_reg) * SCALE <= THR), 1)) { mn = m_reg; alpha = 1.f; }
    else { mn = fmaxf(m_reg, pmax); alpha = __builtin_amdgcn_exp2f((m_reg - mn) * C2); m_reg = mn; }
    const float mnL = -mn * C2;
    for (int r = 0; r < 16; ++r) p0[r] = fmaf(p0[r], C2, mnL); for (int r = 0; r < 16; ++r) p1[r] = fmaf(p1[r], C2, mnL);
    for (int r = 0; r < 16; ++r) p0[r] = __builtin_amdgcn_exp2f(p0[r]);
}
__device__ __forceinline__ void finishSM(f32x16& p0, f32x16& p1, float alpha, float& l_reg, bf16x8& pa0, bf16x8& pa1, bf16x8& pa2, bf16x8& pa3) {
    for (int r = 0; r < 16; ++r) p1[r] = __builtin_amdgcn_exp2f(p1[r]);
    float ps = 0; for (int r = 0; r < 16; ++r) ps += p0[r]; for (int r = 0; r < 16; ++r) ps += p1[r];
    { auto rr = __builtin_amdgcn_permlane32_swap(__float_as_uint(ps), __float_as_uint(ps), false, false);
      ps = __uint_as_float(rr[0]) + __uint_as_float(rr[1]); }
    l_reg = l_reg * alpha + ps;
#define PK4(P, B_, OUT) do { unsigned a0 = cvtpk(P[B_+0], P[B_+1]), a1 = cvtpk(P[B_+2], P[B_+3]);                          \
        unsigned b0 = cvtpk(P[B_+4], P[B_+5]), b1 = cvtpk(P[B_+6], P[B_+7]);                                             \
        auto r0 = __builtin_amdgcn_permlane32_swap(a0, b0, false, false); auto r1 = __builtin_amdgcn_permlane32_swap(a1, b1, false, false); \
        u32x4 w = {r0[0], r1[0], r0[1], r1[1]}; OUT = *reinterpret_cast<bf16x8*>(&w); } while (0)
    PK4(p0, 0, pa0); PK4(p0, 8, pa1); PK4(p1, 0, pa2); PK4(p1, 8, pa3);
#undef PK4
}
template <int KB>
__device__ __forceinline__ void qkt(f32x16& p0, f32x16& p1, const char* K_lds, int r32, int hi, const bf16x8* qr) {
    p0 = f32x16{}; p1 = f32x16{};
    const char* kb[4];
#pragma unroll
    for (int dd = 0; dd < 4; ++dd) kb[dd] = K_lds + KB * SHM_K + KSWZ(r32, (dd * 16 + hi * 8) * 2);
#pragma unroll
    for (int d0 = 0; d0 < 8; ++d0) { const char* a = kb[d0 & 3] + (d0 >> 2) * 128;
        bf16x8 b0 = *reinterpret_cast<const bf16x8*>(a);
        bf16x8 b1 = *reinterpret_cast<const bf16x8*>(a + 32 * 256);
        p0 = __builtin_amdgcn_mfma_f32_32x32x16_bf16(b0, qr[d0], p0, 0, 0, 0);
        p1 = __builtin_amdgcn_mfma_f32_32x32x16_bf16(b1, qr[d0], p1, 0, 0, 0); }
}
template <int VB>
__device__ __forceinline__ void pv_tile(f32x16* o, int vb0, bf16x8 pa0, bf16x8 pa1, bf16x8 pa2, bf16x8 pa3) {
#define TRRD(dst, off) asm volatile("ds_read_b64_tr_b16 %0, %1 offset:%2" : "=&v"(dst) : "v"(vb0), "i"(off) : "memory")
#define PV_D0(d0) do { s16x4 l0, l1, l2, l3, h0, h1, h2, h3; constexpr int b_ = VB * SHM_V + v_rd_off(d0, 0, 0);   \
        TRRD(l0, b_); TRRD(h0, b_ + 2048); TRRD(l1, b_ + 4096); TRRD(h1, b_ + 6144); TRRD(l2, b_ + 8192); TRRD(h2, b_ + 10240); TRRD(l3, b_ + 12288); TRRD(h3, b_ + 14336); \
        asm volatile("s_waitcnt lgkmcnt(0)" ::: "memory"); SBAR();   \
        o[d0] = __builtin_amdgcn_mfma_f32_32x32x16_bf16(pa0, (bf16x8){l0[0], l0[1], l0[2], l0[3], h0[0], h0[1], h0[2], h0[3]}, o[d0], 0, 0, 0);   \
        o[d0] = __builtin_amdgcn_mfma_f32_32x32x16_bf16(pa1, (bf16x8){l1[0], l1[1], l1[2], l1[3], h1[0], h1[1], h1[2], h1[3]}, o[d0], 0, 0, 0);   \
        o[d0] = __builtin_amdgcn_mfma_f32_32x32x16_bf16(pa2, (bf16x8){l2[0], l2[1], l2[2], l2[3], h2[0], h2[1], h2[2], h2[3]}, o[d0], 0, 0, 0);   \
        o[d0] = __builtin_amdgcn_mfma_f32_32x32x16_bf16(pa3, (bf16x8){l3[0], l3[1], l3[2], l3[3], h3[0], h3[1], h3[2], h3[3]}, o[d0], 0, 0, 0); } while (0)
    PV_D0(0); PV_D0(1); PV_D0(2); PV_D0(3);
#undef PV_D0
#undef TRRD
}
struct BlockRef { const bf16* Q; const bf16* K; const bf16* V; int P0, tok0, hh; };
struct Seam { bf16x8 qr[8]; bf16x8 st_v0, st_v1, st_k0, st_k1; };
__device__ __forceinline__ int swa_jlo(int P0, int W) { const int lowk = P0 - W + 1; return lowk > 0 ? lowk / KVBLK : 0; }
#define ROW(p, k0, rr) ((p) + (size_t)((k0) + (rr)) * D + sc)
#define VMW() asm volatile("s_waitcnt vmcnt(0)" ::: "memory")
#define VMWN(n) asm volatile("s_waitcnt vmcnt(%0)" :: "i"(n) : "memory")
#define SLOAD_H(Kp, Vp, k0) do { S.st_v0 = load8(ROW(Vp, k0, sr)); S.st_v1 = load8(ROW(Vp, k0, 32 + sr));              \
                         S.st_k0 = load8(ROW(Kp, k0, sr)); S.st_k1 = load8(ROW(Kp, k0, 32 + sr)); } while (0)
#define SWRITE_HK(bf) do { *(bf16x8*)(K_lds + (bf) * SHM_K + kws) = S.st_k0; *(bf16x8*)(K_lds + (bf) * SHM_K + kws + 32 * 256) = S.st_k1; } while (0)
#define SWRITE_HV(bf) do { *(bf16x8*)(V_lds + (bf) * SHM_V + vst0) = S.st_v0; *(bf16x8*)(V_lds + (bf) * SHM_V + vst1) = S.st_v1; } while (0)
#define SWRITE_H(bf) do { SWRITE_HV(bf); SWRITE_HK(bf); } while (0)
__device__ __forceinline__ int lane_id() { return (int)__builtin_amdgcn_mbcnt_hi(~0u, __builtin_amdgcn_mbcnt_lo(~0u, 0u)); }
__device__ __forceinline__ void prime(const BlockRef& cur, int W, char* lds, Seam& S, int wid) {
    (void)wid; const int tid = threadIdx.x, lane = tid & 63, r32 = lane & 31, hi = lane >> 5;
    const int sr = tid >> 4, sc = (tid & 15) * 8, kws = KSWZ(sr, sc * 2); char* K_lds = lds + 2 * SHM_V;
    const int kb0 = swa_jlo(cur.P0, W) * KVBLK;
    for (int d0 = 0; d0 < 8; ++d0) S.qr[d0] = load8(cur.Q + (size_t)(wid * QBLK + r32) * D + d0 * 16 + hi * 8);
    SLOAD_H(cur.K, cur.V, kb0); VMW(); SWRITE_HK(0);
    __syncthreads();
}
template <bool SEL, int MODE>
__device__ __forceinline__ void block(const BlockRef& cur, const BlockRef& nxt, int skv, int W, char* lds, Seam& S,
                                      const unsigned long long* SELM, const float* GATES, int gate_off, float* OACC, bf16* OCAT, int wid) {
    (void)wid; const int tid = threadIdx.x, lane = tid & 63, r32 = lane & 31, hi = lane >> 5;
    const int j_lo = swa_jlo(cur.P0, W);
    int j_hi = (cur.P0 + QB - 1) / KVBLK + 1; if (j_hi > skv / KVBLK) j_hi = skv / KVBLK;
    const int NT = j_hi - j_lo;
    const int kbn = swa_jlo(nxt.P0, W) * KVBLK;
    const int qlo = cur.P0 + wid * QBLK, qm = qlo + r32 - 4 * hi;
    char* V_lds = lds; char* K_lds = lds + 2 * SHM_V;
    float* ws = (float*)(lds + 2 * SHM_V + 2 * SHM_K) + wid * 64; float* li_l = ws, * al_l = ws + 32;
    float m_reg = -1e30f, l_reg = 0; f32x16 o[4] = {};
    const int sr = tid >> 4, sc = (tid & 15) * 8, vst0 = v_st(sr, sc), vst1 = vst0 + 8192  , kws = KSWZ(sr, sc * 2);
    const int vb0 = (int)(uintptr_t)V_lds + v_rd_base(lane);
    const bf16* Kh = cur.K; const bf16* Vh = cur.V;
    unsigned long long* selt = (unsigned long long*)(lds + LDS_BYTES) + wid * 32;
    if (SEL) { if (hi == 0) selt[r32] = SELM[(size_t)(cur.tok0 + wid * QBLK + r32) * 4 + (cur.hh >> 2)]; }
#define RESC(a) do { if (__any((a) < 1.f)) { if (hi == 0) al_l[r32] = (a); asm volatile("s_waitcnt lgkmcnt(0)" ::: "memory");              \
                     for (int d_ = 0; d_ < 4; ++d_) for (int r = 0; r < 16; ++r) o[d_][r] *= al_l[crow(r, hi)]; } } while (0)
#define KBASE(t) ((j_lo + (t)) * KVBLK)
#define MASKT(P0_, P1_, t) do { const int kb_ = KBASE(t); if (kb_ + KVBLK - 1 > qlo || kb_ <= qlo + QBLK - 1 - W) mask_tile(P0_, P1_, qm - kb_, (unsigned)W); \
                                if (SEL) { const unsigned long long sm_ = selt[r32]; mask_all(P0_, P1_, ((sm_ >> (j_lo + (t))) & 1ull) != 0ull); } } while (0)
    constexpr int NQL = 8;
#define SEAM_K0() do { VMWN(NQL); SWRITE_HK(0); SBAR(); } while (0)
    f32x16 pA0, pA1, pB0, pB1; float mnA, mnB, alA, alB; bf16x8 pa0, pa1, pa2, pa3;
    SWRITE_HV(0); SBAR();
    if (NT > 1) { SLOAD_H(Kh, Vh, KBASE(1)); }
    SBAR(); qkt<0>(pA0, pA1, K_lds, r32, hi, S.qr);
    MASKT(pA0, pA1, 0); partialSM(pA0, pA1, m_reg, mnA, alA);
    if (NT > 1) { VMW(); SWRITE_H(1); }
    __syncthreads();
#define HALF_STEP(PX0, PX1, mnX, alX, PY0, PY1, alY, t, KB, VB, SB) do {                                                      \
        SBAR(); qkt<KB>(PX0, PX1, K_lds, r32, hi, S.qr);                                             \
        finishSM(PY0, PY1, alY, l_reg, pa0, pa1, pa2, pa3); SBAR();                                                           \
        if ((t) + 1 < NT) { SLOAD_H(Kh, Vh, KBASE((t) + 1)); SBAR(); }                                               \
        pv_tile<VB>(o, vb0, pa0, pa1, pa2, pa3); MASKT(PX0, PX1, (t)); partialSM(PX0, PX1, m_reg, mnX, alX);                                        \
        __syncthreads();                                                                                                      \
        if ((t) + 1 < NT) { VMW(); SWRITE_H(SB); }                                                                          \
        RESC(alX); __syncthreads(); } while (0)
    for (int t = 1; t + 1 < NT; t += 2) {
        HALF_STEP(pB0, pB1, mnB, alB, pA0, pA1, alA, t, 1, 0, 0);
        HALF_STEP(pA0, pA1, mnA, alA, pB0, pB1, alB, t + 1, 0, 1, 1);
    }
    const bool even = (NT & 1) == 0;
    if (even) { SBAR(); qkt<1>(pB0, pB1, K_lds, r32, hi, S.qr); SBAR(); }
    SLOAD_H(nxt.K, nxt.V, kbn); SBAR();
#pragma unroll
    for (int d0 = 0; d0 < 8; ++d0) S.qr[d0] = load8(nxt.Q + (size_t)(wid * QBLK + r32) * D + d0 * 16 + hi * 8);
    SBAR();
    finishSM(pA0, pA1, alA, l_reg, pa0, pa1, pa2, pa3); SBAR();
    pv_tile<0>(o, vb0, pa0, pa1, pa2, pa3);
    if (even) { MASKT(pB0, pB1, NT - 1); partialSM(pB0, pB1, m_reg, mnB, alB); __syncthreads(); RESC(alB);
        finishSM(pB0, pB1, alB, l_reg, pa0, pa1, pa2, pa3); SBAR(); pv_tile<1>(o, vb0, pa0, pa1, pa2, pa3); }
    SBAR(); SEAM_K0();
    if (hi == 0) li_l[r32] = l_reg; asm volatile("s_waitcnt lgkmcnt(0)" ::: "memory");
    { const int le = lane_id(), r32e = le & 31, hie = le >> 5;
      const int tokw = cur.tok0 + wid * QBLK; const float* gp = GATES + (size_t)tokw * 48 + gate_off + cur.hh;
      float* op = OACC + (size_t)tokw * DM + cur.hh * 128; bf16* cp = OCAT + (size_t)tokw * DM + cur.hh * 128;
#pragma unroll
      for (int r = 0; r < 16; ++r) { const int orow = crow(r, hie);
        const float sc_ = gp[orow * 48] * __builtin_amdgcn_rcpf(li_l[orow]);
        const unsigned ob = (unsigned)(orow * DM + r32e);
#pragma unroll
        for (int d0 = 0; d0 < 4; ++d0) { const float v = op[ob + d0 * 32] + o[d0][r] * sc_;
            if (MODE == 0) ((unsigned*)op)[ob + d0 * 32] = __float_as_uint(v);
            else cp[ob + d0 * 32] = (bf16)(cvtpk(v, v) & 0xffffu); } } }
    __syncthreads();
#undef RESC
#undef KBASE
#undef MASKT
#undef SEAM_K0
#undef HALF_STEP
}
#undef ROW
#undef VMW
#undef VMWN
#undef SLOAD_H
#undef SWRITE_HK
#undef SWRITE_HV
#undef SWRITE_H
__device__ __forceinline__ int swa_nramp(int nqb, int W) { const int t = W - 1; const int n = t < 0 ? 0 : t / QB + 1; return n > nqb ? nqb : n; }
struct SwaItem { int bh, qb0, qb1; };
__device__ __forceinline__ SwaItem swa_decode(int L, int nqb, int nx, int nramp) {
    SwaItem it; it.bh = L / nx; const int x = L - it.bh * nx; const int ns = nqb - nramp;
    if (x < ns) { it.qb0 = it.qb1 = nqb - 1 - x; } else { it.qb0 = x - ns; it.qb1 = nramp - 1 - it.qb0; }
    return it;
}
template <bool SEL, int MODE>
__device__ __forceinline__ void phase(int wid, char* lds, const bf16* Q, const bf16* K, const bf16* V, int W, const unsigned long long* SELM, const float* GATES, int gate_off, float* OACC, bf16* OCAT) {
    constexpr int nqb = SEQ / QB;
    const int nramp = swa_nramp(nqb, W), nx = (nramp + 1) / 2 + (nqb - nramp), total = nx * BATCH * 16, stride = gridDim.x;
    int L = blockIdx.x; if (L >= total) return;
    auto mkref = [&](const SwaItem& it, int pass) { const int qb = pass ? it.qb1 : it.qb0, b = it.bh >> 4, hh = it.bh & 15; BlockRef r;
        r.Q = Q + ((size_t)it.bh * SEQ + (size_t)qb * QB) * D; r.K = K + (size_t)(b * 4 + (hh >> 2)) * SPAD * D; r.V = V + (size_t)(b * 4 + (hh >> 2)) * SPAD * D;
        r.P0 = qb * QB; r.tok0 = b * SEQ + qb * QB; r.hh = hh; return r; };
    SwaItem it = swa_decode(L, nqb, nx, nramp); int pass = 0;
    BlockRef cur = mkref(it, 0);
    Seam S;
    __syncthreads();
    prime(cur, W, lds, S, wid);
    for (;;) {
        const bool more_pass = pass == 0 && it.qb1 != it.qb0, more_item = L + stride < total, last = !more_pass && !more_item;
        SwaItem itn = it; int passn = pass + 1, Ln = L;
        if (!more_pass) { passn = 0; Ln = more_item ? L + stride : L; itn = swa_decode(Ln, nqb, nx, nramp); }
        const BlockRef nxt = last ? cur : mkref(itn, passn);
        block<SEL, MODE>(cur, nxt, SEQ, W, lds, S, SELM, GATES, gate_off, OACC, OCAT, wid);
        if (last) break;
        cur = nxt; it = itn; pass = passn; L = Ln;
    }
}
#undef KSWZ
#undef SBAR
}

#ifndef REPEAT_PHASE
#define REPEAT_PHASE -1
#endif
#ifndef PROBE_LO
#define PROBE_LO 22
#define PROBE_HI 22
#define PROBE_SCALE 0.1f
#endif
#ifndef PROBE
#define PROBE 0
#endif
__device__ __forceinline__ void probe_compare(const Ctx& C, const bf16* Xa, const bf16* Xb, size_t n) {
    float se = 0.f, sr = 0.f;
    for (size_t i = (size_t)C.bid * NTHR + C.tid; i < n; i += (size_t)C.G * NTHR) { const float a = bf2f(Xa[i]), b = bf2f(Xb[i]); se += (a - b) * (a - b); sr += b * b; }
    se = wave_sum(se); sr = wave_sum(sr);
    if (C.lane == 0) { atomicAdd(WSP(float, WS_CTL) + CW_PROBE, se); atomicAdd(WSP(float, WS_CTL) + CW_PROBE + 1, sr); }
}
#ifndef MK_SPLIT
#define MK_SPLIT 0
#endif
constexpr int N_PHASES = 39;
#define COMMON_PHASES(l, pb) \
      \
      \
    if (IN(pb + 1)) { FRESH_TID(); pg8::Gemm g{WSP(bf16, WS_XR), WSP(bf16, WS_WKT) + (size_t)l * 4 * 1024 * DM, DM, DM, DM}; \
                      CrossOrder S{4, G, c, 1024, (long long)256 * DM * 2, (long long)256 * DM * 2, (long long)1024 * DM * 2}; EpiSoftmaxP E{ARP(bf16, A_PC), 1024, WSP(float, WS_RSQ) + (size_t)(2 * l) * T * 8, (LAS float*)(C.lds + LDS_AUX)}; pg8::gemm_phase(L, g, S, E, C.tid); } SEAM(pb + 1); \
      \
    if (IN(pb + 3)) { FRESH_TID(); pg8::Gemm g{ARP(bf16, A_PC), WSP(bf16, WS_VWT) + (size_t)l * 4 * DM * 1024, 1024, 1024, 1024}; \
                      CrossOrder S{8, G, c, DM, (long long)256 * 1024 * 2, (long long)256 * 1024 * 2, (long long)DM * 1024 * 2}; EpiResidT<false> E{WSP(bf16, WS_XR), WSP(bf16, WS_XR), DM, WSP(float, WS_RSQ) + (size_t)(2 * l + 1) * T * 8, (LAS float*)(C.lds + LDS_AUX)}; pg8::gemm_phase(L, g, S, E, C.tid); } SEAM(pb + 3); \
      \
      \
    if (IN(pb + 5)) { FRESH_TID(); pg8::Gemm g{WSP(bf16, WS_XR), WSP(bf16, WS_W_ROUTER) + (size_t)l * 256 * DM, DM, DM, 512}; RouterOrder S{G, c}; EpiStoreF32Rows E{ARP(float, A_XS), 256, WSP(float, WS_RSQ) + (size_t)(2 * l + 1) * T * 8};     pg8::gemm_phase(L, g, S, E, C.tid); } SEAM(pb + 5); \
    if (IN(pb + 6)) { FRESH_TID(); phase_route(C, A, l); } SEAM(pb + 6); \
    if (IN(pb + 7)) { FRESH_TID(); phase_gather(C, l); } SEAM(pb + 7); \
    if (IN(pb + 8)) { FRESH_TID(); const bool side_ = (l == 0) && (G == 256) && MOE_CVT_SIDE_H > 0; const int Gm_ = side_ ? G - MOE_CVT_WG : G; \
                      if (side_ && c >= Gm_) moe_convert_items_x2(C, MOE_CVT_BASE_H, MOE_CVT_BASE_H + MOE_CVT_SIDE_H, (c - Gm_) * NWAVES + C.wave, MOE_CVT_WG * NWAVES); else { \
                      LAS int* tab = (LAS int*)(C.lds + LDS_AUX); moe_build_table(C, ctl + CW_MOE_CNT + l * 64, tab); \
                      pg8::Gemm g{WSP(bf16, WS_XR), WSP(bf16, WS_W_GU) + (size_t)l * NEXP * 1024 * DM, DM, DM, DM}; MoeOrder S{tab, 4, Gm_, c, 0}; EpiHid E{ARP(bf16, A_HID), ARP(int, A_ROWSLOT), WSP(float, WS_RSQ) + (size_t)(2 * l + 1) * T * 8}; \
                      LAS int* rc = tab + 256; { pg8::Unit u_; const int* rs_ = ARP(int, A_ROWSLOT); for (int i_ = 0; i_ < 12 && S.next(i_, u_); ++i_) if (C.tid < 256) rc[i_ * 256 + C.tid] = (C.tid < u_.pm) ? (rs_[u_.aux + C.tid] >> 1) : 0; } __syncthreads(); \
                      pg8::gemm_phase<EpiHid, MoeOrder, true>(L, g, S, E, C.tid, rc); } } SEAM(pb + 8); \
    if (IN(pb + 9)) { FRESH_TID(); const bool side_ = (l == 0) && (G == 256) && MOE_CVT_SIDE_H2 > 0; const int Gm_ = side_ ? G - MOE_CVT_WG : G; \
                      if (side_ && c >= Gm_) moe_convert_items_x2(C, MOE_CVT_BASE_H2, MOE_CVT_BASE_H2 + MOE_CVT_SIDE_H2, (c - Gm_) * NWAVES + C.wave, MOE_CVT_WG * NWAVES); else { \
                      LAS int* tab = (LAS int*)(C.lds + LDS_AUX); moe_build_table(C, ctl + CW_MOE_CNT + l * 64, tab); \
                      pg8::Gemm g{ARP(bf16, A_HID), WSP(bf16, WS_W_DN) + (size_t)l * NEXP * DM * FF, FF, FF, FF}; MoeOrder S{tab, 8, Gm_, c, 1}; EpiMoeDown E{ARP(int, A_ROWSLOT), ARP(float, A_WTS), ARP(bf16, A_YE)}; pg8::gemm_phase(L, g, S, E, C.tid); } } SEAM(pb + 9); \
    if (IN(pb + 10)) { FRESH_TID(); if (l == 0) phase_combine_norm(C, nullptr, nullptr); else phase_combine_norm(C, INP(I_NORM_FINAL), ((float*)INP(N_INPUTS))); } \
    if (l == 0) SEAM(pb + 10);

__global__ void __launch_bounds__(NTHR, 2) mk_fwd(Args args) {
    extern __shared__ __attribute__((aligned(16))) unsigned char lds_raw[];
    Ctx C; C.lds = (LAS unsigned char*)lds_raw; C.tid = threadIdx.x; C.lane = C.tid & 63; C.wave = __builtin_amdgcn_readfirstlane(C.tid >> 6);
    C.G = gridDim.x; C.bid = blockIdx.x; C.gw = C.bid * NWAVES + C.wave; C.ngw = C.G * NWAVES; C.ws = args.ws;
    const Args& A = args; (void)A;
    volatile LAS unsigned* MISC = (volatile LAS unsigned*)(C.lds + LDS_MISC);
    if (C.tid < 64) MISC[C.tid] = 0u;
    if (C.tid <= N_INPUTS) ((LAS unsigned long long*)(C.lds + LDS_PTAB))[C.tid] = (C.tid < N_INPUTS) ? (unsigned long long)args.in[C.tid < N_INPUTS ? C.tid : 0] : (unsigned long long)args.out;
    __syncthreads();
    unsigned* ctl = WSP(unsigned, WS_CTL);
    const int lo = args.ph_lo, hi = args.ph_hi;
    XcdBarrier bar; bar.bar = ctl + CW_BAR; bar.x = 0; bar.st = MISC + 8;
    if (hi - lo > 1) bar = xcd_barrier_post(ctl + CW_BAR, MISC + 8);
#ifndef ONLY_PHASE
#define ONLY_PHASE -1
#endif
#define FRESH_TID() do { int t_ = threadIdx.x; asm volatile("" : "+v"(t_)); C.tid = t_; C.lane = t_ & 63; } while (0)
#define IN(k) ((ONLY_PHASE < 0 || ONLY_PHASE == (k)) && lo <= (k) && (k) < hi)
#if PROBE == 2
    unsigned long long tA_ = 0, tB_ = 0;
    if (PROBE_LO == 0) tA_ = __builtin_amdgcn_s_memrealtime();
#define SEAM(k) do { if (IN(k) && IN((k) + 1)) xcd_barrier(bar); if ((k) == PROBE_LO - 1) tA_ = __builtin_amdgcn_s_memrealtime(); if ((k) == PROBE_HI) tB_ = __builtin_amdgcn_s_memrealtime(); } while (0)
#else
#define SEAM(k) do { if (IN(k) && IN((k) + 1)) xcd_barrier(bar); } while (0)
#endif
    LAS unsigned char* L = C.lds;
    const int c = C.bid, G = C.G;

    if (IN(0)) { FRESH_TID(); for (int rep = 0; rep < (REPEAT_PHASE == 0 ? 2 : 1); ++rep) phase_prologue(C, A); } SEAM(0);
    if (IN(3)) { FRESH_TID(); const bool side = (G == 256) && MOE_CVT_SIDE_A > 0; const int Gg = side ? G - MOE_CVT_WG : G;
                 if (c < Gg) { pg8::Gemm g{(const bf16*)C.ws, (const bf16*)C.ws, DM, DM, DM}; AbInMemOrder S; S.d.init(T, AB_PAD, DM, DM, AB_PAD, Gg, c); S.m = MemProjOrder{Gg, c};
                               EpiAbInMem E{EpiAbIn{ARP(bf16, A_PAB), ARP(float, A_GF32)}, EpiStoreBf16{WSP(bf16, WS_KP), DM, 1.f}}; pg8::gemm_phase(L, g, S, E, C.tid); }
                 else moe_convert_items(C, MOE_CVT_TOTAL - MOE_CVT_SIDE_A - MOE_CVT_SIDE_B, MOE_CVT_TOTAL - MOE_CVT_SIDE_B, (c - Gg) * NWAVES + C.wave, MOE_CVT_WG * NWAVES); } SEAM(3);
    if (IN(4)) { FRESH_TID(); phase_mixer_prep(C, A); } SEAM(4);
    if (IN(5)) { FRESH_TID(); if (C.bid < 16 && C.wave == 0) ml_gate_scan(C, C.bid);
                 pg8::Gemm g{ARP(bf16, A_LIN), WSP(bf16, WS_W_LORA), 256, 256, 256}; pg8::DenseOrder S; S.init(T, 3072, 256, 256, 3072, G, c);
                 EpiLora E{INP(I_RW_W0), INP(I_RW_A0), INP(I_RW_K_A), ARP(bf16, A_KK), ARP(bf16, A_KR), ARP(float, A_WD), ARP(bf16, A_BV), ARP(bf16, A_KP), ARP(bf16, A_GG)}; pg8::gemm_phase(L, g, S, E, C.tid);
                 { pg8::Gemm g2{WSP(bf16, WS_KP), WSP(bf16, WS_W_CAQ), DM, DM, 512}; WktOrder S2{G, c}; EpiStoreBf16 E2{WSP(bf16, WS_WKT), DM, 0.04419417382415922f}; pg8::gemm_phase(L, g2, S2, E2, C.tid); }
                 { pg8::Gemm g3{WSP(bf16, WS_W_CAO), WSP(bf16, WS_VP), DM, DM, 512}; VwtOrder S3{G, c}; EpiStoreBf16 E3{WSP(bf16, WS_VWT), 1024, 1.f}; pg8::gemm_phase(L, g3, S3, E3, C.tid); } } SEAM(5);
    if (IN(6)) { FRESH_TID(); rwkv_prep_units(C, G == 256); for (int it = C.bid; it < 1024; it += G) ml_intra_unit(C, it, G == 256); } SEAM(6);
    if (IN(7)) { FRESH_TID(); for (int it = C.bid; it < 256; it += G) rwkv_scan_slice(C, it); ml_state_scan(C, 0, G); } SEAM(7);
    if (IN(8)) { FRESH_TID(); for (int it = C.bid; it < 1024; it += G) ml_out_unit(C, it, (G == 256) && MOE_CVT_SIDE_G > 0); rwkv_out_items(C); } SEAM(8);
    if (IN(9)) { FRESH_TID(); pg8::Gemm g{ARP(bf16, A_YCAT), WSP(bf16, WS_W_ABOUT), DM, DM, DM}; pg8::DenseOrder S; S.init(T, DM, DM, DM, DM, G, c); EpiResidT<true> E{INP(I_X), WSP(bf16, WS_XR), DM, WSP(float, WS_RSQ), (LAS float*)(C.lds + LDS_AUX)}; pg8::gemm_phase(L, g, S, E, C.tid); } SEAM(9);
    COMMON_PHASES(0, 10)
    if (IN(21)) { FRESH_TID(); const bool side = (G == 256); const int Gg = side ? G - MOE_CVT_WG : G;
                  if (c >= Gg) moe_convert_items_x2(C, MOE_CVT_TOTAL - MOE_CVT_SIDE_B, MOE_CVT_TOTAL, (c - Gg) * NWAVES + C.wave, MOE_CVT_WG * NWAVES); else {
                  pg8::Gemm g{WSP(bf16, WS_XR), WSP(bf16, WS_W_NSAIN), DM, DM, DM}; pg8::DenseOrder S; S.init(T, NSA_PAD, DM, DM, NSA_PAD, Gg, c);
                  EpiNsaIn E{ARP(bf16, A_Q), ARP(bf16, A_QROT), ARP(bf16, A_KV6), ARP(float, A_GATES), INP(I_NSA_GATE_B), WSP(float, WS_TAB + TAB_ROPE_COS), WSP(float, WS_TAB + TAB_ROPE_SIN), WSP(float, WS_RSQ) + (size_t)4 * T * 8}; pg8::gemm_phase(L, g, S, E, C.tid); } } SEAM(21);
    if (IN(22)) { FRESH_TID(); pg8::Gemm g{ARP(bf16, A_KV6), WSP(bf16, WS_W_CMP1), 2048, 4096, 512}; CmpOrder S{G, c}; EpiStoreF32 E{ARP(float, A_CPART), 256}; pg8::gemm_phase(L, g, S, E, C.tid); } SEAM(22);
    if (IN(23)) { FRESH_TID(); phase_cmp_finish(C, A); } SEAM(23);
    if (IN(24)) { FRESH_TID(); for (int rep = 0; rep < (REPEAT_PHASE == 24 ? 2 : 1); ++rep) phase_cmp_attn_mma(C, G == 256); } SEAM(24);
#if PROBE == 1
    if (IN(25)) { FRESH_TID(); phase_selwin_naive(C, ARP(bf16, A_OCATREF)); xcd_barrier(bar); }
#endif
    if (IN(25)) { FRESH_TID(); swa::phase<true, 0>(C.wave, (char*)lds_raw, ARP(bf16, A_QROT), (const bf16*)(C.ws + WS_ARENA + A_KV6 + 2 * KV6_STRIDE), (const bf16*)(C.ws + WS_ARENA + A_KV6 + 3 * KV6_STRIDE), SEQ,
                                      ARP(const unsigned long long, A_SELMASK), ARP(float, A_GATES), 16, ARP(float, A_OACC), ARP(bf16, A_OCAT)); } SEAM(25);
    if (IN(26)) { FRESH_TID(); swa::phase<false, 1>(C.wave, (char*)lds_raw, ARP(bf16, A_QROT), (const bf16*)(C.ws + WS_ARENA + A_KV6 + 4 * KV6_STRIDE), (const bf16*)(C.ws + WS_ARENA + A_KV6 + 5 * KV6_STRIDE), 512,
                                       ARP(const unsigned long long, A_SELMASK), ARP(float, A_GATES), 32, ARP(float, A_OACC), ARP(bf16, A_OCAT)); } SEAM(26);
#if PROBE == 1
    if (IN(26)) { FRESH_TID(); probe_compare(C, ARP(bf16, A_OCAT), ARP(bf16, A_OCATREF), (size_t)T * DM); }
#endif
    { int t2 = C.wave * 64 + swa::lane_id(); asm volatile("" : "+v"(t2)); C.tid = t2 & 511; C.lane = t2 & 63; }
    if (IN(27)) { FRESH_TID(); pg8::Gemm g{ARP(bf16, A_OCAT), WSP(bf16, WS_W_NSAOUT), DM, DM, DM}; pg8::DenseOrder S; S.init(T, DM, DM, DM, DM, G, c); EpiResidT<false> E{WSP(bf16, WS_XR), WSP(bf16, WS_XR), DM, WSP(float, WS_RSQ) + (size_t)2 * T * 8, (LAS float*)(C.lds + LDS_AUX)}; pg8::gemm_phase(L, g, S, E, C.tid); } SEAM(27);
    COMMON_PHASES(1, 28)
#if PROBE == 2
    xcd_barrier(bar);
    if (C.bid == 0 && C.tid == 0) ((float*)INP(N_INPUTS))[0] = (float)(tB_ - tA_) * (0.01f * PROBE_SCALE);
#elif PROBE
    xcd_barrier(bar);
    if (C.bid == 0 && C.tid == 0) { const float se = __hip_atomic_load((float*)(ctl + CW_PROBE), __ATOMIC_RELAXED, __HIP_MEMORY_SCOPE_AGENT), sr = __hip_atomic_load((float*)(ctl + CW_PROBE + 1), __ATOMIC_RELAXED, __HIP_MEMORY_SCOPE_AGENT);
        ((float*)INP(N_INPUTS))[0] = 1e6f * sqrtf(se / fmaxf(sr, 1e-30f)); }
#endif
#undef IN
#undef SEAM
}

extern "C" void kernel_launch(void* const* d_in, const int* in_sizes, int n_in, void* d_out, int out_size, void* d_ws, size_t ws_size, hipStream_t stream) {
    static int grid = 0;
    if (grid == 0) {
        if (n_in != N_INPUTS || out_size != T * DM || ws_size < WS_END) { fprintf(stderr, "kernel_launch: unexpected shapes (n_in %d, out %d, ws %zu, need %zu)\n", n_in, out_size, ws_size, (size_t)WS_END); grid = -1; return; }
        int dev = 0, cus = 0, per_cu = 0;
        if (hipGetDevice(&dev) != hipSuccess || hipDeviceGetAttribute(&cus, hipDeviceAttributeMultiprocessorCount, dev) != hipSuccess) { grid = -1; return; }
        if (hipFuncSetAttribute((const void*)mk_fwd, hipFuncAttributeMaxDynamicSharedMemorySize, LDS_BYTES) != hipSuccess) { fprintf(stderr, "kernel_launch: hipFuncSetAttribute failed\n"); grid = -1; return; }
        if (hipOccupancyMaxActiveBlocksPerMultiprocessor(&per_cu, (const void*)mk_fwd, NTHR, LDS_BYTES) != hipSuccess || per_cu < 1) fprintf(stderr, "kernel_launch: occupancy query says %d\n", per_cu);
        (void)hipGetLastError();
        grid = cus;
    }
    if (grid < 0) return;
    (void)hipMemsetAsync((char*)d_ws + WS_CTL, 0, CTL_BYTES, stream);
    Args a{};
    for (int i = 0; i < N_INPUTS; ++i) a.in[i] = (const float*)d_in[i];
    a.out = (float*)d_out; a.ws = (unsigned char*)d_ws;
#if MK_SPLIT
    for (int p = 0; p < N_PHASES; ++p) { a.ph_lo = p; a.ph_hi = p + 1; hipLaunchKernelGGL(mk_fwd, dim3(grid), dim3(NTHR), LDS_BYTES, stream, a); }
#else
    a.ph_lo = 0; a.ph_hi = N_PHASES; hipLaunchKernelGGL(mk_fwd, dim3(grid), dim3(NTHR), LDS_BYTES, stream, a);
#endif
}
```

```cpp
#include <hip/hip_runtime.h>
#include <cstdio>
#include <cstdint>

#define LAS __attribute__((address_space(3)))
#define GAS __attribute__((address_space(1)))
typedef unsigned short bf16;
typedef short bf16x8 __attribute__((ext_vector_type(8)));
typedef float f32x4 __attribute__((ext_vector_type(4)));
typedef float f32x2 __attribute__((ext_vector_type(2)));
typedef unsigned u32x4 __attribute__((ext_vector_type(4)));
typedef unsigned u32x2 __attribute__((ext_vector_type(2)));

constexpr int BATCH = 4, SEQ = 4096, DM = 2048, T = BATCH * SEQ, MEMT = 256, MT = BATCH * MEMT;
constexpr float EPS = 1e-6f;
constexpr int ML_COLS = 3080, RW_COLS = 3328, AB_COLS = 6408, AB_PAD = 6656;
constexpr int NSA_COLS = 5168, NSA_PAD = 5376;
constexpr int NEXP = 64, FF = 512;
constexpr int XS_ROWS = 49152;
constexpr int SPAD = SEQ + 64;

enum { I_X = 0, I_MEM, I_NORM_MIX, I_NORM_CROSS, I_NORM_MEM, I_NORM_FFN, I_NORM_FINAL, I_AB_W_IN, I_ML_CONV_W, I_ML_CONV_B, I_ML_GATE_B,
       I_RW_MU, I_RW_W0, I_RW_W_UP, I_RW_A0, I_RW_A_UP, I_RW_G_UP, I_RW_K_K, I_RW_K_A, I_RW_R_K, I_RW_LN_W, I_RW_LN_B, I_AB_W_OUT,
       I_NSA_W_IN, I_NSA_GATE_B, I_CMP_POS, I_CMP_W1, I_CMP_W2, I_NSA_W_OUT, I_CA_WQ, I_CA_WK, I_CA_WV, I_CA_WO,
       I_MOE_WG, I_MOE_BG, I_MOE_WE, I_MOE_BE, I_MOE_W_GATE, I_MOE_W_UP, I_MOE_W_DOWN, N_INPUTS };

constexpr size_t MiB = (size_t)1 << 20;
constexpr size_t WS_CTL = 0, CTL_BYTES = 1 * MiB;
constexpr size_t WS_TAB = 1 * MiB;
constexpr size_t WS_W_ABIN = 3 * MiB;
constexpr size_t WS_W_ABOUT = WS_W_ABIN + 26 * MiB;
constexpr size_t WS_W_LORA = WS_W_ABOUT + 8 * MiB;
constexpr size_t WS_W_NSAIN = WS_W_LORA + 2 * MiB;
constexpr size_t WS_W_NSAOUT = WS_W_NSAIN + 21 * MiB;
constexpr size_t WS_W_CMP1 = WS_W_NSAOUT + 8 * MiB;
constexpr size_t WS_W_CAQ = WS_W_CMP1 + 4 * MiB;
constexpr size_t WS_W_CAK = WS_W_CAQ + 16 * MiB;
constexpr size_t WS_W_CAV = WS_W_CAK + 16 * MiB;
constexpr size_t WS_W_CAO = WS_W_CAV + 16 * MiB;
constexpr size_t WS_W_ROUTER = WS_W_CAO + 16 * MiB;
constexpr size_t WS_W_GU = WS_W_ROUTER + 2 * MiB;
constexpr size_t WS_W_DN = WS_W_GU + 512 * MiB;
constexpr size_t WS_MEMN = WS_W_DN + 256 * MiB;
constexpr size_t WS_KP = WS_MEMN + 8 * MiB;
constexpr size_t WS_VP = WS_KP + 8 * MiB;
constexpr size_t WS_WKT = WS_VP + 8 * MiB;
constexpr size_t WS_VWT = WS_WKT + 32 * MiB;
constexpr size_t WS_XR = WS_VWT + 32 * MiB;
constexpr size_t WS_RSQ = WS_XR + 64 * MiB;
constexpr size_t WS_XN = WS_XR + 128 * MiB;
constexpr size_t WS_ARENA = WS_XN + 64 * MiB;
constexpr size_t A_PAB = 0;
constexpr size_t A_GF32 = A_PAB + 208 * MiB;
constexpr size_t A_QM = A_GF32 + 16 * MiB;
constexpr size_t A_KM = A_QM + 16 * MiB;
constexpr size_t A_IG = A_KM + 16 * MiB;
constexpr size_t A_LF = A_IG + 1 * MiB;
constexpr size_t A_MLA = A_LF + 256 * 1024, A_MLM = A_LF + 512 * 1024;
constexpr size_t A_RR = A_LF + 1 * MiB;
constexpr size_t A_KR = A_RR + 32 * MiB;
constexpr size_t A_VR = A_KR + 32 * MiB;
constexpr size_t A_KK = A_VR + 32 * MiB;
constexpr size_t A_LIN = A_KK + 32 * MiB;
constexpr size_t A_WD = A_LIN + 8 * MiB;
constexpr size_t A_BV = A_WD + 64 * MiB;
constexpr size_t A_KP = A_BV + 32 * MiB;
constexpr size_t A_GG = A_KP + 32 * MiB;
constexpr size_t A_YCAT = A_GG + 32 * MiB;
constexpr size_t A_RWM = A_YCAT + 64 * MiB;
constexpr size_t A_RWN = A_RWM + 32 * MiB, A_RWRW = A_RWN + 32 * MiB, A_RWYL = A_RWRW + 32 * MiB;
constexpr size_t A_MLKV = A_RWYL + 32 * MiB;
constexpr size_t A_MLNUM = A_MLKV + 68 * MiB;
constexpr size_t A_END0 = A_MLNUM + 34 * MiB;
constexpr size_t A_SC = 0;
constexpr size_t A_PC = A_SC + 64 * MiB;
constexpr size_t A_LOGIT = 0;
constexpr size_t A_EID = A_LOGIT + 16 * MiB;
constexpr size_t A_WTS = A_EID + 1 * MiB;
constexpr size_t A_ROWSLOT = A_WTS + 1 * MiB;
constexpr size_t A_LRANK = A_ROWSLOT + 256 * 1024, A_BHIST = A_ROWSLOT + 512 * 1024;
constexpr size_t A_XS = A_ROWSLOT + 1 * MiB;
constexpr size_t A_HID = A_XS + 192 * MiB;
constexpr size_t A_YE = A_HID + 48 * MiB;
constexpr size_t A_END2 = A_YE + 128 * MiB;
constexpr size_t A_Q = 0;
constexpr size_t A_QROT = A_Q + 64 * MiB;
constexpr size_t A_KV6 = A_QROT + 64 * MiB;
constexpr size_t KV6_STRIDE = 17 * MiB;
constexpr size_t A_GATES = A_KV6 + 6 * KV6_STRIDE;
constexpr size_t A_CPART = A_GATES + 4 * MiB;
constexpr size_t A_KCMP = A_CPART + 64 * MiB;
constexpr size_t A_VCMP = A_KCMP + 1 * MiB;
constexpr size_t A_SELMASK = A_VCMP + 1 * MiB;
constexpr size_t A_OACC = A_SELMASK + 1 * MiB;
constexpr size_t A_OCAT = A_OACC + 128 * MiB;
constexpr size_t A_OCATREF = A_OCAT + 64 * MiB;
constexpr size_t A_VCT = A_OCATREF + 64 * MiB;
constexpr size_t A_END3 = A_VCT + 1 * MiB;
constexpr size_t ARENA_BYTES = 860 * MiB;
static_assert(A_END0 <= ARENA_BYTES && A_END2 <= ARENA_BYTES && A_END3 <= ARENA_BYTES, "arena");
constexpr size_t WS_END = WS_ARENA + ARENA_BYTES;
static_assert(WS_END <= (size_t)2048 * MiB, "workspace");
constexpr size_t TAB_ROPE_COS = 0, TAB_ROPE_SIN = 256 * 1024, TAB_CMPBIAS = 512 * 1024, TAB_RSTD = 1024 * 1024;
constexpr int CW_BAR = 4096;
constexpr int CW_MOE_CNT = 16384;
constexpr int CW_MOE_CUR = 16384 + 256;
constexpr int CW_PROBE = 32768;
constexpr int CW_RSQ = 65536;

__device__ __forceinline__ float bf2f(bf16 v) { return __uint_as_float((unsigned)v << 16); }
__device__ __forceinline__ unsigned f2bf(float f) { unsigned u = __float_as_uint(f); return (u + 0x7fffu + ((u >> 16) & 1u)) >> 16; }
__device__ __forceinline__ unsigned pk2(float lo, float hi) { return f2bf(lo) | (f2bf(hi) << 16); }
__device__ __forceinline__ float lo_bf(unsigned w) { return __uint_as_float(w << 16); }
__device__ __forceinline__ float hi_bf(unsigned w) { return __uint_as_float(w & 0xffff0000u); }
__device__ __forceinline__ float sigmoidf_(float x) { return 1.f / (1.f + __expf(-x)); }
__device__ __forceinline__ float siluf_(float x) { return x / (1.f + __expf(-x)); }
#define DPPF(v, ctrl) __int_as_float(__builtin_amdgcn_update_dpp(0, __float_as_int(v), (ctrl), 0xf, 0xf, true))
#define DPP_XOR1 0xB1
#define DPP_XOR2 0x4E
#define DPP_HMIRROR 0x141
#define DPP_MIRROR 0x140
__device__ __forceinline__ float xor16f(float v) { const unsigned u = __float_as_uint(v); auto r = __builtin_amdgcn_permlane16_swap(u, u, false, false); return __uint_as_float(r[0] ^ r[1] ^ u); }
__device__ __forceinline__ float xor32f(float v) { const unsigned u = __float_as_uint(v); auto r = __builtin_amdgcn_permlane32_swap(u, u, false, false); return __uint_as_float(r[0] ^ r[1] ^ u); }
__device__ __forceinline__ float wave_sum(float v) {
    v += DPPF(v, DPP_XOR1); v += DPPF(v, DPP_XOR2); v += DPPF(v, DPP_HMIRROR); v += DPPF(v, DPP_MIRROR); v += xor16f(v); v += xor32f(v); return v;
}
__device__ __forceinline__ float wave_max(float v) {
    v = fmaxf(v, DPPF(v, DPP_XOR1)); v = fmaxf(v, DPPF(v, DPP_XOR2)); v = fmaxf(v, DPPF(v, DPP_HMIRROR)); v = fmaxf(v, DPPF(v, DPP_MIRROR)); v = fmaxf(v, xor16f(v)); v = fmaxf(v, xor32f(v)); return v;
}
__device__ __forceinline__ void unpack8(u32x4 w, float* f) {
    f[0] = lo_bf(w.x); f[1] = hi_bf(w.x); f[2] = lo_bf(w.y); f[3] = hi_bf(w.y); f[4] = lo_bf(w.z); f[5] = hi_bf(w.z); f[6] = lo_bf(w.w); f[7] = hi_bf(w.w);
}
__device__ __forceinline__ void st16_f(void* p, u32x4 w) { *(f32x4*)p = __builtin_bit_cast(f32x4, w); }
__device__ __forceinline__ void st8_f(void* p, u32x2 w) { *(f32x2*)p = __builtin_bit_cast(f32x2, w); }
__device__ __forceinline__ u32x4 pack8f(const float* f) { u32x4 w; w.x = pk2(f[0], f[1]); w.y = pk2(f[2], f[3]); w.z = pk2(f[4], f[5]); w.w = pk2(f[6], f[7]); return w; }

namespace pg8 {
constexpr int BM = 256, BK = 64, HALF = 128, HTB = HALF * BK * 2, STAGE_BYTES = 8 * HTB, NXCD = 8, WGM = 8;
__host__ __device__ __forceinline__ int lds_byte(int r, int c) { const int st = (r >> 4) * 2 + (c >> 5), rr = r & 15, cc = c & 31, ob = rr * 64 + cc * 2; return st * 1024 + (ob ^ (((ob >> 9) & 1) << 5)); }
__host__ __device__ __forceinline__ void stage_rc(int b, int& R, int& C) { const int st = b / 1024, sb = b % 1024, swz = sb ^ (((sb >> 9) & 1) << 5); R = (st >> 1) * 16 + swz / 64; C = (st & 1) * 32 + (swz % 64) / 2; }
__host__ __device__ __forceinline__ int perm32(int rho) { const int n = rho >> 4, i = rho & 15; return 8 * (i >> 2) + 4 * n + (i & 3); }

struct Unit { long long aoff, boff, coff; int pm, pn, aux; };
struct Gemm { const bf16* A; const bf16* Bt; int lda, ldb, K; };

__device__ __forceinline__ bool tile_of(long L, int nM, int nN, int& pm, int& pn) {
    const int nwg = nM * nN; if (L >= nwg) return false;
    int wgid = (int)L; { const int q = nwg / NXCD, r = nwg % NXCD, xcd = wgid % NXCD, off = wgid / NXCD; wgid = (xcd < r ? xcd * (q + 1) : r * (q + 1) + (xcd - r) * q) + off; }
    const int nig = WGM * nN, gid = wgid / nig, fm = gid * WGM, gsz = (nM - fm) < WGM ? (nM - fm) : WGM;
    pm = fm + ((wgid % nig) % gsz); pn = (wgid % nig) / gsz; return true;
}
struct DenseOrder {
    int nM, nN, G, c, ldc; long long astep, bstep;
    __device__ void init(int M, int N, int lda, int ldb, int ldc_, int G_, int c_) { nM = M / BM; nN = N / BM; G = G_; c = c_; ldc = ldc_; astep = (long long)BM * lda * 2; bstep = (long long)BM * ldb * 2; }
    __device__ __forceinline__ bool next(int i, Unit& u) const {
        int pm, pn; if (!tile_of((long)i * G + c, nM, nN, pm, pn)) return false;
        u.pm = pm; u.pn = pn; u.aux = 0; u.aoff = pm * astep; u.boff = pn * bstep; u.coff = (long long)pm * BM * ldc + pn * BM; return true;
    }
};

__device__ __forceinline__ unsigned cvt_pk_bf16(float lo, float hi) { unsigned r; asm volatile("v_cvt_pk_bf16_f32 %0, %1, %2" : "=v"(r) : "v"(lo), "v"(hi)); return r; }

template <class Epi, class Sched, bool GATHER = false>
__device__ __forceinline__ void gemm_phase(LAS unsigned char* lds, const Gemm g, const Sched& S, const Epi& E, int tid_, const LAS int* rowcache = nullptr) {
    __builtin_assume(tid_ >= 0 && tid_ < 512); const int tid = tid_, wid = __builtin_amdgcn_readfirstlane(tid >> 6), lane = tid & 63, wr = wid >> 2, wc = wid & 3, fr = lane & 15, fq = lane >> 4;
    int nt = g.K / BK; asm volatile("" : "+s"(nt));
    const size_t kstep = (size_t)(BK * 2);
    const size_t hstepA = (size_t)HALF * g.lda * 2, hstepB = (size_t)HALF * g.ldb * 2;
    unsigned vA0[2], vA1[2], vN0[2], vN1[2], voffB[2]; int Rr[2], Cb[2];
#pragma unroll
    for (int i = 0; i < 2; ++i) { int R, C; stage_rc(tid * 16 + i * 8192, R, C); const int Rb = (R & ~31) + perm32(R & 31); Rr[i] = R; Cb[i] = C * 2;
        vA0[i] = (unsigned)(R * g.lda + C) * 2u; vA1[i] = vA0[i] + (unsigned)hstepA; vN0[i] = vA0[i]; vN1[i] = vA1[i]; voffB[i] = (unsigned)(Rb * g.ldb + C) * 2u; }
#define PG8_GATHER(d0, d1, ui_) do { _Pragma("unroll") for (int _i = 0; _i < 2; ++_i) { d0[_i] = (unsigned)(rowcache[(ui_) * 256 + Rr[_i]] * g.lda * 2 + Cb[_i]); d1[_i] = (unsigned)(rowcache[(ui_) * 256 + 128 + Rr[_i]] * g.lda * 2 + Cb[_i]); } } while (0)
    if (GATHER) PG8_GATHER(vA0, vA1, 0);
    const unsigned ldsw = (unsigned)wid * 1024u;
    const int aoff = lds_byte(wr * 64 + fr, fq * 8), boff = lds_byte(wc * 32 + fr, fq * 8);
#define PG8_SA(b, h) (((b) * 2 + (h)) * HTB)
#define PG8_SB(b, h) ((4 + (b) * 2 + (h)) * HTB)
#define PG8_STAGE(bufoff, gbase, voff) do { _Pragma("unroll") for (int _i = 0; _i < 2; ++_i) \
        __builtin_amdgcn_global_load_lds((const unsigned*)((const char*)(gbase) + (voff)[_i]), (LAS unsigned*)(lds + (bufoff) + ldsw + _i * 8192), 16, 0, 0); } while (0)
#define PG8_LDA(dst, b, h) do { _Pragma("unroll") for (int m = 0; m < 4; ++m) _Pragma("unroll") for (int k = 0; k < 2; ++k) dst[m][k] = *(const LAS bf16x8*)(lds + PG8_SA(b, h) + aoff + m * 2048 + k * 1024); } while (0)
#define PG8_LDB(dst, b, h) do { _Pragma("unroll") for (int n = 0; n < 2; ++n) _Pragma("unroll") for (int k = 0; k < 2; ++k) dst[n][k] = *(const LAS bf16x8*)(lds + PG8_SB(b, h) + boff + n * 2048 + k * 1024); } while (0)
#define PG8_MMA(ai, bj, At, Bt) do { __builtin_amdgcn_s_setprio(1); _Pragma("unroll") for (int m = 0; m < 4; ++m) _Pragma("unroll") for (int n = 0; n < 2; ++n) _Pragma("unroll") for (int k = 0; k < 2; ++k) \
        acc[ai][bj][m][n] = __builtin_amdgcn_mfma_f32_16x16x32_bf16(Bt[n][k], At[m][k], acc[ai][bj][m][n], 0, 0, 0); __builtin_amdgcn_s_setprio(0); } while (0)
#define PG8_WAIT_V(n) asm volatile("s_waitcnt vmcnt(" #n ")" ::: "memory")
#define PG8_WAIT_L(n) asm volatile("s_waitcnt lgkmcnt(" #n ")" ::: "memory")
#define PG8_BAR __builtin_amdgcn_s_barrier()
#define PG8_SCHED __builtin_amdgcn_sched_barrier(0)
    Unit cur, nxt; int ui = 0;
    if (!S.next(0, cur)) return;
    f32x4 acc[2][2][4][2];
#pragma unroll
    for (int a = 0; a < 2; ++a)
#pragma unroll
        for (int b = 0; b < 2; ++b)
#pragma unroll
            for (int m = 0; m < 4; ++m)
#pragma unroll
                for (int n = 0; n < 2; ++n) acc[a][b][m][n] = (f32x4){0.f, 0.f, 0.f, 0.f};
    bf16x8 At[4][2], B0[2][2], B1[2][2];
    const char* cA = (const char*)g.A + cur.aoff; const char* cB = (const char*)g.Bt + cur.boff;
    PG8_STAGE(PG8_SB(0, 0), cB, voffB); PG8_STAGE(PG8_SB(0, 1), cB + hstepB, voffB); PG8_STAGE(PG8_SA(0, 0), cA, vA0); PG8_STAGE(PG8_SA(0, 1), cA, vA1);
    if (wr == 1) PG8_BAR;
    PG8_WAIT_V(2); PG8_BAR;
    PG8_STAGE(PG8_SB(1, 0), cB + kstep, voffB); PG8_STAGE(PG8_SA(1, 0), cA + kstep, vA0); PG8_STAGE(PG8_SB(1, 1), cB + hstepB + kstep, voffB);
    PG8_WAIT_V(6); PG8_BAR;
    for (;;) {
        const bool has_next = S.next(ui + 1, nxt);
        const char* nA = has_next ? (const char*)g.A + nxt.aoff : cA; const char* nB = has_next ? (const char*)g.Bt + nxt.boff : cB;
        if (GATHER) { if (has_next) PG8_GATHER(vN0, vN1, ui + 1); else { vN0[0] = vA0[0]; vN0[1] = vA0[1]; vN1[0] = vA1[0]; vN1[1] = vA1[1]; } }
        for (int t = 0; t < nt; t += 2) {
            const bool last = (t == nt - 2);
            const char* a1 = cA + (size_t)(t + 1) * kstep;
            const char* a2 = last ? nA : cA + (size_t)(t + 2) * kstep; const char* b2 = last ? nB : cB + (size_t)(t + 2) * kstep;
            const char* a3 = a2 + kstep; const char* b3 = b2 + kstep;
            unsigned w0[2], w1[2];
            if (GATHER) { w0[0] = last ? vN0[0] : vA0[0]; w0[1] = last ? vN0[1] : vA0[1]; w1[0] = last ? vN1[0] : vA1[0]; w1[1] = last ? vN1[1] : vA1[1]; } else { w0[0] = vA0[0]; w0[1] = vA0[1]; w1[0] = vA1[0]; w1[1] = vA1[1]; }
            PG8_LDB(B0, 0, 0); PG8_LDB(B1, 0, 1); PG8_SCHED; PG8_LDA(At, 0, 0); PG8_STAGE(PG8_SA(1, 1), a1, vA1);
            PG8_WAIT_V(8); PG8_WAIT_L(0); PG8_BAR; PG8_MMA(0, 0, At, B0); PG8_MMA(0, 1, At, B1); PG8_BAR; PG8_SCHED;
            PG8_LDA(At, 0, 1); PG8_STAGE(PG8_SB(0, 0), b2, voffB); PG8_STAGE(PG8_SB(0, 1), b2 + hstepB, voffB); PG8_STAGE(PG8_SA(0, 0), a2, w0);
            PG8_WAIT_V(8); PG8_WAIT_L(0); PG8_BAR; PG8_MMA(1, 0, At, B0); PG8_MMA(1, 1, At, B1); PG8_BAR; PG8_SCHED;
            PG8_LDB(B0, 1, 0); PG8_LDB(B1, 1, 1); PG8_SCHED; PG8_LDA(At, 1, 0); PG8_STAGE(PG8_SA(0, 1), a2, w1);
            PG8_WAIT_V(8); PG8_WAIT_L(0); PG8_BAR; PG8_MMA(0, 0, At, B0); PG8_MMA(0, 1, At, B1); PG8_BAR; PG8_SCHED;
            PG8_LDA(At, 1, 1); PG8_STAGE(PG8_SB(1, 0), b3, voffB); PG8_STAGE(PG8_SB(1, 1), b3 + hstepB, voffB); PG8_STAGE(PG8_SA(1, 0), a3, w0);
            PG8_WAIT_V(8); PG8_WAIT_L(0); PG8_BAR; PG8_MMA(1, 0, At, B0); PG8_MMA(1, 1, At, B1); PG8_BAR; PG8_SCHED;
        }
        if (wr == 0) PG8_BAR;
        E(acc, cur, wr, wc, fr, fq);
        if (!has_next) break;
#pragma unroll
        for (int a = 0; a < 2; ++a)
#pragma unroll
            for (int b = 0; b < 2; ++b)
#pragma unroll
                for (int m = 0; m < 4; ++m)
#pragma unroll
                    for (int n = 0; n < 2; ++n) acc[a][b][m][n] = (f32x4){0.f, 0.f, 0.f, 0.f};
        cur = nxt; cA = nA; cB = nB; ++ui;
        if (GATHER) { vA0[0] = vN0[0]; vA0[1] = vN0[1]; vA1[0] = vN1[0]; vA1[1] = vN1[1]; }
        if (wr == 1) PG8_BAR;
    }
    PG8_WAIT_V(0);
    PG8_BAR;
#undef PG8_SA
#undef PG8_SB
#undef PG8_STAGE
#undef PG8_GATHER
#undef PG8_LDA
#undef PG8_LDB
#undef PG8_MMA
#undef PG8_WAIT_V
#undef PG8_WAIT_L
#undef PG8_BAR
#undef PG8_SCHED
}
}

#define XB_TMO      128
#define XB_XCNT(j)  (256  + 64 * (j))
#define XB_XSUB(j)  (1280 + 64 * (j))
#define XB_XGEN(j)  (2304 + 64 * (j))
#define XB_TOP      3328
#define XB_TOPGEN   3392
#define XCD_BAR_WORDS 3456
#define XB_SPIN_CAP (1u << 22)
__device__ __forceinline__ unsigned xb_ld(unsigned* p)              { return __hip_atomic_load(p, __ATOMIC_RELAXED, __HIP_MEMORY_SCOPE_AGENT); }
__device__ __forceinline__ unsigned xb_add(unsigned* p, unsigned v) { return __hip_atomic_fetch_add(p, v, __ATOMIC_RELAXED, __HIP_MEMORY_SCOPE_AGENT); }
__device__ __forceinline__ unsigned xb_xcc_id() { return (unsigned)__builtin_amdgcn_s_getreg((3 << 11) | 20) & 0xFu; }
#define XB_SPIN(cond, bar) do { unsigned _sp = 0; while (cond) { __builtin_amdgcn_s_sleep(1); \
    if ((++_sp & 255u) == 0u) { if (xb_ld(&(bar)[XB_TMO])) break; if (_sp > XB_SPIN_CAP) { atomicAdd(&(bar)[XB_TMO], 1u); break; } } } } while (0)
struct XcdBarrier { unsigned* bar; unsigned x; volatile LAS unsigned* st; };
__device__ __forceinline__ XcdBarrier xcd_barrier_post(unsigned* bar, volatile LAS unsigned* st) {
    XcdBarrier b; b.bar = bar; b.x = xb_xcc_id(); b.st = st;
    if (threadIdx.x == 0) (void)xb_add(&bar[XB_XCNT(b.x)], 1u);
    return b;
}
__device__ __forceinline__ void xcd_barrier_complete(unsigned* bar, unsigned x, unsigned& nloc, unsigned& nx) {
    const unsigned G = gridDim.x * gridDim.y * gridDim.z;
    unsigned sum, cnt, mine, sp = 0u;
    for (;;) {
        sum = 0u; cnt = 0u; mine = 0u;
#pragma unroll
        for (unsigned j = 0; j < 16; ++j) { const unsigned c = xb_ld(&bar[XB_XCNT(j)]); sum += c; cnt += (c > 0u) ? 1u : 0u; mine = (j == x) ? c : mine; }
        if (sum == G) break;
        __builtin_amdgcn_s_sleep(1);
        if ((++sp & 255u) == 0u) { if (xb_ld(&bar[XB_TMO])) break; if (sp > XB_SPIN_CAP) { atomicAdd(&bar[XB_TMO], 1u); break; } }
    }
    nloc = mine > 0u ? mine : 1u; nx = cnt > 0u ? cnt : 1u;
}
__device__ __forceinline__ void xcd_barrier(const XcdBarrier& b) {
    asm volatile("s_waitcnt vmcnt(0)" ::: "memory");
    __syncthreads();
    if (threadIdx.x == 0) {
        unsigned* bar = b.bar;
        __builtin_amdgcn_s_waitcnt(0);
        unsigned nloc = b.st[0], nx = b.st[1];
        if (nloc == 0u) { xcd_barrier_complete(bar, b.x, nloc, nx); b.st[0] = nloc; b.st[1] = nx; }
        const unsigned old = xb_add(&bar[XB_XSUB(b.x)], 1u);
        const unsigned gen = old / nloc;
        if (old + 1u == (gen + 1u) * nloc) {
            __builtin_amdgcn_fence(__ATOMIC_RELEASE, "agent");
            asm volatile("s_waitcnt vmcnt(0)" ::: "memory");
            const unsigned og = xb_add(&bar[XB_TOP], 1u);
            const unsigned tg = og / nx;
            if (og + 1u == (tg + 1u) * nx) xb_add(&bar[XB_TOPGEN], 1u);
            else XB_SPIN(xb_ld(&bar[XB_TOPGEN]) == tg, bar);
            __builtin_amdgcn_fence(__ATOMIC_ACQUIRE, "agent");
            xb_add(&bar[XB_XGEN(b.x)], 1u);
            asm volatile("s_waitcnt vmcnt(0)" ::: "memory");
        } else {
            XB_SPIN(xb_ld(&bar[XB_XGEN(b.x)]) == gen, bar);
            __builtin_amdgcn_fence(__ATOMIC_ACQUIRE, "agent");
            asm volatile("s_waitcnt vmcnt(0)" ::: "memory");
        }
    }
    __syncthreads();
}

constexpr int NWAVES = 8, NTHR = 512;
constexpr int LDS_MAIN = 131072;
constexpr int LDS_AUX = 131072, LDS_AUX_BYTES = 16384;
constexpr int LDS_MISC = LDS_AUX + LDS_AUX_BYTES;
constexpr int LDS_PTAB = LDS_MISC + 256;
constexpr int LDS_BYTES = LDS_MISC + 1024;
struct Args { const float* in[N_INPUTS]; float* out; unsigned char* ws; int ph_lo, ph_hi; };

struct Ctx {
    LAS unsigned char* lds;
    int tid, lane, wave, G, bid, gw, ngw;
    unsigned char* ws;
};
__device__ __forceinline__ const float* lds_inp(LAS unsigned char* lds, int i) {
    const LAS unsigned* p = (const LAS unsigned*)(lds + LDS_PTAB) + 2 * i;
    const unsigned lo = __builtin_amdgcn_readfirstlane(p[0]), hi = __builtin_amdgcn_readfirstlane(p[1]);
    return (const float*)(const GAS float*)(((unsigned long long)hi << 32) | lo);
}
#define INP(i) lds_inp(C.lds, (i))
#define WSP(T_, off) ((T_*)(C.ws + (off)))
#define ARP(T_, off) ((T_*)(C.ws + WS_ARENA + (off)))
#define LDS_WAIT() asm volatile("s_waitcnt lgkmcnt(0)" ::: "memory")

__device__ __forceinline__ void rms_row_bf16(const float* xrow, const float* gain, bf16* orow, int lane) {
    f32x4 v[8]; float s = 0.f;
#pragma unroll
    for (int j = 0; j < 8; ++j) { v[j] = *(const f32x4*)(xrow + (j * 64 + lane) * 4); s += v[j].x * v[j].x + v[j].y * v[j].y + v[j].z * v[j].z + v[j].w * v[j].w; }
    const float rstd = rsqrtf(wave_sum(s) * (1.f / DM) + EPS);
#pragma unroll
    for (int j = 0; j < 8; ++j) { const f32x4 g = *(const f32x4*)(gain + (j * 64 + lane) * 4);
        u32x2 w; w.x = pk2(v[j].x * rstd * g.x, v[j].y * rstd * g.y); w.y = pk2(v[j].z * rstd * g.z, v[j].w * rstd * g.w);
        *(u32x2*)(orow + (j * 64 + lane) * 4) = w; }
}

template <int NT, class F>
__device__ __forceinline__ void transpose_tiles(const float* W, int ldw, int nvalid, int k0, int n0, bf16* WT, int ldt, F drow, int lane, const float* kscale) {
    const int g = lane >> 3, c = lane & 7; f32x4 v[NT][8];
#pragma unroll
    for (int q = 0; q < NT; ++q) { const int n = n0 + 32 * q + 4 * c; const bool ok = n < nvalid;
#pragma unroll
        for (int j = 0; j < 8; ++j) v[q][j] = ok ? *(const f32x4*)(W + (size_t)(k0 + 8 * g + j) * ldw + n) : (f32x4){0.f, 0.f, 0.f, 0.f}; }
    f32x4 ka = (f32x4){1.f, 1.f, 1.f, 1.f}, kb = ka;
    if (kscale) { ka = *(const f32x4*)(kscale + k0 + 8 * g); kb = *(const f32x4*)(kscale + k0 + 8 * g + 4); }
#pragma unroll
    for (int q = 0; q < NT; ++q) { const int n = n0 + 32 * q + 4 * c;
#pragma unroll
        for (int i = 0; i < 4; ++i) { u32x4 o; o.x = pk2(v[q][0][i] * ka.x, v[q][1][i] * ka.y); o.y = pk2(v[q][2][i] * ka.z, v[q][3][i] * ka.w); o.z = pk2(v[q][4][i] * kb.x, v[q][5][i] * kb.y); o.w = pk2(v[q][6][i] * kb.z, v[q][7][i] * kb.w);
            *(u32x4*)(WT + (size_t)drow(n + i) * ldt + k0 + 8 * g) = o; } }
}
template <class F>
__device__ __forceinline__ void transpose_tile(const float* W, int ldw, int nvalid, int k0, int n0, bf16* WT, int ldt, F drow, LAS float* scr, int lane, const float* kscale = nullptr) {
    (void)scr; transpose_tiles<1>(W, ldw, nvalid, k0, n0, WT, ldt, drow, lane, kscale);
}
template <class F>
__device__ __forceinline__ void transpose_matrix(const Ctx& C, const float* W, int K, int N, int Npad, bf16* WT, int ldt, F drow, LAS float* scr, const float* kscale = nullptr) {
    const int nblk = Npad / 32, items = (K / 64) * nblk;
    for (int it = C.gw; it < items; it += C.ngw) { const int kb = it / nblk, nb = it % nblk; transpose_tile(W, N, N, kb * 64, nb * 32, WT, ldt, drow, scr, C.lane, kscale); }
}

#define EPI_ARGS const f32x4 (&acc)[2][2][4][2], const pg8::Unit& u, int wr, int wc, int fr, int fq
struct EpiStoreBf16 {
    bf16* O; int ldc; float scale;
    __device__ __forceinline__ void operator()(EPI_ARGS) const {
        bf16* base = O + u.coff + (size_t)(wr * 64 + fr) * ldc + wc * 32 + 8 * fq;
#pragma unroll
        for (int ai = 0; ai < 2; ++ai)
#pragma unroll
            for (int m = 0; m < 4; ++m) { bf16* rowp = base + (size_t)(ai * 128 + m * 16) * ldc;
#pragma unroll
                for (int bj = 0; bj < 2; ++bj) { const f32x4 v0 = acc[ai][bj][m][0] * scale, v1 = acc[ai][bj][m][1] * scale;
                    u32x4 w; w.x = pg8::cvt_pk_bf16(v0[0], v0[1]); w.y = pg8::cvt_pk_bf16(v0[2], v0[3]); w.z = pg8::cvt_pk_bf16(v1[0], v1[1]); w.w = pg8::cvt_pk_bf16(v1[2], v1[3]);
                    *(u32x4*)(rowp + bj * 128) = w; } }
    }
};
struct EpiStoreF32 {
    float* O; int ldc;
    __device__ __forceinline__ void operator()(EPI_ARGS) const {
        float* base = O + u.coff + (size_t)(wr * 64 + fr) * ldc + wc * 32 + 8 * fq;
#pragma unroll
        for (int ai = 0; ai < 2; ++ai)
#pragma unroll
            for (int m = 0; m < 4; ++m) { float* rowp = base + (size_t)(ai * 128 + m * 16) * ldc;
#pragma unroll
                for (int bj = 0; bj < 2; ++bj) { *(f32x4*)(rowp + bj * 128) = acc[ai][bj][m][0]; *(f32x4*)(rowp + bj * 128 + 4) = acc[ai][bj][m][1]; } }
    }
};
template <bool BASE_F32> struct EpiResidT {
    const void* base; bf16* out; int ldc; float* rsq; LAS float* xch;
    __device__ __forceinline__ void operator()(EPI_ARGS) const {
        const size_t o0 = (size_t)u.coff + (size_t)(wr * 64 + fr) * ldc + wc * 32 + 8 * fq;
        u32x4 braw[BASE_F32 ? 1 : 16];
        if (!BASE_F32) {
#pragma unroll
            for (int ai = 0; ai < 2; ++ai)
#pragma unroll
                for (int m = 0; m < 4; ++m)
#pragma unroll
                    for (int bj = 0; bj < 2; ++bj) braw[(ai * 4 + m) * 2 + bj] = *(const u32x4*)((const bf16*)base + o0 + (size_t)(ai * 128 + m * 16) * ldc + bj * 128); }
#pragma unroll
        for (int ai = 0; ai < 2; ++ai)
#pragma unroll
            for (int m = 0; m < 4; ++m) { const size_t o = o0 + (size_t)(ai * 128 + m * 16) * ldc; float ssq = 0.f;
#pragma unroll
                for (int bj = 0; bj < 2; ++bj) { float bv[8];
                    if (BASE_F32) { const f32x4 b0 = *(const f32x4*)((const float*)base + o + bj * 128), b1 = *(const f32x4*)((const float*)base + o + bj * 128 + 4);
                        bv[0] = b0[0]; bv[1] = b0[1]; bv[2] = b0[2]; bv[3] = b0[3]; bv[4] = b1[0]; bv[5] = b1[1]; bv[6] = b1[2]; bv[7] = b1[3]; }
                    else unpack8(braw[BASE_F32 ? 0 : (ai * 4 + m) * 2 + bj], bv);
#pragma unroll
                    for (int j = 0; j < 4; ++j) { bv[j] += acc[ai][bj][m][0][j]; bv[4 + j] += acc[ai][bj][m][1][j]; }
                    const u32x4 w = pack8f(bv); *(u32x4*)(out + o + bj * 128) = w; float rf[8]; unpack8(w, rf);
#pragma unroll
                    for (int j = 0; j < 8; ++j) ssq += rf[j] * rf[j]; }
                ssq += xor16f(ssq); ssq += xor32f(ssq);
                if (fq == 0) xch[(ai * 128 + wr * 64 + m * 16 + fr) * 4 + wc] = ssq; }
        asm volatile("s_waitcnt lgkmcnt(0)" ::: "memory"); __builtin_amdgcn_s_barrier(); asm volatile("" ::: "memory");
        if (wc == 0 && fq == 0) {
#pragma unroll
            for (int ai = 0; ai < 2; ++ai)
#pragma unroll
                for (int m = 0; m < 4; ++m) { const int r = ai * 128 + wr * 64 + m * 16 + fr; const f32x4 p = *(const LAS f32x4*)(xch + r * 4); rsq[(size_t)(u.pm * 256 + r) * 8 + u.pn] = (p[0] + p[1]) + (p[2] + p[3]); } }
    }
};
__device__ __forceinline__ float rstd_of(float ssq) { return rsqrtf(ssq * (1.f / DM) + EPS); }
__device__ __forceinline__ float rstd_row(const float* rs8, int row) { const f32x4 a = *(const f32x4*)(rs8 + (size_t)row * 8), b = *(const f32x4*)(rs8 + (size_t)row * 8 + 4); return rstd_of(((a.x + a.y) + (a.z + a.w)) + ((b.x + b.y) + (b.z + b.w))); }
struct EpiStoreF32Rows {
    float* O; int ldc; const float* rs;
    __device__ __forceinline__ void operator()(EPI_ARGS) const {
        float* base = O + u.coff + (size_t)(wr * 64 + fr) * ldc + wc * 32 + 8 * fq; const int rp = u.pm * 256 + wr * 64 + fr;
#pragma unroll
        for (int ai = 0; ai < 2; ++ai)
#pragma unroll
            for (int m = 0; m < 4; ++m) { float* rowp = base + (size_t)(ai * 128 + m * 16) * ldc; const float r_ = rstd_row(rs, rp + ai * 128 + m * 16);
#pragma unroll
                for (int bj = 0; bj < 2; ++bj) { *(f32x4*)(rowp + bj * 128) = acc[ai][bj][m][0] * r_; *(f32x4*)(rowp + bj * 128 + 4) = acc[ai][bj][m][1] * r_; } }
    }
};
struct EpiSoftmaxP {
    bf16* P; int ldc; const float* rs; LAS float* xch;
    __device__ __forceinline__ void operator()(f32x4 (&acc)[2][2][4][2], const pg8::Unit& u, int wr, int wc, int fr, int fq) const {
#pragma unroll
        for (int ai = 0; ai < 2; ++ai)
#pragma unroll
            for (int m = 0; m < 4; ++m) { const int r = ai * 128 + wr * 64 + m * 16 + fr; const float r_ = rstd_row(rs, u.pm * 256 + r); float mx = -INFINITY;
#pragma unroll
                for (int bj = 0; bj < 2; ++bj)
#pragma unroll
                    for (int n = 0; n < 2; ++n) { acc[ai][bj][m][n] = acc[ai][bj][m][n] * r_;
#pragma unroll
                        for (int j = 0; j < 4; ++j) mx = fmaxf(mx, acc[ai][bj][m][n][j]); }
                mx = fmaxf(mx, xor16f(mx)); mx = fmaxf(mx, xor32f(mx)); if (fq == 0) xch[r * 4 + wc] = mx; }
        asm volatile("s_waitcnt lgkmcnt(0)" ::: "memory"); __builtin_amdgcn_s_barrier(); asm volatile("" ::: "memory");
#pragma unroll
        for (int ai = 0; ai < 2; ++ai)
#pragma unroll
            for (int m = 0; m < 4; ++m) { const int r = ai * 128 + wr * 64 + m * 16 + fr; const f32x4 mv = *(const LAS f32x4*)(xch + r * 4); const float mx = fmaxf(fmaxf(mv[0], mv[1]), fmaxf(mv[2], mv[3])); float sm_ = 0.f;
#pragma unroll
                for (int bj = 0; bj < 2; ++bj)
#pragma unroll
                    for (int n = 0; n < 2; ++n)
#pragma unroll
                        for (int j = 0; j < 4; ++j) { const float e = __expf(acc[ai][bj][m][n][j] - mx); acc[ai][bj][m][n][j] = e; sm_ += e; }
                sm_ += xor16f(sm_); sm_ += xor32f(sm_); if (fq == 0) xch[1024 + r * 4 + wc] = sm_; }
        asm volatile("s_waitcnt lgkmcnt(0)" ::: "memory"); __builtin_amdgcn_s_barrier(); asm volatile("" ::: "memory");
        bf16* base = P + u.coff + (size_t)(wr * 64 + fr) * ldc + wc * 32 + 8 * fq;
#pragma unroll
        for (int ai = 0; ai < 2; ++ai)
#pragma unroll
            for (int m = 0; m < 4; ++m) { const int r = ai * 128 + wr * 64 + m * 16 + fr; const f32x4 sv = *(const LAS f32x4*)(xch + 1024 + r * 4); const float inv = 1.f / ((sv[0] + sv[1]) + (sv[2] + sv[3]));
                bf16* rowp = base + (size_t)(ai * 128 + m * 16) * ldc;
#pragma unroll
                for (int bj = 0; bj < 2; ++bj) { const f32x4 v0 = acc[ai][bj][m][0] * inv, v1 = acc[ai][bj][m][1] * inv;
                    u32x4 w; w.x = pg8::cvt_pk_bf16(v0[0], v0[1]); w.y = pg8::cvt_pk_bf16(v0[2], v0[3]); w.z = pg8::cvt_pk_bf16(v1[0], v1[1]); w.w = pg8::cvt_pk_bf16(v1[2], v1[3]);
                    *(u32x4*)(rowp + bj * 128) = w; } }
    }
};
struct EpiAbIn {
    bf16* P; float* G32;
    __device__ __forceinline__ void operator()(EPI_ARGS) const {
        const int row0 = u.pm * 256 + wr * 64 + fr, col0 = u.pn * 256 + wc * 32 + 8 * fq;
#pragma unroll
        for (int ai = 0; ai < 2; ++ai)
#pragma unroll
            for (int m = 0; m < 4; ++m) { const int row = row0 + ai * 128 + m * 16; bf16* rowp = P + (size_t)row * AB_PAD + col0;
#pragma unroll
                for (int bj = 0; bj < 2; ++bj) { const f32x4 v0 = acc[ai][bj][m][0], v1 = acc[ai][bj][m][1];
                    u32x4 w; w.x = pg8::cvt_pk_bf16(v0[0], v0[1]); w.y = pg8::cvt_pk_bf16(v0[2], v0[3]); w.z = pg8::cvt_pk_bf16(v1[0], v1[1]); w.w = pg8::cvt_pk_bf16(v1[2], v1[3]);
                    *(u32x4*)(rowp + bj * 128) = w;
                    if (u.pn == 12) { float* g = G32 + (size_t)row * 256 + wc * 32 + 8 * fq + bj * 128; *(f32x4*)g = v0; *(f32x4*)(g + 4) = v1; } } }
    }
};
struct EpiLora {
    const float *w0, *a0, *k_a; const bf16 *KK, *KR; float* WD; bf16 *BV, *KP, *GG;
    __device__ __forceinline__ void operator()(EPI_ARGS) const {
        const int grp = u.pn >> 2, row0 = u.pm * 256 + wr * 64 + fr, cc0 = (u.pn & 3) * 256 + wc * 32 + 8 * fq;
#pragma unroll
        for (int ai = 0; ai < 2; ++ai)
#pragma unroll
            for (int m = 0; m < 4; ++m) { const size_t ro = (size_t)(row0 + ai * 128 + m * 16) * 1024;
#pragma unroll
                for (int bj = 0; bj < 2; ++bj) { const int cc = cc0 + bj * 128; float v[8];
#pragma unroll
                    for (int j = 0; j < 4; ++j) { v[j] = acc[ai][bj][m][0][j]; v[4 + j] = acc[ai][bj][m][1][j]; }
                    if (grp == 0) { float o[8]; const f32x4 p0 = *(const f32x4*)(w0 + cc), p1 = *(const f32x4*)(w0 + cc + 4); const float pw[8] = {p0.x, p0.y, p0.z, p0.w, p1.x, p1.y, p1.z, p1.w};
#pragma unroll
                        for (int j = 0; j < 8; ++j) o[j] = -0.6065306597126334f * sigmoidf_(pw[j] + v[j]);
                        *(f32x4*)(WD + ro + cc) = (f32x4){o[0], o[1], o[2], o[3]}; *(f32x4*)(WD + ro + cc + 4) = (f32x4){o[4], o[5], o[6], o[7]};
                    } else if (grp == 1) { float kk[8], kr[8], ob[8], ok[8];
                        unpack8(*(const u32x4*)(KK + ro + cc), kk); unpack8(*(const u32x4*)(KR + ro + cc), kr);
                        const f32x4 p0 = *(const f32x4*)(a0 + cc), p1 = *(const f32x4*)(a0 + cc + 4), q0 = *(const f32x4*)(k_a + cc), q1 = *(const f32x4*)(k_a + cc + 4);
                        const float pa[8] = {p0.x, p0.y, p0.z, p0.w, p1.x, p1.y, p1.z, p1.w}, qa[8] = {q0.x, q0.y, q0.z, q0.w, q1.x, q1.y, q1.z, q1.w};
#pragma unroll
                        for (int j = 0; j < 8; ++j) { const float a = sigmoidf_(pa[j] + v[j]); ob[j] = kk[j] * a; ok[j] = kr[j] * (1.f + (a - 1.f) * qa[j]); }
                        st16_f(BV + ro + cc, pack8f(ob)); st16_f(KP + ro + cc, pack8f(ok));
                    } else { st16_f(GG + ro + cc, pack8f(v)); } } }
    }
};
struct EpiHid {
    bf16* H; const int* rowslot; const float* rs;
    __device__ __forceinline__ void operator()(EPI_ARGS) const {
        bf16* base = H + (size_t)(u.aux + wr * 64 + fr) * FF + u.pn * 128 + wc * 32 + 8 * fq;
#pragma unroll
        for (int ai = 0; ai < 2; ++ai)
#pragma unroll
            for (int m = 0; m < 4; ++m) { float h[8]; const int r = ai * 128 + wr * 64 + m * 16 + fr; const float r_ = (r < u.pm) ? rstd_row(rs, rowslot[u.aux + r] >> 1) : 0.f;
#pragma unroll
                for (int j = 0; j < 4; ++j) { h[j] = siluf_(acc[ai][0][m][0][j] * r_) * (acc[ai][1][m][0][j] * r_); h[4 + j] = siluf_(acc[ai][0][m][1][j] * r_) * (acc[ai][1][m][1][j] * r_); }
                *(u32x4*)(base + (size_t)(ai * 128 + m * 16) * FF) = pack8f(h); }
    }
};
struct EpiMoeDown {
    const int* rowslot; const float* wts; bf16* YE;
    __device__ __forceinline__ void operator()(EPI_ARGS) const {
#pragma unroll
        for (int ai = 0; ai < 2; ++ai)
#pragma unroll
            for (int m = 0; m < 4; ++m) { const int r = ai * 128 + wr * 64 + m * 16 + fr;
                if (r < u.pm) { const int slot = rowslot[u.aux + r]; const float w = wts[slot]; bf16* rowp = YE + (size_t)slot * DM + u.pn * 256 + wc * 32 + 8 * fq;
#pragma unroll
                    for (int bj = 0; bj < 2; ++bj) { const f32x4 v0 = acc[ai][bj][m][0] * w, v1 = acc[ai][bj][m][1] * w;
                        u32x4 o; o.x = pg8::cvt_pk_bf16(v0[0], v0[1]); o.y = pg8::cvt_pk_bf16(v0[2], v0[3]); o.z = pg8::cvt_pk_bf16(v1[0], v1[1]); o.w = pg8::cvt_pk_bf16(v1[2], v1[3]);
                        *(u32x4*)(rowp + bj * 128) = o; } } }
    }
};
struct EpiNsaIn {
    bf16 *Q, *QROT, *KV6; float* GATES; const float *gate_b, *rcos, *rsin, *rs;
    __device__ __forceinline__ void operator()(EPI_ARGS) const {
        const int pn = u.pn;
#pragma unroll
        for (int ai = 0; ai < 2; ++ai)
#pragma unroll
            for (int m = 0; m < 4; ++m) { const int t = u.pm * 256 + ai * 128 + wr * 64 + m * 16 + fr, b = t >> 12, s = t & 4095; const float r_ = rstd_row(rs, t);
#pragma unroll
                for (int bj = 0; bj < 2; ++bj) { float v[8];
#pragma unroll
                    for (int j = 0; j < 4; ++j) { v[j] = acc[ai][bj][m][0][j] * r_; v[4 + j] = acc[ai][bj][m][1][j] * r_; }
                    const int d0 = wc * 32 + 8 * fq;
                    if (pn == 20) {
                        const int c = bj * 128 + d0;
                        if (c < 48) { float o[8];
#pragma unroll
                            for (int j = 0; j < 8; ++j) o[j] = sigmoidf_(v[j] + gate_b[c + j]);
                            float* g = GATES + (size_t)t * 48 + c; *(f32x4*)g = (f32x4){o[0], o[1], o[2], o[3]}; *(f32x4*)(g + 4) = (f32x4){o[4], o[5], o[6], o[7]}; }
                        continue; }
                    float vr[8];
#pragma unroll
                    for (int j = 0; j < 8; ++j) vr[j] = v[j];
                    if (wc == 0) { float pv[8];
#pragma unroll
                      for (int j = 0; j < 8; ++j) pv[j] = xor32f(v[j]);
                      const f32x4 c0 = *(const f32x4*)(rcos + s * 16 + 8 * (fq & 1)), c1 = *(const f32x4*)(rcos + s * 16 + 8 * (fq & 1) + 4), s0 = *(const f32x4*)(rsin + s * 16 + 8 * (fq & 1)), s1 = *(const f32x4*)(rsin + s * 16 + 8 * (fq & 1) + 4);
                      const float cs[8] = {c0.x, c0.y, c0.z, c0.w, c1.x, c1.y, c1.z, c1.w}, sn[8] = {s0.x, s0.y, s0.z, s0.w, s1.x, s1.y, s1.z, s1.w};
#pragma unroll
                      for (int j = 0; j < 8; ++j) vr[j] = (fq < 2) ? (v[j] * cs[j] - pv[j] * sn[j]) : (v[j] * cs[j] + pv[j] * sn[j]); }
                    if (pn < 8) { const int hh = pn * 2 + bj; const size_t o = (((size_t)(b * 16 + hh)) * SEQ + s) * 128 + d0;
                        *(u32x4*)(Q + o) = pack8f(v); *(u32x4*)(QROT + o) = pack8f(vr);
                    } else { const int i6 = (pn - 8) >> 1, g = ((pn - 8) & 1) * 2 + bj; const bool rot = (i6 == 2 || i6 == 4) && wc == 0;
                        bf16* dst = (bf16*)((unsigned char*)KV6 + (size_t)i6 * KV6_STRIDE) + (((size_t)(b * 4 + g)) * SPAD + s) * 128 + d0;
                        *(u32x4*)dst = rot ? pack8f(vr) : pack8f(v); } } }
    }
};

constexpr int MOE_CVT_TOTAL = 2 * NEXP * 3 * 512, MOE_CVT_SIDE_A = 0, MOE_CVT_SIDE_B = 28000, MOE_CVT_WG = 32, MOE_CVT_SIDE_C = 4096 * 8 * 2, MOE_CVT_SIDE_F = 1024 * 8 * 2, MOE_CVT_SIDE_G = 0  , MOE_CVT_SIDE_E = 2048 * 8 * 2, MOE_CVT_SIDE_H2 = 13000  , MOE_CVT_SIDE_H = 22000  ;
#define MOE_CVT_PROLOGUE_END(G_) ((G_) == 256 ? MOE_CVT_TOTAL - MOE_CVT_SIDE_A - MOE_CVT_SIDE_B - MOE_CVT_SIDE_C - MOE_CVT_SIDE_F - MOE_CVT_SIDE_G - MOE_CVT_SIDE_E - MOE_CVT_SIDE_H - MOE_CVT_SIDE_H2 : MOE_CVT_TOTAL)
#define MOE_CVT_BASE_C MOE_CVT_PROLOGUE_END(256)
#define MOE_CVT_BASE_F (MOE_CVT_BASE_C + MOE_CVT_SIDE_C)
#define MOE_CVT_BASE_G (MOE_CVT_BASE_F + MOE_CVT_SIDE_F)
#define MOE_CVT_BASE_E (MOE_CVT_BASE_G + MOE_CVT_SIDE_G)
#define MOE_CVT_BASE_H (MOE_CVT_BASE_E + MOE_CVT_SIDE_E)
#define MOE_CVT_BASE_H2 (MOE_CVT_BASE_H + MOE_CVT_SIDE_H)
static_assert(MOE_CVT_BASE_E >= MOE_CVT_TOTAL / 2 && MOE_CVT_BASE_H2 + MOE_CVT_SIDE_H2 + MOE_CVT_SIDE_A + MOE_CVT_SIDE_B == MOE_CVT_TOTAL && MOE_CVT_SIDE_H % 2 == 0 && MOE_CVT_SIDE_H2 % 2 == 0 && MOE_CVT_BASE_C % 2 == 0, "MoE conversion item ranges");
__device__ __forceinline__ void moe_convert_pair(const Ctx& C, int it, int lane) {
    auto ident = [](int n) { return n; };
    auto dg = [](int n) { return (n >> 7) * 256 + (n & 127); };
    auto du = [](int n) { return (n >> 7) * 256 + 128 + (n & 127); };
    const int per = 512;
    const int le = it / (3 * per), r = it % (3 * per), which = r / per, q = r % per;
    if (which == 0) { const int kb = q / 16, nb = q % 16; transpose_tiles<2>(INP(I_MOE_W_GATE) + (size_t)le * DM * FF, FF, FF, kb * 64, nb * 32, WSP(bf16, WS_W_GU) + (size_t)le * 1024 * DM, DM, dg, lane, INP(I_NORM_FFN) + (le >> 6) * DM); }
    else if (which == 1) { const int kb = q / 16, nb = q % 16; transpose_tiles<2>(INP(I_MOE_W_UP) + (size_t)le * DM * FF, FF, FF, kb * 64, nb * 32, WSP(bf16, WS_W_GU) + (size_t)le * 1024 * DM, DM, du, lane, INP(I_NORM_FFN) + (le >> 6) * DM); }
    else { const int kb = q / 64, nb = q % 64; transpose_tiles<2>(INP(I_MOE_W_DOWN) + (size_t)le * FF * DM, DM, DM, kb * 64, nb * 32, WSP(bf16, WS_W_DN) + (size_t)le * DM * FF, FF, ident, lane, nullptr); }
}
struct MoeTile { const float* W; bf16* WT; const float* ks; int ldw, ldt, k0, n0, mode; };
__device__ __forceinline__ MoeTile moe_tile_decode(const Ctx& C, int it) {
    const int per = 512, le = it / (3 * per), r = it % (3 * per), which = r / per, q = r % per; MoeTile t; t.mode = which;
    if (which < 2) { t.W = INP(which ? I_MOE_W_UP : I_MOE_W_GATE) + (size_t)le * DM * FF; t.ldw = FF; t.k0 = (q / 16) * 64; t.n0 = (q % 16) * 32; t.WT = WSP(bf16, WS_W_GU) + (size_t)le * 1024 * DM; t.ldt = DM; t.ks = INP(I_NORM_FFN) + (le >> 6) * DM; }
    else { t.W = INP(I_MOE_W_DOWN) + (size_t)le * FF * DM; t.ldw = DM; t.k0 = (q / 64) * 64; t.n0 = (q % 64) * 32; t.WT = WSP(bf16, WS_W_DN) + (size_t)le * DM * FF; t.ldt = FF; t.ks = nullptr; }
    return t;
}
__device__ __forceinline__ void moe_pair_load(const MoeTile& t, f32x4 (&v)[2][8], int lane) {
    const int g = lane >> 3, c = lane & 7;
#pragma unroll
    for (int q = 0; q < 2; ++q)
#pragma unroll
        for (int j = 0; j < 8; ++j) v[q][j] = __builtin_nontemporal_load((const f32x4*)(t.W + (size_t)(t.k0 + 8 * g + j) * t.ldw + t.n0 + 32 * q + 4 * c));
}
__device__ __forceinline__ void moe_pair_store(const MoeTile& t, const f32x4 (&v)[2][8], int lane) {
    const int g = lane >> 3, c = lane & 7; f32x4 ka = (f32x4){1.f, 1.f, 1.f, 1.f}, kb = ka;
    if (t.ks) { ka = *(const f32x4*)(t.ks + t.k0 + 8 * g); kb = *(const f32x4*)(t.ks + t.k0 + 8 * g + 4); }
#pragma unroll
    for (int q = 0; q < 2; ++q)
#pragma unroll
        for (int i = 0; i < 4; ++i) { const int nn = t.n0 + 32 * q + 4 * c + i, dr = (t.mode == 2) ? nn : ((nn >> 7) * 256 + (t.mode == 1 ? 128 : 0) + (nn & 127));
            u32x4 o; o.x = pk2(v[q][0][i] * ka.x, v[q][1][i] * ka.y); o.y = pk2(v[q][2][i] * ka.z, v[q][3][i] * ka.w); o.z = pk2(v[q][4][i] * kb.x, v[q][5][i] * kb.y); o.w = pk2(v[q][6][i] * kb.z, v[q][7][i] * kb.w);
            __builtin_nontemporal_store(o, (u32x4*)(t.WT + (size_t)dr * t.ldt + t.k0 + 8 * g)); }
}
__device__ __forceinline__ void moe_convert_items(const Ctx& C, int lo, int hi, int widx, int nworkers) {
    for (int it = lo + 2 * widx; it < hi; it += 2 * nworkers) moe_convert_pair(C, it, C.lane);
}
__device__ __forceinline__ void moe_convert_items_x2(const Ctx& C, int lo, int hi, int widx, int nworkers) {
    int it = lo + 2 * widx; const int st = 2 * nworkers;
    for (; it + st < hi; it += 2 * st) {
        f32x4 va[2][8], vb[2][8]; const MoeTile ta = moe_tile_decode(C, it), tb = moe_tile_decode(C, it + st);
        moe_pair_load(ta, va, C.lane); moe_pair_load(tb, vb, C.lane);
        moe_pair_store(ta, va, C.lane); moe_pair_store(tb, vb, C.lane);
    }
    for (; it < hi; it += st) moe_convert_pair(C, it, C.lane);
}
__device__ __forceinline__ void phase_prologue(const Ctx& C, const Args& A) {
    LAS float* scr = (LAS float*)(C.lds + C.wave * 8448);
    auto ident = [](int n) { return n; };
    transpose_matrix(C, INP(I_AB_W_IN), DM, AB_COLS, AB_PAD, WSP(bf16, WS_W_ABIN), DM, ident, scr);
    transpose_matrix(C, INP(I_AB_W_OUT), DM, DM, DM, WSP(bf16, WS_W_ABOUT), DM, ident, scr);
    transpose_matrix(C, INP(I_NSA_W_IN), DM, NSA_COLS, NSA_PAD, WSP(bf16, WS_W_NSAIN), DM, ident, scr, INP(I_NORM_MIX) + DM);
    transpose_matrix(C, INP(I_NSA_W_OUT), DM, DM, DM, WSP(bf16, WS_W_NSAOUT), DM, ident, scr);
    for (int l = 0; l < 2; ++l) {
        transpose_matrix(C, INP(I_CA_WK) + (size_t)l * DM * DM, DM, DM, DM, WSP(bf16, WS_W_CAK) + (size_t)l * DM * DM, DM, ident, scr);
        transpose_matrix(C, INP(I_CA_WV) + (size_t)l * DM * DM, DM, DM, DM, WSP(bf16, WS_W_CAV) + (size_t)l * DM * DM, DM, ident, scr);
        transpose_matrix(C, INP(I_CA_WO) + (size_t)l * DM * DM, DM, DM, DM, WSP(bf16, WS_W_CAO) + (size_t)l * DM * DM, DM, ident, scr);
    }
    for (int kv = 0; kv < 2; ++kv)
        transpose_matrix(C, INP(I_CMP_W1) + (size_t)kv * 4096 * 128, 4096, 128, 128, WSP(bf16, WS_W_CMP1) + (size_t)kv * 256 * 4096, 4096, ident, scr);
    moe_convert_items(C, 0, MOE_CVT_PROLOGUE_END(C.G), C.gw, C.ngw);
    const size_t gt = (size_t)C.bid * NTHR + C.tid, gn = (size_t)C.G * NTHR;
    { const float* src = INP(I_CA_WQ); bf16* dst = WSP(bf16, WS_W_CAQ);
      const float* gc = INP(I_NORM_CROSS);
      for (size_t i = gt; i < (size_t)2 * DM * DM / 4; i += gn) { const f32x4 v = *(const f32x4*)(src + i * 4); const float gq = gc[(i * 4) / DM]; u32x2 w; w.x = pk2(v.x * gq, v.y * gq); w.y = pk2(v.z * gq, v.w * gq); *(u32x2*)(dst + i * 4) = w; } }
    { bf16* dst = WSP(bf16, WS_W_LORA);
      for (size_t i = gt; i < (size_t)3072 * 256; i += gn) { const int n = (int)(i >> 8), k = (int)(i & 255); float v = 0.f;
          if (n < 1024) { if (k < 64) v = INP(I_RW_W_UP)[k * 1024 + n]; }
          else if (n < 2048) { if (k >= 64 && k < 128) v = INP(I_RW_A_UP)[(k - 64) * 1024 + (n - 1024)]; }
          else { if (k >= 128) v = INP(I_RW_G_UP)[(k - 128) * 1024 + (n - 2048)]; }
          dst[i] = (bf16)f2bf(v); } }
    { bf16* dst = WSP(bf16, WS_W_ROUTER);
      for (size_t i = gt; i < (size_t)2 * 256 * DM; i += gn) { const int l = (int)(i / (256 * DM)), n = (int)((i / DM) & 255), k = (int)(i % DM); float v = 0.f;
          if (n < 8) v = INP(I_MOE_WG)[((size_t)l * DM + k) * 8 + n]; else if (n < 72) v = INP(I_MOE_WE)[((size_t)l * DM + k) * 64 + (n - 8)];
          v *= INP(I_NORM_FFN)[l * DM + k];
          dst[i] = (bf16)f2bf(v); } }
    { float* rc = WSP(float, WS_TAB + TAB_ROPE_COS); float* rs = WSP(float, WS_TAB + TAB_ROPE_SIN);
      for (size_t i = gt; i < (size_t)SEQ * 16; i += gn) { const int pos = (int)(i >> 4), j = (int)(i & 15);
          const float inv = 1.0f / powf(500000.0f, (float)j / 16.0f); const float ang = (float)pos * inv; rc[i] = cosf(ang); rs[i] = sinf(ang); } }
    for (int w_ = C.gw; w_ < 2048; w_ += C.ngw) { const int o = w_ & 255, part = w_ >> 8, kv = o >> 7, e = o & 127; float s = 0.f;
#pragma unroll
        for (int j = 0; j < 8; ++j) { const int i = part * 512 + j * 64 + C.lane; s += INP(I_CMP_POS)[kv * 4096 + i] * INP(I_CMP_W1)[((size_t)kv * 4096 + i) * 128 + e]; }
        s = wave_sum(s); if (C.lane == 0) WSP(float, WS_TAB + TAB_CMPBIAS)[part * 256 + o] = s; }
    for (int r = C.gw; r < 2 * MT; r += C.ngw) { const int l = r / MT, m = r % MT;
        rms_row_bf16(INP(I_MEM) + (size_t)m * DM, INP(I_NORM_MEM) + l * DM, WSP(bf16, WS_MEMN) + ((size_t)l * MT + m) * DM, C.lane); }
    for (int r = C.gw; r < T; r += C.ngw) rms_row_bf16(INP(I_X) + (size_t)r * DM, INP(I_NORM_MIX), WSP(bf16, WS_XN) + (size_t)r * DM, C.lane);
}

struct MemProjOrder {
    int G, c;
    __device__ __forceinline__ bool next(int i, pg8::Unit& u) const {
        const int L = i * G + c; if (L >= 128) return false;
        const int pn = L & 7, pm = (L >> 3) & 3, kv = (L >> 5) & 1, l = L >> 6;
        u.pm = pm; u.pn = pn; u.aux = 0;
        u.aoff = ((long long)l * MT + pm * 256) * DM * 2;
        u.boff = ((long long)(kv ? (WS_W_CAV - WS_W_CAK) / 2 : 0) + ((long long)l * DM + pn * 256) * DM) * 2;
        u.coff = (long long)(kv ? (WS_VP - WS_KP) / 2 : 0) + ((long long)l * MT + pm * 256) * DM + pn * 256;
        return true;
    }
};
struct AbInMemOrder {
    pg8::DenseOrder d; MemProjOrder m;
    __device__ __forceinline__ bool next(int i, pg8::Unit& u) const {
        const long L = (long)i * d.G + d.c;
        if (L < (T / 256) * (AB_PAD / 256)) { int pm, pn; pg8::tile_of(L, d.nM, d.nN, pm, pn); u.pm = pm; u.pn = pn; u.aux = 0; u.aoff = (long long)WS_XN + pm * d.astep; u.boff = (long long)WS_W_ABIN + pn * d.bstep; u.coff = 0; return true; }
        pg8::Unit t; MemProjOrder mm{1 << 30, (int)(L - (T / 256) * (AB_PAD / 256))}; if (!mm.next(0, t)) return false;
        u = t; u.aux = 1; u.aoff += (long long)WS_MEMN; u.boff += (long long)WS_W_CAK; return true;
    }
};
struct EpiAbInMem { EpiAbIn a; EpiStoreBf16 m;
    __device__ __forceinline__ void operator()(EPI_ARGS) const { if (u.aux == 0) a(acc, u, wr, wc, fr, fq); else m(acc, u, wr, wc, fr, fq); } };
struct RouterOrder {
    int G, c;
    __device__ __forceinline__ bool next(int i, pg8::Unit& u) const {
        const int L = i * G + c; if (L >= 256) return false;
        const int pm = L & 63, ks = L >> 6; u.pm = pm; u.pn = 0; u.aux = ks;
        u.aoff = ((long long)pm * 256 * DM + ks * 512) * 2; u.boff = (long long)ks * 512 * 2; u.coff = ((long long)ks * T + pm * 256) * 256; return true;
    }
};
struct WktOrder {
    int G, c;
    __device__ __forceinline__ bool next(int i, pg8::Unit& u) const {
        const int L = i * G + c; if (L >= 256) return false;
        const int pn = L & 7, h = (L >> 3) & 3, b = (L >> 5) & 3, l = L >> 7;
        u.pm = 0; u.pn = pn; u.aux = 0;
        u.aoff = (((long long)l * MT + b * 256) * DM + h * 512) * 2;
        u.boff = (((long long)l * DM + pn * 256) * DM + h * 512) * 2;
        u.coff = (((long long)(l * 4 + b) * 1024) + h * 256) * DM + pn * 256;
        return true;
    }
};
struct VwtOrder {
    int G, c;
    __device__ __forceinline__ bool next(int i, pg8::Unit& u) const {
        const int L = i * G + c; if (L >= 256) return false;
        const int pm = L & 7, h = (L >> 3) & 3, b = (L >> 5) & 3, l = L >> 7;
        u.pm = pm; u.pn = 0; u.aux = 0;
        u.aoff = (((long long)l * DM + pm * 256) * DM + h * 512) * 2;
        u.boff = (((long long)l * MT + b * 256) * DM + h * 512) * 2;
        u.coff = (((long long)(l * 4 + b) * DM) + pm * 256) * 1024 + h * 256;
        return true;
    }
};
struct CrossOrder {
    int nN, G, c, ldc; long long astep, bstep, bbatch;
    __device__ __forceinline__ bool next(int i, pg8::Unit& u) const {
        int pm, pn; if (!pg8::tile_of((long)i * G + c, T / 256, nN, pm, pn)) return false;
        u.pm = pm; u.pn = pn; u.aux = 0; u.aoff = pm * astep; u.boff = (pm >> 4) * bbatch + pn * bstep; u.coff = (long long)pm * 256 * ldc + pn * 256; return true;
    }
};
struct CmpOrder {
    int G, c;
    __device__ __forceinline__ bool next(int i, pg8::Unit& u) const {
        const int L = i * G + c; if (L >= 256) return false;
        const int bg = L & 15, kv = (L >> 4) & 1, ks = L >> 5;
        u.pm = 0; u.pn = 0; u.aux = 0;
        u.aoff = (long long)kv * KV6_STRIDE + ((long long)bg * SPAD * 128 + ks * 512) * 2;
        u.boff = ((long long)kv * 256 * 4096 + ks * 512) * 2;
        u.coff = ((long long)(ks * 2 + kv) * 16 + bg) * 65536;
        return true;
    }
};
struct MoeOrder {
    const LAS int* tab; int npn, G, c, which;
    __device__ __forceinline__ bool next(int i, pg8::Unit& u) const {
        const int L = i * G + c, ntile = tab[64]; if (L >= ntile * npn) return false;
        const int tix = L / npn, pn = L % npn; int e = 0;
        for (int k = 32; k >= 1; k >>= 1) if (e + k < 64 && tab[e + k] <= tix) e += k;
        while (tab[e + 1] <= tix) ++e;
        const int mt = tix - tab[e], cnt = tab[65 + e], row0 = tab[129 + e] + mt * 256;
        u.pm = min(256, cnt - mt * 256); u.pn = pn; u.aux = row0;
        if (which == 0) { u.aoff = 0; u.boff = ((long long)e * 1024 + pn * 256) * DM * 2; }
        else { u.aoff = (long long)row0 * FF * 2; u.boff = ((long long)e * DM + pn * 256) * FF * 2; }
        u.coff = 0; return true;
    }
};
__device__ __forceinline__ int wave_incl_scan_i(int v, int lane) {
#pragma unroll
    for (int d = 1; d < 64; d <<= 1) { const int t = __shfl_up(v, d, 64); if (lane >= d) v += t; }
    return v;
}
__device__ __forceinline__ void moe_build_table(const Ctx& C, const unsigned* cnt, LAS int* tab) {
    if (C.tid < 64) { const int e = C.tid, n = (int)cnt[e], nt = (n + 255) >> 8; const int inc = wave_incl_scan_i(nt, e), ts = inc - nt;
        tab[e] = ts; tab[65 + e] = n; tab[129 + e] = ts * 256; if (e == 63) tab[64] = inc; }
    __syncthreads();
}

__device__ __forceinline__ float log_sigmoidf_(float x) { return fminf(x, 0.f) - log1pf(__expf(-fabsf(x))); }
__device__ __forceinline__ void phase_mixer_prep(const Ctx& C, const Args& A) {
    const bf16* PAB = ARP(bf16, A_PAB); const float* G32 = ARP(float, A_GF32);
    bf16 *QM = ARP(bf16, A_QM), *KM = ARP(bf16, A_KM), *RR = ARP(bf16, A_RR), *KR = ARP(bf16, A_KR), *VR = ARP(bf16, A_VR), *KK = ARP(bf16, A_KK), *LIN = ARP(bf16, A_LIN);
    float *IG = ARP(float, A_IG), *LF = ARP(float, A_LF);
    const float *cw = INP(I_ML_CONV_W), *cb = INP(I_ML_CONV_B), *gb = INP(I_ML_GATE_B), *mu = INP(I_RW_MU), *k_k = INP(I_RW_K_K);
    const int lane = C.lane;
    for (int t = C.gw; t < T; t += C.ngw) {
        const int b = t >> 12, s = t & 4095; const bf16* P = PAB + (size_t)t * AB_PAD; const bf16* PR = P + ML_COLS;
        u32x4 cx[2][4], pc[7], pq[7]; const u32x4 z4 = (u32x4){0u, 0u, 0u, 0u};
#pragma unroll
        for (int it = 0; it < 2; ++it)
#pragma unroll
            for (int tap = 0; tap < 4; ++tap) { const int back = 3 - tap; cx[it][tap] = z4; if (s >= back) cx[it][tap] = *(const u32x4*)(P - (size_t)back * AB_PAD + (lane + 64 * it) * 8); }
#pragma unroll
        for (int it = 0; it < 7; ++it) { const int chunk = lane + 64 * it; pc[it] = z4; pq[it] = z4;
            if (chunk < 416) { pc[it] = *(const u32x4*)(PR + chunk * 8); if (s > 0) pq[it] = *(const u32x4*)(PR - AB_PAD + chunk * 8); } }
#pragma unroll
        for (int it = 0; it < 2; ++it) { const int c = (lane + 64 * it) * 8; float y[8];
            { const f32x4 b0 = *(const f32x4*)(cb + c), b1 = *(const f32x4*)(cb + c + 4); y[0] = b0.x; y[1] = b0.y; y[2] = b0.z; y[3] = b0.w; y[4] = b1.x; y[5] = b1.y; y[6] = b1.z; y[7] = b1.w; }
#pragma unroll
            for (int tap = 0; tap < 4; ++tap) { float xv[8]; unpack8(cx[it][tap], xv);
                const f32x4 w0 = *(const f32x4*)(cw + tap * 1024 + c), w1 = *(const f32x4*)(cw + tap * 1024 + c + 4);
                y[0] += xv[0] * w0.x; y[1] += xv[1] * w0.y; y[2] += xv[2] * w0.z; y[3] += xv[3] * w0.w; y[4] += xv[4] * w1.x; y[5] += xv[5] * w1.y; y[6] += xv[6] * w1.z; y[7] += xv[7] * w1.w; }
#pragma unroll
            for (int j = 0; j < 8; ++j) y[j] = siluf_(y[j]);
            if (c < 512) *(u32x4*)(QM + (size_t)t * 512 + c) = pack8f(y); else *(u32x4*)(KM + (size_t)t * 512 + c - 512) = pack8f(y); }
        if (lane < 8) { const float g = G32[(size_t)t * 256 + lane] + gb[lane];
            if (lane < 4) IG[(size_t)(b * 4 + lane) * SEQ + s] = g; else LF[(size_t)(b * 4 + lane - 4) * SEQ + s] = log_sigmoidf_(g); }
#pragma unroll
        for (int it = 0; it < 7; ++it) { const int chunk = lane + 64 * it; if (chunk >= 416) break; const int cc = chunk * 8;
            float p[8], pp[8], mx[8]; unpack8(pc[it], p); unpack8(pq[it], pp);
            { const f32x4 m0 = *(const f32x4*)(mu + cc), m1 = *(const f32x4*)(mu + cc + 4); const float mf[8] = {m0.x, m0.y, m0.z, m0.w, m1.x, m1.y, m1.z, m1.w};
#pragma unroll
              for (int j = 0; j < 8; ++j) mx[j] = p[j] + (pp[j] - p[j]) * mf[j]; }
            if (it < 2) *(u32x4*)(RR + (size_t)t * 1024 + cc) = pack8f(mx);
            else if (it < 4) { const int ck = cc - 1024; *(u32x4*)(KR + (size_t)t * 1024 + ck) = pack8f(mx);
                float kk[8], ss = 0.f; const f32x4 q0 = *(const f32x4*)(k_k + ck), q1 = *(const f32x4*)(k_k + ck + 4); const float kf[8] = {q0.x, q0.y, q0.z, q0.w, q1.x, q1.y, q1.z, q1.w};
#pragma unroll
                for (int j = 0; j < 8; ++j) { kk[j] = mx[j] * kf[j]; ss += kk[j] * kk[j]; }
                ss += DPPF(ss, DPP_XOR1); ss += DPPF(ss, DPP_XOR2); ss += DPPF(ss, DPP_HMIRROR);
                const float rn = rsqrtf(ss + 1e-12f);
#pragma unroll
                for (int j = 0; j < 8; ++j) kk[j] *= rn;
                *(u32x4*)(KK + (size_t)t * 1024 + ck) = pack8f(kk); }
            else if (it < 6) *(u32x4*)(VR + (size_t)t * 1024 + cc - 2048) = pack8f(mx);
            else { float o[8];
#pragma unroll
                for (int j = 0; j < 8; ++j) o[j] = (lane < 8) ? tanhf(mx[j]) : ((lane < 16) ? mx[j] : sigmoidf_(mx[j]));
                *(u32x4*)(LIN + (size_t)t * 256 + lane * 8) = pack8f(o); } }
    }
}

__device__ __forceinline__ void rwkv_scan_unit(const Ctx& C, const Args& A, int bh) {
    const int b = bh >> 4, h = bh & 15, w = C.wave, lane = C.lane, tid = C.tid;
    LAS float* IN = (LAS float*)C.lds;
    LAS float* PART = IN + 2 * 6 * 1024;
    LAS float* YP = PART + 2 * 8 * 64;
    const float* WD = ARP(float, A_WD); const bf16 *KKg = ARP(bf16, A_KK), *BV = ARP(bf16, A_BV), *KP = ARP(bf16, A_KP), *RR = ARP(bf16, A_RR), *VR = ARP(bf16, A_VR), *GG = ARP(bf16, A_GG);
    bf16* YCAT = ARP(bf16, A_YCAT);
    const float *r_k = INP(I_RW_R_K), *ln_w = INP(I_RW_LN_W), *ln_b = INP(I_RW_LN_B);
    const int li = tid >> 5, lch = (tid & 31) * 2;
    const size_t gbase = ((size_t)b * SEQ) * 1024 + h * 64 + lch;
    f32x2 rw; unsigned rk, rb, rp, rr_, rv;
#define RW_LOAD(grp) do { const size_t o = gbase + (size_t)((grp) * 16 + li) * 1024; rw = *(const f32x2*)(WD + o); rk = *(const unsigned*)(KKg + o); rb = *(const unsigned*)(BV + o); \
        rp = *(const unsigned*)(KP + o); rr_ = *(const unsigned*)(RR + o); rv = *(const unsigned*)(VR + o); } while (0)
#define RW_STORE(buf) do { LAS float* d = IN + (buf) * 6144 + li * 64 + lch; *(LAS f32x2*)(d) = rw; *(LAS f32x2*)(d + 1024) = (f32x2){lo_bf(rk), hi_bf(rk)}; *(LAS f32x2*)(d + 2048) = (f32x2){lo_bf(rb), hi_bf(rb)}; \
        *(LAS f32x2*)(d + 3072) = (f32x2){lo_bf(rp), hi_bf(rp)}; *(LAS f32x2*)(d + 4096) = (f32x2){lo_bf(rr_), hi_bf(rr_)}; *(LAS f32x2*)(d + 5120) = (f32x2){lo_bf(rv), hi_bf(rv)}; } while (0)
    float st[8];
#pragma unroll
    for (int j = 0; j < 8; ++j) st[j] = 0.f;
    __syncthreads();
    RW_LOAD(0); RW_STORE(0); __syncthreads();
    for (int grp = 0; grp < SEQ / 16; ++grp) {
        const int buf = grp & 1; const LAS float* I0 = IN + buf * 6144;
        if (grp + 1 < SEQ / 16) RW_LOAD(grp + 1);
        for (int i = 0; i < 16; ++i) {
            const LAS float* q = I0 + i * 64 + 8 * w;
            const f32x4 w0 = *(const LAS f32x4*)(q), w1 = *(const LAS f32x4*)(q + 4), k0 = *(const LAS f32x4*)(q + 1024), k1 = *(const LAS f32x4*)(q + 1028);
            const f32x4 b0 = *(const LAS f32x4*)(q + 2048), b1 = *(const LAS f32x4*)(q + 2052), p0 = *(const LAS f32x4*)(q + 3072), p1 = *(const LAS f32x4*)(q + 3076);
            const f32x4 r0 = *(const LAS f32x4*)(q + 4096), r1 = *(const LAS f32x4*)(q + 4100); const float vv = I0[5120 + i * 64 + lane];
            float skp = 0.f;
#pragma unroll
            for (int j = 0; j < 4; ++j) skp += st[j] * k0[j] + st[4 + j] * k1[j];
            PART[(i & 1) * 512 + w * 64 + lane] = skp;
            LDS_WAIT(); __builtin_amdgcn_s_barrier(); asm volatile("" ::: "memory");
            float sk = 0.f;
#pragma unroll
            for (int ww = 0; ww < 8; ++ww) sk += PART[(i & 1) * 512 + ww * 64 + lane];
            float yp = 0.f;
#pragma unroll
            for (int j = 0; j < 4; ++j) { st[j] = st[j] * w0[j] - sk * b0[j] + vv * p0[j]; st[4 + j] = st[4 + j] * w1[j] - sk * b1[j] + vv * p1[j]; yp += st[j] * r0[j] + st[4 + j] * r1[j]; }
            YP[i * 512 + w * 64 + lane] = yp;
        }
        if (grp + 1 < SEQ / 16) RW_STORE(buf ^ 1);
        __syncthreads();
#pragma unroll
        for (int q = 0; q < 2; ++q) { const int i = 2 * w + q; float y = 0.f;
#pragma unroll
            for (int ww = 0; ww < 8; ++ww) y += YP[i * 512 + ww * 64 + lane];
            const float mean = wave_sum(y) * (1.f / 64.f), dv = y - mean, var = wave_sum(dv * dv) * (1.f / 64.f);
            const int ch = h * 64 + lane; const float yn = dv * rsqrtf(var + 64e-5f) * ln_w[ch] + ln_b[ch];
            const float bonus = wave_sum(I0[4096 + i * 64 + lane] * I0[3072 + i * 64 + lane] * r_k[ch]) * I0[5120 + i * 64 + lane];
            const size_t tt = (size_t)b * SEQ + grp * 16 + i;
            const float g = bf2f(GG[tt * 1024 + ch]);
            YCAT[tt * DM + 1024 + ch] = (bf16)f2bf((yn + bonus) * g); }
    }
#undef RW_LOAD
#undef RW_STORE
    __syncthreads();
}

__device__ __forceinline__ f32x4 lds_mma(const LAS bf16* Am, int lda, const LAS bf16* Bt, int ldb, int tm, int tn, int K, int lane, f32x4 acc) {
    const LAS bf16* ap = Am + (tm * 16 + (lane & 15)) * lda + (lane >> 4) * 8;
    const LAS bf16* bp = Bt + (tn * 16 + (lane & 15)) * ldb + (lane >> 4) * 8;
    for (int k = 0; k < K; k += 32) { const bf16x8 a = *(const LAS bf16x8*)(ap + k); const bf16x8 bb = *(const LAS bf16x8*)(bp + k);
        acc = __builtin_amdgcn_mfma_f32_16x16x32_bf16(bb, a, acc, 0, 0, 0); }
    return acc;
}

constexpr int RP = 72;
__device__ __forceinline__ void st4_bf16(LAS bf16* p, f32x4 v) { u32x2 w; w.x = pk2(v[0], v[1]); w.y = pk2(v[2], v[3]); *(LAS u32x2*)p = w; }
__device__ __forceinline__ void st4_bf16_T(LAS bf16* base, int row, int col0, f32x4 v) {
#pragma unroll
    for (int j = 0; j < 4; ++j) base[(col0 + j) * RP + row] = (bf16)f2bf(v[j]);
}
__device__ __forceinline__ void st4_bf16_g(bf16* p, f32x4 v) { u32x2 w; w.x = pk2(v[0], v[1]); w.y = pk2(v[2], v[3]); *(u32x2*)p = w; }
__device__ __forceinline__ void tri_inverse_diag32(const LAS float* Cf, LAS bf16* Tm, LAS bf16* T00T, int lane) {
    const int hb = lane >> 5, j = lane & 31; const LAS float* Cb_ = Cf + hb * (32 * 64 + 32); float Tr[32];
#pragma unroll
    for (int t = 0; t < 32; ++t) { float acc0 = (t == j) ? 1.f : 0.f, acc1 = 0.f, acc2 = 0.f, acc3 = 0.f;
#pragma unroll
        for (int s4 = 0; s4 < (t + 3) / 4; ++s4) { const f32x4 cv = *(const LAS f32x4*)(Cb_ + t * 64 + s4 * 4);
            if (s4 * 4 + 0 < t) acc0 -= cv[0] * Tr[s4 * 4 + 0]; if (s4 * 4 + 1 < t) acc1 -= cv[1] * Tr[s4 * 4 + 1];
            if (s4 * 4 + 2 < t) acc2 -= cv[2] * Tr[s4 * 4 + 2]; if (s4 * 4 + 3 < t) acc3 -= cv[3] * Tr[s4 * 4 + 3]; }
        Tr[t] = (acc0 + acc1) + (acc2 + acc3); Tm[(32 * hb + t) * RP + 32 * hb + j] = (bf16)f2bf(Tr[t]); __builtin_amdgcn_sched_barrier(0); }
    if (hb == 0) {
#pragma unroll
        for (int q = 0; q < 4; ++q) *(LAS u32x4*)(T00T + j * 40 + 8 * q) = pack8f(Tr + 8 * q); }
    { const int t = lane >> 1, h = lane & 1; const u32x4 z = (u32x4){0u, 0u, 0u, 0u}; *(LAS u32x4*)(Tm + t * RP + 32 + 16 * h) = z; *(LAS u32x4*)(Tm + t * RP + 32 + 16 * h + 8) = z; }
}
__device__ __forceinline__ void rwkv_prep_units(const Ctx& C, bool side_cvt) {
    int unit = C.bid; if (unit >= 4096) return;
    const int w = C.wave;
    LAS float* F = (LAS float*)C.lds;
    LAS float* EGL = F + 4096;
    LAS bf16* B0 = (LAS bf16*)(EGL + 64 + 512);
    LAS bf16 *Kt = B0, *Rt = B0 + 64 * RP, *Kb = B0 + 2 * 64 * RP, *Bb = B0 + 3 * 64 * RP, *KtT = B0 + 4 * 64 * RP, *KhT = B0 + 5 * 64 * RP, *BhT = B0 + 6 * 64 * RP,
             *VcT = B0 + 7 * 64 * RP, *Am = B0 + 8 * 64 * RP, *Q1 = B0 + 9 * 64 * RP, *Q2 = B0 + 10 * 64 * RP;
    LAS bf16 *Tm = Kt, *AVT = Kb, *WmT = Bb, *UT = Am;
    LAS bf16 *C10b = (LAS bf16*)(C.lds + LDS_AUX), *T00T = C10b + 32 * 40, *XT = T00T + 32 * 40;
    const float* WD = ARP(float, A_WD); const bf16 *KKg = ARP(bf16, A_KK), *BV = ARP(bf16, A_BV), *KP = ARP(bf16, A_KP), *RR = ARP(bf16, A_RR), *VR = ARP(bf16, A_VR);
    f32x4 lw0, lw1; u32x4 rk, rb, rp, rr, rv;
#define RWP_LOAD(u_) do { const int bh_ = (u_) >> 6, c_ = (u_) & 63; const size_t go_ = ((size_t)(bh_ >> 4) * SEQ + c_ * 64 + (C.tid >> 3)) * 1024 + (bh_ & 15) * 64 + (C.tid & 7) * 8; \
        lw0 = *(const f32x4*)(WD + go_); lw1 = *(const f32x4*)(WD + go_ + 4); rk = *(const u32x4*)(KKg + go_); rb = *(const u32x4*)(BV + go_); rp = *(const u32x4*)(KP + go_); rr = *(const u32x4*)(RR + go_); rv = *(const u32x4*)(VR + go_); } while (0)
    RWP_LOAD(unit);
  for (;;) {
    int tid = C.tid; asm volatile("" : "+v"(tid));
    const int lane = tid & 63, t = tid >> 3, c8 = (tid & 7) * 8;
    bf16 *GM = ARP(bf16, A_RWM) + (size_t)unit * 4096, *GN = ARP(bf16, A_RWN) + (size_t)unit * 4096, *GRW = ARP(bf16, A_RWRW) + (size_t)unit * 4096, *GYL = ARP(bf16, A_RWYL) + (size_t)unit * 4096;
    __syncthreads();
    *(LAS f32x4*)(F + t * 64 + c8) = lw0; *(LAS f32x4*)(F + t * 64 + c8 + 4) = lw1;
    __syncthreads();
    { float g = 0.f;
#pragma unroll
      for (int i = 0; i < 8; ++i) { g += F[(8 * w + i) * 64 + lane]; F[(8 * w + i) * 64 + lane] = g; }
      EGL[64 + w * 64 + lane] = g; }
    __syncthreads();
    { float off = 0.f;
      for (int ww = 0; ww < w; ++ww) off += EGL[64 + ww * 64 + lane];
#pragma unroll
      for (int i = 0; i < 8; ++i) F[(8 * w + i) * 64 + lane] += off; }
    __syncthreads();
    { float G[8], Gm[8], GL[8], kkf[8], bf_[8], kpf[8], rf[8], vf[8];
#pragma unroll
      for (int j = 0; j < 8; ++j) { G[j] = F[t * 64 + c8 + j]; Gm[j] = t > 0 ? F[(t - 1) * 64 + c8 + j] : 0.f; GL[j] = F[63 * 64 + c8 + j]; }
      unpack8(rk, kkf); unpack8(rb, bf_); unpack8(rp, kpf); unpack8(rr, rf); unpack8(rv, vf);
      float okt[8], ort[8], okb[8], obb[8];
#pragma unroll
      for (int j = 0; j < 8; ++j) { const float e1 = __expf(Gm[j]), e2 = __expf(G[j]), e3 = __expf(-G[j]), e4 = __expf(GL[j] - G[j]);
          okt[j] = kkf[j] * e1; ort[j] = rf[j] * e2; okb[j] = kpf[j] * e3; obb[j] = bf_[j] * e3;
          KtT[(c8 + j) * RP + t] = (bf16)f2bf(okt[j]); KhT[(c8 + j) * RP + t] = (bf16)f2bf(kpf[j] * e4); BhT[(c8 + j) * RP + t] = (bf16)f2bf(bf_[j] * e4);
          VcT[(c8 + j) * RP + t] = (bf16)f2bf(vf[j]);
          if (t == 63) EGL[c8 + j] = e2; }
      *(LAS u32x4*)(Kt + t * RP + c8) = pack8f(okt); *(LAS u32x4*)(Rt + t * RP + c8) = pack8f(ort); *(LAS u32x4*)(Kb + t * RP + c8) = pack8f(okb); *(LAS u32x4*)(Bb + t * RP + c8) = pack8f(obb); }
    const int next_unit = unit + C.G; if (next_unit < 4096) RWP_LOAD(next_unit);
    f32x4 cvv[2][8]; MoeTile mt = moe_tile_decode(C, MOE_CVT_BASE_C + (unit * 8 + w) * 2);
    if (side_cvt) moe_pair_load(mt, cvv, lane);
    __syncthreads();
    const int tm = w >> 1, tn0 = (w & 1) * 2, row = tm * 16 + (lane & 15), cq = 4 * (lane >> 4); const f32x4 z4 = (f32x4){0.f, 0.f, 0.f, 0.f};
#pragma unroll
    for (int q = 0; q < 2; ++q) { const int tn = tn0 + q, col = tn * 16 + cq;
        f32x4 a = lds_mma(Kt, RP, Kb, RP, tm, tn, 64, lane, z4), cc = lds_mma(Kt, RP, Bb, RP, tm, tn, 64, lane, z4), q1 = lds_mma(Rt, RP, Kb, RP, tm, tn, 64, lane, z4), q2 = lds_mma(Rt, RP, Bb, RP, tm, tn, 64, lane, z4);
#pragma unroll
        for (int j = 0; j < 4; ++j) { const bool lo_ = (col + j) < row, le_ = (col + j) <= row; a[j] = lo_ ? a[j] : 0.f; cc[j] = lo_ ? cc[j] : 0.f; q1[j] = le_ ? q1[j] : 0.f; q2[j] = le_ ? q2[j] : 0.f; }
        st4_bf16(Am + row * RP + col, a); st4_bf16(Q1 + row * RP + col, q1); st4_bf16(Q2 + row * RP + col, q2); *(LAS f32x4*)(F + row * 64 + col) = cc;
        if (row >= 32 && col < 32) st4_bf16(C10b + (row - 32) * 40 + col, cc); }
    __syncthreads();
    if (w == 0) tri_inverse_diag32(F, Tm, T00T, lane);
    else { for (int tile = w - 1; tile < 16; tile += 7) { const int am = tile >> 2, an = tile & 3; const f32x4 av = lds_mma(Am, RP, VcT, RP, am, an, 64, lane, z4); st4_bf16_T(AVT, am * 16 + (lane & 15), an * 16 + cq, av); } }
    __syncthreads();
    if (w < 4) { const int bm = w >> 1, bn = w & 1; const f32x4 x = lds_mma(C10b, 40, T00T, 40, bm, bn, 32, lane, z4);
#pragma unroll
        for (int j = 0; j < 4; ++j) XT[(bn * 16 + cq + j) * 40 + bm * 16 + (lane & 15)] = (bf16)f2bf(x[j]); }
    __syncthreads();
    if (w < 4) { const int bm = w >> 1, bn = w & 1; const f32x4 x = lds_mma(Tm + 32 * RP + 32, RP, XT, 40, bm, bn, 32, lane, z4);
        st4_bf16(Tm + (32 + bm * 16 + (lane & 15)) * RP + bn * 16 + cq, (f32x4){-x[0], -x[1], -x[2], -x[3]}); }
    if (side_cvt) moe_pair_store(mt, cvv, lane);
    __syncthreads();
#pragma unroll
    for (int q = 0; q < 2; ++q) { const int tn = tn0 + q, col = tn * 16 + cq;
        const f32x4 wm = lds_mma(Tm, RP, KtT, RP, tm, tn, 64, lane, z4), uu = lds_mma(Tm, RP, AVT, RP, tm, tn, 64, lane, z4);
        st4_bf16_T(WmT, row, col, wm); st4_bf16_T(UT, row, col, uu); }
    __syncthreads();
#pragma unroll
    for (int q = 0; q < 2; ++q) { const int tn = tn0 + q, col = tn * 16 + cq;
        { f32x4 p = lds_mma(Q2, RP, WmT, RP, tm, tn, 64, lane, z4); const u32x2 rw_ = *(const LAS u32x2*)(Rt + row * RP + col);
          st4_bf16_g(GRW + row * 64 + col, (f32x4){lo_bf(rw_.x) - p[0], hi_bf(rw_.x) - p[1], lo_bf(rw_.y) - p[2], hi_bf(rw_.y) - p[3]}); }
        { const f32x4 p1 = lds_mma(Q1, RP, VcT, RP, tm, tn, 64, lane, z4), p2 = lds_mma(Q2, RP, UT, RP, tm, tn, 64, lane, z4); st4_bf16_g(GYL + row * 64 + col, p1 - p2); }
        { f32x4 p = lds_mma(BhT, RP, WmT, RP, tm, tn, 64, lane, z4);
#pragma unroll
          for (int j = 0; j < 4; ++j) p[j] = ((col + j) == row ? EGL[row] : 0.f) - p[j];
          st4_bf16_g(GM + row * 64 + col, p); }
        { const f32x4 p1 = lds_mma(KhT, RP, VcT, RP, tm, tn, 64, lane, z4), p2 = lds_mma(BhT, RP, UT, RP, tm, tn, 64, lane, z4); st4_bf16_g(GN + row * 64 + col, p1 - p2); } }
    if (next_unit >= 4096) break; unit = next_unit;
  }
#undef RWP_LOAD
}
__device__ __forceinline__ void rwkv_scan_slice(const Ctx& C, int item) {
    const int bh = item >> 2, v0 = (item & 3) * 16, b = bh >> 4, h = bh & 15, lane = C.lane, w = C.wave;
    LAS bf16* SH = (LAS bf16*)C.lds;
    LAS bf16* SL = SH + 2 * 16 * RP;
    const bf16 *GM = ARP(bf16, A_RWM) + (size_t)bh * 64 * 4096, *GN = ARP(bf16, A_RWN) + (size_t)bh * 64 * 4096, *GRW = ARP(bf16, A_RWRW) + (size_t)bh * 64 * 4096, *GYL = ARP(bf16, A_RWYL) + (size_t)bh * 64 * 4096;
    bf16* YRAW = ARP(bf16, A_KR);
    const bool is_state = w >= 4; const int tm = w & 3, row = tm * 16 + (lane & 15), cq = 4 * (lane >> 4), kq = (lane >> 4) * 8;
    const bf16* GA = is_state ? GM : GRW; const bf16* GB = is_state ? GN : GYL;
    f32x4 st = (f32x4){0.f, 0.f, 0.f, 0.f};
    bf16x8 a0, a1, b0, b1; u32x2 addA, addB;
#define RWS_LOAD(cc_, X0, X1, XA) do { const size_t uo_ = (size_t)(cc_) * 4096; X0 = *(const bf16x8*)(GA + uo_ + row * 64 + kq); X1 = *(const bf16x8*)(GA + uo_ + row * 64 + 32 + kq); XA = *(const u32x2*)(GB + uo_ + row * 64 + v0 + cq); } while (0)
#define RWS_STEP(c_, X0, X1, XA) do { \
        LAS bf16* sh = SH + ((c_) & 1) * 16 * RP; LAS bf16* sl = SL + ((c_) & 1) * 16 * RP; \
        if (is_state) { _Pragma("unroll") for (int j = 0; j < 4; ++j) { const float s_ = st[j]; const unsigned hb = f2bf(s_); sh[(cq + j) * RP + row] = (bf16)hb; sl[(cq + j) * RP + row] = (bf16)f2bf(s_ - __uint_as_float(hb << 16)); } } \
        LDS_WAIT(); __builtin_amdgcn_s_barrier(); asm volatile("" ::: "memory"); \
        const LAS bf16* bh_ = sh + (lane & 15) * RP + kq; const LAS bf16* bl_ = sl + (lane & 15) * RP + kq; \
        const bf16x8 h0 = *(const LAS bf16x8*)bh_, h1 = *(const LAS bf16x8*)(bh_ + 32), l0 = *(const LAS bf16x8*)bl_, l1 = *(const LAS bf16x8*)(bl_ + 32); \
        f32x4 acc = (f32x4){lo_bf(XA.x), hi_bf(XA.x), lo_bf(XA.y), hi_bf(XA.y)}; \
        acc = __builtin_amdgcn_mfma_f32_16x16x32_bf16(h0, X0, acc, 0, 0, 0); acc = __builtin_amdgcn_mfma_f32_16x16x32_bf16(h1, X1, acc, 0, 0, 0); \
        acc = __builtin_amdgcn_mfma_f32_16x16x32_bf16(l0, X0, acc, 0, 0, 0); acc = __builtin_amdgcn_mfma_f32_16x16x32_bf16(l1, X1, acc, 0, 0, 0); \
        if ((c_) + 2 < 64) RWS_LOAD((c_) + 2, X0, X1, XA); \
        if (is_state) st = acc; \
        else st4_bf16_g(YRAW + ((size_t)b * SEQ + (c_) * 64 + row) * 1024 + h * 64 + v0 + cq, acc); } while (0)
    RWS_LOAD(0, a0, a1, addA); RWS_LOAD(1, b0, b1, addB);
    __syncthreads();
    for (int c = 0; c < 64; c += 2) { RWS_STEP(c, a0, a1, addA); RWS_STEP(c + 1, b0, b1, addB); }
#undef RWS_LOAD
#undef RWS_STEP
    __syncthreads();
}
__device__ __forceinline__ float sum8(float v) { v += DPPF(v, DPP_XOR1); v += DPPF(v, DPP_XOR2); v += DPPF(v, DPP_HMIRROR); return v; }
__device__ __forceinline__ void rwkv_out_items(const Ctx& C) {
    const bf16 *YRAW = ARP(bf16, A_KR), *KP = ARP(bf16, A_KP), *RR = ARP(bf16, A_RR), *VR = ARP(bf16, A_VR), *GG = ARP(bf16, A_GG); bf16* YCAT = ARP(bf16, A_YCAT);
    const float *r_k = INP(I_RW_R_K), *ln_w = INP(I_RW_LN_W), *ln_b = INP(I_RW_LN_B); const int lane = C.lane;
    for (int tt = C.gw; tt < T; tt += C.ngw) {
#pragma unroll
        for (int j = 0; j < 2; ++j) { const int ch = (j * 64 + lane) * 8; const size_t o = (size_t)tt * 1024 + ch;
            float y[8], rr[8], kp[8], vr[8], gg[8]; unpack8(*(const u32x4*)(YRAW + o), y); unpack8(*(const u32x4*)(RR + o), rr); unpack8(*(const u32x4*)(KP + o), kp); unpack8(*(const u32x4*)(VR + o), vr); unpack8(*(const u32x4*)(GG + o), gg);
            const f32x4 rk0 = *(const f32x4*)(r_k + ch), rk1 = *(const f32x4*)(r_k + ch + 4), lw0 = *(const f32x4*)(ln_w + ch), lw1 = *(const f32x4*)(ln_w + ch + 4), lb0 = *(const f32x4*)(ln_b + ch), lb1 = *(const f32x4*)(ln_b + ch + 4);
            const float rkf[8] = {rk0.x, rk0.y, rk0.z, rk0.w, rk1.x, rk1.y, rk1.z, rk1.w}, lwf[8] = {lw0.x, lw0.y, lw0.z, lw0.w, lw1.x, lw1.y, lw1.z, lw1.w}, lbf[8] = {lb0.x, lb0.y, lb0.z, lb0.w, lb1.x, lb1.y, lb1.z, lb1.w};
            float s1 = 0.f, sb = 0.f;
#pragma unroll
            for (int q = 0; q < 8; ++q) { s1 += y[q]; sb += rr[q] * kp[q] * rkf[q]; }
            const float mean = sum8(s1) * (1.f / 64.f), bonus = sum8(sb); float s2 = 0.f;
#pragma unroll
            for (int q = 0; q < 8; ++q) { y[q] -= mean; s2 += y[q] * y[q]; }
            const float rstd = rsqrtf(sum8(s2) * (1.f / 64.f) + 64e-5f); float o8[8];
#pragma unroll
            for (int q = 0; q < 8; ++q) o8[q] = (y[q] * rstd * lwf[q] + lbf[q] + bonus * vr[q]) * gg[q];
            st16_f(YCAT + (size_t)tt * DM + 1024 + ch, pack8f(o8)); }
    }
}
constexpr int MLE = 272;
__device__ __forceinline__ void ml_gate_scan(const Ctx& C, int bh4) {
    const float *IG = ARP(float, A_IG) + (size_t)bh4 * SEQ, *LFp = ARP(float, A_LF) + (size_t)bh4 * SEQ; float *AAg = ARP(float, A_MLA) + (size_t)bh4 * SEQ, *MXg = ARP(float, A_MLM) + (size_t)bh4 * SEQ;
    const int lane = C.lane, p0 = lane * 64; float tot = 0.f;
    for (int i = 0; i < 64; i += 4) { const f32x4 f = *(const f32x4*)(LFp + p0 + i); tot += (f.x + f.y) + (f.z + f.w); }
    float inc = tot;
#pragma unroll
    for (int o = 1; o < 64; o <<= 1) { const float n = __shfl_up(inc, o); if (lane >= o) inc += n; }
    float F = inc - tot, mloc = -INFINITY; f32x4 av[16];
#pragma unroll
    for (int i = 0; i < 16; ++i) { const f32x4 f = *(const f32x4*)(LFp + p0 + 4 * i), g = *(const f32x4*)(IG + p0 + 4 * i); f32x4 a;
        F += f.x; a.x = g.x - F; F += f.y; a.y = g.y - F; F += f.z; a.z = g.z - F; F += f.w; a.w = g.w - F;
        *(f32x4*)(AAg + p0 + 4 * i) = a; av[i] = a; mloc = fmaxf(fmaxf(mloc, fmaxf(a.x, a.y)), fmaxf(a.z, a.w)); }
    float minc = mloc;
#pragma unroll
    for (int o = 1; o < 64; o <<= 1) { const float n = __shfl_up(minc, o); if (lane >= o) minc = fmaxf(minc, n); }
    float run = __shfl_up(minc, 1); if (lane == 0) run = 0.f; run = fmaxf(run, 0.f);
#pragma unroll
    for (int i = 0; i < 16; ++i) { const f32x4 a = av[i]; f32x4 m;
        run = fmaxf(run, a.x); m.x = run; run = fmaxf(run, a.y); m.y = run; run = fmaxf(run, a.z); m.z = run; run = fmaxf(run, a.w); m.w = run;
        *(f32x4*)(MXg + p0 + 4 * i) = m; }
}
__device__ __forceinline__ void ml_intra_unit(const Ctx& C, int unit, bool side_cvt) {
    int tid = C.tid; asm volatile("" : "+v"(tid));
    const int bh4 = unit >> 6, c = unit & 63, b = bh4 >> 2, h = bh4 & 3, w = C.wave, lane = tid & 63, t0 = c * 64;
    LAS bf16* Qs = (LAS bf16*)C.lds;
    LAS bf16* Ks = Qs + 64 * 136;
    LAS bf16* KwT = Ks + 64 * 136;
    LAS bf16* VtE = KwT + 128 * 72;
    LAS bf16* Ps = VtE + MLE * 72;
    LAS float* AAs = (LAS float*)(Ps + 64 * 72);
    const bf16 *QM = ARP(bf16, A_QM), *KM = ARP(bf16, A_KM), *PAB = ARP(bf16, A_PAB);
    const float *AAg = ARP(float, A_MLA) + (size_t)bh4 * SEQ + t0, *MXg = ARP(float, A_MLM) + (size_t)bh4 * SEQ + t0;
    bf16* NUMI = ARP(bf16, A_MLNUM) + (size_t)unit * 64 * MLE; bf16* KVT = ARP(bf16, A_MLKV) + (size_t)unit * MLE * 128;
    const size_t tok0 = (size_t)b * SEQ + t0;
    u32x4 rq[2], rk[2], rv[4];
#pragma unroll
    for (int k = 0; k < 2; ++k) { const int idx = tid + 512 * k, r = idx >> 4, c8 = (idx & 15) * 8; const size_t o = (tok0 + r) * 512 + h * 128 + c8; rq[k] = *(const u32x4*)(QM + o); rk[k] = *(const u32x4*)(KM + o); }
#pragma unroll
    for (int k = 0; k < 4; ++k) { const int idx = tid + 512 * k, r = idx >> 5, e8 = (idx & 31) * 8; rv[k] = *(const u32x4*)(PAB + (tok0 + r) * AB_PAD + 1024 + h * 256 + e8); }
    const float Mc2 = MXg[63];
    f32x4 cvv[2][8]; MoeTile mt = moe_tile_decode(C, MOE_CVT_BASE_F + (unit * 8 + w) * 2); if (side_cvt) moe_pair_load(mt, cvv, lane);
    __syncthreads();
    if (tid < 64) { AAs[tid] = AAg[tid]; AAs[64 + tid] = MXg[tid]; }
    for (int i = tid; i < 16 * 72; i += NTHR) VtE[256 * 72 + i] = (i < 72) ? (bf16)0x3f80 : (bf16)0;
#pragma unroll
    for (int k = 0; k < 2; ++k) { const int idx = tid + 512 * k, r = idx >> 4, c8 = (idx & 15) * 8;
        *(LAS u32x4*)(Qs + r * 136 + c8) = rq[k]; *(LAS u32x4*)(Ks + r * 136 + c8) = rk[k];
        float kf[8]; unpack8(rk[k], kf); const float wk = __expf(AAg[r] - Mc2);
#pragma unroll
        for (int j = 0; j < 8; ++j) KwT[(c8 + j) * 72 + r] = (bf16)f2bf(kf[j] * wk); }
#pragma unroll
    for (int k = 0; k < 4; ++k) { const int idx = tid + 512 * k, r = idx >> 5, e8 = (idx & 31) * 8; const unsigned wv[4] = {rv[k].x, rv[k].y, rv[k].z, rv[k].w};
#pragma unroll
        for (int j = 0; j < 4; ++j) { VtE[(e8 + 2 * j) * 72 + r] = (bf16)(wv[j] & 0xffff); VtE[(e8 + 2 * j + 1) * 72 + r] = (bf16)(wv[j] >> 16); } }
    __syncthreads();
#pragma unroll
    for (int q = 0; q < 2; ++q) { const int tile = 2 * w + q, tm = tile >> 2, tn = tile & 3; const int t = tm * 16 + (lane & 15), l0 = tn * 16 + 4 * (lane >> 4);
        f32x4 s = (f32x4){0.f, 0.f, 0.f, 0.f};
        if (tn <= tm) s = lds_mma(Qs, 136, Ks, 136, tm, tn, 128, lane, s);
        const float mxt = AAs[64 + t]; float pvv[4];
#pragma unroll
        for (int j = 0; j < 4; ++j) { const int l = l0 + j; pvv[j] = (l <= t) ? s[j] * __expf(AAs[l] - mxt) : 0.f; }
        u32x2 pw; pw.x = pk2(pvv[0], pvv[1]); pw.y = pk2(pvv[2], pvv[3]); *(LAS u32x2*)(Ps + t * 72 + l0) = pw; }
    { const int tn = w;
      for (int tm = 0; tm < 17; ++tm) { const f32x4 kv = lds_mma(VtE, 72, KwT, 72, tm, tn, 64, lane, (f32x4){0.f, 0.f, 0.f, 0.f}); const int e = tm * 16 + (lane & 15);
          if (e <= 256) st4_bf16_g(KVT + (size_t)e * 128 + tn * 16 + 4 * (lane >> 4), kv); } }
    __syncthreads();
    { const int tm = w >> 1, t = tm * 16 + (lane & 15);
      for (int tn = (w & 1); tn < 17; tn += 2) { const f32x4 nv = lds_mma(Ps, 72, VtE, 72, tm, tn, 64, lane, (f32x4){0.f, 0.f, 0.f, 0.f}); st4_bf16_g(NUMI + (size_t)t * MLE + tn * 16 + 4 * (lane >> 4), nv); } }
    if (side_cvt) moe_pair_store(mt, cvv, lane);
}
__device__ __forceinline__ void ml_state_scan(const Ctx& C, int first_block, int nblocks) {
    const float* MXg = ARP(float, A_MLM); bf16* KVT = ARP(bf16, A_MLKV);
    constexpr int NPAIR = 16 * 257 * 64;
    const int nthr = nblocks * NTHR, g0 = (C.bid - first_block) * NTHR + C.tid;
    unsigned eoff[3], moff[3]; f32x2 cst[3]; float mprev[3]; bool ev[3];
#pragma unroll
    for (int k = 0; k < 3; ++k) { const int pi = g0 + k * nthr; ev[k] = pi < NPAIR; const int bh4 = ev[k] ? pi / (257 * 64) : 0, r = ev[k] ? pi - bh4 * (257 * 64) : 0;
        eoff[k] = (unsigned)(bh4 * 64 * MLE * 128 + 2 * r); moff[k] = (unsigned)(bh4 * SEQ); cst[k] = (f32x2){0.f, 0.f}; mprev[k] = 0.f; }
    for (int c0 = 0; c0 < 64; c0 += 8) {
        unsigned kvw[3][8]; float mn[3][8];
#pragma unroll
        for (int k = 0; k < 3; ++k)
#pragma unroll
            for (int j = 0; j < 8; ++j) { kvw[k][j] = 0u; mn[k][j] = 0.f; if (ev[k]) { kvw[k][j] = *(const unsigned*)(KVT + eoff[k] + (unsigned)(c0 + j) * (MLE * 128)); mn[k][j] = MXg[moff[k] + (c0 + j) * 64 + 63]; } }
#pragma unroll
        for (int j = 0; j < 8; ++j)
#pragma unroll
            for (int k = 0; k < 3; ++k) if (ev[k]) { *(unsigned*)(KVT + eoff[k] + (unsigned)(c0 + j) * (MLE * 128)) = pk2(cst[k].x, cst[k].y);
                const float dc = __expf(mprev[k] - mn[k][j]); cst[k].x = dc * cst[k].x + lo_bf(kvw[k][j]); cst[k].y = dc * cst[k].y + hi_bf(kvw[k][j]); mprev[k] = mn[k][j]; } }
}
__device__ __forceinline__ void ml_out_unit(const Ctx& C, int unit, bool side_cvt) {
    int tid = C.tid; asm volatile("" : "+v"(tid));
    const int bh4 = unit >> 6, c = unit & 63, b = bh4 >> 2, h = bh4 & 3, w = C.wave, lane = tid & 63, t0 = c * 64;
    LAS bf16* Qs = (LAS bf16*)C.lds;
    LAS bf16* CTs = Qs + 64 * 136;
    const bf16 *QM = ARP(bf16, A_QM), *PAB = ARP(bf16, A_PAB), *NUMI = ARP(bf16, A_MLNUM) + (size_t)unit * 64 * MLE, *KVT = ARP(bf16, A_MLKV) + (size_t)unit * MLE * 128; bf16* YCAT = ARP(bf16, A_YCAT);
    const float *IG = ARP(float, A_IG) + (size_t)bh4 * SEQ + t0, *AAg = ARP(float, A_MLA) + (size_t)bh4 * SEQ + t0, *MXg = ARP(float, A_MLM) + (size_t)bh4 * SEQ + t0;
    const size_t tok0 = (size_t)b * SEQ + t0;
    u32x4 rq[2], rc[9];
#pragma unroll
    for (int k = 0; k < 2; ++k) { const int idx = tid + 512 * k, r = idx >> 4, c8 = (idx & 15) * 8; rq[k] = *(const u32x4*)(QM + (tok0 + r) * 512 + h * 128 + c8); }
#pragma unroll
    for (int k = 0; k < 9; ++k) { const int idx = tid + 512 * k, e = idx >> 4, c8 = (idx & 15) * 8; rc[k] = (u32x4){0u, 0u, 0u, 0u}; if (e <= 256) rc[k] = *(const u32x4*)(KVT + (size_t)e * 128 + c8); }
    const float Mc = c ? MXg[-1] : 0.f;
    f32x4 cvv[2][8]; MoeTile mt = moe_tile_decode(C, MOE_CVT_BASE_G + (unit * 8 + w) * 2); if (side_cvt) moe_pair_load(mt, cvv, lane);
    __syncthreads();
#pragma unroll
    for (int k = 0; k < 2; ++k) { const int idx = tid + 512 * k, r = idx >> 4, c8 = (idx & 15) * 8; *(LAS u32x4*)(Qs + r * 136 + c8) = rq[k]; }
#pragma unroll
    for (int k = 0; k < 9; ++k) { const int idx = tid + 512 * k, e = idx >> 4, c8 = (idx & 15) * 8; if (e < MLE) *(LAS u32x4*)(CTs + e * 136 + c8) = rc[k]; }
    __syncthreads();
    const int tm = w >> 1, t = tm * 16 + (lane & 15), cq = 4 * (lane >> 4); const size_t tt = tok0 + t; const float scale = 0.08838834764831845f;
    const float wst = __expf(Mc - MXg[t]), mrow = IG[t] - AAg[t] + MXg[t];
    float inv;
    { const f32x4 a2 = lds_mma(Qs, 136, CTs, 136, tm, 16, 128, lane, (f32x4){0.f, 0.f, 0.f, 0.f}); const float di = bf2f(NUMI[(size_t)t * MLE + 256]);
      float den = (lane < 16) ? (di + a2[0] * wst) * scale : 0.f; den += xor16f(den); den += xor32f(den);
      inv = 1.f / fmaxf(fabsf(den), __expf(-mrow)); }
    for (int tn = (w & 1); tn < 16; tn += 2) { const f32x4 a2 = lds_mma(Qs, 136, CTs, 136, tm, tn, 128, lane, (f32x4){0.f, 0.f, 0.f, 0.f});
        const u32x2 ni = *(const u32x2*)(NUMI + (size_t)t * MLE + tn * 16 + cq); const u32x2 og = *(const u32x2*)(PAB + tt * AB_PAD + 2048 + h * 256 + tn * 16 + cq);
        const float n0 = (lo_bf(ni.x) + a2[0] * wst) * scale * inv, n1 = (hi_bf(ni.x) + a2[1] * wst) * scale * inv, n2 = (lo_bf(ni.y) + a2[2] * wst) * scale * inv, n3 = (hi_bf(ni.y) + a2[3] * wst) * scale * inv;
        u32x2 o; o.x = pk2(sigmoidf_(lo_bf(og.x)) * n0, sigmoidf_(hi_bf(og.x)) * n1); o.y = pk2(sigmoidf_(lo_bf(og.y)) * n2, sigmoidf_(hi_bf(og.y)) * n3);
        st8_f(YCAT + tt * DM + h * 256 + tn * 16 + cq, o); }
    if (side_cvt) moe_pair_store(mt, cvv, lane);
}

__device__ __forceinline__ void mlstm_unit(const Ctx& C, const Args& A, int unit) {
    const int bh = unit >> 3, dvs = unit & 7, b = bh >> 2, h = bh & 3, w = C.wave, lane = C.lane, tid = C.tid;
    LAS float* AA = (LAS float*)C.lds;
    LAS float* MX = AA + 4096;
    LAS bf16* Qs = (LAS bf16*)(MX + 4096);
    LAS bf16* Ks = Qs + 64 * 136;
    LAS bf16* KwT = Ks + 64 * 136;
    LAS bf16* Vt = KwT + 128 * 72;
    LAS bf16* Ps = Vt + 48 * 72;
    LAS bf16* CT = Ps + 64 * 72;
    LAS float* NUM = (LAS float*)(CT + 48 * 136);
    const float *IG = ARP(float, A_IG) + (size_t)bh * SEQ, *LFp = ARP(float, A_LF) + (size_t)bh * SEQ;
    const bf16 *QM = ARP(bf16, A_QM), *KM = ARP(bf16, A_KM), *PAB = ARP(bf16, A_PAB); bf16* YCAT = ARP(bf16, A_YCAT);
    __syncthreads();
    if (w == 0) { float carryF = 0.f, carryM = 0.f;
        for (int c = 0; c < 64; ++c) { const int p = c * 64 + lane; float f = LFp[p];
#pragma unroll
            for (int o = 1; o < 64; o <<= 1) { const float n = __shfl_up(f, o); if (lane >= o) f += n; }
            f += carryF; const float a = IG[p] - f; float m = a;
#pragma unroll
            for (int o = 1; o < 64; o <<= 1) { const float n = __shfl_up(m, o); if (lane >= o) m = fmaxf(m, n); }
            m = fmaxf(m, carryM); AA[p] = a; MX[p] = m; carryF = __shfl(f, 63); carryM = __shfl(m, 63); } }
    for (int i = tid; i < 48 * 72; i += NTHR) { const int r = i / 72; Vt[i] = (r == 32) ? (bf16)0x3f80 : (bf16)0; }
    for (int i = tid; i < 48 * 136; i += NTHR) CT[i] = 0;
    f32x4 accC[3];
#pragma unroll
    for (int k = 0; k < 3; ++k) accC[k] = (f32x4){0.f, 0.f, 0.f, 0.f};
    const size_t tok0 = (size_t)b * SEQ;
    u32x4 rq[2], rk[2], rv;
#define ML_LOAD(c) do { _Pragma("unroll") for (int k = 0; k < 2; ++k) { const int idx = tid + 512 * k, r = idx >> 4, c8 = (idx & 15) * 8; const size_t o = (tok0 + (c) * 64 + r) * 512 + h * 128 + c8; \
            rq[k] = *(const u32x4*)(QM + o); rk[k] = *(const u32x4*)(KM + o); } \
        if (tid < 256) rv = *(const u32x4*)(PAB + (tok0 + (c) * 64 + (tid >> 2)) * AB_PAD + 1024 + h * 256 + dvs * 32 + (tid & 3) * 8); } while (0)
    ML_LOAD(0);
    __syncthreads();
    const float scale = 0.08838834764831845f;
    for (int c = 0; c < 64; ++c) {
        const int t0 = c * 64; const float Mc = c ? MX[t0 - 1] : 0.f, Mc2 = MX[t0 + 63];
#pragma unroll
        for (int k = 0; k < 2; ++k) { const int idx = tid + 512 * k, r = idx >> 4, c8 = (idx & 15) * 8;
            *(LAS u32x4*)(Qs + r * 136 + c8) = rq[k]; *(LAS u32x4*)(Ks + r * 136 + c8) = rk[k];
            float kf[8]; unpack8(rk[k], kf); const float wk = __expf(AA[t0 + r] - Mc2);
#pragma unroll
            for (int j = 0; j < 8; ++j) KwT[(c8 + j) * 72 + r] = (bf16)f2bf(kf[j] * wk); }
        if (tid < 256) { const int r = tid >> 2, e8 = (tid & 3) * 8; const unsigned wv[4] = {rv.x, rv.y, rv.z, rv.w};
#pragma unroll
            for (int j = 0; j < 4; ++j) { Vt[(e8 + 2 * j) * 72 + r] = (bf16)(wv[j] & 0xffff); Vt[(e8 + 2 * j + 1) * 72 + r] = (bf16)(wv[j] >> 16); } }
        if (c + 1 < 64) ML_LOAD(c + 1);
        __syncthreads();
#pragma unroll
        for (int q = 0; q < 2; ++q) { const int tile = 2 * w + q, tm = tile >> 2, tn = tile & 3; const int t = tm * 16 + (lane & 15), l0 = tn * 16 + 4 * (lane >> 4);
            f32x4 s = (f32x4){0.f, 0.f, 0.f, 0.f};
            if (tn <= tm) s = lds_mma(Qs, 136, Ks, 136, tm, tn, 128, lane, s);
            const float mxt = MX[t0 + t]; float pvv[4];
#pragma unroll
            for (int j = 0; j < 4; ++j) { const int l = l0 + j; pvv[j] = (l <= t) ? s[j] * __expf(AA[t0 + l] - mxt) : 0.f; }
            u32x2 pw; pw.x = pk2(pvv[0], pvv[1]); pw.y = pk2(pvv[2], pvv[3]); *(LAS u32x2*)(Ps + t * 72 + l0) = pw; }
        __syncthreads();
        for (int tile = w; tile < 12; tile += 8) { const int tm = tile / 3, tn = tile % 3; const int t = tm * 16 + (lane & 15);
            f32x4 a1 = lds_mma(Ps, 72, Vt, 72, tm, tn, 64, lane, (f32x4){0.f, 0.f, 0.f, 0.f});
            f32x4 a2 = lds_mma(Qs, 136, CT, 136, tm, tn, 128, lane, (f32x4){0.f, 0.f, 0.f, 0.f});
            const float wst = __expf(Mc - MX[t0 + t]);
            *(LAS f32x4*)(NUM + t * 48 + tn * 16 + 4 * (lane >> 4)) = (a1 + a2 * wst) * scale; }
        __syncthreads();
        { const int t = tid >> 3, e4 = (tid & 7) * 4; const size_t tt = tok0 + t0 + t;
          const float den = NUM[t * 48 + 32], mrow = IG[t0 + t] - AA[t0 + t] + MX[t0 + t];
          const float inv = 1.f / fmaxf(fabsf(den), __expf(-mrow));
          const f32x4 nv = *(const LAS f32x4*)(NUM + t * 48 + e4);
          const u32x2 og = *(const u32x2*)(PAB + tt * AB_PAD + 2048 + h * 256 + dvs * 32 + e4);
          u32x2 o; o.x = pk2(sigmoidf_(lo_bf(og.x)) * nv[0] * inv, sigmoidf_(hi_bf(og.x)) * nv[1] * inv); o.y = pk2(sigmoidf_(lo_bf(og.y)) * nv[2] * inv, sigmoidf_(hi_bf(og.y)) * nv[3] * inv);
          *(u32x2*)(YCAT + tt * DM + h * 256 + dvs * 32 + e4) = o; }
        { const float decay = __expf(Mc - Mc2);
#pragma unroll
          for (int tm = 0; tm < 3; ++tm) { accC[tm] = lds_mma(Vt, 72, KwT, 72, tm, w, 64, lane, accC[tm] * decay);
              u32x2 cw; cw.x = pk2(accC[tm][0], accC[tm][1]); cw.y = pk2(accC[tm][2], accC[tm][3]);
              *(LAS u32x2*)(CT + (tm * 16 + (lane & 15)) * 136 + w * 16 + 4 * (lane >> 4)) = cw; } }
        __syncthreads();
    }
#undef ML_LOAD
}

__device__ __forceinline__ void phase_rowstat(const Ctx& C) {
    const bf16* XR = WSP(bf16, WS_XR); float* RS = WSP(float, WS_TAB + TAB_RSTD);
    for (int r = C.gw; r < T; r += C.ngw) { const u32x4* xr = (const u32x4*)(XR + (size_t)r * DM); float s = 0.f;
#pragma unroll
        for (int j = 0; j < 4; ++j) { float f[8]; unpack8(xr[j * 64 + C.lane], f);
#pragma unroll
            for (int q = 0; q < 8; ++q) s += f[q] * f[q]; }
        s = wave_sum(s); if (C.lane == 0) RS[r] = rsqrtf(s * (1.f / DM) + EPS); }
}
__device__ __forceinline__ void phase_softmax256(const Ctx& C) {
    const float* SC = ARP(float, A_SC); bf16* PC = ARP(bf16, A_PC);
    for (int it = C.gw; it < T * 4; it += C.ngw) { const size_t o = (size_t)it * 256 + C.lane * 4;
        const f32x4 v = *(const f32x4*)(SC + o); const float m = wave_max(fmaxf(fmaxf(v.x, v.y), fmaxf(v.z, v.w)));
        const float e0 = __expf(v.x - m), e1 = __expf(v.y - m), e2 = __expf(v.z - m), e3 = __expf(v.w - m);
        const float inv = 1.f / wave_sum(e0 + e1 + e2 + e3);
        u32x2 w; w.x = pk2(e0 * inv, e1 * inv); w.y = pk2(e2 * inv, e3 * inv); *(u32x2*)(PC + o) = w; }
}
constexpr int MOE_NB = 256, MOE_TPB = T / MOE_NB;
__device__ __forceinline__ void phase_route(const Ctx& C, const Args& A, int l) {
    const float* LG = ARP(float, A_XS); constexpr size_t PL = (size_t)T * 256;     int* EID = ARP(int, A_EID); float* WTS = ARP(float, A_WTS); int* LRANK = ARP(int, A_LRANK); int* BH = ARP(int, A_BHIST);
    const float *bg = INP(I_MOE_BG) + l * 8, *be = INP(I_MOE_BE) + l * 64;
    LAS int* hist = (LAS int*)(C.lds + LDS_AUX);
    for (int bk = C.bid; bk < MOE_NB; bk += C.G) {
        __syncthreads();
        if (C.tid < 64) hist[C.tid] = 0;
        __syncthreads();
        if (C.tid < MOE_TPB) { const int t = bk * MOE_TPB + C.tid; const float* L = LG + (size_t)t * 256;
            float lg[8], mx = -INFINITY; int grp = 0;
#pragma unroll
            for (int g = 0; g < 8; ++g) { lg[g] = ((L[g] + L[PL + g]) + (L[2 * PL + g] + L[3 * PL + g])) + bg[g]; if (lg[g] > mx) { mx = lg[g]; grp = g; } }
            float se = 0.f;
#pragma unroll
            for (int g = 0; g < 8; ++g) se += __expf(lg[g] - mx);
            const float pgrp = 1.f / se;
            float l1 = -INFINITY, l2 = -INFINITY; int i1 = 0, i2 = 0;
            for (int j = 0; j < 8; ++j) { const int x = 8 + grp * 8 + j; const float v = ((L[x] + L[PL + x]) + (L[2 * PL + x] + L[3 * PL + x])) + be[grp * 8 + j];
                if (v > l1) { l2 = l1; i2 = i1; l1 = v; i1 = j; } else if (v > l2) { l2 = v; i2 = j; } }
            const float w1 = 1.f / (1.f + __expf(l2 - l1)), w2 = 1.f - w1;
            const int e1 = grp * 8 + i1, e2 = grp * 8 + i2;
            EID[2 * t] = e1; EID[2 * t + 1] = e2; WTS[2 * t] = pgrp * w1; WTS[2 * t + 1] = pgrp * w2;
            LRANK[2 * t] = atomicAdd((int*)(hist + e1), 1); LRANK[2 * t + 1] = atomicAdd((int*)(hist + e2), 1); }
        __syncthreads();
        if (C.tid < 64) BH[bk * 64 + C.tid] = hist[C.tid];
    }
}
__device__ __forceinline__ void phase_gather(const Ctx& C, int l) {
    LAS int* tab = (LAS int*)(C.lds + LDS_AUX);
    const int* BH = ARP(int, A_BHIST); const int* EID = ARP(int, A_EID); const int* LRANK = ARP(int, A_LRANK); int* ROWSLOT = ARP(int, A_ROWSLOT); const bf16* XNp = WSP(bf16, WS_XR); bf16* XS = ARP(bf16, A_XS);
    unsigned* cnt = WSP(unsigned, WS_CTL) + CW_MOE_CNT + l * 64;
    for (int bk = C.bid; bk < MOE_NB; bk += C.G) {
        __syncthreads();
        { static_assert(MOE_NB == 8 * 32, "8 waves x 32 buckets"); const int e = C.tid & 63, part = C.tid >> 6; int tot = 0, before = 0;
#pragma unroll 8
            for (int q = part * 32; q < part * 32 + 32; ++q) { const int v = BH[q * 64 + e]; tot += v; if (q < bk) before += v; }
            tab[256 + part * 64 + e] = tot; tab[768 + part * 64 + e] = before; }
        __syncthreads();
        if (C.tid < 64) { int tot = 0, before = 0;
#pragma unroll
            for (int part = 0; part < 8; ++part) { tot += tab[256 + part * 64 + C.tid]; before += tab[768 + part * 64 + C.tid]; }
            const int seg = ((tot + 255) >> 8) << 8, inc = wave_incl_scan_i(seg, C.tid);
            tab[C.tid] = inc - seg; tab[64 + C.tid] = before; if (bk == 0) cnt[C.tid] = (unsigned)tot; }
        __syncthreads();
        if (C.tid < 2 * MOE_TPB) { const int a = bk * 2 * MOE_TPB + C.tid, e = EID[a], pos = tab[e] + tab[64 + e] + LRANK[a]; tab[128 + C.tid] = pos; ROWSLOT[pos] = a; }
        __syncthreads();
    }
}
__device__ __forceinline__ void phase_combine_norm(const Ctx& C, const float* gain, float* OUT) {
    bf16* XR = WSP(bf16, WS_XR); const bf16* YE = ARP(bf16, A_YE); float* RS = WSP(float, WS_RSQ) + (size_t)4 * T * 8; const int lane = C.lane;
    for (int t = C.gw; t < T; t += C.ngw) { bf16* xr = XR + (size_t)t * DM; const bf16* y0 = YE + (size_t)(2 * t) * DM; const bf16* y1 = y0 + DM;
        float v[4][8]; float s = 0.f; u32x4 rx[4], ra[4], rb[4];
#pragma unroll
        for (int j = 0; j < 4; ++j) { const int o = (j * 64 + lane) * 8; rx[j] = *(const u32x4*)(xr + o); ra[j] = *(const u32x4*)(y0 + o); rb[j] = *(const u32x4*)(y1 + o); }
#pragma unroll
        for (int j = 0; j < 4; ++j) { const int o = (j * 64 + lane) * 8; float a[8], b0[8]; unpack8(rx[j], v[j]); unpack8(ra[j], a); unpack8(rb[j], b0);
#pragma unroll
            for (int q = 0; q < 8; ++q) v[j][q] += a[q] + b0[q];
            if (!OUT) { const u32x4 w = pack8f(v[j]); *(u32x4*)(xr + o) = w; unpack8(w, v[j]); }
#pragma unroll
            for (int q = 0; q < 8; ++q) s += v[j][q] * v[j][q]; }
        const float ssq = wave_sum(s), rstd = rstd_of(ssq);
        if (!OUT) { if (lane < 8) RS[(size_t)t * 8 + lane] = (lane == 0) ? ssq : 0.f; }
        else {
#pragma unroll
            for (int j = 0; j < 4; ++j) { const int o = (j * 64 + lane) * 8; const f32x4 g0 = *(const f32x4*)(gain + o), g1 = *(const f32x4*)(gain + o + 4);
                *(f32x4*)(OUT + (size_t)t * DM + o) = (f32x4){v[j][0] * rstd * g0.x, v[j][1] * rstd * g0.y, v[j][2] * rstd * g0.z, v[j][3] * rstd * g0.w};
                *(f32x4*)(OUT + (size_t)t * DM + o + 4) = (f32x4){v[j][4] * rstd * g1.x, v[j][5] * rstd * g1.y, v[j][6] * rstd * g1.z, v[j][7] * rstd * g1.w}; } }
    }
}

__device__ __forceinline__ float gelu_tanh(float x) { return 0.5f * x * (1.f + tanhf(0.7978845608028654f * (x + 0.044715f * x * x * x))); }
__device__ __forceinline__ void phase_cmp_finish(const Ctx& C, const Args& A) {
    const float* CP = ARP(float, A_CPART); const float* bias = WSP(float, WS_TAB + TAB_CMPBIAS); const float* w2 = INP(I_CMP_W2);
    LAS float* hid = (LAS float*)C.lds + C.wave * 128; const int lane = C.lane;
    for (int it = C.gw; it < 2 * 16 * 256; it += C.ngw) { const int j = it & 255, bg = (it >> 8) & 15, kv = it >> 12;
        bf16* dst = ARP(bf16, kv ? A_VCMP : A_KCMP) + ((size_t)bg * 256 + j) * 128;
        bf16* dstT = ARP(bf16, A_VCT) + (size_t)bg * 128 * 256 + j;
        if (j == 255) { dst[lane] = 0; dst[lane + 64] = 0; if (kv) { dstT[(size_t)lane * 256] = 0; dstT[(size_t)(lane + 64) * 256] = 0; } continue; }
        float h0 = 0.f, h1 = 0.f;
#pragma unroll
        for (int part = 0; part < 8; ++part) { h0 += bias[part * 256 + kv * 128 + lane]; h1 += bias[part * 256 + kv * 128 + 64 + lane]; }
#pragma unroll
        for (int ks = 0; ks < 8; ++ks) { const float* p = CP + ((size_t)((ks * 2 + kv) * 16 + bg) * 256 + j) * 256; h0 += p[lane]; h1 += p[64 + lane]; }
        hid[lane] = gelu_tanh(h0); hid[64 + lane] = gelu_tanh(h1); LDS_WAIT(); asm volatile("" ::: "memory");
        float o0 = 0.f, o1 = 0.f; const float* W = w2 + (size_t)kv * 128 * 128;
        for (int e = 0; e < 128; ++e) { const float hv = hid[e]; o0 += hv * W[e * 128 + lane]; o1 += hv * W[e * 128 + 64 + lane]; }
        dst[lane] = (bf16)f2bf(o0); dst[lane + 64] = (bf16)f2bf(o1); if (kv) { dstT[(size_t)lane * 256] = (bf16)f2bf(o0); dstT[(size_t)(lane + 64) * 256] = (bf16)f2bf(o1); } LDS_WAIT(); asm volatile("" ::: "memory"); }
}
__device__ __forceinline__ void phase_cmp_attn(const Ctx& C) {
    const bf16 *Q = ARP(bf16, A_Q), *KC = ARP(bf16, A_KCMP), *VC = ARP(bf16, A_VCMP); const float* GATES = ARP(float, A_GATES);
    float* OACC = ARP(float, A_OACC); unsigned long long* SELM = ARP(unsigned long long, A_SELMASK);
    LAS float* qs = (LAS float*)C.lds + C.wave * 1536;
    LAS float* ps = qs + 512; const int lane = C.lane; const float scale = 0.08838834764831845f;
    for (int it = C.gw; it < T * 4; it += C.ngw) { const int t = it >> 2, g = it & 3, b = t >> 12, s = t & 4095;
        const int nvalid = (s >= 31) ? ((s - 31) >> 4) + 1 : 0;
#pragma unroll
        for (int r = 0; r < 4; ++r) { const bf16* qp = Q + (((size_t)(b * 16 + g * 4 + r)) * SEQ + s) * 128; qs[r * 128 + lane] = bf2f(qp[lane]); qs[r * 128 + 64 + lane] = bf2f(qp[64 + lane]); }
        LDS_WAIT(); asm volatile("" ::: "memory");
        float sc[4][4];
#pragma unroll
        for (int i = 0; i < 4; ++i) { const int j = lane + 64 * i;
#pragma unroll
            for (int r = 0; r < 4; ++r) sc[r][i] = 0.f;
            if (j < nvalid) { const bf16* kp = KC + ((size_t)(b * 4 + g) * 256 + j) * 128;
                for (int d8 = 0; d8 < 16; ++d8) { float kf[8]; unpack8(*(const u32x4*)(kp + d8 * 8), kf);
#pragma unroll
                    for (int r = 0; r < 4; ++r) { float a = 0.f;
#pragma unroll
                        for (int jj = 0; jj < 8; ++jj) a += qs[r * 128 + d8 * 8 + jj] * kf[jj];
                        sc[r][i] += a; } } } }
#pragma unroll
        for (int r = 0; r < 4; ++r) { float m = -INFINITY;
#pragma unroll
            for (int i = 0; i < 4; ++i) if (lane + 64 * i < nvalid) m = fmaxf(m, sc[r][i] * scale);
            m = wave_max(m); if (!(m > -INFINITY)) m = 0.f; float e[4], sum = 0.f;
#pragma unroll
            for (int i = 0; i < 4; ++i) { e[i] = (lane + 64 * i < nvalid) ? __expf(sc[r][i] * scale - m) : 0.f; sum += e[i]; }
            sum = wave_sum(sum); const float inv = sum > 0.f ? 1.f / sum : 1.f;
#pragma unroll
            for (int i = 0; i < 4; ++i) ps[r * 256 + lane + 64 * i] = e[i] * inv; }
        LDS_WAIT(); asm volatile("" ::: "memory");
        float o[4][2];
#pragma unroll
        for (int r = 0; r < 4; ++r) { o[r][0] = 0.f; o[r][1] = 0.f; }
        for (int j = 0; j < nvalid; ++j) { const bf16* vp = VC + ((size_t)(b * 4 + g) * 256 + j) * 128; const float v0 = bf2f(vp[lane]), v1 = bf2f(vp[64 + lane]);
#pragma unroll
            for (int r = 0; r < 4; ++r) { const float p = ps[r * 256 + j]; o[r][0] += p * v0; o[r][1] += p * v1; } }
#pragma unroll
        for (int r = 0; r < 4; ++r) { const float gt = GATES[(size_t)t * 48 + g * 4 + r]; float* op = OACC + (size_t)t * DM + (g * 4 + r) * 128; op[lane] = gt * o[r][0]; op[64 + lane] = gt * o[r][1]; }
        float imp = 0.f;
#pragma unroll
        for (int r = 0; r < 4; ++r) { const LAS float* p = ps + r * 256; const int j0 = 4 * lane;
            imp += (j0 > 0 ? 0.5f * p[j0 - 1] : 0.f) + p[j0] + p[j0 + 1] + p[j0 + 2] + 0.5f * p[j0 + 3]; }
        const int cur = s >> 6; float score;
        if (lane == 0 || lane == cur || lane == cur - 1) score = INFINITY; else score = (lane <= cur) ? imp : -INFINITY;
        int rank = 0;
        for (int o2 = 0; o2 < 64; ++o2) { const float so = __int_as_float(__builtin_amdgcn_readlane(__float_as_int(score), o2)); rank += (so > score || (so == score && o2 < lane)) ? 1 : 0; }
        const unsigned long long m = __ballot(rank < 16 && score > -INFINITY);
        if (lane == 0) SELM[(size_t)t * 4 + g] = m;
        LDS_WAIT(); asm volatile("" ::: "memory");
    }
}
struct NaiveAttnState { float m[4], l[4], o[4][2]; };
__device__ __forceinline__ void naive_tile(NaiveAttnState& S, const LAS float* qs, LAS float* pt, const bf16* Kt, const bf16* Vt_, int key0, bool valid, int lane) {
    float sc[4] = {0.f, 0.f, 0.f, 0.f}; const float scale = 0.08838834764831845f;
    if (valid) { const bf16* kp = Kt + (size_t)(key0 + lane) * 128;
        for (int d8 = 0; d8 < 16; ++d8) { float kf[8]; unpack8(*(const u32x4*)(kp + d8 * 8), kf);
#pragma unroll
            for (int r = 0; r < 4; ++r) { float a = 0.f;
#pragma unroll
                for (int jj = 0; jj < 8; ++jj) a += qs[r * 128 + d8 * 8 + jj] * kf[jj];
                sc[r] += a; } } }
    const unsigned long long vm = __ballot(valid);
    if (vm == 0ull) return;
#pragma unroll
    for (int r = 0; r < 4; ++r) { const float sv = valid ? sc[r] * scale : -INFINITY; const float mt = wave_max(sv), mn = fmaxf(S.m[r], mt);
        const float alpha = __expf(S.m[r] - mn), p = valid ? __expf(sv - mn) : 0.f;
        S.l[r] = S.l[r] * alpha + wave_sum(p); S.o[r][0] *= alpha; S.o[r][1] *= alpha; S.m[r] = mn; pt[r * 64 + lane] = p; }
    LDS_WAIT(); asm volatile("" ::: "memory");
    for (int k = 0; k < 64; ++k) { if (!((vm >> k) & 1ull)) continue; const bf16* vp = Vt_ + (size_t)(key0 + k) * 128; const float v0 = bf2f(vp[lane]), v1 = bf2f(vp[64 + lane]);
#pragma unroll
        for (int r = 0; r < 4; ++r) { const float p = pt[r * 64 + k]; S.o[r][0] += p * v0; S.o[r][1] += p * v1; } }
    LDS_WAIT(); asm volatile("" ::: "memory");
}
__device__ __forceinline__ void phase_selwin_naive(const Ctx& C, bf16* OCAT) {
    const bf16* QR = ARP(bf16, A_QROT); const float* GATES = ARP(float, A_GATES); const float* OACC = ARP(float, A_OACC);
    const unsigned long long* SELM = ARP(const unsigned long long, A_SELMASK);
    const bf16* KS = (const bf16*)(C.ws + WS_ARENA + A_KV6 + 2 * KV6_STRIDE); const bf16* VS = (const bf16*)(C.ws + WS_ARENA + A_KV6 + 3 * KV6_STRIDE);
    const bf16* KW = (const bf16*)(C.ws + WS_ARENA + A_KV6 + 4 * KV6_STRIDE); const bf16* VW = (const bf16*)(C.ws + WS_ARENA + A_KV6 + 5 * KV6_STRIDE);
    LAS float* qs = (LAS float*)C.lds + C.wave * 768; LAS float* pt = qs + 512; const int lane = C.lane;
    for (int it = C.gw; it < T * 4; it += C.ngw) { const int t = it >> 2, g = it & 3, b = t >> 12, s = t & 4095; const size_t slab = (size_t)(b * 4 + g) * SPAD * 128;
#pragma unroll
        for (int r = 0; r < 4; ++r) { const bf16* qp = QR + (((size_t)(b * 16 + g * 4 + r)) * SEQ + s) * 128; qs[r * 128 + lane] = bf2f(qp[lane]); qs[r * 128 + 64 + lane] = bf2f(qp[64 + lane]); }
        LDS_WAIT(); asm volatile("" ::: "memory");
        float res[4][2];
#pragma unroll
        for (int r = 0; r < 4; ++r) { res[r][0] = OACC[(size_t)t * DM + (g * 4 + r) * 128 + lane]; res[r][1] = OACC[(size_t)t * DM + (g * 4 + r) * 128 + 64 + lane]; }
        { NaiveAttnState S;
#pragma unroll
          for (int r = 0; r < 4; ++r) { S.m[r] = -1e30f; S.l[r] = 0.f; S.o[r][0] = 0.f; S.o[r][1] = 0.f; }
          const unsigned long long m = SELM[(size_t)t * 4 + g];
          for (int blk = 0; blk <= (s >> 6); ++blk) if ((m >> blk) & 1ull) naive_tile(S, qs, pt, KS + slab, VS + slab, blk * 64, blk * 64 + lane <= s, lane);
#pragma unroll
          for (int r = 0; r < 4; ++r) { const float gt = GATES[(size_t)t * 48 + 16 + g * 4 + r], inv = S.l[r] > 0.f ? 1.f / S.l[r] : 0.f; res[r][0] += gt * S.o[r][0] * inv; res[r][1] += gt * S.o[r][1] * inv; } }
        { NaiveAttnState S;
#pragma unroll
          for (int r = 0; r < 4; ++r) { S.m[r] = -1e30f; S.l[r] = 0.f; S.o[r][0] = 0.f; S.o[r][1] = 0.f; }
          const int lo = s - 511 > 0 ? s - 511 : 0;
          for (int k0 = lo & ~63; k0 <= s; k0 += 64) naive_tile(S, qs, pt, KW + slab, VW + slab, k0, (k0 + lane >= lo) && (k0 + lane <= s), lane);
#pragma unroll
          for (int r = 0; r < 4; ++r) { const float gt = GATES[(size_t)t * 48 + 32 + g * 4 + r], inv = S.l[r] > 0.f ? 1.f / S.l[r] : 0.f; res[r][0] += gt * S.o[r][0] * inv; res[r][1] += gt * S.o[r][1] * inv; } }
#pragma unroll
        for (int r = 0; r < 4; ++r) { bf16* op = OCAT + (size_t)t * DM + (g * 4 + r) * 128; op[lane] = (bf16)f2bf(res[r][0]); op[64 + lane] = (bf16)f2bf(res[r][1]); }
    }
}


__device__ __forceinline__ void phase_cmp_attn_mma(const Ctx& C, bool side_cvt) {
    const bf16 *Q = ARP(bf16, A_Q), *KC = ARP(bf16, A_KCMP), *VCT = ARP(bf16, A_VCT); const float* GATES = ARP(float, A_GATES);
    float* OACC = ARP(float, A_OACC); unsigned long long* SELM = ARP(unsigned long long, A_SELMASK);
    LAS bf16* Qs = (LAS bf16*)C.lds;
    LAS bf16* Ks = Qs + 128 * 136;
    LAS bf16* Pm = (LAS bf16*)C.lds;
    LAS bf16* Vt = Pm + 128 * 264;
    const int w = C.wave; const float scale = 0.08838834764831845f;
    for (int it = C.bid; it < 2048; it += C.G) { int tid = C.tid; asm volatile("" : "+v"(tid)); const int lane = tid & 63;     const int bg = it >> 7, tt = ((it / C.G) & 1) ? 127 - (it & 127) : (it & 127), b = bg >> 2, g = bg & 3, t0 = tt * 32;
        const int nv = t0 / 16 + 1 > 255 ? 255 : ((t0 + 31 >= 31) ? t0 / 16 + 1 : 0);
        const int nct = (nv + 15) >> 4, kmax = ((nv + 31) >> 5) << 5;
        f32x4 cvv[2][8]; MoeTile mt = moe_tile_decode(C, MOE_CVT_BASE_E + (it * 8 + w) * 2); if (side_cvt) moe_pair_load(mt, cvv, lane);
        __syncthreads();
#pragma unroll
        for (int k = 0; k < 4; ++k) { const int idx = tid + 512 * k, row = idx >> 4, c8 = (idx & 15) * 8, r = row >> 5, tl = row & 31;
            *(LAS u32x4*)(Qs + row * 136 + c8) = *(const u32x4*)(Q + (((size_t)(b * 16 + g * 4 + r)) * SEQ + t0 + tl) * 128 + c8); }
        { u32x4 tk[8];
#pragma unroll
          for (int k = 0; k < 8; ++k) { const int idx = tid + 512 * k, row = idx >> 4, c8 = (idx & 15) * 8; tk[k] = (u32x4){0u, 0u, 0u, 0u};
              if (row < nct * 16) tk[k] = *(const u32x4*)(KC + ((size_t)bg * 256 + row) * 128 + c8); }
#pragma unroll
          for (int k = 0; k < 8; ++k) { const int idx = tid + 512 * k, row = idx >> 4, c8 = (idx & 15) * 8; *(LAS u32x4*)(Ks + row * 136 + c8) = tk[k]; } }
        __syncthreads();
        f32x4 sacc[16];
        { bf16x8 qa[4];
#pragma unroll
          for (int k = 0; k < 4; ++k) qa[k] = *(const LAS bf16x8*)(Qs + (w * 16 + (lane & 15)) * 136 + (lane >> 4) * 8 + 32 * k);
#pragma unroll
          for (int ct = 0; ct < 16; ++ct) { sacc[ct] = (f32x4){0.f, 0.f, 0.f, 0.f};
              if (ct < nct) { const LAS bf16* bp = Ks + (ct * 16 + (lane & 15)) * 136 + (lane >> 4) * 8;
#pragma unroll
                  for (int k = 0; k < 4; ++k) sacc[ct] = __builtin_amdgcn_mfma_f32_16x16x32_bf16(*(const LAS bf16x8*)(bp + 32 * k), qa[k], sacc[ct], 0, 0, 0); } } }
        const int trow = t0 + (w & 1) * 16 + (lane & 15);
        const int nvr = (trow >= 31) ? ((trow - 31) >> 4) + 1 : 0;
        float m = -INFINITY;
#pragma unroll
        for (int ct = 0; ct < 16; ++ct)
#pragma unroll
            for (int j = 0; j < 4; ++j) { const int key = ct * 16 + 4 * (lane >> 4) + j; const float v = (key < nvr) ? sacc[ct][j] * scale : -INFINITY; sacc[ct][j] = v; m = fmaxf(m, v); }
        m = fmaxf(m, xor16f(m)); m = fmaxf(m, xor32f(m)); if (!(m > -INFINITY)) m = 0.f;
        float sum = 0.f;
#pragma unroll
        for (int ct = 0; ct < 16; ++ct)
#pragma unroll
            for (int j = 0; j < 4; ++j) { const float e = __expf(sacc[ct][j] - m); sacc[ct][j] = e; sum += e; }
        sum += xor16f(sum); sum += xor32f(sum);
        const float inv = sum > 0.f ? 1.f / sum : 1.f;
        __syncthreads();
#pragma unroll
        for (int ct = 0; ct < 16; ++ct) if (ct * 16 < kmax) { u32x2 pw; pw.x = pk2(sacc[ct][0] * inv, sacc[ct][1] * inv); pw.y = pk2(sacc[ct][2] * inv, sacc[ct][3] * inv);
            *(LAS u32x2*)(Pm + (w * 16 + (lane & 15)) * 264 + ct * 16 + 4 * (lane >> 4)) = pw; }
        { u32x4 tv[8];
#pragma unroll
          for (int k = 0; k < 8; ++k) { const int idx = tid + 512 * k, d = idx >> 5, j8 = (idx & 31) * 8; tv[k] = (u32x4){0u, 0u, 0u, 0u};
              if (j8 < kmax) tv[k] = *(const u32x4*)(VCT + ((size_t)bg * 128 + d) * 256 + j8); }
#pragma unroll
          for (int k = 0; k < 8; ++k) { const int idx = tid + 512 * k, d = idx >> 5, j8 = (idx & 31) * 8; *(LAS u32x4*)(Vt + d * 264 + j8) = tv[k]; } }
        __syncthreads();
        { const int r = w >> 1, tl = (w & 1) * 16 + (lane & 15), t = b * SEQ + t0 + tl, hh = g * 4 + r; const float gt = GATES[(size_t)t * 48 + hh];
          float* op = OACC + (size_t)t * DM + hh * 128 + 4 * (lane >> 4);
          bf16x8 pa[8];
#pragma unroll
          for (int k = 0; k < 8; ++k) { pa[k] = (bf16x8){0, 0, 0, 0, 0, 0, 0, 0}; if (k * 32 < kmax) pa[k] = *(const LAS bf16x8*)(Pm + (w * 16 + (lane & 15)) * 264 + (lane >> 4) * 8 + 32 * k); }
#pragma unroll
          for (int dt = 0; dt < 8; ++dt) { f32x4 o = (f32x4){0.f, 0.f, 0.f, 0.f}; const LAS bf16* bp = Vt + (dt * 16 + (lane & 15)) * 264 + (lane >> 4) * 8;
#pragma unroll
              for (int k = 0; k < 8; ++k) if (k * 32 < kmax) o = __builtin_amdgcn_mfma_f32_16x16x32_bf16(*(const LAS bf16x8*)(bp + 32 * k), pa[k], o, 0, 0, 0);
              *(f32x4*)(op + dt * 16) = o * gt; } }
        { float score[4]; const int cur = (t0 + w * 4) >> 6;
#pragma unroll
          for (int q = 0; q < 4; ++q) { const int tl = w * 4 + q; float imp = 0.f;
            if (kmax > 0) {
#pragma unroll
                for (int r = 0; r < 4; ++r) { const LAS bf16* p = Pm + (r * 32 + tl) * 264; const int j0 = 4 * lane;
                    if (j0 < kmax) { const u32x2 pw = *(const LAS u32x2*)(p + j0); imp += lo_bf(pw.x) + hi_bf(pw.x) + lo_bf(pw.y) + 0.5f * hi_bf(pw.y); if (j0 > 0) imp += 0.5f * bf2f(p[j0 - 1]); } } }
            if (lane == 0 || lane == cur || lane == cur - 1) score[q] = INFINITY; else score[q] = (lane <= cur) ? imp : -INFINITY; }
          int rank[4] = {0, 0, 0, 0};
          for (int o2 = 0; o2 <= cur; ++o2) {
#pragma unroll
              for (int q = 0; q < 4; ++q) { const float so = __int_as_float(__builtin_amdgcn_readlane(__float_as_int(score[q]), o2)); rank[q] += (so > score[q] || (so == score[q] && o2 < lane)) ? 1 : 0; } }
#pragma unroll
          for (int q = 0; q < 4; ++q) { const unsigned long long mk = __ballot(rank[q] < 16 && score[q] > -INFINITY);
              if (lane == 0) SELM[(size_t)(b * SEQ + t0 + w * 4 + q) * 4 + g] = mk; } }
        if (side_cvt) moe_pair_store(mt, cvv, lane);
    }
    __syncthreads();
}

namespace swa {
constexpr int D = 128, NW = 8, QBLK = 32, KVBLK = 64, QB = NW * QBLK;
constexpr int SHM_V = KVBLK * D * 2, SHM_K = KVBLK * D * 2;
constexpr int LDS_BYTES = 2 * SHM_V + 2 * SHM_K + NW * 64 * 4;
constexpr float SCALE = 0.08838834764831845f, THR = 8.f;
typedef short s16x4 __attribute__((ext_vector_type(4)));
typedef float f32x16 __attribute__((ext_vector_type(16)));
#define KSWZ(row, colB) ((row) * 256 + ((colB) ^ (((row) & 7) << 4)))
#define SBAR() __builtin_amdgcn_sched_barrier(0)
__device__ __forceinline__ int v_st(int k, int c) { const int kk = (k & ~0xC) | ((k & 4) << 1) | ((k & 8) >> 1); return ((kk >> 3) * 4 + (c >> 5)) * 512 + ((kk & 7) * 32 + (c & 31)) * 2; }
__device__ __forceinline__ int v_rd_base(int lane) { return ((lane & 3) << 3) | (((lane >> 2) & 3) << 6) | (((lane >> 4) & 1) << 5) | (((lane >> 5) & 1) << 8); }
constexpr int v_rd_off(int d0, int ks, int half) { return d0 * 512 + ks * 4096 + half * 2048; }
__device__ __forceinline__ int crow(int r, int hi) { return (r & 3) + 8 * (r >> 2) + 4 * hi; }
__device__ __forceinline__ unsigned cvtpk(float lo, float hi) { unsigned r; asm volatile("v_cvt_pk_bf16_f32 %0, %1, %2" : "=v"(r) : "v"(lo), "v"(hi)); return r; }
__device__ __forceinline__ bf16x8 load8(const bf16* p) { return *reinterpret_cast<const bf16x8*>(p); }
__device__ __forceinline__ void mask_tile(f32x16& p0, f32x16& p1, int dq, unsigned W) {
    const float NEG = -__builtin_inff();
    asm volatile("" : "+v"(dq));
#pragma unroll
    for (int r = 0; r < 16; ++r) { const int c = (r & 3) + 8 * (r >> 2);
        if ((unsigned)(dq - c) >= W) p0[r] = NEG;
        if ((unsigned)(dq - c - 32) >= W) p1[r] = NEG; }
}
__device__ __forceinline__ void mask_all(f32x16& p0, f32x16& p1, bool on) {
    const float NEG = -__builtin_inff();
#pragma unroll
    for (int r = 0; r < 16; ++r) { p0[r] = on ? p0[r] : NEG; p1[r] = on ? p1[r] : NEG; }
}
__device__ __forceinline__ void partialSM(f32x16& p0, f32x16& p1, float& m_reg, float& mn, float& alpha) {
    float pmax = p0[0]; for (int r = 1; r < 16; ++r) pmax = fmaxf(pmax, p0[r]); for (int r = 0; r < 16; ++r) pmax = fmaxf(pmax, p1[r]);
    { auto rr = __builtin_amdgcn_permlane32_swap(__float_as_uint(pmax), __float_as_uint(pmax), false, false);
      pmax = fmaxf(__uint_as_float(rr[0]), __uint_as_float(rr[1])); }
    constexpr float C2 = 1.4426950408889634f * SCALE;
    if (__builtin_expect(__all((pmax - m_reg) * SCALE <= THR), 1)) { mn = m_reg; alpha = 1.f; }
    else { mn = fmaxf(m_reg, pmax); alpha = __builtin_amdgcn_exp2f((m_reg - mn) * C2); m_reg = mn; }
    const float mnL = -mn * C2;
    for (int r = 0; r < 16; ++r) p0[r] = fmaf(p0[r], C2, mnL); for (int r = 0; r < 16; ++r) p1[r] = fmaf(p1[r], C2, mnL);
    for (int r = 0; r < 16; ++r) p0[r] = __builtin_amdgcn_exp2f(p0[r]);
}
__device__ __forceinline__ void finishSM(f32x16& p0, f32x16& p1, float alpha, float& l_reg, bf16x8& pa0, bf16x8& pa1, bf16x8& pa2, bf16x8& pa3) {
    for (int r = 0; r < 16; ++r) p1[r] = __builtin_amdgcn_exp2f(p1[r]);
    float ps = 0; for (int r = 0; r < 16; ++r) ps += p0[r]; for (int r = 0; r < 16; ++r) ps += p1[r];
    { auto rr = __builtin_amdgcn_permlane32_swap(__float_as_uint(ps), __float_as_uint(ps), false, false);
      ps = __uint_as_float(rr[0]) + __uint_as_float(rr[1]); }
    l_reg = l_reg * alpha + ps;
#define PK4(P, B_, OUT) do { unsigned a0 = cvtpk(P[B_+0], P[B_+1]), a1 = cvtpk(P[B_+2], P[B_+3]);                          \
        unsigned b0 = cvtpk(P[B_+4], P[B_+5]), b1 = cvtpk(P[B_+6], P[B_+7]);                                             \
        auto r0 = __builtin_amdgcn_permlane32_swap(a0, b0, false, false); auto r1 = __builtin_amdgcn_permlane32_swap(a1, b1, false, false); \
        u32x4 w = {r0[0], r1[0], r0[1], r1[1]}; OUT = *reinterpret_cast<bf16x8*>(&w); } while (0)
    PK4(p0, 0, pa0); PK4(p0, 8, pa1); PK4(p1, 0, pa2); PK4(p1, 8, pa3);
#undef PK4
}
template <int KB>
__device__ __forceinline__ void qkt(f32x16& p0, f32x16& p1, const char* K_lds, int r32, int hi, const bf16x8* qr) {
    p0 = f32x16{}; p1 = f32x16{};
    const char* kb[4];
#pragma unroll
    for (int dd = 0; dd < 4; ++dd) kb[dd] = K_lds + KB * SHM_K + KSWZ(r32, (dd * 16 + hi * 8) * 2);
#pragma unroll
    for (int d0 = 0; d0 < 8; ++d0) { const char* a = kb[d0 & 3] + (d0 >> 2) * 128;
        bf16x8 b0 = *reinterpret_cast<const bf16x8*>(a);
        bf16x8 b1 = *reinterpret_cast<const bf16x8*>(a + 32 * 256);
        p0 = __builtin_amdgcn_mfma_f32_32x32x16_bf16(b0, qr[d0], p0, 0, 0, 0);
        p1 = __builtin_amdgcn_mfma_f32_32x32x16_bf16(b1, qr[d0], p1, 0, 0, 0); }
}
template <int VB>
__device__ __forceinline__ void pv_tile(f32x16* o, int vb0, bf16x8 pa0, bf16x8 pa1, bf16x8 pa2, bf16x8 pa3) {
#define TRRD(dst, off) asm volatile("ds_read_b64_tr_b16 %0, %1 offset:%2" : "=&v"(dst) : "v"(vb0), "i"(off) : "memory")
#define PV_D0(d0) do { s16x4 l0, l1, l2, l3, h0, h1, h2, h3; constexpr int b_ = VB * SHM_V + v_rd_off(d0, 0, 0);   \
        TRRD(l0, b_); TRRD(h0, b_ + 2048); TRRD(l1, b_ + 4096); TRRD(h1, b_ + 6144); TRRD(l2, b_ + 8192); TRRD(h2, b_ + 10240); TRRD(l3, b_ + 12288); TRRD(h3, b_ + 14336); \
        asm volatile("s_waitcnt lgkmcnt(0)" ::: "memory"); SBAR();   \
        o[d0] = __builtin_amdgcn_mfma_f32_32x32x16_bf16(pa0, (bf16x8){l0[0], l0[1], l0[2], l0[3], h0[0], h0[1], h0[2], h0[3]}, o[d0], 0, 0, 0);   \
        o[d0] = __builtin_amdgcn_mfma_f32_32x32x16_bf16(pa1, (bf16x8){l1[0], l1[1], l1[2], l1[3], h1[0], h1[1], h1[2], h1[3]}, o[d0], 0, 0, 0);   \
        o[d0] = __builtin_amdgcn_mfma_f32_32x32x16_bf16(pa2, (bf16x8){l2[0], l2[1], l2[2], l2[3], h2[0], h2[1], h2[2], h2[3]}, o[d0], 0, 0, 0);   \
        o[d0] = __builtin_amdgcn_mfma_f32_32x32x16_bf16(pa3, (bf16x8){l3[0], l3[1], l3[2], l3[3], h3[0], h3[1], h3[2], h3[3]}, o[d0], 0, 0, 0); } while (0)
    PV_D0(0); PV_D0(1); PV_D0(2); PV_D0(3);
#undef PV_D0
#undef TRRD
}
struct BlockRef { const bf16* Q; const bf16* K; const bf16* V; int P0, tok0, hh; };
struct Seam { bf16x8 qr[8]; bf16x8 st_v0, st_v1, st_k0, st_k1; };
__device__ __forceinline__ int swa_jlo(int P0, int W) { const int lowk = P0 - W + 1; return lowk > 0 ? lowk / KVBLK : 0; }
#define ROW(p, k0, rr) ((p) + (size_t)((k0) + (rr)) * D + sc)
#define VMW() asm volatile("s_waitcnt vmcnt(0)" ::: "memory")
#define VMWN(n) asm volatile("s_waitcnt vmcnt(%0)" :: "i"(n) : "memory")
#define SLOAD_H(Kp, Vp, k0) do { S.st_v0 = load8(ROW(Vp, k0, sr)); S.st_v1 = load8(ROW(Vp, k0, 32 + sr));              \
                         S.st_k0 = load8(ROW(Kp, k0, sr)); S.st_k1 = load8(ROW(Kp, k0, 32 + sr)); } while (0)
#define SWRITE_HK(bf) do { *(bf16x8*)(K_lds + (bf) * SHM_K + kws) = S.st_k0; *(bf16x8*)(K_lds + (bf) * SHM_K + kws + 32 * 256) = S.st_k1; } while (0)
#define SWRITE_HV(bf) do { *(bf16x8*)(V_lds + (bf) * SHM_V + vst0) = S.st_v0; *(bf16x8*)(V_lds + (bf) * SHM_V + vst1) = S.st_v1; } while (0)
#define SWRITE_H(bf) do { SWRITE_HV(bf); SWRITE_HK(bf); } while (0)
__device__ __forceinline__ int lane_id() { return (int)__builtin_amdgcn_mbcnt_hi(~0u, __builtin_amdgcn_mbcnt_lo(~0u, 0u)); }
__device__ __forceinline__ void prime(const BlockRef& cur, int W, char* lds, Seam& S, int wid) {
    (void)wid; const int tid = threadIdx.x, lane = tid & 63, r32 = lane & 31, hi = lane >> 5;
    const int sr = tid >> 4, sc = (tid & 15) * 8, kws = KSWZ(sr, sc * 2); char* K_lds = lds + 2 * SHM_V;
    const int kb0 = swa_jlo(cur.P0, W) * KVBLK;
    for (int d0 = 0; d0 < 8; ++d0) S.qr[d0] = load8(cur.Q + (size_t)(wid * QBLK + r32) * D + d0 * 16 + hi * 8);
    SLOAD_H(cur.K, cur.V, kb0); VMW(); SWRITE_HK(0);
    __syncthreads();
}
template <bool SEL, int MODE>
__device__ __forceinline__ void block(const BlockRef& cur, const BlockRef& nxt, int skv, int W, char* lds, Seam& S,
                                      const unsigned long long* SELM, const float* GATES, int gate_off, float* OACC, bf16* OCAT, int wid) {
    (void)wid; const int tid = threadIdx.x, lane = tid & 63, r32 = lane & 31, hi = lane >> 5;
    const int j_lo = swa_jlo(cur.P0, W);
    int j_hi = (cur.P0 + QB - 1) / KVBLK + 1; if (j_hi > skv / KVBLK) j_hi = skv / KVBLK;
    const int NT = j_hi - j_lo;
    const int kbn = swa_jlo(nxt.P0, W) * KVBLK;
    const int qlo = cur.P0 + wid * QBLK, qm = qlo + r32 - 4 * hi;
    char* V_lds = lds; char* K_lds = lds + 2 * SHM_V;
    float* ws = (float*)(lds + 2 * SHM_V + 2 * SHM_K) + wid * 64; float* li_l = ws, * al_l = ws + 32;
    float m_reg = -1e30f, l_reg = 0; f32x16 o[4] = {};
    const int sr = tid >> 4, sc = (tid & 15) * 8, vst0 = v_st(sr, sc), vst1 = vst0 + 8192  , kws = KSWZ(sr, sc * 2);
    const int vb0 = (int)(uintptr_t)V_lds + v_rd_base(lane);
    const bf16* Kh = cur.K; const bf16* Vh = cur.V;
    unsigned long long* selt = (unsigned long long*)(lds + LDS_BYTES) + wid * 32;
    if (SEL) { if (hi == 0) selt[r32] = SELM[(size_t)(cur.tok0 + wid * QBLK + r32) * 4 + (cur.hh >> 2)]; }
#define RESC(a) do { if (__any((a) < 1.f)) { if (hi == 0) al_l[r32] = (a); asm volatile("s_waitcnt lgkmcnt(0)" ::: "memory");              \
                     for (int d_ = 0; d_ < 4; ++d_) for (int r = 0; r < 16; ++r) o[d_][r] *= al_l[crow(r, hi)]; } } while (0)
#define KBASE(t) ((j_lo + (t)) * KVBLK)
#define MASKT(P0_, P1_, t) do { const int kb_ = KBASE(t); if (kb_ + KVBLK - 1 > qlo || kb_ <= qlo + QBLK - 1 - W) mask_tile(P0_, P1_, qm - kb_, (unsigned)W); \
                                if (SEL) { const unsigned long long sm_ = selt[r32]; mask_all(P0_, P1_, ((sm_ >> (j_lo + (t))) & 1ull) != 0ull); } } while (0)
    constexpr int NQL = 8;
#define SEAM_K0() do { VMWN(NQL); SWRITE_HK(0); SBAR(); } while (0)
    f32x16 pA0, pA1, pB0, pB1; float mnA, mnB, alA, alB; bf16x8 pa0, pa1, pa2, pa3;
    SWRITE_HV(0); SBAR();
    if (NT > 1) { SLOAD_H(Kh, Vh, KBASE(1)); }
    SBAR(); qkt<0>(pA0, pA1, K_lds, r32, hi, S.qr);
    MASKT(pA0, pA1, 0); partialSM(pA0, pA1, m_reg, mnA, alA);
    if (NT > 1) { VMW(); SWRITE_H(1); }
    __syncthreads();
#define HALF_STEP(PX0, PX1, mnX, alX, PY0, PY1, alY, t, KB, VB, SB) do {                                                      \
        SBAR(); qkt<KB>(PX0, PX1, K_lds, r32, hi, S.qr);                                             \
        finishSM(PY0, PY1, alY, l_reg, pa0, pa1, pa2, pa3); SBAR();                                                           \
        if ((t) + 1 < NT) { SLOAD_H(Kh, Vh, KBASE((t) + 1)); SBAR(); }                                               \
        pv_tile<VB>(o, vb0, pa0, pa1, pa2, pa3); MASKT(PX0, PX1, (t)); partialSM(PX0, PX1, m_reg, mnX, alX);                                        \
        __syncthreads();                                                                                                      \
        if ((t) + 1 < NT) { VMW(); SWRITE_H(SB); }                                                                          \
        RESC(alX); __syncthreads(); } while (0)
    for (int t = 1; t + 1 < NT; t += 2) {
        HALF_STEP(pB0, pB1, mnB, alB, pA0, pA1, alA, t, 1, 0, 0);
        HALF_STEP(pA0, pA1, mnA, alA, pB0, pB1, alB, t + 1, 0, 1, 1);
    }
    const bool even = (NT & 1) == 0;
    if (even) { SBAR(); qkt<1>(pB0, pB1, K_lds, r32, hi, S.qr); SBAR(); }
    SLOAD_H(nxt.K, nxt.V, kbn); SBAR();
#pragma unroll
    for (int d0 = 0; d0 < 8; ++d0) S.qr[d0] = load8(nxt.Q + (size_t)(wid * QBLK + r32) * D + d0 * 16 + hi * 8);
    SBAR();
    finishSM(pA0, pA1, alA, l_reg, pa0, pa1, pa2, pa3); SBAR();
    pv_tile<0>(o, vb0, pa0, pa1, pa2, pa3);
    if (even) { MASKT(pB0, pB1, NT - 1); partialSM(pB0, pB1, m_reg, mnB, alB); __syncthreads(); RESC(alB);
        finishSM(pB0, pB1, alB, l_reg, pa0, pa1, pa2, pa3); SBAR(); pv_tile<1>(o, vb0, pa0, pa1, pa2, pa3); }
    SBAR(); SEAM_K0();
    if (hi == 0) li_l[r32] = l_reg; asm volatile("s_waitcnt lgkmcnt(0)" ::: "memory");
    { const int le = lane_id(), r32e = le & 31, hie = le >> 5;
      const int tokw = cur.tok0 + wid * QBLK; const float* gp = GATES + (size_t)tokw * 48 + gate_off + cur.hh;
      float* op = OACC + (size_t)tokw * DM + cur.hh * 128; bf16* cp = OCAT + (size_t)tokw * DM + cur.hh * 128;
#pragma unroll
      for (int r = 0; r < 16; ++r) { const int orow = crow(r, hie);
        const float sc_ = gp[orow * 48] * __builtin_amdgcn_rcpf(li_l[orow]);
        const unsigned ob = (unsigned)(orow * DM + r32e);
#pragma unroll
        for (int d0 = 0; d0 < 4; ++d0) { const float v = op[ob + d0 * 32] + o[d0][r] * sc_;
            if (MODE == 0) ((unsigned*)op)[ob + d0 * 32] = __float_as_uint(v);
            else cp[ob + d0 * 32] = (bf16)(cvtpk(v, v) & 0xffffu); } } }
    __syncthreads();
#undef RESC
#undef KBASE
#undef MASKT
#undef SEAM_K0
#undef HALF_STEP
}
#undef ROW
#undef VMW
#undef VMWN
#undef SLOAD_H
#undef SWRITE_HK
#undef SWRITE_HV
#undef SWRITE_H
__device__ __forceinline__ int swa_nramp(int nqb, int W) { const int t = W - 1; const int n = t < 0 ? 0 : t / QB + 1; return n > nqb ? nqb : n; }
struct SwaItem { int bh, qb0, qb1; };
__device__ __forceinline__ SwaItem swa_decode(int L, int nqb, int nx, int nramp) {
    SwaItem it; it.bh = L / nx; const int x = L - it.bh * nx; const int ns = nqb - nramp;
    if (x < ns) { it.qb0 = it.qb1 = nqb - 1 - x; } else { it.qb0 = x - ns; it.qb1 = nramp - 1 - it.qb0; }
    return it;
}
template <bool SEL, int MODE>
__device__ __forceinline__ void phase(int wid, char* lds, const bf16* Q, const bf16* K, const bf16* V, int W, const unsigned long long* SELM, const float* GATES, int gate_off, float* OACC, bf16* OCAT) {
    constexpr int nqb = SEQ / QB;
    const int nramp = swa_nramp(nqb, W), nx = (nramp + 1) / 2 + (nqb - nramp), total = nx * BATCH * 16, stride = gridDim.x;
    int L = blockIdx.x; if (L >= total) return;
    auto mkref = [&](const SwaItem& it, int pass) { const int qb = pass ? it.qb1 : it.qb0, b = it.bh >> 4, hh = it.bh & 15; BlockRef r;
        r.Q = Q + ((size_t)it.bh * SEQ + (size_t)qb * QB) * D; r.K = K + (size_t)(b * 4 + (hh >> 2)) * SPAD * D; r.V = V + (size_t)(b * 4 + (hh >> 2)) * SPAD * D;
        r.P0 = qb * QB; r.tok0 = b * SEQ + qb * QB; r.hh = hh; return r; };
    SwaItem it = swa_decode(L, nqb, nx, nramp); int pass = 0;
    BlockRef cur = mkref(it, 0);
    Seam S;
    __syncthreads();
    prime(cur, W, lds, S, wid);
    for (;;) {
        const bool more_pass = pass == 0 && it.qb1 != it.qb0, more_item = L + stride < total, last = !more_pass && !more_item;
        SwaItem itn = it; int passn = pass + 1, Ln = L;
        if (!more_pass) { passn = 0; Ln = more_item ? L + stride : L; itn = swa_decode(Ln, nqb, nx, nramp); }
        const BlockRef nxt = last ? cur : mkref(itn, passn);
        block<SEL, MODE>(cur, nxt, SEQ, W, lds, S, SELM, GATES, gate_off, OACC, OCAT, wid);
        if (last) break;
        cur = nxt; it = itn; pass = passn; L = Ln;
    }
}
#undef KSWZ
#undef SBAR
}

#ifndef REPEAT_PHASE
#define REPEAT_PHASE -1
#endif
#ifndef PROBE_LO
#define PROBE_LO 22
#define PROBE_HI 22
#define PROBE_SCALE 0.1f
#endif
#ifndef PROBE
#define PROBE 0
#endif
__device__ __forceinline__ void probe_compare(const Ctx& C, const bf16* Xa, const bf16* Xb, size_t n) {
    float se = 0.f, sr = 0.f;
    for (size_t i = (size_t)C.bid * NTHR + C.tid; i < n; i += (size_t)C.G * NTHR) { const float a = bf2f(Xa[i]), b = bf2f(Xb[i]); se += (a - b) * (a - b); sr += b * b; }
    se = wave_sum(se); sr = wave_sum(sr);
    if (C.lane == 0) { atomicAdd(WSP(float, WS_CTL) + CW_PROBE, se); atomicAdd(WSP(float, WS_CTL) + CW_PROBE + 1, sr); }
}
#ifndef MK_SPLIT
#define MK_SPLIT 0
#endif
constexpr int N_PHASES = 39;
#define COMMON_PHASES(l, pb) \
      \
      \
    if (IN(pb + 1)) { FRESH_TID(); pg8::Gemm g{WSP(bf16, WS_XR), WSP(bf16, WS_WKT) + (size_t)l * 4 * 1024 * DM, DM, DM, DM}; \
                      CrossOrder S{4, G, c, 1024, (long long)256 * DM * 2, (long long)256 * DM * 2, (long long)1024 * DM * 2}; EpiSoftmaxP E{ARP(bf16, A_PC), 1024, WSP(float, WS_RSQ) + (size_t)(2 * l) * T * 8, (LAS float*)(C.lds + LDS_AUX)}; pg8::gemm_phase(L, g, S, E, C.tid); } SEAM(pb + 1); \
      \
    if (IN(pb + 3)) { FRESH_TID(); pg8::Gemm g{ARP(bf16, A_PC), WSP(bf16, WS_VWT) + (size_t)l * 4 * DM * 1024, 1024, 1024, 1024}; \
                      CrossOrder S{8, G, c, DM, (long long)256 * 1024 * 2, (long long)256 * 1024 * 2, (long long)DM * 1024 * 2}; EpiResidT<false> E{WSP(bf16, WS_XR), WSP(bf16, WS_XR), DM, WSP(float, WS_RSQ) + (size_t)(2 * l + 1) * T * 8, (LAS float*)(C.lds + LDS_AUX)}; pg8::gemm_phase(L, g, S, E, C.tid); } SEAM(pb + 3); \
      \
      \
    if (IN(pb + 5)) { FRESH_TID(); pg8::Gemm g{WSP(bf16, WS_XR), WSP(bf16, WS_W_ROUTER) + (size_t)l * 256 * DM, DM, DM, 512}; RouterOrder S{G, c}; EpiStoreF32Rows E{ARP(float, A_XS), 256, WSP(float, WS_RSQ) + (size_t)(2 * l + 1) * T * 8};     pg8::gemm_phase(L, g, S, E, C.tid); } SEAM(pb + 5); \
    if (IN(pb + 6)) { FRESH_TID(); phase_route(C, A, l); } SEAM(pb + 6); \
    if (IN(pb + 7)) { FRESH_TID(); phase_gather(C, l); } SEAM(pb + 7); \
    if (IN(pb + 8)) { FRESH_TID(); const bool side_ = (l == 0) && (G == 256) && MOE_CVT_SIDE_H > 0; const int Gm_ = side_ ? G - MOE_CVT_WG : G; \
                      if (side_ && c >= Gm_) moe_convert_items_x2(C, MOE_CVT_BASE_H, MOE_CVT_BASE_H + MOE_CVT_SIDE_H, (c - Gm_) * NWAVES + C.wave, MOE_CVT_WG * NWAVES); else { \
                      LAS int* tab = (LAS int*)(C.lds + LDS_AUX); moe_build_table(C, ctl + CW_MOE_CNT + l * 64, tab); \
                      pg8::Gemm g{WSP(bf16, WS_XR), WSP(bf16, WS_W_GU) + (size_t)l * NEXP * 1024 * DM, DM, DM, DM}; MoeOrder S{tab, 4, Gm_, c, 0}; EpiHid E{ARP(bf16, A_HID), ARP(int, A_ROWSLOT), WSP(float, WS_RSQ) + (size_t)(2 * l + 1) * T * 8}; \
                      LAS int* rc = tab + 256; { pg8::Unit u_; const int* rs_ = ARP(int, A_ROWSLOT); for (int i_ = 0; i_ < 12 && S.next(i_, u_); ++i_) if (C.tid < 256) rc[i_ * 256 + C.tid] = (C.tid < u_.pm) ? (rs_[u_.aux + C.tid] >> 1) : 0; } __syncthreads(); \
                      pg8::gemm_phase<EpiHid, MoeOrder, true>(L, g, S, E, C.tid, rc); } } SEAM(pb + 8); \
    if (IN(pb + 9)) { FRESH_TID(); const bool side_ = (l == 0) && (G == 256) && MOE_CVT_SIDE_H2 > 0; const int Gm_ = side_ ? G - MOE_CVT_WG : G; \
                      if (side_ && c >= Gm_) moe_convert_items_x2(C, MOE_CVT_BASE_H2, MOE_CVT_BASE_H2 + MOE_CVT_SIDE_H2, (c - Gm_) * NWAVES + C.wave, MOE_CVT_WG * NWAVES); else { \
                      LAS int* tab = (LAS int*)(C.lds + LDS_AUX); moe_build_table(C, ctl + CW_MOE_CNT + l * 64, tab); \
                      pg8::Gemm g{ARP(bf16, A_HID), WSP(bf16, WS_W_DN) + (size_t)l * NEXP * DM * FF, FF, FF, FF}; MoeOrder S{tab, 8, Gm_, c, 1}; EpiMoeDown E{ARP(int, A_ROWSLOT), ARP(float, A_WTS), ARP(bf16, A_YE)}; pg8::gemm_phase(L, g, S, E, C.tid); } } SEAM(pb + 9); \
    if (IN(pb + 10)) { FRESH_TID(); if (l == 0) phase_combine_norm(C, nullptr, nullptr); else phase_combine_norm(C, INP(I_NORM_FINAL), ((float*)INP(N_INPUTS))); } \
    if (l == 0) SEAM(pb + 10);

__global__ void __launch_bounds__(NTHR, 2) mk_fwd(Args args) {
    extern __shared__ __attribute__((aligned(16))) unsigned char lds_raw[];
    Ctx C; C.lds = (LAS unsigned char*)lds_raw; C.tid = threadIdx.x; C.lane = C.tid & 63; C.wave = __builtin_amdgcn_readfirstlane(C.tid >> 6);
    C.G = gridDim.x; C.bid = blockIdx.x; C.gw = C.bid * NWAVES + C.wave; C.ngw = C.G * NWAVES; C.ws = args.ws;
    const Args& A = args; (void)A;
    volatile LAS unsigned* MISC = (volatile LAS unsigned*)(C.lds + LDS_MISC);
    if (C.tid < 64) MISC[C.tid] = 0u;
    if (C.tid <= N_INPUTS) ((LAS unsigned long long*)(C.lds + LDS_PTAB))[C.tid] = (C.tid < N_INPUTS) ? (unsigned long long)args.in[C.tid < N_INPUTS ? C.tid : 0] : (unsigned long long)args.out;
    __syncthreads();
    unsigned* ctl = WSP(unsigned, WS_CTL);
    const int lo = args.ph_lo, hi = args.ph_hi;
    XcdBarrier bar; bar.bar = ctl + CW_BAR; bar.x = 0; bar.st = MISC + 8;
    if (hi - lo > 1) bar = xcd_barrier_post(ctl + CW_BAR, MISC + 8);
#ifndef ONLY_PHASE
#define ONLY_PHASE -1
#endif
#define FRESH_TID() do { int t_ = threadIdx.x; asm volatile("" : "+v"(t_)); C.tid = t_; C.lane = t_ & 63; } while (0)
#define IN(k) ((ONLY_PHASE < 0 || ONLY_PHASE == (k)) && lo <= (k) && (k) < hi)
#if PROBE == 2
    unsigned long long tA_ = 0, tB_ = 0;
    if (PROBE_LO == 0) tA_ = __builtin_amdgcn_s_memrealtime();
#define SEAM(k) do { if (IN(k) && IN((k) + 1)) xcd_barrier(bar); if ((k) == PROBE_LO - 1) tA_ = __builtin_amdgcn_s_memrealtime(); if ((k) == PROBE_HI) tB_ = __builtin_amdgcn_s_memrealtime(); } while (0)
#else
#define SEAM(k) do { if (IN(k) && IN((k) + 1)) xcd_barrier(bar); } while (0)
#endif
    LAS unsigned char* L = C.lds;
    const int c = C.bid, G = C.G;

    if (IN(0)) { FRESH_TID(); for (int rep = 0; rep < (REPEAT_PHASE == 0 ? 2 : 1); ++rep) phase_prologue(C, A); } SEAM(0);
    if (IN(3)) { FRESH_TID(); const bool side = (G == 256) && MOE_CVT_SIDE_A > 0; const int Gg = side ? G - MOE_CVT_WG : G;
                 if (c < Gg) { pg8::Gemm g{(const bf16*)C.ws, (const bf16*)C.ws, DM, DM, DM}; AbInMemOrder S; S.d.init(T, AB_PAD, DM, DM, AB_PAD, Gg, c); S.m = MemProjOrder{Gg, c};
                               EpiAbInMem E{EpiAbIn{ARP(bf16, A_PAB), ARP(float, A_GF32)}, EpiStoreBf16{WSP(bf16, WS_KP), DM, 1.f}}; pg8::gemm_phase(L, g, S, E, C.tid); }
                 else moe_convert_items(C, MOE_CVT_TOTAL - MOE_CVT_SIDE_A - MOE_CVT_SIDE_B, MOE_CVT_TOTAL - MOE_CVT_SIDE_B, (c - Gg) * NWAVES + C.wave, MOE_CVT_WG * NWAVES); } SEAM(3);
    if (IN(4)) { FRESH_TID(); phase_mixer_prep(C, A); } SEAM(4);
    if (IN(5)) { FRESH_TID(); if (C.bid < 16 && C.wave == 0) ml_gate_scan(C, C.bid);
                 pg8::Gemm g{ARP(bf16, A_LIN), WSP(bf16, WS_W_LORA), 256, 256, 256}; pg8::DenseOrder S; S.init(T, 3072, 256, 256, 3072, G, c);
                 EpiLora E{INP(I_RW_W0), INP(I_RW_A0), INP(I_RW_K_A), ARP(bf16, A_KK), ARP(bf16, A_KR), ARP(float, A_WD), ARP(bf16, A_BV), ARP(bf16, A_KP), ARP(bf16, A_GG)}; pg8::gemm_phase(L, g, S, E, C.tid);
                 { pg8::Gemm g2{WSP(bf16, WS_KP), WSP(bf16, WS_W_CAQ), DM, DM, 512}; WktOrder S2{G, c}; EpiStoreBf16 E2{WSP(bf16, WS_WKT), DM, 0.04419417382415922f}; pg8::gemm_phase(L, g2, S2, E2, C.tid); }
                 { pg8::Gemm g3{WSP(bf16, WS_W_CAO), WSP(bf16, WS_VP), DM, DM, 512}; VwtOrder S3{G, c}; EpiStoreBf16 E3{WSP(bf16, WS_VWT), 1024, 1.f}; pg8::gemm_phase(L, g3, S3, E3, C.tid); } } SEAM(5);
    if (IN(6)) { FRESH_TID(); rwkv_prep_units(C, G == 256); for (int it = C.bid; it < 1024; it += G) ml_intra_unit(C, it, G == 256); } SEAM(6);
    if (IN(7)) { FRESH_TID(); for (int it = C.bid; it < 256; it += G) rwkv_scan_slice(C, it); ml_state_scan(C, 0, G); } SEAM(7);
    if (IN(8)) { FRESH_TID(); for (int it = C.bid; it < 1024; it += G) ml_out_unit(C, it, (G == 256) && MOE_CVT_SIDE_G > 0); rwkv_out_items(C); } SEAM(8);
    if (IN(9)) { FRESH_TID(); pg8::Gemm g{ARP(bf16, A_YCAT), WSP(bf16, WS_W_ABOUT), DM, DM, DM}; pg8::DenseOrder S; S.init(T, DM, DM, DM, DM, G, c); EpiResidT<true> E{INP(I_X), WSP(bf16, WS_XR), DM, WSP(float, WS_RSQ), (LAS float*)(C.lds + LDS_AUX)}; pg8::gemm_phase(L, g, S, E, C.tid); } SEAM(9);
    COMMON_PHASES(0, 10)
    if (IN(21)) { FRESH_TID(); const bool side = (G == 256); const int Gg = side ? G - MOE_CVT_WG : G;
                  if (c >= Gg) moe_convert_items_x2(C, MOE_CVT_TOTAL - MOE_CVT_SIDE_B, MOE_CVT_TOTAL, (c - Gg) * NWAVES + C.wave, MOE_CVT_WG * NWAVES); else {
                  pg8::Gemm g{WSP(bf16, WS_XR), WSP(bf16, WS_W_NSAIN), DM, DM, DM}; pg8::DenseOrder S; S.init(T, NSA_PAD, DM, DM, NSA_PAD, Gg, c);
                  EpiNsaIn E{ARP(bf16, A_Q), ARP(bf16, A_QROT), ARP(bf16, A_KV6), ARP(float, A_GATES), INP(I_NSA_GATE_B), WSP(float, WS_TAB + TAB_ROPE_COS), WSP(float, WS_TAB + TAB_ROPE_SIN), WSP(float, WS_RSQ) + (size_t)4 * T * 8}; pg8::gemm_phase(L, g, S, E, C.tid); } } SEAM(21);
    if (IN(22)) { FRESH_TID(); pg8::Gemm g{ARP(bf16, A_KV6), WSP(bf16, WS_W_CMP1), 2048, 4096, 512}; CmpOrder S{G, c}; EpiStoreF32 E{ARP(float, A_CPART), 256}; pg8::gemm_phase(L, g, S, E, C.tid); } SEAM(22);
    if (IN(23)) { FRESH_TID(); phase_cmp_finish(C, A); } SEAM(23);
    if (IN(24)) { FRESH_TID(); for (int rep = 0; rep < (REPEAT_PHASE == 24 ? 2 : 1); ++rep) phase_cmp_attn_mma(C, G == 256); } SEAM(24);
#if PROBE == 1
    if (IN(25)) { FRESH_TID(); phase_selwin_naive(C, ARP(bf16, A_OCATREF)); xcd_barrier(bar); }
#endif
    if (IN(25)) { FRESH_TID(); swa::phase<true, 0>(C.wave, (char*)lds_raw, ARP(bf16, A_QROT), (const bf16*)(C.ws + WS_ARENA + A_KV6 + 2 * KV6_STRIDE), (const bf16*)(C.ws + WS_ARENA + A_KV6 + 3 * KV6_STRIDE), SEQ,
                                      ARP(const unsigned long long, A_SELMASK), ARP(float, A_GATES), 16, ARP(float, A_OACC), ARP(bf16, A_OCAT)); } SEAM(25);
    if (IN(26)) { FRESH_TID(); swa::phase<false, 1>(C.wave, (char*)lds_raw, ARP(bf16, A_QROT), (const bf16*)(C.ws + WS_ARENA + A_KV6 + 4 * KV6_STRIDE), (const bf16*)(C.ws + WS_ARENA + A_KV6 + 5 * KV6_STRIDE), 512,
                                       ARP(const unsigned long long, A_SELMASK), ARP(float, A_GATES), 32, ARP(float, A_OACC), ARP(bf16, A_OCAT)); } SEAM(26);
#if PROBE == 1
    if (IN(26)) { FRESH_TID(); probe_compare(C, ARP(bf16, A_OCAT), ARP(bf16, A_OCATREF), (size_t)T * DM); }
#endif
    { int t2 = C.wave * 64 + swa::lane_id(); asm volatile("" : "+v"(t2)); C.tid = t2 & 511; C.lane = t2 & 63; }
    if (IN(27)) { FRESH_TID(); pg8::Gemm g{ARP(bf16, A_OCAT), WSP(bf16, WS_W_NSAOUT), DM, DM, DM}; pg8::DenseOrder S; S.init(T, DM, DM, DM, DM, G, c); EpiResidT<false> E{WSP(bf16, WS_XR), WSP(bf16, WS_XR), DM, WSP(float, WS_RSQ) + (size_t)2 * T * 8, (LAS float*)(C.lds + LDS_AUX)}; pg8::gemm_phase(L, g, S, E, C.tid); } SEAM(27);
    COMMON_PHASES(1, 28)
#if PROBE == 2
    xcd_barrier(bar);
    if (C.bid == 0 && C.tid == 0) ((float*)INP(N_INPUTS))[0] = (float)(tB_ - tA_) * (0.01f * PROBE_SCALE);
#elif PROBE
    xcd_barrier(bar);
    if (C.bid == 0 && C.tid == 0) { const float se = __hip_atomic_load((float*)(ctl + CW_PROBE), __ATOMIC_RELAXED, __HIP_MEMORY_SCOPE_AGENT), sr = __hip_atomic_load((float*)(ctl + CW_PROBE + 1), __ATOMIC_RELAXED, __HIP_MEMORY_SCOPE_AGENT);
        ((float*)INP(N_INPUTS))[0] = 1e6f * sqrtf(se / fmaxf(sr, 1e-30f)); }
#endif
#undef IN
#undef SEAM
}

extern "C" void kernel_launch(void* const* d_in, const int* in_sizes, int n_in, void* d_out, int out_size, void* d_ws, size_t ws_size, hipStream_t stream) {
    static int grid = 0;
    if (grid == 0) {
        if (n_in != N_INPUTS || out_size != T * DM || ws_size < WS_END) { fprintf(stderr, "kernel_launch: unexpected shapes (n_in %d, out %d, ws %zu, need %zu)\n", n_in, out_size, ws_size, (size_t)WS_END); grid = -1; return; }
        int dev = 0, cus = 0, per_cu = 0;
        if (hipGetDevice(&dev) != hipSuccess || hipDeviceGetAttribute(&cus, hipDeviceAttributeMultiprocessorCount, dev) != hipSuccess) { grid = -1; return; }
        if (hipFuncSetAttribute((const void*)mk_fwd, hipFuncAttributeMaxDynamicSharedMemorySize, LDS_BYTES) != hipSuccess) { fprintf(stderr, "kernel_launch: hipFuncSetAttribute failed\n"); grid = -1; return; }
        if (hipOccupancyMaxActiveBlocksPerMultiprocessor(&per_cu, (const void*)mk_fwd, NTHR, LDS_BYTES) != hipSuccess || per_cu < 1) fprintf(stderr, "kernel_launch: occupancy query says %d\n", per_cu);
        (void)hipGetLastError();
        grid = cus;
    }
    if (grid < 0) return;
    (void)hipMemsetAsync((char*)d_ws + WS_CTL, 0, CTL_BYTES, stream);
    Args a{};
    for (int i = 0; i < N_INPUTS; ++i) a.in[i] = (const float*)d_in[i];
    a.out = (float*)d_out; a.ws = (unsigned char*)d_ws;
#if MK_SPLIT
    for (int p = 0; p < N_PHASES; ++p) { a.ph_lo = p; a.ph_hi = p + 1; hipLaunchKernelGGL(mk_fwd, dim3(grid), dim3(NTHR), LDS_BYTES, stream, a); }
#else
    a.ph_lo = 0; a.ph_hi = N_PHASES; hipLaunchKernelGGL(mk_fwd, dim3(grid), dim3(NTHR), LDS_BYTES, stream, a);
#endif
}
```

```cpp
#include <hip/hip_runtime.h>
#include <cstdio>
#include <cstdint>

#define LAS __attribute__((address_space(3)))
#define GAS __attribute__((address_space(1)))
typedef unsigned short bf16;
typedef short bf16x8 __attribute__((ext_vector_type(8)));
typedef float f32x4 __attribute__((ext_vector_type(4)));
typedef float f32x2 __attribute__((ext_vector_type(2)));
typedef unsigned u32x4 __attribute__((ext_vector_type(4)));
typedef unsigned u32x2 __attribute__((ext_vector_type(2)));

constexpr int BATCH = 4, SEQ = 4096, DM = 2048, T = BATCH * SEQ, MEMT = 256, MT = BATCH * MEMT;
constexpr float EPS = 1e-6f;
constexpr int ML_COLS = 3080, RW_COLS = 3328, AB_COLS = 6408, AB_PAD = 6656;
constexpr int NSA_COLS = 5168, NSA_PAD = 5376;
constexpr int NEXP = 64, FF = 512;
constexpr int XS_ROWS = 49152;
constexpr int SPAD = SEQ + 64;

enum { I_X = 0, I_MEM, I_NORM_MIX, I_NORM_CROSS, I_NORM_MEM, I_NORM_FFN, I_NORM_FINAL, I_AB_W_IN, I_ML_CONV_W, I_ML_CONV_B, I_ML_GATE_B,
       I_RW_MU, I_RW_W0, I_RW_W_UP, I_RW_A0, I_RW_A_UP, I_RW_G_UP, I_RW_K_K, I_RW_K_A, I_RW_R_K, I_RW_LN_W, I_RW_LN_B, I_AB_W_OUT,
       I_NSA_W_IN, I_NSA_GATE_B, I_CMP_POS, I_CMP_W1, I_CMP_W2, I_NSA_W_OUT, I_CA_WQ, I_CA_WK, I_CA_WV, I_CA_WO,
       I_MOE_WG, I_MOE_BG, I_MOE_WE, I_MOE_BE, I_MOE_W_GATE, I_MOE_W_UP, I_MOE_W_DOWN, N_INPUTS };

constexpr size_t MiB = (size_t)1 << 20;
constexpr size_t WS_CTL = 0, CTL_BYTES = 1 * MiB;
constexpr size_t WS_TAB = 1 * MiB;
constexpr size_t WS_W_ABIN = 3 * MiB;
constexpr size_t WS_W_ABOUT = WS_W_ABIN + 26 * MiB;
constexpr size_t WS_W_LORA = WS_W_ABOUT + 8 * MiB;
constexpr size_t WS_W_NSAIN = WS_W_LORA + 2 * MiB;
constexpr size_t WS_W_NSAOUT = WS_W_NSAIN + 21 * MiB;
constexpr size_t WS_W_CMP1 = WS_W_NSAOUT + 8 * MiB;
constexpr size_t WS_W_CAQ = WS_W_CMP1 + 4 * MiB;
constexpr size_t WS_W_CAK = WS_W_CAQ + 16 * MiB;
constexpr size_t WS_W_CAV = WS_W_CAK + 16 * MiB;
constexpr size_t WS_W_CAO = WS_W_CAV + 16 * MiB;
constexpr size_t WS_W_ROUTER = WS_W_CAO + 16 * MiB;
constexpr size_t WS_W_GU = WS_W_ROUTER + 2 * MiB;
constexpr size_t WS_W_DN = WS_W_GU + 512 * MiB;
constexpr size_t WS_MEMN = WS_W_DN + 256 * MiB;
constexpr size_t WS_KP = WS_MEMN + 8 * MiB;
constexpr size_t WS_VP = WS_KP + 8 * MiB;
constexpr size_t WS_WKT = WS_VP + 8 * MiB;
constexpr size_t WS_VWT = WS_WKT + 32 * MiB;
constexpr size_t WS_XR = WS_VWT + 32 * MiB;
constexpr size_t WS_RSQ = WS_XR + 64 * MiB;
constexpr size_t WS_XN = WS_XR + 128 * MiB;
constexpr size_t WS_ARENA = WS_XN + 64 * MiB;
constexpr size_t A_PAB = 0;
constexpr size_t A_GF32 = A_PAB + 208 * MiB;
constexpr size_t A_QM = A_GF32 + 16 * MiB;
constexpr size_t A_KM = A_QM + 16 * MiB;
constexpr size_t A_IG = A_KM + 16 * MiB;
constexpr size_t A_LF = A_IG + 1 * MiB;
constexpr size_t A_MLA = A_LF + 256 * 1024, A_MLM = A_LF + 512 * 1024;
constexpr size_t A_RR = A_LF + 1 * MiB;
constexpr size_t A_KR = A_RR + 32 * MiB;
constexpr size_t A_VR = A_KR + 32 * MiB;
constexpr size_t A_KK = A_VR + 32 * MiB;
constexpr size_t A_LIN = A_KK + 32 * MiB;
constexpr size_t A_WD = A_LIN + 8 * MiB;
constexpr size_t A_BV = A_WD + 64 * MiB;
constexpr size_t A_KP = A_BV + 32 * MiB;
constexpr size_t A_GG = A_KP + 32 * MiB;
constexpr size_t A_YCAT = A_GG + 32 * MiB;
constexpr size_t A_RWM = A_YCAT + 64 * MiB;
constexpr size_t A_RWN = A_RWM + 32 * MiB, A_RWRW = A_RWN + 32 * MiB, A_RWYL = A_RWRW + 32 * MiB;
constexpr size_t A_MLKV = A_RWYL + 32 * MiB;
constexpr size_t A_MLNUM = A_MLKV + 68 * MiB;
constexpr size_t A_END0 = A_MLNUM + 34 * MiB;
constexpr size_t A_SC = 0;
constexpr size_t A_PC = A_SC + 64 * MiB;
constexpr size_t A_LOGIT = 0;
constexpr size_t A_EID = A_LOGIT + 16 * MiB;
constexpr size_t A_WTS = A_EID + 1 * MiB;
constexpr size_t A_ROWSLOT = A_WTS + 1 * MiB;
constexpr size_t A_LRANK = A_ROWSLOT + 256 * 1024, A_BHIST = A_ROWSLOT + 512 * 1024;
constexpr size_t A_XS = A_ROWSLOT + 1 * MiB;
constexpr size_t A_HID = A_XS + 192 * MiB;
constexpr size_t A_YE = A_HID + 48 * MiB;
constexpr size_t A_END2 = A_YE + 128 * MiB;
constexpr size_t A_Q = 0;
constexpr size_t A_QROT = A_Q + 64 * MiB;
constexpr size_t A_KV6 = A_QROT + 64 * MiB;
constexpr size_t KV6_STRIDE = 17 * MiB;
constexpr size_t A_GATES = A_KV6 + 6 * KV6_STRIDE;
constexpr size_t A_CPART = A_GATES + 4 * MiB;
constexpr size_t A_KCMP = A_CPART + 64 * MiB;
constexpr size_t A_VCMP = A_KCMP + 1 * MiB;
constexpr size_t A_SELMASK = A_VCMP + 1 * MiB;
constexpr size_t A_OACC = A_SELMASK + 1 * MiB;
constexpr size_t A_OCAT = A_OACC + 128 * MiB;
constexpr size_t A_OCATREF = A_OCAT + 64 * MiB;
constexpr size_t A_VCT = A_OCATREF + 64 * MiB;
constexpr size_t A_END3 = A_VCT + 1 * MiB;
constexpr size_t ARENA_BYTES = 860 * MiB;
static_assert(A_END0 <= ARENA_BYTES && A_END2 <= ARENA_BYTES && A_END3 <= ARENA_BYTES, "arena");
constexpr size_t WS_END = WS_ARENA + ARENA_BYTES;
static_assert(WS_END <= (size_t)2048 * MiB, "workspace");
constexpr size_t TAB_ROPE_COS = 0, TAB_ROPE_SIN = 256 * 1024, TAB_CMPBIAS = 512 * 1024, TAB_RSTD = 1024 * 1024;
constexpr int CW_BAR = 4096;
constexpr int CW_MOE_CNT = 16384;
constexpr int CW_MOE_CUR = 16384 + 256;
constexpr int CW_PROBE = 32768;
constexpr int CW_RSQ = 65536;

__device__ __forceinline__ float bf2f(bf16 v) { return __uint_as_float((unsigned)v << 16); }
__device__ __forceinline__ unsigned f2bf(float f) { unsigned u = __float_as_uint(f); return (u + 0x7fffu + ((u >> 16) & 1u)) >> 16; }
__device__ __forceinline__ unsigned pk2(float lo, float hi) { return f2bf(lo) | (f2bf(hi) << 16); }
__device__ __forceinline__ float lo_bf(unsigned w) { return __uint_as_float(w << 16); }
__device__ __forceinline__ float hi_bf(unsigned w) { return __uint_as_float(w & 0xffff0000u); }
__device__ __forceinline__ float sigmoidf_(float x) { return 1.f / (1.f + __expf(-x)); }
__device__ __forceinline__ float siluf_(float x) { return x / (1.f + __expf(-x)); }
#define DPPF(v, ctrl) __int_as_float(__builtin_amdgcn_update_dpp(0, __float_as_int(v), (ctrl), 0xf, 0xf, true))
#define DPP_XOR1 0xB1
#define DPP_XOR2 0x4E
#define DPP_HMIRROR 0x141
#define DPP_MIRROR 0x140
__device__ __forceinline__ float xor16f(float v) { const unsigned u = __float_as_uint(v); auto r = __builtin_amdgcn_permlane16_swap(u, u, false, false); return __uint_as_float(r[0] ^ r[1] ^ u); }
__device__ __forceinline__ float xor32f(float v) { const unsigned u = __float_as_uint(v); auto r = __builtin_amdgcn_permlane32_swap(u, u, false, false); return __uint_as_float(r[0] ^ r[1] ^ u); }
__device__ __forceinline__ float wave_sum(float v) {
    v += DPPF(v, DPP_XOR1); v += DPPF(v, DPP_XOR2); v += DPPF(v, DPP_HMIRROR); v += DPPF(v, DPP_MIRROR); v += xor16f(v); v += xor32f(v); return v;
}
__device__ __forceinline__ float wave_max(float v) {
    v = fmaxf(v, DPPF(v, DPP_XOR1)); v = fmaxf(v, DPPF(v, DPP_XOR2)); v = fmaxf(v, DPPF(v, DPP_HMIRROR)); v = fmaxf(v, DPPF(v, DPP_MIRROR)); v = fmaxf(v, xor16f(v)); v = fmaxf(v, xor32f(v)); return v;
}
__device__ __forceinline__ void unpack8(u32x4 w, float* f) {
    f[0] = lo_bf(w.x); f[1] = hi_bf(w.x); f[2] = lo_bf(w.y); f[3] = hi_bf(w.y); f[4] = lo_bf(w.z); f[5] = hi_bf(w.z); f[6] = lo_bf(w.w); f[7] = hi_bf(w.w);
}
__device__ __forceinline__ void st16_f(void* p, u32x4 w) { *(f32x4*)p = __builtin_bit_cast(f32x4, w); }
__device__ __forceinline__ void st8_f(void* p, u32x2 w) { *(f32x2*)p = __builtin_bit_cast(f32x2, w); }
__device__ __forceinline__ u32x4 pack8f(const float* f) { u32x4 w; w.x = pk2(f[0], f[1]); w.y = pk2(f[2], f[3]); w.z = pk2(f[4], f[5]); w.w = pk2(f[6], f[7]); return w; }

namespace pg8 {
constexpr int BM = 256, BK = 64, HALF = 128, HTB = HALF * BK * 2, STAGE_BYTES = 8 * HTB, NXCD = 8, WGM = 8;
__host__ __device__ __forceinline__ int lds_byte(int r, int c) { const int st = (r >> 4) * 2 + (c >> 5), rr = r & 15, cc = c & 31, ob = rr * 64 + cc * 2; return st * 1024 + (ob ^ (((ob >> 9) & 1) << 5)); }
__host__ __device__ __forceinline__ void stage_rc(int b, int& R, int& C) { const int st = b / 1024, sb = b % 1024, swz = sb ^ (((sb >> 9) & 1) << 5); R = (st >> 1) * 16 + swz / 64; C = (st & 1) * 32 + (swz % 64) / 2; }
__host__ __device__ __forceinline__ int perm32(int rho) { const int n = rho >> 4, i = rho & 15; return 8 * (i >> 2) + 4 * n + (i & 3); }

struct Unit { long long aoff, boff, coff; int pm, pn, aux; };
struct Gemm { const bf16* A; const bf16* Bt; int lda, ldb, K; };

__device__ __forceinline__ bool tile_of(long L, int nM, int nN, int& pm, int& pn) {
    const int nwg = nM * nN; if (L >= nwg) return false;
    int wgid = (int)L; { const int q = nwg / NXCD, r = nwg % NXCD, xcd = wgid % NXCD, off = wgid / NXCD; wgid = (xcd < r ? xcd * (q + 1) : r * (q + 1) + (xcd - r) * q) + off; }
    const int nig = WGM * nN, gid = wgid / nig, fm = gid * WGM, gsz = (nM - fm) < WGM ? (nM - fm) : WGM;
    pm = fm + ((wgid % nig) % gsz); pn = (wgid % nig) / gsz; return true;
}
struct DenseOrder {
    int nM, nN, G, c, ldc; long long astep, bstep;
    __device__ void init(int M, int N, int lda, int ldb, int ldc_, int G_, int c_) { nM = M / BM; nN = N / BM; G = G_; c = c_; ldc = ldc_; astep = (long long)BM * lda * 2; bstep = (long long)BM * ldb * 2; }
    __device__ __forceinline__ bool next(int i, Unit& u) const {
        int pm, pn; if (!tile_of((long)i * G + c, nM, nN, pm, pn)) return false;
        u.pm = pm; u.pn = pn; u.aux = 0; u.aoff = pm * astep; u.boff = pn * bstep; u.coff = (long long)pm * BM * ldc + pn * BM; return true;
    }
};

__device__ __forceinline__ unsigned cvt_pk_bf16(float lo, float hi) { unsigned r; asm volatile("v_cvt_pk_bf16_f32 %0, %1, %2" : "=v"(r) : "v"(lo), "v"(hi)); return r; }

template <class Epi, class Sched, bool GATHER = false>
__device__ __forceinline__ void gemm_phase(LAS unsigned char* lds, const Gemm g, const Sched& S, const Epi& E, int tid_, const LAS int* rowcache = nullptr) {
    __builtin_assume(tid_ >= 0 && tid_ < 512); const int tid = tid_, wid = __builtin_amdgcn_readfirstlane(tid >> 6), lane = tid & 63, wr = wid >> 2, wc = wid & 3, fr = lane & 15, fq = lane >> 4;
    int nt = g.K / BK; asm volatile("" : "+s"(nt));
    const size_t kstep = (size_t)(BK * 2);
    const size_t hstepA = (size_t)HALF * g.lda * 2, hstepB = (size_t)HALF * g.ldb * 2;
    unsigned vA0[2], vA1[2], vN0[2], vN1[2], voffB[2]; int Rr[2], Cb[2];
#pragma unroll
    for (int i = 0; i < 2; ++i) { int R, C; stage_rc(tid * 16 + i * 8192, R, C); const int Rb = (R & ~31) + perm32(R & 31); Rr[i] = R; Cb[i] = C * 2;
        vA0[i] = (unsigned)(R * g.lda + C) * 2u; vA1[i] = vA0[i] + (unsigned)hstepA; vN0[i] = vA0[i]; vN1[i] = vA1[i]; voffB[i] = (unsigned)(Rb * g.ldb + C) * 2u; }
#define PG8_GATHER(d0, d1, ui_) do { _Pragma("unroll") for (int _i = 0; _i < 2; ++_i) { d0[_i] = (unsigned)(rowcache[(ui_) * 256 + Rr[_i]] * g.lda * 2 + Cb[_i]); d1[_i] = (unsigned)(rowcache[(ui_) * 256 + 128 + Rr[_i]] * g.lda * 2 + Cb[_i]); } } while (0)
    if (GATHER) PG8_GATHER(vA0, vA1, 0);
    const unsigned ldsw = (unsigned)wid * 1024u;
    const int aoff = lds_byte(wr * 64 + fr, fq * 8), boff = lds_byte(wc * 32 + fr, fq * 8);
#define PG8_SA(b, h) (((b) * 2 + (h)) * HTB)
#define PG8_SB(b, h) ((4 + (b) * 2 + (h)) * HTB)
#define PG8_STAGE(bufoff, gbase, voff) do { _Pragma("unroll") for (int _i = 0; _i < 2; ++_i) \
        __builtin_amdgcn_global_load_lds((const unsigned*)((const char*)(gbase) + (voff)[_i]), (LAS unsigned*)(lds + (bufoff) + ldsw + _i * 8192), 16, 0, 0); } while (0)
#define PG8_LDA(dst, b, h) do { _Pragma("unroll") for (int m = 0; m < 4; ++m) _Pragma("unroll") for (int k = 0; k < 2; ++k) dst[m][k] = *(const LAS bf16x8*)(lds + PG8_SA(b, h) + aoff + m * 2048 + k * 1024); } while (0)
#define PG8_LDB(dst, b, h) do { _Pragma("unroll") for (int n = 0; n < 2; ++n) _Pragma("unroll") for (int k = 0; k < 2; ++k) dst[n][k] = *(const LAS bf16x8*)(lds + PG8_SB(b, h) + boff + n * 2048 + k * 1024); } while (0)
#define PG8_MMA(ai, bj, At, Bt) do { __builtin_amdgcn_s_setprio(1); _Pragma("unroll") for (int m = 0; m < 4; ++m) _Pragma("unroll") for (int n = 0; n < 2; ++n) _Pragma("unroll") for (int k = 0; k < 2; ++k) \
        acc[ai][bj][m][n] = __builtin_amdgcn_mfma_f32_16x16x32_bf16(Bt[n][k], At[m][k], acc[ai][bj][m][n], 0, 0, 0); __builtin_amdgcn_s_setprio(0); } while (0)
#define PG8_WAIT_V(n) asm volatile("s_waitcnt vmcnt(" #n ")" ::: "memory")
#define PG8_WAIT_L(n) asm volatile("s_waitcnt lgkmcnt(" #n ")" ::: "memory")
#define PG8_BAR __builtin_amdgcn_s_barrier()
#define PG8_SCHED __builtin_amdgcn_sched_barrier(0)
    Unit cur, nxt; int ui = 0;
    if (!S.next(0, cur)) return;
    f32x4 acc[2][2][4][2];
#pragma unroll
    for (int a = 0; a < 2; ++a)
#pragma unroll
        for (int b = 0; b < 2; ++b)
#pragma unroll
            for (int m = 0; m < 4; ++m)
#pragma unroll
                for (int n = 0; n < 2; ++n) acc[a][b][m][n] = (f32x4){0.f, 0.f, 0.f, 0.f};
    bf16x8 At[4][2], B0[2][2], B1[2][2];
    const char* cA = (const char*)g.A + cur.aoff; const char* cB = (const char*)g.Bt + cur.boff;
    PG8_STAGE(PG8_SB(0, 0), cB, voffB); PG8_STAGE(PG8_SB(0, 1), cB + hstepB, voffB); PG8_STAGE(PG8_SA(0, 0), cA, vA0); PG8_STAGE(PG8_SA(0, 1), cA, vA1);
    if (wr == 1) PG8_BAR;
    PG8_WAIT_V(2); PG8_BAR;
    PG8_STAGE(PG8_SB(1, 0), cB + kstep, voffB); PG8_STAGE(PG8_SA(1, 0), cA + kstep, vA0); PG8_STAGE(PG8_SB(1, 1), cB + hstepB + kstep, voffB);
    PG8_WAIT_V(6); PG8_BAR;
    for (;;) {
        const bool has_next = S.next(ui + 1, nxt);
        const char* nA = has_next ? (const char*)g.A + nxt.aoff : cA; const char* nB = has_next ? (const char*)g.Bt + nxt.boff : cB;
        if (GATHER) { if (has_next) PG8_GATHER(vN0, vN1, ui + 1); else { vN0[0] = vA0[0]; vN0[1] = vA0[1]; vN1[0] = vA1[0]; vN1[1] = vA1[1]; } }
        for (int t = 0; t < nt; t += 2) {
            const bool last = (t == nt - 2);
            const char* a1 = cA + (size_t)(t + 1) * kstep;
            const char* a2 = last ? nA : cA + (size_t)(t + 2) * kstep; const char* b2 = last ? nB : cB + (size_t)(t + 2) * kstep;
            const char* a3 = a2 + kstep; const char* b3 = b2 + kstep;
            unsigned w0[2], w1[2];
            if (GATHER) { w0[0] = last ? vN0[0] : vA0[0]; w0[1] = last ? vN0[1] : vA0[1]; w1[0] = last ? vN1[0] : vA1[0]; w1[1] = last ? vN1[1] : vA1[1]; } else { w0[0] = vA0[0]; w0[1] = vA0[1]; w1[0] = vA1[0]; w1[1] = vA1[1]; }
            PG8_LDB(B0, 0, 0); PG8_LDB(B1, 0, 1); PG8_SCHED; PG8_LDA(At, 0, 0); PG8_STAGE(PG8_SA(1, 1), a1, vA1);
            PG8_WAIT_V(8); PG8_WAIT_L(0); PG8_BAR; PG8_MMA(0, 0, At, B0); PG8_MMA(0, 1, At, B1); PG8_BAR; PG8_SCHED;
            PG8_LDA(At, 0, 1); PG8_STAGE(PG8_SB(0, 0), b2, voffB); PG8_STAGE(PG8_SB(0, 1), b2 + hstepB, voffB); PG8_STAGE(PG8_SA(0, 0), a2, w0);
            PG8_WAIT_V(8); PG8_WAIT_L(0); PG8_BAR; PG8_MMA(1, 0, At, B0); PG8_MMA(1, 1, At, B1); PG8_BAR; PG8_SCHED;
            PG8_LDB(B0, 1, 0); PG8_LDB(B1, 1, 1); PG8_SCHED; PG8_LDA(At, 1, 0); PG8_STAGE(PG8_SA(0, 1), a2, w1);
            PG8_WAIT_V(8); PG8_WAIT_L(0); PG8_BAR; PG8_MMA(0, 0, At, B0); PG8_MMA(0, 1, At, B1); PG8_BAR; PG8_SCHED;
            PG8_LDA(At, 1, 1); PG8_STAGE(PG8_SB(1, 0), b3, voffB); PG8_STAGE(PG8_SB(1, 1), b3 + hstepB, voffB); PG8_STAGE(PG8_SA(1, 0), a3, w0);
            PG8_WAIT_V(8); PG8_WAIT_L(0); PG8_BAR; PG8_MMA(1, 0, At, B0); PG8_MMA(1, 1, At, B1); PG8_BAR; PG8_SCHED;
        }
        if (wr == 0) PG8_BAR;
        E(acc, cur, wr, wc, fr, fq);
        if (!has_next) break;
#pragma unroll
        for (int a = 0; a < 2; ++a)
#pragma unroll
            for (int b = 0; b < 2; ++b)
#pragma unroll
                for (int m = 0; m < 4; ++m)
#pragma unroll
                    for (int n = 0; n < 2; ++n) acc[a][b][m][n] = (f32x4){0.f, 0.f, 0.f, 0.f};
        cur = nxt; cA = nA; cB = nB; ++ui;
        if (GATHER) { vA0[0] = vN0[0]; vA0[1] = vN0[1]; vA1[0] = vN1[0]; vA1[1] = vN1[1]; }
        if (wr == 1) PG8_BAR;
    }
    PG8_WAIT_V(0);
    PG8_BAR;
#undef PG8_SA
#undef PG8_SB
#undef PG8_STAGE
#undef PG8_GATHER
#undef PG8_LDA
#undef PG8_LDB
#undef PG8_MMA
#undef PG8_WAIT_V
#undef PG8_WAIT_L
#undef PG8_BAR
#undef PG8_SCHED
}
}

#define XB_TMO      128
#define XB_XCNT(j)  (256  + 64 * (j))
#define XB_XSUB(j)  (1280 + 64 * (j))
#define XB_XGEN(j)  (2304 + 64 * (j))
#define XB_TOP      3328
#define XB_TOPGEN   3392
#define XCD_BAR_WORDS 3456
#define XB_SPIN_CAP (1u << 22)
__device__ __forceinline__ unsigned xb_ld(unsigned* p)              { return __hip_atomic_load(p, __ATOMIC_RELAXED, __HIP_MEMORY_SCOPE_AGENT); }
__device__ __forceinline__ unsigned xb_add(unsigned* p, unsigned v) { return __hip_atomic_fetch_add(p, v, __ATOMIC_RELAXED, __HIP_MEMORY_SCOPE_AGENT); }
__device__ __forceinline__ unsigned xb_xcc_id() { return (unsigned)__builtin_amdgcn_s_getreg((3 << 11) | 20) & 0xFu; }
#define XB_SPIN(cond, bar) do { unsigned _sp = 0; while (cond) { __builtin_amdgcn_s_sleep(1); \
    if ((++_sp & 255u) == 0u) { if (xb_ld(&(bar)[XB_TMO])) break; if (_sp > XB_SPIN_CAP) { atomicAdd(&(bar)[XB_TMO], 1u); break; } } } } while (0)
struct XcdBarrier { unsigned* bar; unsigned x; volatile LAS unsigned* st; };
__device__ __forceinline__ XcdBarrier xcd_barrier_post(unsigned* bar, volatile LAS unsigned* st) {
    XcdBarrier b; b.bar = bar; b.x = xb_xcc_id(); b.st = st;
    if (threadIdx.x == 0) (void)xb_add(&bar[XB_XCNT(b.x)], 1u);
    return b;
}
__device__ __forceinline__ void xcd_barrier_complete(unsigned* bar, unsigned x, unsigned& nloc, unsigned& nx) {
    const unsigned G = gridDim.x * gridDim.y * gridDim.z;
    unsigned sum, cnt, mine, sp = 0u;
    for (;;) {
        sum = 0u; cnt = 0u; mine = 0u;
#pragma unroll
        for (unsigned j = 0; j < 16; ++j) { const unsigned c = xb_ld(&bar[XB_XCNT(j)]); sum += c; cnt += (c > 0u) ? 1u : 0u; mine = (j == x) ? c : mine; }
        if (sum == G) break;
        __builtin_amdgcn_s_sleep(1);
        if ((++sp & 255u) == 0u) { if (xb_ld(&bar[XB_TMO])) break; if (sp > XB_SPIN_CAP) { atomicAdd(&bar[XB_TMO], 1u); break; } }
    }
    nloc = mine > 0u ? mine : 1u; nx = cnt > 0u ? cnt : 1u;
}
__device__ __forceinline__ void xcd_barrier(const XcdBarrier& b) {
    asm volatile("s_waitcnt vmcnt(0)" ::: "memory");
    __syncthreads();
    if (threadIdx.x == 0) {
        unsigned* bar = b.bar;
        __builtin_amdgcn_s_waitcnt(0);
        unsigned nloc = b.st[0], nx = b.st[1];
        if (nloc == 0u) { xcd_barrier_complete(bar, b.x, nloc, nx); b.st[0] = nloc; b.st[1] = nx; }
        const unsigned old = xb_add(&bar[XB_XSUB(b.x)], 1u);
        const unsigned gen = old / nloc;
        if (old + 1u == (gen + 1u) * nloc) {
            __builtin_amdgcn_fence(__ATOMIC_RELEASE, "agent");
            asm volatile("s_waitcnt vmcnt(0)" ::: "memory");
            const unsigned og = xb_add(&bar[XB_TOP], 1u);
            const unsigned tg = og / nx;
            if (og + 1u == (tg + 1u) * nx) xb_add(&bar[XB_TOPGEN], 1u);
            else XB_SPIN(xb_ld(&bar[XB_TOPGEN]) == tg, bar);
            __builtin_amdgcn_fence(__ATOMIC_ACQUIRE, "agent");
            xb_add(&bar[XB_XGEN(b.x)], 1u);
            asm volatile("s_waitcnt vmcnt(0)" ::: "memory");
        } else {
            XB_SPIN(xb_ld(&bar[XB_XGEN(b.x)]) == gen, bar);
            __builtin_amdgcn_fence(__ATOMIC_ACQUIRE, "agent");
            asm volatile("s_waitcnt vmcnt(0)" ::: "memory");
        }
    }
    __syncthreads();
}

constexpr int NWAVES = 8, NTHR = 512;
constexpr int LDS_MAIN = 131072;
constexpr int LDS_AUX = 131072, LDS_AUX_BYTES = 16384;
constexpr int LDS_MISC = LDS_AUX + LDS_AUX_BYTES;
constexpr int LDS_PTAB = LDS_MISC + 256;
constexpr int LDS_BYTES = LDS_MISC + 1024;
struct Args { const float* in[N_INPUTS]; float* out; unsigned char* ws; int ph_lo, ph_hi; };

struct Ctx {
    LAS unsigned char* lds;
    int tid, lane, wave, G, bid, gw, ngw;
    unsigned char* ws;
};
__device__ __forceinline__ const float* lds_inp(LAS unsigned char* lds, int i) {
    const LAS unsigned* p = (const LAS unsigned*)(lds + LDS_PTAB) + 2 * i;
    const unsigned lo = __builtin_amdgcn_readfirstlane(p[0]), hi = __builtin_amdgcn_readfirstlane(p[1]);
    return (const float*)(const GAS float*)(((unsigned long long)hi << 32) | lo);
}
#define INP(i) lds_inp(C.lds, (i))
#define WSP(T_, off) ((T_*)(C.ws + (off)))
#define ARP(T_, off) ((T_*)(C.ws + WS_ARENA + (off)))
#define LDS_WAIT() asm volatile("s_waitcnt lgkmcnt(0)" ::: "memory")

__device__ __forceinline__ void rms_row_bf16(const float* xrow, const float* gain, bf16* orow, int lane) {
    f32x4 v[8]; float s = 0.f;
#pragma unroll
    for (int j = 0; j < 8; ++j) { v[j] = *(const f32x4*)(xrow + (j * 64 + lane) * 4); s += v[j].x * v[j].x + v[j].y * v[j].y + v[j].z * v[j].z + v[j].w * v[j].w; }
    const float rstd = rsqrtf(wave_sum(s) * (1.f / DM) + EPS);
#pragma unroll
    for (int j = 0; j < 8; ++j) { const f32x4 g = *(const f32x4*)(gain + (j * 64 + lane) * 4);
        u32x2 w; w.x = pk2(v[j].x * rstd * g.x, v[j].y * rstd * g.y); w.y = pk2(v[j].z * rstd * g.z, v[j].w * rstd * g.w);
        *(u32x2*)(orow + (j * 64 + lane) * 4) = w; }
}

template <int NT, class F>
__device__ __forceinline__ void transpose_tiles(const float* W, int ldw, int nvalid, int k0, int n0, bf16* WT, int ldt, F drow, int lane, const float* kscale) {
    const int g = lane >> 3, c = lane & 7; f32x4 v[NT][8];
#pragma unroll
    for (int q = 0; q < NT; ++q) { const int n = n0 + 32 * q + 4 * c; const bool ok = n < nvalid;
#pragma unroll
        for (int j = 0; j < 8; ++j) v[q][j] = ok ? *(const f32x4*)(W + (size_t)(k0 + 8 * g + j) * ldw + n) : (f32x4){0.f, 0.f, 0.f, 0.f}; }
    f32x4 ka = (f32x4){1.f, 1.f, 1.f, 1.f}, kb = ka;
    if (kscale) { ka = *(const f32x4*)(kscale + k0 + 8 * g); kb = *(const f32x4*)(kscale + k0 + 8 * g + 4); }
#pragma unroll
    for (int q = 0; q < NT; ++q) { const int n = n0 + 32 * q + 4 * c;
#pragma unroll
        for (int i = 0; i < 4; ++i) { u32x4 o; o.x = pk2(v[q][0][i] * ka.x, v[q][1][i] * ka.y); o.y = pk2(v[q][2][i] * ka.z, v[q][3][i] * ka.w); o.z = pk2(v[q][4][i] * kb.x, v[q][5][i] * kb.y); o.w = pk2(v[q][6][i] * kb.z, v[q][7][i] * kb.w);
            *(u32x4*)(WT + (size_t)drow(n + i) * ldt + k0 + 8 * g) = o; } }
}
template <class F>
__device__ __forceinline__ void transpose_tile(const float* W, int ldw, int nvalid, int k0, int n0, bf16* WT, int ldt, F drow, LAS float* scr, int lane, const float* kscale = nullptr) {
    (void)scr; transpose_tiles<1>(W, ldw, nvalid, k0, n0, WT, ldt, drow, lane, kscale);
}
template <class F>
__device__ __forceinline__ void transpose_matrix(const Ctx& C, const float* W, int K, int N, int Npad, bf16* WT, int ldt, F drow, LAS float* scr, const float* kscale = nullptr) {
    const int nblk = Npad / 32, items = (K / 64) * nblk;
    for (int it = C.gw; it < items; it += C.ngw) { const int kb = it / nblk, nb = it % nblk; transpose_tile(W, N, N, kb * 64, nb * 32, WT, ldt, drow, scr, C.lane, kscale); }
}

#define EPI_ARGS const f32x4 (&acc)[2][2][4][2], const pg8::Unit& u, int wr, int wc, int fr, int fq
struct EpiStoreBf16 {
    bf16* O; int ldc; float scale;
    __device__ __forceinline__ void operator()(EPI_ARGS) const {
        bf16* base = O + u.coff + (size_t)(wr * 64 + fr) * ldc + wc * 32 + 8 * fq;
#pragma unroll
        for (int ai = 0; ai < 2; ++ai)
#pragma unroll
            for (int m = 0; m < 4; ++m) { bf16* rowp = base + (size_t)(ai * 128 + m * 16) * ldc;
#pragma unroll
                for (int bj = 0; bj < 2; ++bj) { const f32x4 v0 = acc[ai][bj][m][0] * scale, v1 = acc[ai][bj][m][1] * scale;
                    u32x4 w; w.x = pg8::cvt_pk_bf16(v0[0], v0[1]); w.y = pg8::cvt_pk_bf16(v0[2], v0[3]); w.z = pg8::cvt_pk_bf16(v1[0], v1[1]); w.w = pg8::cvt_pk_bf16(v1[2], v1[3]);
                    *(u32x4*)(rowp + bj * 128) = w; } }
    }
};
struct EpiStoreF32 {
    float* O; int ldc;
    __device__ __forceinline__ void operator()(EPI_ARGS) const {
        float* base = O + u.coff + (size_t)(wr * 64 + fr) * ldc + wc * 32 + 8 * fq;
#pragma unroll
        for (int ai = 0; ai < 2; ++ai)
#pragma unroll
            for (int m = 0; m < 4; ++m) { float* rowp = base + (size_t)(ai * 128 + m * 16) * ldc;
#pragma unroll
                for (int bj = 0; bj < 2; ++bj) { *(f32x4*)(rowp + bj * 128) = acc[ai][bj][m][0]; *(f32x4*)(rowp + bj * 128 + 4) = acc[ai][bj][m][1]; } }
    }
};
template <bool BASE_F32> struct EpiResidT {
    const void* base; bf16* out; int ldc; float* rsq; LAS float* xch;
    __device__ __forceinline__ void operator()(EPI_ARGS) const {
        const size_t o0 = (size_t)u.coff + (size_t)(wr * 64 + fr) * ldc + wc * 32 + 8 * fq;
        u32x4 braw[BASE_F32 ? 1 : 16];
        if (!BASE_F32) {
#pragma unroll
            for (int ai = 0; ai < 2; ++ai)
#pragma unroll
                for (int m = 0; m < 4; ++m)
#pragma unroll
                    for (int bj = 0; bj < 2; ++bj) braw[(ai * 4 + m) * 2 + bj] = *(const u32x4*)((const bf16*)base + o0 + (size_t)(ai * 128 + m * 16) * ldc + bj * 128); }
#pragma unroll
        for (int ai = 0; ai < 2; ++ai)
#pragma unroll
            for (int m = 0; m < 4; ++m) { const size_t o = o0 + (size_t)(ai * 128 + m * 16) * ldc; float ssq = 0.f;
#pragma unroll
                for (int bj = 0; bj < 2; ++bj) { float bv[8];
                    if (BASE_F32) { const f32x4 b0 = *(const f32x4*)((const float*)base + o + bj * 128), b1 = *(const f32x4*)((const float*)base + o + bj * 128 + 4);
                        bv[0] = b0[0]; bv[1] = b0[1]; bv[2] = b0[2]; bv[3] = b0[3]; bv[4] = b1[0]; bv[5] = b1[1]; bv[6] = b1[2]; bv[7] = b1[3]; }
                    else unpack8(braw[BASE_F32 ? 0 : (ai * 4 + m) * 2 + bj], bv);
#pragma unroll
                    for (int j = 0; j < 4; ++j) { bv[j] += acc[ai][bj][m][0][j]; bv[4 + j] += acc[ai][bj][m][1][j]; }
                    const u32x4 w = pack8f(bv); *(u32x4*)(out + o + bj * 128) = w; float rf[8]; unpack8(w, rf);
#pragma unroll
                    for (int j = 0; j < 8; ++j) ssq += rf[j] * rf[j]; }
                ssq += xor16f(ssq); ssq += xor32f(ssq);
                if (fq == 0) xch[(ai * 128 + wr * 64 + m * 16 + fr) * 4 + wc] = ssq; }
        asm volatile("s_waitcnt lgkmcnt(0)" ::: "memory"); __builtin_amdgcn_s_barrier(); asm volatile("" ::: "memory");
        if (wc == 0 && fq == 0) {
#pragma unroll
            for (int ai = 0; ai < 2; ++ai)
#pragma unroll
                for (int m = 0; m < 4; ++m) { const int r = ai * 128 + wr * 64 + m * 16 + fr; const f32x4 p = *(const LAS f32x4*)(xch + r * 4); rsq[(size_t)(u.pm * 256 + r) * 8 + u.pn] = (p[0] + p[1]) + (p[2] + p[3]); } }
    }
};
__device__ __forceinline__ float rstd_of(float ssq) { return rsqrtf(ssq * (1.f / DM) + EPS); }
__device__ __forceinline__ float rstd_row(const float* rs8, int row) { const f32x4 a = *(const f32x4*)(rs8 + (size_t)row * 8), b = *(const f32x4*)(rs8 + (size_t)row * 8 + 4); return rstd_of(((a.x + a.y) + (a.z + a.w)) + ((b.x + b.y) + (b.z + b.w))); }
struct EpiStoreF32Rows {
    float* O; int ldc; const float* rs;
    __device__ __forceinline__ void operator()(EPI_ARGS) const {
        float* base = O + u.coff + (size_t)(wr * 64 + fr) * ldc + wc * 32 + 8 * fq; const int rp = u.pm * 256 + wr * 64 + fr;
#pragma unroll
        for (int ai = 0; ai < 2; ++ai)
#pragma unroll
            for (int m = 0; m < 4; ++m) { float* rowp = base + (size_t)(ai * 128 + m * 16) * ldc; const float r_ = rstd_row(rs, rp + ai * 128 + m * 16);
#pragma unroll
                for (int bj = 0; bj < 2; ++bj) { *(f32x4*)(rowp + bj * 128) = acc[ai][bj][m][0] * r_; *(f32x4*)(rowp + bj * 128 + 4) = acc[ai][bj][m][1] * r_; } }
    }
};
struct EpiSoftmaxP {
    bf16* P; int ldc; const float* rs; LAS float* xch;
    __device__ __forceinline__ void operator()(f32x4 (&acc)[2][2][4][2], const pg8::Unit& u, int wr, int wc, int fr, int fq) const {
#pragma unroll
        for (int ai = 0; ai < 2; ++ai)
#pragma unroll
            for (int m = 0; m < 4; ++m) { const int r = ai * 128 + wr * 64 + m * 16 + fr; const float r_ = rstd_row(rs, u.pm * 256 + r); float mx = -INFINITY;
#pragma unroll
                for (int bj = 0; bj < 2; ++bj)
#pragma unroll
                    for (int n = 0; n < 2; ++n) { acc[ai][bj][m][n] = acc[ai][bj][m][n] * r_;
#pragma unroll
                        for (int j = 0; j < 4; ++j) mx = fmaxf(mx, acc[ai][bj][m][n][j]); }
                mx = fmaxf(mx, xor16f(mx)); mx = fmaxf(mx, xor32f(mx)); if (fq == 0) xch[r * 4 + wc] = mx; }
        asm volatile("s_waitcnt lgkmcnt(0)" ::: "memory"); __builtin_amdgcn_s_barrier(); asm volatile("" ::: "memory");
#pragma unroll
        for (int ai = 0; ai < 2; ++ai)
#pragma unroll
            for (int m = 0; m < 4; ++m) { const int r = ai * 128 + wr * 64 + m * 16 + fr; const f32x4 mv = *(const LAS f32x4*)(xch + r * 4); const float mx = fmaxf(fmaxf(mv[0], mv[1]), fmaxf(mv[2], mv[3])); float sm_ = 0.f;
#pragma unroll
                for (int bj = 0; bj < 2; ++bj)
#pragma unroll
                    for (int n = 0; n < 2; ++n)
#pragma unroll
                        for (int j = 0; j < 4; ++j) { const float e = __expf(acc[ai][bj][m][n][j] - mx); acc[ai][bj][m][n][j] = e; sm_ += e; }
                sm_ += xor16f(sm_); sm_ += xor32f(sm_); if (fq == 0) xch[1024 + r * 4 + wc] = sm_; }
        asm volatile("s_waitcnt lgkmcnt(0)" ::: "memory"); __builtin_amdgcn_s_barrier(); asm volatile("" ::: "memory");
        bf16* base = P + u.coff + (size_t)(wr * 64 + fr) * ldc + wc * 32 + 8 * fq;
#pragma unroll
        for (int ai = 0; ai < 2; ++ai)
#pragma unroll
            for (int m = 0; m < 4; ++m) { const int r = ai * 128 + wr * 64 + m * 16 + fr; const f32x4 sv = *(const LAS f32x4*)(xch + 1024 + r * 4); const float inv = 1.f / ((sv[0] + sv[1]) + (sv[2] + sv[3]));
                bf16* rowp = base + (size_t)(ai * 128 + m * 16) * ldc;
#pragma unroll
                for (int bj = 0; bj < 2; ++bj) { const f32x4 v0 = acc[ai][bj][m][0] * inv, v1 = acc[ai][bj][m][1] * inv;
                    u32x4 w; w.x = pg8::cvt_pk_bf16(v0[0], v0[1]); w.y = pg8::cvt_pk_bf16(v0[2], v0[3]); w.z = pg8::cvt_pk_bf16(v1[0], v1[1]); w.w = pg8::cvt_pk_bf16(v1[2], v1[3]);
                    *(u32x4*)(rowp + bj * 128) = w; } }
    }
};
struct EpiAbIn {
    bf16* P; float* G32;
    __device__ __forceinline__ void operator()(EPI_ARGS) const {
        const int row0 = u.pm * 256 + wr * 64 + fr, col0 = u.pn * 256 + wc * 32 + 8 * fq;
#pragma unroll
        for (int ai = 0; ai < 2; ++ai)
#pragma unroll
            for (int m = 0; m < 4; ++m) { const int row = row0 + ai * 128 + m * 16; bf16* rowp = P + (size_t)row * AB_PAD + col0;
#pragma unroll
                for (int bj = 0; bj < 2; ++bj) { const f32x4 v0 = acc[ai][bj][m][0], v1 = acc[ai][bj][m][1];
                    u32x4 w; w.x = pg8::cvt_pk_bf16(v0[0], v0[1]); w.y = pg8::cvt_pk_bf16(v0[2], v0[3]); w.z = pg8::cvt_pk_bf16(v1[0], v1[1]); w.w = pg8::cvt_pk_bf16(v1[2], v1[3]);
                    *(u32x4*)(rowp + bj * 128) = w;
                    if (u.pn == 12) { float* g = G32 + (size_t)row * 256 + wc * 32 + 8 * fq + bj * 128; *(f32x4*)g = v0; *(f32x4*)(g + 4) = v1; } } }
    }
};
struct EpiLora {
    const float *w0, *a0, *k_a; const bf16 *KK, *KR; float* WD; bf16 *BV, *KP, *GG;
    __device__ __forceinline__ void operator()(EPI_ARGS) const {
        const int grp = u.pn >> 2, row0 = u.pm * 256 + wr * 64 + fr, cc0 = (u.pn & 3) * 256 + wc * 32 + 8 * fq;
#pragma unroll
        for (int ai = 0; ai < 2; ++ai)
#pragma unroll
            for (int m = 0; m < 4; ++m) { const size_t ro = (size_t)(row0 + ai * 128 + m * 16) * 1024;
#pragma unroll
                for (int bj = 0; bj < 2; ++bj) { const int cc = cc0 + bj * 128; float v[8];
#pragma unroll
                    for (int j = 0; j < 4; ++j) { v[j] = acc[ai][bj][m][0][j]; v[4 + j] = acc[ai][bj][m][1][j]; }
                    if (grp == 0) { float o[8]; const f32x4 p0 = *(const f32x4*)(w0 + cc), p1 = *(const f32x4*)(w0 + cc + 4); const float pw[8] = {p0.x, p0.y, p0.z, p0.w, p1.x, p1.y, p1.z, p1.w};
#pragma unroll
                        for (int j = 0; j < 8; ++j) o[j] = -0.6065306597126334f * sigmoidf_(pw[j] + v[j]);
                        *(f32x4*)(WD + ro + cc) = (f32x4){o[0], o[1], o[2], o[3]}; *(f32x4*)(WD + ro + cc + 4) = (f32x4){o[4], o[5], o[6], o[7]};
                    } else if (grp == 1) { float kk[8], kr[8], ob[8], ok[8];
                        unpack8(*(const u32x4*)(KK + ro + cc), kk); unpack8(*(const u32x4*)(KR + ro + cc), kr);
                        const f32x4 p0 = *(const f32x4*)(a0 + cc), p1 = *(const f32x4*)(a0 + cc + 4), q0 = *(const f32x4*)(k_a + cc), q1 = *(const f32x4*)(k_a + cc + 4);
                        const float pa[8] = {p0.x, p0.y, p0.z, p0.w, p1.x, p1.y, p1.z, p1.w}, qa[8] = {q0.x, q0.y, q0.z, q0.w, q1.x, q1.y, q1.z, q1.w};
#pragma unroll
                        for (int j = 0; j < 8; ++j) { const float a = sigmoidf_(pa[j] + v[j]); ob[j] = kk[j] * a; ok[j] = kr[j] * (1.f + (a - 1.f) * qa[j]); }
                        st16_f(BV + ro + cc, pack8f(ob)); st16_f(KP + ro + cc, pack8f(ok));
                    } else { st16_f(GG + ro + cc, pack8f(v)); } } }
    }
};
struct EpiHid {
    bf16* H; const int* rowslot; const float* rs;
    __device__ __forceinline__ void operator()(EPI_ARGS) const {
        bf16* base = H + (size_t)(u.aux + wr * 64 + fr) * FF + u.pn * 128 + wc * 32 + 8 * fq;
#pragma unroll
        for (int ai = 0; ai < 2; ++ai)
#pragma unroll
            for (int m = 0; m < 4; ++m) { float h[8]; const int r = ai * 128 + wr * 64 + m * 16 + fr; const float r_ = (r < u.pm) ? rstd_row(rs, rowslot[u.aux + r] >> 1) : 0.f;
#pragma unroll
                for (int j = 0; j < 4; ++j) { h[j] = siluf_(acc[ai][0][m][0][j] * r_) * (acc[ai][1][m][0][j] * r_); h[4 + j] = siluf_(acc[ai][0][m][1][j] * r_) * (acc[ai][1][m][1][j] * r_); }
                *(u32x4*)(base + (size_t)(ai * 128 + m * 16) * FF) = pack8f(h); }
    }
};
struct EpiMoeDown {
    const int* rowslot; const float* wts; bf16* YE;
    __device__ __forceinline__ void operator()(EPI_ARGS) const {
#pragma unroll
        for (int ai = 0; ai < 2; ++ai)
#pragma unroll
            for (int m = 0; m < 4; ++m) { const int r = ai * 128 + wr * 64 + m * 16 + fr;
                if (r < u.pm) { const int slot = rowslot[u.aux + r]; const float w = wts[slot]; bf16* rowp = YE + (size_t)slot * DM + u.pn * 256 + wc * 32 + 8 * fq;
#pragma unroll
                    for (int bj = 0; bj < 2; ++bj) { const f32x4 v0 = acc[ai][bj][m][0] * w, v1 = acc[ai][bj][m][1] * w;
                        u32x4 o; o.x = pg8::cvt_pk_bf16(v0[0], v0[1]); o.y = pg8::cvt_pk_bf16(v0[2], v0[3]); o.z = pg8::cvt_pk_bf16(v1[0], v1[1]); o.w = pg8::cvt_pk_bf16(v1[2], v1[3]);
                        *(u32x4*)(rowp + bj * 128) = o; } } }
    }
};
struct EpiNsaIn {
    bf16 *Q, *QROT, *KV6; float* GATES; const float *gate_b, *rcos, *rsin, *rs;
    __device__ __forceinline__ void operator()(EPI_ARGS) const {
        const int pn = u.pn;
#pragma unroll
        for (int ai = 0; ai < 2; ++ai)
#pragma unroll
            for (int m = 0; m < 4; ++m) { const int t = u.pm * 256 + ai * 128 + wr * 64 + m * 16 + fr, b = t >> 12, s = t & 4095; const float r_ = rstd_row(rs, t);
#pragma unroll
                for (int bj = 0; bj < 2; ++bj) { float v[8];
#pragma unroll
                    for (int j = 0; j < 4; ++j) { v[j] = acc[ai][bj][m][0][j] * r_; v[4 + j] = acc[ai][bj][m][1][j] * r_; }
                    const int d0 = wc * 32 + 8 * fq;
                    if (pn == 20) {
                        const int c = bj * 128 + d0;
                        if (c < 48) { float o[8];
#pragma unroll
                            for (int j = 0; j < 8; ++j) o[j] = sigmoidf_(v[j] + gate_b[c + j]);
                            float* g = GATES + (size_t)t * 48 + c; *(f32x4*)g = (f32x4){o[0], o[1], o[2], o[3]}; *(f32x4*)(g + 4) = (f32x4){o[4], o[5], o[6], o[7]}; }
                        continue; }
                    float vr[8];
#pragma unroll
                    for (int j = 0; j < 8; ++j) vr[j] = v[j];
                    if (wc == 0) { float pv[8];
#pragma unroll
                      for (int j = 0; j < 8; ++j) pv[j] = xor32f(v[j]);
                      const f32x4 c0 = *(const f32x4*)(rcos + s * 16 + 8 * (fq & 1)), c1 = *(const f32x4*)(rcos + s * 16 + 8 * (fq & 1) + 4), s0 = *(const f32x4*)(rsin + s * 16 + 8 * (fq & 1)), s1 = *(const f32x4*)(rsin + s * 16 + 8 * (fq & 1) + 4);
                      const float cs[8] = {c0.x, c0.y, c0.z, c0.w, c1.x, c1.y, c1.z, c1.w}, sn[8] = {s0.x, s0.y, s0.z, s0.w, s1.x, s1.y, s1.z, s1.w};
#pragma unroll
                      for (int j = 0; j < 8; ++j) vr[j] = (fq < 2) ? (v[j] * cs[j] - pv[j] * sn[j]) : (v[j] * cs[j] + pv[j] * sn[j]); }
                    if (pn < 8) { const int hh = pn * 2 + bj; const size_t o = (((size_t)(b * 16 + hh)) * SEQ + s) * 128 + d0;
                        *(u32x4*)(Q + o) = pack8f(v); *(u32x4*)(QROT + o) = pack8f(vr);
                    } else { const int i6 = (pn - 8) >> 1, g = ((pn - 8) & 1) * 2 + bj; const bool rot = (i6 == 2 || i6 == 4) && wc == 0;
                        bf16* dst = (bf16*)((unsigned char*)KV6 + (size_t)i6 * KV6_STRIDE) + (((size_t)(b * 4 + g)) * SPAD + s) * 128 + d0;
                        *(u32x4*)dst = rot ? pack8f(vr) : pack8f(v); } } }
    }
};

constexpr int MOE_CVT_TOTAL = 2 * NEXP * 3 * 512, MOE_CVT_SIDE_A = 0, MOE_CVT_SIDE_B = 28000, MOE_CVT_WG = 32, MOE_CVT_SIDE_C = 4096 * 8 * 2, MOE_CVT_SIDE_F = 1024 * 8 * 2, MOE_CVT_SIDE_G = 0  , MOE_CVT_SIDE_E = 2048 * 8 * 2, MOE_CVT_SIDE_H2 = 13000  , MOE_CVT_SIDE_H = 22000  ;
#define MOE_CVT_PROLOGUE_END(G_) ((G_) == 256 ? MOE_CVT_TOTAL - MOE_CVT_SIDE_A - MOE_CVT_SIDE_B - MOE_CVT_SIDE_C - MOE_CVT_SIDE_F - MOE_CVT_SIDE_G - MOE_CVT_SIDE_E - MOE_CVT_SIDE_H - MOE_CVT_SIDE_H2 : MOE_CVT_TOTAL)
#define MOE_CVT_BASE_C MOE_CVT_PROLOGUE_END(256)
#define MOE_CVT_BASE_F (MOE_CVT_BASE_C + MOE_CVT_SIDE_C)
#define MOE_CVT_BASE_G (MOE_CVT_BASE_F + MOE_CVT_SIDE_F)
#define MOE_CVT_BASE_E (MOE_CVT_BASE_G + MOE_CVT_SIDE_G)
#define MOE_CVT_BASE_H (MOE_CVT_BASE_E + MOE_CVT_SIDE_E)
#define MOE_CVT_BASE_H2 (MOE_CVT_BASE_H + MOE_CVT_SIDE_H)
static_assert(MOE_CVT_BASE_E >= MOE_CVT_TOTAL / 2 && MOE_CVT_BASE_H2 + MOE_CVT_SIDE_H2 + MOE_CVT_SIDE_A + MOE_CVT_SIDE_B == MOE_CVT_TOTAL && MOE_CVT_SIDE_H % 2 == 0 && MOE_CVT_SIDE_H2 % 2 == 0 && MOE_CVT_BASE_C % 2 == 0, "MoE conversion item ranges");
__device__ __forceinline__ void moe_convert_pair(const Ctx& C, int it, int lane) {
    auto ident = [](int n) { return n; };
    auto dg = [](int n) { return (n >> 7) * 256 + (n & 127); };
    auto du = [](int n) { return (n >> 7) * 256 + 128 + (n & 127); };
    const int per = 512;
    const int le = it / (3 * per), r = it % (3 * per), which = r / per, q = r % per;
    if (which == 0) { const int kb = q / 16, nb = q % 16; transpose_tiles<2>(INP(I_MOE_W_GATE) + (size_t)le * DM * FF, FF, FF, kb * 64, nb * 32, WSP(bf16, WS_W_GU) + (size_t)le * 1024 * DM, DM, dg, lane, INP(I_NORM_FFN) + (le >> 6) * DM); }
    else if (which == 1) { const int kb = q / 16, nb = q % 16; transpose_tiles<2>(INP(I_MOE_W_UP) + (size_t)le * DM * FF, FF, FF, kb * 64, nb * 32, WSP(bf16, WS_W_GU) + (size_t)le * 1024 * DM, DM, du, lane, INP(I_NORM_FFN) + (le >> 6) * DM); }
    else { const int kb = q / 64, nb = q % 64; transpose_tiles<2>(INP(I_MOE_W_DOWN) + (size_t)le * FF * DM, DM, DM, kb * 64, nb * 32, WSP(bf16, WS_W_DN) + (size_t)le * DM * FF, FF, ident, lane, nullptr); }
}
struct MoeTile { const float* W; bf16* WT; const float* ks; int ldw, ldt, k0, n0, mode; };
__device__ __forceinline__ MoeTile moe_tile_decode(const Ctx& C, int it) {
    const int per = 512, le = it / (3 * per), r = it % (3 * per), which = r / per, q = r % per; MoeTile t; t.mode = which;
    if (which < 2) { t.W = INP(which ? I_MOE_W_UP : I_MOE_W_GATE) + (size_t)le * DM * FF; t.ldw = FF; t.k0 = (q / 16) * 64; t.n0 = (q % 16) * 32; t.WT = WSP(bf16, WS_W_GU) + (size_t)le * 1024 * DM; t.ldt = DM; t.ks = INP(I_NORM_FFN) + (le >> 6) * DM; }
    else { t.W = INP(I_MOE_W_DOWN) + (size_t)le * FF * DM; t.ldw = DM; t.k0 = (q / 64) * 64; t.n0 = (q % 64) * 32; t.WT = WSP(bf16, WS_W_DN) + (size_t)le * DM * FF; t.ldt = FF; t.ks = nullptr; }
    return t;
}
__device__ __forceinline__ void moe_pair_load(const MoeTile& t, f32x4 (&v)[2][8], int lane) {
    const int g = lane >> 3, c = lane & 7;
#pragma unroll
    for (int q = 0; q < 2; ++q)
#pragma unroll
        for (int j = 0; j < 8; ++j) v[q][j] = __builtin_nontemporal_load((const f32x4*)(t.W + (size_t)(t.k0 + 8 * g + j) * t.ldw + t.n0 + 32 * q + 4 * c));
}
__device__ __forceinline__ void moe_pair_store(const MoeTile& t, const f32x4 (&v)[2][8], int lane) {
    const int g = lane >> 3, c = lane & 7; f32x4 ka = (f32x4){1.f, 1.f, 1.f, 1.f}, kb = ka;
    if (t.ks) { ka = *(const f32x4*)(t.ks + t.k0 + 8 * g); kb = *(const f32x4*)(t.ks + t.k0 + 8 * g + 4); }
#pragma unroll
    for (int q = 0; q < 2; ++q)
#pragma unroll
        for (int i = 0; i < 4; ++i) { const int nn = t.n0 + 32 * q + 4 * c + i, dr = (t.mode == 2) ? nn : ((nn >> 7) * 256 + (t.mode == 1 ? 128 : 0) + (nn & 127));
            u32x4 o; o.x = pk2(v[q][0][i] * ka.x, v[q][1][i] * ka.y); o.y = pk2(v[q][2][i] * ka.z, v[q][3][i] * ka.w); o.z = pk2(v[q][4][i] * kb.x, v[q][5][i] * kb.y); o.w = pk2(v[q][6][i] * kb.z, v[q][7][i] * kb.w);
            __builtin_nontemporal_store(o, (u32x4*)(t.WT + (size_t)dr * t.ldt + t.k0 + 8 * g)); }
}
__device__ __forceinline__ void moe_convert_items(const Ctx& C, int lo, int hi, int widx, int nworkers) {
    for (int it = lo + 2 * widx; it < hi; it += 2 * nworkers) moe_convert_pair(C, it, C.lane);
}
__device__ __forceinline__ void moe_convert_items_x2(const Ctx& C, int lo, int hi, int widx, int nworkers) {
    int it = lo + 2 * widx; const int st = 2 * nworkers;
    for (; it + st < hi; it += 2 * st) {
        f32x4 va[2][8], vb[2][8]; const MoeTile ta = moe_tile_decode(C, it), tb = moe_tile_decode(C, it + st);
        moe_pair_load(ta, va, C.lane); moe_pair_load(tb, vb, C.lane);
        moe_pair_store(ta, va, C.lane); moe_pair_store(tb, vb, C.lane);
    }
    for (; it < hi; it += st) moe_convert_pair(C, it, C.lane);
}
__device__ __forceinline__ void phase_prologue(const Ctx& C, const Args& A) {
    LAS float* scr = (LAS float*)(C.lds + C.wave * 8448);
    auto ident = [](int n) { return n; };
    transpose_matrix(C, INP(I_AB_W_IN), DM, AB_COLS, AB_PAD, WSP(bf16, WS_W_ABIN), DM, ident, scr);
    transpose_matrix(C, INP(I_AB_W_OUT), DM, DM, DM, WSP(bf16, WS_W_ABOUT), DM, ident, scr);
    transpose_matrix(C, INP(I_NSA_W_IN), DM, NSA_COLS, NSA_PAD, WSP(bf16, WS_W_NSAIN), DM, ident, scr, INP(I_NORM_MIX) + DM);
    transpose_matrix(C, INP(I_NSA_W_OUT), DM, DM, DM, WSP(bf16, WS_W_NSAOUT), DM, ident, scr);
    for (int l = 0; l < 2; ++l) {
        transpose_matrix(C, INP(I_CA_WK) + (size_t)l * DM * DM, DM, DM, DM, WSP(bf16, WS_W_CAK) + (size_t)l * DM * DM, DM, ident, scr);
        transpose_matrix(C, INP(I_CA_WV) + (size_t)l * DM * DM, DM, DM, DM, WSP(bf16, WS_W_CAV) + (size_t)l * DM * DM, DM, ident, scr);
        transpose_matrix(C, INP(I_CA_WO) + (size_t)l * DM * DM, DM, DM, DM, WSP(bf16, WS_W_CAO) + (size_t)l * DM * DM, DM, ident, scr);
    }
    for (int kv = 0; kv < 2; ++kv)
        transpose_matrix(C, INP(I_CMP_W1) + (size_t)kv * 4096 * 128, 4096, 128, 128, WSP(bf16, WS_W_CMP1) + (size_t)kv * 256 * 4096, 4096, ident, scr);
    moe_convert_items(C, 0, MOE_CVT_PROLOGUE_END(C.G), C.gw, C.ngw);
    const size_t gt = (size_t)C.bid * NTHR + C.tid, gn = (size_t)C.G * NTHR;
    { const float* src = INP(I_CA_WQ); bf16* dst = WSP(bf16, WS_W_CAQ);
      const float* gc = INP(I_NORM_CROSS);
      for (size_t i = gt; i < (size_t)2 * DM * DM / 4; i += gn) { const f32x4 v = *(const f32x4*)(src + i * 4); const float gq = gc[(i * 4) / DM]; u32x2 w; w.x = pk2(v.x * gq, v.y * gq); w.y = pk2(v.z * gq, v.w * gq); *(u32x2*)(dst + i * 4) = w; } }
    { bf16* dst = WSP(bf16, WS_W_LORA);
      for (size_t i = gt; i < (size_t)3072 * 256; i += gn) { const int n = (int)(i >> 8), k = (int)(i & 255); float v = 0.f;
          if (n < 1024) { if (k < 64) v = INP(I_RW_W_UP)[k * 1024 + n]; }
          else if (n < 2048) { if (k >= 64 && k < 128) v = INP(I_RW_A_UP)[(k - 64) * 1024 + (n - 1024)]; }
          else { if (k >= 128) v = INP(I_RW_G_UP)[(k - 128) * 1024 + (n - 2048)]; }
          dst[i] = (bf16)f2bf(v); } }
    { bf16* dst = WSP(bf16, WS_W_ROUTER);
      for (size_t i = gt; i < (size_t)2 * 256 * DM; i += gn) { const int l = (int)(i / (256 * DM)), n = (int)((i / DM) & 255), k = (int)(i % DM); float v = 0.f;
          if (n < 8) v = INP(I_MOE_WG)[((size_t)l * DM + k) * 8 + n]; else if (n < 72) v = INP(I_MOE_WE)[((size_t)l * DM + k) * 64 + (n - 8)];
          v *= INP(I_NORM_FFN)[l * DM + k];
          dst[i] = (bf16)f2bf(v); } }
    { float* rc = WSP(float, WS_TAB + TAB_ROPE_COS); float* rs = WSP(float, WS_TAB + TAB_ROPE_SIN);
      for (size_t i = gt; i < (size_t)SEQ * 16; i += gn) { const int pos = (int)(i >> 4), j = (int)(i & 15);
          const float inv = 1.0f / powf(500000.0f, (float)j / 16.0f); const float ang = (float)pos * inv; rc[i] = cosf(ang); rs[i] = sinf(ang); } }
    for (int w_ = C.gw; w_ < 2048; w_ += C.ngw) { const int o = w_ & 255, part = w_ >> 8, kv = o >> 7, e = o & 127; float s = 0.f;
#pragma unroll
        for (int j = 0; j < 8; ++j) { const int i = part * 512 + j * 64 + C.lane; s += INP(I_CMP_POS)[kv * 4096 + i] * INP(I_CMP_W1)[((size_t)kv * 4096 + i) * 128 + e]; }
        s = wave_sum(s); if (C.lane == 0) WSP(float, WS_TAB + TAB_CMPBIAS)[part * 256 + o] = s; }
    for (int r = C.gw; r < 2 * MT; r += C.ngw) { const int l = r / MT, m = r % MT;
        rms_row_bf16(INP(I_MEM) + (size_t)m * DM, INP(I_NORM_MEM) + l * DM, WSP(bf16, WS_MEMN) + ((size_t)l * MT + m) * DM, C.lane); }
    for (int r = C.gw; r < T; r += C.ngw) rms_row_bf16(INP(I_X) + (size_t)r * DM, INP(I_NORM_MIX), WSP(bf16, WS_XN) + (size_t)r * DM, C.lane);
}

struct MemProjOrder {
    int G, c;
    __device__ __forceinline__ bool next(int i, pg8::Unit& u) const {
        const int L = i * G + c; if (L >= 128) return false;
        const int pn = L & 7, pm = (L >> 3) & 3, kv = (L >> 5) & 1, l = L >> 6;
        u.pm = pm; u.pn = pn; u.aux = 0;
        u.aoff = ((long long)l * MT + pm * 256) * DM * 2;
        u.boff = ((long long)(kv ? (WS_W_CAV - WS_W_CAK) / 2 : 0) + ((long long)l * DM + pn * 256) * DM) * 2;
        u.coff = (long long)(kv ? (WS_VP - WS_KP) / 2 : 0) + ((long long)l * MT + pm * 256) * DM + pn * 256;
        return true;
    }
};
struct AbInMemOrder {
    pg8::DenseOrder d; MemProjOrder m;
    __device__ __forceinline__ bool next(int i, pg8::Unit& u) const {
        const long L = (long)i * d.G + d.c;
        if (L < (T / 256) * (AB_PAD / 256)) { int pm, pn; pg8::tile_of(L, d.nM, d.nN, pm, pn); u.pm = pm; u.pn = pn; u.aux = 0; u.aoff = (long long)WS_XN + pm * d.astep; u.boff = (long long)WS_W_ABIN + pn * d.bstep; u.coff = 0; return true; }
        pg8::Unit t; MemProjOrder mm{1 << 30, (int)(L - (T / 256) * (AB_PAD / 256))}; if (!mm.next(0, t)) return false;
        u = t; u.aux = 1; u.aoff += (long long)WS_MEMN; u.boff += (long long)WS_W_CAK; return true;
    }
};
struct EpiAbInMem { EpiAbIn a; EpiStoreBf16 m;
    __device__ __forceinline__ void operator()(EPI_ARGS) const { if (u.aux == 0) a(acc, u, wr, wc, fr, fq); else m(acc, u, wr, wc, fr, fq); } };
struct RouterOrder {
    int G, c;
    __device__ __forceinline__ bool next(int i, pg8::Unit& u) const {
        const int L = i * G + c; if (L >= 256) return false;
        const int pm = L & 63, ks = L >> 6; u.pm = pm; u.pn = 0; u.aux = ks;
        u.aoff = ((long long)pm * 256 * DM + ks * 512) * 2; u.boff = (long long)ks * 512 * 2; u.coff = ((long long)ks * T + pm * 256) * 256; return true;
    }
};
struct WktOrder {
    int G, c;
    __device__ __forceinline__ bool next(int i, pg8::Unit& u) const {
        const int L = i * G + c; if (L >= 256) return false;
        const int pn = L & 7, h = (L >> 3) & 3, b = (L >> 5) & 3, l = L >> 7;
        u.pm = 0; u.pn = pn; u.aux = 0;
        u.aoff = (((long long)l * MT + b * 256) * DM + h * 512) * 2;
        u.boff = (((long long)l * DM + pn * 256) * DM + h * 512) * 2;
        u.coff = (((long long)(l * 4 + b) * 1024) + h * 256) * DM + pn * 256;
        return true;
    }
};
struct VwtOrder {
    int G, c;
    __device__ __forceinline__ bool next(int i, pg8::Unit& u) const {
        const int L = i * G + c; if (L >= 256) return false;
        const int pm = L & 7, h = (L >> 3) & 3, b = (L >> 5) & 3, l = L >> 7;
        u.pm = pm; u.pn = 0; u.aux = 0;
        u.aoff = (((long long)l * DM + pm * 256) * DM + h * 512) * 2;
        u.boff = (((long long)l * MT + b * 256) * DM + h * 512) * 2;
        u.coff = (((long long)(l * 4 + b) * DM) + pm * 256) * 1024 + h * 256;
        return true;
    }
};
struct CrossOrder {
    int nN, G, c, ldc; long long astep, bstep, bbatch;
    __device__ __forceinline__ bool next(int i, pg8::Unit& u) const {
        int pm, pn; if (!pg8::tile_of((long)i * G + c, T / 256, nN, pm, pn)) return false;
        u.pm = pm; u.pn = pn; u.aux = 0; u.aoff = pm * astep; u.boff = (pm >> 4) * bbatch + pn * bstep; u.coff = (long long)pm * 256 * ldc + pn * 256; return true;
    }
};
struct CmpOrder {
    int G, c;
    __device__ __forceinline__ bool next(int i, pg8::Unit& u) const {
        const int L = i * G + c; if (L >= 256) return false;
        const int bg = L & 15, kv = (L >> 4) & 1, ks = L >> 5;
        u.pm = 0; u.pn = 0; u.aux = 0;
        u.aoff = (long long)kv * KV6_STRIDE + ((long long)bg * SPAD * 128 + ks * 512) * 2;
        u.boff = ((long long)kv * 256 * 4096 + ks * 512) * 2;
        u.coff = ((long long)(ks * 2 + kv) * 16 + bg) * 65536;
        return true;
    }
};
struct MoeOrder {
    const LAS int* tab; int npn, G, c, which;
    __device__ __forceinline__ bool next(int i, pg8::Unit& u) const {
        const int L = i * G + c, ntile = tab[64]; if (L >= ntile * npn) return false;
        const int tix = L / npn, pn = L % npn; int e = 0;
        for (int k = 32; k >= 1; k >>= 1) if (e + k < 64 && tab[e + k] <= tix) e += k;
        while (tab[e + 1] <= tix) ++e;
        const int mt = tix - tab[e], cnt = tab[65 + e], row0 = tab[129 + e] + mt * 256;
        u.pm = min(256, cnt - mt * 256); u.pn = pn; u.aux = row0;
        if (which == 0) { u.aoff = 0; u.boff = ((long long)e * 1024 + pn * 256) * DM * 2; }
        else { u.aoff = (long long)row0 * FF * 2; u.boff = ((long long)e * DM + pn * 256) * FF * 2; }
        u.coff = 0; return true;
    }
};
__device__ __forceinline__ int wave_incl_scan_i(int v, int lane) {
#pragma unroll
    for (int d = 1; d < 64; d <<= 1) { const int t = __shfl_up(v, d, 64); if (lane >= d) v += t; }
    return v;
}
__device__ __forceinline__ void moe_build_table(const Ctx& C, const unsigned* cnt, LAS int* tab) {
    if (C.tid < 64) { const int e = C.tid, n = (int)cnt[e], nt = (n + 255) >> 8; const int inc = wave_incl_scan_i(nt, e), ts = inc - nt;
        tab[e] = ts; tab[65 + e] = n; tab[129 + e] = ts * 256; if (e == 63) tab[64] = inc; }
    __syncthreads();
}

__device__ __forceinline__ float log_sigmoidf_(float x) { return fminf(x, 0.f) - log1pf(__expf(-fabsf(x))); }
__device__ __forceinline__ void phase_mixer_prep(const Ctx& C, const Args& A) {
    const bf16* PAB = ARP(bf16, A_PAB); const float* G32 = ARP(float, A_GF32);
    bf16 *QM = ARP(bf16, A_QM), *KM = ARP(bf16, A_KM), *RR = ARP(bf16, A_RR), *KR = ARP(bf16, A_KR), *VR = ARP(bf16, A_VR), *KK = ARP(bf16, A_KK), *LIN = ARP(bf16, A_LIN);
    float *IG = ARP(float, A_IG), *LF = ARP(float, A_LF);
    const float *cw = INP(I_ML_CONV_W), *cb = INP(I_ML_CONV_B), *gb = INP(I_ML_GATE_B), *mu = INP(I_RW_MU), *k_k = INP(I_RW_K_K);
    const int lane = C.lane;
    for (int t = C.gw; t < T; t += C.ngw) {
        const int b = t >> 12, s = t & 4095; const bf16* P = PAB + (size_t)t * AB_PAD; const bf16* PR = P + ML_COLS;
        u32x4 cx[2][4], pc[7], pq[7]; const u32x4 z4 = (u32x4){0u, 0u, 0u, 0u};
#pragma unroll
        for (int it = 0; it < 2; ++it)
#pragma unroll
            for (int tap = 0; tap < 4; ++tap) { const int back = 3 - tap; cx[it][tap] = z4; if (s >= back) cx[it][tap] = *(const u32x4*)(P - (size_t)back * AB_PAD + (lane + 64 * it) * 8); }
#pragma unroll
        for (int it = 0; it < 7; ++it) { const int chunk = lane + 64 * it; pc[it] = z4; pq[it] = z4;
            if (chunk < 416) { pc[it] = *(const u32x4*)(PR + chunk * 8); if (s > 0) pq[it] = *(const u32x4*)(PR - AB_PAD + chunk * 8); } }
#pragma unroll
        for (int it = 0; it < 2; ++it) { const int c = (lane + 64 * it) * 8; float y[8];
            { const f32x4 b0 = *(const f32x4*)(cb + c), b1 = *(const f32x4*)(cb + c + 4); y[0] = b0.x; y[1] = b0.y; y[2] = b0.z; y[3] = b0.w; y[4] = b1.x; y[5] = b1.y; y[6] = b1.z; y[7] = b1.w; }
#pragma unroll
            for (int tap = 0; tap < 4; ++tap) { float xv[8]; unpack8(cx[it][tap], xv);
                const f32x4 w0 = *(const f32x4*)(cw + tap * 1024 + c), w1 = *(const f32x4*)(cw + tap * 1024 + c + 4);
                y[0] += xv[0] * w0.x; y[1] += xv[1] * w0.y; y[2] += xv[2] * w0.z; y[3] += xv[3] * w0.w; y[4] += xv[4] * w1.x; y[5] += xv[5] * w1.y; y[6] += xv[6] * w1.z; y[7] += xv[7] * w1.w; }
#pragma unroll
            for (int j = 0; j < 8; ++j) y[j] = siluf_(y[j]);
            if (c < 512) *(u32x4*)(QM + (size_t)t * 512 + c) = pack8f(y); else *(u32x4*)(KM + (size_t)t * 512 + c - 512) = pack8f(y); }
        if (lane < 8) { const float g = G32[(size_t)t * 256 + lane] + gb[lane];
            if (lane < 4) IG[(size_t)(b * 4 + lane) * SEQ + s] = g; else LF[(size_t)(b * 4 + lane - 4) * SEQ + s] = log_sigmoidf_(g); }
#pragma unroll
        for (int it = 0; it < 7; ++it) { const int chunk = lane + 64 * it; if (chunk >= 416) break; const int cc = chunk * 8;
            float p[8], pp[8], mx[8]; unpack8(pc[it], p); unpack8(pq[it], pp);
            { const f32x4 m0 = *(const f32x4*)(mu + cc), m1 = *(const f32x4*)(mu + cc + 4); const float mf[8] = {m0.x, m0.y, m0.z, m0.w, m1.x, m1.y, m1.z, m1.w};
#pragma unroll
              for (int j = 0; j < 8; ++j) mx[j] = p[j] + (pp[j] - p[j]) * mf[j]; }
            if (it < 2) *(u32x4*)(RR + (size_t)t * 1024 + cc) = pack8f(mx);
            else if (it < 4) { const int ck = cc - 1024; *(u32x4*)(KR + (size_t)t * 1024 + ck) = pack8f(mx);
                float kk[8], ss = 0.f; const f32x4 q0 = *(const f32x4*)(k_k + ck), q1 = *(const f32x4*)(k_k + ck + 4); const float kf[8] = {q0.x, q0.y, q0.z, q0.w, q1.x, q1.y, q1.z, q1.w};
#pragma unroll
                for (int j = 0; j < 8; ++j) { kk[j] = mx[j] * kf[j]; ss += kk[j] * kk[j]; }
                ss += DPPF(ss, DPP_XOR1); ss += DPPF(ss, DPP_XOR2); ss += DPPF(ss, DPP_HMIRROR);
                const float rn = rsqrtf(ss + 1e-12f);
#pragma unroll
                for (int j = 0; j < 8; ++j) kk[j] *= rn;
                *(u32x4*)(KK + (size_t)t * 1024 + ck) = pack8f(kk); }
            else if (it < 6) *(u32x4*)(VR + (size_t)t * 1024 + cc - 2048) = pack8f(mx);
            else { float o[8];
#pragma unroll
                for (int j = 0; j < 8; ++j) o[j] = (lane < 8) ? tanhf(mx[j]) : ((lane < 16) ? mx[j] : sigmoidf_(mx[j]));
                *(u32x4*)(LIN + (size_t)t * 256 + lane * 8) = pack8f(o); } }
    }
}

__device__ __forceinline__ void rwkv_scan_unit(const Ctx& C, const Args& A, int bh) {
    const int b = bh >> 4, h = bh & 15, w = C.wave, lane = C.lane, tid = C.tid;
    LAS float* IN = (LAS float*)C.lds;
    LAS float* PART = IN + 2 * 6 * 1024;
    LAS float* YP = PART + 2 * 8 * 64;
    const float* WD = ARP(float, A_WD); const bf16 *KKg = ARP(bf16, A_KK), *BV = ARP(bf16, A_BV), *KP = ARP(bf16, A_KP), *RR = ARP(bf16, A_RR), *VR = ARP(bf16, A_VR), *GG = ARP(bf16, A_GG);
    bf16* YCAT = ARP(bf16, A_YCAT);
    const float *r_k = INP(I_RW_R_K), *ln_w = INP(I_RW_LN_W), *ln_b = INP(I_RW_LN_B);
    const int li = tid >> 5, lch = (tid & 31) * 2;
    const size_t gbase = ((size_t)b * SEQ) * 1024 + h * 64 + lch;
    f32x2 rw; unsigned rk, rb, rp, rr_, rv;
#define RW_LOAD(grp) do { const size_t o = gbase + (size_t)((grp) * 16 + li) * 1024; rw = *(const f32x2*)(WD + o); rk = *(const unsigned*)(KKg + o); rb = *(const unsigned*)(BV + o); \
        rp = *(const unsigned*)(KP + o); rr_ = *(const unsigned*)(RR + o); rv = *(const unsigned*)(VR + o); } while (0)
#define RW_STORE(buf) do { LAS float* d = IN + (buf) * 6144 + li * 64 + lch; *(LAS f32x2*)(d) = rw; *(LAS f32x2*)(d + 1024) = (f32x2){lo_bf(rk), hi_bf(rk)}; *(LAS f32x2*)(d + 2048) = (f32x2){lo_bf(rb), hi_bf(rb)}; \
        *(LAS f32x2*)(d + 3072) = (f32x2){lo_bf(rp), hi_bf(rp)}; *(LAS f32x2*)(d + 4096) = (f32x2){lo_bf(rr_), hi_bf(rr_)}; *(LAS f32x2*)(d + 5120) = (f32x2){lo_bf(rv), hi_bf(rv)}; } while (0)
    float st[8];
#pragma unroll
    for (int j = 0; j < 8; ++j) st[j] = 0.f;
    __syncthreads();
    RW_LOAD(0); RW_STORE(0); __syncthreads();
    for (int grp = 0; grp < SEQ / 16; ++grp) {
        const int buf = grp & 1; const LAS float* I0 = IN + buf * 6144;
        if (grp + 1 < SEQ / 16) RW_LOAD(grp + 1);
        for (int i = 0; i < 16; ++i) {
            const LAS float* q = I0 + i * 64 + 8 * w;
            const f32x4 w0 = *(const LAS f32x4*)(q), w1 = *(const LAS f32x4*)(q + 4), k0 = *(const LAS f32x4*)(q + 1024), k1 = *(const LAS f32x4*)(q + 1028);
            const f32x4 b0 = *(const LAS f32x4*)(q + 2048), b1 = *(const LAS f32x4*)(q + 2052), p0 = *(const LAS f32x4*)(q + 3072), p1 = *(const LAS f32x4*)(q + 3076);
            const f32x4 r0 = *(const LAS f32x4*)(q + 4096), r1 = *(const LAS f32x4*)(q + 4100); const float vv = I0[5120 + i * 64 + lane];
            float skp = 0.f;
#pragma unroll
            for (int j = 0; j < 4; ++j) skp += st[j] * k0[j] + st[4 + j] * k1[j];
            PART[(i & 1) * 512 + w * 64 + lane] = skp;
            LDS_WAIT(); __builtin_amdgcn_s_barrier(); asm volatile("" ::: "memory");
            float sk = 0.f;
#pragma unroll
            for (int ww = 0; ww < 8; ++ww) sk += PART[(i & 1) * 512 + ww * 64 + lane];
            float yp = 0.f;
#pragma unroll
            for (int j = 0; j < 4; ++j) { st[j] = st[j] * w0[j] - sk * b0[j] + vv * p0[j]; st[4 + j] = st[4 + j] * w1[j] - sk * b1[j] + vv * p1[j]; yp += st[j] * r0[j] + st[4 + j] * r1[j]; }
            YP[i * 512 + w * 64 + lane] = yp;
        }
        if (grp + 1 < SEQ / 16) RW_STORE(buf ^ 1);
        __syncthreads();
#pragma unroll
        for (int q = 0; q < 2; ++q) { const int i = 2 * w + q; float y = 0.f;
#pragma unroll
            for (int ww = 0; ww < 8; ++ww) y += YP[i * 512 + ww * 64 + lane];
            const float mean = wave_sum(y) * (1.f / 64.f), dv = y - mean, var = wave_sum(dv * dv) * (1.f / 64.f);
            const int ch = h * 64 + lane; const float yn = dv * rsqrtf(var + 64e-5f) * ln_w[ch] + ln_b[ch];
            const float bonus = wave_sum(I0[4096 + i * 64 + lane] * I0[3072 + i * 64 + lane] * r_k[ch]) * I0[5120 + i * 64 + lane];
            const size_t tt = (size_t)b * SEQ + grp * 16 + i;
            const float g = bf2f(GG[tt * 1024 + ch]);
            YCAT[tt * DM + 1024 + ch] = (bf16)f2bf((yn + bonus) * g); }
    }
#undef RW_LOAD
#undef RW_STORE
    __syncthreads();
}

__device__ __forceinline__ f32x4 lds_mma(const LAS bf16* Am, int lda, const LAS bf16* Bt, int ldb, int tm, int tn, int K, int lane, f32x4 acc) {
    const LAS bf16* ap = Am + (tm * 16 + (lane & 15)) * lda + (lane >> 4) * 8;
    const LAS bf16* bp = Bt + (tn * 16 + (lane & 15)) * ldb + (lane >> 4) * 8;
    for (int k = 0; k < K; k += 32) { const bf16x8 a = *(const LAS bf16x8*)(ap + k); const bf16x8 bb = *(const LAS bf16x8*)(bp + k);
        acc = __builtin_amdgcn_mfma_f32_16x16x32_bf16(bb, a, acc, 0, 0, 0); }
    return acc;
}

constexpr int RP = 72;
__device__ __forceinline__ void st4_bf16(LAS bf16* p, f32x4 v) { u32x2 w; w.x = pk2(v[0], v[1]); w.y = pk2(v[2], v[3]); *(LAS u32x2*)p = w; }
__device__ __forceinline__ void st4_bf16_T(LAS bf16* base, int row, int col0, f32x4 v) {
#pragma unroll
    for (int j = 0; j < 4; ++j) base[(col0 + j) * RP + row] = (bf16)f2bf(v[j]);
}
__device__ __forceinline__ void st4_bf16_g(bf16* p, f32x4 v) { u32x2 w; w.x = pk2(v[0], v[1]); w.y = pk2(v[2], v[3]); *(u32x2*)p = w; }
__device__ __forceinline__ void tri_inverse_diag32(const LAS float* Cf, LAS bf16* Tm, LAS bf16* T00T, int lane) {
    const int hb = lane >> 5, j = lane & 31; const LAS float* Cb_ = Cf + hb * (32 * 64 + 32); float Tr[32];
#pragma unroll
    for (int t = 0; t < 32; ++t) { float acc0 = (t == j) ? 1.f : 0.f, acc1 = 0.f, acc2 = 0.f, acc3 = 0.f;
#pragma unroll
        for (int s4 = 0; s4 < (t + 3) / 4; ++s4) { const f32x4 cv = *(const LAS f32x4*)(Cb_ + t * 64 + s4 * 4);
            if (s4 * 4 + 0 < t) acc0 -= cv[0] * Tr[s4 * 4 + 0]; if (s4 * 4 + 1 < t) acc1 -= cv[1] * Tr[s4 * 4 + 1];
            if (s4 * 4 + 2 < t) acc2 -= cv[2] * Tr[s4 * 4 + 2]; if (s4 * 4 + 3 < t) acc3 -= cv[3] * Tr[s4 * 4 + 3]; }
        Tr[t] = (acc0 + acc1) + (acc2 + acc3); Tm[(32 * hb + t) * RP + 32 * hb + j] = (bf16)f2bf(Tr[t]); __builtin_amdgcn_sched_barrier(0); }
    if (hb == 0) {
#pragma unroll
        for (int q = 0; q < 4; ++q) *(LAS u32x4*)(T00T + j * 40 + 8 * q) = pack8f(Tr + 8 * q); }
    { const int t = lane >> 1, h = lane & 1; const u32x4 z = (u32x4){0u, 0u, 0u, 0u}; *(LAS u32x4*)(Tm + t * RP + 32 + 16 * h) = z; *(LAS u32x4*)(Tm + t * RP + 32 + 16 * h + 8) = z; }
}
__device__ __forceinline__ void rwkv_prep_units(const Ctx& C, bool side_cvt) {
    int unit = C.bid; if (unit >= 4096) return;
    const int w = C.wave;
    LAS float* F = (LAS float*)C.lds;
    LAS float* EGL = F + 4096;
    LAS bf16* B0 = (LAS bf16*)(EGL + 64 + 512);
    LAS bf16 *Kt = B0, *Rt = B0 + 64 * RP, *Kb = B0 + 2 * 64 * RP, *Bb = B0 + 3 * 64 * RP, *KtT = B0 + 4 * 64 * RP, *KhT = B0 + 5 * 64 * RP, *BhT = B0 + 6 * 64 * RP,
             *VcT = B0 + 7 * 64 * RP, *Am = B0 + 8 * 64 * RP, *Q1 = B0 + 9 * 64 * RP, *Q2 = B0 + 10 * 64 * RP;
    LAS bf16 *Tm = Kt, *AVT = Kb, *WmT = Bb, *UT = Am;
    LAS bf16 *C10b = (LAS bf16*)(C.lds + LDS_AUX), *T00T = C10b + 32 * 40, *XT = T00T + 32 * 40;
    const float* WD = ARP(float, A_WD); const bf16 *KKg = ARP(bf16, A_KK), *BV = ARP(bf16, A_BV), *KP = ARP(bf16, A_KP), *RR = ARP(bf16, A_RR), *VR = ARP(bf16, A_VR);
    f32x4 lw0, lw1; u32x4 rk, rb, rp, rr, rv;
#define RWP_LOAD(u_) do { const int bh_ = (u_) >> 6, c_ = (u_) & 63; const size_t go_ = ((size_t)(bh_ >> 4) * SEQ + c_ * 64 + (C.tid >> 3)) * 1024 + (bh_ & 15) * 64 + (C.tid & 7) * 8; \
        lw0 = *(const f32x4*)(WD + go_); lw1 = *(const f32x4*)(WD + go_ + 4); rk = *(const u32x4*)(KKg + go_); rb = *(const u32x4*)(BV + go_); rp = *(const u32x4*)(KP + go_); rr = *(const u32x4*)(RR + go_); rv = *(const u32x4*)(VR + go_); } while (0)
    RWP_LOAD(unit);
  for (;;) {
    int tid = C.tid; asm volatile("" : "+v"(tid));
    const int lane = tid & 63, t = tid >> 3, c8 = (tid & 7) * 8;
    bf16 *GM = ARP(bf16, A_RWM) + (size_t)unit * 4096, *GN = ARP(bf16, A_RWN) + (size_t)unit * 4096, *GRW = ARP(bf16, A_RWRW) + (size_t)unit * 4096, *GYL = ARP(bf16, A_RWYL) + (size_t)unit * 4096;
    __syncthreads();
    *(LAS f32x4*)(F + t * 64 + c8) = lw0; *(LAS f32x4*)(F + t * 64 + c8 + 4) = lw1;
    __syncthreads();
    { float g = 0.f;
#pragma unroll
      for (int i = 0; i < 8; ++i) { g += F[(8 * w + i) * 64 + lane]; F[(8 * w + i) * 64 + lane] = g; }
      EGL[64 + w * 64 + lane] = g; }
    __syncthreads();
    { float off = 0.f;
      for (int ww = 0; ww < w; ++ww) off += EGL[64 + ww * 64 + lane];
#pragma unroll
      for (int i = 0; i < 8; ++i) F[(8 * w + i) * 64 + lane] += off; }
    __syncthreads();
    { float G[8], Gm[8], GL[8], kkf[8], bf_[8], kpf[8], rf[8], vf[8];
#pragma unroll
      for (int j = 0; j < 8; ++j) { G[j] = F[t * 64 + c8 + j]; Gm[j] = t > 0 ? F[(t - 1) * 64 + c8 + j] : 0.f; GL[j] = F[63 * 64 + c8 + j]; }
      unpack8(rk, kkf); unpack8(rb, bf_); unpack8(rp, kpf); unpack8(rr, rf); unpack8(rv, vf);
      float okt[8], ort[8], okb[8], obb[8];
#pragma unroll
      for (int j = 0; j < 8; ++j) { const float e1 = __expf(Gm[j]), e2 = __expf(G[j]), e3 = __expf(-G[j]), e4 = __expf(GL[j] - G[j]);
          okt[j] = kkf[j] * e1; ort[j] = rf[j] * e2; okb[j] = kpf[j] * e3; obb[j] = bf_[j] * e3;
          KtT[(c8 + j) * RP + t] = (bf16)f2bf(okt[j]); KhT[(c8 + j) * RP + t] = (bf16)f2bf(kpf[j] * e4); BhT[(c8 + j) * RP + t] = (bf16)f2bf(bf_[j] * e4);
          VcT[(c8 + j) * RP + t] = (bf16)f2bf(vf[j]);
          if (t == 63) EGL[c8 + j] = e2; }
      *(LAS u32x4*)(Kt + t * RP + c8) = pack8f(okt); *(LAS u32x4*)(Rt + t * RP + c8) = pack8f(ort); *(LAS u32x4*)(Kb + t * RP + c8) = pack8f(okb); *(LAS u32x4*)(Bb + t * RP + c8) = pack8f(obb); }
    const int next_unit = unit + C.G; if (next_unit < 4096) RWP_LOAD(next_unit);
    f32x4 cvv[2][8]; MoeTile mt = moe_tile_decode(C, MOE_CVT_BASE_C + (unit * 8 + w) * 2);
    if (side_cvt) moe_pair_load(mt, cvv, lane);
    __syncthreads();
    const int tm = w >> 1, tn0 = (w & 1) * 2, row = tm * 16 + (lane & 15), cq = 4 * (lane >> 4); const f32x4 z4 = (f32x4){0.f, 0.f, 0.f, 0.f};
#pragma unroll
    for (int q = 0; q < 2; ++q) { const int tn = tn0 + q, col = tn * 16 + cq;
        f32x4 a = lds_mma(Kt, RP, Kb, RP, tm, tn, 64, lane, z4), cc = lds_mma(Kt, RP, Bb, RP, tm, tn, 64, lane, z4), q1 = lds_mma(Rt, RP, Kb, RP, tm, tn, 64, lane, z4), q2 = lds_mma(Rt, RP, Bb, RP, tm, tn, 64, lane, z4);
#pragma unroll
        for (int j = 0; j < 4; ++j) { const bool lo_ = (col + j) < row, le_ = (col + j) <= row; a[j] = lo_ ? a[j] : 0.f; cc[j] = lo_ ? cc[j] : 0.f; q1[j] = le_ ? q1[j] : 0.f; q2[j] = le_ ? q2[j] : 0.f; }
        st4_bf16(Am + row * RP + col, a); st4_bf16(Q1 + row * RP + col, q1); st4_bf16(Q2 + row * RP + col, q2); *(LAS f32x4*)(F + row * 64 + col) = cc;
        if (row >= 32 && col < 32) st4_bf16(C10b + (row - 32) * 40 + col, cc); }
    __syncthreads();
    if (w == 0) tri_inverse_diag32(F, Tm, T00T, lane);
    else { for (int tile = w - 1; tile < 16; tile += 7) { const int am = tile >> 2, an = tile & 3; const f32x4 av = lds_mma(Am, RP, VcT, RP, am, an, 64, lane, z4); st4_bf16_T(AVT, am * 16 + (lane & 15), an * 16 + cq, av); } }
    __syncthreads();
    if (w < 4) { const int bm = w >> 1, bn = w & 1; const f32x4 x = lds_mma(C10b, 40, T00T, 40, bm, bn, 32, lane, z4);
#pragma unroll
        for (int j = 0; j < 4; ++j) XT[(bn * 16 + cq + j) * 40 + bm * 16 + (lane & 15)] = (bf16)f2bf(x[j]); }
    __syncthreads();
    if (w < 4) { const int bm = w >> 1, bn = w & 1; const f32x4 x = lds_mma(Tm + 32 * RP + 32, RP, XT, 40, bm, bn, 32, lane, z4);
        st4_bf16(Tm + (32 + bm * 16 + (lane & 15)) * RP + bn * 16 + cq, (f32x4){-x[0], -x[1], -x[2], -x[3]}); }
    if (side_cvt) moe_pair_store(mt, cvv, lane);
    __syncthreads();
#pragma unroll
    for (int q = 0; q < 2; ++q) { const int tn = tn0 + q, col = tn * 16 + cq;
        const f32x4 wm = lds_mma(Tm, RP, KtT, RP, tm, tn, 64, lane, z4), uu = lds_mma(Tm, RP, AVT, RP, tm, tn, 64, lane, z4);
        st4_bf16_T(WmT, row, col, wm); st4_bf16_T(UT, row, col, uu); }
    __syncthreads();
#pragma unroll
    for (int q = 0; q < 2; ++q) { const int tn = tn0 + q, col = tn * 16 + cq;
        { f32x4 p = lds_mma(Q2, RP, WmT, RP, tm, tn, 64, lane, z4); const u32x2 rw_ = *(const LAS u32x2*)(Rt + row * RP + col);
          st4_bf16_g(GRW + row * 64 + col, (f32x4){lo_bf(rw_.x) - p[0], hi_bf(rw_.x) - p[1], lo_bf(rw_.y) - p[2], hi_bf(rw_.y) - p[3]}); }
        { const f32x4 p1 = lds_mma(Q1, RP, VcT, RP, tm, tn, 64, lane, z4), p2 = lds_mma(Q2, RP, UT, RP, tm, tn, 64, lane, z4); st4_bf16_g(GYL + row * 64 + col, p1 - p2); }
        { f32x4 p = lds_mma(BhT, RP, WmT, RP, tm, tn, 64, lane, z4);
#pragma unroll
          for (int j = 0; j < 4; ++j) p[j] = ((col + j) == row ? EGL[row] : 0.f) - p[j];
          st4_bf16_g(GM + row * 64 + col, p); }
        { const f32x4 p1 = lds_mma(KhT, RP, VcT, RP, tm, tn, 64, lane, z4), p2 = lds_mma(BhT, RP, UT, RP, tm, tn, 64, lane, z4); st4_bf16_g(GN + row * 64 + col, p1 - p2); } }
    if (next_unit >= 4096) break; unit = next_unit;
  }
#undef RWP_LOAD
}
__device__ __forceinline__ void rwkv_scan_slice(const Ctx& C, int item) {
    const int bh = item >> 2, v0 = (item & 3) * 16, b = bh >> 4, h = bh & 15, lane = C.lane, w = C.wave;
    LAS bf16* SH = (LAS bf16*)C.lds;
    LAS bf16* SL = SH + 2 * 16 * RP;
    const bf16 *GM = ARP(bf16, A_RWM) + (size_t)bh * 64 * 4096, *GN = ARP(bf16, A_RWN) + (size_t)bh * 64 * 4096, *GRW = ARP(bf16, A_RWRW) + (size_t)bh * 64 * 4096, *GYL = ARP(bf16, A_RWYL) + (size_t)bh * 64 * 4096;
    bf16* YRAW = ARP(bf16, A_KR);
    const bool is_state = w >= 4; const int tm = w & 3, row = tm * 16 + (lane & 15), cq = 4 * (lane >> 4), kq = (lane >> 4) * 8;
    const bf16* GA = is_state ? GM : GRW; const bf16* GB = is_state ? GN : GYL;
    f32x4 st = (f32x4){0.f, 0.f, 0.f, 0.f};
    bf16x8 a0, a1, b0, b1; u32x2 addA, addB;
#define RWS_LOAD(cc_, X0, X1, XA) do { const size_t uo_ = (size_t)(cc_) * 4096; X0 = *(const bf16x8*)(GA + uo_ + row * 64 + kq); X1 = *(const bf16x8*)(GA + uo_ + row * 64 + 32 + kq); XA = *(const u32x2*)(GB + uo_ + row * 64 + v0 + cq); } while (0)
#define RWS_STEP(c_, X0, X1, XA) do { \
        LAS bf16* sh = SH + ((c_) & 1) * 16 * RP; LAS bf16* sl = SL + ((c_) & 1) * 16 * RP; \
        if (is_state) { _Pragma("unroll") for (int j = 0; j < 4; ++j) { const float s_ = st[j]; const unsigned hb = f2bf(s_); sh[(cq + j) * RP + row] = (bf16)hb; sl[(cq + j) * RP + row] = (bf16)f2bf(s_ - __uint_as_float(hb << 16)); } } \
        LDS_WAIT(); __builtin_amdgcn_s_barrier(); asm volatile("" ::: "memory"); \
        const LAS bf16* bh_ = sh + (lane & 15) * RP + kq; const LAS bf16* bl_ = sl + (lane & 15) * RP + kq; \
        const bf16x8 h0 = *(const LAS bf16x8*)bh_, h1 = *(const LAS bf16x8*)(bh_ + 32), l0 = *(const LAS bf16x8*)bl_, l1 = *(const LAS bf16x8*)(bl_ + 32); \
        f32x4 acc = (f32x4){lo_bf(XA.x), hi_bf(XA.x), lo_bf(XA.y), hi_bf(XA.y)}; \
        acc = __builtin_amdgcn_mfma_f32_16x16x32_bf16(h0, X0, acc, 0, 0, 0); acc = __builtin_amdgcn_mfma_f32_16x16x32_bf16(h1, X1, acc, 0, 0, 0); \
        acc = __builtin_amdgcn_mfma_f32_16x16x32_bf16(l0, X0, acc, 0, 0, 0); acc = __builtin_amdgcn_mfma_f32_16x16x32_bf16(l1, X1, acc, 0, 0, 0); \
        if ((c_) + 2 < 64) RWS_LOAD((c_) + 2, X0, X1, XA); \
        if (is_state) st = acc; \
        else st4_bf16_g(YRAW + ((size_t)b * SEQ + (c_) * 64 + row) * 1024 + h * 64 + v0 + cq, acc); } while (0)
    RWS_LOAD(0, a0, a1, addA); RWS_LOAD(1, b0, b1, addB);
    __syncthreads();
    for (int c = 0; c < 64; c += 2) { RWS_STEP(c, a0, a1, addA); RWS_STEP(c + 1, b0, b1, addB); }
#undef RWS_LOAD
#undef RWS_STEP
    __syncthreads();
}
__device__ __forceinline__ float sum8(float v) { v += DPPF(v, DPP_XOR1); v += DPPF(v, DPP_XOR2); v += DPPF(v, DPP_HMIRROR); return v; }
__device__ __forceinline__ void rwkv_out_items(const Ctx& C) {
    const bf16 *YRAW = ARP(bf16, A_KR), *KP = ARP(bf16, A_KP), *RR = ARP(bf16, A_RR), *VR = ARP(bf16, A_VR), *GG = ARP(bf16, A_GG); bf16* YCAT = ARP(bf16, A_YCAT);
    const float *r_k = INP(I_RW_R_K), *ln_w = INP(I_RW_LN_W), *ln_b = INP(I_RW_LN_B); const int lane = C.lane;
    for (int tt = C.gw; tt < T; tt += C.ngw) {
#pragma unroll
        for (int j = 0; j < 2; ++j) { const int ch = (j * 64 + lane) * 8; const size_t o = (size_t)tt * 1024 + ch;
            float y[8], rr[8], kp[8], vr[8], gg[8]; unpack8(*(const u32x4*)(YRAW + o), y); unpack8(*(const u32x4*)(RR + o), rr); unpack8(*(const u32x4*)(KP + o), kp); unpack8(*(const u32x4*)(VR + o), vr); unpack8(*(const u32x4*)(GG + o), gg);
            const f32x4 rk0 = *(const f32x4*)(r_k + ch), rk1 = *(const f32x4*)(r_k + ch + 4), lw0 = *(const f32x4*)(ln_w + ch), lw1 = *(const f32x4*)(ln_w + ch + 4), lb0 = *(const f32x4*)(ln_b + ch), lb1 = *(const f32x4*)(ln_b + ch + 4);
            const float rkf[8] = {rk0.x, rk0.y, rk0.z, rk0.w, rk1.x, rk1.y, rk1.z, rk1.w}, lwf[8] = {lw0.x, lw0.y, lw0.z, lw0.w, lw1.x, lw1.y, lw1.z, lw1.w}, lbf[8] = {lb0.x, lb0.y, lb0.z, lb0.w, lb1.x, lb1.y, lb1.z, lb1.w};
            float s1 = 0.f, sb = 0.f;
#pragma unroll
            for (int q = 0; q < 8; ++q) { s1 += y[q]; sb += rr[q] * kp[q] * rkf[q]; }
            const float mean = sum8(s1) * (1.f / 64.f), bonus = sum8(sb); float s2 = 0.f;
#pragma unroll
            for (int q = 0; q < 8; ++q) { y[q] -= mean; s2 += y[q] * y[q]; }
            const float rstd = rsqrtf(sum8(s2) * (1.f / 64.f) + 64e-5f); float o8[8];
#pragma unroll
            for (int q = 0; q < 8; ++q) o8[q] = (y[q] * rstd * lwf[q] + lbf[q] + bonus * vr[q]) * gg[q];
            st16_f(YCAT + (size_t)tt * DM + 1024 + ch, pack8f(o8)); }
    }
}
constexpr int MLE = 272;
__device__ __forceinline__ void ml_gate_scan(const Ctx& C, int bh4) {
    const float *IG = ARP(float, A_IG) + (size_t)bh4 * SEQ, *LFp = ARP(float, A_LF) + (size_t)bh4 * SEQ; float *AAg = ARP(float, A_MLA) + (size_t)bh4 * SEQ, *MXg = ARP(float, A_MLM) + (size_t)bh4 * SEQ;
    const int lane = C.lane, p0 = lane * 64; float tot = 0.f;
    for (int i = 0; i < 64; i += 4) { const f32x4 f = *(const f32x4*)(LFp + p0 + i); tot += (f.x + f.y) + (f.z + f.w); }
    float inc = tot;
#pragma unroll
    for (int o = 1; o < 64; o <<= 1) { const float n = __shfl_up(inc, o); if (lane >= o) inc += n; }
    float F = inc - tot, mloc = -INFINITY; f32x4 av[16];
#pragma unroll
    for (int i = 0; i < 16; ++i) { const f32x4 f = *(const f32x4*)(LFp + p0 + 4 * i), g = *(const f32x4*)(IG + p0 + 4 * i); f32x4 a;
        F += f.x; a.x = g.x - F; F += f.y; a.y = g.y - F; F += f.z; a.z = g.z - F; F += f.w; a.w = g.w - F;
        *(f32x4*)(AAg + p0 + 4 * i) = a; av[i] = a; mloc = fmaxf(fmaxf(mloc, fmaxf(a.x, a.y)), fmaxf(a.z, a.w)); }
    float minc = mloc;
#pragma unroll
    for (int o = 1; o < 64; o <<= 1) { const float n = __shfl_up(minc, o); if (lane >= o) minc = fmaxf(minc, n); }
    float run = __shfl_up(minc, 1); if (lane == 0) run = 0.f; run = fmaxf(run, 0.f);
#pragma unroll
    for (int i = 0; i < 16; ++i) { const f32x4 a = av[i]; f32x4 m;
        run = fmaxf(run, a.x); m.x = run; run = fmaxf(run, a.y); m.y = run; run = fmaxf(run, a.z); m.z = run; run = fmaxf(run, a.w); m.w = run;
        *(f32x4*)(MXg + p0 + 4 * i) = m; }
}
__device__ __forceinline__ void ml_intra_unit(const Ctx& C, int unit, bool side_cvt) {
    int tid = C.tid; asm volatile("" : "+v"(tid));
    const int bh4 = unit >> 6, c = unit & 63, b = bh4 >> 2, h = bh4 & 3, w = C.wave, lane = tid & 63, t0 = c * 64;
    LAS bf16* Qs = (LAS bf16*)C.lds;
    LAS bf16* Ks = Qs + 64 * 136;
    LAS bf16* KwT = Ks + 64 * 136;
    LAS bf16* VtE = KwT + 128 * 72;
    LAS bf16* Ps = VtE + MLE * 72;
    LAS float* AAs = (LAS float*)(Ps + 64 * 72);
    const bf16 *QM = ARP(bf16, A_QM), *KM = ARP(bf16, A_KM), *PAB = ARP(bf16, A_PAB);
    const float *AAg = ARP(float, A_MLA) + (size_t)bh4 * SEQ + t0, *MXg = ARP(float, A_MLM) + (size_t)bh4 * SEQ + t0;
    bf16* NUMI = ARP(bf16, A_MLNUM) + (size_t)unit * 64 * MLE; bf16* KVT = ARP(bf16, A_MLKV) + (size_t)unit * MLE * 128;
    const size_t tok0 = (size_t)b * SEQ + t0;
    u32x4 rq[2], rk[2], rv[4];
#pragma unroll
    for (int k = 0; k < 2; ++k) { const int idx = tid + 512 * k, r = idx >> 4, c8 = (idx & 15) * 8; const size_t o = (tok0 + r) * 512 + h * 128 + c8; rq[k] = *(const u32x4*)(QM + o); rk[k] = *(const u32x4*)(KM + o); }
#pragma unroll
    for (int k = 0; k < 4; ++k) { const int idx = tid + 512 * k, r = idx >> 5, e8 = (idx & 31) * 8; rv[k] = *(const u32x4*)(PAB + (tok0 + r) * AB_PAD + 1024 + h * 256 + e8); }
    const float Mc2 = MXg[63];
    f32x4 cvv[2][8]; MoeTile mt = moe_tile_decode(C, MOE_CVT_BASE_F + (unit * 8 + w) * 2); if (side_cvt) moe_pair_load(mt, cvv, lane);
    __syncthreads();
    if (tid < 64) { AAs[tid] = AAg[tid]; AAs[64 + tid] = MXg[tid]; }
    for (int i = tid; i < 16 * 72; i += NTHR) VtE[256 * 72 + i] = (i < 72) ? (bf16)0x3f80 : (bf16)0;
#pragma unroll
    for (int k = 0; k < 2; ++k) { const int idx = tid + 512 * k, r = idx >> 4, c8 = (idx & 15) * 8;
        *(LAS u32x4*)(Qs + r * 136 + c8) = rq[k]; *(LAS u32x4*)(Ks + r * 136 + c8) = rk[k];
        float kf[8]; unpack8(rk[k], kf); const float wk = __expf(AAg[r] - Mc2);
#pragma unroll
        for (int j = 0; j < 8; ++j) KwT[(c8 + j) * 72 + r] = (bf16)f2bf(kf[j] * wk); }
#pragma unroll
    for (int k = 0; k < 4; ++k) { const int idx = tid + 512 * k, r = idx >> 5, e8 = (idx & 31) * 8; const unsigned wv[4] = {rv[k].x, rv[k].y, rv[k].z, rv[k].w};
#pragma unroll
        for (int j = 0; j < 4; ++j) { VtE[(e8 + 2 * j) * 72 + r] = (bf16)(wv[j] & 0xffff); VtE[(e8 + 2 * j + 1) * 72 + r] = (bf16)(wv[j] >> 16); } }
    __syncthreads();
#pragma unroll
    for (int q = 0; q < 2; ++q) { const int tile = 2 * w + q, tm = tile >> 2, tn = tile & 3; const int t = tm * 16 + (lane & 15), l0 = tn * 16 + 4 * (lane >> 4);
        f32x4 s = (f32x4){0.f, 0.f, 0.f, 0.f};
        if (tn <= tm) s = lds_mma(Qs, 136, Ks, 136, tm, tn, 128, lane, s);
        const float mxt = AAs[64 + t]; float pvv[4];
#pragma unroll
        for (int j = 0; j < 4; ++j) { const int l = l0 + j; pvv[j] = (l <= t) ? s[j] * __expf(AAs[l] - mxt) : 0.f; }
        u32x2 pw; pw.x = pk2(pvv[0], pvv[1]); pw.y = pk2(pvv[2], pvv[3]); *(LAS u32x2*)(Ps + t * 72 + l0) = pw; }
    { const int tn = w;
      for (int tm = 0; tm < 17; ++tm) { const f32x4 kv = lds_mma(VtE, 72, KwT, 72, tm, tn, 64, lane, (f32x4){0.f, 0.f, 0.f, 0.f}); const int e = tm * 16 + (lane & 15);
          if (e <= 256) st4_bf16_g(KVT + (size_t)e * 128 + tn * 16 + 4 * (lane >> 4), kv); } }
    __syncthreads();
    { const int tm = w >> 1, t = tm * 16 + (lane & 15);
      for (int tn = (w & 1); tn < 17; tn += 2) { const f32x4 nv = lds_mma(Ps, 72, VtE, 72, tm, tn, 64, lane, (f32x4){0.f, 0.f, 0.f, 0.f}); st4_bf16_g(NUMI + (size_t)t * MLE + tn * 16 + 4 * (lane >> 4), nv); } }
    if (side_cvt) moe_pair_store(mt, cvv, lane);
}
__device__ __forceinline__ void ml_state_scan(const Ctx& C, int first_block, int nblocks) {
    const float* MXg = ARP(float, A_MLM); bf16* KVT = ARP(bf16, A_MLKV);
    constexpr int NPAIR = 16 * 257 * 64;
    const int nthr = nblocks * NTHR, g0 = (C.bid - first_block) * NTHR + C.tid;
    unsigned eoff[3], moff[3]; f32x2 cst[3]; float mprev[3]; bool ev[3];
#pragma unroll
    for (int k = 0; k < 3; ++k) { const int pi = g0 + k * nthr; ev[k] = pi < NPAIR; const int bh4 = ev[k] ? pi / (257 * 64) : 0, r = ev[k] ? pi - bh4 * (257 * 64) : 0;
        eoff[k] = (unsigned)(bh4 * 64 * MLE * 128 + 2 * r); moff[k] = (unsigned)(bh4 * SEQ); cst[k] = (f32x2){0.f, 0.f}; mprev[k] = 0.f; }
    for (int c0 = 0; c0 < 64; c0 += 8) {
        unsigned kvw[3][8]; float mn[3][8];
#pragma unroll
        for (int k = 0; k < 3; ++k)
#pragma unroll
            for (int j = 0; j < 8; ++j) { kvw[k][j] = 0u; mn[k][j] = 0.f; if (ev[k]) { kvw[k][j] = *(const unsigned*)(KVT + eoff[k] + (unsigned)(c0 + j) * (MLE * 128)); mn[k][j] = MXg[moff[k] + (c0 + j) * 64 + 63]; } }
#pragma unroll
        for (int j = 0; j < 8; ++j)
#pragma unroll
            for (int k = 0; k < 3; ++k) if (ev[k]) { *(unsigned*)(KVT + eoff[k] + (unsigned)(c0 + j) * (MLE * 128)) = pk2(cst[k].x, cst[k].y);
                const float dc = __expf(mprev[k] - mn[k][j]); cst[k].x = dc * cst[k].x + lo_bf(kvw[k][j]); cst[k].y = dc * cst[k].y + hi_bf(kvw[k][j]); mprev[k] = mn[k][j]; } }
}
__device__ __forceinline__ void ml_out_unit(const Ctx& C, int unit, bool side_cvt) {
    int tid = C.tid; asm volatile("" : "+v"(tid));
    const int bh4 = unit >> 6, c = unit & 63, b = bh4 >> 2, h = bh4 & 3, w = C.wave, lane = tid & 63, t0 = c * 64;
    LAS bf16* Qs = (LAS bf16*)C.lds;
    LAS bf16* CTs = Qs + 64 * 136;
    const bf16 *QM = ARP(bf16, A_QM), *PAB = ARP(bf16, A_PAB), *NUMI = ARP(bf16, A_MLNUM) + (size_t)unit * 64 * MLE, *KVT = ARP(bf16, A_MLKV) + (size_t)unit * MLE * 128; bf16* YCAT = ARP(bf16, A_YCAT);
    const float *IG = ARP(float, A_IG) + (size_t)bh4 * SEQ + t0, *AAg = ARP(float, A_MLA) + (size_t)bh4 * SEQ + t0, *MXg = ARP(float, A_MLM) + (size_t)bh4 * SEQ + t0;
    const size_t tok0 = (size_t)b * SEQ + t0;
    u32x4 rq[2], rc[9];
#pragma unroll
    for (int k = 0; k < 2; ++k) { const int idx = tid + 512 * k, r = idx >> 4, c8 = (idx & 15) * 8; rq[k] = *(const u32x4*)(QM + (tok0 + r) * 512 + h * 128 + c8); }
#pragma unroll
    for (int k = 0; k < 9; ++k) { const int idx = tid + 512 * k, e = idx >> 4, c8 = (idx & 15) * 8; rc[k] = (u32x4){0u, 0u, 0u, 0u}; if (e <= 256) rc[k] = *(const u32x4*)(KVT + (size_t)e * 128 + c8); }
    const float Mc = c ? MXg[-1] : 0.f;
    f32x4 cvv[2][8]; MoeTile mt = moe_tile_decode(C, MOE_CVT_BASE_G + (unit * 8 + w) * 2); if (side_cvt) moe_pair_load(mt, cvv, lane);
    __syncthreads();
#pragma unroll
    for (int k = 0; k < 2; ++k) { const int idx = tid + 512 * k, r = idx >> 4, c8 = (idx & 15) * 8; *(LAS u32x4*)(Qs + r * 136 + c8) = rq[k]; }
#pragma unroll
    for (int k = 0; k < 9; ++k) { const int idx = tid + 512 * k, e = idx >> 4, c8 = (idx & 15) * 8; if (e < MLE) *(LAS u32x4*)(CTs + e * 136 + c8) = rc[k]; }
    __syncthreads();
    const int tm = w >> 1, t = tm * 16 + (lane & 15), cq = 4 * (lane >> 4); const size_t tt = tok0 + t; const float scale = 0.08838834764831845f;
    const float wst = __expf(Mc - MXg[t]), mrow = IG[t] - AAg[t] + MXg[t];
    float inv;
    { const f32x4 a2 = lds_mma(Qs, 136, CTs, 136, tm, 16, 128, lane, (f32x4){0.f, 0.f, 0.f, 0.f}); const float di = bf2f(NUMI[(size_t)t * MLE + 256]);
      float den = (lane < 16) ? (di + a2[0] * wst) * scale : 0.f; den += xor16f(den); den += xor32f(den);
      inv = 1.f / fmaxf(fabsf(den), __expf(-mrow)); }
    for (int tn = (w & 1); tn < 16; tn += 2) { const f32x4 a2 = lds_mma(Qs, 136, CTs, 136, tm, tn, 128, lane, (f32x4){0.f, 0.f, 0.f, 0.f});
        const u32x2 ni = *(const u32x2*)(NUMI + (size_t)t * MLE + tn * 16 + cq); const u32x2 og = *(const u32x2*)(PAB + tt * AB_PAD + 2048 + h * 256 + tn * 16 + cq);
        const float n0 = (lo_bf(ni.x) + a2[0] * wst) * scale * inv, n1 = (hi_bf(ni.x) + a2[1] * wst) * scale * inv, n2 = (lo_bf(ni.y) + a2[2] * wst) * scale * inv, n3 = (hi_bf(ni.y) + a2[3] * wst) * scale * inv;
        u32x2 o; o.x = pk2(sigmoidf_(lo_bf(og.x)) * n0, sigmoidf_(hi_bf(og.x)) * n1); o.y = pk2(sigmoidf_(lo_bf(og.y)) * n2, sigmoidf_(hi_bf(og.y)) * n3);
        st8_f(YCAT + tt * DM + h * 256 + tn * 16 + cq, o); }
    if (side_cvt) moe_pair_store(mt, cvv, lane);
}

__device__ __forceinline__ void mlstm_unit(const Ctx& C, const Args& A, int unit) {
    const int bh = unit >> 3, dvs = unit & 7, b = bh >> 2, h = bh & 3, w = C.wave, lane = C.lane, tid = C.tid;
    LAS float* AA = (LAS float*)C.lds;
    LAS float* MX = AA + 4096;
    LAS bf16* Qs = (LAS bf16*)(MX + 4096);
    LAS bf16* Ks = Qs + 64 * 136;
    LAS bf16* KwT = Ks + 64 * 136;
    LAS bf16* Vt = KwT + 128 * 72;
    LAS bf16* Ps = Vt + 48 * 72;
    LAS bf16* CT = Ps + 64 * 72;
    LAS float* NUM = (LAS float*)(CT + 48 * 136);
    const float *IG = ARP(float, A_IG) + (size_t)bh * SEQ, *LFp = ARP(float, A_LF) + (size_t)bh * SEQ;
    const bf16 *QM = ARP(bf16, A_QM), *KM = ARP(bf16, A_KM), *PAB = ARP(bf16, A_PAB); bf16* YCAT = ARP(bf16, A_YCAT);
    __syncthreads();
    if (w == 0) { float carryF = 0.f, carryM = 0.f;
        for (int c = 0; c < 64; ++c) { const int p = c * 64 + lane; float f = LFp[p];
#pragma unroll
            for (int o = 1; o < 64; o <<= 1) { const float n = __shfl_up(f, o); if (lane >= o) f += n; }
            f += carryF; const float a = IG[p] - f; float m = a;
#pragma unroll
            for (int o = 1; o < 64; o <<= 1) { const float n = __shfl_up(m, o); if (lane >= o) m = fmaxf(m, n); }
            m = fmaxf(m, carryM); AA[p] = a; MX[p] = m; carryF = __shfl(f, 63); carryM = __shfl(m, 63); } }
    for (int i = tid; i < 48 * 72; i += NTHR) { const int r = i / 72; Vt[i] = (r == 32) ? (bf16)0x3f80 : (bf16)0; }
    for (int i = tid; i < 48 * 136; i += NTHR) CT[i] = 0;
    f32x4 accC[3];
#pragma unroll
    for (int k = 0; k < 3; ++k) accC[k] = (f32x4){0.f, 0.f, 0.f, 0.f};
    const size_t tok0 = (size_t)b * SEQ;
    u32x4 rq[2], rk[2], rv;
#define ML_LOAD(c) do { _Pragma("unroll") for (int k = 0; k < 2; ++k) { const int idx = tid + 512 * k, r = idx >> 4, c8 = (idx & 15) * 8; const size_t o = (tok0 + (c) * 64 + r) * 512 + h * 128 + c8; \
            rq[k] = *(const u32x4*)(QM + o); rk[k] = *(const u32x4*)(KM + o); } \
        if (tid < 256) rv = *(const u32x4*)(PAB + (tok0 + (c) * 64 + (tid >> 2)) * AB_PAD + 1024 + h * 256 + dvs * 32 + (tid & 3) * 8); } while (0)
    ML_LOAD(0);
    __syncthreads();
    const float scale = 0.08838834764831845f;
    for (int c = 0; c < 64; ++c) {
        const int t0 = c * 64; const float Mc = c ? MX[t0 - 1] : 0.f, Mc2 = MX[t0 + 63];
#pragma unroll
        for (int k = 0; k < 2; ++k) { const int idx = tid + 512 * k, r = idx >> 4, c8 = (idx & 15) * 8;
            *(LAS u32x4*)(Qs + r * 136 + c8) = rq[k]; *(LAS u32x4*)(Ks + r * 136 + c8) = rk[k];
            float kf[8]; unpack8(rk[k], kf); const float wk = __expf(AA[t0 + r] - Mc2);
#pragma unroll
            for (int j = 0; j < 8; ++j) KwT[(c8 + j) * 72 + r] = (bf16)f2bf(kf[j] * wk); }
        if (tid < 256) { const int r = tid >> 2, e8 = (tid & 3) * 8; const unsigned wv[4] = {rv.x, rv.y, rv.z, rv.w};
#pragma unroll
            for (int j = 0; j < 4; ++j) { Vt[(e8 + 2 * j) * 72 + r] = (bf16)(wv[j] & 0xffff); Vt[(e8 + 2 * j + 1) * 72 + r] = (bf16)(wv[j] >> 16); } }
        if (c + 1 < 64) ML_LOAD(c + 1);
        __syncthreads();
#pragma unroll
        for (int q = 0; q < 2; ++q) { const int tile = 2 * w + q, tm = tile >> 2, tn = tile & 3; const int t = tm * 16 + (lane & 15), l0 = tn * 16 + 4 * (lane >> 4);
            f32x4 s = (f32x4){0.f, 0.f, 0.f, 0.f};
            if (tn <= tm) s = lds_mma(Qs, 136, Ks, 136, tm, tn, 128, lane, s);
            const float mxt = MX[t0 + t]; float pvv[4];
#pragma unroll
            for (int j = 0; j < 4; ++j) { const int l = l0 + j; pvv[j] = (l <= t) ? s[j] * __expf(AA[t0 + l] - mxt) : 0.f; }
            u32x2 pw; pw.x = pk2(pvv[0], pvv[1]); pw.y = pk2(pvv[2], pvv[3]); *(LAS u32x2*)(Ps + t * 72 + l0) = pw; }
        __syncthreads();
        for (int tile = w; tile < 12; tile += 8) { const int tm = tile / 3, tn = tile % 3; const int t = tm * 16 + (lane & 15);
            f32x4 a1 = lds_mma(Ps, 72, Vt, 72, tm, tn, 64, lane, (f32x4){0.f, 0.f, 0.f, 0.f});
            f32x4 a2 = lds_mma(Qs, 136, CT, 136, tm, tn, 128, lane, (f32x4){0.f, 0.f, 0.f, 0.f});
            const float wst = __expf(Mc - MX[t0 + t]);
            *(LAS f32x4*)(NUM + t * 48 + tn * 16 + 4 * (lane >> 4)) = (a1 + a2 * wst) * scale; }
        __syncthreads();
        { const int t = tid >> 3, e4 = (tid & 7) * 4; const size_t tt = tok0 + t0 + t;
          const float den = NUM[t * 48 + 32], mrow = IG[t0 + t] - AA[t0 + t] + MX[t0 + t];
          const float inv = 1.f / fmaxf(fabsf(den), __expf(-mrow));
          const f32x4 nv = *(const LAS f32x4*)(NUM + t * 48 + e4);
          const u32x2 og = *(const u32x2*)(PAB + tt * AB_PAD + 2048 + h * 256 + dvs * 32 + e4);
          u32x2 o; o.x = pk2(sigmoidf_(lo_bf(og.x)) * nv[0] * inv, sigmoidf_(hi_bf(og.x)) * nv[1] * inv); o.y = pk2(sigmoidf_(lo_bf(og.y)) * nv[2] * inv, sigmoidf_(hi_bf(og.y)) * nv[3] * inv);
          *(u32x2*)(YCAT + tt * DM + h * 256 + dvs * 32 + e4) = o; }
        { const float decay = __expf(Mc - Mc2);
#pragma unroll
          for (int tm = 0; tm < 3; ++tm) { accC[tm] = lds_mma(Vt, 72, KwT, 72, tm, w, 64, lane, accC[tm] * decay);
              u32x2 cw; cw.x = pk2(accC[tm][0], accC[tm][1]); cw.y = pk2(accC[tm][2], accC[tm][3]);
              *(LAS u32x2*)(CT + (tm * 16 + (lane & 15)) * 136 + w * 16 + 4 * (lane >> 4)) = cw; } }
        __syncthreads();
    }
#undef ML_LOAD
}

__device__ __forceinline__ void phase_rowstat(const Ctx& C) {
    const bf16* XR = WSP(bf16, WS_XR); float* RS = WSP(float, WS_TAB + TAB_RSTD);
    for (int r = C.gw; r < T; r += C.ngw) { const u32x4* xr = (const u32x4*)(XR + (size_t)r * DM); float s = 0.f;
#pragma unroll
        for (int j = 0; j < 4; ++j) { float f[8]; unpack8(xr[j * 64 + C.lane], f);
#pragma unroll
            for (int q = 0; q < 8; ++q) s += f[q] * f[q]; }
        s = wave_sum(s); if (C.lane == 0) RS[r] = rsqrtf(s * (1.f / DM) + EPS); }
}
__device__ __forceinline__ void phase_softmax256(const Ctx& C) {
    const float* SC = ARP(float, A_SC); bf16* PC = ARP(bf16, A_PC);
    for (int it = C.gw; it < T * 4; it += C.ngw) { const size_t o = (size_t)it * 256 + C.lane * 4;
        const f32x4 v = *(const f32x4*)(SC + o); const float m = wave_max(fmaxf(fmaxf(v.x, v.y), fmaxf(v.z, v.w)));
        const float e0 = __expf(v.x - m), e1 = __expf(v.y - m), e2 = __expf(v.z - m), e3 = __expf(v.w - m);
        const float inv = 1.f / wave_sum(e0 + e1 + e2 + e3);
        u32x2 w; w.x = pk2(e0 * inv, e1 * inv); w.y = pk2(e2 * inv, e3 * inv); *(u32x2*)(PC + o) = w; }
}
constexpr int MOE_NB = 256, MOE_TPB = T / MOE_NB;
__device__ __forceinline__ void phase_route(const Ctx& C, const Args& A, int l) {
    const float* LG = ARP(float, A_XS); constexpr size_t PL = (size_t)T * 256;     int* EID = ARP(int, A_EID); float* WTS = ARP(float, A_WTS); int* LRANK = ARP(int, A_LRANK); int* BH = ARP(int, A_BHIST);
    const float *bg = INP(I_MOE_BG) + l * 8, *be = INP(I_MOE_BE) + l * 64;
    LAS int* hist = (LAS int*)(C.lds + LDS_AUX);
    for (int bk = C.bid; bk < MOE_NB; bk += C.G) {
        __syncthreads();
        if (C.tid < 64) hist[C.tid] = 0;
        __syncthreads();
        if (C.tid < MOE_TPB) { const int t = bk * MOE_TPB + C.tid; const float* L = LG + (size_t)t * 256;
            float lg[8], mx = -INFINITY; int grp = 0;
#pragma unroll
            for (int g = 0; g < 8; ++g) { lg[g] = ((L[g] + L[PL + g]) + (L[2 * PL + g] + L[3 * PL + g])) + bg[g]; if (lg[g] > mx) { mx = lg[g]; grp = g; } }
            float se = 0.f;
#pragma unroll
            for (int g = 0; g < 8; ++g) se += __expf(lg[g] - mx);
            const float pgrp = 1.f / se;
            float l1 = -INFINITY, l2 = -INFINITY; int i1 = 0, i2 = 0;
            for (int j = 0; j < 8; ++j) { const int x = 8 + grp * 8 + j; const float v = ((L[x] + L[PL + x]) + (L[2 * PL + x] + L[3 * PL + x])) + be[grp * 8 + j];
                if (v > l1) { l2 = l1; i2 = i1; l1 = v; i1 = j; } else if (v > l2) { l2 = v; i2 = j; } }
            const float w1 = 1.f / (1.f + __expf(l2 - l1)), w2 = 1.f - w1;
            const int e1 = grp * 8 + i1, e2 = grp * 8 + i2;
            EID[2 * t] = e1; EID[2 * t + 1] = e2; WTS[2 * t] = pgrp * w1; WTS[2 * t + 1] = pgrp * w2;
            LRANK[2 * t] = atomicAdd((int*)(hist + e1), 1); LRANK[2 * t + 1] = atomicAdd((int*)(hist + e2), 1); }
        __syncthreads();
        if (C.tid < 64) BH[bk * 64 + C.tid] = hist[C.tid];
    }
}
__device__ __forceinline__ void phase_gather(const Ctx& C, int l) {
    LAS int* tab = (LAS int*)(C.lds + LDS_AUX);
    const int* BH = ARP(int, A_BHIST); const int* EID = ARP(int, A_EID); const int* LRANK = ARP(int, A_LRANK); int* ROWSLOT = ARP(int, A_ROWSLOT); const bf16* XNp = WSP(bf16, WS_XR); bf16* XS = ARP(bf16, A_XS);
    unsigned* cnt = WSP(unsigned, WS_CTL) + CW_MOE_CNT + l * 64;
    for (int bk = C.bid; bk < MOE_NB; bk += C.G) {
        __syncthreads();
        { static_assert(MOE_NB == 8 * 32, "8 waves x 32 buckets"); const int e = C.tid & 63, part = C.tid >> 6; int tot = 0, before = 0;
#pragma unroll 8
            for (int q = part * 32; q < part * 32 + 32; ++q) { const int v = BH[q * 64 + e]; tot += v; if (q < bk) before += v; }
            tab[256 + part * 64 + e] = tot; tab[768 + part * 64 + e] = before; }
        __syncthreads();
        if (C.tid < 64) { int tot = 0, before = 0;
#pragma unroll
            for (int part = 0; part < 8; ++part) { tot += tab[256 + part * 64 + C.tid]; before += tab[768 + part * 64 + C.tid]; }
            const int seg = ((tot + 255) >> 8) << 8, inc = wave_incl_scan_i(seg, C.tid);
            tab[C.tid] = inc - seg; tab[64 + C.tid] = before; if (bk == 0) cnt[C.tid] = (unsigned)tot; }
        __syncthreads();
        if (C.tid < 2 * MOE_TPB) { const int a = bk * 2 * MOE_TPB + C.tid, e = EID[a], pos = tab[e] + tab[64 + e] + LRANK[a]; tab[128 + C.tid] = pos; ROWSLOT[pos] = a; }
        __syncthreads();
    }
}
__device__ __forceinline__ void phase_combine_norm(const Ctx& C, const float* gain, float* OUT) {
    bf16* XR = WSP(bf16, WS_XR); const bf16* YE = ARP(bf16, A_YE); float* RS = WSP(float, WS_RSQ) + (size_t)4 * T * 8; const int lane = C.lane;
    for (int t = C.gw; t < T; t += C.ngw) { bf16* xr = XR + (size_t)t * DM; const bf16* y0 = YE + (size_t)(2 * t) * DM; const bf16* y1 = y0 + DM;
        float v[4][8]; float s = 0.f; u32x4 rx[4], ra[4], rb[4];
#pragma unroll
        for (int j = 0; j < 4; ++j) { const int o = (j * 64 + lane) * 8; rx[j] = *(const u32x4*)(xr + o); ra[j] = *(const u32x4*)(y0 + o); rb[j] = *(const u32x4*)(y1 + o); }
#pragma unroll
        for (int j = 0; j < 4; ++j) { const int o = (j * 64 + lane) * 8; float a[8], b0[8]; unpack8(rx[j], v[j]); unpack8(ra[j], a); unpack8(rb[j], b0);
#pragma unroll
            for (int q = 0; q < 8; ++q) v[j][q] += a[q] + b0[q];
            if (!OUT) { const u32x4 w = pack8f(v[j]); *(u32x4*)(xr + o) = w; unpack8(w, v[j]); }
#pragma unroll
            for (int q = 0; q < 8; ++q) s += v[j][q] * v[j][q]; }
        const float ssq = wave_sum(s), rstd = rstd_of(ssq);
        if (!OUT) { if (lane < 8) RS[(size_t)t * 8 + lane] = (lane == 0) ? ssq : 0.f; }
        else {
#pragma unroll
            for (int j = 0; j < 4; ++j) { const int o = (j * 64 + lane) * 8; const f32x4 g0 = *(const f32x4*)(gain + o), g1 = *(const f32x4*)(gain + o + 4);
                *(f32x4*)(OUT + (size_t)t * DM + o) = (f32x4){v[j][0] * rstd * g0.x, v[j][1] * rstd * g0.y, v[j][2] * rstd * g0.z, v[j][3] * rstd * g0.w};
                *(f32x4*)(OUT + (size_t)t * DM + o + 4) = (f32x4){v[j][4] * rstd * g1.x, v[j][5] * rstd * g1.y, v[j][6] * rstd * g1.z, v[j][7] * rstd * g1.w}; } }
    }
}

__device__ __forceinline__ float gelu_tanh(float x) { return 0.5f * x * (1.f + tanhf(0.7978845608028654f * (x + 0.044715f * x * x * x))); }
__device__ __forceinline__ void phase_cmp_finish(const Ctx& C, const Args& A) {
    const float* CP = ARP(float, A_CPART); const float* bias = WSP(float, WS_TAB + TAB_CMPBIAS); const float* w2 = INP(I_CMP_W2);
    LAS float* hid = (LAS float*)C.lds + C.wave * 128; const int lane = C.lane;
    for (int it = C.gw; it < 2 * 16 * 256; it += C.ngw) { const int j = it & 255, bg = (it >> 8) & 15, kv = it >> 12;
        bf16* dst = ARP(bf16, kv ? A_VCMP : A_KCMP) + ((size_t)bg * 256 + j) * 128;
        bf16* dstT = ARP(bf16, A_VCT) + (size_t)bg * 128 * 256 + j;
        if (j == 255) { dst[lane] = 0; dst[lane + 64] = 0; if (kv) { dstT[(size_t)lane * 256] = 0; dstT[(size_t)(lane + 64) * 256] = 0; } continue; }
        float h0 = 0.f, h1 = 0.f;
#pragma unroll
        for (int part = 0; part < 8; ++part) { h0 += bias[part * 256 + kv * 128 + lane]; h1 += bias[part * 256 + kv * 128 + 64 + lane]; }
#pragma unroll
        for (int ks = 0; ks < 8; ++ks) { const float* p = CP + ((size_t)((ks * 2 + kv) * 16 + bg) * 256 + j) * 256; h0 += p[lane]; h1 += p[64 + lane]; }
        hid[lane] = gelu_tanh(h0); hid[64 + lane] = gelu_tanh(h1); LDS_WAIT(); asm volatile("" ::: "memory");
        float o0 = 0.f, o1 = 0.f; const float* W = w2 + (size_t)kv * 128 * 128;
#pragma unroll 16
        for (int e = 0; e < 128; ++e) { const float hv = hid[e]; o0 += hv * W[e * 128 + lane]; o1 += hv * W[e * 128 + 64 + lane]; }
        dst[lane] = (bf16)f2bf(o0); dst[lane + 64] = (bf16)f2bf(o1); if (kv) { dstT[(size_t)lane * 256] = (bf16)f2bf(o0); dstT[(size_t)(lane + 64) * 256] = (bf16)f2bf(o1); } LDS_WAIT(); asm volatile("" ::: "memory"); }
}
__device__ __forceinline__ void phase_cmp_attn(const Ctx& C) {
    const bf16 *Q = ARP(bf16, A_Q), *KC = ARP(bf16, A_KCMP), *VC = ARP(bf16, A_VCMP); const float* GATES = ARP(float, A_GATES);
    float* OACC = ARP(float, A_OACC); unsigned long long* SELM = ARP(unsigned long long, A_SELMASK);
    LAS float* qs = (LAS float*)C.lds + C.wave * 1536;
    LAS float* ps = qs + 512; const int lane = C.lane; const float scale = 0.08838834764831845f;
    for (int it = C.gw; it < T * 4; it += C.ngw) { const int t = it >> 2, g = it & 3, b = t >> 12, s = t & 4095;
        const int nvalid = (s >= 31) ? ((s - 31) >> 4) + 1 : 0;
#pragma unroll
        for (int r = 0; r < 4; ++r) { const bf16* qp = Q + (((size_t)(b * 16 + g * 4 + r)) * SEQ + s) * 128; qs[r * 128 + lane] = bf2f(qp[lane]); qs[r * 128 + 64 + lane] = bf2f(qp[64 + lane]); }
        LDS_WAIT(); asm volatile("" ::: "memory");
        float sc[4][4];
#pragma unroll
        for (int i = 0; i < 4; ++i) { const int j = lane + 64 * i;
#pragma unroll
            for (int r = 0; r < 4; ++r) sc[r][i] = 0.f;
            if (j < nvalid) { const bf16* kp = KC + ((size_t)(b * 4 + g) * 256 + j) * 128;
                for (int d8 = 0; d8 < 16; ++d8) { float kf[8]; unpack8(*(const u32x4*)(kp + d8 * 8), kf);
#pragma unroll
                    for (int r = 0; r < 4; ++r) { float a = 0.f;
#pragma unroll
                        for (int jj = 0; jj < 8; ++jj) a += qs[r * 128 + d8 * 8 + jj] * kf[jj];
                        sc[r][i] += a; } } } }
#pragma unroll
        for (int r = 0; r < 4; ++r) { float m = -INFINITY;
#pragma unroll
            for (int i = 0; i < 4; ++i) if (lane + 64 * i < nvalid) m = fmaxf(m, sc[r][i] * scale);
            m = wave_max(m); if (!(m > -INFINITY)) m = 0.f; float e[4], sum = 0.f;
#pragma unroll
            for (int i = 0; i < 4; ++i) { e[i] = (lane + 64 * i < nvalid) ? __expf(sc[r][i] * scale - m) : 0.f; sum += e[i]; }
            sum = wave_sum(sum); const float inv = sum > 0.f ? 1.f / sum : 1.f;
#pragma unroll
            for (int i = 0; i < 4; ++i) ps[r * 256 + lane + 64 * i] = e[i] * inv; }
        LDS_WAIT(); asm volatile("" ::: "memory");
        float o[4][2];
#pragma unroll
        for (int r = 0; r < 4; ++r) { o[r][0] = 0.f; o[r][1] = 0.f; }
        for (int j = 0; j < nvalid; ++j) { const bf16* vp = VC + ((size_t)(b * 4 + g) * 256 + j) * 128; const float v0 = bf2f(vp[lane]), v1 = bf2f(vp[64 + lane]);
#pragma unroll
            for (int r = 0; r < 4; ++r) { const float p = ps[r * 256 + j]; o[r][0] += p * v0; o[r][1] += p * v1; } }
#pragma unroll
        for (int r = 0; r < 4; ++r) { const float gt = GATES[(size_t)t * 48 + g * 4 + r]; float* op = OACC + (size_t)t * DM + (g * 4 + r) * 128; op[lane] = gt * o[r][0]; op[64 + lane] = gt * o[r][1]; }
        float imp = 0.f;
#pragma unroll
        for (int r = 0; r < 4; ++r) { const LAS float* p = ps + r * 256; const int j0 = 4 * lane;
            imp += (j0 > 0 ? 0.5f * p[j0 - 1] : 0.f) + p[j0] + p[j0 + 1] + p[j0 + 2] + 0.5f * p[j0 + 3]; }
        const int cur = s >> 6; float score;
        if (lane == 0 || lane == cur || lane == cur - 1) score = INFINITY; else score = (lane <= cur) ? imp : -INFINITY;
        int rank = 0;
        for (int o2 = 0; o2 < 64; ++o2) { const float so = __int_as_float(__builtin_amdgcn_readlane(__float_as_int(score), o2)); rank += (so > score || (so == score && o2 < lane)) ? 1 : 0; }
        const unsigned long long m = __ballot(rank < 16 && score > -INFINITY);
        if (lane == 0) SELM[(size_t)t * 4 + g] = m;
        LDS_WAIT(); asm volatile("" ::: "memory");
    }
}
struct NaiveAttnState { float m[4], l[4], o[4][2]; };
__device__ __forceinline__ void naive_tile(NaiveAttnState& S, const LAS float* qs, LAS float* pt, const bf16* Kt, const bf16* Vt_, int key0, bool valid, int lane) {
    float sc[4] = {0.f, 0.f, 0.f, 0.f}; const float scale = 0.08838834764831845f;
    if (valid) { const bf16* kp = Kt + (size_t)(key0 + lane) * 128;
        for (int d8 = 0; d8 < 16; ++d8) { float kf[8]; unpack8(*(const u32x4*)(kp + d8 * 8), kf);
#pragma unroll
            for (int r = 0; r < 4; ++r) { float a = 0.f;
#pragma unroll
                for (int jj = 0; jj < 8; ++jj) a += qs[r * 128 + d8 * 8 + jj] * kf[jj];
                sc[r] += a; } } }
    const unsigned long long vm = __ballot(valid);
    if (vm == 0ull) return;
#pragma unroll
    for (int r = 0; r < 4; ++r) { const float sv = valid ? sc[r] * scale : -INFINITY; const float mt = wave_max(sv), mn = fmaxf(S.m[r], mt);
        const float alpha = __expf(S.m[r] - mn), p = valid ? __expf(sv - mn) : 0.f;
        S.l[r] = S.l[r] * alpha + wave_sum(p); S.o[r][0] *= alpha; S.o[r][1] *= alpha; S.m[r] = mn; pt[r * 64 + lane] = p; }
    LDS_WAIT(); asm volatile("" ::: "memory");
    for (int k = 0; k < 64; ++k) { if (!((vm >> k) & 1ull)) continue; const bf16* vp = Vt_ + (size_t)(key0 + k) * 128; const float v0 = bf2f(vp[lane]), v1 = bf2f(vp[64 + lane]);
#pragma unroll
        for (int r = 0; r < 4; ++r) { const float p = pt[r * 64 + k]; S.o[r][0] += p * v0; S.o[r][1] += p * v1; } }
    LDS_WAIT(); asm volatile("" ::: "memory");
}
__device__ __forceinline__ void phase_selwin_naive(const Ctx& C, bf16* OCAT) {
    const bf16* QR = ARP(bf16, A_QROT); const float* GATES = ARP(float, A_GATES); const float* OACC = ARP(float, A_OACC);
    const unsigned long long* SELM = ARP(const unsigned long long, A_SELMASK);
    const bf16* KS = (const bf16*)(C.ws + WS_ARENA + A_KV6 + 2 * KV6_STRIDE); const bf16* VS = (const bf16*)(C.ws + WS_ARENA + A_KV6 + 3 * KV6_STRIDE);
    const bf16* KW = (const bf16*)(C.ws + WS_ARENA + A_KV6 + 4 * KV6_STRIDE); const bf16* VW = (const bf16*)(C.ws + WS_ARENA + A_KV6 + 5 * KV6_STRIDE);
    LAS float* qs = (LAS float*)C.lds + C.wave * 768; LAS float* pt = qs + 512; const int lane = C.lane;
    for (int it = C.gw; it < T * 4; it += C.ngw) { const int t = it >> 2, g = it & 3, b = t >> 12, s = t & 4095; const size_t slab = (size_t)(b * 4 + g) * SPAD * 128;
#pragma unroll
        for (int r = 0; r < 4; ++r) { const bf16* qp = QR + (((size_t)(b * 16 + g * 4 + r)) * SEQ + s) * 128; qs[r * 128 + lane] = bf2f(qp[lane]); qs[r * 128 + 64 + lane] = bf2f(qp[64 + lane]); }
        LDS_WAIT(); asm volatile("" ::: "memory");
        float res[4][2];
#pragma unroll
        for (int r = 0; r < 4; ++r) { res[r][0] = OACC[(size_t)t * DM + (g * 4 + r) * 128 + lane]; res[r][1] = OACC[(size_t)t * DM + (g * 4 + r) * 128 + 64 + lane]; }
        { NaiveAttnState S;
#pragma unroll
          for (int r = 0; r < 4; ++r) { S.m[r] = -1e30f; S.l[r] = 0.f; S.o[r][0] = 0.f; S.o[r][1] = 0.f; }
          const unsigned long long m = SELM[(size_t)t * 4 + g];
          for (int blk = 0; blk <= (s >> 6); ++blk) if ((m >> blk) & 1ull) naive_tile(S, qs, pt, KS + slab, VS + slab, blk * 64, blk * 64 + lane <= s, lane);
#pragma unroll
          for (int r = 0; r < 4; ++r) { const float gt = GATES[(size_t)t * 48 + 16 + g * 4 + r], inv = S.l[r] > 0.f ? 1.f / S.l[r] : 0.f; res[r][0] += gt * S.o[r][0] * inv; res[r][1] += gt * S.o[r][1] * inv; } }
        { NaiveAttnState S;
#pragma unroll
          for (int r = 0; r < 4; ++r) { S.m[r] = -1e30f; S.l[r] = 0.f; S.o[r][0] = 0.f; S.o[r][1] = 0.f; }
          const int lo = s - 511 > 0 ? s - 511 : 0;
          for (int k0 = lo & ~63; k0 <= s; k0 += 64) naive_tile(S, qs, pt, KW + slab, VW + slab, k0, (k0 + lane >= lo) && (k0 + lane <= s), lane);
#pragma unroll
          for (int r = 0; r < 4; ++r) { const float gt = GATES[(size_t)t * 48 + 32 + g * 4 + r], inv = S.l[r] > 0.f ? 1.f / S.l[r] : 0.f; res[r][0] += gt * S.o[r][0] * inv; res[r][1] += gt * S.o[r][1] * inv; } }
#pragma unroll
        for (int r = 0; r < 4; ++r) { bf16* op = OCAT + (size_t)t * DM + (g * 4 + r) * 128; op[lane] = (bf16)f2bf(res[r][0]); op[64 + lane] = (bf16)f2bf(res[r][1]); }
    }
}


__device__ __forceinline__ void phase_cmp_attn_mma(const Ctx& C, bool side_cvt) {
    const bf16 *Q = ARP(bf16, A_Q), *KC = ARP(bf16, A_KCMP), *VCT = ARP(bf16, A_VCT); const float* GATES = ARP(float, A_GATES);
    float* OACC = ARP(float, A_OACC); unsigned long long* SELM = ARP(unsigned long long, A_SELMASK);
    LAS bf16* Qs = (LAS bf16*)C.lds;
    LAS bf16* Ks = Qs + 128 * 136;
    LAS bf16* Pm = (LAS bf16*)C.lds;
    LAS bf16* Vt = Pm + 128 * 264;
    const int w = C.wave; const float scale = 0.08838834764831845f;
    for (int it = C.bid; it < 2048; it += C.G) { int tid = C.tid; asm volatile("" : "+v"(tid)); const int lane = tid & 63;     const int bg = it >> 7, tt = ((it / C.G) & 1) ? 127 - (it & 127) : (it & 127), b = bg >> 2, g = bg & 3, t0 = tt * 32;
        const int nv = t0 / 16 + 1 > 255 ? 255 : ((t0 + 31 >= 31) ? t0 / 16 + 1 : 0);
        const int nct = (nv + 15) >> 4, kmax = ((nv + 31) >> 5) << 5;
        f32x4 cvv[2][8]; MoeTile mt = moe_tile_decode(C, MOE_CVT_BASE_E + (it * 8 + w) * 2); if (side_cvt) moe_pair_load(mt, cvv, lane);
        __syncthreads();
#pragma unroll
        for (int k = 0; k < 4; ++k) { const int idx = tid + 512 * k, row = idx >> 4, c8 = (idx & 15) * 8, r = row >> 5, tl = row & 31;
            *(LAS u32x4*)(Qs + row * 136 + c8) = *(const u32x4*)(Q + (((size_t)(b * 16 + g * 4 + r)) * SEQ + t0 + tl) * 128 + c8); }
        { u32x4 tk[8];
#pragma unroll
          for (int k = 0; k < 8; ++k) { const int idx = tid + 512 * k, row = idx >> 4, c8 = (idx & 15) * 8; tk[k] = (u32x4){0u, 0u, 0u, 0u};
              if (row < nct * 16) tk[k] = *(const u32x4*)(KC + ((size_t)bg * 256 + row) * 128 + c8); }
#pragma unroll
          for (int k = 0; k < 8; ++k) { const int idx = tid + 512 * k, row = idx >> 4, c8 = (idx & 15) * 8; *(LAS u32x4*)(Ks + row * 136 + c8) = tk[k]; } }
        __syncthreads();
        f32x4 sacc[16];
        { bf16x8 qa[4];
#pragma unroll
          for (int k = 0; k < 4; ++k) qa[k] = *(const LAS bf16x8*)(Qs + (w * 16 + (lane & 15)) * 136 + (lane >> 4) * 8 + 32 * k);
#pragma unroll
          for (int ct = 0; ct < 16; ++ct) { sacc[ct] = (f32x4){0.f, 0.f, 0.f, 0.f};
              if (ct < nct) { const LAS bf16* bp = Ks + (ct * 16 + (lane & 15)) * 136 + (lane >> 4) * 8;
#pragma unroll
                  for (int k = 0; k < 4; ++k) sacc[ct] = __builtin_amdgcn_mfma_f32_16x16x32_bf16(*(const LAS bf16x8*)(bp + 32 * k), qa[k], sacc[ct], 0, 0, 0); } } }
        const int trow = t0 + (w & 1) * 16 + (lane & 15);
        const int nvr = (trow >= 31) ? ((trow - 31) >> 4) + 1 : 0;
        float m = -INFINITY;
#pragma unroll
        for (int ct = 0; ct < 16; ++ct)
#pragma unroll
            for (int j = 0; j < 4; ++j) { const int key = ct * 16 + 4 * (lane >> 4) + j; const float v = (key < nvr) ? sacc[ct][j] * scale : -INFINITY; sacc[ct][j] = v; m = fmaxf(m, v); }
        m = fmaxf(m, xor16f(m)); m = fmaxf(m, xor32f(m)); if (!(m > -INFINITY)) m = 0.f;
        float sum = 0.f;
#pragma unroll
        for (int ct = 0; ct < 16; ++ct)
#pragma unroll
            for (int j = 0; j < 4; ++j) { const float e = __expf(sacc[ct][j] - m); sacc[ct][j] = e; sum += e; }
        sum += xor16f(sum); sum += xor32f(sum);
        const float inv = sum > 0.f ? 1.f / sum : 1.f;
        __syncthreads();
#pragma unroll
        for (int ct = 0; ct < 16; ++ct) if (ct * 16 < kmax) { u32x2 pw; pw.x = pk2(sacc[ct][0] * inv, sacc[ct][1] * inv); pw.y = pk2(sacc[ct][2] * inv, sacc[ct][3] * inv);
            *(LAS u32x2*)(Pm + (w * 16 + (lane & 15)) * 264 + ct * 16 + 4 * (lane >> 4)) = pw; }
        { u32x4 tv[8];
#pragma unroll
          for (int k = 0; k < 8; ++k) { const int idx = tid + 512 * k, d = idx >> 5, j8 = (idx & 31) * 8; tv[k] = (u32x4){0u, 0u, 0u, 0u};
              if (j8 < kmax) tv[k] = *(const u32x4*)(VCT + ((size_t)bg * 128 + d) * 256 + j8); }
#pragma unroll
          for (int k = 0; k < 8; ++k) { const int idx = tid + 512 * k, d = idx >> 5, j8 = (idx & 31) * 8; *(LAS u32x4*)(Vt + d * 264 + j8) = tv[k]; } }
        __syncthreads();
        { const int r = w >> 1, tl = (w & 1) * 16 + (lane & 15), t = b * SEQ + t0 + tl, hh = g * 4 + r; const float gt = GATES[(size_t)t * 48 + hh];
          float* op = OACC + (size_t)t * DM + hh * 128 + 4 * (lane >> 4);
          bf16x8 pa[8];
#pragma unroll
          for (int k = 0; k < 8; ++k) { pa[k] = (bf16x8){0, 0, 0, 0, 0, 0, 0, 0}; if (k * 32 < kmax) pa[k] = *(const LAS bf16x8*)(Pm + (w * 16 + (lane & 15)) * 264 + (lane >> 4) * 8 + 32 * k); }
#pragma unroll
          for (int dt = 0; dt < 8; ++dt) { f32x4 o = (f32x4){0.f, 0.f, 0.f, 0.f}; const LAS bf16* bp = Vt + (dt * 16 + (lane & 15)) * 264 + (lane >> 4) * 8;
#pragma unroll
              for (int k = 0; k < 8; ++k) if (k * 32 < kmax) o = __builtin_amdgcn_mfma_f32_16x16x32_bf16(*(const LAS bf16x8*)(bp + 32 * k), pa[k], o, 0, 0, 0);
              *(f32x4*)(op + dt * 16) = o * gt; } }
        { float score[4]; const int cur = (t0 + w * 4) >> 6;
#pragma unroll
          for (int q = 0; q < 4; ++q) { const int tl = w * 4 + q; float imp = 0.f;
            if (kmax > 0) {
#pragma unroll
                for (int r = 0; r < 4; ++r) { const LAS bf16* p = Pm + (r * 32 + tl) * 264; const int j0 = 4 * lane;
                    if (j0 < kmax) { const u32x2 pw = *(const LAS u32x2*)(p + j0); imp += lo_bf(pw.x) + hi_bf(pw.x) + lo_bf(pw.y) + 0.5f * hi_bf(pw.y); if (j0 > 0) imp += 0.5f * bf2f(p[j0 - 1]); } } }
            if (lane == 0 || lane == cur || lane == cur - 1) score[q] = INFINITY; else score[q] = (lane <= cur) ? imp : -INFINITY; }
          int rank[4] = {0, 0, 0, 0};
          for (int o2 = 0; o2 <= cur; ++o2) {
#pragma unroll
              for (int q = 0; q < 4; ++q) { const float so = __int_as_float(__builtin_amdgcn_readlane(__float_as_int(score[q]), o2)); rank[q] += (so > score[q] || (so == score[q] && o2 < lane)) ? 1 : 0; } }
#pragma unroll
          for (int q = 0; q < 4; ++q) { const unsigned long long mk = __ballot(rank[q] < 16 && score[q] > -INFINITY);
              if (lane == 0) SELM[(size_t)(b * SEQ + t0 + w * 4 + q) * 4 + g] = mk; } }
        if (side_cvt) moe_pair_store(mt, cvv, lane);
    }
    __syncthreads();
}

namespace swa {
constexpr int D = 128, NW = 8, QBLK = 32, KVBLK = 64, QB = NW * QBLK;
constexpr int SHM_V = KVBLK * D * 2, SHM_K = KVBLK * D * 2;
constexpr int LDS_BYTES = 2 * SHM_V + 2 * SHM_K + NW * 64 * 4;
constexpr float SCALE = 0.08838834764831845f, THR = 8.f;
typedef short s16x4 __attribute__((ext_vector_type(4)));
typedef float f32x16 __attribute__((ext_vector_type(16)));
#define KSWZ(row, colB) ((row) * 256 + ((colB) ^ (((row) & 7) << 4)))
#define SBAR() __builtin_amdgcn_sched_barrier(0)
__device__ __forceinline__ int v_st(int k, int c) { const int kk = (k & ~0xC) | ((k & 4) << 1) | ((k & 8) >> 1); return ((kk >> 3) * 4 + (c >> 5)) * 512 + ((kk & 7) * 32 + (c & 31)) * 2; }
__device__ __forceinline__ int v_rd_base(int lane) { return ((lane & 3) << 3) | (((lane >> 2) & 3) << 6) | (((lane >> 4) & 1) << 5) | (((lane >> 5) & 1) << 8); }
constexpr int v_rd_off(int d0, int ks, int half) { return d0 * 512 + ks * 4096 + half * 2048; }
__device__ __forceinline__ int crow(int r, int hi) { return (r & 3) + 8 * (r >> 2) + 4 * hi; }
__device__ __forceinline__ unsigned cvtpk(float lo, float hi) { unsigned r; asm volatile("v_cvt_pk_bf16_f32 %0, %1, %2" : "=v"(r) : "v"(lo), "v"(hi)); return r; }
__device__ __forceinline__ bf16x8 load8(const bf16* p) { return *reinterpret_cast<const bf16x8*>(p); }
__device__ __forceinline__ void mask_tile(f32x16& p0, f32x16& p1, int dq, unsigned W) {
    const float NEG = -__builtin_inff();
    asm volatile("" : "+v"(dq));
#pragma unroll
    for (int r = 0; r < 16; ++r) { const int c = (r & 3) + 8 * (r >> 2);
        if ((unsigned)(dq - c) >= W) p0[r] = NEG;
        if ((unsigned)(dq - c - 32) >= W) p1[r] = NEG; }
}
__device__ __forceinline__ void mask_all(f32x16& p0, f32x16& p1, bool on) {
    const float NEG = -__builtin_inff();
#pragma unroll
    for (int r = 0; r < 16; ++r) { p0[r] = on ? p0[r] : NEG; p1[r] = on ? p1[r] : NEG; }
}
__device__ __forceinline__ void partialSM(f32x16& p0, f32x16& p1, float& m_reg, float& mn, float& alpha) {
    float pmax = p0[0]; for (int r = 1; r < 16; ++r) pmax = fmaxf(pmax, p0[r]); for (int r = 0; r < 16; ++r) pmax = fmaxf(pmax, p1[r]);
    { auto rr = __builtin_amdgcn_permlane32_swap(__float_as_uint(pmax), __float_as_uint(pmax), false, false);
      pmax = fmaxf(__uint_as_float(rr[0]), __uint_as_float(rr[1])); }
    constexpr float C2 = 1.4426950408889634f * SCALE;
    if (__builtin_expect(__all((pmax - m_reg) * SCALE <= THR), 1)) { mn = m_reg; alpha = 1.f; }
    else { mn = fmaxf(m_reg, pmax); alpha = __builtin_amdgcn_exp2f((m_reg - mn) * C2); m_reg = mn; }
    const float mnL = -mn * C2;
    for (int r = 0; r < 16; ++r) p0[r] = fmaf(p0[r], C2, mnL); for (int r = 0; r < 16; ++r) p1[r] = fmaf(p1[r], C2, mnL);
    for (int r = 0; r < 16; ++r) p0[r] = __builtin_amdgcn_exp2f(p0[r]);
}
__device__ __forceinline__ void finishSM(f32x16& p0, f32x16& p1, float alpha, float& l_reg, bf16x8& pa0, bf16x8& pa1, bf16x8& pa2, bf16x8& pa3) {
    for (int r = 0; r < 16; ++r) p1[r] = __builtin_amdgcn_exp2f(p1[r]);
    float ps = 0; for (int r = 0; r < 16; ++r) ps += p0[r]; for (int r = 0; r < 16; ++r) ps += p1[r];
    { auto rr = __builtin_amdgcn_permlane32_swap(__float_as_uint(ps), __float_as_uint(ps), false, false);
      ps = __uint_as_float(rr[0]) + __uint_as_float(rr[1]); }
    l_reg = l_reg * alpha + ps;
#define PK4(P, B_, OUT) do { unsigned a0 = cvtpk(P[B_+0], P[B_+1]), a1 = cvtpk(P[B_+2], P[B_+3]);                          \
        unsigned b0 = cvtpk(P[B_+4], P[B_+5]), b1 = cvtpk(P[B_+6], P[B_+7]);                                             \
        auto r0 = __builtin_amdgcn_permlane32_swap(a0, b0, false, false); auto r1 = __builtin_amdgcn_permlane32_swap(a1, b1, false, false); \
        u32x4 w = {r0[0], r1[0], r0[1], r1[1]}; OUT = *reinterpret_cast<bf16x8*>(&w); } while (0)
    PK4(p0, 0, pa0); PK4(p0, 8, pa1); PK4(p1, 0, pa2); PK4(p1, 8, pa3);
#undef PK4
}
template <int KB>
__device__ __forceinline__ void qkt(f32x16& p0, f32x16& p1, const char* K_lds, int r32, int hi, const bf16x8* qr) {
    p0 = f32x16{}; p1 = f32x16{};
    const char* kb[4];
#pragma unroll
    for (int dd = 0; dd < 4; ++dd) kb[dd] = K_lds + KB * SHM_K + KSWZ(r32, (dd * 16 + hi * 8) * 2);
#pragma unroll
    for (int d0 = 0; d0 < 8; ++d0) { const char* a = kb[d0 & 3] + (d0 >> 2) * 128;
        bf16x8 b0 = *reinterpret_cast<const bf16x8*>(a);
        bf16x8 b1 = *reinterpret_cast<const bf16x8*>(a + 32 * 256);
        p0 = __builtin_amdgcn_mfma_f32_32x32x16_bf16(b0, qr[d0], p0, 0, 0, 0);
        p1 = __builtin_amdgcn_mfma_f32_32x32x16_bf16(b1, qr[d0], p1, 0, 0, 0); }
}
template <int VB>
__device__ __forceinline__ void pv_tile(f32x16* o, int vb0, bf16x8 pa0, bf16x8 pa1, bf16x8 pa2, bf16x8 pa3) {
#define TRRD(dst, off) asm volatile("ds_read_b64_tr_b16 %0, %1 offset:%2" : "=&v"(dst) : "v"(vb0), "i"(off) : "memory")
#define PV_D0(d0) do { s16x4 l0, l1, l2, l3, h0, h1, h2, h3; constexpr int b_ = VB * SHM_V + v_rd_off(d0, 0, 0);   \
        TRRD(l0, b_); TRRD(h0, b_ + 2048); TRRD(l1, b_ + 4096); TRRD(h1, b_ + 6144); TRRD(l2, b_ + 8192); TRRD(h2, b_ + 10240); TRRD(l3, b_ + 12288); TRRD(h3, b_ + 14336); \
        asm volatile("s_waitcnt lgkmcnt(0)" ::: "memory"); SBAR();   \
        o[d0] = __builtin_amdgcn_mfma_f32_32x32x16_bf16(pa0, (bf16x8){l0[0], l0[1], l0[2], l0[3], h0[0], h0[1], h0[2], h0[3]}, o[d0], 0, 0, 0);   \
        o[d0] = __builtin_amdgcn_mfma_f32_32x32x16_bf16(pa1, (bf16x8){l1[0], l1[1], l1[2], l1[3], h1[0], h1[1], h1[2], h1[3]}, o[d0], 0, 0, 0);   \
        o[d0] = __builtin_amdgcn_mfma_f32_32x32x16_bf16(pa2, (bf16x8){l2[0], l2[1], l2[2], l2[3], h2[0], h2[1], h2[2], h2[3]}, o[d0], 0, 0, 0);   \
        o[d0] = __builtin_amdgcn_mfma_f32_32x32x16_bf16(pa3, (bf16x8){l3[0], l3[1], l3[2], l3[3], h3[0], h3[1], h3[2], h3[3]}, o[d0], 0, 0, 0); } while (0)
    PV_D0(0); PV_D0(1); PV_D0(2); PV_D0(3);
#undef PV_D0
#undef TRRD
}
struct BlockRef { const bf16* Q; const bf16* K; const bf16* V; int P0, tok0, hh; };
struct Seam { bf16x8 qr[8]; bf16x8 st_v0, st_v1, st_k0, st_k1; };
__device__ __forceinline__ int swa_jlo(int P0, int W) { const int lowk = P0 - W + 1; return lowk > 0 ? lowk / KVBLK : 0; }
#define ROW(p, k0, rr) ((p) + (size_t)((k0) + (rr)) * D + sc)
#define VMW() asm volatile("s_waitcnt vmcnt(0)" ::: "memory")
#define VMWN(n) asm volatile("s_waitcnt vmcnt(%0)" :: "i"(n) : "memory")
#define SLOAD_H(Kp, Vp, k0) do { S.st_v0 = load8(ROW(Vp, k0, sr)); S.st_v1 = load8(ROW(Vp, k0, 32 + sr));              \
                         S.st_k0 = load8(ROW(Kp, k0, sr)); S.st_k1 = load8(ROW(Kp, k0, 32 + sr)); } while (0)
#define SWRITE_HK(bf) do { *(bf16x8*)(K_lds + (bf) * SHM_K + kws) = S.st_k0; *(bf16x8*)(K_lds + (bf) * SHM_K + kws + 32 * 256) = S.st_k1; } while (0)
#define SWRITE_HV(bf) do { *(bf16x8*)(V_lds + (bf) * SHM_V + vst0) = S.st_v0; *(bf16x8*)(V_lds + (bf) * SHM_V + vst1) = S.st_v1; } while (0)
#define SWRITE_H(bf) do { SWRITE_HV(bf); SWRITE_HK(bf); } while (0)
__device__ __forceinline__ int lane_id() { return (int)__builtin_amdgcn_mbcnt_hi(~0u, __builtin_amdgcn_mbcnt_lo(~0u, 0u)); }
__device__ __forceinline__ void prime(const BlockRef& cur, int W, char* lds, Seam& S, int wid) {
    (void)wid; const int tid = threadIdx.x, lane = tid & 63, r32 = lane & 31, hi = lane >> 5;
    const int sr = tid >> 4, sc = (tid & 15) * 8, kws = KSWZ(sr, sc * 2); char* K_lds = lds + 2 * SHM_V;
    const int kb0 = swa_jlo(cur.P0, W) * KVBLK;
    for (int d0 = 0; d0 < 8; ++d0) S.qr[d0] = load8(cur.Q + (size_t)(wid * QBLK + r32) * D + d0 * 16 + hi * 8);
    SLOAD_H(cur.K, cur.V, kb0); VMW(); SWRITE_HK(0);
    __syncthreads();
}
template <bool SEL, int MODE>
__device__ __forceinline__ void block(const BlockRef& cur, const BlockRef& nxt, int skv, int W, char* lds, Seam& S,
                                      const unsigned long long* SELM, const float* GATES, int gate_off, float* OACC, bf16* OCAT, int wid) {
    (void)wid; const int tid = threadIdx.x, lane = tid & 63, r32 = lane & 31, hi = lane >> 5;
    const int j_lo = swa_jlo(cur.P0, W);
    int j_hi = (cur.P0 + QB - 1) / KVBLK + 1; if (j_hi > skv / KVBLK) j_hi = skv / KVBLK;
    const int NT = j_hi - j_lo;
    const int kbn = swa_jlo(nxt.P0, W) * KVBLK;
    const int qlo = cur.P0 + wid * QBLK, qm = qlo + r32 - 4 * hi;
    char* V_lds = lds; char* K_lds = lds + 2 * SHM_V;
    float* ws = (float*)(lds + 2 * SHM_V + 2 * SHM_K) + wid * 64; float* li_l = ws, * al_l = ws + 32;
    float m_reg = -1e30f, l_reg = 0; f32x16 o[4] = {};
    const int sr = tid >> 4, sc = (tid & 15) * 8, vst0 = v_st(sr, sc), vst1 = vst0 + 8192  , kws = KSWZ(sr, sc * 2);
    const int vb0 = (int)(uintptr_t)V_lds + v_rd_base(lane);
    const bf16* Kh = cur.K; const bf16* Vh = cur.V;
    unsigned long long* selt = (unsigned long long*)(lds + LDS_BYTES) + wid * 32;
    if (SEL) { if (hi == 0) selt[r32] = SELM[(size_t)(cur.tok0 + wid * QBLK + r32) * 4 + (cur.hh >> 2)]; }
#define RESC(a) do { if (__any((a) < 1.f)) { if (hi == 0) al_l[r32] = (a); asm volatile("s_waitcnt lgkmcnt(0)" ::: "memory");              \
                     for (int d_ = 0; d_ < 4; ++d_) for (int r = 0; r < 16; ++r) o[d_][r] *= al_l[crow(r, hi)]; } } while (0)
#define KBASE(t) ((j_lo + (t)) * KVBLK)
#define MASKT(P0_, P1_, t) do { const int kb_ = KBASE(t); if (kb_ + KVBLK - 1 > qlo || kb_ <= qlo + QBLK - 1 - W) mask_tile(P0_, P1_, qm - kb_, (unsigned)W); \
                                if (SEL) { const unsigned long long sm_ = selt[r32]; mask_all(P0_, P1_, ((sm_ >> (j_lo + (t))) & 1ull) != 0ull); } } while (0)
    constexpr int NQL = 8;
#define SEAM_K0() do { VMWN(NQL); SWRITE_HK(0); SBAR(); } while (0)
    f32x16 pA0, pA1, pB0, pB1; float mnA, mnB, alA, alB; bf16x8 pa0, pa1, pa2, pa3;
    SWRITE_HV(0); SBAR();
    if (NT > 1) { SLOAD_H(Kh, Vh, KBASE(1)); }
    SBAR(); qkt<0>(pA0, pA1, K_lds, r32, hi, S.qr);
    MASKT(pA0, pA1, 0); partialSM(pA0, pA1, m_reg, mnA, alA);
    if (NT > 1) { VMW(); SWRITE_H(1); }
    __syncthreads();
#define HALF_STEP(PX0, PX1, mnX, alX, PY0, PY1, alY, t, KB, VB, SB) do {                                                      \
        SBAR(); qkt<KB>(PX0, PX1, K_lds, r32, hi, S.qr);                                             \
        finishSM(PY0, PY1, alY, l_reg, pa0, pa1, pa2, pa3); SBAR();                                                           \
        if ((t) + 1 < NT) { SLOAD_H(Kh, Vh, KBASE((t) + 1)); SBAR(); }                                               \
        pv_tile<VB>(o, vb0, pa0, pa1, pa2, pa3); MASKT(PX0, PX1, (t)); partialSM(PX0, PX1, m_reg, mnX, alX);                                        \
        __syncthreads();                                                                                                      \
        if ((t) + 1 < NT) { VMW(); SWRITE_H(SB); }                                                                          \
        RESC(alX); __syncthreads(); } while (0)
    for (int t = 1; t + 1 < NT; t += 2) {
        HALF_STEP(pB0, pB1, mnB, alB, pA0, pA1, alA, t, 1, 0, 0);
        HALF_STEP(pA0, pA1, mnA, alA, pB0, pB1, alB, t + 1, 0, 1, 1);
    }
    const bool even = (NT & 1) == 0;
    if (even) { SBAR(); qkt<1>(pB0, pB1, K_lds, r32, hi, S.qr); SBAR(); }
    SLOAD_H(nxt.K, nxt.V, kbn); SBAR();
#pragma unroll
    for (int d0 = 0; d0 < 8; ++d0) S.qr[d0] = load8(nxt.Q + (size_t)(wid * QBLK + r32) * D + d0 * 16 + hi * 8);
    SBAR();
    finishSM(pA0, pA1, alA, l_reg, pa0, pa1, pa2, pa3); SBAR();
    pv_tile<0>(o, vb0, pa0, pa1, pa2, pa3);
    if (even) { MASKT(pB0, pB1, NT - 1); partialSM(pB0, pB1, m_reg, mnB, alB); __syncthreads(); RESC(alB);
        finishSM(pB0, pB1, alB, l_reg, pa0, pa1, pa2, pa3); SBAR(); pv_tile<1>(o, vb0, pa0, pa1, pa2, pa3); }
    SBAR(); SEAM_K0();
    if (hi == 0) li_l[r32] = l_reg; asm volatile("s_waitcnt lgkmcnt(0)" ::: "memory");
    { const int le = lane_id(), r32e = le & 31, hie = le >> 5;
      const int tokw = cur.tok0 + wid * QBLK; const float* gp = GATES + (size_t)tokw * 48 + gate_off + cur.hh;
      float* op = OACC + (size_t)tokw * DM + cur.hh * 128; bf16* cp = OCAT + (size_t)tokw * DM + cur.hh * 128;
#pragma unroll
      for (int r = 0; r < 16; ++r) { const int orow = crow(r, hie);
        const float sc_ = gp[orow * 48] * __builtin_amdgcn_rcpf(li_l[orow]);
        const unsigned ob = (unsigned)(orow * DM + r32e);
#pragma unroll
        for (int d0 = 0; d0 < 4; ++d0) { const float v = op[ob + d0 * 32] + o[d0][r] * sc_;
            if (MODE == 0) ((unsigned*)op)[ob + d0 * 32] = __float_as_uint(v);
            else cp[ob + d0 * 32] = (bf16)(cvtpk(v, v) & 0xffffu); } } }
    __syncthreads();
#undef RESC
#undef KBASE
#undef MASKT
#undef SEAM_K0
#undef HALF_STEP
}
#undef ROW
#undef VMW
#undef VMWN
#undef SLOAD_H
#undef SWRITE_HK
#undef SWRITE_HV
#undef SWRITE_H
__device__ __forceinline__ int swa_nramp(int nqb, int W) { const int t = W - 1; const int n = t < 0 ? 0 : t / QB + 1; return n > nqb ? nqb : n; }
struct SwaItem { int bh, qb0, qb1; };
__device__ __forceinline__ SwaItem swa_decode(int L, int nqb, int nx, int nramp) {
    SwaItem it; it.bh = L / nx; const int x = L - it.bh * nx; const int ns = nqb - nramp;
    if (x < ns) { it.qb0 = it.qb1 = nqb - 1 - x; } else { it.qb0 = x - ns; it.qb1 = nramp - 1 - it.qb0; }
    return it;
}
template <bool SEL, int MODE>
__device__ __forceinline__ void phase(int wid, char* lds, const bf16* Q, const bf16* K, const bf16* V, int W, const unsigned long long* SELM, const float* GATES, int gate_off, float* OACC, bf16* OCAT) {
    constexpr int nqb = SEQ / QB;
    const int nramp = swa_nramp(nqb, W), nx = (nramp + 1) / 2 + (nqb - nramp), total = nx * BATCH * 16, stride = gridDim.x;
    int L = blockIdx.x; if (L >= total) return;
    auto mkref = [&](const SwaItem& it, int pass) { const int qb = pass ? it.qb1 : it.qb0, b = it.bh >> 4, hh = it.bh & 15; BlockRef r;
        r.Q = Q + ((size_t)it.bh * SEQ + (size_t)qb * QB) * D; r.K = K + (size_t)(b * 4 + (hh >> 2)) * SPAD * D; r.V = V + (size_t)(b * 4 + (hh >> 2)) * SPAD * D;
        r.P0 = qb * QB; r.tok0 = b * SEQ + qb * QB; r.hh = hh; return r; };
    SwaItem it = swa_decode(L, nqb, nx, nramp); int pass = 0;
    BlockRef cur = mkref(it, 0);
    Seam S;
    __syncthreads();
    prime(cur, W, lds, S, wid);
    for (;;) {
        const bool more_pass = pass == 0 && it.qb1 != it.qb0, more_item = L + stride < total, last = !more_pass && !more_item;
        SwaItem itn = it; int passn = pass + 1, Ln = L;
        if (!more_pass) { passn = 0; Ln = more_item ? L + stride : L; itn = swa_decode(Ln, nqb, nx, nramp); }
        const BlockRef nxt = last ? cur : mkref(itn, passn);
        block<SEL, MODE>(cur, nxt, SEQ, W, lds, S, SELM, GATES, gate_off, OACC, OCAT, wid);
        if (last) break;
        cur = nxt; it = itn; pass = passn; L = Ln;
    }
}
#undef KSWZ
#undef SBAR
}

#ifndef REPEAT_PHASE
#define REPEAT_PHASE -1
#endif
#ifndef PROBE_LO
#define PROBE_LO 22
#define PROBE_HI 22
#define PROBE_SCALE 0.1f
#endif
#ifndef PROBE
#define PROBE 0
#endif
__device__ __forceinline__ void probe_compare(const Ctx& C, const bf16* Xa, const bf16* Xb, size_t n) {
    float se = 0.f, sr = 0.f;
    for (size_t i = (size_t)C.bid * NTHR + C.tid; i < n; i += (size_t)C.G * NTHR) { const float a = bf2f(Xa[i]), b = bf2f(Xb[i]); se += (a - b) * (a - b); sr += b * b; }
    se = wave_sum(se); sr = wave_sum(sr);
    if (C.lane == 0) { atomicAdd(WSP(float, WS_CTL) + CW_PROBE, se); atomicAdd(WSP(float, WS_CTL) + CW_PROBE + 1, sr); }
}
#ifndef MK_SPLIT
#define MK_SPLIT 0
#endif
constexpr int N_PHASES = 39;
#define COMMON_PHASES(l, pb) \
      \
      \
    if (IN(pb + 1)) { FRESH_TID(); pg8::Gemm g{WSP(bf16, WS_XR), WSP(bf16, WS_WKT) + (size_t)l * 4 * 1024 * DM, DM, DM, DM}; \
                      CrossOrder S{4, G, c, 1024, (long long)256 * DM * 2, (long long)256 * DM * 2, (long long)1024 * DM * 2}; EpiSoftmaxP E{ARP(bf16, A_PC), 1024, WSP(float, WS_RSQ) + (size_t)(2 * l) * T * 8, (LAS float*)(C.lds + LDS_AUX)}; pg8::gemm_phase(L, g, S, E, C.tid); } SEAM(pb + 1); \
      \
    if (IN(pb + 3)) { FRESH_TID(); pg8::Gemm g{ARP(bf16, A_PC), WSP(bf16, WS_VWT) + (size_t)l * 4 * DM * 1024, 1024, 1024, 1024}; \
                      CrossOrder S{8, G, c, DM, (long long)256 * 1024 * 2, (long long)256 * 1024 * 2, (long long)DM * 1024 * 2}; EpiResidT<false> E{WSP(bf16, WS_XR), WSP(bf16, WS_XR), DM, WSP(float, WS_RSQ) + (size_t)(2 * l + 1) * T * 8, (LAS float*)(C.lds + LDS_AUX)}; pg8::gemm_phase(L, g, S, E, C.tid); } SEAM(pb + 3); \
      \
      \
    if (IN(pb + 5)) { FRESH_TID(); pg8::Gemm g{WSP(bf16, WS_XR), WSP(bf16, WS_W_ROUTER) + (size_t)l * 256 * DM, DM, DM, 512}; RouterOrder S{G, c}; EpiStoreF32Rows E{ARP(float, A_XS), 256, WSP(float, WS_RSQ) + (size_t)(2 * l + 1) * T * 8};     pg8::gemm_phase(L, g, S, E, C.tid); } SEAM(pb + 5); \
    if (IN(pb + 6)) { FRESH_TID(); phase_route(C, A, l); } SEAM(pb + 6); \
    if (IN(pb + 7)) { FRESH_TID(); phase_gather(C, l); } SEAM(pb + 7); \
    if (IN(pb + 8)) { FRESH_TID(); const bool side_ = (l == 0) && (G == 256) && MOE_CVT_SIDE_H > 0; const int Gm_ = side_ ? G - MOE_CVT_WG : G; \
                      if (side_ && c >= Gm_) moe_convert_items_x2(C, MOE_CVT_BASE_H, MOE_CVT_BASE_H + MOE_CVT_SIDE_H, (c - Gm_) * NWAVES + C.wave, MOE_CVT_WG * NWAVES); else { \
                      LAS int* tab = (LAS int*)(C.lds + LDS_AUX); moe_build_table(C, ctl + CW_MOE_CNT + l * 64, tab); \
                      pg8::Gemm g{WSP(bf16, WS_XR), WSP(bf16, WS_W_GU) + (size_t)l * NEXP * 1024 * DM, DM, DM, DM}; MoeOrder S{tab, 4, Gm_, c, 0}; EpiHid E{ARP(bf16, A_HID), ARP(int, A_ROWSLOT), WSP(float, WS_RSQ) + (size_t)(2 * l + 1) * T * 8}; \
                      LAS int* rc = tab + 256; { pg8::Unit u_; const int* rs_ = ARP(int, A_ROWSLOT); for (int i_ = 0; i_ < 12 && S.next(i_, u_); ++i_) if (C.tid < 256) rc[i_ * 256 + C.tid] = (C.tid < u_.pm) ? (rs_[u_.aux + C.tid] >> 1) : 0; } __syncthreads(); \
                      pg8::gemm_phase<EpiHid, MoeOrder, true>(L, g, S, E, C.tid, rc); } } SEAM(pb + 8); \
    if (IN(pb + 9)) { FRESH_TID(); const bool side_ = (l == 0) && (G == 256) && MOE_CVT_SIDE_H2 > 0; const int Gm_ = side_ ? G - MOE_CVT_WG : G; \
                      if (side_ && c >= Gm_) moe_convert_items_x2(C, MOE_CVT_BASE_H2, MOE_CVT_BASE_H2 + MOE_CVT_SIDE_H2, (c - Gm_) * NWAVES + C.wave, MOE_CVT_WG * NWAVES); else { \
                      LAS int* tab = (LAS int*)(C.lds + LDS_AUX); moe_build_table(C, ctl + CW_MOE_CNT + l * 64, tab); \
                      pg8::Gemm g{ARP(bf16, A_HID), WSP(bf16, WS_W_DN) + (size_t)l * NEXP * DM * FF, FF, FF, FF}; MoeOrder S{tab, 8, Gm_, c, 1}; EpiMoeDown E{ARP(int, A_ROWSLOT), ARP(float, A_WTS), ARP(bf16, A_YE)}; pg8::gemm_phase(L, g, S, E, C.tid); } } SEAM(pb + 9); \
    if (IN(pb + 10)) { FRESH_TID(); if (l == 0) phase_combine_norm(C, nullptr, nullptr); else phase_combine_norm(C, INP(I_NORM_FINAL), ((float*)INP(N_INPUTS))); } \
    if (l == 0) SEAM(pb + 10);

__global__ void __launch_bounds__(NTHR, 2) mk_fwd(Args args) {
    extern __shared__ __attribute__((aligned(16))) unsigned char lds_raw[];
    Ctx C; C.lds = (LAS unsigned char*)lds_raw; C.tid = threadIdx.x; C.lane = C.tid & 63; C.wave = __builtin_amdgcn_readfirstlane(C.tid >> 6);
    C.G = gridDim.x; C.bid = blockIdx.x; C.gw = C.bid * NWAVES + C.wave; C.ngw = C.G * NWAVES; C.ws = args.ws;
    const Args& A = args; (void)A;
    volatile LAS unsigned* MISC = (volatile LAS unsigned*)(C.lds + LDS_MISC);
    if (C.tid < 64) MISC[C.tid] = 0u;
    if (C.tid <= N_INPUTS) ((LAS unsigned long long*)(C.lds + LDS_PTAB))[C.tid] = (C.tid < N_INPUTS) ? (unsigned long long)args.in[C.tid < N_INPUTS ? C.tid : 0] : (unsigned long long)args.out;
    __syncthreads();
    unsigned* ctl = WSP(unsigned, WS_CTL);
    const int lo = args.ph_lo, hi = args.ph_hi;
    XcdBarrier bar; bar.bar = ctl + CW_BAR; bar.x = 0; bar.st = MISC + 8;
    if (hi - lo > 1) bar = xcd_barrier_post(ctl + CW_BAR, MISC + 8);
#ifndef ONLY_PHASE
#define ONLY_PHASE -1
#endif
#define FRESH_TID() do { int t_ = threadIdx.x; asm volatile("" : "+v"(t_)); C.tid = t_; C.lane = t_ & 63; } while (0)
#define IN(k) ((ONLY_PHASE < 0 || ONLY_PHASE == (k)) && lo <= (k) && (k) < hi)
#if PROBE == 2
    unsigned long long tA_ = 0, tB_ = 0;
    if (PROBE_LO == 0) tA_ = __builtin_amdgcn_s_memrealtime();
#define SEAM(k) do { if (IN(k) && IN((k) + 1)) xcd_barrier(bar); if ((k) == PROBE_LO - 1) tA_ = __builtin_amdgcn_s_memrealtime(); if ((k) == PROBE_HI) tB_ = __builtin_amdgcn_s_memrealtime(); } while (0)
#else
#define SEAM(k) do { if (IN(k) && IN((k) + 1)) xcd_barrier(bar); } while (0)
#endif
    LAS unsigned char* L = C.lds;
    const int c = C.bid, G = C.G;

    if (IN(0)) { FRESH_TID(); for (int rep = 0; rep < (REPEAT_PHASE == 0 ? 2 : 1); ++rep) phase_prologue(C, A); } SEAM(0);
    if (IN(3)) { FRESH_TID(); const bool side = (G == 256) && MOE_CVT_SIDE_A > 0; const int Gg = side ? G - MOE_CVT_WG : G;
                 if (c < Gg) { pg8::Gemm g{(const bf16*)C.ws, (const bf16*)C.ws, DM, DM, DM}; AbInMemOrder S; S.d.init(T, AB_PAD, DM, DM, AB_PAD, Gg, c); S.m = MemProjOrder{Gg, c};
                               EpiAbInMem E{EpiAbIn{ARP(bf16, A_PAB), ARP(float, A_GF32)}, EpiStoreBf16{WSP(bf16, WS_KP), DM, 1.f}}; pg8::gemm_phase(L, g, S, E, C.tid); }
                 else moe_convert_items(C, MOE_CVT_TOTAL - MOE_CVT_SIDE_A - MOE_CVT_SIDE_B, MOE_CVT_TOTAL - MOE_CVT_SIDE_B, (c - Gg) * NWAVES + C.wave, MOE_CVT_WG * NWAVES); } SEAM(3);
    if (IN(4)) { FRESH_TID(); phase_mixer_prep(C, A); } SEAM(4);
    if (IN(5)) { FRESH_TID(); if (C.bid < 16 && C.wave == 0) ml_gate_scan(C, C.bid);
                 pg8::Gemm g{ARP(bf16, A_LIN), WSP(bf16, WS_W_LORA), 256, 256, 256}; pg8::DenseOrder S; S.init(T, 3072, 256, 256, 3072, G, c);
                 EpiLora E{INP(I_RW_W0), INP(I_RW_A0), INP(I_RW_K_A), ARP(bf16, A_KK), ARP(bf16, A_KR), ARP(float, A_WD), ARP(bf16, A_BV), ARP(bf16, A_KP), ARP(bf16, A_GG)}; pg8::gemm_phase(L, g, S, E, C.tid);
                 { pg8::Gemm g2{WSP(bf16, WS_KP), WSP(bf16, WS_W_CAQ), DM, DM, 512}; WktOrder S2{G, c}; EpiStoreBf16 E2{WSP(bf16, WS_WKT), DM, 0.04419417382415922f}; pg8::gemm_phase(L, g2, S2, E2, C.tid); }
                 { pg8::Gemm g3{WSP(bf16, WS_W_CAO), WSP(bf16, WS_VP), DM, DM, 512}; VwtOrder S3{G, c}; EpiStoreBf16 E3{WSP(bf16, WS_VWT), 1024, 1.f}; pg8::gemm_phase(L, g3, S3, E3, C.tid); } } SEAM(5);
    if (IN(6)) { FRESH_TID(); rwkv_prep_units(C, G == 256); for (int it = C.bid; it < 1024; it += G) ml_intra_unit(C, it, G == 256); } SEAM(6);
    if (IN(7)) { FRESH_TID(); for (int it = C.bid; it < 256; it += G) rwkv_scan_slice(C, it); ml_state_scan(C, 0, G); } SEAM(7);
    if (IN(8)) { FRESH_TID(); for (int it = C.bid; it < 1024; it += G) ml_out_unit(C, it, (G == 256) && MOE_CVT_SIDE_G > 0); rwkv_out_items(C); } SEAM(8);
    if (IN(9)) { FRESH_TID(); pg8::Gemm g{ARP(bf16, A_YCAT), WSP(bf16, WS_W_ABOUT), DM, DM, DM}; pg8::DenseOrder S; S.init(T, DM, DM, DM, DM, G, c); EpiResidT<true> E{INP(I_X), WSP(bf16, WS_XR), DM, WSP(float, WS_RSQ), (LAS float*)(C.lds + LDS_AUX)}; pg8::gemm_phase(L, g, S, E, C.tid); } SEAM(9);
    COMMON_PHASES(0, 10)
    if (IN(21)) { FRESH_TID(); const bool side = (G == 256); const int Gg = side ? G - MOE_CVT_WG : G;
                  if (c >= Gg) moe_convert_items_x2(C, MOE_CVT_TOTAL - MOE_CVT_SIDE_B, MOE_CVT_TOTAL, (c - Gg) * NWAVES + C.wave, MOE_CVT_WG * NWAVES); else {
                  pg8::Gemm g{WSP(bf16, WS_XR), WSP(bf16, WS_W_NSAIN), DM, DM, DM}; pg8::DenseOrder S; S.init(T, NSA_PAD, DM, DM, NSA_PAD, Gg, c);
                  EpiNsaIn E{ARP(bf16, A_Q), ARP(bf16, A_QROT), ARP(bf16, A_KV6), ARP(float, A_GATES), INP(I_NSA_GATE_B), WSP(float, WS_TAB + TAB_ROPE_COS), WSP(float, WS_TAB + TAB_ROPE_SIN), WSP(float, WS_RSQ) + (size_t)4 * T * 8}; pg8::gemm_phase(L, g, S, E, C.tid); } } SEAM(21);
    if (IN(22)) { FRESH_TID(); pg8::Gemm g{ARP(bf16, A_KV6), WSP(bf16, WS_W_CMP1), 2048, 4096, 512}; CmpOrder S{G, c}; EpiStoreF32 E{ARP(float, A_CPART), 256}; pg8::gemm_phase(L, g, S, E, C.tid); } SEAM(22);
    if (IN(23)) { FRESH_TID(); phase_cmp_finish(C, A); } SEAM(23);
    if (IN(24)) { FRESH_TID(); for (int rep = 0; rep < (REPEAT_PHASE == 24 ? 2 : 1); ++rep) phase_cmp_attn_mma(C, G == 256); } SEAM(24);
#if PROBE == 1
    if (IN(25)) { FRESH_TID(); phase_selwin_naive(C, ARP(bf16, A_OCATREF)); xcd_barrier(bar); }
#endif
    if (IN(25)) { FRESH_TID(); swa::phase<true, 0>(C.wave, (char*)lds_raw, ARP(bf16, A_QROT), (const bf16*)(C.ws + WS_ARENA + A_KV6 + 2 * KV6_STRIDE), (const bf16*)(C.ws + WS_ARENA + A_KV6 + 3 * KV6_STRIDE), SEQ,
                                      ARP(const unsigned long long, A_SELMASK), ARP(float, A_GATES), 16, ARP(float, A_OACC), ARP(bf16, A_OCAT)); } SEAM(25);
    if (IN(26)) { FRESH_TID(); swa::phase<false, 1>(C.wave, (char*)lds_raw, ARP(bf16, A_QROT), (const bf16*)(C.ws + WS_ARENA + A_KV6 + 4 * KV6_STRIDE), (const bf16*)(C.ws + WS_ARENA + A_KV6 + 5 * KV6_STRIDE), 512,
                                       ARP(const unsigned long long, A_SELMASK), ARP(float, A_GATES), 32, ARP(float, A_OACC), ARP(bf16, A_OCAT)); } SEAM(26);
#if PROBE == 1
    if (IN(26)) { FRESH_TID(); probe_compare(C, ARP(bf16, A_OCAT), ARP(bf16, A_OCATREF), (size_t)T * DM); }
#endif
    { int t2 = C.wave * 64 + swa::lane_id(); asm volatile("" : "+v"(t2)); C.tid = t2 & 511; C.lane = t2 & 63; }
    if (IN(27)) { FRESH_TID(); pg8::Gemm g{ARP(bf16, A_OCAT), WSP(bf16, WS_W_NSAOUT), DM, DM, DM}; pg8::DenseOrder S; S.init(T, DM, DM, DM, DM, G, c); EpiResidT<false> E{WSP(bf16, WS_XR), WSP(bf16, WS_XR), DM, WSP(float, WS_RSQ) + (size_t)2 * T * 8, (LAS float*)(C.lds + LDS_AUX)}; pg8::gemm_phase(L, g, S, E, C.tid); } SEAM(27);
    COMMON_PHASES(1, 28)
#if PROBE == 2
    xcd_barrier(bar);
    if (C.bid == 0 && C.tid == 0) ((float*)INP(N_INPUTS))[0] = (float)(tB_ - tA_) * (0.01f * PROBE_SCALE);
#elif PROBE
    xcd_barrier(bar);
    if (C.bid == 0 && C.tid == 0) { const float se = __hip_atomic_load((float*)(ctl + CW_PROBE), __ATOMIC_RELAXED, __HIP_MEMORY_SCOPE_AGENT), sr = __hip_atomic_load((float*)(ctl + CW_PROBE + 1), __ATOMIC_RELAXED, __HIP_MEMORY_SCOPE_AGENT);
        ((float*)INP(N_INPUTS))[0] = 1e6f * sqrtf(se / fmaxf(sr, 1e-30f)); }
#endif
#undef IN
#undef SEAM
}

extern "C" void kernel_launch(void* const* d_in, const int* in_sizes, int n_in, void* d_out, int out_size, void* d_ws, size_t ws_size, hipStream_t stream) {
    static int grid = 0;
    if (grid == 0) {
        if (n_in != N_INPUTS || out_size != T * DM || ws_size < WS_END) { fprintf(stderr, "kernel_launch: unexpected shapes (n_in %d, out %d, ws %zu, need %zu)\n", n_in, out_size, ws_size, (size_t)WS_END); grid = -1; return; }
        int dev = 0, cus = 0, per_cu = 0;
        if (hipGetDevice(&dev) != hipSuccess || hipDeviceGetAttribute(&cus, hipDeviceAttributeMultiprocessorCount, dev) != hipSuccess) { grid = -1; return; }
        if (hipFuncSetAttribute((const void*)mk_fwd, hipFuncAttributeMaxDynamicSharedMemorySize, LDS_BYTES) != hipSuccess) { fprintf(stderr, "kernel_launch: hipFuncSetAttribute failed\n"); grid = -1; return; }
        if (hipOccupancyMaxActiveBlocksPerMultiprocessor(&per_cu, (const void*)mk_fwd, NTHR, LDS_BYTES) != hipSuccess || per_cu < 1) fprintf(stderr, "kernel_launch: occupancy query says %d\n", per_cu);
        (void)hipGetLastError();
        grid = cus;
    }
    if (grid < 0) return;
    (void)hipMemsetAsync((char*)d_ws + WS_CTL, 0, CTL_BYTES, stream);
    Args a{};
    for (int i = 0; i < N_INPUTS; ++i) a.in[i] = (const float*)d_in[i];
    a.out = (float*)d_out; a.ws = (unsigned char*)d_ws;
#if MK_SPLIT
    for (int p = 0; p < N_PHASES; ++p) { a.ph_lo = p; a.ph_hi = p + 1; hipLaunchKernelGGL(mk_fwd, dim3(grid), dim3(NTHR), LDS_BYTES, stream, a); }
#else
    a.ph_lo = 0; a.ph_hi = N_PHASES; hipLaunchKernelGGL(mk_fwd, dim3(grid), dim3(NTHR), LDS_BYTES, stream, a);
#endif
}
```
